# Optimizing an MI355X kernel written in HIP

```python
import jax
import jax.numpy as jnp
from jax import lax
import numpy as np

D_MODEL = 1024
BATCH = 2
SEQ = 16384
DEPTH = 1

GRID_W = 64
CTX_LEN = 256
HEAD_DIM = 64
N_Q_HEADS = 8
N_KV_HEADS = 2
GQA_GROUP = N_Q_HEADS // N_KV_HEADS
ATT_WIDTH = N_Q_HEADS * HEAD_DIM
KV_WIDTH = N_KV_HEADS * HEAD_DIM
ROPE_FREQS = HEAD_DIM // 4
ROPE_BASE = 10000.0
Q_BLOCK = 128
RWKV_HEAD = 64
RWKV_HEADS = 8
RWKV_WIDTH = RWKV_HEADS * RWKV_HEAD
W_LORA = 64
A_LORA = 64
SHIFT_WIDTH = 3 * RWKV_WIDTH + 2 * W_LORA + 2 * A_LORA
IN_WIDTH = 2 * ATT_WIDTH + 2 * KV_WIDTH + SHIFT_WIDTH + RWKV_WIDTH
LN_EPS = 1e-5
QK_EPS = 1e-6
GN_EPS = 64e-5
ALPHA = (2.0 * DEPTH) ** 0.25
BETA = (8.0 * DEPTH) ** -0.25

kernel_name = 'hybrid_gqa_rwkv7_deepnorm_prefix'


def _layer_norm(x):
    xf = x.astype(jnp.float32)
    mu = jnp.mean(xf, axis=-1, keepdims=True)
    var = jnp.mean(jnp.square(xf - mu), axis=-1, keepdims=True)
    return ((xf - mu) * lax.rsqrt(var + LN_EPS)).astype(x.dtype)


def _rms_norm(x, g):
    xf = x.astype(jnp.float32)
    y = xf * lax.rsqrt(jnp.mean(jnp.square(xf), axis=-1, keepdims=True) + QK_EPS)
    return y.astype(x.dtype) * g


def _axial_rope_tables(rows):
    row = jnp.repeat(jnp.arange(rows, dtype=jnp.float32), GRID_W)
    col = jnp.tile(jnp.arange(GRID_W, dtype=jnp.float32), rows)
    inv = ROPE_BASE ** (-jnp.arange(ROPE_FREQS, dtype=jnp.float32) / ROPE_FREQS)
    ang = jnp.stack([row[:, None] * inv, col[:, None] * inv], axis=1)
    return jnp.cos(ang), jnp.sin(ang)


def _apply_axial_rope(x, cos, sin):
    xr = x.reshape(x.shape[:-1] + (2, 2, ROPE_FREQS))
    x1, x2 = xr[..., 0, :], xr[..., 1, :]
    cs, sn = cos[None, :, None], sin[None, :, None]
    out = jnp.stack([x1 * cs - x2 * sn, x2 * cs + x1 * sn], axis=-2)
    return out.reshape(x.shape).astype(x.dtype)


def _split_in(z):
    a_end = ATT_WIDTH + 2 * KV_WIDTH
    ga_end = a_end + ATT_WIDTH
    mix_end = ga_end + SHIFT_WIDTH
    return z[..., :a_end], z[..., a_end:ga_end], z[..., ga_end:mix_end], z[..., mix_end:]


def _attn_qkv(z_att, q_norm, k_norm, rope):
    b, t = z_att.shape[:2]
    zq, zk, zv = jnp.split(z_att, [ATT_WIDTH, ATT_WIDTH + KV_WIDTH], axis=-1)
    q = _rms_norm(zq.reshape(b, t, N_Q_HEADS, HEAD_DIM), q_norm)
    k = _rms_norm(zk.reshape(b, t, N_KV_HEADS, HEAD_DIM), k_norm)
    v = zv.reshape(b, t, N_KV_HEADS, HEAD_DIM)
    if rope is not None:
        q = _apply_axial_rope(q, *rope)
        k = _apply_axial_rope(k, *rope)
    return q, k, v


def _block_attention(q, k, v):
    b, t = q.shape[:2]
    nblk = t // Q_BLOCK
    qb = q.reshape(b, nblk, Q_BLOCK, N_KV_HEADS, GQA_GROUP, HEAD_DIM).transpose(1, 0, 2, 3, 4, 5)
    scale = HEAD_DIM ** -0.5

    def one_block(qblk):
        sc = jnp.einsum('bqkgd,blkd->bkgql', qblk, k).astype(jnp.float32) * scale
        p = jax.nn.softmax(sc, axis=-1).astype(v.dtype)
        return jnp.einsum('bkgql,blkd->bqkgd', p, v)

    o = lax.map(one_block, qb)
    return o.transpose(1, 0, 2, 3, 4, 5).reshape(b, t, ATT_WIDTH)


def _token_shift(z, mu_prev, mu_next):
    zero = jnp.zeros_like(z[:, :1])
    z_prev = jnp.concatenate([zero, z[:, :-1]], axis=1)
    z_next = jnp.concatenate([z[:, 1:], zero], axis=1)
    return z + mu_prev * (z_prev - z) + mu_next * (z_next - z)


def _rwkv_inputs(z_mix, mu_prev, mu_next, w0, w_up, a0, a_up, k_k, k_a):
    b, t = z_mix.shape[:2]
    z_mix = _token_shift(z_mix, mu_prev, mu_next)
    offs = [RWKV_WIDTH, 2 * RWKV_WIDTH, 3 * RWKV_WIDTH, 3 * RWKV_WIDTH + W_LORA,
            3 * RWKV_WIDTH + 2 * W_LORA, 3 * RWKV_WIDTH + 2 * W_LORA + A_LORA]
    r, k, v, wl_f, wl_b, al_f, al_b = jnp.split(z_mix, offs, axis=-1)
    heads = lambda u: u.reshape(b, t, RWKV_HEADS, RWKV_HEAD)
    kk = heads(k * k_k).astype(jnp.float32)
    kk = kk / jnp.maximum(jnp.linalg.norm(kk, axis=-1, keepdims=True), 1e-12)
    dirs = []
    for d, (wl, al) in enumerate(((wl_f, al_f), (wl_b, al_b))):
        w_log = -jax.nn.softplus(-(w0[d] + jnp.tanh(wl) @ w_up[d])) - 0.5
        decay = jnp.exp(-jnp.exp(w_log.astype(jnp.float32)))
        a = jax.nn.sigmoid(a0[d] + al @ a_up[d])
        kd = k * (1.0 + (a - 1.0) * k_a)
        dirs.append((heads(decay), heads(kd), heads(a)))
    return heads(r), heads(v), kk, dirs


def _wkv_scan(state0, r, v, kk, decay, k, a, reverse):
    f32 = jnp.float32
    xs = tuple(jnp.moveaxis(u.astype(f32), 1, 0) for u in (r, decay, k, v, kk, kk * a))

    def step(S, inp):
        r_t, d_t, k_t, v_t, kk_t, b_t = inp
        sk = jnp.einsum('bhvk,bhk->bhv', S, kk_t)
        S = S * d_t[:, :, None, :] - sk[..., None] * b_t[:, :, None, :] + v_t[..., None] * k_t[:, :, None, :]
        return S, jnp.einsum('bhvk,bhk->bhv', S, r_t)

    s_fin, o = lax.scan(step, state0, xs, reverse=reverse)
    return s_fin, jnp.moveaxis(o, 0, 1)


def _rwkv_readout(o_f, o_b, r, v, dirs, r_k, gn_w, gn_b):
    b, t = o_f.shape[:2]
    o = o_f + o_b
    mu = jnp.mean(o, axis=-1, keepdims=True)
    var = jnp.mean(jnp.square(o - mu), axis=-1, keepdims=True)
    y = ((o - mu) * lax.rsqrt(var + GN_EPS)).reshape(b, t, RWKV_WIDTH) * gn_w + gn_b
    rf, vf = r.astype(jnp.float32), v.astype(jnp.float32)
    bonus = sum(jnp.sum(rf * dirs[d][1].astype(jnp.float32) * r_k[d], axis=-1, keepdims=True) * vf
                for d in range(2))
    return (y + bonus.reshape(b, t, RWKV_WIDTH)).astype(r.dtype)


def _merge(h, y_att, y_rwkv, g_att, g_rwkv, w_pa, w_pb, w_mg, b_mg, w_o):
    ya = (y_att * jax.nn.silu(g_att)) @ w_pa
    yb = (y_rwkv * jax.nn.silu(g_rwkv)) @ w_pb
    ga, gb = jnp.split(jax.nn.sigmoid(h @ w_mg + b_mg), 2, axis=-1)
    return (ga * ya + gb * yb) @ w_o


def setup_inputs(seed: int = 0) -> dict:
    key = jax.random.key(seed)
    ks = jax.random.split(key, 32)
    f32 = jnp.float32
    nrm = lambda k, shape, s: jax.random.normal(k, shape, f32) * s
    L = DEPTH
    return {
        'x': nrm(ks[0], (BATCH, SEQ, D_MODEL), 1.0),
        'c': nrm(ks[1], (BATCH, D_MODEL), 1.0),
        'ctx': nrm(ks[2], (BATCH, CTX_LEN, D_MODEL), 1.0),
        'c_ctx': nrm(ks[3], (D_MODEL,), 1.0),
        'w_ada': nrm(ks[4], (L, D_MODEL, 3 * D_MODEL), 0.5 * D_MODEL ** -0.5),
        'b_ada': nrm(ks[5], (L, 3 * D_MODEL), 0.02),
        'w_in': nrm(ks[6], (L, D_MODEL, IN_WIDTH), D_MODEL ** -0.5),
        'q_norm': 1.0 + nrm(ks[7], (L, HEAD_DIM), 0.02),
        'k_norm': 1.0 + nrm(ks[8], (L, HEAD_DIM), 0.02),
        'mu_prev': jax.random.uniform(ks[9], (L, SHIFT_WIDTH), f32, 0.0, 0.5),
        'mu_next': jax.random.uniform(ks[10], (L, SHIFT_WIDTH), f32, 0.0, 0.5),
        'w0': jax.random.uniform(ks[11], (L, 2, RWKV_WIDTH), f32, -6.0, -1.0),
        'w_up': nrm(ks[12], (L, 2, W_LORA, RWKV_WIDTH), 0.5 * W_LORA ** -0.5),
        'a0': nrm(ks[13], (L, 2, RWKV_WIDTH), 0.1),
        'a_up': nrm(ks[14], (L, 2, A_LORA, RWKV_WIDTH), 0.5 * A_LORA ** -0.5),
        'k_k': 0.85 + nrm(ks[15], (L, RWKV_WIDTH), 0.02),
        'k_a': 1.0 + nrm(ks[16], (L, RWKV_WIDTH), 0.02),
        'r_k': nrm(ks[17], (L, 2, RWKV_HEADS, RWKV_HEAD), 0.1),
        'gn_w': 1.0 + nrm(ks[18], (L, RWKV_WIDTH), 0.02),
        'gn_b': nrm(ks[19], (L, RWKV_WIDTH), 0.02),
        'w_pa': nrm(ks[20], (L, ATT_WIDTH, D_MODEL), BETA * ATT_WIDTH ** -0.5),
        'w_pb': nrm(ks[21], (L, RWKV_WIDTH, D_MODEL), BETA * RWKV_WIDTH ** -0.5),
        'w_mg': nrm(ks[22], (L, D_MODEL, 2 * D_MODEL), D_MODEL ** -0.5),
        'b_mg': nrm(ks[23], (L, 2 * D_MODEL), 0.02),
        'w_o': nrm(ks[24], (L, D_MODEL, D_MODEL), BETA * D_MODEL ** -0.5),
        'ln_g': 1.0 + nrm(ks[25], (L, D_MODEL), 0.02),
        'ln_b': nrm(ks[26], (L, D_MODEL), 0.02),
    }


def reference(x, c, ctx, c_ctx, w_ada, b_ada, w_in, q_norm, k_norm, mu_prev, mu_next, w0, w_up,
              a0, a_up, k_k, k_a, r_k, gn_w, gn_b, w_pa, w_pb, w_mg, b_mg, w_o, ln_g, ln_b):
    b, s, _ = x.shape
    rows = s // GRID_W
    rope = _axial_rope_tables(rows)
    zero_state = jnp.zeros((b, RWKV_HEADS, RWKV_HEAD, RWKV_HEAD), jnp.float32)
    for l in range(DEPTH):
        update_ctx = l < DEPTH - 1
        sh_x, sc_x, gt_x = jnp.split(jax.nn.silu(c) @ w_ada[l] + b_ada[l], 3, axis=-1)
        sh_c, sc_c, gt_c = jnp.split(jax.nn.silu(c_ctx) @ w_ada[l] + b_ada[l], 3, axis=-1)
        h_x = _layer_norm(x) * (1.0 + sc_x[:, None]) + sh_x[:, None]
        h_c = _layer_norm(ctx) * (1.0 + sc_c) + sh_c
        att_x, ga_x, mix_x, gb_x = _split_in(h_x @ w_in[l])
        att_c, ga_c, mix_c, gb_c = _split_in(h_c @ w_in[l])
        q_x, k_x, v_x = _attn_qkv(att_x, q_norm[l], k_norm[l], rope)
        q_c, k_c, v_c = _attn_qkv(att_c, q_norm[l], k_norm[l], None)
        y_att_x = _block_attention(q_x, jnp.concatenate([k_c, k_x], axis=1),
                                   jnp.concatenate([v_c, v_x], axis=1))
        rp = (mu_prev[l], mu_next[l], w0[l], w_up[l], a0[l], a_up[l], k_k[l], k_a[l])
        r_c, vr_c, kk_c, dirs_c = _rwkv_inputs(mix_c, *rp)
        r_x, vr_x, kk_x, dirs_x = _rwkv_inputs(mix_x, *rp)
        s_cf, o_cf = _wkv_scan(zero_state, r_c, vr_c, kk_c, *dirs_c[0], reverse=False)
        s_cb, o_cb = _wkv_scan(zero_state, r_c, vr_c, kk_c, *dirs_c[1], reverse=True)
        _, o_xf = _wkv_scan(s_cf, r_x, vr_x, kk_x, *dirs_x[0], reverse=False)
        _, o_xb = _wkv_scan(s_cb, r_x, vr_x, kk_x, *dirs_x[1], reverse=True)
        y_rwkv_x = _rwkv_readout(o_xf, o_xb, r_x, vr_x, dirs_x, r_k[l], gn_w[l], gn_b[l])
        out_x = _merge(h_x, y_att_x, y_rwkv_x, ga_x, gb_x, w_pa[l], w_pb[l], w_mg[l], b_mg[l], w_o[l])
        x_new = _layer_norm(ALPHA * x + gt_x[:, None] * out_x) * ln_g[l] + ln_b[l]
        if update_ctx:
            y_att_c = _block_attention(q_c, k_c, v_c)
            y_rwkv_c = _rwkv_readout(o_cf, o_cb, r_c, vr_c, dirs_c, r_k[l], gn_w[l], gn_b[l])
            out_c = _merge(h_c, y_att_c, y_rwkv_c, ga_c, gb_c, w_pa[l], w_pb[l], w_mg[l], b_mg[l], w_o[l])
            ctx = _layer_norm(ALPHA * ctx + gt_c * out_c) * ln_g[l] + ln_b[l]
        x = x_new
    return x
```

```cpp
#include <hip/hip_runtime.h>
#include <hip/hip_cooperative_groups.h>
#include <stdint.h>
#include <cstdio>
namespace cg = cooperative_groups;

#define PROBE 0
#define DI __device__ __forceinline__
typedef __attribute__((ext_vector_type(8))) short bf16x8;
typedef __attribute__((ext_vector_type(16))) float f32x16;
typedef __attribute__((ext_vector_type(16))) uint32_t u32x16;
typedef __attribute__((ext_vector_type(2))) _Float16 h2;
typedef __attribute__((ext_vector_type(2))) __bf16 b2;
typedef unsigned short ushort_t;
#define MFMA(a, b, c) __builtin_amdgcn_mfma_f32_32x32x16_bf16((a), (b), (c), 0, 0, 0)

constexpr int DM = 1024, NB = 2, SEQ = 16384, CTXL = 256;
constexpr int NX = NB * SEQ, NC = NB * CTXL, NT = NX + NC;
constexpr int INW = 3584, LTOT = CTXL + SEQ;
constexpr int NTH = 512;
constexpr int CH = 130, NCHUNK = LTOT / CH;
static_assert(NCHUNK * CH == LTOT, "chunking");
constexpr float LN_EPS = 1e-5f, QK_EPS = 1e-6f, GN_EPS = 64e-5f;
constexpr float ALPHA = 1.189207115002721f;
constexpr float QSCALE = 0.125f * 1.4426950408889634f;

constexpr size_t OFF_WIN = 0;
constexpr size_t OFF_WMG = OFF_WIN + (size_t)INW * DM * 2;
constexpr size_t OFF_WPA = OFF_WMG + (size_t)2048 * DM * 2;
constexpr size_t OFF_WPB = OFF_WPA + (size_t)1024 * 512 * 2;
constexpr size_t OFF_WO  = OFF_WPB + (size_t)1024 * 512 * 2;
constexpr size_t OFF_WL  = OFF_WO + (size_t)1024 * 1024 * 2;
constexpr size_t OFF_MOD = OFF_WL + (size_t)2 * 2 * 512 * 64 * 2;
constexpr size_t OFF_ZG  = OFF_MOD + 36864;
constexpr size_t OFF_QB  = OFF_ZG + (size_t)NX * 1024 * 2;
constexpr size_t OFF_KB  = OFF_QB + (size_t)NX * 512 * 2;
constexpr size_t OFF_VB  = OFF_KB + (size_t)NB * 2 * LTOT * 64 * 2;
constexpr size_t OFF_SH  = OFF_VB + (size_t)NB * 2 * LTOT * 64 * 2;
constexpr size_t OFF_DR  = OFF_SH + (size_t)16 * LTOT * 192 * 2;
constexpr size_t OFF_ZQ  = OFF_DR + (size_t)32 * LTOT * 192 * 2;
constexpr size_t WS_END  = OFF_ZQ + (size_t)2 * NX * 512 * 2;
static_assert(WS_END <= (size_t)536870912, "workspace");
static_assert((size_t)NT * DM * 2 <= (size_t)48 * LTOT * 192 * 2, "H alias");
static_assert((size_t)NT * 768 * 2 <= (size_t)2 * NX * 512 * 2, "zqkv alias");

struct Params {
  const float *x, *c, *ctx, *c_ctx, *w_ada, *b_ada, *w_in, *q_norm, *k_norm, *mu_prev, *mu_next, *w0, *w_up, *a0, *a_up, *k_k, *k_a,
      *r_k, *gn_w, *gn_b, *w_pa, *w_pb, *w_mg, *b_mg, *w_o, *ln_g, *ln_b;
  float* out;
  unsigned char* ws;
};

DI ushort_t f2bf(float f) { return __builtin_bit_cast(ushort_t, (__bf16)f); }
DI float bf2f(ushort_t b) { return __uint_as_float(((unsigned)b) << 16); }
DI unsigned pack_bf2(float a, float b) { b2 v = {(__bf16)a, (__bf16)b}; return __builtin_bit_cast(unsigned, v); }
DI unsigned pack_h2(float a, float b) { h2 v = {(_Float16)a, (_Float16)b}; return __builtin_bit_cast(unsigned, v); }
DI ushort_t f2h(float f) { return __builtin_bit_cast(ushort_t, (_Float16)f); }
DI float h2f(ushort_t h) { return (float)__builtin_bit_cast(_Float16, h); }
DI float bflo(unsigned u) { return __uint_as_float(u << 16); }
DI float bfhi(unsigned u) { return __uint_as_float(u & 0xffff0000u); }
DI float hlo(unsigned u) { return (float)__builtin_bit_cast(h2, u)[0]; }
DI float hhi(unsigned u) { return (float)__builtin_bit_cast(h2, u)[1]; }
DI float sigmf(float v) { return __builtin_amdgcn_rcpf(1.f + __expf(-v)); }
DI float siluf(float v) { return v * sigmf(v); }
DI int crow(int reg, int h) { return (reg & 3) + 8 * (reg >> 2) + 4 * h; }
DI float wave_sum(float v) {
#pragma unroll
  for (int o = 32; o >= 1; o >>= 1) v += __shfl_xor(v, o, 64);
  return v;
}
DI f32x16 zero16() { f32x16 z;
#pragma unroll
  for (int i = 0; i < 16; ++i) z[i] = 0.f; return z; }

#define SCAN_VLOAD 0
#define PROBE_NAIVE_SCAN 0
#if SCAN_VLOAD
DI void sload2(u32x16& a0, u32x16& a1, const void* p) { a0 = *(const u32x16*)p; a1 = *((const u32x16*)p + 1); }
DI void sload4(u32x16& a0, u32x16& a1, u32x16& b0, u32x16& b1, const void* p, const void* q) {
  a0 = *(const u32x16*)p; a1 = *((const u32x16*)p + 1); b0 = *(const u32x16*)q; b1 = *((const u32x16*)q + 1);
}
#else
DI void sload2(u32x16& a0, u32x16& a1, const void* p) {
  asm volatile("s_load_dwordx16 %0, %2, 0x0\n\ts_load_dwordx16 %1, %2, 0x40\n\ts_waitcnt lgkmcnt(0)" : "=&s"(a0), "=&s"(a1) : "s"(p) : "memory");
}
DI void sload4(u32x16& a0, u32x16& a1, u32x16& b0, u32x16& b1, const void* p, const void* q) {
  asm volatile("s_load_dwordx16 %0, %4, 0x0\n\ts_load_dwordx16 %1, %4, 0x40\n\ts_load_dwordx16 %2, %5, 0x0\n\ts_load_dwordx16 %3, %5, 0x40\n\ts_waitcnt lgkmcnt(0)"
               : "=&s"(a0), "=&s"(a1), "=&s"(b0), "=&s"(b1) : "s"(p), "s"(q) : "memory");
}
#endif
DI float HV(const u32x16& v, int j) { const uint32_t w = v[j >> 1]; const h2 t = __builtin_bit_cast(h2, w); return (float)t[j & 1]; }

constexpr int LDK = 72;
template <int BM, int BN, int MI, int NI, class AL, class BL>
DI void gemm_pass(f32x16 (&acc)[MI][NI], AL aload, BL bload, int K, ushort_t* As, ushort_t* Bs, int wrow0, int wcol0, int tid) {
  constexpr int NA = BM * 8 / NTH, NBC = BN * 8 / NTH;
  const int lane = tid & 63, l31 = lane & 31, hh = lane >> 5;
  uint4 ra[NA], rb[NBC];
#pragma unroll
  for (int i = 0; i < NA; ++i) { const int id = tid + i * NTH; ra[i] = aload(id >> 3, (id & 7) * 8); }
#pragma unroll
  for (int i = 0; i < NBC; ++i) { const int id = tid + i * NTH; rb[i] = bload(id >> 3, (id & 7) * 8); }
#pragma unroll 1
  for (int k0 = 0; k0 < K; k0 += 64) {
    __syncthreads();
#pragma unroll
    for (int i = 0; i < NA; ++i) { const int id = tid + i * NTH; *(uint4*)&As[(id >> 3) * LDK + (id & 7) * 8] = ra[i]; }
#pragma unroll
    for (int i = 0; i < NBC; ++i) { const int id = tid + i * NTH; *(uint4*)&Bs[(id >> 3) * LDK + (id & 7) * 8] = rb[i]; }
    __syncthreads();
    if (k0 + 64 < K) {
#pragma unroll
      for (int i = 0; i < NA; ++i) { const int id = tid + i * NTH; ra[i] = aload(id >> 3, k0 + 64 + (id & 7) * 8); }
#pragma unroll
      for (int i = 0; i < NBC; ++i) { const int id = tid + i * NTH; rb[i] = bload(id >> 3, k0 + 64 + (id & 7) * 8); }
    }
#pragma unroll
    for (int ks = 0; ks < 4; ++ks) {
      bf16x8 af[MI], bfv[NI];
#pragma unroll
      for (int mi = 0; mi < MI; ++mi) af[mi] = *(const bf16x8*)&As[(wrow0 + mi * 32 + l31) * LDK + ks * 16 + hh * 8];
#pragma unroll
      for (int ni = 0; ni < NI; ++ni) bfv[ni] = *(const bf16x8*)&Bs[(wcol0 + ni * 32 + l31) * LDK + ks * 16 + hh * 8];
#pragma unroll
      for (int mi = 0; mi < MI; ++mi)
#pragma unroll
        for (int ni = 0; ni < NI; ++ni) acc[mi][ni] = MFMA(af[mi], bfv[ni], acc[mi][ni]);
    }
  }
}

DI void transpose_tile(const float* __restrict__ src, int ld_src, ushort_t* dst, int ld_dst, int k0, int n0, float* T) {
  const int tid = threadIdx.x;
#pragma unroll
  for (int i = 0; i < 2; ++i) {
    const int k = (tid >> 4) + 32 * i, n4 = (tid & 15) * 4;
    const float4 v = *(const float4*)(src + (size_t)(k0 + k) * ld_src + n0 + n4);
    T[k * 65 + n4 + 0] = v.x; T[k * 65 + n4 + 1] = v.y; T[k * 65 + n4 + 2] = v.z; T[k * 65 + n4 + 3] = v.w;
  }
  __syncthreads();
  const int n = tid >> 3, kc = tid & 7;
  uint4 o;
  o.x = pack_bf2(T[(kc * 8 + 0) * 65 + n], T[(kc * 8 + 1) * 65 + n]);
  o.y = pack_bf2(T[(kc * 8 + 2) * 65 + n], T[(kc * 8 + 3) * 65 + n]);
  o.z = pack_bf2(T[(kc * 8 + 4) * 65 + n], T[(kc * 8 + 5) * 65 + n]);
  o.w = pack_bf2(T[(kc * 8 + 6) * 65 + n], T[(kc * 8 + 7) * 65 + n]);
  *(uint4*)(dst + (size_t)(n0 + n) * ld_dst + k0 + kc * 8) = o;
  __syncthreads();
}

DI void phase0(const Params& p, unsigned char* smem) {
  float* T = (float*)smem;
  ushort_t* win = (ushort_t*)(p.ws + OFF_WIN);
  ushort_t* wmg = (ushort_t*)(p.ws + OFF_WMG);
  ushort_t* wpa = (ushort_t*)(p.ws + OFF_WPA);
  ushort_t* wpb = (ushort_t*)(p.ws + OFF_WPB);
  ushort_t* wo = (ushort_t*)(p.ws + OFF_WO);
  ushort_t* wl = (ushort_t*)(p.ws + OFF_WL);
  float* mod = (float*)(p.ws + OFF_MOD);
  constexpr int T_IN = 16 * 56, T_MG = 16 * 32, T_PA = 8 * 16, T_PB = 8 * 16, T_O = 16 * 16, T_L = 32, T_MOD = 48;
  constexpr int TOTAL = T_MOD + T_IN + T_MG + T_PA + T_PB + T_O + T_L;
  for (int t = blockIdx.x; t < TOTAL; t += gridDim.x) {
    int u = t;
    if (u < T_MOD) {
      float* sil = T;
      float* red = T + 3072;
      const int tid = threadIdx.x;
      for (int i = tid; i < 3072; i += NTH) {
        const int v = i >> 10, k = i & 1023;
        const float cv = (v < 2) ? p.c[v * 1024 + k] : p.c_ctx[k];
        sil[i] = siluf(cv);
      }
      __syncthreads();
      const int n = tid & 63, ksl = tid >> 6, n0 = u * 64;
      float a0 = 0.f, a1 = 0.f, a2 = 0.f;
      for (int k = ksl * 128; k < ksl * 128 + 128; ++k) {
        const float w = p.w_ada[(size_t)k * 3072 + n0 + n];
        a0 = fmaf(sil[k], w, a0); a1 = fmaf(sil[1024 + k], w, a1); a2 = fmaf(sil[2048 + k], w, a2);
      }
      red[(ksl * 3 + 0) * 64 + n] = a0; red[(ksl * 3 + 1) * 64 + n] = a1; red[(ksl * 3 + 2) * 64 + n] = a2;
      __syncthreads();
      if (tid < 192) {
        const int v = tid >> 6, nn = tid & 63;
        float s = 0.f;
#pragma unroll
        for (int q = 0; q < 8; ++q) s += red[(q * 3 + v) * 64 + nn];
        mod[v * 3072 + n0 + nn] = s + p.b_ada[n0 + nn];
      }
      __syncthreads();
      continue;
    }
    u -= T_MOD;
    if (u < T_IN) { transpose_tile(p.w_in, INW, win, 1024, (u / 56) * 64, (u % 56) * 64, T); continue; }
    u -= T_IN;
    if (u < T_MG) { transpose_tile(p.w_mg, 2048, wmg, 1024, (u / 32) * 64, (u % 32) * 64, T); continue; }
    u -= T_MG;
    if (u < T_PA) { transpose_tile(p.w_pa, 1024, wpa, 512, (u / 16) * 64, (u % 16) * 64, T); continue; }
    u -= T_PA;
    if (u < T_PB) { transpose_tile(p.w_pb, 1024, wpb, 512, (u / 16) * 64, (u % 16) * 64, T); continue; }
    u -= T_PB;
    if (u < T_O) { transpose_tile(p.w_o, 1024, wo, 1024, (u / 16) * 64, (u % 16) * 64, T); continue; }
    u -= T_O;
    {
      const int which = u >> 4, dir = (u >> 3) & 1, nt = u & 7;
      const float* src = (which ? p.a_up : p.w_up) + (size_t)dir * 64 * 512;
      transpose_tile(src, 512, wl + (size_t)((dir * 2 + which) * 512) * 64, 64, 0, nt * 64, T);
    }
  }
}

DI void phase_h(const Params& p) {
  const float* mod = (const float*)(p.ws + OFF_MOD);
  ushort_t* H = (ushort_t*)(p.ws + OFF_SH);
  const int lane = threadIdx.x & 63, gw = blockIdx.x * 8 + (threadIdx.x >> 6);
  for (int row = gw; row < NT; row += gridDim.x * 8) {
    const float* src = (row < NX) ? p.x + (size_t)row * DM : p.ctx + (size_t)(row - NX) * DM;
    const float* md = mod + ((row < NX) ? (row / SEQ) : 2) * 3072;
    float4 v[4];
    float s = 0.f;
#pragma unroll
    for (int i = 0; i < 4; ++i) { v[i] = *(const float4*)(src + lane * 4 + 256 * i); s += v[i].x + v[i].y + v[i].z + v[i].w; }
    const float mu = wave_sum(s) * (1.f / DM);
    float q = 0.f;
#pragma unroll
    for (int i = 0; i < 4; ++i) { v[i].x -= mu; v[i].y -= mu; v[i].z -= mu; v[i].w -= mu; q += v[i].x * v[i].x + v[i].y * v[i].y + v[i].z * v[i].z + v[i].w * v[i].w; }
    const float rstd = rsqrtf(wave_sum(q) * (1.f / DM) + LN_EPS);
#pragma unroll
    for (int i = 0; i < 4; ++i) {
      const int col = lane * 4 + 256 * i;
      const float4 sh = *(const float4*)(md + col), sc = *(const float4*)(md + 1024 + col);
      uint2 o;
      o.x = pack_bf2(v[i].x * rstd * (1.f + sc.x) + sh.x, v[i].y * rstd * (1.f + sc.y) + sh.y);
      o.y = pack_bf2(v[i].z * rstd * (1.f + sc.z) + sh.z, v[i].w * rstd * (1.f + sc.w) + sh.w);
      *(uint2*)(H + (size_t)row * DM + col) = o;
    }
  }
}

DI void phase_gemm1(const Params& p, unsigned char* smem) {
  ushort_t* As = (ushort_t*)smem;
  ushort_t* Bs = As + 256 * LDK;
  const ushort_t* H = (const ushort_t*)(p.ws + OFF_SH);
  const ushort_t* W = (const ushort_t*)(p.ws + OFF_WIN);
  ushort_t* zq = (ushort_t*)(p.ws + OFF_ZQ);
  ushort_t* zg = (ushort_t*)(p.ws + OFF_ZG);
  ushort_t* zm = (ushort_t*)p.out;
  const int tid = threadIdx.x, wave = tid >> 6, lane = tid & 63, l31 = lane & 31, hh = lane >> 5;
  const int wrow0 = (wave & 3) * 64, wcol0 = (wave >> 2) * 64;
  constexpr int MT = NT / 256, NTL = INW / 128;
  for (int t = blockIdx.x; t < MT * NTL; t += gridDim.x) {
    const int mt = t / NTL, nt = t % NTL;
    const bool is_g = (nt >= 6 && nt < 10) || nt >= 24;
    if (is_g && mt >= NX / 256) continue;
    const int row0 = mt * 256, col0 = nt * 128;
    f32x16 acc[2][2];
#pragma unroll
    for (int a = 0; a < 2; ++a)
#pragma unroll
      for (int b = 0; b < 2; ++b) acc[a][b] = zero16();
    auto aload = [&](int r, int k) { return *(const uint4*)(H + (size_t)(row0 + r) * DM + k); };
    auto bload = [&](int n, int k) { return *(const uint4*)(W + (size_t)(col0 + n) * DM + k); };
    gemm_pass<256, 128, 2, 2>(acc, aload, bload, DM, As, Bs, wrow0, wcol0, tid);
    ushort_t* dst; int ld, cbase;
    if (nt < 6) { dst = zq; ld = 768; cbase = col0; }
    else if (nt < 10) { dst = zg; ld = 1024; cbase = col0 - 768; }
    else if (nt < 24) { dst = zm; ld = 1792; cbase = col0 - 1280; }
    else { dst = zg; ld = 1024; cbase = 512 + col0 - 3072; }
#pragma unroll
    for (int mi = 0; mi < 2; ++mi)
#pragma unroll
      for (int ni = 0; ni < 2; ++ni)
#pragma unroll
        for (int i = 0; i < 16; ++i) {
          const int row = row0 + wrow0 + mi * 32 + crow(i, hh), col = cbase + wcol0 + ni * 32 + l31;
          dst[(size_t)row * ld + col] = f2bf(acc[mi][ni][i]);
        }
  }
}

DI void phase_qkv(const Params& p) {
  const ushort_t* zq = (const ushort_t*)(p.ws + OFF_ZQ);
  ushort_t* QB = (ushort_t*)(p.ws + OFF_QB);
  ushort_t* KB = (ushort_t*)(p.ws + OFF_KB);
  ushort_t* VB = (ushort_t*)(p.ws + OFF_VB);
  const int lane = threadIdx.x & 63, gw = blockIdx.x * 8 + (threadIdx.x >> 6);
  const int j = lane & 31, half = lane >> 5, axis = j >> 4, f = j & 15;
  const int d1 = axis * 32 + f, d2 = d1 + 16;
  const float inv = powf(10000.f, -(float)f * (1.f / 16.f));
  const float gq1 = p.q_norm[d1], gq2 = p.q_norm[d2], gk1 = p.k_norm[d1], gk2 = p.k_norm[d2];
  for (int row = gw; row < NT; row += gridDim.x * 8) {
    const bool isx = row < NX;
    const int b = isx ? row / SEQ : (row - NX) / CTXL;
    const int t = isx ? row % SEQ : (row - NX) % CTXL;
    const int pos = isx ? CTXL + t : t;
    const ushort_t* z = zq + (size_t)row * 768;
    float cs = 1.f, sn = 0.f;
    if (isx) { const float ang = (float)(axis ? (t & 63) : (t >> 6)) * inv; sincosf(ang, &sn, &cs); }
#pragma unroll
    for (int it = 0; it < 5; ++it) {
      const int hd = it * 2 + half;
      if (!isx && hd < 8) continue;
      const float v1 = bf2f(z[hd * 64 + d1]), v2 = bf2f(z[hd * 64 + d2]);
      float ss = v1 * v1 + v2 * v2;
#pragma unroll
      for (int o = 16; o >= 1; o >>= 1) ss += __shfl_xor(ss, o, 64);
      const float rms = rsqrtf(ss * (1.f / 64.f) + QK_EPS);
      const bool isq = hd < 8;
      const float y1 = v1 * rms * (isq ? gq1 : gk1), y2 = v2 * rms * (isq ? gq2 : gk2);
      float o1 = y1 * cs - y2 * sn, o2 = y2 * cs + y1 * sn;
      if (isq) {
        ushort_t* dst = QB + ((size_t)(b * 8 + hd) * SEQ + t) * 64;
        dst[d1] = f2bf(o1 * QSCALE); dst[d2] = f2bf(o2 * QSCALE);
      } else {
        ushort_t* dst = KB + ((size_t)(b * 2 + (hd - 8)) * LTOT + pos) * 64;
        dst[d1] = f2bf(o1); dst[d2] = f2bf(o2);
      }
    }
    VB[((size_t)(b * 2 + 0) * LTOT + pos) * 64 + lane] = z[640 + lane];
    VB[((size_t)(b * 2 + 1) * LTOT + pos) * 64 + lane] = z[704 + lane];
  }
}

DI void phase_rwkv_prep(const Params& p, unsigned char* smem) {
  float* kbuf = (float*)smem;
  ushort_t* codes = (ushort_t*)(smem + 65536);
  float* invn = (float*)(smem + 65536 + 32 * 264 * 2);
  const ushort_t* zm = (const ushort_t*)p.out;
  const ushort_t* WL = (const ushort_t*)(p.ws + OFF_WL);
  ushort_t* SH = (ushort_t*)(p.ws + OFF_SH);
  ushort_t* DR = (ushort_t*)(p.ws + OFF_DR);
  const int tid = threadIdx.x, wave = tid >> 6, lane = tid & 63, l31 = lane & 31, hh = lane >> 5;
  for (int tt = blockIdx.x; tt < NT / 32; tt += gridDim.x) {
    const int row0 = tt * 32;
    int b, t0, len, pbase;
    if (row0 < NX) { b = row0 / SEQ; t0 = row0 % SEQ; len = SEQ; pbase = CTXL; }
    else { const int rc = row0 - NX; b = rc / CTXL; t0 = rc % CTXL; len = CTXL; pbase = 0; }
    __syncthreads();
    for (int id = tid; id < 32 * 224; id += NTH) {
      const int i = id / 224, c0 = (id % 224) * 8;
      const int t = t0 + i;
      const ushort_t* zr = zm + (size_t)(row0 + i) * 1792 + c0;
      const uint4 zc = *(const uint4*)zr;
      uint4 zp = make_uint4(0, 0, 0, 0), zn = make_uint4(0, 0, 0, 0);
      if (t > 0) zp = *(const uint4*)(zr - 1792);
      if (t < len - 1) zn = *(const uint4*)(zr + 1792);
      const float4 mp0 = *(const float4*)(p.mu_prev + c0), mp1 = *(const float4*)(p.mu_prev + c0 + 4);
      const float4 mn0 = *(const float4*)(p.mu_next + c0), mn1 = *(const float4*)(p.mu_next + c0 + 4);
      const unsigned zcw[4] = {zc.x, zc.y, zc.z, zc.w}, zpw[4] = {zp.x, zp.y, zp.z, zp.w}, znw[4] = {zn.x, zn.y, zn.z, zn.w};
      const float mpv[8] = {mp0.x, mp0.y, mp0.z, mp0.w, mp1.x, mp1.y, mp1.z, mp1.w};
      const float mnv[8] = {mn0.x, mn0.y, mn0.z, mn0.w, mn1.x, mn1.y, mn1.z, mn1.w};
      float s[8];
#pragma unroll
      for (int q = 0; q < 4; ++q) {
        const float c_lo = bflo(zcw[q]), c_hi = bfhi(zcw[q]);
        s[2 * q] = c_lo + mpv[2 * q] * (bflo(zpw[q]) - c_lo) + mnv[2 * q] * (bflo(znw[q]) - c_lo);
        s[2 * q + 1] = c_hi + mpv[2 * q + 1] * (bfhi(zpw[q]) - c_hi) + mnv[2 * q + 1] * (bfhi(znw[q]) - c_hi);
      }
      const int pp = pbase + t;
      if (c0 < 512 || (c0 >= 1024 && c0 < 1536)) {
        const int cc = (c0 < 512) ? c0 : c0 - 1024, which = (c0 < 512) ? 1 : 2;
        const int head = cc >> 6, d = cc & 63;
        uint4 o;
        o.x = pack_h2(s[0], s[1]); o.y = pack_h2(s[2], s[3]); o.z = pack_h2(s[4], s[5]); o.w = pack_h2(s[6], s[7]);
        *(uint4*)(SH + (((size_t)(b * 8 + head) * LTOT + pp) * 3 + which) * 64 + d) = o;
      } else if (c0 < 1024) {
        float* kd = kbuf + i * 512 + (c0 - 512);
        *(float4*)kd = make_float4(s[0], s[1], s[2], s[3]);
        *(float4*)(kd + 4) = make_float4(s[4], s[5], s[6], s[7]);
      } else {
        const int cc = c0 - 1536;
        if (cc < 128) {
#pragma unroll
          for (int q = 0; q < 8; ++q) s[q] = tanhf(s[q]);
        }
        uint4 o;
        o.x = pack_bf2(s[0], s[1]); o.y = pack_bf2(s[2], s[3]); o.z = pack_bf2(s[4], s[5]); o.w = pack_bf2(s[6], s[7]);
        *(uint4*)(codes + i * 264 + cc) = o;
      }
    }
    __syncthreads();
    {
      const int i = tid >> 4, head = (tid >> 1) & 7, hf = tid & 1;
      float ss = 0.f;
#pragma unroll 8
      for (int q = 0; q < 32; ++q) {
        const int n = head * 64 + hf * 32 + q;
        const float v = kbuf[i * 512 + n] * p.k_k[n];
        ss = fmaf(v, v, ss);
      }
      ss += __shfl_xor(ss, 1, 64);
      if (hf == 0) invn[i * 8 + head] = 1.f / fmaxf(sqrtf(ss), 1e-12f);
    }
    __syncthreads();
#pragma unroll 1
    for (int q4 = 0; q4 < 4; ++q4) {
      const int pr = wave * 4 + q4, dir = pr >> 4, ct = pr & 15;
      f32x16 aw = zero16(), aa = zero16();
#pragma unroll
      for (int ks = 0; ks < 4; ++ks) {
        const bf16x8 fw = *(const bf16x8*)&codes[l31 * 264 + dir * 64 + ks * 16 + hh * 8];
        const bf16x8 fa = *(const bf16x8*)&codes[l31 * 264 + 128 + dir * 64 + ks * 16 + hh * 8];
        const bf16x8 bw = *(const bf16x8*)&WL[(size_t)((dir * 2 + 0) * 512 + ct * 32 + l31) * 64 + ks * 16 + hh * 8];
        const bf16x8 ba = *(const bf16x8*)&WL[(size_t)((dir * 2 + 1) * 512 + ct * 32 + l31) * 64 + ks * 16 + hh * 8];
        aw = MFMA(fw, bw, aw);
        aa = MFMA(fa, ba, aa);
      }
      const int n = ct * 32 + l31, head = n >> 6, d = n & 63;
      const float w0v = p.w0[dir * 512 + n], a0v = p.a0[dir * 512 + n], kkw = p.k_k[n], kaw = p.k_a[n];
      const size_t cbase = (size_t)(b * 8 + head) * LTOT;
#pragma unroll
      for (int i = 0; i < 16; ++i) {
        const int ti = crow(i, hh);
        const int pp = pbase + t0 + ti;
        const float wpre = aw[i] + w0v;
        const float wlog = -log1pf(expf(-wpre)) - 0.5f;
        const float e = expf(wlog);
        const float xdec = -expm1f(-e);
        const float a = sigmf(aa[i] + a0v);
        const float kv = kbuf[ti * 512 + n];
        const float kkv = kv * kkw * invn[ti * 8 + head];
        const float kd = kv * (1.f + (a - 1.f) * kaw);
        ushort_t* dr = DR + ((((size_t)dir * 16) * LTOT + cbase + pp) * 3) * 64 + d;
        dr[0] = f2h(xdec); dr[64] = f2h(kd); dr[128] = f2h(kkv * a);
        if (dir == 0) SH[((cbase + pp) * 3) * 64 + d] = f2h(kkv);
      }
    }
  }
}

DI int tau_to_pos(int dir, int tau) { return dir == 0 ? tau : (tau < CTXL ? CTXL - 1 - tau : LTOT - 1 - (tau - CTXL)); }

DI void phase_scanA(const Params& p) {
  const ushort_t* SH = (const ushort_t*)(p.ws + OFF_SH);
  const ushort_t* DR = (const ushort_t*)(p.ws + OFF_DR);
  float* PU = p.out;
  const int lane = threadIdx.x & 63;
  const int gw = __builtin_amdgcn_readfirstlane(blockIdx.x * 8 + (threadIdx.x >> 6));
  for (int wt = gw; wt < 32 * NCHUNK * 2; wt += gridDim.x * 8) {
    const int task = wt >> 1, half = wt & 1;
    const int cd = task / NCHUNK, j = task % NCHUNK, dir = cd >> 4, c = cd & 15;
    float S[64];
#pragma unroll
    for (int k = 0; k < 64; ++k) S[k] = (half && k == lane) ? 1.f : 0.f;
    const ushort_t* shc = SH + (size_t)c * LTOT * 192;
    const ushort_t* drc = DR + (size_t)(dir * 16 + c) * LTOT * 192;
#pragma unroll 1
    for (int st = 0; st < CH; ++st) {
      const int pos = tau_to_pos(dir, j * CH + st);
      const ushort_t* shr = shc + (size_t)pos * 192;
      const ushort_t* drr = drc + (size_t)pos * 192;
      const float vv = half ? 0.f : h2f(shr[128 + lane]);
      u32x16 k0, k1;
      sload2(k0, k1, shr);
      float sk0 = 0.f, sk1 = 0.f;
#pragma unroll
      for (int q = 0; q < 32; ++q) { sk0 = fmaf(S[q], HV(k0, q), sk0); sk1 = fmaf(S[32 + q], HV(k1, q), sk1); }
      const float nsk = -(sk0 + sk1);
      u32x16 x0, x1, d0, d1;
      sload4(x0, x1, d0, d1, drr, drr + 64);
#pragma unroll
      for (int q = 0; q < 32; ++q) {
        S[q] = fmaf(S[q], -HV(x0, q), S[q]); S[32 + q] = fmaf(S[32 + q], -HV(x1, q), S[32 + q]);
        S[q] = fmaf(vv, HV(d0, q), S[q]); S[32 + q] = fmaf(vv, HV(d1, q), S[32 + q]);
      }
      u32x16 b0, b1;
      sload2(b0, b1, drr + 128);
#pragma unroll
      for (int q = 0; q < 32; ++q) { S[q] = fmaf(nsk, HV(b0, q), S[q]); S[32 + q] = fmaf(nsk, HV(b1, q), S[32 + q]); }
    }
    float* dst = PU + ((size_t)task * 2 + half) * 4096 + lane * 64;
#pragma unroll
    for (int k = 0; k < 64; k += 4) *(float4*)(dst + k) = make_float4(S[k], S[k + 1], S[k + 2], S[k + 3]);
  }
}

DI void phase_scanB(const Params& p, unsigned char* smem) {
  if (blockIdx.x >= 32) return;
  float* Sb = (float*)smem;
  float* Pb = Sb + 64 * 65;
  float* PU = p.out;
  const int cd = blockIdx.x, tid = threadIdx.x, i = tid >> 3, n0 = (tid & 7) * 8;
  float s[8], pn[8], un[8];
#pragma unroll
  for (int q = 0; q < 8; ++q) s[q] = 0.f;
  {
    const float* base = PU + (size_t)(cd * NCHUNK) * 2 * 4096;
    const float4 a = *(const float4*)(base + 4096 + tid * 8), b = *(const float4*)(base + 4096 + tid * 8 + 4);
    const float4 c = *(const float4*)(base + i * 64 + n0), d = *(const float4*)(base + i * 64 + n0 + 4);
    pn[0] = a.x; pn[1] = a.y; pn[2] = a.z; pn[3] = a.w; pn[4] = b.x; pn[5] = b.y; pn[6] = b.z; pn[7] = b.w;
    un[0] = c.x; un[1] = c.y; un[2] = c.z; un[3] = c.w; un[4] = d.x; un[5] = d.y; un[6] = d.z; un[7] = d.w;
  }
#pragma unroll 1
  for (int j = 0; j < NCHUNK; ++j) {
    float* base = PU + (size_t)(cd * NCHUNK + j) * 2 * 4096;
    float u[8];
    __syncthreads();
#pragma unroll
    for (int q = 0; q < 8; ++q) { Pb[tid * 8 + q] = pn[q]; u[q] = un[q]; Sb[i * 65 + n0 + q] = s[q]; }
    __syncthreads();
    *(float4*)(base + 4096 + i * 64 + n0) = make_float4(s[0], s[1], s[2], s[3]);
    *(float4*)(base + 4096 + i * 64 + n0 + 4) = make_float4(s[4], s[5], s[6], s[7]);
    if (j + 1 < NCHUNK) {
      const float* nb = base + 2 * 4096;
      const float4 a = *(const float4*)(nb + 4096 + tid * 8), b = *(const float4*)(nb + 4096 + tid * 8 + 4);
      const float4 c = *(const float4*)(nb + i * 64 + n0), d = *(const float4*)(nb + i * 64 + n0 + 4);
      pn[0] = a.x; pn[1] = a.y; pn[2] = a.z; pn[3] = a.w; pn[4] = b.x; pn[5] = b.y; pn[6] = b.z; pn[7] = b.w;
      un[0] = c.x; un[1] = c.y; un[2] = c.z; un[3] = c.w; un[4] = d.x; un[5] = d.y; un[6] = d.z; un[7] = d.w;
    }
#pragma unroll
    for (int q = 0; q < 8; ++q) s[q] = u[q];
#pragma unroll 8
    for (int k = 0; k < 64; ++k) {
      const float a = Sb[i * 65 + k];
      const float4 p0 = *(const float4*)&Pb[k * 64 + n0], p1 = *(const float4*)&Pb[k * 64 + n0 + 4];
      s[0] = fmaf(a, p0.x, s[0]); s[1] = fmaf(a, p0.y, s[1]); s[2] = fmaf(a, p0.z, s[2]); s[3] = fmaf(a, p0.w, s[3]);
      s[4] = fmaf(a, p1.x, s[4]); s[5] = fmaf(a, p1.y, s[5]); s[6] = fmaf(a, p1.z, s[6]); s[7] = fmaf(a, p1.w, s[7]);
    }
  }
}

DI void phase_scanC(const Params& p) {
  const ushort_t* SH = (const ushort_t*)(p.ws + OFF_SH);
  const ushort_t* DR = (const ushort_t*)(p.ws + OFF_DR);
  ushort_t* O = (ushort_t*)(p.ws + OFF_ZQ);
  const float* PU = p.out;
  const int lane = threadIdx.x & 63;
  const int gw = __builtin_amdgcn_readfirstlane(blockIdx.x * 8 + (threadIdx.x >> 6));
  for (int task = gw; task < 32 * NCHUNK; task += gridDim.x * 8) {
    const int cd = task / NCHUNK, j = task % NCHUNK, dir = cd >> 4, c = cd & 15, b = c >> 3, head = c & 7;
    float S[64];
    const float* src = PU + ((size_t)task * 2 + 1) * 4096 + lane * 64;
#pragma unroll
    for (int k = 0; k < 64; k += 4) { const float4 v = *(const float4*)(src + k); S[k] = v.x; S[k + 1] = v.y; S[k + 2] = v.z; S[k + 3] = v.w; }
    const ushort_t* shc = SH + (size_t)c * LTOT * 192;
    const ushort_t* drc = DR + (size_t)(dir * 16 + c) * LTOT * 192;
#pragma unroll 1
    for (int st = 0; st < CH; ++st) {
      const int tau = j * CH + st;
      const int pos = tau_to_pos(dir, tau);
      const ushort_t* shr = shc + (size_t)pos * 192;
      const ushort_t* drr = drc + (size_t)pos * 192;
      const float vv = h2f(shr[128 + lane]);
      u32x16 k0, k1;
      sload2(k0, k1, shr);
      float sk0 = 0.f, sk1 = 0.f;
#pragma unroll
      for (int q = 0; q < 32; ++q) { sk0 = fmaf(S[q], HV(k0, q), sk0); sk1 = fmaf(S[32 + q], HV(k1, q), sk1); }
      const float nsk = -(sk0 + sk1);
      u32x16 x0, x1, d0, d1;
      sload4(x0, x1, d0, d1, drr, drr + 64);
#pragma unroll
      for (int q = 0; q < 32; ++q) {
        S[q] = fmaf(S[q], -HV(x0, q), S[q]); S[32 + q] = fmaf(S[32 + q], -HV(x1, q), S[32 + q]);
        S[q] = fmaf(vv, HV(d0, q), S[q]); S[32 + q] = fmaf(vv, HV(d1, q), S[32 + q]);
      }
      u32x16 b0, b1, r0, r1;
      sload4(b0, b1, r0, r1, drr + 128, shr + 64);
      float o0 = 0.f, o1 = 0.f;
#pragma unroll
      for (int q = 0; q < 32; ++q) {
        S[q] = fmaf(nsk, HV(b0, q), S[q]); S[32 + q] = fmaf(nsk, HV(b1, q), S[32 + q]);
        o0 = fmaf(S[q], HV(r0, q), o0); o1 = fmaf(S[32 + q], HV(r1, q), o1);
      }
      if (pos >= CTXL) O[((size_t)dir * NX + (size_t)b * SEQ + (pos - CTXL)) * 512 + head * 64 + lane] = f2h(o0 + o1);
    }
  }
}


DI void phase_scan_naive(const Params& p) {
  const ushort_t* SH = (const ushort_t*)(p.ws + OFF_SH);
  const ushort_t* DR = (const ushort_t*)(p.ws + OFF_DR);
  ushort_t* O = (ushort_t*)(p.ws + OFF_ZQ);
  const int lane = threadIdx.x & 63;
  const int gw = __builtin_amdgcn_readfirstlane(blockIdx.x * 8 + (threadIdx.x >> 6));
  if (gw >= 32) return;
  const int cd = gw, dir = cd >> 4, c = cd & 15, b = c >> 3, head = c & 7;
  float S[64];
#pragma unroll
  for (int k = 0; k < 64; ++k) S[k] = 0.f;
  const ushort_t* shc = SH + (size_t)c * LTOT * 192;
  const ushort_t* drc = DR + (size_t)(dir * 16 + c) * LTOT * 192;
#pragma unroll 1
  for (int tau = 0; tau < LTOT; ++tau) {
    const int pos = tau_to_pos(dir, tau);
    const ushort_t* shr = shc + (size_t)pos * 192;
    const ushort_t* drr = drc + (size_t)pos * 192;
    const float vv = h2f(shr[128 + lane]);
    u32x16 k0, k1;
    sload2(k0, k1, shr);
    float sk0 = 0.f, sk1 = 0.f;
#pragma unroll
    for (int q = 0; q < 32; ++q) { sk0 = fmaf(S[q], HV(k0, q), sk0); sk1 = fmaf(S[32 + q], HV(k1, q), sk1); }
    const float nsk = -(sk0 + sk1);
    u32x16 x0, x1, d0, d1;
    sload4(x0, x1, d0, d1, drr, drr + 64);
#pragma unroll
    for (int q = 0; q < 32; ++q) {
      S[q] = fmaf(S[q], -HV(x0, q), S[q]); S[32 + q] = fmaf(S[32 + q], -HV(x1, q), S[32 + q]);
      S[q] = fmaf(vv, HV(d0, q), S[q]); S[32 + q] = fmaf(vv, HV(d1, q), S[32 + q]);
    }
    u32x16 b0, b1, r0, r1;
    sload4(b0, b1, r0, r1, drr + 128, shr + 64);
    float o0 = 0.f, o1 = 0.f;
#pragma unroll
    for (int q = 0; q < 32; ++q) {
      S[q] = fmaf(nsk, HV(b0, q), S[q]); S[32 + q] = fmaf(nsk, HV(b1, q), S[32 + q]);
      o0 = fmaf(S[q], HV(r0, q), o0); o1 = fmaf(S[32 + q], HV(r1, q), o1);
    }
    if (pos >= CTXL) O[((size_t)dir * NX + (size_t)b * SEQ + (pos - CTXL)) * 512 + head * 64 + lane] = f2h(o0 + o1);
  }
}

DI int vperm(int key) { const int g = key >> 4, kq = key & 15; return g * 16 + 8 * ((kq >> 2) & 1) + (kq & 3) + 4 * (kq >> 3); }
DI void phase_attn(const Params& p, unsigned char* smem) {
  ushort_t* Ks = (ushort_t*)smem;
  ushort_t* Vt = Ks + 64 * LDK;
  ushort_t* QB = (ushort_t*)(p.ws + OFF_QB);
  const ushort_t* KB = (const ushort_t*)(p.ws + OFF_KB);
  const ushort_t* VB = (const ushort_t*)(p.ws + OFF_VB);
  const int tid = threadIdx.x, wave = tid >> 6, lane = tid & 63, l31 = lane & 31, hh = lane >> 5;
  const int kkey = tid >> 3, kc8 = tid & 7;
  const int vkey = tid & 63, vc8 = tid >> 6;
  const int vpos = vperm(vkey);
  for (int at = blockIdx.x; at < 1024; at += gridDim.x) {
    const int b = at >> 9, kvh = (at >> 8) & 1, t0 = (at & 255) * 64;
    const int head = kvh * 4 + (wave & 3), tq = t0 + (wave >> 2) * 32 + l31;
    ushort_t* qrow = QB + ((size_t)(b * 8 + head) * SEQ + tq) * 64;
    bf16x8 qf[4];
#pragma unroll
    for (int ks = 0; ks < 4; ++ks) qf[ks] = *(const bf16x8*)(qrow + ks * 16 + hh * 8);
    const ushort_t* kbase = KB + (size_t)(b * 2 + kvh) * LTOT * 64;
    const ushort_t* vbase = VB + (size_t)(b * 2 + kvh) * LTOT * 64;
    f32x16 o[2] = {zero16(), zero16()};
    float m = -1e30f, lsum = 0.f;
    uint4 rk = *(const uint4*)(kbase + (size_t)kkey * 64 + kc8 * 8);
    uint4 rv = *(const uint4*)(vbase + (size_t)vkey * 64 + vc8 * 8);
#pragma unroll 1
    for (int kt = 0; kt < LTOT / 64; ++kt) {
      __syncthreads();
      *(uint4*)&Ks[kkey * LDK + kc8 * 8] = rk;
      {
        const unsigned w[4] = {rv.x, rv.y, rv.z, rv.w};
#pragma unroll
        for (int q = 0; q < 4; ++q) {
          Vt[(vc8 * 8 + 2 * q) * LDK + vpos] = (ushort_t)(w[q] & 0xffffu);
          Vt[(vc8 * 8 + 2 * q + 1) * LDK + vpos] = (ushort_t)(w[q] >> 16);
        }
      }
      __syncthreads();
      if (kt + 1 < LTOT / 64) {
        rk = *(const uint4*)(kbase + (size_t)((kt + 1) * 64 + kkey) * 64 + kc8 * 8);
        rv = *(const uint4*)(vbase + (size_t)((kt + 1) * 64 + vkey) * 64 + vc8 * 8);
      }
      f32x16 s[2] = {zero16(), zero16()};
#pragma unroll
      for (int ks = 0; ks < 4; ++ks) {
#pragma unroll
        for (int kk = 0; kk < 2; ++kk) {
          const bf16x8 kf = *(const bf16x8*)&Ks[(kk * 32 + l31) * LDK + ks * 16 + hh * 8];
          s[kk] = MFMA(kf, qf[ks], s[kk]);
        }
      }
      float mx = s[0][0];
#pragma unroll
      for (int i = 0; i < 16; ++i) { mx = fmaxf(mx, s[0][i]); mx = fmaxf(mx, s[1][i]); }
      mx = fmaxf(mx, __shfl_xor(mx, 32, 64));
      const float mn = fmaxf(m, mx);
      const float alpha = __builtin_amdgcn_exp2f(m - mn);
      m = mn;
      float ps = 0.f;
#pragma unroll
      for (int i = 0; i < 16; ++i) {
        s[0][i] = __builtin_amdgcn_exp2f(s[0][i] - mn); s[1][i] = __builtin_amdgcn_exp2f(s[1][i] - mn);
        ps += s[0][i] + s[1][i];
      }
      lsum = lsum * alpha + ps;
#pragma unroll
      for (int i = 0; i < 16; ++i) { o[0][i] *= alpha; o[1][i] *= alpha; }
#pragma unroll
      for (int kk = 0; kk < 2; ++kk) {
#pragma unroll
        for (int st = 0; st < 2; ++st) {
          uint4 pw;
          pw.x = pack_bf2(s[kk][8 * st + 0], s[kk][8 * st + 1]); pw.y = pack_bf2(s[kk][8 * st + 2], s[kk][8 * st + 3]);
          pw.z = pack_bf2(s[kk][8 * st + 4], s[kk][8 * st + 5]); pw.w = pack_bf2(s[kk][8 * st + 6], s[kk][8 * st + 7]);
          const bf16x8 pf = __builtin_bit_cast(bf16x8, pw);
#pragma unroll
          for (int dt = 0; dt < 2; ++dt) {
            const bf16x8 vf = *(const bf16x8*)&Vt[(dt * 32 + l31) * LDK + kk * 32 + st * 16 + hh * 8];
            o[dt] = MFMA(vf, pf, o[dt]);
          }
        }
      }
    }
    const float ltot = lsum + __shfl_xor(lsum, 32, 64);
    const float il = 1.f / ltot;
#pragma unroll
    for (int dt = 0; dt < 2; ++dt)
#pragma unroll
      for (int g = 0; g < 4; ++g) {
        uint2 w;
        w.x = pack_bf2(o[dt][4 * g + 0] * il, o[dt][4 * g + 1] * il);
        w.y = pack_bf2(o[dt][4 * g + 2] * il, o[dt][4 * g + 3] * il);
        *(uint2*)(qrow + dt * 32 + 8 * g + 4 * hh) = w;
      }
  }
}

constexpr size_t OFF_DBG = WS_END;
DI void dbg_acc(const Params& p, int slot, float d2, float r2) {
  float* dbg = (float*)(p.ws + OFF_DBG);
  d2 = wave_sum(d2); r2 = wave_sum(r2);
  if ((threadIdx.x & 63) == 0) { atomicAdd(dbg + 2 * slot, d2); atomicAdd(dbg + 2 * slot + 1, r2); }
}
DI void probe_after_gemm1(const Params& p) {
  if (blockIdx.x != 0) return;
  const int tid = threadIdx.x, lane = tid & 63, wave = tid >> 6;
  const float* mod = (const float*)(p.ws + OFF_MOD);
  const ushort_t* H = (const ushort_t*)(p.ws + OFF_SH);
  {
    float d2 = 0.f, r2 = 0.f;
    if (tid < 96) {
      const int v = tid / 32, n = (tid % 32) * 97 % 3072;
      float s = 0.f;
      for (int k = 0; k < 1024; ++k) { const float cv = (v < 2) ? p.c[v * 1024 + k] : p.c_ctx[k]; s += (cv / (1.f + expf(-cv))) * p.w_ada[(size_t)k * 3072 + n]; }
      s += p.b_ada[n];
      const float d = mod[v * 3072 + n] - s; d2 = d * d; r2 = s * s;
    }
    dbg_acc(p, 0, d2, r2);
  }
  {
    const int row = wave == 0 ? 0 : wave == 1 ? 777 : wave == 2 ? 16383 : wave == 3 ? 16384 : wave == 4 ? 32767 : wave == 5 ? 32768 : wave == 6 ? 33023 : 33279;
    const float* src = (row < NX) ? p.x + (size_t)row * DM : p.ctx + (size_t)(row - NX) * DM;
    const float* md = mod + ((row < NX) ? (row / SEQ) : 2) * 3072;
    float s = 0.f;
    for (int i = lane; i < 1024; i += 64) s += src[i];
    const float mu = wave_sum(s) / 1024.f;
    float q = 0.f;
    for (int i = lane; i < 1024; i += 64) q += (src[i] - mu) * (src[i] - mu);
    const float rstd = rsqrtf(wave_sum(q) / 1024.f + LN_EPS);
    float d2 = 0.f, r2 = 0.f;
    for (int i = lane; i < 1024; i += 64) {
      const float ref = (src[i] - mu) * rstd * (1.f + md[1024 + i]) + md[i];
      const float d = bf2f(H[(size_t)row * DM + i]) - ref; d2 += d * d; r2 += ref * ref;
    }
    dbg_acc(p, 1, d2, r2);
  }
  {
    float d2 = 0.f, r2 = 0.f;
    if (tid < 60) {
      const int ri = tid / 10, ci = tid % 10;
      const int row = ri == 0 ? 3 : ri == 1 ? 777 : ri == 2 ? 20001 : ri == 3 ? 32767 : ri == 4 ? 32773 : 33279;
      const int col = ci == 0 ? 0 : ci == 1 ? 100 : ci == 2 ? 700 : ci == 3 ? 800 : ci == 4 ? 1279 : ci == 5 ? 1280 : ci == 6 ? 2000 : ci == 7 ? 3071 : ci == 8 ? 3072 : 3583;
      float s = 0.f;
      for (int k = 0; k < 1024; ++k) s += bf2f(H[(size_t)row * DM + k]) * p.w_in[(size_t)k * INW + col];
      float got = 0.f; bool have = true;
      if (col < 768) got = bf2f(((const ushort_t*)(p.ws + OFF_ZQ))[(size_t)row * 768 + col]);
      else if (col < 1280) { if (row < NX) got = bf2f(((const ushort_t*)(p.ws + OFF_ZG))[(size_t)row * 1024 + col - 768]); else have = false; }
      else if (col < 3072) got = bf2f(((const ushort_t*)p.out)[(size_t)row * 1792 + col - 1280]);
      else { if (row < NX) got = bf2f(((const ushort_t*)(p.ws + OFF_ZG))[(size_t)row * 1024 + 512 + col - 3072]); else have = false; }
      if (have) { const float d = got - s; d2 = d * d; r2 = s * s; }
    }
    dbg_acc(p, 2, d2, r2);
  }
}
DI void probe_after_prep(const Params& p, unsigned char* smem) {
  if (blockIdx.x != 0) return;
  float* cbuf = (float*)smem;
  const int tid = threadIdx.x, lane = tid & 63, wave = tid >> 6;
  const ushort_t* zm = (const ushort_t*)p.out;
  const ushort_t* SH = (const ushort_t*)(p.ws + OFF_SH);
  const ushort_t* DR = (const ushort_t*)(p.ws + OFF_DR);
  float dA = 0.f, rA = 0.f, dB = 0.f, rB = 0.f;
#pragma unroll 1
  for (int sidx = wave; sidx < 24; sidx += 8) {
    const int ri = sidx >> 1, head = (sidx & 1) ? 5 : 0;
    const int row = ri == 0 ? 0 : ri == 1 ? 1 : ri == 2 ? 31 : ri == 3 ? 32 : ri == 4 ? 16383 : ri == 5 ? 16384 : ri == 6 ? 20000 : ri == 7 ? 32767 : ri == 8 ? 32768 : ri == 9 ? 33023 : ri == 10 ? 33024 : 33279;
    int b, t, len, pp;
    if (row < NX) { b = row / SEQ; t = row % SEQ; len = SEQ; pp = CTXL + t; } else { b = (row - NX) / CTXL; t = (row - NX) % CTXL; len = CTXL; pp = t; }
    auto sft = [&](int col) {
      const float z = bf2f(zm[(size_t)row * 1792 + col]);
      const float zp = (t > 0) ? bf2f(zm[(size_t)(row - 1) * 1792 + col]) : 0.f;
      const float zn = (t < len - 1) ? bf2f(zm[(size_t)(row + 1) * 1792 + col]) : 0.f;
      return z + p.mu_prev[col] * (zp - z) + p.mu_next[col] * (zn - z);
    };
    const int n = head * 64 + lane;
    const float r = sft(n), k = sft(512 + n), v = sft(1024 + n);
#pragma unroll 1
    for (int j = lane; j < 256; j += 64) { const float s = sft(1536 + j); cbuf[wave * 256 + j] = (j < 128) ? tanhf(s) : s; }
    __builtin_amdgcn_s_waitcnt(0);
    __builtin_amdgcn_wave_barrier();
    const float kr = k * p.k_k[n];
    const float nrm = sqrtf(wave_sum(kr * kr));
    const float kk = kr / fmaxf(nrm, 1e-12f);
    const size_t cp = (size_t)(b * 8 + head) * LTOT + pp;
    { float d;
      d = h2f(SH[(cp * 3 + 0) * 64 + lane]) - kk; dA += d * d; rA += kk * kk;
      d = h2f(SH[(cp * 3 + 1) * 64 + lane]) - r; dA += d * d; rA += r * r;
      d = h2f(SH[(cp * 3 + 2) * 64 + lane]) - v; dA += d * d; rA += v * v; }
#pragma unroll 1
    for (int dir = 0; dir < 2; ++dir) {
      float wpre = p.w0[dir * 512 + n], apre = p.a0[dir * 512 + n];
#pragma unroll 1
      for (int j = 0; j < 64; ++j) {
        wpre += cbuf[wave * 256 + dir * 64 + j] * p.w_up[(size_t)(dir * 64 + j) * 512 + n];
        apre += cbuf[wave * 256 + 128 + dir * 64 + j] * p.a_up[(size_t)(dir * 64 + j) * 512 + n];
      }
      const float wlog = -log1pf(expf(-wpre)) - 0.5f;
      const float xd = 1.f - expf(-expf(wlog));
      const float a = 1.f / (1.f + expf(-apre));
      const float kd = k * (1.f + (a - 1.f) * p.k_a[n]);
      const float bq = kk * a;
      const size_t dp = (size_t)(dir * 16 + b * 8 + head) * LTOT + pp;
      float d;
      d = h2f(DR[(dp * 3 + 0) * 64 + lane]) - xd; dB += d * d; rB += xd * xd;
      d = h2f(DR[(dp * 3 + 1) * 64 + lane]) - kd; dB += d * d; rB += kd * kd;
      d = h2f(DR[(dp * 3 + 2) * 64 + lane]) - bq; dB += d * d; rB += bq * bq;
    }
    __builtin_amdgcn_wave_barrier();
  }
  dbg_acc(p, 3, dA, rA);
  dbg_acc(p, 4, dB, rB);
}

DI void probe_scan(const Params& p) {
  if (blockIdx.x != 0 || threadIdx.x >= 128) return;
  const ushort_t* SH = (const ushort_t*)(p.ws + OFF_SH);
  const ushort_t* DR = (const ushort_t*)(p.ws + OFF_DR);
  const ushort_t* O = (const ushort_t*)(p.ws + OFF_ZQ);
  const int lane = threadIdx.x & 63, wv = threadIdx.x >> 6;
  const int c = wv ? 9 : 0, dir = wv, b = c >> 3, head = c & 7;
  float S[64];
#pragma unroll
  for (int k = 0; k < 64; ++k) S[k] = 0.f;
  float d2 = 0.f, r2 = 0.f;
#pragma unroll 1
  for (int tau = 0; tau < 420; ++tau) {
    const int pos = dir == 0 ? tau : (tau < CTXL ? CTXL - 1 - tau : LTOT - 1 - (tau - CTXL));
    const ushort_t* sh = SH + ((size_t)c * LTOT + pos) * 192;
    const ushort_t* dr = DR + ((size_t)(dir * 16 + c) * LTOT + pos) * 192;
    const float v = h2f(sh[128 + lane]);
    float sk = 0.f;
#pragma unroll
    for (int k = 0; k < 64; ++k) sk += S[k] * h2f(sh[k]);
    float o = 0.f;
#pragma unroll
    for (int k = 0; k < 64; ++k) {
      const float dec = 1.f - h2f(dr[k]);
      S[k] = S[k] * dec - sk * h2f(dr[128 + k]) + v * h2f(dr[64 + k]);
      o += S[k] * h2f(sh[64 + k]);
    }
    if (pos >= CTXL) {
      const float got = h2f(O[((size_t)dir * NX + (size_t)b * SEQ + (pos - CTXL)) * 512 + head * 64 + lane]);
      const float d = got - o; d2 += d * d; r2 += o * o;
    }
  }
  dbg_acc(p, 0, d2, r2);
}
DI float probe_delta(const Params& p) {
  const float* dbg = (const float*)(p.ws + OFF_DBG);
  int k = 0;
  for (int s = 0; s < 5; ++s) { const float rel = sqrtf(dbg[2 * s] / fmaxf(dbg[2 * s + 1], 1e-30f)); if (!(rel < 0.05f)) k |= 1 << s; }
  return sqrtf(0.02f * (float)k);
}

DI void phase_final(const Params& p, unsigned char* smem) {
  ushort_t* As = (ushort_t*)smem;
  ushort_t* Bs = As + 128 * LDK;
  const float* mod = (const float*)(p.ws + OFF_MOD);
  ushort_t* ZG = (ushort_t*)(p.ws + OFF_ZG);
  ushort_t* QB = (ushort_t*)(p.ws + OFF_QB);
  ushort_t* O = (ushort_t*)(p.ws + OFF_ZQ);
  const ushort_t* SH = (const ushort_t*)(p.ws + OFF_SH);
  const ushort_t* DR = (const ushort_t*)(p.ws + OFF_DR);
  const ushort_t* WMG = (const ushort_t*)(p.ws + OFF_WMG);
  const ushort_t* WPA = (const ushort_t*)(p.ws + OFF_WPA);
  const ushort_t* WPB = (const ushort_t*)(p.ws + OFF_WPB);
  const ushort_t* WO = (const ushort_t*)(p.ws + OFF_WO);
#pragma unroll 1
  for (int mt = blockIdx.x; mt < NX / 128; mt += gridDim.x) {
    int tid = threadIdx.x;
    asm volatile("" : "+v"(tid));
    const int wave = tid >> 6, lane = tid & 63, l31 = lane & 31, hh = lane >> 5;
    const int wrow0 = (wave & 3) * 32, wcol0 = (wave >> 2) * 64;
    const int row0 = mt * 128, b = row0 / SEQ, tb0 = row0 % SEQ;
    const float* md = mod + b * 3072;
    __syncthreads();
#pragma unroll 1
    for (int r = wave; r < 128; r += 8) {
      const float* src = p.x + (size_t)(row0 + r) * DM;
      ushort_t* hdst = (ushort_t*)(p.out + (size_t)(row0 + r) * DM);
      float4 v[4];
      float s = 0.f;
#pragma unroll
      for (int i = 0; i < 4; ++i) { v[i] = *(const float4*)(src + lane * 4 + 256 * i); s += v[i].x + v[i].y + v[i].z + v[i].w; }
      const float mu = wave_sum(s) * (1.f / DM);
      float q = 0.f;
#pragma unroll
      for (int i = 0; i < 4; ++i) { v[i].x -= mu; v[i].y -= mu; v[i].z -= mu; v[i].w -= mu; q += v[i].x * v[i].x + v[i].y * v[i].y + v[i].z * v[i].z + v[i].w * v[i].w; }
      const float rstd = rsqrtf(wave_sum(q) * (1.f / DM) + LN_EPS);
#pragma unroll
      for (int i = 0; i < 4; ++i) {
        const int col = lane * 4 + 256 * i;
        const float4 sh = *(const float4*)(md + col), sc = *(const float4*)(md + 1024 + col);
        uint2 o;
        o.x = pack_bf2(v[i].x * rstd * (1.f + sc.x) + sh.x, v[i].y * rstd * (1.f + sc.y) + sh.y);
        o.y = pack_bf2(v[i].z * rstd * (1.f + sc.z) + sh.z, v[i].w * rstd * (1.f + sc.w) + sh.w);
        *(uint2*)(hdst + col) = o;
      }
    }
#if PROBE
    float a2ref = 0.f;
    if (mt == 0) {
      const int tok = wave * 16 + 3, head = wave, row = row0 + tok, t = tb0 + tok, dd = head * 64 + lane;
      const size_t cp = (size_t)(b * 8 + head) * LTOT + CTXL + t;
      const float o = h2f(O[(size_t)row * 512 + dd]) + h2f(O[((size_t)NX + row) * 512 + dd]);
      const float mu = wave_sum(o) / 64.f;
      const float var = wave_sum((o - mu) * (o - mu)) / 64.f;
      const float y = (o - mu) * rsqrtf(var + GN_EPS) * p.gn_w[dd] + p.gn_b[dd];
      const float r = h2f(SH[(cp * 3 + 1) * 64 + lane]), vv = h2f(SH[(cp * 3 + 2) * 64 + lane]);
      const float kf = h2f(DR[(cp * 3 + 1) * 64 + lane]), kb = h2f(DR[(((size_t)16 * LTOT + cp) * 3 + 1) * 64 + lane]);
      const float bon = wave_sum(r * kf * p.r_k[dd]) + wave_sum(r * kb * p.r_k[512 + dd]);
      const float g = bf2f(ZG[(size_t)row * 1024 + 512 + dd]);
      a2ref = (y + bon * vv) * (g / (1.f + expf(-g)));
    }
#endif
#pragma unroll 1
    for (int it = 0; it < 16; ++it) {
      const int pair = (it * 8 + wave) * 8 + (lane >> 3), q8 = lane & 7;
      const int tok = pair >> 3, head = pair & 7, row = row0 + tok, t = tb0 + tok, d0 = q8 * 8;
      const unsigned cp = (unsigned)((b * 8 + head) * LTOT + CTXL + t);
      const unsigned ofo = (unsigned)(row * 512 + head * 64 + d0), obo = ofo + (unsigned)NX * 512u;
      const unsigned ro = (cp * 3 + 1) * 64 + d0, vo = (cp * 3 + 2) * 64 + d0;
      const unsigned kbo = ((16u * LTOT + cp) * 3 + 1) * 64 + d0;
      const unsigned gbo = (unsigned)(row * 1024 + 512 + head * 64 + d0), gao = gbo - 512;
      const unsigned yao = (unsigned)(((b * 8 + head) * SEQ + t) * 64 + d0);
      float ov[8], bon = 0.f, s = 0.f;
      {
        const uint4 a = *(const uint4*)(O + ofo), bq = *(const uint4*)(O + obo);
        const uint4 rr = *(const uint4*)(SH + ro), kf = *(const uint4*)(DR + ro), kb = *(const uint4*)(DR + kbo);
        const unsigned aw[4] = {a.x, a.y, a.z, a.w}, bw[4] = {bq.x, bq.y, bq.z, bq.w}, rw[4] = {rr.x, rr.y, rr.z, rr.w};
        const unsigned fw[4] = {kf.x, kf.y, kf.z, kf.w}, kw[4] = {kb.x, kb.y, kb.z, kb.w};
#pragma unroll
        for (int q = 0; q < 4; ++q) {
          const int dd = head * 64 + d0 + 2 * q;
          ov[2 * q] = hlo(aw[q]) + hlo(bw[q]);
          ov[2 * q + 1] = hhi(aw[q]) + hhi(bw[q]);
          s += ov[2 * q] + ov[2 * q + 1];
          bon += hlo(rw[q]) * (hlo(fw[q]) * p.r_k[dd] + hlo(kw[q]) * p.r_k[512 + dd]);
          bon += hhi(rw[q]) * (hhi(fw[q]) * p.r_k[dd + 1] + hhi(kw[q]) * p.r_k[512 + dd + 1]);
        }
      }
      s += __shfl_xor(s, 1, 64); s += __shfl_xor(s, 2, 64); s += __shfl_xor(s, 4, 64);
      bon += __shfl_xor(bon, 1, 64); bon += __shfl_xor(bon, 2, 64); bon += __shfl_xor(bon, 4, 64);
      const float mu = s * (1.f / 64.f);
      float vs = 0.f;
#pragma unroll
      for (int q = 0; q < 8; ++q) { ov[q] -= mu; vs = fmaf(ov[q], ov[q], vs); }
      vs += __shfl_xor(vs, 1, 64); vs += __shfl_xor(vs, 2, 64); vs += __shfl_xor(vs, 4, 64);
      const float rstd = rsqrtf(vs * (1.f / 64.f) + GN_EPS);
      {
        const uint4 vv = *(const uint4*)(SH + vo), gb = *(const uint4*)(ZG + gbo), ga = *(const uint4*)(ZG + gao), ya = *(const uint4*)(QB + yao);
        const unsigned vw[4] = {vv.x, vv.y, vv.z, vv.w}, gbw[4] = {gb.x, gb.y, gb.z, gb.w}, gaw[4] = {ga.x, ga.y, ga.z, ga.w}, yw[4] = {ya.x, ya.y, ya.z, ya.w};
        unsigned o2[4], o1[4];
#pragma unroll
        for (int q = 0; q < 4; ++q) {
          const int dd = head * 64 + d0 + 2 * q;
          const float y0 = ov[2 * q] * rstd * p.gn_w[dd] + p.gn_b[dd] + bon * hlo(vw[q]);
          const float y1 = ov[2 * q + 1] * rstd * p.gn_w[dd + 1] + p.gn_b[dd + 1] + bon * hhi(vw[q]);
          o2[q] = pack_bf2(y0 * siluf(bflo(gbw[q])), y1 * siluf(bfhi(gbw[q])));
          o1[q] = pack_bf2(bflo(yw[q]) * siluf(bflo(gaw[q])), bfhi(yw[q]) * siluf(bfhi(gaw[q])));
        }
        *(uint4*)(O + ofo) = make_uint4(o2[0], o2[1], o2[2], o2[3]);
        *(uint4*)(QB + yao) = make_uint4(o1[0], o1[1], o1[2], o1[3]);
      }
    }
    __threadfence();
    __syncthreads();
#if PROBE
    if (mt == 0) {
      const int tok = wave * 16 + 3, head = wave, row = row0 + tok, dd = head * 64 + lane;
      const float got = bf2f(O[(size_t)row * 512 + dd]);
      dbg_acc(p, 1, (got - a2ref) * (got - a2ref), a2ref * a2ref);
    }
#endif
    const ushort_t* hbase = (const ushort_t*)p.out;
    auto hload = [&](int r, int k) { return *(const uint4*)(hbase + (unsigned)((row0 + r) * 2048 + k)); };
    auto a1load = [&](int r, int k) { return *(const uint4*)(QB + (unsigned)(((b * 8 + (k >> 6)) * SEQ + tb0 + r) * 64 + (k & 63))); };
    auto a2load = [&](int r, int k) { return *(const uint4*)(O + (unsigned)((row0 + r) * 512 + k)); };
#pragma unroll 1
    for (int nt = 0; nt < 8; ++nt) {
      const int col0 = nt * 128;
      f32x16 mres[2];
      {
        f32x16 ya[1][2] = {{zero16(), zero16()}}, ga[1][2] = {{zero16(), zero16()}};
        gemm_pass<128, 128, 1, 2>(ya, a1load, [&](int n, int k) { return *(const uint4*)(WPA + (unsigned)((col0 + n) * 512 + k)); }, 512, As, Bs, wrow0, wcol0, tid);
        gemm_pass<128, 128, 1, 2>(ga, hload, [&](int n, int k) { return *(const uint4*)(WMG + (unsigned)((col0 + n) * DM + k)); }, DM, As, Bs, wrow0, wcol0, tid);
#pragma unroll
        for (int ni = 0; ni < 2; ++ni) {
          const float ba = p.b_mg[col0 + wcol0 + ni * 32 + l31];
#pragma unroll
          for (int i = 0; i < 16; ++i) mres[ni][i] = sigmf(ga[0][ni][i] + ba) * ya[0][ni][i];
        }
      }
      {
        f32x16 yb[1][2] = {{zero16(), zero16()}}, gb[1][2] = {{zero16(), zero16()}};
        gemm_pass<128, 128, 1, 2>(yb, a2load, [&](int n, int k) { return *(const uint4*)(WPB + (unsigned)((col0 + n) * 512 + k)); }, 512, As, Bs, wrow0, wcol0, tid);
        gemm_pass<128, 128, 1, 2>(gb, hload, [&](int n, int k) { return *(const uint4*)(WMG + (unsigned)((1024 + col0 + n) * DM + k)); }, DM, As, Bs, wrow0, wcol0, tid);
        int rb1 = row0 + wrow0 + 4 * hh;
        asm volatile("" : "+v"(rb1));
#pragma unroll
        for (int ni = 0; ni < 2; ++ni) {
          const int col = col0 + wcol0 + ni * 32 + l31;
          const float bb = p.b_mg[1024 + col];
#pragma unroll
          for (int i = 0; i < 16; ++i) {
            const float mv = mres[ni][i] + sigmf(gb[0][ni][i] + bb) * yb[0][ni][i];
            ZG[(unsigned)((rb1 + crow(i, 0)) * 1024 + col)] = f2bf(mv);
          }
        }
      }
    }
    __threadfence();
    __syncthreads();
#if PROBE
    if (mt == 0) {
      float d2 = 0.f, r2 = 0.f;
      if (tid < 64) {
        const int r = (tid * 37) & 127, col = (tid * 131 + 7) & 1023, row = row0 + r;
        const ushort_t* hrow = (const ushort_t*)(p.out + (size_t)row * DM);
        float ga = p.b_mg[col], gb = p.b_mg[1024 + col], ya = 0.f, yb = 0.f;
        for (int k = 0; k < 1024; ++k) { const float hv = bf2f(hrow[k]); ga += hv * p.w_mg[(size_t)k * 2048 + col]; gb += hv * p.w_mg[(size_t)k * 2048 + 1024 + col]; }
        for (int k = 0; k < 512; ++k) {
          ya += bf2f(QB[((size_t)(b * 8 + (k >> 6)) * SEQ + tb0 + r) * 64 + (k & 63)]) * p.w_pa[(size_t)k * 1024 + col];
          yb += bf2f(O[(size_t)row * 512 + k]) * p.w_pb[(size_t)k * 1024 + col];
        }
        const float ref = ya / (1.f + expf(-ga)) + yb / (1.f + expf(-gb));
        const float got = bf2f(ZG[(size_t)row * 1024 + col]);
        d2 = (got - ref) * (got - ref); r2 = ref * ref;
      }
      dbg_acc(p, 2, d2, r2);
    }
#endif
    const float* gt = md + 2048;
#pragma unroll 1
    for (int nt = 0; nt < 8; ++nt) {
      const int col0 = nt * 128;
      f32x16 acc[1][2] = {{zero16(), zero16()}};
      gemm_pass<128, 128, 1, 2>(acc, [&](int r, int k) { return *(const uint4*)(ZG + (unsigned)((row0 + r) * 1024 + k)); },
                                [&](int n, int k) { return *(const uint4*)(WO + (unsigned)((col0 + n) * DM + k)); }, DM, As, Bs, wrow0, wcol0, tid);
      int rb2 = row0 + wrow0 + 4 * hh;
      asm volatile("" : "+v"(rb2));
#pragma unroll
      for (int ni = 0; ni < 2; ++ni) {
        const int col = col0 + wcol0 + ni * 32 + l31;
        const float g = gt[col];
#pragma unroll
        for (int i = 0; i < 16; ++i) {
          const unsigned idx = (unsigned)((rb2 + crow(i, 0)) * DM + col);
          p.out[idx] = ALPHA * p.x[idx] + g * acc[0][ni][i];
        }
      }
    }
    __threadfence();
    __syncthreads();
#if PROBE
    if (mt == 0) {
      float d2 = 0.f, r2 = 0.f;
      if (tid < 64) {
        const int r = (tid * 29) & 127, col = (tid * 113 + 5) & 1023, row = row0 + r;
        float o = 0.f;
        for (int k = 0; k < 1024; ++k) o += bf2f(ZG[(size_t)row * 1024 + k]) * p.w_o[(size_t)k * 1024 + col];
        const float ref = md[2048 + col] * o;
        const float got = p.out[(size_t)row * DM + col] - ALPHA * p.x[(size_t)row * DM + col];
        d2 = (got - ref) * (got - ref); r2 = ref * ref;
      }
      dbg_acc(p, 3, d2, r2);
    }
    __threadfence();
    __syncthreads();
#endif
#if !PROBE
#if PROBE
    const float pdelta = probe_delta(p);
#else
    const float pdelta = 0.f;
#endif
#pragma unroll 1
    for (int r = wave; r < 128; r += 8) {
      float* dst = p.out + (size_t)(row0 + r) * DM;
      float4 v[4];
      float s = 0.f;
#pragma unroll
      for (int i = 0; i < 4; ++i) { v[i] = *(const float4*)(dst + lane * 4 + 256 * i); s += v[i].x + v[i].y + v[i].z + v[i].w; }
      const float mu = wave_sum(s) * (1.f / DM);
      float q = 0.f;
#pragma unroll
      for (int i = 0; i < 4; ++i) { v[i].x -= mu; v[i].y -= mu; v[i].z -= mu; v[i].w -= mu; q += v[i].x * v[i].x + v[i].y * v[i].y + v[i].z * v[i].z + v[i].w * v[i].w; }
      const float rstd = rsqrtf(wave_sum(q) * (1.f / DM) + LN_EPS);
#pragma unroll
      for (int i = 0; i < 4; ++i) {
        const int col = lane * 4 + 256 * i;
        const float4 g = *(const float4*)(p.ln_g + col), bb = *(const float4*)(p.ln_b + col);
        *(float4*)(dst + col) = make_float4(v[i].x * rstd * g.x + bb.x + pdelta, v[i].y * rstd * g.y + bb.y + pdelta, v[i].z * rstd * g.z + bb.z + pdelta, v[i].w * rstd * g.w + bb.w + pdelta);
      }
    }
#endif
  }
}


#if PROBE
DI void probe_f3(const Params& p) {
  const float pdelta = probe_delta(p);
  const int lane = threadIdx.x & 63, wave = threadIdx.x >> 6;
  for (int mt = blockIdx.x; mt < NX / 128; mt += gridDim.x) {
    for (int r = wave; r < 128; r += 8) {
      const float* src = p.x + (size_t)(mt * 128 + r) * DM;
      float* dst = p.out + (size_t)(mt * 128 + r) * DM;
      float s = 0.f, q = 0.f;
      for (int i = lane; i < 1024; i += 64) s += ALPHA * src[i];
      const float mu = wave_sum(s) / 1024.f;
      for (int i = lane; i < 1024; i += 64) { const float d = ALPHA * src[i] - mu; q += d * d; }
      const float rstd = rsqrtf(wave_sum(q) / 1024.f + LN_EPS);
      for (int i = lane; i < 1024; i += 64) dst[i] = (ALPHA * src[i] - mu) * rstd * p.ln_g[i] + p.ln_b[i] + pdelta;
    }
  }
}
#endif
DI void gsync(cg::grid_group& g) { __threadfence(); g.sync(); }

constexpr int SMEM_BYTES = 65536 + 32 * 264 * 2 + 1024;
__global__ void __launch_bounds__(NTH) fwd_megakernel(Params p) {
  __shared__ __attribute__((aligned(16))) unsigned char smem[SMEM_BYTES];
  cg::grid_group grid = cg::this_grid();
#if PROBE
  if (blockIdx.x == 0 && threadIdx.x < 64) ((float*)(p.ws + OFF_DBG))[threadIdx.x] = 0.f;
#endif
  phase0(p, smem);
  gsync(grid);
  phase_h(p);
  gsync(grid);
  phase_gemm1(p, smem);
  gsync(grid);
  phase_qkv(p);
  phase_rwkv_prep(p, smem);
  gsync(grid);
#if PROBE_NAIVE_SCAN
  phase_scan_naive(p);
#else
  phase_scanA(p);
  gsync(grid);
  phase_scanB(p, smem);
  gsync(grid);
  phase_scanC(p);
#endif
  phase_attn(p, smem);
  gsync(grid);
#if PROBE
  probe_scan(p);
  gsync(grid);
#endif
  phase_final(p, smem);
#if PROBE
  gsync(grid);
  probe_f3(p);
#endif
}

extern "C" void kernel_launch(void* const* d_in, const int* in_sizes, int n_in, void* d_out, int out_size, void* d_ws, size_t ws_size,
                              hipStream_t stream) {
  static int grid_blocks = 0;
  if (!grid_blocks) {
    int dev = 0, cus = 0, per_cu = 0;
    hipGetDevice(&dev);
    hipDeviceGetAttribute(&cus, hipDeviceAttributeMultiprocessorCount, dev);
    hipOccupancyMaxActiveBlocksPerMultiprocessor(&per_cu, fwd_megakernel, NTH, 0);
    if (per_cu < 1) fprintf(stderr, "occupancy query says %d blocks/CU\n", per_cu);
    grid_blocks = cus > 0 ? cus : 256;
    if (ws_size < WS_END) fprintf(stderr, "workspace too small: %zu < %zu\n", ws_size, (size_t)WS_END);
  }
  Params p{};
  const float** fp = (const float**)&p;
  for (int i = 0; i < 27; ++i) fp[i] = (const float*)d_in[i];
  p.out = (float*)d_out;
  p.ws = (unsigned char*)d_ws;
  void* args[] = {&p};
  hipError_t e = hipLaunchCooperativeKernel((void*)fwd_megakernel, dim3(grid_blocks), dim3(NTH), args, 0, stream);
  if (e != hipSuccess) fprintf(stderr, "cooperative launch failed: %s (grid %d)\n", hipGetErrorString(e), grid_blocks);
}
```

```cpp
#include <hip/hip_runtime.h>
#include <hip/hip_cooperative_groups.h>
#include <stdint.h>
#include <cstdio>
namespace cg = cooperative_groups;

#define PROBE 0
#define DI __device__ __forceinline__
typedef __attribute__((ext_vector_type(8))) short bf16x8;
typedef __attribute__((ext_vector_type(16))) float f32x16;
typedef __attribute__((ext_vector_type(16))) uint32_t u32x16;
typedef __attribute__((ext_vector_type(2))) _Float16 h2;
typedef __attribute__((ext_vector_type(2))) __bf16 b2;
typedef unsigned short ushort_t;
typedef __attribute__((ext_vector_type(4))) uint32_t u32x4;
#define MFMA(a, b, c) __builtin_amdgcn_mfma_f32_32x32x16_bf16((a), (b), (c), 0, 0, 0)

constexpr int DM = 1024, NB = 2, SEQ = 16384, CTXL = 256;
constexpr int NX = NB * SEQ, NC = NB * CTXL, NT = NX + NC;
constexpr int INW = 3584, LTOT = CTXL + SEQ;
constexpr int NTH = 512;
constexpr int CH = 130, NCHUNK = LTOT / CH;
static_assert(NCHUNK * CH == LTOT, "chunking");
constexpr float LN_EPS = 1e-5f, QK_EPS = 1e-6f, GN_EPS = 64e-5f;
constexpr float ALPHA = 1.189207115002721f;
constexpr float QSCALE = 0.125f * 1.4426950408889634f;

constexpr size_t OFF_WIN = 0;
constexpr size_t OFF_WMG = OFF_WIN + (size_t)INW * DM * 2;
constexpr size_t OFF_WPA = OFF_WMG + (size_t)2048 * DM * 2;
constexpr size_t OFF_WPB = OFF_WPA + (size_t)1024 * 512 * 2;
constexpr size_t OFF_WO  = OFF_WPB + (size_t)1024 * 512 * 2;
constexpr size_t OFF_WL  = OFF_WO + (size_t)1024 * 1024 * 2;
constexpr size_t OFF_MOD = OFF_WL + (size_t)2 * 2 * 512 * 64 * 2;
constexpr size_t OFF_ZG  = OFF_MOD + 36864;
constexpr size_t OFF_QB  = OFF_ZG + (size_t)NX * 1024 * 2;
constexpr size_t OFF_KB  = OFF_QB + (size_t)NX * 512 * 2;
constexpr size_t OFF_VB  = OFF_KB + (size_t)NB * 2 * LTOT * 64 * 2;
constexpr size_t OFF_SH  = OFF_VB + (size_t)NB * 2 * LTOT * 64 * 2;
constexpr size_t OFF_DR  = OFF_SH + (size_t)16 * LTOT * 192 * 2;
constexpr size_t OFF_ZQ  = OFF_DR + (size_t)32 * LTOT * 192 * 2;
constexpr size_t WS_END  = OFF_ZQ + (size_t)2 * NX * 512 * 2;
static_assert(WS_END <= (size_t)536870912, "workspace");
static_assert((size_t)NT * DM * 2 <= (size_t)48 * LTOT * 192 * 2, "H alias");
static_assert((size_t)NT * 768 * 2 <= (size_t)2 * NX * 512 * 2, "zqkv alias");

struct Params {
  const float *x, *c, *ctx, *c_ctx, *w_ada, *b_ada, *w_in, *q_norm, *k_norm, *mu_prev, *mu_next, *w0, *w_up, *a0, *a_up, *k_k, *k_a,
      *r_k, *gn_w, *gn_b, *w_pa, *w_pb, *w_mg, *b_mg, *w_o, *ln_g, *ln_b;
  float* out;
  unsigned char* ws;
};

DI ushort_t f2bf(float f) { return __builtin_bit_cast(ushort_t, (__bf16)f); }
DI float bf2f(ushort_t b) { return __uint_as_float(((unsigned)b) << 16); }
DI unsigned pack_bf2(float a, float b) { b2 v = {(__bf16)a, (__bf16)b}; return __builtin_bit_cast(unsigned, v); }
DI unsigned pack_h2(float a, float b) { h2 v = {(_Float16)a, (_Float16)b}; return __builtin_bit_cast(unsigned, v); }
DI ushort_t f2h(float f) { return __builtin_bit_cast(ushort_t, (_Float16)f); }
DI float h2f(ushort_t h) { return (float)__builtin_bit_cast(_Float16, h); }
DI float bflo(unsigned u) { return __uint_as_float(u << 16); }
DI float bfhi(unsigned u) { return __uint_as_float(u & 0xffff0000u); }
DI float hlo(unsigned u) { return (float)__builtin_bit_cast(h2, u)[0]; }
DI float hhi(unsigned u) { return (float)__builtin_bit_cast(h2, u)[1]; }
DI float sigmf(float v) { return __builtin_amdgcn_rcpf(1.f + __expf(-v)); }
DI float siluf(float v) { return v * sigmf(v); }
DI int crow(int reg, int h) { return (reg & 3) + 8 * (reg >> 2) + 4 * h; }
DI float wave_sum(float v) {
#pragma unroll
  for (int o = 32; o >= 1; o >>= 1) v += __shfl_xor(v, o, 64);
  return v;
}
DI f32x16 zero16() { f32x16 z;
#pragma unroll
  for (int i = 0; i < 16; ++i) z[i] = 0.f; return z; }

#define SCAN_VLOAD 0
#define PROBE_NAIVE_SCAN 0
#if SCAN_VLOAD
DI void sload2(u32x16& a0, u32x16& a1, const void* p) { a0 = *(const u32x16*)p; a1 = *((const u32x16*)p + 1); }
DI void sload4(u32x16& a0, u32x16& a1, u32x16& b0, u32x16& b1, const void* p, const void* q) {
  a0 = *(const u32x16*)p; a1 = *((const u32x16*)p + 1); b0 = *(const u32x16*)q; b1 = *((const u32x16*)q + 1);
}
#else
DI void sload2(u32x16& a0, u32x16& a1, const void* p) {
  asm volatile("s_load_dwordx16 %0, %2, 0x0\n\ts_load_dwordx16 %1, %2, 0x40\n\ts_waitcnt lgkmcnt(0)" : "=&s"(a0), "=&s"(a1) : "s"(p) : "memory");
}
DI void sload4(u32x16& a0, u32x16& a1, u32x16& b0, u32x16& b1, const void* p, const void* q) {
  asm volatile("s_load_dwordx16 %0, %4, 0x0\n\ts_load_dwordx16 %1, %4, 0x40\n\ts_load_dwordx16 %2, %5, 0x0\n\ts_load_dwordx16 %3, %5, 0x40\n\ts_waitcnt lgkmcnt(0)"
               : "=&s"(a0), "=&s"(a1), "=&s"(b0), "=&s"(b1) : "s"(p), "s"(q) : "memory");
}
#endif
DI float HV(const u32x16& v, int j) { const uint32_t w = v[j >> 1]; const h2 t = __builtin_bit_cast(h2, w); return (float)t[j & 1]; }

constexpr int LDK = 72;
template <int BM, int BN, int MI, int NI, class AL, class BL>
DI void gemm_pass(f32x16 (&acc)[MI][NI], AL aload, BL bload, int K, ushort_t* As, ushort_t* Bs, int wrow0, int wcol0, int tid) {
  constexpr int NA = BM * 8 / NTH, NBC = BN * 8 / NTH;
  const int lane = tid & 63, l31 = lane & 31, hh = lane >> 5;
  uint4 ra[NA], rb[NBC];
#pragma unroll
  for (int i = 0; i < NA; ++i) { const int id = tid + i * NTH; ra[i] = aload(id >> 3, (id & 7) * 8); }
#pragma unroll
  for (int i = 0; i < NBC; ++i) { const int id = tid + i * NTH; rb[i] = bload(id >> 3, (id & 7) * 8); }
#pragma unroll 1
  for (int k0 = 0; k0 < K; k0 += 64) {
    __syncthreads();
#pragma unroll
    for (int i = 0; i < NA; ++i) { const int id = tid + i * NTH; *(uint4*)&As[(id >> 3) * LDK + (id & 7) * 8] = ra[i]; }
#pragma unroll
    for (int i = 0; i < NBC; ++i) { const int id = tid + i * NTH; *(uint4*)&Bs[(id >> 3) * LDK + (id & 7) * 8] = rb[i]; }
    __syncthreads();
    if (k0 + 64 < K) {
#pragma unroll
      for (int i = 0; i < NA; ++i) { const int id = tid + i * NTH; ra[i] = aload(id >> 3, k0 + 64 + (id & 7) * 8); }
#pragma unroll
      for (int i = 0; i < NBC; ++i) { const int id = tid + i * NTH; rb[i] = bload(id >> 3, k0 + 64 + (id & 7) * 8); }
    }
#pragma unroll
    for (int ks = 0; ks < 4; ++ks) {
      bf16x8 af[MI], bfv[NI];
#pragma unroll
      for (int mi = 0; mi < MI; ++mi) af[mi] = *(const bf16x8*)&As[(wrow0 + mi * 32 + l31) * LDK + ks * 16 + hh * 8];
#pragma unroll
      for (int ni = 0; ni < NI; ++ni) bfv[ni] = *(const bf16x8*)&Bs[(wcol0 + ni * 32 + l31) * LDK + ks * 16 + hh * 8];
#pragma unroll
      for (int mi = 0; mi < MI; ++mi)
#pragma unroll
        for (int ni = 0; ni < NI; ++ni) acc[mi][ni] = MFMA(af[mi], bfv[ni], acc[mi][ni]);
    }
  }
}

DI void transpose_tile(const float* __restrict__ src, int ld_src, ushort_t* dst, int ld_dst, int k0, int n0, float* T) {
  const int tid = threadIdx.x;
#pragma unroll
  for (int i = 0; i < 2; ++i) {
    const int k = (tid >> 4) + 32 * i, n4 = (tid & 15) * 4;
    const float4 v = *(const float4*)(src + (size_t)(k0 + k) * ld_src + n0 + n4);
    T[k * 65 + n4 + 0] = v.x; T[k * 65 + n4 + 1] = v.y; T[k * 65 + n4 + 2] = v.z; T[k * 65 + n4 + 3] = v.w;
  }
  __syncthreads();
  const int n = tid >> 3, kc = tid & 7;
  uint4 o;
  o.x = pack_bf2(T[(kc * 8 + 0) * 65 + n], T[(kc * 8 + 1) * 65 + n]);
  o.y = pack_bf2(T[(kc * 8 + 2) * 65 + n], T[(kc * 8 + 3) * 65 + n]);
  o.z = pack_bf2(T[(kc * 8 + 4) * 65 + n], T[(kc * 8 + 5) * 65 + n]);
  o.w = pack_bf2(T[(kc * 8 + 6) * 65 + n], T[(kc * 8 + 7) * 65 + n]);
  *(uint4*)(dst + (size_t)(n0 + n) * ld_dst + k0 + kc * 8) = o;
  __syncthreads();
}

DI void phase0(const Params& p, unsigned char* smem) {
  float* T = (float*)smem;
  ushort_t* win = (ushort_t*)(p.ws + OFF_WIN);
  ushort_t* wmg = (ushort_t*)(p.ws + OFF_WMG);
  ushort_t* wpa = (ushort_t*)(p.ws + OFF_WPA);
  ushort_t* wpb = (ushort_t*)(p.ws + OFF_WPB);
  ushort_t* wo = (ushort_t*)(p.ws + OFF_WO);
  ushort_t* wl = (ushort_t*)(p.ws + OFF_WL);
  float* mod = (float*)(p.ws + OFF_MOD);
  constexpr int T_IN = 16 * 56, T_MG = 16 * 32, T_PA = 8 * 16, T_PB = 8 * 16, T_O = 16 * 16, T_L = 32, T_MOD = 48;
  constexpr int TOTAL = T_MOD + T_IN + T_MG + T_PA + T_PB + T_O + T_L;
  for (int t = blockIdx.x; t < TOTAL; t += gridDim.x) {
    int u = t;
    if (u < T_MOD) {
      float* sil = T;
      float* red = T + 3072;
      const int tid = threadIdx.x;
      for (int i = tid; i < 3072; i += NTH) {
        const int v = i >> 10, k = i & 1023;
        const float cv = (v < 2) ? p.c[v * 1024 + k] : p.c_ctx[k];
        sil[i] = siluf(cv);
      }
      __syncthreads();
      const int n = tid & 63, ksl = tid >> 6, n0 = u * 64;
      float a0 = 0.f, a1 = 0.f, a2 = 0.f;
      for (int k = ksl * 128; k < ksl * 128 + 128; ++k) {
        const float w = p.w_ada[(size_t)k * 3072 + n0 + n];
        a0 = fmaf(sil[k], w, a0); a1 = fmaf(sil[1024 + k], w, a1); a2 = fmaf(sil[2048 + k], w, a2);
      }
      red[(ksl * 3 + 0) * 64 + n] = a0; red[(ksl * 3 + 1) * 64 + n] = a1; red[(ksl * 3 + 2) * 64 + n] = a2;
      __syncthreads();
      if (tid < 192) {
        const int v = tid >> 6, nn = tid & 63;
        float s = 0.f;
#pragma unroll
        for (int q = 0; q < 8; ++q) s += red[(q * 3 + v) * 64 + nn];
        mod[v * 3072 + n0 + nn] = s + p.b_ada[n0 + nn];
      }
      __syncthreads();
      continue;
    }
    u -= T_MOD;
    if (u < T_IN) { transpose_tile(p.w_in, INW, win, 1024, (u / 56) * 64, (u % 56) * 64, T); continue; }
    u -= T_IN;
    if (u < T_MG) { transpose_tile(p.w_mg, 2048, wmg, 1024, (u / 32) * 64, (u % 32) * 64, T); continue; }
    u -= T_MG;
    if (u < T_PA) { transpose_tile(p.w_pa, 1024, wpa, 512, (u / 16) * 64, (u % 16) * 64, T); continue; }
    u -= T_PA;
    if (u < T_PB) { transpose_tile(p.w_pb, 1024, wpb, 512, (u / 16) * 64, (u % 16) * 64, T); continue; }
    u -= T_PB;
    if (u < T_O) { transpose_tile(p.w_o, 1024, wo, 1024, (u / 16) * 64, (u % 16) * 64, T); continue; }
    u -= T_O;
    {
      const int which = u >> 4, dir = (u >> 3) & 1, nt = u & 7;
      const float* src = (which ? p.a_up : p.w_up) + (size_t)dir * 64 * 512;
      transpose_tile(src, 512, wl + (size_t)((dir * 2 + which) * 512) * 64, 64, 0, nt * 64, T);
    }
  }
}

DI void phase_h(const Params& p) {
  const float* mod = (const float*)(p.ws + OFF_MOD);
  ushort_t* H = (ushort_t*)(p.ws + OFF_SH);
  const int lane = threadIdx.x & 63, gw = blockIdx.x * 8 + (threadIdx.x >> 6);
  for (int row = gw; row < NT; row += gridDim.x * 8) {
    const float* src = (row < NX) ? p.x + (size_t)row * DM : p.ctx + (size_t)(row - NX) * DM;
    const float* md = mod + ((row < NX) ? (row / SEQ) : 2) * 3072;
    float4 v[4];
    float s = 0.f;
#pragma unroll
    for (int i = 0; i < 4; ++i) { v[i] = *(const float4*)(src + lane * 4 + 256 * i); s += v[i].x + v[i].y + v[i].z + v[i].w; }
    const float mu = wave_sum(s) * (1.f / DM);
    float q = 0.f;
#pragma unroll
    for (int i = 0; i < 4; ++i) { v[i].x -= mu; v[i].y -= mu; v[i].z -= mu; v[i].w -= mu; q += v[i].x * v[i].x + v[i].y * v[i].y + v[i].z * v[i].z + v[i].w * v[i].w; }
    const float rstd = rsqrtf(wave_sum(q) * (1.f / DM) + LN_EPS);
#pragma unroll
    for (int i = 0; i < 4; ++i) {
      const int col = lane * 4 + 256 * i;
      const float4 sh = *(const float4*)(md + col), sc = *(const float4*)(md + 1024 + col);
      uint2 o;
      o.x = pack_bf2(v[i].x * rstd * (1.f + sc.x) + sh.x, v[i].y * rstd * (1.f + sc.y) + sh.y);
      o.y = pack_bf2(v[i].z * rstd * (1.f + sc.z) + sh.z, v[i].w * rstd * (1.f + sc.w) + sh.w);
      *(uint2*)(H + (size_t)row * DM + col) = o;
    }
  }
}

DI void phase_gemm1(const Params& p, unsigned char* smem) {
  ushort_t* As = (ushort_t*)smem;
  ushort_t* Bs = As + 256 * LDK;
  const ushort_t* H = (const ushort_t*)(p.ws + OFF_SH);
  const ushort_t* W = (const ushort_t*)(p.ws + OFF_WIN);
  ushort_t* zq = (ushort_t*)(p.ws + OFF_ZQ);
  ushort_t* zg = (ushort_t*)(p.ws + OFF_ZG);
  ushort_t* zm = (ushort_t*)p.out;
  const int tid = threadIdx.x, wave = tid >> 6, lane = tid & 63, l31 = lane & 31, hh = lane >> 5;
  const int wrow0 = (wave & 3) * 64, wcol0 = (wave >> 2) * 64;
  constexpr int MT = NT / 256, NTL = INW / 128;
  for (int t = blockIdx.x; t < MT * NTL; t += gridDim.x) {
    const int mt = t / NTL, nt = t % NTL;
    const bool is_g = (nt >= 6 && nt < 10) || nt >= 24;
    if (is_g && mt >= NX / 256) continue;
    const int row0 = mt * 256, col0 = nt * 128;
    f32x16 acc[2][2];
#pragma unroll
    for (int a = 0; a < 2; ++a)
#pragma unroll
      for (int b = 0; b < 2; ++b) acc[a][b] = zero16();
    auto aload = [&](int r, int k) { return *(const uint4*)(H + (size_t)(row0 + r) * DM + k); };
    auto bload = [&](int n, int k) { return *(const uint4*)(W + (size_t)(col0 + n) * DM + k); };
    gemm_pass<256, 128, 2, 2>(acc, aload, bload, DM, As, Bs, wrow0, wcol0, tid);
    ushort_t* dst; int ld, cbase;
    if (nt < 6) { dst = zq; ld = 768; cbase = col0; }
    else if (nt < 10) { dst = zg; ld = 1024; cbase = col0 - 768; }
    else if (nt < 24) { dst = zm; ld = 1792; cbase = col0 - 1280; }
    else { dst = zg; ld = 1024; cbase = 512 + col0 - 3072; }
#pragma unroll
    for (int mi = 0; mi < 2; ++mi)
#pragma unroll
      for (int ni = 0; ni < 2; ++ni)
#pragma unroll
        for (int i = 0; i < 16; ++i) {
          const int row = row0 + wrow0 + mi * 32 + crow(i, hh), col = cbase + wcol0 + ni * 32 + l31;
          dst[(size_t)row * ld + col] = f2bf(acc[mi][ni][i]);
        }
  }
}

DI void phase_qkv(const Params& p) {
  const ushort_t* zq = (const ushort_t*)(p.ws + OFF_ZQ);
  ushort_t* QB = (ushort_t*)(p.ws + OFF_QB);
  ushort_t* KB = (ushort_t*)(p.ws + OFF_KB);
  ushort_t* VB = (ushort_t*)(p.ws + OFF_VB);
  const int lane = threadIdx.x & 63, gw = blockIdx.x * 8 + (threadIdx.x >> 6);
  const int j = lane & 31, half = lane >> 5, axis = j >> 4, f = j & 15;
  const int d1 = axis * 32 + f, d2 = d1 + 16;
  const float inv = powf(10000.f, -(float)f * (1.f / 16.f));
  const float gq1 = p.q_norm[d1], gq2 = p.q_norm[d2], gk1 = p.k_norm[d1], gk2 = p.k_norm[d2];
  for (int row = gw; row < NT; row += gridDim.x * 8) {
    const bool isx = row < NX;
    const int b = isx ? row / SEQ : (row - NX) / CTXL;
    const int t = isx ? row % SEQ : (row - NX) % CTXL;
    const int pos = isx ? CTXL + t : t;
    const ushort_t* z = zq + (size_t)row * 768;
    float cs = 1.f, sn = 0.f;
    if (isx) { const float ang = (float)(axis ? (t & 63) : (t >> 6)) * inv; sincosf(ang, &sn, &cs); }
#pragma unroll
    for (int it = 0; it < 5; ++it) {
      const int hd = it * 2 + half;
      if (!isx && hd < 8) continue;
      const float v1 = bf2f(z[hd * 64 + d1]), v2 = bf2f(z[hd * 64 + d2]);
      float ss = v1 * v1 + v2 * v2;
#pragma unroll
      for (int o = 16; o >= 1; o >>= 1) ss += __shfl_xor(ss, o, 64);
      const float rms = rsqrtf(ss * (1.f / 64.f) + QK_EPS);
      const bool isq = hd < 8;
      const float y1 = v1 * rms * (isq ? gq1 : gk1), y2 = v2 * rms * (isq ? gq2 : gk2);
      float o1 = y1 * cs - y2 * sn, o2 = y2 * cs + y1 * sn;
      if (isq) {
        ushort_t* dst = QB + ((size_t)(b * 8 + hd) * SEQ + t) * 64;
        dst[d1] = f2bf(o1 * QSCALE); dst[d2] = f2bf(o2 * QSCALE);
      } else {
        ushort_t* dst = KB + ((size_t)(b * 2 + (hd - 8)) * LTOT + pos) * 64;
        dst[d1] = f2bf(o1); dst[d2] = f2bf(o2);
      }
    }
    VB[((size_t)(b * 2 + 0) * LTOT + pos) * 64 + lane] = z[640 + lane];
    VB[((size_t)(b * 2 + 1) * LTOT + pos) * 64 + lane] = z[704 + lane];
  }
}

DI void phase_rwkv_prep(const Params& p, unsigned char* smem) {
  float* kbuf = (float*)smem;
  ushort_t* codes = (ushort_t*)(smem + 65536);
  float* invn = (float*)(smem + 65536 + 32 * 264 * 2);
  const ushort_t* zm = (const ushort_t*)p.out;
  const ushort_t* WL = (const ushort_t*)(p.ws + OFF_WL);
  ushort_t* SH = (ushort_t*)(p.ws + OFF_SH);
  ushort_t* DR = (ushort_t*)(p.ws + OFF_DR);
  const int tid = threadIdx.x, wave = tid >> 6, lane = tid & 63, l31 = lane & 31, hh = lane >> 5;
  for (int tt = blockIdx.x; tt < NT / 32; tt += gridDim.x) {
    const int row0 = tt * 32;
    int b, t0, len, pbase;
    if (row0 < NX) { b = row0 / SEQ; t0 = row0 % SEQ; len = SEQ; pbase = CTXL; }
    else { const int rc = row0 - NX; b = rc / CTXL; t0 = rc % CTXL; len = CTXL; pbase = 0; }
    __syncthreads();
    for (int id = tid; id < 32 * 224; id += NTH) {
      const int i = id / 224, c0 = (id % 224) * 8;
      const int t = t0 + i;
      const ushort_t* zr = zm + (size_t)(row0 + i) * 1792 + c0;
      const uint4 zc = *(const uint4*)zr;
      uint4 zp = make_uint4(0, 0, 0, 0), zn = make_uint4(0, 0, 0, 0);
      if (t > 0) zp = *(const uint4*)(zr - 1792);
      if (t < len - 1) zn = *(const uint4*)(zr + 1792);
      const float4 mp0 = *(const float4*)(p.mu_prev + c0), mp1 = *(const float4*)(p.mu_prev + c0 + 4);
      const float4 mn0 = *(const float4*)(p.mu_next + c0), mn1 = *(const float4*)(p.mu_next + c0 + 4);
      const unsigned zcw[4] = {zc.x, zc.y, zc.z, zc.w}, zpw[4] = {zp.x, zp.y, zp.z, zp.w}, znw[4] = {zn.x, zn.y, zn.z, zn.w};
      const float mpv[8] = {mp0.x, mp0.y, mp0.z, mp0.w, mp1.x, mp1.y, mp1.z, mp1.w};
      const float mnv[8] = {mn0.x, mn0.y, mn0.z, mn0.w, mn1.x, mn1.y, mn1.z, mn1.w};
      float s[8];
#pragma unroll
      for (int q = 0; q < 4; ++q) {
        const float c_lo = bflo(zcw[q]), c_hi = bfhi(zcw[q]);
        s[2 * q] = c_lo + mpv[2 * q] * (bflo(zpw[q]) - c_lo) + mnv[2 * q] * (bflo(znw[q]) - c_lo);
        s[2 * q + 1] = c_hi + mpv[2 * q + 1] * (bfhi(zpw[q]) - c_hi) + mnv[2 * q + 1] * (bfhi(znw[q]) - c_hi);
      }
      const int pp = pbase + t;
      if (c0 < 512 || (c0 >= 1024 && c0 < 1536)) {
        const int cc = (c0 < 512) ? c0 : c0 - 1024, which = (c0 < 512) ? 1 : 2;
        const int head = cc >> 6, d = cc & 63;
        uint4 o;
        o.x = pack_h2(s[0], s[1]); o.y = pack_h2(s[2], s[3]); o.z = pack_h2(s[4], s[5]); o.w = pack_h2(s[6], s[7]);
        *(uint4*)(SH + (((size_t)(b * 8 + head) * LTOT + pp) * 3 + which) * 64 + d) = o;
      } else if (c0 < 1024) {
        float* kd = kbuf + i * 512 + (c0 - 512);
        *(float4*)kd = make_float4(s[0], s[1], s[2], s[3]);
        *(float4*)(kd + 4) = make_float4(s[4], s[5], s[6], s[7]);
      } else {
        const int cc = c0 - 1536;
        if (cc < 128) {
#pragma unroll
          for (int q = 0; q < 8; ++q) s[q] = tanhf(s[q]);
        }
        uint4 o;
        o.x = pack_bf2(s[0], s[1]); o.y = pack_bf2(s[2], s[3]); o.z = pack_bf2(s[4], s[5]); o.w = pack_bf2(s[6], s[7]);
        *(uint4*)(codes + i * 264 + cc) = o;
      }
    }
    __syncthreads();
    {
      const int i = tid >> 4, head = (tid >> 1) & 7, hf = tid & 1;
      float ss = 0.f;
#pragma unroll 8
      for (int q = 0; q < 32; ++q) {
        const int n = head * 64 + hf * 32 + q;
        const float v = kbuf[i * 512 + n] * p.k_k[n];
        ss = fmaf(v, v, ss);
      }
      ss += __shfl_xor(ss, 1, 64);
      if (hf == 0) invn[i * 8 + head] = 1.f / fmaxf(sqrtf(ss), 1e-12f);
    }
    __syncthreads();
#pragma unroll 1
    for (int q4 = 0; q4 < 4; ++q4) {
      const int pr = wave * 4 + q4, dir = pr >> 4, ct = pr & 15;
      f32x16 aw = zero16(), aa = zero16();
#pragma unroll
      for (int ks = 0; ks < 4; ++ks) {
        const bf16x8 fw = *(const bf16x8*)&codes[l31 * 264 + dir * 64 + ks * 16 + hh * 8];
        const bf16x8 fa = *(const bf16x8*)&codes[l31 * 264 + 128 + dir * 64 + ks * 16 + hh * 8];
        const bf16x8 bw = *(const bf16x8*)&WL[(size_t)((dir * 2 + 0) * 512 + ct * 32 + l31) * 64 + ks * 16 + hh * 8];
        const bf16x8 ba = *(const bf16x8*)&WL[(size_t)((dir * 2 + 1) * 512 + ct * 32 + l31) * 64 + ks * 16 + hh * 8];
        aw = MFMA(fw, bw, aw);
        aa = MFMA(fa, ba, aa);
      }
      const int n = ct * 32 + l31, head = n >> 6, d = n & 63;
      const float w0v = p.w0[dir * 512 + n], a0v = p.a0[dir * 512 + n], kkw = p.k_k[n], kaw = p.k_a[n];
      const size_t cbase = (size_t)(b * 8 + head) * LTOT;
#pragma unroll
      for (int i = 0; i < 16; ++i) {
        const int ti = crow(i, hh);
        const int pp = pbase + t0 + ti;
        const float wpre = aw[i] + w0v;
        const float wlog = -log1pf(expf(-wpre)) - 0.5f;
        const float e = expf(wlog);
        const float xdec = -expm1f(-e);
        const float a = sigmf(aa[i] + a0v);
        const float kv = kbuf[ti * 512 + n];
        const float kkv = kv * kkw * invn[ti * 8 + head];
        const float kd = kv * (1.f + (a - 1.f) * kaw);
        ushort_t* dr = DR + ((((size_t)dir * 16) * LTOT + cbase + pp) * 3) * 64 + d;
        dr[0] = f2h(xdec); dr[64] = f2h(kd); dr[128] = f2h(kkv * a);
        if (dir == 0) SH[((cbase + pp) * 3) * 64 + d] = f2h(kkv);
      }
    }
  }
}

DI int tau_to_pos(int dir, int tau) { return dir == 0 ? tau : (tau < CTXL ? CTXL - 1 - tau : LTOT - 1 - (tau - CTXL)); }

struct ScanRec { uint32_t sh, dr, bb; ushort_t v; };
DI ScanRec scan_load(const ushort_t* shc, const ushort_t* drc, int pos, int lane) {
  ScanRec r;
  const ushort_t* s = shc + (size_t)pos * 192;
  const uint32_t* d = (const uint32_t*)(drc + (size_t)pos * 192);
  r.sh = ((const uint32_t*)s)[lane];
  r.v = s[128 + lane];
  r.dr = d[lane];
  r.bb = d[64 + (lane & 31)];
  return r;
}
#define RL(v, l) ((uint32_t)__builtin_amdgcn_readlane((int)(v), (l)))
template <bool WITH_OUT>
DI float scan_step(float (&S)[64], const ScanRec& c, float vv) {
  float sk0 = 0.f, sk1 = 0.f;
#pragma unroll
  for (int q = 0; q < 32; ++q) { const uint32_t w = RL(c.sh, q); sk0 = fmaf(S[2 * q], hlo(w), sk0); sk1 = fmaf(S[2 * q + 1], hhi(w), sk1); }
  const float nsk = -(sk0 + sk1);
#pragma unroll
  for (int q = 0; q < 32; ++q) {
    const uint32_t x = RL(c.dr, q), kd = RL(c.dr, 32 + q), bq = RL(c.bb, q);
    float s0 = S[2 * q], s1 = S[2 * q + 1];
    s0 = fmaf(s0, -hlo(x), s0); s1 = fmaf(s1, -hhi(x), s1);
    s0 = fmaf(vv, hlo(kd), s0); s1 = fmaf(vv, hhi(kd), s1);
    s0 = fmaf(nsk, hlo(bq), s0); s1 = fmaf(nsk, hhi(bq), s1);
    S[2 * q] = s0; S[2 * q + 1] = s1;
  }
  float o0 = 0.f, o1 = 0.f;
  if (WITH_OUT) {
#pragma unroll
    for (int q = 0; q < 32; ++q) { const uint32_t w = RL(c.sh, 32 + q); o0 = fmaf(S[2 * q], hlo(w), o0); o1 = fmaf(S[2 * q + 1], hhi(w), o1); }
  }
  return o0 + o1;
}
constexpr int SPF = 3;
DI void phase_scanA(const Params& p, unsigned char* smem) {
  const ushort_t* SH = (const ushort_t*)(p.ws + OFF_SH);
  const ushort_t* DR = (const ushort_t*)(p.ws + OFF_DR);
  float* PU = p.out;
  const int lane = threadIdx.x & 63;
  const int gw = __builtin_amdgcn_readfirstlane(blockIdx.x * 8 + (threadIdx.x >> 6));
  for (int wt = gw; wt < 32 * NCHUNK * 2; wt += gridDim.x * 8) {
    const int task = wt >> 1, half = wt & 1;
    const int cd = task / NCHUNK, j = task % NCHUNK, dir = cd >> 4, c = cd & 15;
    float S[64];
#pragma unroll
    for (int k = 0; k < 64; ++k) S[k] = (half && k == lane) ? 1.f : 0.f;
    const ushort_t* shc = SH + (size_t)c * LTOT * 192;
    const ushort_t* drc = DR + (size_t)(dir * 16 + c) * LTOT * 192;
    ScanRec r0 = scan_load(shc, drc, tau_to_pos(dir, j * CH + 0), lane);
    ScanRec r1 = scan_load(shc, drc, tau_to_pos(dir, j * CH + 1), lane);
    ScanRec r2 = scan_load(shc, drc, tau_to_pos(dir, j * CH + 2), lane);
#pragma unroll 1
    for (int st = 0; st < CH; ++st) {
      const ScanRec r3 = scan_load(shc, drc, tau_to_pos(dir, j * CH + (st + SPF < CH ? st + SPF : CH - 1)), lane);
      const float vv = half ? 0.f : h2f(r0.v);
      scan_step<false>(S, r0, vv);
      r0 = r1; r1 = r2; r2 = r3;
    }
    float* dst = PU + ((size_t)task * 2 + half) * 4096 + lane * 64;
#pragma unroll
    for (int k = 0; k < 64; k += 4) *(float4*)(dst + k) = make_float4(S[k], S[k + 1], S[k + 2], S[k + 3]);
  }
}

DI void phase_scanB(const Params& p, unsigned char* smem) {
  if (blockIdx.x >= 32) return;
  float* Sb = (float*)smem;
  float* Pb = Sb + 64 * 65;
  float* PU = p.out;
  const int cd = blockIdx.x, tid = threadIdx.x, i = tid >> 3, n0 = (tid & 7) * 8;
  float s[8], pn[8], un[8];
#pragma unroll
  for (int q = 0; q < 8; ++q) s[q] = 0.f;
  {
    const float* base = PU + (size_t)(cd * NCHUNK) * 2 * 4096;
    const float4 a = *(const float4*)(base + 4096 + tid * 8), b = *(const float4*)(base + 4096 + tid * 8 + 4);
    const float4 c = *(const float4*)(base + i * 64 + n0), d = *(const float4*)(base + i * 64 + n0 + 4);
    pn[0] = a.x; pn[1] = a.y; pn[2] = a.z; pn[3] = a.w; pn[4] = b.x; pn[5] = b.y; pn[6] = b.z; pn[7] = b.w;
    un[0] = c.x; un[1] = c.y; un[2] = c.z; un[3] = c.w; un[4] = d.x; un[5] = d.y; un[6] = d.z; un[7] = d.w;
  }
#pragma unroll 1
  for (int j = 0; j < NCHUNK; ++j) {
    float* base = PU + (size_t)(cd * NCHUNK + j) * 2 * 4096;
    float u[8];
    __syncthreads();
#pragma unroll
    for (int q = 0; q < 8; ++q) { Pb[tid * 8 + q] = pn[q]; u[q] = un[q]; Sb[i * 65 + n0 + q] = s[q]; }
    __syncthreads();
    *(float4*)(base + 4096 + i * 64 + n0) = make_float4(s[0], s[1], s[2], s[3]);
    *(float4*)(base + 4096 + i * 64 + n0 + 4) = make_float4(s[4], s[5], s[6], s[7]);
    if (j + 1 < NCHUNK) {
      const float* nb = base + 2 * 4096;
      const float4 a = *(const float4*)(nb + 4096 + tid * 8), b = *(const float4*)(nb + 4096 + tid * 8 + 4);
      const float4 c = *(const float4*)(nb + i * 64 + n0), d = *(const float4*)(nb + i * 64 + n0 + 4);
      pn[0] = a.x; pn[1] = a.y; pn[2] = a.z; pn[3] = a.w; pn[4] = b.x; pn[5] = b.y; pn[6] = b.z; pn[7] = b.w;
      un[0] = c.x; un[1] = c.y; un[2] = c.z; un[3] = c.w; un[4] = d.x; un[5] = d.y; un[6] = d.z; un[7] = d.w;
    }
#pragma unroll
    for (int q = 0; q < 8; ++q) s[q] = u[q];
#pragma unroll 8
    for (int k = 0; k < 64; ++k) {
      const float a = Sb[i * 65 + k];
      const float4 p0 = *(const float4*)&Pb[k * 64 + n0], p1 = *(const float4*)&Pb[k * 64 + n0 + 4];
      s[0] = fmaf(a, p0.x, s[0]); s[1] = fmaf(a, p0.y, s[1]); s[2] = fmaf(a, p0.z, s[2]); s[3] = fmaf(a, p0.w, s[3]);
      s[4] = fmaf(a, p1.x, s[4]); s[5] = fmaf(a, p1.y, s[5]); s[6] = fmaf(a, p1.z, s[6]); s[7] = fmaf(a, p1.w, s[7]);
    }
  }
}

DI void phase_scanC(const Params& p, unsigned char* smem) {
  const ushort_t* SH = (const ushort_t*)(p.ws + OFF_SH);
  const ushort_t* DR = (const ushort_t*)(p.ws + OFF_DR);
  ushort_t* O = (ushort_t*)(p.ws + OFF_ZQ);
  const float* PU = p.out;
  const int lane = threadIdx.x & 63;
  const int gw = __builtin_amdgcn_readfirstlane(blockIdx.x * 8 + (threadIdx.x >> 6));
  for (int task = gw; task < 32 * NCHUNK; task += gridDim.x * 8) {
    const int cd = task / NCHUNK, j = task % NCHUNK, dir = cd >> 4, c = cd & 15, b = c >> 3, head = c & 7;
    float S[64];
    const float* src = PU + ((size_t)task * 2 + 1) * 4096 + lane * 64;
#pragma unroll
    for (int k = 0; k < 64; k += 4) { const float4 v = *(const float4*)(src + k); S[k] = v.x; S[k + 1] = v.y; S[k + 2] = v.z; S[k + 3] = v.w; }
    const ushort_t* shc = SH + (size_t)c * LTOT * 192;
    const ushort_t* drc = DR + (size_t)(dir * 16 + c) * LTOT * 192;
    ushort_t* obase = O + ((size_t)dir * NX + (size_t)b * SEQ) * 512 + head * 64 + lane;
    ScanRec r0 = scan_load(shc, drc, tau_to_pos(dir, j * CH + 0), lane);
    ScanRec r1 = scan_load(shc, drc, tau_to_pos(dir, j * CH + 1), lane);
    ScanRec r2 = scan_load(shc, drc, tau_to_pos(dir, j * CH + 2), lane);
#pragma unroll 1
    for (int st = 0; st < CH; ++st) {
      const int pos = tau_to_pos(dir, j * CH + st);
      const ScanRec r3 = scan_load(shc, drc, tau_to_pos(dir, j * CH + (st + SPF < CH ? st + SPF : CH - 1)), lane);
      const float o = scan_step<true>(S, r0, h2f(r0.v));
      if (pos >= CTXL) obase[(size_t)(pos - CTXL) * 512] = f2h(o);
      r0 = r1; r1 = r2; r2 = r3;
    }
  }
}

DI void phase_scan_naive(const Params& p) {
  const ushort_t* SH = (const ushort_t*)(p.ws + OFF_SH);
  const ushort_t* DR = (const ushort_t*)(p.ws + OFF_DR);
  ushort_t* O = (ushort_t*)(p.ws + OFF_ZQ);
  const int lane = threadIdx.x & 63;
  const int gw = __builtin_amdgcn_readfirstlane(blockIdx.x * 8 + (threadIdx.x >> 6));
  if (gw >= 32) return;
  const int cd = gw, dir = cd >> 4, c = cd & 15, b = c >> 3, head = c & 7;
  float S[64];
#pragma unroll
  for (int k = 0; k < 64; ++k) S[k] = 0.f;
  const ushort_t* shc = SH + (size_t)c * LTOT * 192;
  const ushort_t* drc = DR + (size_t)(dir * 16 + c) * LTOT * 192;
#pragma unroll 1
  for (int tau = 0; tau < LTOT; ++tau) {
    const int pos = tau_to_pos(dir, tau);
    const ushort_t* shr = shc + (size_t)pos * 192;
    const ushort_t* drr = drc + (size_t)pos * 192;
    const float vv = h2f(shr[128 + lane]);
    u32x16 k0, k1;
    sload2(k0, k1, shr);
    float sk0 = 0.f, sk1 = 0.f;
#pragma unroll
    for (int q = 0; q < 32; ++q) { sk0 = fmaf(S[q], HV(k0, q), sk0); sk1 = fmaf(S[32 + q], HV(k1, q), sk1); }
    const float nsk = -(sk0 + sk1);
    u32x16 x0, x1, d0, d1;
    sload4(x0, x1, d0, d1, drr, drr + 64);
#pragma unroll
    for (int q = 0; q < 32; ++q) {
      S[q] = fmaf(S[q], -HV(x0, q), S[q]); S[32 + q] = fmaf(S[32 + q], -HV(x1, q), S[32 + q]);
      S[q] = fmaf(vv, HV(d0, q), S[q]); S[32 + q] = fmaf(vv, HV(d1, q), S[32 + q]);
    }
    u32x16 b0, b1, r0, r1;
    sload4(b0, b1, r0, r1, drr + 128, shr + 64);
    float o0 = 0.f, o1 = 0.f;
#pragma unroll
    for (int q = 0; q < 32; ++q) {
      S[q] = fmaf(nsk, HV(b0, q), S[q]); S[32 + q] = fmaf(nsk, HV(b1, q), S[32 + q]);
      o0 = fmaf(S[q], HV(r0, q), o0); o1 = fmaf(S[32 + q], HV(r1, q), o1);
    }
    if (pos >= CTXL) O[((size_t)dir * NX + (size_t)b * SEQ + (pos - CTXL)) * 512 + head * 64 + lane] = f2h(o0 + o1);
  }
}

DI int vperm(int key) { const int g = key >> 4, kq = key & 15; return g * 16 + 8 * ((kq >> 2) & 1) + (kq & 3) + 4 * (kq >> 3); }
DI void phase_attn(const Params& p, unsigned char* smem) {
  ushort_t* Ks = (ushort_t*)smem;
  ushort_t* Vt = Ks + 64 * LDK;
  ushort_t* QB = (ushort_t*)(p.ws + OFF_QB);
  const ushort_t* KB = (const ushort_t*)(p.ws + OFF_KB);
  const ushort_t* VB = (const ushort_t*)(p.ws + OFF_VB);
  const int tid = threadIdx.x, wave = tid >> 6, lane = tid & 63, l31 = lane & 31, hh = lane >> 5;
  const int kkey = tid >> 3, kc8 = tid & 7;
  const int vkey = tid & 63, vc8 = tid >> 6;
  const int vpos = vperm(vkey);
  for (int at = blockIdx.x; at < 1024; at += gridDim.x) {
    const int b = at >> 9, kvh = (at >> 8) & 1, t0 = (at & 255) * 64;
    const int head = kvh * 4 + (wave & 3), tq = t0 + (wave >> 2) * 32 + l31;
    ushort_t* qrow = QB + ((size_t)(b * 8 + head) * SEQ + tq) * 64;
    bf16x8 qf[4];
#pragma unroll
    for (int ks = 0; ks < 4; ++ks) qf[ks] = *(const bf16x8*)(qrow + ks * 16 + hh * 8);
    const ushort_t* kbase = KB + (size_t)(b * 2 + kvh) * LTOT * 64;
    const ushort_t* vbase = VB + (size_t)(b * 2 + kvh) * LTOT * 64;
    f32x16 o[2] = {zero16(), zero16()};
    float m = -1e30f, lsum = 0.f;
    uint4 rk = *(const uint4*)(kbase + (size_t)kkey * 64 + kc8 * 8);
    uint4 rv = *(const uint4*)(vbase + (size_t)vkey * 64 + vc8 * 8);
#pragma unroll 1
    for (int kt = 0; kt < LTOT / 64; ++kt) {
      __syncthreads();
      *(uint4*)&Ks[kkey * LDK + kc8 * 8] = rk;
      {
        const unsigned w[4] = {rv.x, rv.y, rv.z, rv.w};
#pragma unroll
        for (int q = 0; q < 4; ++q) {
          Vt[(vc8 * 8 + 2 * q) * LDK + vpos] = (ushort_t)(w[q] & 0xffffu);
          Vt[(vc8 * 8 + 2 * q + 1) * LDK + vpos] = (ushort_t)(w[q] >> 16);
        }
      }
      __syncthreads();
      if (kt + 1 < LTOT / 64) {
        rk = *(const uint4*)(kbase + (size_t)((kt + 1) * 64 + kkey) * 64 + kc8 * 8);
        rv = *(const uint4*)(vbase + (size_t)((kt + 1) * 64 + vkey) * 64 + vc8 * 8);
      }
      f32x16 s[2] = {zero16(), zero16()};
#pragma unroll
      for (int ks = 0; ks < 4; ++ks) {
#pragma unroll
        for (int kk = 0; kk < 2; ++kk) {
          const bf16x8 kf = *(const bf16x8*)&Ks[(kk * 32 + l31) * LDK + ks * 16 + hh * 8];
          s[kk] = MFMA(kf, qf[ks], s[kk]);
        }
      }
      float mx = s[0][0];
#pragma unroll
      for (int i = 0; i < 16; ++i) { mx = fmaxf(mx, s[0][i]); mx = fmaxf(mx, s[1][i]); }
      mx = fmaxf(mx, __shfl_xor(mx, 32, 64));
      const float mn = fmaxf(m, mx);
      const float alpha = __builtin_amdgcn_exp2f(m - mn);
      m = mn;
      float ps = 0.f;
#pragma unroll
      for (int i = 0; i < 16; ++i) {
        s[0][i] = __builtin_amdgcn_exp2f(s[0][i] - mn); s[1][i] = __builtin_amdgcn_exp2f(s[1][i] - mn);
        ps += s[0][i] + s[1][i];
      }
      lsum = lsum * alpha + ps;
#pragma unroll
      for (int i = 0; i < 16; ++i) { o[0][i] *= alpha; o[1][i] *= alpha; }
#pragma unroll
      for (int kk = 0; kk < 2; ++kk) {
#pragma unroll
        for (int st = 0; st < 2; ++st) {
          uint4 pw;
          pw.x = pack_bf2(s[kk][8 * st + 0], s[kk][8 * st + 1]); pw.y = pack_bf2(s[kk][8 * st + 2], s[kk][8 * st + 3]);
          pw.z = pack_bf2(s[kk][8 * st + 4], s[kk][8 * st + 5]); pw.w = pack_bf2(s[kk][8 * st + 6], s[kk][8 * st + 7]);
          const bf16x8 pf = __builtin_bit_cast(bf16x8, pw);
#pragma unroll
          for (int dt = 0; dt < 2; ++dt) {
            const bf16x8 vf = *(const bf16x8*)&Vt[(dt * 32 + l31) * LDK + kk * 32 + st * 16 + hh * 8];
            o[dt] = MFMA(vf, pf, o[dt]);
          }
        }
      }
    }
    const float ltot = lsum + __shfl_xor(lsum, 32, 64);
    const float il = 1.f / ltot;
#pragma unroll
    for (int dt = 0; dt < 2; ++dt)
#pragma unroll
      for (int g = 0; g < 4; ++g) {
        uint2 w;
        w.x = pack_bf2(o[dt][4 * g + 0] * il, o[dt][4 * g + 1] * il);
        w.y = pack_bf2(o[dt][4 * g + 2] * il, o[dt][4 * g + 3] * il);
        *(uint2*)(qrow + dt * 32 + 8 * g + 4 * hh) = w;
      }
  }
}

constexpr size_t OFF_DBG = WS_END;
DI void dbg_acc(const Params& p, int slot, float d2, float r2) {
  float* dbg = (float*)(p.ws + OFF_DBG);
  d2 = wave_sum(d2); r2 = wave_sum(r2);
  if ((threadIdx.x & 63) == 0) { atomicAdd(dbg + 2 * slot, d2); atomicAdd(dbg + 2 * slot + 1, r2); }
}
DI void probe_after_gemm1(const Params& p) {
  if (blockIdx.x != 0) return;
  const int tid = threadIdx.x, lane = tid & 63, wave = tid >> 6;
  const float* mod = (const float*)(p.ws + OFF_MOD);
  const ushort_t* H = (const ushort_t*)(p.ws + OFF_SH);
  {
    float d2 = 0.f, r2 = 0.f;
    if (tid < 96) {
      const int v = tid / 32, n = (tid % 32) * 97 % 3072;
      float s = 0.f;
      for (int k = 0; k < 1024; ++k) { const float cv = (v < 2) ? p.c[v * 1024 + k] : p.c_ctx[k]; s += (cv / (1.f + expf(-cv))) * p.w_ada[(size_t)k * 3072 + n]; }
      s += p.b_ada[n];
      const float d = mod[v * 3072 + n] - s; d2 = d * d; r2 = s * s;
    }
    dbg_acc(p, 0, d2, r2);
  }
  {
    const int row = wave == 0 ? 0 : wave == 1 ? 777 : wave == 2 ? 16383 : wave == 3 ? 16384 : wave == 4 ? 32767 : wave == 5 ? 32768 : wave == 6 ? 33023 : 33279;
    const float* src = (row < NX) ? p.x + (size_t)row * DM : p.ctx + (size_t)(row - NX) * DM;
    const float* md = mod + ((row < NX) ? (row / SEQ) : 2) * 3072;
    float s = 0.f;
    for (int i = lane; i < 1024; i += 64) s += src[i];
    const float mu = wave_sum(s) / 1024.f;
    float q = 0.f;
    for (int i = lane; i < 1024; i += 64) q += (src[i] - mu) * (src[i] - mu);
    const float rstd = rsqrtf(wave_sum(q) / 1024.f + LN_EPS);
    float d2 = 0.f, r2 = 0.f;
    for (int i = lane; i < 1024; i += 64) {
      const float ref = (src[i] - mu) * rstd * (1.f + md[1024 + i]) + md[i];
      const float d = bf2f(H[(size_t)row * DM + i]) - ref; d2 += d * d; r2 += ref * ref;
    }
    dbg_acc(p, 1, d2, r2);
  }
  {
    float d2 = 0.f, r2 = 0.f;
    if (tid < 60) {
      const int ri = tid / 10, ci = tid % 10;
      const int row = ri == 0 ? 3 : ri == 1 ? 777 : ri == 2 ? 20001 : ri == 3 ? 32767 : ri == 4 ? 32773 : 33279;
      const int col = ci == 0 ? 0 : ci == 1 ? 100 : ci == 2 ? 700 : ci == 3 ? 800 : ci == 4 ? 1279 : ci == 5 ? 1280 : ci == 6 ? 2000 : ci == 7 ? 3071 : ci == 8 ? 3072 : 3583;
      float s = 0.f;
      for (int k = 0; k < 1024; ++k) s += bf2f(H[(size_t)row * DM + k]) * p.w_in[(size_t)k * INW + col];
      float got = 0.f; bool have = true;
      if (col < 768) got = bf2f(((const ushort_t*)(p.ws + OFF_ZQ))[(size_t)row * 768 + col]);
      else if (col < 1280) { if (row < NX) got = bf2f(((const ushort_t*)(p.ws + OFF_ZG))[(size_t)row * 1024 + col - 768]); else have = false; }
      else if (col < 3072) got = bf2f(((const ushort_t*)p.out)[(size_t)row * 1792 + col - 1280]);
      else { if (row < NX) got = bf2f(((const ushort_t*)(p.ws + OFF_ZG))[(size_t)row * 1024 + 512 + col - 3072]); else have = false; }
      if (have) { const float d = got - s; d2 = d * d; r2 = s * s; }
    }
    dbg_acc(p, 2, d2, r2);
  }
}
DI void probe_after_prep(const Params& p, unsigned char* smem) {
  if (blockIdx.x != 0) return;
  float* cbuf = (float*)smem;
  const int tid = threadIdx.x, lane = tid & 63, wave = tid >> 6;
  const ushort_t* zm = (const ushort_t*)p.out;
  const ushort_t* SH = (const ushort_t*)(p.ws + OFF_SH);
  const ushort_t* DR = (const ushort_t*)(p.ws + OFF_DR);
  float dA = 0.f, rA = 0.f, dB = 0.f, rB = 0.f;
#pragma unroll 1
  for (int sidx = wave; sidx < 24; sidx += 8) {
    const int ri = sidx >> 1, head = (sidx & 1) ? 5 : 0;
    const int row = ri == 0 ? 0 : ri == 1 ? 1 : ri == 2 ? 31 : ri == 3 ? 32 : ri == 4 ? 16383 : ri == 5 ? 16384 : ri == 6 ? 20000 : ri == 7 ? 32767 : ri == 8 ? 32768 : ri == 9 ? 33023 : ri == 10 ? 33024 : 33279;
    int b, t, len, pp;
    if (row < NX) { b = row / SEQ; t = row % SEQ; len = SEQ; pp = CTXL + t; } else { b = (row - NX) / CTXL; t = (row - NX) % CTXL; len = CTXL; pp = t; }
    auto sft = [&](int col) {
      const float z = bf2f(zm[(size_t)row * 1792 + col]);
      const float zp = (t > 0) ? bf2f(zm[(size_t)(row - 1) * 1792 + col]) : 0.f;
      const float zn = (t < len - 1) ? bf2f(zm[(size_t)(row + 1) * 1792 + col]) : 0.f;
      return z + p.mu_prev[col] * (zp - z) + p.mu_next[col] * (zn - z);
    };
    const int n = head * 64 + lane;
    const float r = sft(n), k = sft(512 + n), v = sft(1024 + n);
#pragma unroll 1
    for (int j = lane; j < 256; j += 64) { const float s = sft(1536 + j); cbuf[wave * 256 + j] = (j < 128) ? tanhf(s) : s; }
    __builtin_amdgcn_s_waitcnt(0);
    __builtin_amdgcn_wave_barrier();
    const float kr = k * p.k_k[n];
    const float nrm = sqrtf(wave_sum(kr * kr));
    const float kk = kr / fmaxf(nrm, 1e-12f);
    const size_t cp = (size_t)(b * 8 + head) * LTOT + pp;
    { float d;
      d = h2f(SH[(cp * 3 + 0) * 64 + lane]) - kk; dA += d * d; rA += kk * kk;
      d = h2f(SH[(cp * 3 + 1) * 64 + lane]) - r; dA += d * d; rA += r * r;
      d = h2f(SH[(cp * 3 + 2) * 64 + lane]) - v; dA += d * d; rA += v * v; }
#pragma unroll 1
    for (int dir = 0; dir < 2; ++dir) {
      float wpre = p.w0[dir * 512 + n], apre = p.a0[dir * 512 + n];
#pragma unroll 1
      for (int j = 0; j < 64; ++j) {
        wpre += cbuf[wave * 256 + dir * 64 + j] * p.w_up[(size_t)(dir * 64 + j) * 512 + n];
        apre += cbuf[wave * 256 + 128 + dir * 64 + j] * p.a_up[(size_t)(dir * 64 + j) * 512 + n];
      }
      const float wlog = -log1pf(expf(-wpre)) - 0.5f;
      const float xd = 1.f - expf(-expf(wlog));
      const float a = 1.f / (1.f + expf(-apre));
      const float kd = k * (1.f + (a - 1.f) * p.k_a[n]);
      const float bq = kk * a;
      const size_t dp = (size_t)(dir * 16 + b * 8 + head) * LTOT + pp;
      float d;
      d = h2f(DR[(dp * 3 + 0) * 64 + lane]) - xd; dB += d * d; rB += xd * xd;
      d = h2f(DR[(dp * 3 + 1) * 64 + lane]) - kd; dB += d * d; rB += kd * kd;
      d = h2f(DR[(dp * 3 + 2) * 64 + lane]) - bq; dB += d * d; rB += bq * bq;
    }
    __builtin_amdgcn_wave_barrier();
  }
  dbg_acc(p, 3, dA, rA);
  dbg_acc(p, 4, dB, rB);
}

DI void probe_scan(const Params& p) {
  if (blockIdx.x != 0 || threadIdx.x >= 128) return;
  const ushort_t* SH = (const ushort_t*)(p.ws + OFF_SH);
  const ushort_t* DR = (const ushort_t*)(p.ws + OFF_DR);
  const ushort_t* O = (const ushort_t*)(p.ws + OFF_ZQ);
  const int lane = threadIdx.x & 63, wv = threadIdx.x >> 6;
  const int c = wv ? 9 : 0, dir = wv, b = c >> 3, head = c & 7;
  float S[64];
#pragma unroll
  for (int k = 0; k < 64; ++k) S[k] = 0.f;
  float d2 = 0.f, r2 = 0.f;
#pragma unroll 1
  for (int tau = 0; tau < 420; ++tau) {
    const int pos = dir == 0 ? tau : (tau < CTXL ? CTXL - 1 - tau : LTOT - 1 - (tau - CTXL));
    const ushort_t* sh = SH + ((size_t)c * LTOT + pos) * 192;
    const ushort_t* dr = DR + ((size_t)(dir * 16 + c) * LTOT + pos) * 192;
    const float v = h2f(sh[128 + lane]);
    float sk = 0.f;
#pragma unroll
    for (int k = 0; k < 64; ++k) sk += S[k] * h2f(sh[k]);
    float o = 0.f;
#pragma unroll
    for (int k = 0; k < 64; ++k) {
      const float dec = 1.f - h2f(dr[k]);
      S[k] = S[k] * dec - sk * h2f(dr[128 + k]) + v * h2f(dr[64 + k]);
      o += S[k] * h2f(sh[64 + k]);
    }
    if (pos >= CTXL) {
      const float got = h2f(O[((size_t)dir * NX + (size_t)b * SEQ + (pos - CTXL)) * 512 + head * 64 + lane]);
      const float d = got - o; d2 += d * d; r2 += o * o;
    }
  }
  dbg_acc(p, 0, d2, r2);
}
DI float probe_delta(const Params& p) {
  const float* dbg = (const float*)(p.ws + OFF_DBG);
  int k = 0;
  for (int s = 0; s < 5; ++s) { const float rel = sqrtf(dbg[2 * s] / fmaxf(dbg[2 * s + 1], 1e-30f)); if (!(rel < 0.05f)) k |= 1 << s; }
  return sqrtf(0.02f * (float)k);
}

DI void phase_final(const Params& p, unsigned char* smem) {
  ushort_t* As = (ushort_t*)smem;
  ushort_t* Bs = As + 128 * LDK;
  const float* mod = (const float*)(p.ws + OFF_MOD);
  ushort_t* ZG = (ushort_t*)(p.ws + OFF_ZG);
  ushort_t* QB = (ushort_t*)(p.ws + OFF_QB);
  ushort_t* O = (ushort_t*)(p.ws + OFF_ZQ);
  const ushort_t* SH = (const ushort_t*)(p.ws + OFF_SH);
  const ushort_t* DR = (const ushort_t*)(p.ws + OFF_DR);
  const ushort_t* WMG = (const ushort_t*)(p.ws + OFF_WMG);
  const ushort_t* WPA = (const ushort_t*)(p.ws + OFF_WPA);
  const ushort_t* WPB = (const ushort_t*)(p.ws + OFF_WPB);
  const ushort_t* WO = (const ushort_t*)(p.ws + OFF_WO);
#pragma unroll 1
  for (int mt = blockIdx.x; mt < NX / 128; mt += gridDim.x) {
    int tid = threadIdx.x;
    asm volatile("" : "+v"(tid));
    const int wave = tid >> 6, lane = tid & 63, l31 = lane & 31, hh = lane >> 5;
    const int wrow0 = (wave & 3) * 32, wcol0 = (wave >> 2) * 64;
    const int row0 = mt * 128, b = row0 / SEQ, tb0 = row0 % SEQ;
    const float* md = mod + b * 3072;
    __syncthreads();
#pragma unroll 1
    for (int r = wave; r < 128; r += 8) {
      const float* src = p.x + (size_t)(row0 + r) * DM;
      ushort_t* hdst = (ushort_t*)(p.out + (size_t)(row0 + r) * DM);
      float4 v[4];
      float s = 0.f;
#pragma unroll
      for (int i = 0; i < 4; ++i) { v[i] = *(const float4*)(src + lane * 4 + 256 * i); s += v[i].x + v[i].y + v[i].z + v[i].w; }
      const float mu = wave_sum(s) * (1.f / DM);
      float q = 0.f;
#pragma unroll
      for (int i = 0; i < 4; ++i) { v[i].x -= mu; v[i].y -= mu; v[i].z -= mu; v[i].w -= mu; q += v[i].x * v[i].x + v[i].y * v[i].y + v[i].z * v[i].z + v[i].w * v[i].w; }
      const float rstd = rsqrtf(wave_sum(q) * (1.f / DM) + LN_EPS);
#pragma unroll
      for (int i = 0; i < 4; ++i) {
        const int col = lane * 4 + 256 * i;
        const float4 sh = *(const float4*)(md + col), sc = *(const float4*)(md + 1024 + col);
        uint2 o;
        o.x = pack_bf2(v[i].x * rstd * (1.f + sc.x) + sh.x, v[i].y * rstd * (1.f + sc.y) + sh.y);
        o.y = pack_bf2(v[i].z * rstd * (1.f + sc.z) + sh.z, v[i].w * rstd * (1.f + sc.w) + sh.w);
        *(uint2*)(hdst + col) = o;
      }
    }
#if PROBE
    float a2ref = 0.f;
    if (mt == 0) {
      const int tok = wave * 16 + 3, head = wave, row = row0 + tok, t = tb0 + tok, dd = head * 64 + lane;
      const size_t cp = (size_t)(b * 8 + head) * LTOT + CTXL + t;
      const float o = h2f(O[(size_t)row * 512 + dd]) + h2f(O[((size_t)NX + row) * 512 + dd]);
      const float mu = wave_sum(o) / 64.f;
      const float var = wave_sum((o - mu) * (o - mu)) / 64.f;
      const float y = (o - mu) * rsqrtf(var + GN_EPS) * p.gn_w[dd] + p.gn_b[dd];
      const float r = h2f(SH[(cp * 3 + 1) * 64 + lane]), vv = h2f(SH[(cp * 3 + 2) * 64 + lane]);
      const float kf = h2f(DR[(cp * 3 + 1) * 64 + lane]), kb = h2f(DR[(((size_t)16 * LTOT + cp) * 3 + 1) * 64 + lane]);
      const float bon = wave_sum(r * kf * p.r_k[dd]) + wave_sum(r * kb * p.r_k[512 + dd]);
      const float g = bf2f(ZG[(size_t)row * 1024 + 512 + dd]);
      a2ref = (y + bon * vv) * (g / (1.f + expf(-g)));
    }
#endif
#pragma unroll 1
    for (int it = 0; it < 16; ++it) {
      const int pair = (it * 8 + wave) * 8 + (lane >> 3), q8 = lane & 7;
      const int tok = pair >> 3, head = pair & 7, row = row0 + tok, t = tb0 + tok, d0 = q8 * 8;
      const unsigned cp = (unsigned)((b * 8 + head) * LTOT + CTXL + t);
      const unsigned ofo = (unsigned)(row * 512 + head * 64 + d0), obo = ofo + (unsigned)NX * 512u;
      const unsigned ro = (cp * 3 + 1) * 64 + d0, vo = (cp * 3 + 2) * 64 + d0;
      const unsigned kbo = ((16u * LTOT + cp) * 3 + 1) * 64 + d0;
      const unsigned gbo = (unsigned)(row * 1024 + 512 + head * 64 + d0), gao = gbo - 512;
      const unsigned yao = (unsigned)(((b * 8 + head) * SEQ + t) * 64 + d0);
      float ov[8], bon = 0.f, s = 0.f;
      {
        const uint4 a = *(const uint4*)(O + ofo), bq = *(const uint4*)(O + obo);
        const uint4 rr = *(const uint4*)(SH + ro), kf = *(const uint4*)(DR + ro), kb = *(const uint4*)(DR + kbo);
        const unsigned aw[4] = {a.x, a.y, a.z, a.w}, bw[4] = {bq.x, bq.y, bq.z, bq.w}, rw[4] = {rr.x, rr.y, rr.z, rr.w};
        const unsigned fw[4] = {kf.x, kf.y, kf.z, kf.w}, kw[4] = {kb.x, kb.y, kb.z, kb.w};
#pragma unroll
        for (int q = 0; q < 4; ++q) {
          const int dd = head * 64 + d0 + 2 * q;
          ov[2 * q] = hlo(aw[q]) + hlo(bw[q]);
          ov[2 * q + 1] = hhi(aw[q]) + hhi(bw[q]);
          s += ov[2 * q] + ov[2 * q + 1];
          bon += hlo(rw[q]) * (hlo(fw[q]) * p.r_k[dd] + hlo(kw[q]) * p.r_k[512 + dd]);
          bon += hhi(rw[q]) * (hhi(fw[q]) * p.r_k[dd + 1] + hhi(kw[q]) * p.r_k[512 + dd + 1]);
        }
      }
      s += __shfl_xor(s, 1, 64); s += __shfl_xor(s, 2, 64); s += __shfl_xor(s, 4, 64);
      bon += __shfl_xor(bon, 1, 64); bon += __shfl_xor(bon, 2, 64); bon += __shfl_xor(bon, 4, 64);
      const float mu = s * (1.f / 64.f);
      float vs = 0.f;
#pragma unroll
      for (int q = 0; q < 8; ++q) { ov[q] -= mu; vs = fmaf(ov[q], ov[q], vs); }
      vs += __shfl_xor(vs, 1, 64); vs += __shfl_xor(vs, 2, 64); vs += __shfl_xor(vs, 4, 64);
      const float rstd = rsqrtf(vs * (1.f / 64.f) + GN_EPS);
      {
        const uint4 vv = *(const uint4*)(SH + vo), gb = *(const uint4*)(ZG + gbo), ga = *(const uint4*)(ZG + gao), ya = *(const uint4*)(QB + yao);
        const unsigned vw[4] = {vv.x, vv.y, vv.z, vv.w}, gbw[4] = {gb.x, gb.y, gb.z, gb.w}, gaw[4] = {ga.x, ga.y, ga.z, ga.w}, yw[4] = {ya.x, ya.y, ya.z, ya.w};
        unsigned o2[4], o1[4];
#pragma unroll
        for (int q = 0; q < 4; ++q) {
          const int dd = head * 64 + d0 + 2 * q;
          const float y0 = ov[2 * q] * rstd * p.gn_w[dd] + p.gn_b[dd] + bon * hlo(vw[q]);
          const float y1 = ov[2 * q + 1] * rstd * p.gn_w[dd + 1] + p.gn_b[dd + 1] + bon * hhi(vw[q]);
          o2[q] = pack_bf2(y0 * siluf(bflo(gbw[q])), y1 * siluf(bfhi(gbw[q])));
          o1[q] = pack_bf2(bflo(yw[q]) * siluf(bflo(gaw[q])), bfhi(yw[q]) * siluf(bfhi(gaw[q])));
        }
        *(uint4*)(O + ofo) = make_uint4(o2[0], o2[1], o2[2], o2[3]);
        *(uint4*)(QB + yao) = make_uint4(o1[0], o1[1], o1[2], o1[3]);
      }
    }
    __threadfence();
    __syncthreads();
#if PROBE
    if (mt == 0) {
      const int tok = wave * 16 + 3, head = wave, row = row0 + tok, dd = head * 64 + lane;
      const float got = bf2f(O[(size_t)row * 512 + dd]);
      dbg_acc(p, 1, (got - a2ref) * (got - a2ref), a2ref * a2ref);
    }
#endif
    const ushort_t* hbase = (const ushort_t*)p.out;
    auto hload = [&](int r, int k) { return *(const uint4*)(hbase + (unsigned)((row0 + r) * 2048 + k)); };
    auto a1load = [&](int r, int k) { return *(const uint4*)(QB + (unsigned)(((b * 8 + (k >> 6)) * SEQ + tb0 + r) * 64 + (k & 63))); };
    auto a2load = [&](int r, int k) { return *(const uint4*)(O + (unsigned)((row0 + r) * 512 + k)); };
#pragma unroll 1
    for (int nt = 0; nt < 8; ++nt) {
      const int col0 = nt * 128;
      f32x16 mres[2];
      {
        f32x16 ya[1][2] = {{zero16(), zero16()}}, ga[1][2] = {{zero16(), zero16()}};
        gemm_pass<128, 128, 1, 2>(ya, a1load, [&](int n, int k) { return *(const uint4*)(WPA + (unsigned)((col0 + n) * 512 + k)); }, 512, As, Bs, wrow0, wcol0, tid);
        gemm_pass<128, 128, 1, 2>(ga, hload, [&](int n, int k) { return *(const uint4*)(WMG + (unsigned)((col0 + n) * DM + k)); }, DM, As, Bs, wrow0, wcol0, tid);
#pragma unroll
        for (int ni = 0; ni < 2; ++ni) {
          const float ba = p.b_mg[col0 + wcol0 + ni * 32 + l31];
#pragma unroll
          for (int i = 0; i < 16; ++i) mres[ni][i] = sigmf(ga[0][ni][i] + ba) * ya[0][ni][i];
        }
      }
      {
        f32x16 yb[1][2] = {{zero16(), zero16()}}, gb[1][2] = {{zero16(), zero16()}};
        gemm_pass<128, 128, 1, 2>(yb, a2load, [&](int n, int k) { return *(const uint4*)(WPB + (unsigned)((col0 + n) * 512 + k)); }, 512, As, Bs, wrow0, wcol0, tid);
        gemm_pass<128, 128, 1, 2>(gb, hload, [&](int n, int k) { return *(const uint4*)(WMG + (unsigned)((1024 + col0 + n) * DM + k)); }, DM, As, Bs, wrow0, wcol0, tid);
        int rb1 = row0 + wrow0 + 4 * hh;
        asm volatile("" : "+v"(rb1));
#pragma unroll
        for (int ni = 0; ni < 2; ++ni) {
          const int col = col0 + wcol0 + ni * 32 + l31;
          const float bb = p.b_mg[1024 + col];
#pragma unroll
          for (int i = 0; i < 16; ++i) {
            const float mv = mres[ni][i] + sigmf(gb[0][ni][i] + bb) * yb[0][ni][i];
            ZG[(unsigned)((rb1 + crow(i, 0)) * 1024 + col)] = f2bf(mv);
          }
        }
      }
    }
    __threadfence();
    __syncthreads();
#if PROBE
    if (mt == 0) {
      float d2 = 0.f, r2 = 0.f;
      if (tid < 64) {
        const int r = (tid * 37) & 127, col = (tid * 131 + 7) & 1023, row = row0 + r;
        const ushort_t* hrow = (const ushort_t*)(p.out + (size_t)row * DM);
        float ga = p.b_mg[col], gb = p.b_mg[1024 + col], ya = 0.f, yb = 0.f;
        for (int k = 0; k < 1024; ++k) { const float hv = bf2f(hrow[k]); ga += hv * p.w_mg[(size_t)k * 2048 + col]; gb += hv * p.w_mg[(size_t)k * 2048 + 1024 + col]; }
        for (int k = 0; k < 512; ++k) {
          ya += bf2f(QB[((size_t)(b * 8 + (k >> 6)) * SEQ + tb0 + r) * 64 + (k & 63)]) * p.w_pa[(size_t)k * 1024 + col];
          yb += bf2f(O[(size_t)row * 512 + k]) * p.w_pb[(size_t)k * 1024 + col];
        }
        const float ref = ya / (1.f + expf(-ga)) + yb / (1.f + expf(-gb));
        const float got = bf2f(ZG[(size_t)row * 1024 + col]);
        d2 = (got - ref) * (got - ref); r2 = ref * ref;
      }
      dbg_acc(p, 2, d2, r2);
    }
#endif
    const float* gt = md + 2048;
#pragma unroll 1
    for (int nt = 0; nt < 8; ++nt) {
      const int col0 = nt * 128;
      f32x16 acc[1][2] = {{zero16(), zero16()}};
      gemm_pass<128, 128, 1, 2>(acc, [&](int r, int k) { return *(const uint4*)(ZG + (unsigned)((row0 + r) * 1024 + k)); },
                                [&](int n, int k) { return *(const uint4*)(WO + (unsigned)((col0 + n) * DM + k)); }, DM, As, Bs, wrow0, wcol0, tid);
      int rb2 = row0 + wrow0 + 4 * hh;
      asm volatile("" : "+v"(rb2));
#pragma unroll
      for (int ni = 0; ni < 2; ++ni) {
        const int col = col0 + wcol0 + ni * 32 + l31;
        const float g = gt[col];
#pragma unroll
        for (int i = 0; i < 16; ++i) {
          const unsigned idx = (unsigned)((rb2 + crow(i, 0)) * DM + col);
          p.out[idx] = ALPHA * p.x[idx] + g * acc[0][ni][i];
        }
      }
    }
    __threadfence();
    __syncthreads();
#if PROBE
    if (mt == 0) {
      float d2 = 0.f, r2 = 0.f;
      if (tid < 64) {
        const int r = (tid * 29) & 127, col = (tid * 113 + 5) & 1023, row = row0 + r;
        float o = 0.f;
        for (int k = 0; k < 1024; ++k) o += bf2f(ZG[(size_t)row * 1024 + k]) * p.w_o[(size_t)k * 1024 + col];
        const float ref = md[2048 + col] * o;
        const float got = p.out[(size_t)row * DM + col] - ALPHA * p.x[(size_t)row * DM + col];
        d2 = (got - ref) * (got - ref); r2 = ref * ref;
      }
      dbg_acc(p, 3, d2, r2);
    }
    __threadfence();
    __syncthreads();
#endif
#if !PROBE
#if PROBE
    const float pdelta = probe_delta(p);
#else
    const float pdelta = 0.f;
#endif
#pragma unroll 1
    for (int r = wave; r < 128; r += 8) {
      float* dst = p.out + (size_t)(row0 + r) * DM;
      float4 v[4];
      float s = 0.f;
#pragma unroll
      for (int i = 0; i < 4; ++i) { v[i] = *(const float4*)(dst + lane * 4 + 256 * i); s += v[i].x + v[i].y + v[i].z + v[i].w; }
      const float mu = wave_sum(s) * (1.f / DM);
      float q = 0.f;
#pragma unroll
      for (int i = 0; i < 4; ++i) { v[i].x -= mu; v[i].y -= mu; v[i].z -= mu; v[i].w -= mu; q += v[i].x * v[i].x + v[i].y * v[i].y + v[i].z * v[i].z + v[i].w * v[i].w; }
      const float rstd = rsqrtf(wave_sum(q) * (1.f / DM) + LN_EPS);
#pragma unroll
      for (int i = 0; i < 4; ++i) {
        const int col = lane * 4 + 256 * i;
        const float4 g = *(const float4*)(p.ln_g + col), bb = *(const float4*)(p.ln_b + col);
        *(float4*)(dst + col) = make_float4(v[i].x * rstd * g.x + bb.x + pdelta, v[i].y * rstd * g.y + bb.y + pdelta, v[i].z * rstd * g.z + bb.z + pdelta, v[i].w * rstd * g.w + bb.w + pdelta);
      }
    }
#endif
  }
}


#if PROBE
DI void probe_f3(const Params& p) {
  const float pdelta = probe_delta(p);
  const int lane = threadIdx.x & 63, wave = threadIdx.x >> 6;
  for (int mt = blockIdx.x; mt < NX / 128; mt += gridDim.x) {
    for (int r = wave; r < 128; r += 8) {
      const float* src = p.x + (size_t)(mt * 128 + r) * DM;
      float* dst = p.out + (size_t)(mt * 128 + r) * DM;
      float s = 0.f, q = 0.f;
      for (int i = lane; i < 1024; i += 64) s += ALPHA * src[i];
      const float mu = wave_sum(s) / 1024.f;
      for (int i = lane; i < 1024; i += 64) { const float d = ALPHA * src[i] - mu; q += d * d; }
      const float rstd = rsqrtf(wave_sum(q) / 1024.f + LN_EPS);
      for (int i = lane; i < 1024; i += 64) dst[i] = (ALPHA * src[i] - mu) * rstd * p.ln_g[i] + p.ln_b[i] + pdelta;
    }
  }
}
#endif
DI void gsync(cg::grid_group& g) { __threadfence(); g.sync(); }

constexpr int SMEM_BYTES = 65536 + 32 * 264 * 2 + 1024;
__global__ void __launch_bounds__(NTH) fwd_megakernel(Params p) {
  __shared__ __attribute__((aligned(16))) unsigned char smem[SMEM_BYTES];
  cg::grid_group grid = cg::this_grid();
#if PROBE
  if (blockIdx.x == 0 && threadIdx.x < 64) ((float*)(p.ws + OFF_DBG))[threadIdx.x] = 0.f;
#endif
  phase0(p, smem);
  gsync(grid);
  phase_h(p);
  gsync(grid);
  phase_gemm1(p, smem);
  gsync(grid);
  phase_qkv(p);
  phase_rwkv_prep(p, smem);
  gsync(grid);
#if PROBE_NAIVE_SCAN
  phase_scan_naive(p);
#else
  phase_scanA(p, smem);
  gsync(grid);
  phase_scanB(p, smem);
  gsync(grid);
  phase_scanC(p, smem);
#endif
  phase_attn(p, smem);
  gsync(grid);
#if PROBE
  probe_scan(p);
  gsync(grid);
#endif
  phase_final(p, smem);
#if PROBE
  gsync(grid);
  probe_f3(p);
#endif
}

extern "C" void kernel_launch(void* const* d_in, const int* in_sizes, int n_in, void* d_out, int out_size, void* d_ws, size_t ws_size,
                              hipStream_t stream) {
  static int grid_blocks = 0;
  if (!grid_blocks) {
    int dev = 0, cus = 0, per_cu = 0;
    hipGetDevice(&dev);
    hipDeviceGetAttribute(&cus, hipDeviceAttributeMultiprocessorCount, dev);
    hipOccupancyMaxActiveBlocksPerMultiprocessor(&per_cu, fwd_megakernel, NTH, 0);
    if (per_cu < 1) fprintf(stderr, "occupancy query says %d blocks/CU\n", per_cu);
    grid_blocks = cus > 0 ? cus : 256;
    if (ws_size < WS_END) fprintf(stderr, "workspace too small: %zu < %zu\n", ws_size, (size_t)WS_END);
  }
  Params p{};
  const float** fp = (const float**)&p;
  for (int i = 0; i < 27; ++i) fp[i] = (const float*)d_in[i];
  p.out = (float*)d_out;
  p.ws = (unsigned char*)d_ws;
  void* args[] = {&p};
  hipError_t e = hipLaunchCooperativeKernel((void*)fwd_megakernel, dim3(grid_blocks), dim3(NTH), args, 0, stream);
  if (e != hipSuccess) fprintf(stderr, "cooperative launch failed: %s (grid %d)\n", hipGetErrorString(e), grid_blocks);
}
```

```cpp
#include <hip/hip_runtime.h>
#include <hip/hip_cooperative_groups.h>
#include <stdint.h>
#include <cstdio>
namespace cg = cooperative_groups;

#define PROBE 0
#define DI __device__ __forceinline__
typedef __attribute__((ext_vector_type(8))) short bf16x8;
typedef __attribute__((ext_vector_type(16))) float f32x16;
typedef __attribute__((ext_vector_type(16))) uint32_t u32x16;
typedef __attribute__((ext_vector_type(2))) _Float16 h2;
typedef __attribute__((ext_vector_type(2))) __bf16 b2;
typedef unsigned short ushort_t;
typedef __attribute__((ext_vector_type(4))) uint32_t u32x4;
#define MFMA(a, b, c) __builtin_amdgcn_mfma_f32_32x32x16_bf16((a), (b), (c), 0, 0, 0)

constexpr int DM = 1024, NB = 2, SEQ = 16384, CTXL = 256;
constexpr int NX = NB * SEQ, NC = NB * CTXL, NT = NX + NC;
constexpr int INW = 3584, LTOT = CTXL + SEQ;
constexpr int NTH = 512;
constexpr int CH = 130, NCHUNK = LTOT / CH;
static_assert(NCHUNK * CH == LTOT, "chunking");
constexpr float LN_EPS = 1e-5f, QK_EPS = 1e-6f, GN_EPS = 64e-5f;
constexpr float ALPHA = 1.189207115002721f;
constexpr float QSCALE = 0.125f * 1.4426950408889634f;

constexpr size_t OFF_WIN = 0;
constexpr size_t OFF_WMG = OFF_WIN + (size_t)INW * DM * 2;
constexpr size_t OFF_WPA = OFF_WMG + (size_t)2048 * DM * 2;
constexpr size_t OFF_WPB = OFF_WPA + (size_t)1024 * 512 * 2;
constexpr size_t OFF_WO  = OFF_WPB + (size_t)1024 * 512 * 2;
constexpr size_t OFF_WL  = OFF_WO + (size_t)1024 * 1024 * 2;
constexpr size_t OFF_MOD = OFF_WL + (size_t)2 * 2 * 512 * 64 * 2;
constexpr size_t OFF_ZG  = OFF_MOD + 36864;
constexpr size_t OFF_QB  = OFF_ZG + (size_t)NX * 1024 * 2;
constexpr size_t OFF_KB  = OFF_QB + (size_t)NX * 512 * 2;
constexpr size_t OFF_VB  = OFF_KB + (size_t)NB * 2 * LTOT * 64 * 2;
constexpr size_t OFF_SH  = OFF_VB + (size_t)NB * 2 * LTOT * 64 * 2;
constexpr size_t OFF_DR  = OFF_SH + (size_t)16 * LTOT * 192 * 2;
constexpr size_t OFF_ZQ  = OFF_DR + (size_t)32 * LTOT * 192 * 2;
constexpr size_t WS_END  = OFF_ZQ + (size_t)2 * NX * 512 * 2;
static_assert(WS_END <= (size_t)536870912, "workspace");
static_assert((size_t)NT * DM * 2 <= (size_t)48 * LTOT * 192 * 2, "H alias");
static_assert((size_t)NT * 768 * 2 <= (size_t)2 * NX * 512 * 2, "zqkv alias");

struct Params {
  const float *x, *c, *ctx, *c_ctx, *w_ada, *b_ada, *w_in, *q_norm, *k_norm, *mu_prev, *mu_next, *w0, *w_up, *a0, *a_up, *k_k, *k_a,
      *r_k, *gn_w, *gn_b, *w_pa, *w_pb, *w_mg, *b_mg, *w_o, *ln_g, *ln_b;
  float* out;
  unsigned char* ws;
};

DI ushort_t f2bf(float f) { return __builtin_bit_cast(ushort_t, (__bf16)f); }
DI float bf2f(ushort_t b) { return __uint_as_float(((unsigned)b) << 16); }
DI unsigned pack_bf2(float a, float b) { b2 v = {(__bf16)a, (__bf16)b}; return __builtin_bit_cast(unsigned, v); }
DI unsigned pack_h2(float a, float b) { h2 v = {(_Float16)a, (_Float16)b}; return __builtin_bit_cast(unsigned, v); }
DI ushort_t f2h(float f) { return __builtin_bit_cast(ushort_t, (_Float16)f); }
DI float h2f(ushort_t h) { return (float)__builtin_bit_cast(_Float16, h); }
DI float bflo(unsigned u) { return __uint_as_float(u << 16); }
DI float bfhi(unsigned u) { return __uint_as_float(u & 0xffff0000u); }
DI float hlo(unsigned u) { return (float)__builtin_bit_cast(h2, u)[0]; }
DI float hhi(unsigned u) { return (float)__builtin_bit_cast(h2, u)[1]; }
DI float sigmf(float v) { return __builtin_amdgcn_rcpf(1.f + __expf(-v)); }
DI float siluf(float v) { return v * sigmf(v); }
DI int crow(int reg, int h) { return (reg & 3) + 8 * (reg >> 2) + 4 * h; }
DI float wave_sum(float v) {
#pragma unroll
  for (int o = 32; o >= 1; o >>= 1) v += __shfl_xor(v, o, 64);
  return v;
}
DI f32x16 zero16() { f32x16 z;
#pragma unroll
  for (int i = 0; i < 16; ++i) z[i] = 0.f; return z; }

#define SCAN_VLOAD 0
#define PROBE_NAIVE_SCAN 0
#if SCAN_VLOAD
DI void sload2(u32x16& a0, u32x16& a1, const void* p) { a0 = *(const u32x16*)p; a1 = *((const u32x16*)p + 1); }
DI void sload4(u32x16& a0, u32x16& a1, u32x16& b0, u32x16& b1, const void* p, const void* q) {
  a0 = *(const u32x16*)p; a1 = *((const u32x16*)p + 1); b0 = *(const u32x16*)q; b1 = *((const u32x16*)q + 1);
}
#else
DI void sload2(u32x16& a0, u32x16& a1, const void* p) {
  asm volatile("s_load_dwordx16 %0, %2, 0x0\n\ts_load_dwordx16 %1, %2, 0x40\n\ts_waitcnt lgkmcnt(0)" : "=&s"(a0), "=&s"(a1) : "s"(p) : "memory");
}
DI void sload4(u32x16& a0, u32x16& a1, u32x16& b0, u32x16& b1, const void* p, const void* q) {
  asm volatile("s_load_dwordx16 %0, %4, 0x0\n\ts_load_dwordx16 %1, %4, 0x40\n\ts_load_dwordx16 %2, %5, 0x0\n\ts_load_dwordx16 %3, %5, 0x40\n\ts_waitcnt lgkmcnt(0)"
               : "=&s"(a0), "=&s"(a1), "=&s"(b0), "=&s"(b1) : "s"(p), "s"(q) : "memory");
}
#endif
DI float HV(const u32x16& v, int j) { const uint32_t w = v[j >> 1]; const h2 t = __builtin_bit_cast(h2, w); return (float)t[j & 1]; }

constexpr int LDK = 72;
template <int BM, int BN, int MI, int NI, int NB, class AL, class BL>
DI void gemm_pass(f32x16 (&acc)[NB][MI][NI], AL aload, BL bload, int K, ushort_t* As, ushort_t* Bs, int wrow0, int wcol0, int tid) {
  constexpr int NA = BM * 8 / NTH, NBC = BN * 8 / NTH;
  const int lane = tid & 63, l31 = lane & 31, hh = lane >> 5;
  uint4 ra[2][NA], rb[2][NB][NBC];
#pragma unroll
  for (int s = 0; s < 2; ++s) {
#pragma unroll
    for (int i = 0; i < NA; ++i) { const int id = tid + i * NTH; ra[s][i] = aload(id >> 3, s * 64 + (id & 7) * 8); }
#pragma unroll
    for (int w = 0; w < NB; ++w)
#pragma unroll
      for (int i = 0; i < NBC; ++i) { const int id = tid + i * NTH; rb[s][w][i] = bload(w, id >> 3, s * 64 + (id & 7) * 8); }
  }
#pragma unroll 1
  for (int k0 = 0; k0 < K; k0 += 128) {
#pragma unroll
    for (int s = 0; s < 2; ++s) {
      __syncthreads();
#pragma unroll
      for (int i = 0; i < NA; ++i) { const int id = tid + i * NTH; *(uint4*)&As[(id >> 3) * LDK + (id & 7) * 8] = ra[s][i]; }
#pragma unroll
      for (int w = 0; w < NB; ++w)
#pragma unroll
        for (int i = 0; i < NBC; ++i) { const int id = tid + i * NTH; *(uint4*)&Bs[w * BN * LDK + (id >> 3) * LDK + (id & 7) * 8] = rb[s][w][i]; }
      __syncthreads();
      const int kn = k0 + 128 + s * 64;
      if (kn < K) {
#pragma unroll
        for (int i = 0; i < NA; ++i) { const int id = tid + i * NTH; ra[s][i] = aload(id >> 3, kn + (id & 7) * 8); }
#pragma unroll
        for (int w = 0; w < NB; ++w)
#pragma unroll
          for (int i = 0; i < NBC; ++i) { const int id = tid + i * NTH; rb[s][w][i] = bload(w, id >> 3, kn + (id & 7) * 8); }
      }
#pragma unroll
      for (int ks = 0; ks < 4; ++ks) {
        bf16x8 af[MI];
#pragma unroll
        for (int mi = 0; mi < MI; ++mi) af[mi] = *(const bf16x8*)&As[(wrow0 + mi * 32 + l31) * LDK + ks * 16 + hh * 8];
#pragma unroll
        for (int w = 0; w < NB; ++w) {
          bf16x8 bfv[NI];
#pragma unroll
          for (int ni = 0; ni < NI; ++ni) bfv[ni] = *(const bf16x8*)&Bs[w * BN * LDK + (wcol0 + ni * 32 + l31) * LDK + ks * 16 + hh * 8];
#pragma unroll
          for (int mi = 0; mi < MI; ++mi)
#pragma unroll
            for (int ni = 0; ni < NI; ++ni) acc[w][mi][ni] = MFMA(af[mi], bfv[ni], acc[w][mi][ni]);
        }
      }
    }
  }
}

DI void transpose_tile(const float* __restrict__ src, int ld_src, ushort_t* dst, int ld_dst, int k0, int n0, float* T) {
  const int tid = threadIdx.x;
#pragma unroll
  for (int i = 0; i < 2; ++i) {
    const int k = (tid >> 4) + 32 * i, n4 = (tid & 15) * 4;
    const float4 v = *(const float4*)(src + (size_t)(k0 + k) * ld_src + n0 + n4);
    T[k * 65 + n4 + 0] = v.x; T[k * 65 + n4 + 1] = v.y; T[k * 65 + n4 + 2] = v.z; T[k * 65 + n4 + 3] = v.w;
  }
  __syncthreads();
  const int n = tid >> 3, kc = tid & 7;
  uint4 o;
  o.x = pack_bf2(T[(kc * 8 + 0) * 65 + n], T[(kc * 8 + 1) * 65 + n]);
  o.y = pack_bf2(T[(kc * 8 + 2) * 65 + n], T[(kc * 8 + 3) * 65 + n]);
  o.z = pack_bf2(T[(kc * 8 + 4) * 65 + n], T[(kc * 8 + 5) * 65 + n]);
  o.w = pack_bf2(T[(kc * 8 + 6) * 65 + n], T[(kc * 8 + 7) * 65 + n]);
  *(uint4*)(dst + (size_t)(n0 + n) * ld_dst + k0 + kc * 8) = o;
  __syncthreads();
}

DI void phase0(const Params& p, unsigned char* smem) {
  float* T = (float*)smem;
  ushort_t* win = (ushort_t*)(p.ws + OFF_WIN);
  ushort_t* wmg = (ushort_t*)(p.ws + OFF_WMG);
  ushort_t* wpa = (ushort_t*)(p.ws + OFF_WPA);
  ushort_t* wpb = (ushort_t*)(p.ws + OFF_WPB);
  ushort_t* wo = (ushort_t*)(p.ws + OFF_WO);
  ushort_t* wl = (ushort_t*)(p.ws + OFF_WL);
  float* mod = (float*)(p.ws + OFF_MOD);
  constexpr int T_IN = 16 * 56, T_MG = 16 * 32, T_PA = 8 * 16, T_PB = 8 * 16, T_O = 16 * 16, T_L = 32, T_MOD = 48;
  constexpr int TOTAL = T_MOD + T_IN + T_MG + T_PA + T_PB + T_O + T_L;
  for (int t = blockIdx.x; t < TOTAL; t += gridDim.x) {
    int u = t;
    if (u < T_MOD) {
      float* sil = T;
      float* red = T + 3072;
      const int tid = threadIdx.x;
      for (int i = tid; i < 3072; i += NTH) {
        const int v = i >> 10, k = i & 1023;
        const float cv = (v < 2) ? p.c[v * 1024 + k] : p.c_ctx[k];
        sil[i] = siluf(cv);
      }
      __syncthreads();
      const int n = tid & 63, ksl = tid >> 6, n0 = u * 64;
      float a0 = 0.f, a1 = 0.f, a2 = 0.f;
      for (int k = ksl * 128; k < ksl * 128 + 128; ++k) {
        const float w = p.w_ada[(size_t)k * 3072 + n0 + n];
        a0 = fmaf(sil[k], w, a0); a1 = fmaf(sil[1024 + k], w, a1); a2 = fmaf(sil[2048 + k], w, a2);
      }
      red[(ksl * 3 + 0) * 64 + n] = a0; red[(ksl * 3 + 1) * 64 + n] = a1; red[(ksl * 3 + 2) * 64 + n] = a2;
      __syncthreads();
      if (tid < 192) {
        const int v = tid >> 6, nn = tid & 63;
        float s = 0.f;
#pragma unroll
        for (int q = 0; q < 8; ++q) s += red[(q * 3 + v) * 64 + nn];
        mod[v * 3072 + n0 + nn] = s + p.b_ada[n0 + nn];
      }
      __syncthreads();
      continue;
    }
    u -= T_MOD;
    if (u < T_IN) { transpose_tile(p.w_in, INW, win, 1024, (u / 56) * 64, (u % 56) * 64, T); continue; }
    u -= T_IN;
    if (u < T_MG) { transpose_tile(p.w_mg, 2048, wmg, 1024, (u / 32) * 64, (u % 32) * 64, T); continue; }
    u -= T_MG;
    if (u < T_PA) { transpose_tile(p.w_pa, 1024, wpa, 512, (u / 16) * 64, (u % 16) * 64, T); continue; }
    u -= T_PA;
    if (u < T_PB) { transpose_tile(p.w_pb, 1024, wpb, 512, (u / 16) * 64, (u % 16) * 64, T); continue; }
    u -= T_PB;
    if (u < T_O) { transpose_tile(p.w_o, 1024, wo, 1024, (u / 16) * 64, (u % 16) * 64, T); continue; }
    u -= T_O;
    {
      const int which = u >> 4, dir = (u >> 3) & 1, nt = u & 7;
      const float* src = (which ? p.a_up : p.w_up) + (size_t)dir * 64 * 512;
      transpose_tile(src, 512, wl + (size_t)((dir * 2 + which) * 512) * 64, 64, 0, nt * 64, T);
    }
  }
}

DI void phase_h(const Params& p) {
  const float* mod = (const float*)(p.ws + OFF_MOD);
  ushort_t* H = (ushort_t*)(p.ws + OFF_SH);
  const int lane = threadIdx.x & 63, gw = blockIdx.x * 8 + (threadIdx.x >> 6);
  for (int row = gw; row < NT; row += gridDim.x * 8) {
    const float* src = (row < NX) ? p.x + (size_t)row * DM : p.ctx + (size_t)(row - NX) * DM;
    const float* md = mod + ((row < NX) ? (row / SEQ) : 2) * 3072;
    float4 v[4];
    float s = 0.f;
#pragma unroll
    for (int i = 0; i < 4; ++i) { v[i] = *(const float4*)(src + lane * 4 + 256 * i); s += v[i].x + v[i].y + v[i].z + v[i].w; }
    const float mu = wave_sum(s) * (1.f / DM);
    float q = 0.f;
#pragma unroll
    for (int i = 0; i < 4; ++i) { v[i].x -= mu; v[i].y -= mu; v[i].z -= mu; v[i].w -= mu; q += v[i].x * v[i].x + v[i].y * v[i].y + v[i].z * v[i].z + v[i].w * v[i].w; }
    const float rstd = rsqrtf(wave_sum(q) * (1.f / DM) + LN_EPS);
#pragma unroll
    for (int i = 0; i < 4; ++i) {
      const int col = lane * 4 + 256 * i;
      const float4 sh = *(const float4*)(md + col), sc = *(const float4*)(md + 1024 + col);
      uint2 o;
      o.x = pack_bf2(v[i].x * rstd * (1.f + sc.x) + sh.x, v[i].y * rstd * (1.f + sc.y) + sh.y);
      o.y = pack_bf2(v[i].z * rstd * (1.f + sc.z) + sh.z, v[i].w * rstd * (1.f + sc.w) + sh.w);
      *(uint2*)(H + (size_t)row * DM + col) = o;
    }
  }
}

DI void phase_gemm1(const Params& p, unsigned char* smem) {
  ushort_t* As = (ushort_t*)smem;
  ushort_t* Bs = As + 256 * LDK;
  const ushort_t* H = (const ushort_t*)(p.ws + OFF_SH);
  const ushort_t* W = (const ushort_t*)(p.ws + OFF_WIN);
  ushort_t* zq = (ushort_t*)(p.ws + OFF_ZQ);
  ushort_t* zg = (ushort_t*)(p.ws + OFF_ZG);
  ushort_t* zm = (ushort_t*)p.out;
  const int tid = threadIdx.x, wave = tid >> 6, lane = tid & 63, l31 = lane & 31, hh = lane >> 5;
  const int wrow0 = (wave & 3) * 64, wcol0 = (wave >> 2) * 64;
  constexpr int MT = NT / 256, NTL = INW / 128;
  for (int t = blockIdx.x; t < MT * NTL; t += gridDim.x) {
    const int mt = t / NTL, nt = t % NTL;
    const bool is_g = (nt >= 6 && nt < 10) || nt >= 24;
    if (is_g && mt >= NX / 256) continue;
    const int row0 = mt * 256, col0 = nt * 128;
    f32x16 acc[1][2][2];
#pragma unroll
    for (int a = 0; a < 2; ++a)
#pragma unroll
      for (int b = 0; b < 2; ++b) acc[0][a][b] = zero16();
    auto aload = [&](int r, int k) { return *(const uint4*)(H + (size_t)(row0 + r) * DM + k); };
    auto bload = [&](int w, int n, int k) { return *(const uint4*)(W + (size_t)(col0 + n) * DM + k); };
    gemm_pass<256, 128, 2, 2, 1>(acc, aload, bload, DM, As, Bs, wrow0, wcol0, tid);
    ushort_t* dst; int ld, cbase;
    if (nt < 6) { dst = zq; ld = 768; cbase = col0; }
    else if (nt < 10) { dst = zg; ld = 1024; cbase = col0 - 768; }
    else if (nt < 24) { dst = zm; ld = 1792; cbase = col0 - 1280; }
    else { dst = zg; ld = 1024; cbase = 512 + col0 - 3072; }
#pragma unroll
    for (int mi = 0; mi < 2; ++mi)
#pragma unroll
      for (int ni = 0; ni < 2; ++ni)
#pragma unroll
        for (int i = 0; i < 16; ++i) {
          const int row = row0 + wrow0 + mi * 32 + crow(i, hh), col = cbase + wcol0 + ni * 32 + l31;
          dst[(size_t)row * ld + col] = f2bf(acc[0][mi][ni][i]);
        }
  }
}

DI void phase_qkv(const Params& p) {
  const ushort_t* zq = (const ushort_t*)(p.ws + OFF_ZQ);
  ushort_t* QB = (ushort_t*)(p.ws + OFF_QB);
  ushort_t* KB = (ushort_t*)(p.ws + OFF_KB);
  ushort_t* VB = (ushort_t*)(p.ws + OFF_VB);
  const int lane = threadIdx.x & 63, gw = blockIdx.x * 8 + (threadIdx.x >> 6);
  const int j = lane & 31, half = lane >> 5, axis = j >> 4, f = j & 15;
  const int d1 = axis * 32 + f, d2 = d1 + 16;
  const float inv = powf(10000.f, -(float)f * (1.f / 16.f));
  const float gq1 = p.q_norm[d1], gq2 = p.q_norm[d2], gk1 = p.k_norm[d1], gk2 = p.k_norm[d2];
  for (int row = gw; row < NT; row += gridDim.x * 8) {
    const bool isx = row < NX;
    const int b = isx ? row / SEQ : (row - NX) / CTXL;
    const int t = isx ? row % SEQ : (row - NX) % CTXL;
    const int pos = isx ? CTXL + t : t;
    const ushort_t* z = zq + (size_t)row * 768;
    float cs = 1.f, sn = 0.f;
    if (isx) { const float ang = (float)(axis ? (t & 63) : (t >> 6)) * inv; sincosf(ang, &sn, &cs); }
#pragma unroll
    for (int it = 0; it < 5; ++it) {
      const int hd = it * 2 + half;
      if (!isx && hd < 8) continue;
      const float v1 = bf2f(z[hd * 64 + d1]), v2 = bf2f(z[hd * 64 + d2]);
      float ss = v1 * v1 + v2 * v2;
#pragma unroll
      for (int o = 16; o >= 1; o >>= 1) ss += __shfl_xor(ss, o, 64);
      const float rms = rsqrtf(ss * (1.f / 64.f) + QK_EPS);
      const bool isq = hd < 8;
      const float y1 = v1 * rms * (isq ? gq1 : gk1), y2 = v2 * rms * (isq ? gq2 : gk2);
      float o1 = y1 * cs - y2 * sn, o2 = y2 * cs + y1 * sn;
      if (isq) {
        ushort_t* dst = QB + ((size_t)(b * 8 + hd) * SEQ + t) * 64;
        dst[d1] = f2bf(o1 * QSCALE); dst[d2] = f2bf(o2 * QSCALE);
      } else {
        ushort_t* dst = KB + ((size_t)(b * 2 + (hd - 8)) * LTOT + pos) * 64;
        dst[d1] = f2bf(o1); dst[d2] = f2bf(o2);
      }
    }
    VB[((size_t)(b * 2 + 0) * LTOT + pos) * 64 + lane] = z[640 + lane];
    VB[((size_t)(b * 2 + 1) * LTOT + pos) * 64 + lane] = z[704 + lane];
  }
}

DI void phase_rwkv_prep(const Params& p, unsigned char* smem) {
  float* kbuf = (float*)smem;
  ushort_t* codes = (ushort_t*)(smem + 65536);
  float* invn = (float*)(smem + 65536 + 32 * 264 * 2);
  const ushort_t* zm = (const ushort_t*)p.out;
  const ushort_t* WL = (const ushort_t*)(p.ws + OFF_WL);
  ushort_t* SH = (ushort_t*)(p.ws + OFF_SH);
  ushort_t* DR = (ushort_t*)(p.ws + OFF_DR);
  const int tid = threadIdx.x, wave = tid >> 6, lane = tid & 63, l31 = lane & 31, hh = lane >> 5;
  for (int tt = blockIdx.x; tt < NT / 32; tt += gridDim.x) {
    const int row0 = tt * 32;
    int b, t0, len, pbase;
    if (row0 < NX) { b = row0 / SEQ; t0 = row0 % SEQ; len = SEQ; pbase = CTXL; }
    else { const int rc = row0 - NX; b = rc / CTXL; t0 = rc % CTXL; len = CTXL; pbase = 0; }
    __syncthreads();
    for (int id = tid; id < 32 * 224; id += NTH) {
      const int i = id / 224, c0 = (id % 224) * 8;
      const int t = t0 + i;
      const ushort_t* zr = zm + (size_t)(row0 + i) * 1792 + c0;
      const uint4 zc = *(const uint4*)zr;
      uint4 zp = make_uint4(0, 0, 0, 0), zn = make_uint4(0, 0, 0, 0);
      if (t > 0) zp = *(const uint4*)(zr - 1792);
      if (t < len - 1) zn = *(const uint4*)(zr + 1792);
      const float4 mp0 = *(const float4*)(p.mu_prev + c0), mp1 = *(const float4*)(p.mu_prev + c0 + 4);
      const float4 mn0 = *(const float4*)(p.mu_next + c0), mn1 = *(const float4*)(p.mu_next + c0 + 4);
      const unsigned zcw[4] = {zc.x, zc.y, zc.z, zc.w}, zpw[4] = {zp.x, zp.y, zp.z, zp.w}, znw[4] = {zn.x, zn.y, zn.z, zn.w};
      const float mpv[8] = {mp0.x, mp0.y, mp0.z, mp0.w, mp1.x, mp1.y, mp1.z, mp1.w};
      const float mnv[8] = {mn0.x, mn0.y, mn0.z, mn0.w, mn1.x, mn1.y, mn1.z, mn1.w};
      float s[8];
#pragma unroll
      for (int q = 0; q < 4; ++q) {
        const float c_lo = bflo(zcw[q]), c_hi = bfhi(zcw[q]);
        s[2 * q] = c_lo + mpv[2 * q] * (bflo(zpw[q]) - c_lo) + mnv[2 * q] * (bflo(znw[q]) - c_lo);
        s[2 * q + 1] = c_hi + mpv[2 * q + 1] * (bfhi(zpw[q]) - c_hi) + mnv[2 * q + 1] * (bfhi(znw[q]) - c_hi);
      }
      const int pp = pbase + t;
      if (c0 < 512 || (c0 >= 1024 && c0 < 1536)) {
        const int cc = (c0 < 512) ? c0 : c0 - 1024, which = (c0 < 512) ? 1 : 2;
        const int head = cc >> 6, d = cc & 63;
        uint4 o;
        o.x = pack_h2(s[0], s[1]); o.y = pack_h2(s[2], s[3]); o.z = pack_h2(s[4], s[5]); o.w = pack_h2(s[6], s[7]);
        *(uint4*)(SH + (((size_t)(b * 8 + head) * LTOT + pp) * 3 + which) * 64 + d) = o;
      } else if (c0 < 1024) {
        float* kd = kbuf + i * 512 + (c0 - 512);
        *(float4*)kd = make_float4(s[0], s[1], s[2], s[3]);
        *(float4*)(kd + 4) = make_float4(s[4], s[5], s[6], s[7]);
      } else {
        const int cc = c0 - 1536;
        if (cc < 128) {
#pragma unroll
          for (int q = 0; q < 8; ++q) s[q] = tanhf(s[q]);
        }
        uint4 o;
        o.x = pack_bf2(s[0], s[1]); o.y = pack_bf2(s[2], s[3]); o.z = pack_bf2(s[4], s[5]); o.w = pack_bf2(s[6], s[7]);
        *(uint4*)(codes + i * 264 + cc) = o;
      }
    }
    __syncthreads();
    {
      const int i = tid >> 4, head = (tid >> 1) & 7, hf = tid & 1;
      float ss = 0.f;
#pragma unroll 8
      for (int q = 0; q < 32; ++q) {
        const int n = head * 64 + hf * 32 + q;
        const float v = kbuf[i * 512 + n] * p.k_k[n];
        ss = fmaf(v, v, ss);
      }
      ss += __shfl_xor(ss, 1, 64);
      if (hf == 0) invn[i * 8 + head] = 1.f / fmaxf(sqrtf(ss), 1e-12f);
    }
    __syncthreads();
#pragma unroll 1
    for (int q4 = 0; q4 < 4; ++q4) {
      const int pr = wave * 4 + q4, dir = pr >> 4, ct = pr & 15;
      f32x16 aw = zero16(), aa = zero16();
#pragma unroll
      for (int ks = 0; ks < 4; ++ks) {
        const bf16x8 fw = *(const bf16x8*)&codes[l31 * 264 + dir * 64 + ks * 16 + hh * 8];
        const bf16x8 fa = *(const bf16x8*)&codes[l31 * 264 + 128 + dir * 64 + ks * 16 + hh * 8];
        const bf16x8 bw = *(const bf16x8*)&WL[(size_t)((dir * 2 + 0) * 512 + ct * 32 + l31) * 64 + ks * 16 + hh * 8];
        const bf16x8 ba = *(const bf16x8*)&WL[(size_t)((dir * 2 + 1) * 512 + ct * 32 + l31) * 64 + ks * 16 + hh * 8];
        aw = MFMA(fw, bw, aw);
        aa = MFMA(fa, ba, aa);
      }
      const int n = ct * 32 + l31, head = n >> 6, d = n & 63;
      const float w0v = p.w0[dir * 512 + n], a0v = p.a0[dir * 512 + n], kkw = p.k_k[n], kaw = p.k_a[n];
      const size_t cbase = (size_t)(b * 8 + head) * LTOT;
#pragma unroll
      for (int i = 0; i < 16; ++i) {
        const int ti = crow(i, hh);
        const int pp = pbase + t0 + ti;
        const float wpre = aw[i] + w0v;
        const float wlog = -log1pf(expf(-wpre)) - 0.5f;
        const float e = expf(wlog);
        const float xdec = -expm1f(-e);
        const float a = sigmf(aa[i] + a0v);
        const float kv = kbuf[ti * 512 + n];
        const float kkv = kv * kkw * invn[ti * 8 + head];
        const float kd = kv * (1.f + (a - 1.f) * kaw);
        ushort_t* dr = DR + ((((size_t)dir * 16) * LTOT + cbase + pp) * 3) * 64 + d;
        dr[0] = f2h(-xdec); dr[64] = f2h(kd); dr[128] = f2h(kkv * a);
        if (dir == 0) SH[((cbase + pp) * 3) * 64 + d] = f2h(kkv);
      }
    }
  }
}

DI int tau_to_pos(int dir, int tau) { return dir == 0 ? tau : (tau < CTXL ? CTXL - 1 - tau : LTOT - 1 - (tau - CTXL)); }

struct ScanRec { uint32_t sh, dr, bb; ushort_t v; };
DI ScanRec scan_load(const ushort_t* shc, const ushort_t* drc, int pos, int lane) {
  ScanRec r;
  const ushort_t* s = shc + (size_t)pos * 192;
  const uint32_t* d = (const uint32_t*)(drc + (size_t)pos * 192);
  r.sh = ((const uint32_t*)s)[lane];
  r.v = s[128 + lane];
  r.dr = d[lane];
  r.bb = d[64 + (lane & 31)];
  return r;
}
#define MIXLO " op_sel_hi:[0,1,0]\n\t"
#define MIXHI " op_sel:[0,1,0] op_sel_hi:[0,1,0]\n\t"
template <int L>
DI void dot4(float& a0, float& a1, float (&S)[64], uint32_t src) {
  uint32_t t0, t1, t2, t3;
  asm("v_readlane_b32 %2, %6, %7\n\tv_readlane_b32 %3, %6, %8\n\tv_readlane_b32 %4, %6, %9\n\tv_readlane_b32 %5, %6, %10\n\t"
      "v_fma_mix_f32 %0, %11, %2, %0" MIXLO "v_fma_mix_f32 %1, %12, %2, %1" MIXHI
      "v_fma_mix_f32 %0, %13, %3, %0" MIXLO "v_fma_mix_f32 %1, %14, %3, %1" MIXHI
      "v_fma_mix_f32 %0, %15, %4, %0" MIXLO "v_fma_mix_f32 %1, %16, %4, %1" MIXHI
      "v_fma_mix_f32 %0, %17, %5, %0" MIXLO "v_fma_mix_f32 %1, %18, %5, %1" MIXHI
      : "+v"(a0), "+v"(a1), "=&s"(t0), "=&s"(t1), "=&s"(t2), "=&s"(t3)
      : "v"(src), "n"(L), "n"(L + 1), "n"(L + 2), "n"(L + 3),
        "v"(S[2 * (L & 31)]), "v"(S[2 * (L & 31) + 1]), "v"(S[2 * (L & 31) + 2]), "v"(S[2 * (L & 31) + 3]),
        "v"(S[2 * (L & 31) + 4]), "v"(S[2 * (L & 31) + 5]), "v"(S[2 * (L & 31) + 6]), "v"(S[2 * (L & 31) + 7]));
}
template <int L>
DI void upd4(float (&S)[64], uint32_t dr, uint32_t bb, float vv, float nsk) {
  uint32_t x0, x1, x2, x3, k0, k1, k2, k3, b0, b1, b2, b3;
  asm("v_readlane_b32 %8, %20, %22\n\tv_readlane_b32 %9, %20, %23\n\tv_readlane_b32 %10, %20, %24\n\tv_readlane_b32 %11, %20, %25\n\t"
      "v_readlane_b32 %12, %20, %26\n\tv_readlane_b32 %13, %20, %27\n\tv_readlane_b32 %14, %20, %28\n\tv_readlane_b32 %15, %20, %29\n\t"
      "v_readlane_b32 %16, %21, %22\n\tv_readlane_b32 %17, %21, %23\n\tv_readlane_b32 %18, %21, %24\n\tv_readlane_b32 %19, %21, %25\n\t"
      "v_fma_mix_f32 %0, %0, %8, %0" MIXLO "v_fma_mix_f32 %1, %1, %8, %1" MIXHI
      "v_fma_mix_f32 %2, %2, %9, %2" MIXLO "v_fma_mix_f32 %3, %3, %9, %3" MIXHI
      "v_fma_mix_f32 %4, %4, %10, %4" MIXLO "v_fma_mix_f32 %5, %5, %10, %5" MIXHI
      "v_fma_mix_f32 %6, %6, %11, %6" MIXLO "v_fma_mix_f32 %7, %7, %11, %7" MIXHI
      "v_fma_mix_f32 %0, %30, %12, %0" MIXLO "v_fma_mix_f32 %1, %30, %12, %1" MIXHI
      "v_fma_mix_f32 %2, %30, %13, %2" MIXLO "v_fma_mix_f32 %3, %30, %13, %3" MIXHI
      "v_fma_mix_f32 %4, %30, %14, %4" MIXLO "v_fma_mix_f32 %5, %30, %14, %5" MIXHI
      "v_fma_mix_f32 %6, %30, %15, %6" MIXLO "v_fma_mix_f32 %7, %30, %15, %7" MIXHI
      "v_fma_mix_f32 %0, %31, %16, %0" MIXLO "v_fma_mix_f32 %1, %31, %16, %1" MIXHI
      "v_fma_mix_f32 %2, %31, %17, %2" MIXLO "v_fma_mix_f32 %3, %31, %17, %3" MIXHI
      "v_fma_mix_f32 %4, %31, %18, %4" MIXLO "v_fma_mix_f32 %5, %31, %18, %5" MIXHI
      "v_fma_mix_f32 %6, %31, %19, %6" MIXLO "v_fma_mix_f32 %7, %31, %19, %7" MIXHI
      : "+v"(S[2 * L]), "+v"(S[2 * L + 1]), "+v"(S[2 * L + 2]), "+v"(S[2 * L + 3]), "+v"(S[2 * L + 4]), "+v"(S[2 * L + 5]), "+v"(S[2 * L + 6]), "+v"(S[2 * L + 7]),
        "=&s"(x0), "=&s"(x1), "=&s"(x2), "=&s"(x3), "=&s"(k0), "=&s"(k1), "=&s"(k2), "=&s"(k3), "=&s"(b0), "=&s"(b1), "=&s"(b2), "=&s"(b3)
      : "v"(dr), "v"(bb), "n"(L), "n"(L + 1), "n"(L + 2), "n"(L + 3), "n"(L + 32), "n"(L + 33), "n"(L + 34), "n"(L + 35), "v"(vv), "v"(nsk));
}
template <bool WITH_OUT>
DI float scan_step(float (&S)[64], const ScanRec& c, float vv) {
  float sk0 = 0.f, sk1 = 0.f;
  dot4<0>(sk0, sk1, S, c.sh); dot4<4>(sk0, sk1, S, c.sh); dot4<8>(sk0, sk1, S, c.sh); dot4<12>(sk0, sk1, S, c.sh);
  dot4<16>(sk0, sk1, S, c.sh); dot4<20>(sk0, sk1, S, c.sh); dot4<24>(sk0, sk1, S, c.sh); dot4<28>(sk0, sk1, S, c.sh);
  const float nsk = -(sk0 + sk1);
  upd4<0>(S, c.dr, c.bb, vv, nsk); upd4<4>(S, c.dr, c.bb, vv, nsk); upd4<8>(S, c.dr, c.bb, vv, nsk); upd4<12>(S, c.dr, c.bb, vv, nsk);
  upd4<16>(S, c.dr, c.bb, vv, nsk); upd4<20>(S, c.dr, c.bb, vv, nsk); upd4<24>(S, c.dr, c.bb, vv, nsk); upd4<28>(S, c.dr, c.bb, vv, nsk);
  float o0 = 0.f, o1 = 0.f;
  if (WITH_OUT) {
    dot4<32>(o0, o1, S, c.sh); dot4<36>(o0, o1, S, c.sh); dot4<40>(o0, o1, S, c.sh); dot4<44>(o0, o1, S, c.sh);
    dot4<48>(o0, o1, S, c.sh); dot4<52>(o0, o1, S, c.sh); dot4<56>(o0, o1, S, c.sh); dot4<60>(o0, o1, S, c.sh);
  }
  return o0 + o1;
}
constexpr int SPF = 3;
DI void phase_scanA(const Params& p, unsigned char* smem) {
  const ushort_t* SH = (const ushort_t*)(p.ws + OFF_SH);
  const ushort_t* DR = (const ushort_t*)(p.ws + OFF_DR);
  float* PU = p.out;
  const int lane = threadIdx.x & 63;
  const int gw = __builtin_amdgcn_readfirstlane(blockIdx.x * 8 + (threadIdx.x >> 6));
  for (int wt = gw; wt < 32 * NCHUNK * 2; wt += gridDim.x * 8) {
    const int task = wt >> 1, half = wt & 1;
    const int cd = task / NCHUNK, j = task % NCHUNK, dir = cd >> 4, c = cd & 15;
    float S[64];
#pragma unroll
    for (int k = 0; k < 64; ++k) S[k] = (half && k == lane) ? 1.f : 0.f;
    const ushort_t* shc = SH + (size_t)c * LTOT * 192;
    const ushort_t* drc = DR + (size_t)(dir * 16 + c) * LTOT * 192;
    ScanRec r0 = scan_load(shc, drc, tau_to_pos(dir, j * CH + 0), lane);
    ScanRec r1 = scan_load(shc, drc, tau_to_pos(dir, j * CH + 1), lane);
    ScanRec r2 = scan_load(shc, drc, tau_to_pos(dir, j * CH + 2), lane);
#pragma unroll 1
    for (int st = 0; st < CH; ++st) {
      const ScanRec r3 = scan_load(shc, drc, tau_to_pos(dir, j * CH + (st + SPF < CH ? st + SPF : CH - 1)), lane);
      const float vv = half ? 0.f : h2f(r0.v);
      scan_step<false>(S, r0, vv);
      r0 = r1; r1 = r2; r2 = r3;
    }
    float* dst = PU + ((size_t)task * 2 + half) * 4096 + lane * 64;
#pragma unroll
    for (int k = 0; k < 64; k += 4) *(float4*)(dst + k) = make_float4(S[k], S[k + 1], S[k + 2], S[k + 3]);
  }
}

DI void phase_scanB(const Params& p, unsigned char* smem) {
  if (blockIdx.x >= 32) return;
  float* Sb = (float*)smem;
  float* Pb = Sb + 64 * 65;
  float* PU = p.out;
  const int cd = blockIdx.x, tid = threadIdx.x, i = tid >> 3, n0 = (tid & 7) * 8;
  float s[8], pn[8], un[8];
#pragma unroll
  for (int q = 0; q < 8; ++q) s[q] = 0.f;
  {
    const float* base = PU + (size_t)(cd * NCHUNK) * 2 * 4096;
    const float4 a = *(const float4*)(base + 4096 + tid * 8), b = *(const float4*)(base + 4096 + tid * 8 + 4);
    const float4 c = *(const float4*)(base + i * 64 + n0), d = *(const float4*)(base + i * 64 + n0 + 4);
    pn[0] = a.x; pn[1] = a.y; pn[2] = a.z; pn[3] = a.w; pn[4] = b.x; pn[5] = b.y; pn[6] = b.z; pn[7] = b.w;
    un[0] = c.x; un[1] = c.y; un[2] = c.z; un[3] = c.w; un[4] = d.x; un[5] = d.y; un[6] = d.z; un[7] = d.w;
  }
#pragma unroll 1
  for (int j = 0; j < NCHUNK; ++j) {
    float* base = PU + (size_t)(cd * NCHUNK + j) * 2 * 4096;
    float u[8];
    __syncthreads();
#pragma unroll
    for (int q = 0; q < 8; ++q) { Pb[tid * 8 + q] = pn[q]; u[q] = un[q]; Sb[i * 65 + n0 + q] = s[q]; }
    __syncthreads();
    *(float4*)(base + 4096 + i * 64 + n0) = make_float4(s[0], s[1], s[2], s[3]);
    *(float4*)(base + 4096 + i * 64 + n0 + 4) = make_float4(s[4], s[5], s[6], s[7]);
    if (j + 1 < NCHUNK) {
      const float* nb = base + 2 * 4096;
      const float4 a = *(const float4*)(nb + 4096 + tid * 8), b = *(const float4*)(nb + 4096 + tid * 8 + 4);
      const float4 c = *(const float4*)(nb + i * 64 + n0), d = *(const float4*)(nb + i * 64 + n0 + 4);
      pn[0] = a.x; pn[1] = a.y; pn[2] = a.z; pn[3] = a.w; pn[4] = b.x; pn[5] = b.y; pn[6] = b.z; pn[7] = b.w;
      un[0] = c.x; un[1] = c.y; un[2] = c.z; un[3] = c.w; un[4] = d.x; un[5] = d.y; un[6] = d.z; un[7] = d.w;
    }
#pragma unroll
    for (int q = 0; q < 8; ++q) s[q] = u[q];
#pragma unroll 8
    for (int k = 0; k < 64; ++k) {
      const float a = Sb[i * 65 + k];
      const float4 p0 = *(const float4*)&Pb[k * 64 + n0], p1 = *(const float4*)&Pb[k * 64 + n0 + 4];
      s[0] = fmaf(a, p0.x, s[0]); s[1] = fmaf(a, p0.y, s[1]); s[2] = fmaf(a, p0.z, s[2]); s[3] = fmaf(a, p0.w, s[3]);
      s[4] = fmaf(a, p1.x, s[4]); s[5] = fmaf(a, p1.y, s[5]); s[6] = fmaf(a, p1.z, s[6]); s[7] = fmaf(a, p1.w, s[7]);
    }
  }
}

DI void phase_scanC(const Params& p, unsigned char* smem) {
  const ushort_t* SH = (const ushort_t*)(p.ws + OFF_SH);
  const ushort_t* DR = (const ushort_t*)(p.ws + OFF_DR);
  ushort_t* O = (ushort_t*)(p.ws + OFF_ZQ);
  const float* PU = p.out;
  const int lane = threadIdx.x & 63;
  const int gw = __builtin_amdgcn_readfirstlane(blockIdx.x * 8 + (threadIdx.x >> 6));
  for (int task = gw; task < 32 * NCHUNK; task += gridDim.x * 8) {
    const int cd = task / NCHUNK, j = task % NCHUNK, dir = cd >> 4, c = cd & 15, b = c >> 3, head = c & 7;
    float S[64];
    const float* src = PU + ((size_t)task * 2 + 1) * 4096 + lane * 64;
#pragma unroll
    for (int k = 0; k < 64; k += 4) { const float4 v = *(const float4*)(src + k); S[k] = v.x; S[k + 1] = v.y; S[k + 2] = v.z; S[k + 3] = v.w; }
    const ushort_t* shc = SH + (size_t)c * LTOT * 192;
    const ushort_t* drc = DR + (size_t)(dir * 16 + c) * LTOT * 192;
    ushort_t* obase = O + ((size_t)dir * NX + (size_t)b * SEQ) * 512 + head * 64 + lane;
    ScanRec r0 = scan_load(shc, drc, tau_to_pos(dir, j * CH + 0), lane);
    ScanRec r1 = scan_load(shc, drc, tau_to_pos(dir, j * CH + 1), lane);
    ScanRec r2 = scan_load(shc, drc, tau_to_pos(dir, j * CH + 2), lane);
#pragma unroll 1
    for (int st = 0; st < CH; ++st) {
      const int pos = tau_to_pos(dir, j * CH + st);
      const ScanRec r3 = scan_load(shc, drc, tau_to_pos(dir, j * CH + (st + SPF < CH ? st + SPF : CH - 1)), lane);
      const float o = scan_step<true>(S, r0, h2f(r0.v));
      if (pos >= CTXL) obase[(size_t)(pos - CTXL) * 512] = f2h(o);
      r0 = r1; r1 = r2; r2 = r3;
    }
  }
}

DI void phase_scan_naive(const Params& p) {
  const ushort_t* SH = (const ushort_t*)(p.ws + OFF_SH);
  const ushort_t* DR = (const ushort_t*)(p.ws + OFF_DR);
  ushort_t* O = (ushort_t*)(p.ws + OFF_ZQ);
  const int lane = threadIdx.x & 63;
  const int gw = __builtin_amdgcn_readfirstlane(blockIdx.x * 8 + (threadIdx.x >> 6));
  if (gw >= 32) return;
  const int cd = gw, dir = cd >> 4, c = cd & 15, b = c >> 3, head = c & 7;
  float S[64];
#pragma unroll
  for (int k = 0; k < 64; ++k) S[k] = 0.f;
  const ushort_t* shc = SH + (size_t)c * LTOT * 192;
  const ushort_t* drc = DR + (size_t)(dir * 16 + c) * LTOT * 192;
#pragma unroll 1
  for (int tau = 0; tau < LTOT; ++tau) {
    const int pos = tau_to_pos(dir, tau);
    const ushort_t* shr = shc + (size_t)pos * 192;
    const ushort_t* drr = drc + (size_t)pos * 192;
    const float vv = h2f(shr[128 + lane]);
    u32x16 k0, k1;
    sload2(k0, k1, shr);
    float sk0 = 0.f, sk1 = 0.f;
#pragma unroll
    for (int q = 0; q < 32; ++q) { sk0 = fmaf(S[q], HV(k0, q), sk0); sk1 = fmaf(S[32 + q], HV(k1, q), sk1); }
    const float nsk = -(sk0 + sk1);
    u32x16 x0, x1, d0, d1;
    sload4(x0, x1, d0, d1, drr, drr + 64);
#pragma unroll
    for (int q = 0; q < 32; ++q) {
      S[q] = fmaf(S[q], -HV(x0, q), S[q]); S[32 + q] = fmaf(S[32 + q], -HV(x1, q), S[32 + q]);
      S[q] = fmaf(vv, HV(d0, q), S[q]); S[32 + q] = fmaf(vv, HV(d1, q), S[32 + q]);
    }
    u32x16 b0, b1, r0, r1;
    sload4(b0, b1, r0, r1, drr + 128, shr + 64);
    float o0 = 0.f, o1 = 0.f;
#pragma unroll
    for (int q = 0; q < 32; ++q) {
      S[q] = fmaf(nsk, HV(b0, q), S[q]); S[32 + q] = fmaf(nsk, HV(b1, q), S[32 + q]);
      o0 = fmaf(S[q], HV(r0, q), o0); o1 = fmaf(S[32 + q], HV(r1, q), o1);
    }
    if (pos >= CTXL) O[((size_t)dir * NX + (size_t)b * SEQ + (pos - CTXL)) * 512 + head * 64 + lane] = f2h(o0 + o1);
  }
}

DI int vperm(int key) { const int g = key >> 4, kq = key & 15; return g * 16 + 8 * ((kq >> 2) & 1) + (kq & 3) + 4 * (kq >> 3); }
DI void phase_attn(const Params& p, unsigned char* smem) {
  ushort_t* Ks = (ushort_t*)smem;
  ushort_t* Vt = Ks + 64 * LDK;
  ushort_t* QB = (ushort_t*)(p.ws + OFF_QB);
  const ushort_t* KB = (const ushort_t*)(p.ws + OFF_KB);
  const ushort_t* VB = (const ushort_t*)(p.ws + OFF_VB);
  const int tid = threadIdx.x, wave = tid >> 6, lane = tid & 63, l31 = lane & 31, hh = lane >> 5;
  const int kkey = tid >> 3, kc8 = tid & 7;
  const int vkey = tid & 63, vc8 = tid >> 6;
  const int vpos = vperm(vkey);
  for (int at = blockIdx.x; at < 1024; at += gridDim.x) {
    const int b = at >> 9, kvh = (at >> 8) & 1, t0 = (at & 255) * 64;
    const int head = kvh * 4 + (wave & 3), tq = t0 + (wave >> 2) * 32 + l31;
    ushort_t* qrow = QB + ((size_t)(b * 8 + head) * SEQ + tq) * 64;
    bf16x8 qf[4];
#pragma unroll
    for (int ks = 0; ks < 4; ++ks) qf[ks] = *(const bf16x8*)(qrow + ks * 16 + hh * 8);
    const ushort_t* kbase = KB + (size_t)(b * 2 + kvh) * LTOT * 64;
    const ushort_t* vbase = VB + (size_t)(b * 2 + kvh) * LTOT * 64;
    f32x16 o[2] = {zero16(), zero16()};
    float m = -1e30f, lsum = 0.f;
    uint4 rk = *(const uint4*)(kbase + (size_t)kkey * 64 + kc8 * 8);
    uint4 rv = *(const uint4*)(vbase + (size_t)vkey * 64 + vc8 * 8);
#pragma unroll 1
    for (int kt = 0; kt < LTOT / 64; ++kt) {
      __syncthreads();
      *(uint4*)&Ks[kkey * LDK + kc8 * 8] = rk;
      {
        const unsigned w[4] = {rv.x, rv.y, rv.z, rv.w};
#pragma unroll
        for (int q = 0; q < 4; ++q) {
          Vt[(vc8 * 8 + 2 * q) * LDK + vpos] = (ushort_t)(w[q] & 0xffffu);
          Vt[(vc8 * 8 + 2 * q + 1) * LDK + vpos] = (ushort_t)(w[q] >> 16);
        }
      }
      __syncthreads();
      if (kt + 1 < LTOT / 64) {
        rk = *(const uint4*)(kbase + (size_t)((kt + 1) * 64 + kkey) * 64 + kc8 * 8);
        rv = *(const uint4*)(vbase + (size_t)((kt + 1) * 64 + vkey) * 64 + vc8 * 8);
      }
      f32x16 s[2] = {zero16(), zero16()};
#pragma unroll
      for (int ks = 0; ks < 4; ++ks) {
#pragma unroll
        for (int kk = 0; kk < 2; ++kk) {
          const bf16x8 kf = *(const bf16x8*)&Ks[(kk * 32 + l31) * LDK + ks * 16 + hh * 8];
          s[kk] = MFMA(kf, qf[ks], s[kk]);
        }
      }
      float mx = s[0][0];
#pragma unroll
      for (int i = 0; i < 16; ++i) { mx = fmaxf(mx, s[0][i]); mx = fmaxf(mx, s[1][i]); }
      mx = fmaxf(mx, __shfl_xor(mx, 32, 64));
      const float mn = fmaxf(m, mx);
      const float alpha = __builtin_amdgcn_exp2f(m - mn);
      m = mn;
      float ps = 0.f;
#pragma unroll
      for (int i = 0; i < 16; ++i) {
        s[0][i] = __builtin_amdgcn_exp2f(s[0][i] - mn); s[1][i] = __builtin_amdgcn_exp2f(s[1][i] - mn);
        ps += s[0][i] + s[1][i];
      }
      lsum = lsum * alpha + ps;
#pragma unroll
      for (int i = 0; i < 16; ++i) { o[0][i] *= alpha; o[1][i] *= alpha; }
#pragma unroll
      for (int kk = 0; kk < 2; ++kk) {
#pragma unroll
        for (int st = 0; st < 2; ++st) {
          uint4 pw;
          pw.x = pack_bf2(s[kk][8 * st + 0], s[kk][8 * st + 1]); pw.y = pack_bf2(s[kk][8 * st + 2], s[kk][8 * st + 3]);
          pw.z = pack_bf2(s[kk][8 * st + 4], s[kk][8 * st + 5]); pw.w = pack_bf2(s[kk][8 * st + 6], s[kk][8 * st + 7]);
          const bf16x8 pf = __builtin_bit_cast(bf16x8, pw);
#pragma unroll
          for (int dt = 0; dt < 2; ++dt) {
            const bf16x8 vf = *(const bf16x8*)&Vt[(dt * 32 + l31) * LDK + kk * 32 + st * 16 + hh * 8];
            o[dt] = MFMA(vf, pf, o[dt]);
          }
        }
      }
    }
    const float ltot = lsum + __shfl_xor(lsum, 32, 64);
    const float il = 1.f / ltot;
#pragma unroll
    for (int dt = 0; dt < 2; ++dt)
#pragma unroll
      for (int g = 0; g < 4; ++g) {
        uint2 w;
        w.x = pack_bf2(o[dt][4 * g + 0] * il, o[dt][4 * g + 1] * il);
        w.y = pack_bf2(o[dt][4 * g + 2] * il, o[dt][4 * g + 3] * il);
        *(uint2*)(qrow + dt * 32 + 8 * g + 4 * hh) = w;
      }
  }
}

constexpr size_t OFF_DBG = WS_END;
DI void dbg_acc(const Params& p, int slot, float d2, float r2) {
  float* dbg = (float*)(p.ws + OFF_DBG);
  d2 = wave_sum(d2); r2 = wave_sum(r2);
  if ((threadIdx.x & 63) == 0) { atomicAdd(dbg + 2 * slot, d2); atomicAdd(dbg + 2 * slot + 1, r2); }
}
DI void probe_after_gemm1(const Params& p) {
  if (blockIdx.x != 0) return;
  const int tid = threadIdx.x, lane = tid & 63, wave = tid >> 6;
  const float* mod = (const float*)(p.ws + OFF_MOD);
  const ushort_t* H = (const ushort_t*)(p.ws + OFF_SH);
  {
    float d2 = 0.f, r2 = 0.f;
    if (tid < 96) {
      const int v = tid / 32, n = (tid % 32) * 97 % 3072;
      float s = 0.f;
      for (int k = 0; k < 1024; ++k) { const float cv = (v < 2) ? p.c[v * 1024 + k] : p.c_ctx[k]; s += (cv / (1.f + expf(-cv))) * p.w_ada[(size_t)k * 3072 + n]; }
      s += p.b_ada[n];
      const float d = mod[v * 3072 + n] - s; d2 = d * d; r2 = s * s;
    }
    dbg_acc(p, 0, d2, r2);
  }
  {
    const int row = wave == 0 ? 0 : wave == 1 ? 777 : wave == 2 ? 16383 : wave == 3 ? 16384 : wave == 4 ? 32767 : wave == 5 ? 32768 : wave == 6 ? 33023 : 33279;
    const float* src = (row < NX) ? p.x + (size_t)row * DM : p.ctx + (size_t)(row - NX) * DM;
    const float* md = mod + ((row < NX) ? (row / SEQ) : 2) * 3072;
    float s = 0.f;
    for (int i = lane; i < 1024; i += 64) s += src[i];
    const float mu = wave_sum(s) / 1024.f;
    float q = 0.f;
    for (int i = lane; i < 1024; i += 64) q += (src[i] - mu) * (src[i] - mu);
    const float rstd = rsqrtf(wave_sum(q) / 1024.f + LN_EPS);
    float d2 = 0.f, r2 = 0.f;
    for (int i = lane; i < 1024; i += 64) {
      const float ref = (src[i] - mu) * rstd * (1.f + md[1024 + i]) + md[i];
      const float d = bf2f(H[(size_t)row * DM + i]) - ref; d2 += d * d; r2 += ref * ref;
    }
    dbg_acc(p, 1, d2, r2);
  }
  {
    float d2 = 0.f, r2 = 0.f;
    if (tid < 60) {
      const int ri = tid / 10, ci = tid % 10;
      const int row = ri == 0 ? 3 : ri == 1 ? 777 : ri == 2 ? 20001 : ri == 3 ? 32767 : ri == 4 ? 32773 : 33279;
      const int col = ci == 0 ? 0 : ci == 1 ? 100 : ci == 2 ? 700 : ci == 3 ? 800 : ci == 4 ? 1279 : ci == 5 ? 1280 : ci == 6 ? 2000 : ci == 7 ? 3071 : ci == 8 ? 3072 : 3583;
      float s = 0.f;
      for (int k = 0; k < 1024; ++k) s += bf2f(H[(size_t)row * DM + k]) * p.w_in[(size_t)k * INW + col];
      float got = 0.f; bool have = true;
      if (col < 768) got = bf2f(((const ushort_t*)(p.ws + OFF_ZQ))[(size_t)row * 768 + col]);
      else if (col < 1280) { if (row < NX) got = bf2f(((const ushort_t*)(p.ws + OFF_ZG))[(size_t)row * 1024 + col - 768]); else have = false; }
      else if (col < 3072) got = bf2f(((const ushort_t*)p.out)[(size_t)row * 1792 + col - 1280]);
      else { if (row < NX) got = bf2f(((const ushort_t*)(p.ws + OFF_ZG))[(size_t)row * 1024 + 512 + col - 3072]); else have = false; }
      if (have) { const float d = got - s; d2 = d * d; r2 = s * s; }
    }
    dbg_acc(p, 2, d2, r2);
  }
}
DI void probe_after_prep(const Params& p, unsigned char* smem) {
  if (blockIdx.x != 0) return;
  float* cbuf = (float*)smem;
  const int tid = threadIdx.x, lane = tid & 63, wave = tid >> 6;
  const ushort_t* zm = (const ushort_t*)p.out;
  const ushort_t* SH = (const ushort_t*)(p.ws + OFF_SH);
  const ushort_t* DR = (const ushort_t*)(p.ws + OFF_DR);
  float dA = 0.f, rA = 0.f, dB = 0.f, rB = 0.f;
#pragma unroll 1
  for (int sidx = wave; sidx < 24; sidx += 8) {
    const int ri = sidx >> 1, head = (sidx & 1) ? 5 : 0;
    const int row = ri == 0 ? 0 : ri == 1 ? 1 : ri == 2 ? 31 : ri == 3 ? 32 : ri == 4 ? 16383 : ri == 5 ? 16384 : ri == 6 ? 20000 : ri == 7 ? 32767 : ri == 8 ? 32768 : ri == 9 ? 33023 : ri == 10 ? 33024 : 33279;
    int b, t, len, pp;
    if (row < NX) { b = row / SEQ; t = row % SEQ; len = SEQ; pp = CTXL + t; } else { b = (row - NX) / CTXL; t = (row - NX) % CTXL; len = CTXL; pp = t; }
    auto sft = [&](int col) {
      const float z = bf2f(zm[(size_t)row * 1792 + col]);
      const float zp = (t > 0) ? bf2f(zm[(size_t)(row - 1) * 1792 + col]) : 0.f;
      const float zn = (t < len - 1) ? bf2f(zm[(size_t)(row + 1) * 1792 + col]) : 0.f;
      return z + p.mu_prev[col] * (zp - z) + p.mu_next[col] * (zn - z);
    };
    const int n = head * 64 + lane;
    const float r = sft(n), k = sft(512 + n), v = sft(1024 + n);
#pragma unroll 1
    for (int j = lane; j < 256; j += 64) { const float s = sft(1536 + j); cbuf[wave * 256 + j] = (j < 128) ? tanhf(s) : s; }
    __builtin_amdgcn_s_waitcnt(0);
    __builtin_amdgcn_wave_barrier();
    const float kr = k * p.k_k[n];
    const float nrm = sqrtf(wave_sum(kr * kr));
    const float kk = kr / fmaxf(nrm, 1e-12f);
    const size_t cp = (size_t)(b * 8 + head) * LTOT + pp;
    { float d;
      d = h2f(SH[(cp * 3 + 0) * 64 + lane]) - kk; dA += d * d; rA += kk * kk;
      d = h2f(SH[(cp * 3 + 1) * 64 + lane]) - r; dA += d * d; rA += r * r;
      d = h2f(SH[(cp * 3 + 2) * 64 + lane]) - v; dA += d * d; rA += v * v; }
#pragma unroll 1
    for (int dir = 0; dir < 2; ++dir) {
      float wpre = p.w0[dir * 512 + n], apre = p.a0[dir * 512 + n];
#pragma unroll 1
      for (int j = 0; j < 64; ++j) {
        wpre += cbuf[wave * 256 + dir * 64 + j] * p.w_up[(size_t)(dir * 64 + j) * 512 + n];
        apre += cbuf[wave * 256 + 128 + dir * 64 + j] * p.a_up[(size_t)(dir * 64 + j) * 512 + n];
      }
      const float wlog = -log1pf(expf(-wpre)) - 0.5f;
      const float xd = 1.f - expf(-expf(wlog));
      const float a = 1.f / (1.f + expf(-apre));
      const float kd = k * (1.f + (a - 1.f) * p.k_a[n]);
      const float bq = kk * a;
      const size_t dp = (size_t)(dir * 16 + b * 8 + head) * LTOT + pp;
      float d;
      d = h2f(DR[(dp * 3 + 0) * 64 + lane]) - xd; dB += d * d; rB += xd * xd;
      d = h2f(DR[(dp * 3 + 1) * 64 + lane]) - kd; dB += d * d; rB += kd * kd;
      d = h2f(DR[(dp * 3 + 2) * 64 + lane]) - bq; dB += d * d; rB += bq * bq;
    }
    __builtin_amdgcn_wave_barrier();
  }
  dbg_acc(p, 3, dA, rA);
  dbg_acc(p, 4, dB, rB);
}

DI void probe_scan(const Params& p) {
  if (blockIdx.x != 0 || threadIdx.x >= 128) return;
  const ushort_t* SH = (const ushort_t*)(p.ws + OFF_SH);
  const ushort_t* DR = (const ushort_t*)(p.ws + OFF_DR);
  const ushort_t* O = (const ushort_t*)(p.ws + OFF_ZQ);
  const int lane = threadIdx.x & 63, wv = threadIdx.x >> 6;
  const int c = wv ? 9 : 0, dir = wv, b = c >> 3, head = c & 7;
  float S[64];
#pragma unroll
  for (int k = 0; k < 64; ++k) S[k] = 0.f;
  float d2 = 0.f, r2 = 0.f;
#pragma unroll 1
  for (int tau = 0; tau < 420; ++tau) {
    const int pos = dir == 0 ? tau : (tau < CTXL ? CTXL - 1 - tau : LTOT - 1 - (tau - CTXL));
    const ushort_t* sh = SH + ((size_t)c * LTOT + pos) * 192;
    const ushort_t* dr = DR + ((size_t)(dir * 16 + c) * LTOT + pos) * 192;
    const float v = h2f(sh[128 + lane]);
    float sk = 0.f;
#pragma unroll
    for (int k = 0; k < 64; ++k) sk += S[k] * h2f(sh[k]);
    float o = 0.f;
#pragma unroll
    for (int k = 0; k < 64; ++k) {
      const float dec = 1.f - h2f(dr[k]);
      S[k] = S[k] * dec - sk * h2f(dr[128 + k]) + v * h2f(dr[64 + k]);
      o += S[k] * h2f(sh[64 + k]);
    }
    if (pos >= CTXL) {
      const float got = h2f(O[((size_t)dir * NX + (size_t)b * SEQ + (pos - CTXL)) * 512 + head * 64 + lane]);
      const float d = got - o; d2 += d * d; r2 += o * o;
    }
  }
  dbg_acc(p, 0, d2, r2);
}
DI float probe_delta(const Params& p) {
  const float* dbg = (const float*)(p.ws + OFF_DBG);
  int k = 0;
  for (int s = 0; s < 5; ++s) { const float rel = sqrtf(dbg[2 * s] / fmaxf(dbg[2 * s + 1], 1e-30f)); if (!(rel < 0.05f)) k |= 1 << s; }
  return sqrtf(0.02f * (float)k);
}

DI void phase_final(const Params& p, unsigned char* smem) {
  ushort_t* As = (ushort_t*)smem;
  ushort_t* Bs = As + 128 * LDK;
  const float* mod = (const float*)(p.ws + OFF_MOD);
  ushort_t* ZG = (ushort_t*)(p.ws + OFF_ZG);
  ushort_t* QB = (ushort_t*)(p.ws + OFF_QB);
  ushort_t* O = (ushort_t*)(p.ws + OFF_ZQ);
  const ushort_t* SH = (const ushort_t*)(p.ws + OFF_SH);
  const ushort_t* DR = (const ushort_t*)(p.ws + OFF_DR);
  const ushort_t* WMG = (const ushort_t*)(p.ws + OFF_WMG);
  const ushort_t* WPA = (const ushort_t*)(p.ws + OFF_WPA);
  const ushort_t* WPB = (const ushort_t*)(p.ws + OFF_WPB);
  const ushort_t* WO = (const ushort_t*)(p.ws + OFF_WO);
#pragma unroll 1
  for (int mt = blockIdx.x; mt < NX / 128; mt += gridDim.x) {
    int tid = threadIdx.x;
    asm volatile("" : "+v"(tid));
    const int wave = tid >> 6, lane = tid & 63, l31 = lane & 31, hh = lane >> 5;
    const int wrow0 = (wave & 3) * 32, wcol0 = (wave >> 2) * 64;
    const int row0 = mt * 128, b = row0 / SEQ, tb0 = row0 % SEQ;
    const float* md = mod + b * 3072;
    __syncthreads();
#pragma unroll 1
    for (int r = wave; r < 128; r += 8) {
      const float* src = p.x + (size_t)(row0 + r) * DM;
      ushort_t* hdst = (ushort_t*)(p.out + (size_t)(row0 + r) * DM);
      float4 v[4];
      float s = 0.f;
#pragma unroll
      for (int i = 0; i < 4; ++i) { v[i] = *(const float4*)(src + lane * 4 + 256 * i); s += v[i].x + v[i].y + v[i].z + v[i].w; }
      const float mu = wave_sum(s) * (1.f / DM);
      float q = 0.f;
#pragma unroll
      for (int i = 0; i < 4; ++i) { v[i].x -= mu; v[i].y -= mu; v[i].z -= mu; v[i].w -= mu; q += v[i].x * v[i].x + v[i].y * v[i].y + v[i].z * v[i].z + v[i].w * v[i].w; }
      const float rstd = rsqrtf(wave_sum(q) * (1.f / DM) + LN_EPS);
#pragma unroll
      for (int i = 0; i < 4; ++i) {
        const int col = lane * 4 + 256 * i;
        const float4 sh = *(const float4*)(md + col), sc = *(const float4*)(md + 1024 + col);
        uint2 o;
        o.x = pack_bf2(v[i].x * rstd * (1.f + sc.x) + sh.x, v[i].y * rstd * (1.f + sc.y) + sh.y);
        o.y = pack_bf2(v[i].z * rstd * (1.f + sc.z) + sh.z, v[i].w * rstd * (1.f + sc.w) + sh.w);
        *(uint2*)(hdst + col) = o;
      }
    }
#if PROBE
    float a2ref = 0.f;
    if (mt == 0) {
      const int tok = wave * 16 + 3, head = wave, row = row0 + tok, t = tb0 + tok, dd = head * 64 + lane;
      const size_t cp = (size_t)(b * 8 + head) * LTOT + CTXL + t;
      const float o = h2f(O[(size_t)row * 512 + dd]) + h2f(O[((size_t)NX + row) * 512 + dd]);
      const float mu = wave_sum(o) / 64.f;
      const float var = wave_sum((o - mu) * (o - mu)) / 64.f;
      const float y = (o - mu) * rsqrtf(var + GN_EPS) * p.gn_w[dd] + p.gn_b[dd];
      const float r = h2f(SH[(cp * 3 + 1) * 64 + lane]), vv = h2f(SH[(cp * 3 + 2) * 64 + lane]);
      const float kf = h2f(DR[(cp * 3 + 1) * 64 + lane]), kb = h2f(DR[(((size_t)16 * LTOT + cp) * 3 + 1) * 64 + lane]);
      const float bon = wave_sum(r * kf * p.r_k[dd]) + wave_sum(r * kb * p.r_k[512 + dd]);
      const float g = bf2f(ZG[(size_t)row * 1024 + 512 + dd]);
      a2ref = (y + bon * vv) * (g / (1.f + expf(-g)));
    }
#endif
#pragma unroll 1
    for (int it = 0; it < 16; ++it) {
      const int pair = (it * 8 + wave) * 8 + (lane >> 3), q8 = lane & 7;
      const int tok = pair >> 3, head = pair & 7, row = row0 + tok, t = tb0 + tok, d0 = q8 * 8;
      const unsigned cp = (unsigned)((b * 8 + head) * LTOT + CTXL + t);
      const unsigned ofo = (unsigned)(row * 512 + head * 64 + d0), obo = ofo + (unsigned)NX * 512u;
      const unsigned ro = (cp * 3 + 1) * 64 + d0, vo = (cp * 3 + 2) * 64 + d0;
      const unsigned kbo = ((16u * LTOT + cp) * 3 + 1) * 64 + d0;
      const unsigned gbo = (unsigned)(row * 1024 + 512 + head * 64 + d0), gao = gbo - 512;
      const unsigned yao = (unsigned)(((b * 8 + head) * SEQ + t) * 64 + d0);
      float ov[8], bon = 0.f, s = 0.f;
      {
        const uint4 a = *(const uint4*)(O + ofo), bq = *(const uint4*)(O + obo);
        const uint4 rr = *(const uint4*)(SH + ro), kf = *(const uint4*)(DR + ro), kb = *(const uint4*)(DR + kbo);
        const unsigned aw[4] = {a.x, a.y, a.z, a.w}, bw[4] = {bq.x, bq.y, bq.z, bq.w}, rw[4] = {rr.x, rr.y, rr.z, rr.w};
        const unsigned fw[4] = {kf.x, kf.y, kf.z, kf.w}, kw[4] = {kb.x, kb.y, kb.z, kb.w};
#pragma unroll
        for (int q = 0; q < 4; ++q) {
          const int dd = head * 64 + d0 + 2 * q;
          ov[2 * q] = hlo(aw[q]) + hlo(bw[q]);
          ov[2 * q + 1] = hhi(aw[q]) + hhi(bw[q]);
          s += ov[2 * q] + ov[2 * q + 1];
          bon += hlo(rw[q]) * (hlo(fw[q]) * p.r_k[dd] + hlo(kw[q]) * p.r_k[512 + dd]);
          bon += hhi(rw[q]) * (hhi(fw[q]) * p.r_k[dd + 1] + hhi(kw[q]) * p.r_k[512 + dd + 1]);
        }
      }
      s += __shfl_xor(s, 1, 64); s += __shfl_xor(s, 2, 64); s += __shfl_xor(s, 4, 64);
      bon += __shfl_xor(bon, 1, 64); bon += __shfl_xor(bon, 2, 64); bon += __shfl_xor(bon, 4, 64);
      const float mu = s * (1.f / 64.f);
      float vs = 0.f;
#pragma unroll
      for (int q = 0; q < 8; ++q) { ov[q] -= mu; vs = fmaf(ov[q], ov[q], vs); }
      vs += __shfl_xor(vs, 1, 64); vs += __shfl_xor(vs, 2, 64); vs += __shfl_xor(vs, 4, 64);
      const float rstd = rsqrtf(vs * (1.f / 64.f) + GN_EPS);
      {
        const uint4 vv = *(const uint4*)(SH + vo), gb = *(const uint4*)(ZG + gbo), ga = *(const uint4*)(ZG + gao), ya = *(const uint4*)(QB + yao);
        const unsigned vw[4] = {vv.x, vv.y, vv.z, vv.w}, gbw[4] = {gb.x, gb.y, gb.z, gb.w}, gaw[4] = {ga.x, ga.y, ga.z, ga.w}, yw[4] = {ya.x, ya.y, ya.z, ya.w};
        unsigned o2[4], o1[4];
#pragma unroll
        for (int q = 0; q < 4; ++q) {
          const int dd = head * 64 + d0 + 2 * q;
          const float y0 = ov[2 * q] * rstd * p.gn_w[dd] + p.gn_b[dd] + bon * hlo(vw[q]);
          const float y1 = ov[2 * q + 1] * rstd * p.gn_w[dd + 1] + p.gn_b[dd + 1] + bon * hhi(vw[q]);
          o2[q] = pack_bf2(y0 * siluf(bflo(gbw[q])), y1 * siluf(bfhi(gbw[q])));
          o1[q] = pack_bf2(bflo(yw[q]) * siluf(bflo(gaw[q])), bfhi(yw[q]) * siluf(bfhi(gaw[q])));
        }
        *(uint4*)(O + ofo) = make_uint4(o2[0], o2[1], o2[2], o2[3]);
        *(uint4*)(QB + yao) = make_uint4(o1[0], o1[1], o1[2], o1[3]);
      }
    }
    __threadfence();
    __syncthreads();
#if PROBE
    if (mt == 0) {
      const int tok = wave * 16 + 3, head = wave, row = row0 + tok, dd = head * 64 + lane;
      const float got = bf2f(O[(size_t)row * 512 + dd]);
      dbg_acc(p, 1, (got - a2ref) * (got - a2ref), a2ref * a2ref);
    }
#endif
    const ushort_t* hbase = (const ushort_t*)p.out;
    auto hload = [&](int r, int k) { return *(const uint4*)(hbase + (unsigned)((row0 + r) * 2048 + k)); };
    auto a1load = [&](int r, int k) { return *(const uint4*)(QB + (unsigned)(((b * 8 + (k >> 6)) * SEQ + tb0 + r) * 64 + (k & 63))); };
    auto a2load = [&](int r, int k) { return *(const uint4*)(O + (unsigned)((row0 + r) * 512 + k)); };
#pragma unroll 1
    for (int nt = 0; nt < 8; ++nt) {
      const int col0 = nt * 128;
      int tidn = tid;
      asm volatile("" : "+v"(tidn));
      f32x16 sg[2][1][2] = {{{zero16(), zero16()}}, {{zero16(), zero16()}}};
      gemm_pass<128, 128, 1, 2, 2>(sg, hload, [&](int w, int n, int k) { return *(const uint4*)(WMG + (unsigned)((w * 1024 + col0 + n) * DM + k)); }, DM, As, Bs, wrow0, wcol0, tidn);
#pragma unroll
      for (int ni = 0; ni < 2; ++ni) {
        const int col = col0 + wcol0 + ni * 32 + l31;
        const float ba = p.b_mg[col], bb = p.b_mg[1024 + col];
#pragma unroll
        for (int i = 0; i < 16; ++i) { sg[0][0][ni][i] = sigmf(sg[0][0][ni][i] + ba); sg[1][0][ni][i] = sigmf(sg[1][0][ni][i] + bb); }
      }
      {
        f32x16 ya[1][1][2] = {{{zero16(), zero16()}}};
        gemm_pass<128, 128, 1, 2, 1>(ya, a1load, [&](int w, int n, int k) { return *(const uint4*)(WPA + (unsigned)((col0 + n) * 512 + k)); }, 512, As, Bs, wrow0, wcol0, tidn);
#pragma unroll
        for (int ni = 0; ni < 2; ++ni)
#pragma unroll
          for (int i = 0; i < 16; ++i) sg[0][0][ni][i] *= ya[0][0][ni][i];
      }
      {
        f32x16 yb[1][1][2] = {{{zero16(), zero16()}}};
        gemm_pass<128, 128, 1, 2, 1>(yb, a2load, [&](int w, int n, int k) { return *(const uint4*)(WPB + (unsigned)((col0 + n) * 512 + k)); }, 512, As, Bs, wrow0, wcol0, tidn);
        int rb1 = row0 + wrow0 + 4 * hh;
        asm volatile("" : "+v"(rb1));
#pragma unroll
        for (int ni = 0; ni < 2; ++ni) {
          const int col = col0 + wcol0 + ni * 32 + l31;
#pragma unroll
          for (int i = 0; i < 16; ++i) {
            const float mv = sg[0][0][ni][i] + sg[1][0][ni][i] * yb[0][0][ni][i];
            ZG[(unsigned)((rb1 + crow(i, 0)) * 1024 + col)] = f2bf(mv);
          }
        }
      }
    }
    __threadfence();
    __syncthreads();
#if PROBE
    if (mt == 0) {
      float d2 = 0.f, r2 = 0.f;
      if (tid < 64) {
        const int r = (tid * 37) & 127, col = (tid * 131 + 7) & 1023, row = row0 + r;
        const ushort_t* hrow = (const ushort_t*)(p.out + (size_t)row * DM);
        float ga = p.b_mg[col], gb = p.b_mg[1024 + col], ya = 0.f, yb = 0.f;
        for (int k = 0; k < 1024; ++k) { const float hv = bf2f(hrow[k]); ga += hv * p.w_mg[(size_t)k * 2048 + col]; gb += hv * p.w_mg[(size_t)k * 2048 + 1024 + col]; }
        for (int k = 0; k < 512; ++k) {
          ya += bf2f(QB[((size_t)(b * 8 + (k >> 6)) * SEQ + tb0 + r) * 64 + (k & 63)]) * p.w_pa[(size_t)k * 1024 + col];
          yb += bf2f(O[(size_t)row * 512 + k]) * p.w_pb[(size_t)k * 1024 + col];
        }
        const float ref = ya / (1.f + expf(-ga)) + yb / (1.f + expf(-gb));
        const float got = bf2f(ZG[(size_t)row * 1024 + col]);
        d2 = (got - ref) * (got - ref); r2 = ref * ref;
      }
      dbg_acc(p, 2, d2, r2);
    }
#endif
    const float* gt = md + 2048;
#pragma unroll 1
    for (int nt = 0; nt < 8; ++nt) {
      const int col0 = nt * 128;
      int tidn = tid;
      asm volatile("" : "+v"(tidn));
      f32x16 acc[1][1][2] = {{{zero16(), zero16()}}};
      gemm_pass<128, 128, 1, 2, 1>(acc, [&](int r, int k) { return *(const uint4*)(ZG + (unsigned)((row0 + r) * 1024 + k)); },
                                   [&](int w, int n, int k) { return *(const uint4*)(WO + (unsigned)((col0 + n) * DM + k)); }, DM, As, Bs, wrow0, wcol0, tidn);
      int rb2 = row0 + wrow0 + 4 * hh;
      asm volatile("" : "+v"(rb2));
#pragma unroll
      for (int ni = 0; ni < 2; ++ni) {
        const int col = col0 + wcol0 + ni * 32 + l31;
        const float g = gt[col];
#pragma unroll
        for (int i = 0; i < 16; ++i) {
          const unsigned idx = (unsigned)((rb2 + crow(i, 0)) * DM + col);
          p.out[idx] = ALPHA * p.x[idx] + g * acc[0][0][ni][i];
        }
      }
    }
    __threadfence();
    __syncthreads();
#if PROBE
    if (mt == 0) {
      float d2 = 0.f, r2 = 0.f;
      if (tid < 64) {
        const int r = (tid * 29) & 127, col = (tid * 113 + 5) & 1023, row = row0 + r;
        float o = 0.f;
        for (int k = 0; k < 1024; ++k) o += bf2f(ZG[(size_t)row * 1024 + k]) * p.w_o[(size_t)k * 1024 + col];
        const float ref = md[2048 + col] * o;
        const float got = p.out[(size_t)row * DM + col] - ALPHA * p.x[(size_t)row * DM + col];
        d2 = (got - ref) * (got - ref); r2 = ref * ref;
      }
      dbg_acc(p, 3, d2, r2);
    }
    __threadfence();
    __syncthreads();
#endif
#if !PROBE
#if PROBE
    const float pdelta = probe_delta(p);
#else
    const float pdelta = 0.f;
#endif
#pragma unroll 1
    for (int r = wave; r < 128; r += 8) {
      float* dst = p.out + (size_t)(row0 + r) * DM;
      float4 v[4];
      float s = 0.f;
#pragma unroll
      for (int i = 0; i < 4; ++i) { v[i] = *(const float4*)(dst + lane * 4 + 256 * i); s += v[i].x + v[i].y + v[i].z + v[i].w; }
      const float mu = wave_sum(s) * (1.f / DM);
      float q = 0.f;
#pragma unroll
      for (int i = 0; i < 4; ++i) { v[i].x -= mu; v[i].y -= mu; v[i].z -= mu; v[i].w -= mu; q += v[i].x * v[i].x + v[i].y * v[i].y + v[i].z * v[i].z + v[i].w * v[i].w; }
      const float rstd = rsqrtf(wave_sum(q) * (1.f / DM) + LN_EPS);
#pragma unroll
      for (int i = 0; i < 4; ++i) {
        const int col = lane * 4 + 256 * i;
        const float4 g = *(const float4*)(p.ln_g + col), bb = *(const float4*)(p.ln_b + col);
        *(float4*)(dst + col) = make_float4(v[i].x * rstd * g.x + bb.x + pdelta, v[i].y * rstd * g.y + bb.y + pdelta, v[i].z * rstd * g.z + bb.z + pdelta, v[i].w * rstd * g.w + bb.w + pdelta);
      }
    }
#endif
  }
}


#if PROBE
DI void probe_f3(const Params& p) {
  const float pdelta = probe_delta(p);
  const int lane = threadIdx.x & 63, wave = threadIdx.x >> 6;
  for (int mt = blockIdx.x; mt < NX / 128; mt += gridDim.x) {
    for (int r = wave; r < 128; r += 8) {
      const float* src = p.x + (size_t)(mt * 128 + r) * DM;
      float* dst = p.out + (size_t)(mt * 128 + r) * DM;
      float s = 0.f, q = 0.f;
      for (int i = lane; i < 1024; i += 64) s += ALPHA * src[i];
      const float mu = wave_sum(s) / 1024.f;
      for (int i = lane; i < 1024; i += 64) { const float d = ALPHA * src[i] - mu; q += d * d; }
      const float rstd = rsqrtf(wave_sum(q) / 1024.f + LN_EPS);
      for (int i = lane; i < 1024; i += 64) dst[i] = (ALPHA * src[i] - mu) * rstd * p.ln_g[i] + p.ln_b[i] + pdelta;
    }
  }
}
#endif
DI void gsync(cg::grid_group& g) { __threadfence(); g.sync(); }

constexpr int SMEM_BYTES = 65536 + 32 * 264 * 2 + 1024;
__global__ void __launch_bounds__(NTH) fwd_megakernel(Params p) {
  __shared__ __attribute__((aligned(16))) unsigned char smem[SMEM_BYTES];
  cg::grid_group grid = cg::this_grid();
#if PROBE
  if (blockIdx.x == 0 && threadIdx.x < 64) ((float*)(p.ws + OFF_DBG))[threadIdx.x] = 0.f;
#endif
  phase0(p, smem);
  gsync(grid);
  phase_h(p);
  gsync(grid);
  phase_gemm1(p, smem);
  gsync(grid);
  phase_qkv(p);
  phase_rwkv_prep(p, smem);
  gsync(grid);
#if PROBE_NAIVE_SCAN
  phase_scan_naive(p);
#else
  phase_scanA(p, smem);
  gsync(grid);
  phase_scanB(p, smem);
  gsync(grid);
  phase_scanC(p, smem);
#endif
  phase_attn(p, smem);
  gsync(grid);
#if PROBE
  probe_scan(p);
  gsync(grid);
#endif
  phase_final(p, smem);
#if PROBE
  gsync(grid);
  probe_f3(p);
#endif
}

extern "C" void kernel_launch(void* const* d_in, const int* in_sizes, int n_in, void* d_out, int out_size, void* d_ws, size_t ws_size,
                              hipStream_t stream) {
  static int grid_blocks = 0;
  if (!grid_blocks) {
    int dev = 0, cus = 0, per_cu = 0;
    hipGetDevice(&dev);
    hipDeviceGetAttribute(&cus, hipDeviceAttributeMultiprocessorCount, dev);
    hipOccupancyMaxActiveBlocksPerMultiprocessor(&per_cu, fwd_megakernel, NTH, 0);
    if (per_cu < 1) fprintf(stderr, "occupancy query says %d blocks/CU\n", per_cu);
    grid_blocks = cus > 0 ? cus : 256;
    if (ws_size < WS_END) fprintf(stderr, "workspace too small: %zu < %zu\n", ws_size, (size_t)WS_END);
  }
  Params p{};
  const float** fp = (const float**)&p;
  for (int i = 0; i < 27; ++i) fp[i] = (const float*)d_in[i];
  p.out = (float*)d_out;
  p.ws = (unsigned char*)d_ws;
  void* args[] = {&p};
  hipError_t e = hipLaunchCooperativeKernel((void*)fwd_megakernel, dim3(grid_blocks), dim3(NTH), args, 0, stream);
  if (e != hipSuccess) fprintf(stderr, "cooperative launch failed: %s (grid %d)\n", hipGetErrorString(e), grid_blocks);
}
```

```cpp
#include <hip/hip_runtime.h>
#include <hip/hip_cooperative_groups.h>
#include <stdint.h>
#include <cstdio>
namespace cg = cooperative_groups;

#define PROBE 0
#define DI __device__ __forceinline__
typedef __attribute__((ext_vector_type(8))) short bf16x8;
typedef __attribute__((ext_vector_type(16))) float f32x16;
typedef __attribute__((ext_vector_type(16))) uint32_t u32x16;
typedef __attribute__((ext_vector_type(2))) _Float16 h2;
typedef __attribute__((ext_vector_type(2))) __bf16 b2;
typedef unsigned short ushort_t;
typedef __attribute__((ext_vector_type(4))) uint32_t u32x4;
#define MFMA(a, b, c) __builtin_amdgcn_mfma_f32_32x32x16_bf16((a), (b), (c), 0, 0, 0)

constexpr int DM = 1024, NB = 2, SEQ = 16384, CTXL = 256;
constexpr int NX = NB * SEQ, NC = NB * CTXL, NT = NX + NC;
constexpr int INW = 3584, LTOT = CTXL + SEQ;
constexpr int NTH = 512;
constexpr int CH = 130, NCHUNK = LTOT / CH;
static_assert(NCHUNK * CH == LTOT, "chunking");
constexpr float LN_EPS = 1e-5f, QK_EPS = 1e-6f, GN_EPS = 64e-5f;
constexpr float ALPHA = 1.189207115002721f;
constexpr float QSCALE = 0.125f * 1.4426950408889634f;

constexpr size_t OFF_WIN = 0;
constexpr size_t OFF_WMG = OFF_WIN + (size_t)INW * DM * 2;
constexpr size_t OFF_WPA = OFF_WMG + (size_t)2048 * DM * 2;
constexpr size_t OFF_WPB = OFF_WPA + (size_t)1024 * 512 * 2;
constexpr size_t OFF_WO  = OFF_WPB + (size_t)1024 * 512 * 2;
constexpr size_t OFF_WL  = OFF_WO + (size_t)1024 * 1024 * 2;
constexpr size_t OFF_MOD = OFF_WL + (size_t)2 * 2 * 512 * 64 * 2;
constexpr size_t OFF_ZG  = OFF_MOD + 36864;
constexpr size_t OFF_QB  = OFF_ZG + (size_t)NX * 1024 * 2;
constexpr size_t OFF_KB  = OFF_QB + (size_t)NX * 512 * 2;
constexpr size_t OFF_VB  = OFF_KB + (size_t)NB * 2 * LTOT * 64 * 2;
constexpr size_t OFF_SH  = OFF_VB + (size_t)NB * 2 * LTOT * 64 * 2;
constexpr size_t OFF_DR  = OFF_SH + (size_t)16 * LTOT * 192 * 2;
constexpr size_t OFF_ZQ  = OFF_DR + (size_t)32 * LTOT * 192 * 2;
constexpr size_t WS_END  = OFF_ZQ + (size_t)2 * NX * 512 * 2;
static_assert(WS_END <= (size_t)536870912, "workspace");
static_assert((size_t)NT * DM * 2 <= (size_t)48 * LTOT * 192 * 2, "H alias");
static_assert((size_t)NT * 768 * 2 <= (size_t)2 * NX * 512 * 2, "zqkv alias");

struct Params {
  const float *x, *c, *ctx, *c_ctx, *w_ada, *b_ada, *w_in, *q_norm, *k_norm, *mu_prev, *mu_next, *w0, *w_up, *a0, *a_up, *k_k, *k_a,
      *r_k, *gn_w, *gn_b, *w_pa, *w_pb, *w_mg, *b_mg, *w_o, *ln_g, *ln_b;
  float* out;
  unsigned char* ws;
};

DI ushort_t f2bf(float f) { return __builtin_bit_cast(ushort_t, (__bf16)f); }
DI float bf2f(ushort_t b) { return __uint_as_float(((unsigned)b) << 16); }
DI unsigned pack_bf2(float a, float b) { b2 v = {(__bf16)a, (__bf16)b}; return __builtin_bit_cast(unsigned, v); }
DI unsigned pack_h2(float a, float b) { h2 v = {(_Float16)a, (_Float16)b}; return __builtin_bit_cast(unsigned, v); }
DI ushort_t f2h(float f) { return __builtin_bit_cast(ushort_t, (_Float16)f); }
DI float h2f(ushort_t h) { return (float)__builtin_bit_cast(_Float16, h); }
DI float bflo(unsigned u) { return __uint_as_float(u << 16); }
DI float bfhi(unsigned u) { return __uint_as_float(u & 0xffff0000u); }
DI float hlo(unsigned u) { return (float)__builtin_bit_cast(h2, u)[0]; }
DI float hhi(unsigned u) { return (float)__builtin_bit_cast(h2, u)[1]; }
DI float sigmf(float v) { return __builtin_amdgcn_rcpf(1.f + __expf(-v)); }
DI float siluf(float v) { return v * sigmf(v); }
DI int crow(int reg, int h) { return (reg & 3) + 8 * (reg >> 2) + 4 * h; }
DI float wave_sum(float v) {
#pragma unroll
  for (int o = 32; o >= 1; o >>= 1) v += __shfl_xor(v, o, 64);
  return v;
}
DI f32x16 zero16() { f32x16 z;
#pragma unroll
  for (int i = 0; i < 16; ++i) z[i] = 0.f; return z; }

#define SCAN_VLOAD 0
#define PROBE_NAIVE_SCAN 0
#if SCAN_VLOAD
DI void sload2(u32x16& a0, u32x16& a1, const void* p) { a0 = *(const u32x16*)p; a1 = *((const u32x16*)p + 1); }
DI void sload4(u32x16& a0, u32x16& a1, u32x16& b0, u32x16& b1, const void* p, const void* q) {
  a0 = *(const u32x16*)p; a1 = *((const u32x16*)p + 1); b0 = *(const u32x16*)q; b1 = *((const u32x16*)q + 1);
}
#else
DI void sload2(u32x16& a0, u32x16& a1, const void* p) {
  asm volatile("s_load_dwordx16 %0, %2, 0x0\n\ts_load_dwordx16 %1, %2, 0x40\n\ts_waitcnt lgkmcnt(0)" : "=&s"(a0), "=&s"(a1) : "s"(p) : "memory");
}
DI void sload4(u32x16& a0, u32x16& a1, u32x16& b0, u32x16& b1, const void* p, const void* q) {
  asm volatile("s_load_dwordx16 %0, %4, 0x0\n\ts_load_dwordx16 %1, %4, 0x40\n\ts_load_dwordx16 %2, %5, 0x0\n\ts_load_dwordx16 %3, %5, 0x40\n\ts_waitcnt lgkmcnt(0)"
               : "=&s"(a0), "=&s"(a1), "=&s"(b0), "=&s"(b1) : "s"(p), "s"(q) : "memory");
}
#endif
DI float HV(const u32x16& v, int j) { const uint32_t w = v[j >> 1]; const h2 t = __builtin_bit_cast(h2, w); return (float)t[j & 1]; }

constexpr int LDK = 72;
template <int BM, int BN, int MI, int NI, int NB, class AL, class BL>
DI void gemm_pass(f32x16 (&acc)[NB][MI][NI], AL aload, BL bload, int K, ushort_t* As, ushort_t* Bs, int wrow0, int wcol0, int tid) {
  constexpr int NA = BM * 8 / NTH, NBC = BN * 8 / NTH;
  constexpr int ASZ = BM * LDK, BSZ = NB * BN * LDK;
  const int lane = tid & 63, l31 = lane & 31, hh = lane >> 5;
  const int nk = K >> 6;
  uint4 ra[2][NA], rb[2][NB][NBC];
  auto gload = [&](int s, int kt) {
#pragma unroll
    for (int i = 0; i < NA; ++i) { const int id = tid + i * NTH; ra[s][i] = aload(id >> 3, kt * 64 + (id & 7) * 8); }
#pragma unroll
    for (int w = 0; w < NB; ++w)
#pragma unroll
      for (int i = 0; i < NBC; ++i) { const int id = tid + i * NTH; rb[s][w][i] = bload(w, id >> 3, kt * 64 + (id & 7) * 8); }
  };
  auto lstore = [&](int s, int buf) {
#pragma unroll
    for (int i = 0; i < NA; ++i) { const int id = tid + i * NTH; *(uint4*)&As[buf * ASZ + (id >> 3) * LDK + (id & 7) * 8] = ra[s][i]; }
#pragma unroll
    for (int w = 0; w < NB; ++w)
#pragma unroll
      for (int i = 0; i < NBC; ++i) { const int id = tid + i * NTH; *(uint4*)&Bs[buf * BSZ + w * BN * LDK + (id >> 3) * LDK + (id & 7) * 8] = rb[s][w][i]; }
  };
  auto compute = [&](int buf) {
#pragma unroll
    for (int ks = 0; ks < 4; ++ks) {
      bf16x8 af[MI];
#pragma unroll
      for (int mi = 0; mi < MI; ++mi) af[mi] = *(const bf16x8*)&As[buf * ASZ + (wrow0 + mi * 32 + l31) * LDK + ks * 16 + hh * 8];
#pragma unroll
      for (int w = 0; w < NB; ++w) {
        bf16x8 bfv[NI];
#pragma unroll
        for (int ni = 0; ni < NI; ++ni) bfv[ni] = *(const bf16x8*)&Bs[buf * BSZ + w * BN * LDK + (wcol0 + ni * 32 + l31) * LDK + ks * 16 + hh * 8];
#pragma unroll
        for (int mi = 0; mi < MI; ++mi)
#pragma unroll
          for (int ni = 0; ni < NI; ++ni) acc[w][mi][ni] = MFMA(af[mi], bfv[ni], acc[w][mi][ni]);
      }
    }
  };
  __syncthreads();
  gload(0, 0);
  lstore(0, 0);
  gload(1, 1);
  gload(0, 2);
#pragma unroll 1
  for (int kt = 0; kt < nk; kt += 2) {
    __syncthreads();
    lstore(1, 1);
    if (kt + 3 < nk) gload(1, kt + 3);
    compute(0);
    __syncthreads();
    if (kt + 2 < nk) { lstore(0, 0); if (kt + 4 < nk) gload(0, kt + 4); }
    compute(1);
  }
}

DI void transpose_tile(const float* __restrict__ src, int ld_src, ushort_t* dst, int ld_dst, int k0, int n0, float* T) {
  const int tid = threadIdx.x;
#pragma unroll
  for (int i = 0; i < 2; ++i) {
    const int k = (tid >> 4) + 32 * i, n4 = (tid & 15) * 4;
    const float4 v = *(const float4*)(src + (size_t)(k0 + k) * ld_src + n0 + n4);
    T[k * 65 + n4 + 0] = v.x; T[k * 65 + n4 + 1] = v.y; T[k * 65 + n4 + 2] = v.z; T[k * 65 + n4 + 3] = v.w;
  }
  __syncthreads();
  const int n = tid >> 3, kc = tid & 7;
  uint4 o;
  o.x = pack_bf2(T[(kc * 8 + 0) * 65 + n], T[(kc * 8 + 1) * 65 + n]);
  o.y = pack_bf2(T[(kc * 8 + 2) * 65 + n], T[(kc * 8 + 3) * 65 + n]);
  o.z = pack_bf2(T[(kc * 8 + 4) * 65 + n], T[(kc * 8 + 5) * 65 + n]);
  o.w = pack_bf2(T[(kc * 8 + 6) * 65 + n], T[(kc * 8 + 7) * 65 + n]);
  *(uint4*)(dst + (size_t)(n0 + n) * ld_dst + k0 + kc * 8) = o;
  __syncthreads();
}

DI void phase0(const Params& p, unsigned char* smem) {
  float* T = (float*)smem;
  ushort_t* win = (ushort_t*)(p.ws + OFF_WIN);
  ushort_t* wmg = (ushort_t*)(p.ws + OFF_WMG);
  ushort_t* wpa = (ushort_t*)(p.ws + OFF_WPA);
  ushort_t* wpb = (ushort_t*)(p.ws + OFF_WPB);
  ushort_t* wo = (ushort_t*)(p.ws + OFF_WO);
  ushort_t* wl = (ushort_t*)(p.ws + OFF_WL);
  float* mod = (float*)(p.ws + OFF_MOD);
  constexpr int T_IN = 16 * 56, T_MG = 16 * 32, T_PA = 8 * 16, T_PB = 8 * 16, T_O = 16 * 16, T_L = 32, T_MOD = 48;
  constexpr int TOTAL = T_MOD + T_IN + T_MG + T_PA + T_PB + T_O + T_L;
  for (int t = blockIdx.x; t < TOTAL; t += gridDim.x) {
    int u = t;
    if (u < T_MOD) {
      float* sil = T;
      float* red = T + 3072;
      const int tid = threadIdx.x;
      for (int i = tid; i < 3072; i += NTH) {
        const int v = i >> 10, k = i & 1023;
        const float cv = (v < 2) ? p.c[v * 1024 + k] : p.c_ctx[k];
        sil[i] = siluf(cv);
      }
      __syncthreads();
      const int n = tid & 63, ksl = tid >> 6, n0 = u * 64;
      float a0 = 0.f, a1 = 0.f, a2 = 0.f;
      for (int k = ksl * 128; k < ksl * 128 + 128; ++k) {
        const float w = p.w_ada[(size_t)k * 3072 + n0 + n];
        a0 = fmaf(sil[k], w, a0); a1 = fmaf(sil[1024 + k], w, a1); a2 = fmaf(sil[2048 + k], w, a2);
      }
      red[(ksl * 3 + 0) * 64 + n] = a0; red[(ksl * 3 + 1) * 64 + n] = a1; red[(ksl * 3 + 2) * 64 + n] = a2;
      __syncthreads();
      if (tid < 192) {
        const int v = tid >> 6, nn = tid & 63;
        float s = 0.f;
#pragma unroll
        for (int q = 0; q < 8; ++q) s += red[(q * 3 + v) * 64 + nn];
        mod[v * 3072 + n0 + nn] = s + p.b_ada[n0 + nn];
      }
      __syncthreads();
      continue;
    }
    u -= T_MOD;
    if (u < T_IN) { transpose_tile(p.w_in, INW, win, 1024, (u / 56) * 64, (u % 56) * 64, T); continue; }
    u -= T_IN;
    if (u < T_MG) { transpose_tile(p.w_mg, 2048, wmg, 1024, (u / 32) * 64, (u % 32) * 64, T); continue; }
    u -= T_MG;
    if (u < T_PA) { transpose_tile(p.w_pa, 1024, wpa, 512, (u / 16) * 64, (u % 16) * 64, T); continue; }
    u -= T_PA;
    if (u < T_PB) { transpose_tile(p.w_pb, 1024, wpb, 512, (u / 16) * 64, (u % 16) * 64, T); continue; }
    u -= T_PB;
    if (u < T_O) { transpose_tile(p.w_o, 1024, wo, 1024, (u / 16) * 64, (u % 16) * 64, T); continue; }
    u -= T_O;
    {
      const int which = u >> 4, dir = (u >> 3) & 1, nt = u & 7;
      const float* src = (which ? p.a_up : p.w_up) + (size_t)dir * 64 * 512;
      transpose_tile(src, 512, wl + (size_t)((dir * 2 + which) * 512) * 64, 64, 0, nt * 64, T);
    }
  }
}

DI void phase_h(const Params& p) {
  const float* mod = (const float*)(p.ws + OFF_MOD);
  ushort_t* H = (ushort_t*)(p.ws + OFF_SH);
  const int lane = threadIdx.x & 63, gw = blockIdx.x * 8 + (threadIdx.x >> 6);
  for (int row = gw; row < NT; row += gridDim.x * 8) {
    const float* src = (row < NX) ? p.x + (size_t)row * DM : p.ctx + (size_t)(row - NX) * DM;
    const float* md = mod + ((row < NX) ? (row / SEQ) : 2) * 3072;
    float4 v[4];
    float s = 0.f;
#pragma unroll
    for (int i = 0; i < 4; ++i) { v[i] = *(const float4*)(src + lane * 4 + 256 * i); s += v[i].x + v[i].y + v[i].z + v[i].w; }
    const float mu = wave_sum(s) * (1.f / DM);
    float q = 0.f;
#pragma unroll
    for (int i = 0; i < 4; ++i) { v[i].x -= mu; v[i].y -= mu; v[i].z -= mu; v[i].w -= mu; q += v[i].x * v[i].x + v[i].y * v[i].y + v[i].z * v[i].z + v[i].w * v[i].w; }
    const float rstd = rsqrtf(wave_sum(q) * (1.f / DM) + LN_EPS);
#pragma unroll
    for (int i = 0; i < 4; ++i) {
      const int col = lane * 4 + 256 * i;
      const float4 sh = *(const float4*)(md + col), sc = *(const float4*)(md + 1024 + col);
      uint2 o;
      o.x = pack_bf2(v[i].x * rstd * (1.f + sc.x) + sh.x, v[i].y * rstd * (1.f + sc.y) + sh.y);
      o.y = pack_bf2(v[i].z * rstd * (1.f + sc.z) + sh.z, v[i].w * rstd * (1.f + sc.w) + sh.w);
      *(uint2*)(H + (size_t)row * DM + col) = o;
    }
  }
}

DI void phase_gemm1(const Params& p, unsigned char* smem) {
  ushort_t* As = (ushort_t*)smem;
  ushort_t* Bs = As + 2 * 256 * LDK;
  const ushort_t* H = (const ushort_t*)(p.ws + OFF_SH);
  const ushort_t* W = (const ushort_t*)(p.ws + OFF_WIN);
  ushort_t* zq = (ushort_t*)(p.ws + OFF_ZQ);
  ushort_t* zg = (ushort_t*)(p.ws + OFF_ZG);
  ushort_t* zm = (ushort_t*)p.out;
  const int tid = threadIdx.x, wave = tid >> 6, lane = tid & 63, l31 = lane & 31, hh = lane >> 5;
  const int wrow0 = (wave & 3) * 64, wcol0 = (wave >> 2) * 64;
  constexpr int MT = NT / 256, NTL = INW / 128;
  for (int t = blockIdx.x; t < MT * NTL; t += gridDim.x) {
    const int mt = t / NTL, nt = t % NTL;
    const bool is_g = (nt >= 6 && nt < 10) || nt >= 24;
    if (is_g && mt >= NX / 256) continue;
    const int row0 = mt * 256, col0 = nt * 128;
    f32x16 acc[1][2][2];
#pragma unroll
    for (int a = 0; a < 2; ++a)
#pragma unroll
      for (int b = 0; b < 2; ++b) acc[0][a][b] = zero16();
    auto aload = [&](int r, int k) { return *(const uint4*)(H + (size_t)(row0 + r) * DM + k); };
    auto bload = [&](int w, int n, int k) { return *(const uint4*)(W + (size_t)(col0 + n) * DM + k); };
    gemm_pass<256, 128, 2, 2, 1>(acc, aload, bload, DM, As, Bs, wrow0, wcol0, tid);
    ushort_t* dst; int ld, cbase;
    if (nt < 6) { dst = zq; ld = 768; cbase = col0; }
    else if (nt < 10) { dst = zg; ld = 1024; cbase = col0 - 768; }
    else if (nt < 24) { dst = zm; ld = 1792; cbase = col0 - 1280; }
    else { dst = zg; ld = 1024; cbase = 512 + col0 - 3072; }
#pragma unroll
    for (int mi = 0; mi < 2; ++mi)
#pragma unroll
      for (int ni = 0; ni < 2; ++ni)
#pragma unroll
        for (int i = 0; i < 16; ++i) {
          const int row = row0 + wrow0 + mi * 32 + crow(i, hh), col = cbase + wcol0 + ni * 32 + l31;
          dst[(size_t)row * ld + col] = f2bf(acc[0][mi][ni][i]);
        }
  }
}

DI int vperm(int key) { const int g = key >> 4, kq = key & 15; return g * 16 + 8 * ((kq >> 2) & 1) + (kq & 3) + 4 * (kq >> 3); }
DI void phase_qkv(const Params& p) {
  const ushort_t* zq = (const ushort_t*)(p.ws + OFF_ZQ);
  ushort_t* QB = (ushort_t*)(p.ws + OFF_QB);
  ushort_t* KB = (ushort_t*)(p.ws + OFF_KB);
  ushort_t* VB = (ushort_t*)(p.ws + OFF_VB);
  const int lane = threadIdx.x & 63, gw = blockIdx.x * 8 + (threadIdx.x >> 6);
  const int j = lane & 31, half = lane >> 5, axis = j >> 4, f = j & 15;
  const int d1 = axis * 32 + f, d2 = d1 + 16;
  const float inv = powf(10000.f, -(float)f * (1.f / 16.f));
  const float gq1 = p.q_norm[d1], gq2 = p.q_norm[d2], gk1 = p.k_norm[d1], gk2 = p.k_norm[d2];
  for (int row = gw; row < NT; row += gridDim.x * 8) {
    const bool isx = row < NX;
    const int b = isx ? row / SEQ : (row - NX) / CTXL;
    const int t = isx ? row % SEQ : (row - NX) % CTXL;
    const int pos = isx ? CTXL + t : t;
    const ushort_t* z = zq + (size_t)row * 768;
    float cs = 1.f, sn = 0.f;
    if (isx) { const float ang = (float)(axis ? (t & 63) : (t >> 6)) * inv; sincosf(ang, &sn, &cs); }
#pragma unroll
    for (int it = 0; it < 5; ++it) {
      const int hd = it * 2 + half;
      if (!isx && hd < 8) continue;
      const float v1 = bf2f(z[hd * 64 + d1]), v2 = bf2f(z[hd * 64 + d2]);
      float ss = v1 * v1 + v2 * v2;
#pragma unroll
      for (int o = 16; o >= 1; o >>= 1) ss += __shfl_xor(ss, o, 64);
      const float rms = rsqrtf(ss * (1.f / 64.f) + QK_EPS);
      const bool isq = hd < 8;
      const float y1 = v1 * rms * (isq ? gq1 : gk1), y2 = v2 * rms * (isq ? gq2 : gk2);
      float o1 = y1 * cs - y2 * sn, o2 = y2 * cs + y1 * sn;
      if (isq) {
        ushort_t* dst = QB + ((size_t)(b * 8 + hd) * SEQ + t) * 64;
        dst[d1] = f2bf(o1 * QSCALE); dst[d2] = f2bf(o2 * QSCALE);
      } else {
        ushort_t* dst = KB + ((size_t)(b * 2 + (hd - 8)) * LTOT + pos) * 64;
        dst[d1] = f2bf(o1); dst[d2] = f2bf(o2);
      }
    }
    {
      const size_t tb = (size_t)(pos >> 6) * 4096 + lane * 64 + vperm(pos & 63);
      VB[(size_t)(b * 2 + 0) * LTOT * 64 + tb] = z[640 + lane];
      VB[(size_t)(b * 2 + 1) * LTOT * 64 + tb] = z[704 + lane];
    }
  }
}

DI void phase_rwkv_prep(const Params& p, unsigned char* smem) {
  float* kbuf = (float*)smem;
  ushort_t* codes = (ushort_t*)(smem + 65536);
  float* invn = (float*)(smem + 65536 + 32 * 264 * 2);
  const ushort_t* zm = (const ushort_t*)p.out;
  const ushort_t* WL = (const ushort_t*)(p.ws + OFF_WL);
  ushort_t* SH = (ushort_t*)(p.ws + OFF_SH);
  ushort_t* DR = (ushort_t*)(p.ws + OFF_DR);
  const int tid = threadIdx.x, wave = tid >> 6, lane = tid & 63, l31 = lane & 31, hh = lane >> 5;
  for (int tt = blockIdx.x; tt < NT / 32; tt += gridDim.x) {
    const int row0 = tt * 32;
    int b, t0, len, pbase;
    if (row0 < NX) { b = row0 / SEQ; t0 = row0 % SEQ; len = SEQ; pbase = CTXL; }
    else { const int rc = row0 - NX; b = rc / CTXL; t0 = rc % CTXL; len = CTXL; pbase = 0; }
    __syncthreads();
    for (int id = tid; id < 32 * 224; id += NTH) {
      const int i = id / 224, c0 = (id % 224) * 8;
      const int t = t0 + i;
      const ushort_t* zr = zm + (size_t)(row0 + i) * 1792 + c0;
      const uint4 zc = *(const uint4*)zr;
      uint4 zp = make_uint4(0, 0, 0, 0), zn = make_uint4(0, 0, 0, 0);
      if (t > 0) zp = *(const uint4*)(zr - 1792);
      if (t < len - 1) zn = *(const uint4*)(zr + 1792);
      const float4 mp0 = *(const float4*)(p.mu_prev + c0), mp1 = *(const float4*)(p.mu_prev + c0 + 4);
      const float4 mn0 = *(const float4*)(p.mu_next + c0), mn1 = *(const float4*)(p.mu_next + c0 + 4);
      const unsigned zcw[4] = {zc.x, zc.y, zc.z, zc.w}, zpw[4] = {zp.x, zp.y, zp.z, zp.w}, znw[4] = {zn.x, zn.y, zn.z, zn.w};
      const float mpv[8] = {mp0.x, mp0.y, mp0.z, mp0.w, mp1.x, mp1.y, mp1.z, mp1.w};
      const float mnv[8] = {mn0.x, mn0.y, mn0.z, mn0.w, mn1.x, mn1.y, mn1.z, mn1.w};
      float s[8];
#pragma unroll
      for (int q = 0; q < 4; ++q) {
        const float c_lo = bflo(zcw[q]), c_hi = bfhi(zcw[q]);
        s[2 * q] = c_lo + mpv[2 * q] * (bflo(zpw[q]) - c_lo) + mnv[2 * q] * (bflo(znw[q]) - c_lo);
        s[2 * q + 1] = c_hi + mpv[2 * q + 1] * (bfhi(zpw[q]) - c_hi) + mnv[2 * q + 1] * (bfhi(znw[q]) - c_hi);
      }
      const int pp = pbase + t;
      if (c0 < 512 || (c0 >= 1024 && c0 < 1536)) {
        const int cc = (c0 < 512) ? c0 : c0 - 1024, which = (c0 < 512) ? 1 : 2;
        const int head = cc >> 6, d = cc & 63;
        uint4 o;
        o.x = pack_h2(s[0], s[1]); o.y = pack_h2(s[2], s[3]); o.z = pack_h2(s[4], s[5]); o.w = pack_h2(s[6], s[7]);
        *(uint4*)(SH + (((size_t)(b * 8 + head) * LTOT + pp) * 3 + which) * 64 + d) = o;
      } else if (c0 < 1024) {
        float* kd = kbuf + i * 512 + (c0 - 512);
        *(float4*)kd = make_float4(s[0], s[1], s[2], s[3]);
        *(float4*)(kd + 4) = make_float4(s[4], s[5], s[6], s[7]);
      } else {
        const int cc = c0 - 1536;
        if (cc < 128) {
#pragma unroll
          for (int q = 0; q < 8; ++q) s[q] = tanhf(s[q]);
        }
        uint4 o;
        o.x = pack_bf2(s[0], s[1]); o.y = pack_bf2(s[2], s[3]); o.z = pack_bf2(s[4], s[5]); o.w = pack_bf2(s[6], s[7]);
        *(uint4*)(codes + i * 264 + cc) = o;
      }
    }
    __syncthreads();
    {
      const int i = tid >> 4, head = (tid >> 1) & 7, hf = tid & 1;
      float ss = 0.f;
#pragma unroll 8
      for (int q = 0; q < 32; ++q) {
        const int n = head * 64 + hf * 32 + q;
        const float v = kbuf[i * 512 + n] * p.k_k[n];
        ss = fmaf(v, v, ss);
      }
      ss += __shfl_xor(ss, 1, 64);
      if (hf == 0) invn[i * 8 + head] = 1.f / fmaxf(sqrtf(ss), 1e-12f);
    }
    __syncthreads();
#pragma unroll 1
    for (int q4 = 0; q4 < 4; ++q4) {
      const int pr = wave * 4 + q4, dir = pr >> 4, ct = pr & 15;
      f32x16 aw = zero16(), aa = zero16();
#pragma unroll
      for (int ks = 0; ks < 4; ++ks) {
        const bf16x8 fw = *(const bf16x8*)&codes[l31 * 264 + dir * 64 + ks * 16 + hh * 8];
        const bf16x8 fa = *(const bf16x8*)&codes[l31 * 264 + 128 + dir * 64 + ks * 16 + hh * 8];
        const bf16x8 bw = *(const bf16x8*)&WL[(size_t)((dir * 2 + 0) * 512 + ct * 32 + l31) * 64 + ks * 16 + hh * 8];
        const bf16x8 ba = *(const bf16x8*)&WL[(size_t)((dir * 2 + 1) * 512 + ct * 32 + l31) * 64 + ks * 16 + hh * 8];
        aw = MFMA(fw, bw, aw);
        aa = MFMA(fa, ba, aa);
      }
      const int n = ct * 32 + l31, head = n >> 6, d = n & 63;
      const float w0v = p.w0[dir * 512 + n], a0v = p.a0[dir * 512 + n], kkw = p.k_k[n], kaw = p.k_a[n];
      const size_t cbase = (size_t)(b * 8 + head) * LTOT;
#pragma unroll
      for (int i = 0; i < 16; ++i) {
        const int ti = crow(i, hh);
        const int pp = pbase + t0 + ti;
        const float wpre = aw[i] + w0v;
        const float e = 0.60653065971263342f * sigmf(wpre);
        const float xdec = 1.f - __expf(-e);
        const float a = sigmf(aa[i] + a0v);
        const float kv = kbuf[ti * 512 + n];
        const float kkv = kv * kkw * invn[ti * 8 + head];
        const float kd = kv * (1.f + (a - 1.f) * kaw);
        ushort_t* dr = DR + ((((size_t)dir * 16) * LTOT + cbase + pp) * 3) * 64 + d;
        dr[0] = f2h(-xdec); dr[64] = f2h(kd); dr[128] = f2h(kkv * a);
        if (dir == 0) SH[((cbase + pp) * 3) * 64 + d] = f2h(kkv);
      }
    }
  }
}

DI int tau_to_pos(int dir, int tau) { return dir == 0 ? tau : (tau < CTXL ? CTXL - 1 - tau : LTOT - 1 - (tau - CTXL)); }

struct ScanRec { uint32_t sh, dr, bb; ushort_t v; };
DI ScanRec scan_load(const ushort_t* shc, const ushort_t* drc, int pos, int lane) {
  ScanRec r;
  const ushort_t* s = shc + (size_t)pos * 192;
  const uint32_t* d = (const uint32_t*)(drc + (size_t)pos * 192);
  r.sh = ((const uint32_t*)s)[lane];
  r.v = s[128 + lane];
  r.dr = d[lane];
  r.bb = d[64 + (lane & 31)];
  return r;
}
#define MIXLO " op_sel_hi:[0,1,0]\n\t"
#define MIXHI " op_sel:[0,1,0] op_sel_hi:[0,1,0]\n\t"
template <int L>
DI void dot4(float& a0, float& a1, float (&S)[64], uint32_t src) {
  uint32_t t0, t1, t2, t3;
  asm("v_readlane_b32 %2, %6, %7\n\tv_readlane_b32 %3, %6, %8\n\tv_readlane_b32 %4, %6, %9\n\tv_readlane_b32 %5, %6, %10\n\t"
      "v_fma_mix_f32 %0, %11, %2, %0" MIXLO "v_fma_mix_f32 %1, %12, %2, %1" MIXHI
      "v_fma_mix_f32 %0, %13, %3, %0" MIXLO "v_fma_mix_f32 %1, %14, %3, %1" MIXHI
      "v_fma_mix_f32 %0, %15, %4, %0" MIXLO "v_fma_mix_f32 %1, %16, %4, %1" MIXHI
      "v_fma_mix_f32 %0, %17, %5, %0" MIXLO "v_fma_mix_f32 %1, %18, %5, %1" MIXHI
      : "+v"(a0), "+v"(a1), "=&s"(t0), "=&s"(t1), "=&s"(t2), "=&s"(t3)
      : "v"(src), "n"(L), "n"(L + 1), "n"(L + 2), "n"(L + 3),
        "v"(S[2 * (L & 31)]), "v"(S[2 * (L & 31) + 1]), "v"(S[2 * (L & 31) + 2]), "v"(S[2 * (L & 31) + 3]),
        "v"(S[2 * (L & 31) + 4]), "v"(S[2 * (L & 31) + 5]), "v"(S[2 * (L & 31) + 6]), "v"(S[2 * (L & 31) + 7]));
}
template <int L>
DI void upd4(float (&S)[64], uint32_t dr, uint32_t bb, float vv, float nsk) {
  uint32_t x0, x1, x2, x3, k0, k1, k2, k3, b0, b1, b2, b3;
  asm("v_readlane_b32 %8, %20, %22\n\tv_readlane_b32 %9, %20, %23\n\tv_readlane_b32 %10, %20, %24\n\tv_readlane_b32 %11, %20, %25\n\t"
      "v_readlane_b32 %12, %20, %26\n\tv_readlane_b32 %13, %20, %27\n\tv_readlane_b32 %14, %20, %28\n\tv_readlane_b32 %15, %20, %29\n\t"
      "v_readlane_b32 %16, %21, %22\n\tv_readlane_b32 %17, %21, %23\n\tv_readlane_b32 %18, %21, %24\n\tv_readlane_b32 %19, %21, %25\n\t"
      "v_fma_mix_f32 %0, %0, %8, %0" MIXLO "v_fma_mix_f32 %1, %1, %8, %1" MIXHI
      "v_fma_mix_f32 %2, %2, %9, %2" MIXLO "v_fma_mix_f32 %3, %3, %9, %3" MIXHI
      "v_fma_mix_f32 %4, %4, %10, %4" MIXLO "v_fma_mix_f32 %5, %5, %10, %5" MIXHI
      "v_fma_mix_f32 %6, %6, %11, %6" MIXLO "v_fma_mix_f32 %7, %7, %11, %7" MIXHI
      "v_fma_mix_f32 %0, %30, %12, %0" MIXLO "v_fma_mix_f32 %1, %30, %12, %1" MIXHI
      "v_fma_mix_f32 %2, %30, %13, %2" MIXLO "v_fma_mix_f32 %3, %30, %13, %3" MIXHI
      "v_fma_mix_f32 %4, %30, %14, %4" MIXLO "v_fma_mix_f32 %5, %30, %14, %5" MIXHI
      "v_fma_mix_f32 %6, %30, %15, %6" MIXLO "v_fma_mix_f32 %7, %30, %15, %7" MIXHI
      "v_fma_mix_f32 %0, %31, %16, %0" MIXLO "v_fma_mix_f32 %1, %31, %16, %1" MIXHI
      "v_fma_mix_f32 %2, %31, %17, %2" MIXLO "v_fma_mix_f32 %3, %31, %17, %3" MIXHI
      "v_fma_mix_f32 %4, %31, %18, %4" MIXLO "v_fma_mix_f32 %5, %31, %18, %5" MIXHI
      "v_fma_mix_f32 %6, %31, %19, %6" MIXLO "v_fma_mix_f32 %7, %31, %19, %7" MIXHI
      : "+v"(S[2 * L]), "+v"(S[2 * L + 1]), "+v"(S[2 * L + 2]), "+v"(S[2 * L + 3]), "+v"(S[2 * L + 4]), "+v"(S[2 * L + 5]), "+v"(S[2 * L + 6]), "+v"(S[2 * L + 7]),
        "=&s"(x0), "=&s"(x1), "=&s"(x2), "=&s"(x3), "=&s"(k0), "=&s"(k1), "=&s"(k2), "=&s"(k3), "=&s"(b0), "=&s"(b1), "=&s"(b2), "=&s"(b3)
      : "v"(dr), "v"(bb), "n"(L), "n"(L + 1), "n"(L + 2), "n"(L + 3), "n"(L + 32), "n"(L + 33), "n"(L + 34), "n"(L + 35), "v"(vv), "v"(nsk));
}
template <int L>
DI void dot4_2(float& a0, float& a1, float& c0, float& c1, float (&SU)[64], float (&SP)[64], uint32_t src) {
  uint32_t t0, t1, t2, t3;
  asm("v_readlane_b32 %4, %8, %9\n\tv_readlane_b32 %5, %8, %10\n\tv_readlane_b32 %6, %8, %11\n\tv_readlane_b32 %7, %8, %12\n\t"
      "v_fma_mix_f32 %0, %13, %4, %0" MIXLO "v_fma_mix_f32 %1, %14, %4, %1" MIXHI
      "v_fma_mix_f32 %2, %21, %4, %2" MIXLO "v_fma_mix_f32 %3, %22, %4, %3" MIXHI
      "v_fma_mix_f32 %0, %15, %5, %0" MIXLO "v_fma_mix_f32 %1, %16, %5, %1" MIXHI
      "v_fma_mix_f32 %2, %23, %5, %2" MIXLO "v_fma_mix_f32 %3, %24, %5, %3" MIXHI
      "v_fma_mix_f32 %0, %17, %6, %0" MIXLO "v_fma_mix_f32 %1, %18, %6, %1" MIXHI
      "v_fma_mix_f32 %2, %25, %6, %2" MIXLO "v_fma_mix_f32 %3, %26, %6, %3" MIXHI
      "v_fma_mix_f32 %0, %19, %7, %0" MIXLO "v_fma_mix_f32 %1, %20, %7, %1" MIXHI
      "v_fma_mix_f32 %2, %27, %7, %2" MIXLO "v_fma_mix_f32 %3, %28, %7, %3" MIXHI
      : "+v"(a0), "+v"(a1), "+v"(c0), "+v"(c1), "=&s"(t0), "=&s"(t1), "=&s"(t2), "=&s"(t3)
      : "v"(src), "n"(L), "n"(L + 1), "n"(L + 2), "n"(L + 3),
        "v"(SU[2 * L]), "v"(SU[2 * L + 1]), "v"(SU[2 * L + 2]), "v"(SU[2 * L + 3]), "v"(SU[2 * L + 4]), "v"(SU[2 * L + 5]), "v"(SU[2 * L + 6]), "v"(SU[2 * L + 7]),
        "v"(SP[2 * L]), "v"(SP[2 * L + 1]), "v"(SP[2 * L + 2]), "v"(SP[2 * L + 3]), "v"(SP[2 * L + 4]), "v"(SP[2 * L + 5]), "v"(SP[2 * L + 6]), "v"(SP[2 * L + 7]));
}
template <int L>
DI void upd4_2(float (&SU)[64], float (&SP)[64], uint32_t dr, uint32_t bb, float vv, float nskU, float nskP) {
  uint32_t x0, x1, x2, x3, k0, k1, k2, k3, b0, b1, b2, b3;
  asm("v_readlane_b32 %16, %28, %30\n\tv_readlane_b32 %17, %28, %31\n\tv_readlane_b32 %18, %28, %32\n\tv_readlane_b32 %19, %28, %33\n\t"
      "v_readlane_b32 %20, %28, %34\n\tv_readlane_b32 %21, %28, %35\n\tv_readlane_b32 %22, %28, %36\n\tv_readlane_b32 %23, %28, %37\n\t"
      "v_readlane_b32 %24, %29, %30\n\tv_readlane_b32 %25, %29, %31\n\tv_readlane_b32 %26, %29, %32\n\tv_readlane_b32 %27, %29, %33\n\t"
      "v_fma_mix_f32 %0, %0, %16, %0" MIXLO "v_fma_mix_f32 %1, %1, %16, %1" MIXHI
      "v_fma_mix_f32 %2, %2, %17, %2" MIXLO "v_fma_mix_f32 %3, %3, %17, %3" MIXHI
      "v_fma_mix_f32 %4, %4, %18, %4" MIXLO "v_fma_mix_f32 %5, %5, %18, %5" MIXHI
      "v_fma_mix_f32 %6, %6, %19, %6" MIXLO "v_fma_mix_f32 %7, %7, %19, %7" MIXHI
      "v_fma_mix_f32 %8, %8, %16, %8" MIXLO "v_fma_mix_f32 %9, %9, %16, %9" MIXHI
      "v_fma_mix_f32 %10, %10, %17, %10" MIXLO "v_fma_mix_f32 %11, %11, %17, %11" MIXHI
      "v_fma_mix_f32 %12, %12, %18, %12" MIXLO "v_fma_mix_f32 %13, %13, %18, %13" MIXHI
      "v_fma_mix_f32 %14, %14, %19, %14" MIXLO "v_fma_mix_f32 %15, %15, %19, %15" MIXHI
      "v_fma_mix_f32 %0, %38, %20, %0" MIXLO "v_fma_mix_f32 %1, %38, %20, %1" MIXHI
      "v_fma_mix_f32 %2, %38, %21, %2" MIXLO "v_fma_mix_f32 %3, %38, %21, %3" MIXHI
      "v_fma_mix_f32 %4, %38, %22, %4" MIXLO "v_fma_mix_f32 %5, %38, %22, %5" MIXHI
      "v_fma_mix_f32 %6, %38, %23, %6" MIXLO "v_fma_mix_f32 %7, %38, %23, %7" MIXHI
      "v_fma_mix_f32 %0, %39, %24, %0" MIXLO "v_fma_mix_f32 %1, %39, %24, %1" MIXHI
      "v_fma_mix_f32 %2, %39, %25, %2" MIXLO "v_fma_mix_f32 %3, %39, %25, %3" MIXHI
      "v_fma_mix_f32 %4, %39, %26, %4" MIXLO "v_fma_mix_f32 %5, %39, %26, %5" MIXHI
      "v_fma_mix_f32 %6, %39, %27, %6" MIXLO "v_fma_mix_f32 %7, %39, %27, %7" MIXHI
      "v_fma_mix_f32 %8, %40, %24, %8" MIXLO "v_fma_mix_f32 %9, %40, %24, %9" MIXHI
      "v_fma_mix_f32 %10, %40, %25, %10" MIXLO "v_fma_mix_f32 %11, %40, %25, %11" MIXHI
      "v_fma_mix_f32 %12, %40, %26, %12" MIXLO "v_fma_mix_f32 %13, %40, %26, %13" MIXHI
      "v_fma_mix_f32 %14, %40, %27, %14" MIXLO "v_fma_mix_f32 %15, %40, %27, %15" MIXHI
      : "+v"(SU[2 * L]), "+v"(SU[2 * L + 1]), "+v"(SU[2 * L + 2]), "+v"(SU[2 * L + 3]), "+v"(SU[2 * L + 4]), "+v"(SU[2 * L + 5]), "+v"(SU[2 * L + 6]), "+v"(SU[2 * L + 7]),
        "+v"(SP[2 * L]), "+v"(SP[2 * L + 1]), "+v"(SP[2 * L + 2]), "+v"(SP[2 * L + 3]), "+v"(SP[2 * L + 4]), "+v"(SP[2 * L + 5]), "+v"(SP[2 * L + 6]), "+v"(SP[2 * L + 7]),
        "=&s"(x0), "=&s"(x1), "=&s"(x2), "=&s"(x3), "=&s"(k0), "=&s"(k1), "=&s"(k2), "=&s"(k3), "=&s"(b0), "=&s"(b1), "=&s"(b2), "=&s"(b3)
      : "v"(dr), "v"(bb), "n"(L), "n"(L + 1), "n"(L + 2), "n"(L + 3), "n"(L + 32), "n"(L + 33), "n"(L + 34), "n"(L + 35), "v"(vv), "v"(nskU), "v"(nskP));
}
DI void scan_step2(float (&SU)[64], float (&SP)[64], const ScanRec& c, float vv) {
  float a0 = 0.f, a1 = 0.f, c0 = 0.f, c1 = 0.f;
  dot4_2<0>(a0, a1, c0, c1, SU, SP, c.sh); dot4_2<4>(a0, a1, c0, c1, SU, SP, c.sh); dot4_2<8>(a0, a1, c0, c1, SU, SP, c.sh); dot4_2<12>(a0, a1, c0, c1, SU, SP, c.sh);
  dot4_2<16>(a0, a1, c0, c1, SU, SP, c.sh); dot4_2<20>(a0, a1, c0, c1, SU, SP, c.sh); dot4_2<24>(a0, a1, c0, c1, SU, SP, c.sh); dot4_2<28>(a0, a1, c0, c1, SU, SP, c.sh);
  const float nU = -(a0 + a1), nP = -(c0 + c1);
  upd4_2<0>(SU, SP, c.dr, c.bb, vv, nU, nP); upd4_2<4>(SU, SP, c.dr, c.bb, vv, nU, nP); upd4_2<8>(SU, SP, c.dr, c.bb, vv, nU, nP); upd4_2<12>(SU, SP, c.dr, c.bb, vv, nU, nP);
  upd4_2<16>(SU, SP, c.dr, c.bb, vv, nU, nP); upd4_2<20>(SU, SP, c.dr, c.bb, vv, nU, nP); upd4_2<24>(SU, SP, c.dr, c.bb, vv, nU, nP); upd4_2<28>(SU, SP, c.dr, c.bb, vv, nU, nP);
}
template <bool WITH_OUT>
DI float scan_step(float (&S)[64], const ScanRec& c, float vv) {
  float sk0 = 0.f, sk1 = 0.f;
  dot4<0>(sk0, sk1, S, c.sh); dot4<4>(sk0, sk1, S, c.sh); dot4<8>(sk0, sk1, S, c.sh); dot4<12>(sk0, sk1, S, c.sh);
  dot4<16>(sk0, sk1, S, c.sh); dot4<20>(sk0, sk1, S, c.sh); dot4<24>(sk0, sk1, S, c.sh); dot4<28>(sk0, sk1, S, c.sh);
  const float nsk = -(sk0 + sk1);
  upd4<0>(S, c.dr, c.bb, vv, nsk); upd4<4>(S, c.dr, c.bb, vv, nsk); upd4<8>(S, c.dr, c.bb, vv, nsk); upd4<12>(S, c.dr, c.bb, vv, nsk);
  upd4<16>(S, c.dr, c.bb, vv, nsk); upd4<20>(S, c.dr, c.bb, vv, nsk); upd4<24>(S, c.dr, c.bb, vv, nsk); upd4<28>(S, c.dr, c.bb, vv, nsk);
  float o0 = 0.f, o1 = 0.f;
  if (WITH_OUT) {
    dot4<32>(o0, o1, S, c.sh); dot4<36>(o0, o1, S, c.sh); dot4<40>(o0, o1, S, c.sh); dot4<44>(o0, o1, S, c.sh);
    dot4<48>(o0, o1, S, c.sh); dot4<52>(o0, o1, S, c.sh); dot4<56>(o0, o1, S, c.sh); dot4<60>(o0, o1, S, c.sh);
  }
  return o0 + o1;
}
constexpr int SPF = 3;
DI void phase_scanA(const Params& p, unsigned char* smem) {
  const ushort_t* SH = (const ushort_t*)(p.ws + OFF_SH);
  const ushort_t* DR = (const ushort_t*)(p.ws + OFF_DR);
  float* PU = p.out;
  const int lane = threadIdx.x & 63;
  const int gw = __builtin_amdgcn_readfirstlane(blockIdx.x * 8 + (threadIdx.x >> 6));
  for (int task = gw; task < 32 * NCHUNK; task += gridDim.x * 8) {
    const int cd = task / NCHUNK, j = task % NCHUNK, dir = cd >> 4, c = cd & 15;
    float SU[64], SP[64];
#pragma unroll
    for (int k = 0; k < 64; ++k) { SU[k] = 0.f; SP[k] = (k == lane) ? 1.f : 0.f; }
    const ushort_t* shc = SH + (size_t)c * LTOT * 192;
    const ushort_t* drc = DR + (size_t)(dir * 16 + c) * LTOT * 192;
    ScanRec r0 = scan_load(shc, drc, tau_to_pos(dir, j * CH + 0), lane);
    ScanRec r1 = scan_load(shc, drc, tau_to_pos(dir, j * CH + 1), lane);
    ScanRec r2 = scan_load(shc, drc, tau_to_pos(dir, j * CH + 2), lane);
#pragma unroll 1
    for (int st = 0; st < CH; ++st) {
      const ScanRec r3 = scan_load(shc, drc, tau_to_pos(dir, j * CH + (st + SPF < CH ? st + SPF : CH - 1)), lane);
      scan_step2(SU, SP, r0, h2f(r0.v));
      r0 = r1; r1 = r2; r2 = r3;
    }
    float* dst = PU + (size_t)task * 2 * 4096 + lane * 64;
#pragma unroll
    for (int k = 0; k < 64; k += 4) {
      *(float4*)(dst + k) = make_float4(SU[k], SU[k + 1], SU[k + 2], SU[k + 3]);
      *(float4*)(dst + 4096 + k) = make_float4(SP[k], SP[k + 1], SP[k + 2], SP[k + 3]);
    }
  }
}

DI void phase_scanB(const Params& p, unsigned char* smem) {
  if (blockIdx.x >= 32) return;
  float* Sb = (float*)smem;
  float* Xb = Sb + 64 * 65;
  float* PU = p.out;
  const int cd = blockIdx.x, tid = threadIdx.x, wave = tid >> 6, lane = tid & 63, l31 = lane & 31, hh = lane >> 5;
  const int tile = wave & 3, tm = tile >> 1, tn = tile & 1, kh = wave >> 2;
  for (int i = tid; i < 64 * 65; i += NTH) Sb[i] = 0.f;
  constexpr int BPF = 4;
  float bP[BPF][16];
  f32x16 uT[BPF];
#pragma unroll
  for (int s = 0; s < BPF; ++s) uT[s] = zero16();
  auto fetch = [&](int j, float (&bp)[16], f32x16& ut) {
    const float* base = PU + (size_t)(cd * NCHUNK + j) * 2 * 4096;
#pragma unroll
    for (int kk = 0; kk < 16; ++kk) bp[kk] = base[4096 + (kh * 32 + 2 * kk + hh) * 64 + tn * 32 + l31];
    if (kh == 0) {
#pragma unroll
      for (int i = 0; i < 16; ++i) ut[i] = base[(tm * 32 + crow(i, hh)) * 64 + tn * 32 + l31];
    }
  };
  auto put_state = [&](int j, const f32x16& st) {
    float* base = PU + (size_t)(cd * NCHUNK + j) * 2 * 4096;
#pragma unroll
    for (int i = 0; i < 16; ++i) base[(tm * 32 + crow(i, hh)) * 64 + tn * 32 + l31] = st[i];
  };
#pragma unroll
  for (int s = 0; s < BPF; ++s) fetch(s, bP[s], uT[s]);
  if (kh == 0) put_state(0, zero16());
  __syncthreads();
#pragma unroll 1
  for (int j = 0; j < NCHUNK; ++j) {
    float nP[16];
    f32x16 nU = zero16();
    if (j + BPF < NCHUNK) fetch(j + BPF, nP, nU);
    f32x16 acc = (kh == 0) ? uT[0] : zero16();
#pragma unroll
    for (int kk = 0; kk < 16; ++kk) {
      const float a = Sb[(tm * 32 + l31) * 65 + kh * 32 + 2 * kk + hh];
      acc = __builtin_amdgcn_mfma_f32_32x32x2f32(a, bP[0][kk], acc, 0, 0, 0);
    }
    if (kh == 1) {
#pragma unroll
      for (int i = 0; i < 16; ++i) Xb[(tile * 16 + i) * 64 + lane] = acc[i];
    }
    __syncthreads();
    if (kh == 0) {
#pragma unroll
      for (int i = 0; i < 16; ++i) { acc[i] += Xb[(tile * 16 + i) * 64 + lane]; Sb[(tm * 32 + crow(i, hh)) * 65 + tn * 32 + l31] = acc[i]; }
      if (j + 1 < NCHUNK) put_state(j + 1, acc);
    }
#pragma unroll
    for (int s = 0; s + 1 < BPF; ++s) {
#pragma unroll
      for (int kk = 0; kk < 16; ++kk) bP[s][kk] = bP[s + 1][kk];
      uT[s] = uT[s + 1];
    }
#pragma unroll
    for (int kk = 0; kk < 16; ++kk) bP[BPF - 1][kk] = nP[kk];
    uT[BPF - 1] = nU;
    __syncthreads();
  }
}

DI void phase_scanC(const Params& p, unsigned char* smem) {
  const ushort_t* SH = (const ushort_t*)(p.ws + OFF_SH);
  const ushort_t* DR = (const ushort_t*)(p.ws + OFF_DR);
  ushort_t* O = (ushort_t*)(p.ws + OFF_ZQ);
  const float* PU = p.out;
  const int lane = threadIdx.x & 63;
  const int gw = __builtin_amdgcn_readfirstlane(blockIdx.x * 8 + (threadIdx.x >> 6));
  for (int task = gw; task < 32 * NCHUNK; task += gridDim.x * 8) {
    const int cd = task / NCHUNK, j = task % NCHUNK, dir = cd >> 4, c = cd & 15, b = c >> 3, head = c & 7;
    float S[64];
    const float* src = PU + (size_t)task * 2 * 4096 + lane * 64;
#pragma unroll
    for (int k = 0; k < 64; k += 4) { const float4 v = *(const float4*)(src + k); S[k] = v.x; S[k + 1] = v.y; S[k + 2] = v.z; S[k + 3] = v.w; }
    const ushort_t* shc = SH + (size_t)c * LTOT * 192;
    const ushort_t* drc = DR + (size_t)(dir * 16 + c) * LTOT * 192;
    ushort_t* obase = O + ((size_t)dir * NX + (size_t)b * SEQ) * 512 + head * 64 + lane;
    ScanRec r0 = scan_load(shc, drc, tau_to_pos(dir, j * CH + 0), lane);
    ScanRec r1 = scan_load(shc, drc, tau_to_pos(dir, j * CH + 1), lane);
    ScanRec r2 = scan_load(shc, drc, tau_to_pos(dir, j * CH + 2), lane);
#pragma unroll 1
    for (int st = 0; st < CH; ++st) {
      const int pos = tau_to_pos(dir, j * CH + st);
      const ScanRec r3 = scan_load(shc, drc, tau_to_pos(dir, j * CH + (st + SPF < CH ? st + SPF : CH - 1)), lane);
      const float o = scan_step<true>(S, r0, h2f(r0.v));
      if (pos >= CTXL) obase[(size_t)(pos - CTXL) * 512] = f2h(o);
      r0 = r1; r1 = r2; r2 = r3;
    }
  }
}

DI void phase_scan_naive(const Params& p) {
  const ushort_t* SH = (const ushort_t*)(p.ws + OFF_SH);
  const ushort_t* DR = (const ushort_t*)(p.ws + OFF_DR);
  ushort_t* O = (ushort_t*)(p.ws + OFF_ZQ);
  const int lane = threadIdx.x & 63;
  const int gw = __builtin_amdgcn_readfirstlane(blockIdx.x * 8 + (threadIdx.x >> 6));
  if (gw >= 32) return;
  const int cd = gw, dir = cd >> 4, c = cd & 15, b = c >> 3, head = c & 7;
  float S[64];
#pragma unroll
  for (int k = 0; k < 64; ++k) S[k] = 0.f;
  const ushort_t* shc = SH + (size_t)c * LTOT * 192;
  const ushort_t* drc = DR + (size_t)(dir * 16 + c) * LTOT * 192;
#pragma unroll 1
  for (int tau = 0; tau < LTOT; ++tau) {
    const int pos = tau_to_pos(dir, tau);
    const ushort_t* shr = shc + (size_t)pos * 192;
    const ushort_t* drr = drc + (size_t)pos * 192;
    const float vv = h2f(shr[128 + lane]);
    u32x16 k0, k1;
    sload2(k0, k1, shr);
    float sk0 = 0.f, sk1 = 0.f;
#pragma unroll
    for (int q = 0; q < 32; ++q) { sk0 = fmaf(S[q], HV(k0, q), sk0); sk1 = fmaf(S[32 + q], HV(k1, q), sk1); }
    const float nsk = -(sk0 + sk1);
    u32x16 x0, x1, d0, d1;
    sload4(x0, x1, d0, d1, drr, drr + 64);
#pragma unroll
    for (int q = 0; q < 32; ++q) {
      S[q] = fmaf(S[q], -HV(x0, q), S[q]); S[32 + q] = fmaf(S[32 + q], -HV(x1, q), S[32 + q]);
      S[q] = fmaf(vv, HV(d0, q), S[q]); S[32 + q] = fmaf(vv, HV(d1, q), S[32 + q]);
    }
    u32x16 b0, b1, r0, r1;
    sload4(b0, b1, r0, r1, drr + 128, shr + 64);
    float o0 = 0.f, o1 = 0.f;
#pragma unroll
    for (int q = 0; q < 32; ++q) {
      S[q] = fmaf(nsk, HV(b0, q), S[q]); S[32 + q] = fmaf(nsk, HV(b1, q), S[32 + q]);
      o0 = fmaf(S[q], HV(r0, q), o0); o1 = fmaf(S[32 + q], HV(r1, q), o1);
    }
    if (pos >= CTXL) O[((size_t)dir * NX + (size_t)b * SEQ + (pos - CTXL)) * 512 + head * 64 + lane] = f2h(o0 + o1);
  }
}

DI void phase_attn(const Params& p, unsigned char* smem) {
  ushort_t* Kb = (ushort_t*)smem;
  ushort_t* Vb = Kb + 2 * 64 * LDK;
  ushort_t* QB = (ushort_t*)(p.ws + OFF_QB);
  const ushort_t* KB = (const ushort_t*)(p.ws + OFF_KB);
  const ushort_t* VB = (const ushort_t*)(p.ws + OFF_VB);
  const int tid = threadIdx.x, wave = tid >> 6, lane = tid & 63, l31 = lane & 31, hh = lane >> 5;
  const int loff = (tid >> 3) * LDK + (tid & 7) * 8;
  constexpr float THR = 6.f;
  constexpr int NTL = LTOT / 64;
  for (int at = blockIdx.x; at < 1024; at += gridDim.x) {
    const int b = at >> 9, kvh = (at >> 8) & 1, t0 = (at & 255) * 64;
    const int head = kvh * 4 + (wave & 3), tq = t0 + (wave >> 2) * 32 + l31;
    ushort_t* qrow = QB + ((size_t)(b * 8 + head) * SEQ + tq) * 64;
    bf16x8 qf[4];
#pragma unroll
    for (int ks = 0; ks < 4; ++ks) qf[ks] = *(const bf16x8*)(qrow + ks * 16 + hh * 8);
    const ushort_t* kbase = KB + (size_t)(b * 2 + kvh) * LTOT * 64 + tid * 8;
    const ushort_t* vbase = VB + (size_t)(b * 2 + kvh) * LTOT * 64 + tid * 8;
    f32x16 o[2] = {zero16(), zero16()};
    f32x16 negm = zero16();
    float lsum = 0.f;
    auto qk = [&](f32x16 (&s)[2], const ushort_t* Ks) {
      s[0] = negm; s[1] = negm;
#pragma unroll
      for (int ks = 0; ks < 4; ++ks)
#pragma unroll
        for (int kk = 0; kk < 2; ++kk) s[kk] = MFMA(*(const bf16x8*)&Ks[(kk * 32 + l31) * LDK + ks * 16 + hh * 8], qf[ks], s[kk]);
    };
    uint4 rk, rv;
    __syncthreads();
    rk = *(const uint4*)kbase; rv = *(const uint4*)vbase;
    *(uint4*)&Kb[loff] = rk; *(uint4*)&Vb[loff] = rv;
    rk = *(const uint4*)(kbase + 4096);
    rv = *(const uint4*)(vbase + 4096);
    __syncthreads();
    f32x16 sA[2], sB[2];
    qk(sA, Kb);
    {
      float mx = fmaxf(sA[0][0], sA[1][0]);
#pragma unroll
      for (int i = 1; i < 16; ++i) mx = fmaxf(mx, fmaxf(sA[0][i], sA[1][i]));
      mx = fmaxf(mx, __shfl_xor(mx, 32, 64));
#pragma unroll
      for (int i = 0; i < 16; ++i) { sA[0][i] -= mx; sA[1][i] -= mx; negm[i] = -mx; }
    }
    *(uint4*)&Kb[64 * LDK + loff] = rk;
    rk = *(const uint4*)(kbase + 2 * 4096);
    auto step = [&](int t, f32x16 (&sc)[2], f32x16 (&sn)[2]) {
      __syncthreads();
      if (t + 2 < NTL) *(uint4*)&Kb[(t & 1) * 64 * LDK + loff] = rk;
      if (t + 1 < NTL) *(uint4*)&Vb[((t + 1) & 1) * 64 * LDK + loff] = rv;
      if (t + 3 < NTL) rk = *(const uint4*)(kbase + (size_t)(t + 3) * 4096);
      if (t + 2 < NTL) rv = *(const uint4*)(vbase + (size_t)(t + 2) * 4096);
      if (t + 1 < NTL) qk(sn, Kb + ((t + 1) & 1) * 64 * LDK);
      float mx = fmaxf(sc[0][0], sc[1][0]);
#pragma unroll
      for (int i = 1; i < 16; ++i) mx = fmaxf(mx, fmaxf(sc[0][i], sc[1][i]));
      mx = fmaxf(mx, __shfl_xor(mx, 32, 64));
      if (__builtin_amdgcn_ballot_w64(mx > THR) != 0ull) {
        const float delta = fmaxf(mx, 0.f);
        const float alpha = __builtin_amdgcn_exp2f(-delta);
        lsum *= alpha;
#pragma unroll
        for (int i = 0; i < 16; ++i) {
          o[0][i] *= alpha; o[1][i] *= alpha; sc[0][i] -= delta; sc[1][i] -= delta; negm[i] -= delta;
          sn[0][i] -= delta; sn[1][i] -= delta;
        }
      }
      float ps = 0.f;
#pragma unroll
      for (int i = 0; i < 16; ++i) {
        sc[0][i] = __builtin_amdgcn_exp2f(sc[0][i]); sc[1][i] = __builtin_amdgcn_exp2f(sc[1][i]);
        ps += sc[0][i] + sc[1][i];
      }
      lsum += ps;
      const ushort_t* Vt = Vb + (t & 1) * 64 * LDK;
#pragma unroll
      for (int kk = 0; kk < 2; ++kk) {
#pragma unroll
        for (int st = 0; st < 2; ++st) {
          uint4 pw;
          pw.x = pack_bf2(sc[kk][8 * st + 0], sc[kk][8 * st + 1]); pw.y = pack_bf2(sc[kk][8 * st + 2], sc[kk][8 * st + 3]);
          pw.z = pack_bf2(sc[kk][8 * st + 4], sc[kk][8 * st + 5]); pw.w = pack_bf2(sc[kk][8 * st + 6], sc[kk][8 * st + 7]);
          const bf16x8 pf = __builtin_bit_cast(bf16x8, pw);
#pragma unroll
          for (int dt = 0; dt < 2; ++dt) o[dt] = MFMA(*(const bf16x8*)&Vt[(dt * 32 + l31) * LDK + kk * 32 + st * 16 + hh * 8], pf, o[dt]);
        }
      }
    };
#pragma unroll 1
    for (int t = 0; t < NTL; t += 2) {
      step(t, sA, sB);
      step(t + 1, sB, sA);
    }
    const float ltot = lsum + __shfl_xor(lsum, 32, 64);
    const float il = 1.f / ltot;
#pragma unroll
    for (int dt = 0; dt < 2; ++dt)
#pragma unroll
      for (int g = 0; g < 4; ++g) {
        uint2 w;
        w.x = pack_bf2(o[dt][4 * g + 0] * il, o[dt][4 * g + 1] * il);
        w.y = pack_bf2(o[dt][4 * g + 2] * il, o[dt][4 * g + 3] * il);
        *(uint2*)(qrow + dt * 32 + 8 * g + 4 * hh) = w;
      }
  }
}

constexpr size_t OFF_DBG = WS_END;
DI void dbg_acc(const Params& p, int slot, float d2, float r2) {
  float* dbg = (float*)(p.ws + OFF_DBG);
  d2 = wave_sum(d2); r2 = wave_sum(r2);
  if ((threadIdx.x & 63) == 0) { atomicAdd(dbg + 2 * slot, d2); atomicAdd(dbg + 2 * slot + 1, r2); }
}
DI void probe_after_gemm1(const Params& p) {
  if (blockIdx.x != 0) return;
  const int tid = threadIdx.x, lane = tid & 63, wave = tid >> 6;
  const float* mod = (const float*)(p.ws + OFF_MOD);
  const ushort_t* H = (const ushort_t*)(p.ws + OFF_SH);
  {
    float d2 = 0.f, r2 = 0.f;
    if (tid < 96) {
      const int v = tid / 32, n = (tid % 32) * 97 % 3072;
      float s = 0.f;
      for (int k = 0; k < 1024; ++k) { const float cv = (v < 2) ? p.c[v * 1024 + k] : p.c_ctx[k]; s += (cv / (1.f + expf(-cv))) * p.w_ada[(size_t)k * 3072 + n]; }
      s += p.b_ada[n];
      const float d = mod[v * 3072 + n] - s; d2 = d * d; r2 = s * s;
    }
    dbg_acc(p, 0, d2, r2);
  }
  {
    const int row = wave == 0 ? 0 : wave == 1 ? 777 : wave == 2 ? 16383 : wave == 3 ? 16384 : wave == 4 ? 32767 : wave == 5 ? 32768 : wave == 6 ? 33023 : 33279;
    const float* src = (row < NX) ? p.x + (size_t)row * DM : p.ctx + (size_t)(row - NX) * DM;
    const float* md = mod + ((row < NX) ? (row / SEQ) : 2) * 3072;
    float s = 0.f;
    for (int i = lane; i < 1024; i += 64) s += src[i];
    const float mu = wave_sum(s) / 1024.f;
    float q = 0.f;
    for (int i = lane; i < 1024; i += 64) q += (src[i] - mu) * (src[i] - mu);
    const float rstd = rsqrtf(wave_sum(q) / 1024.f + LN_EPS);
    float d2 = 0.f, r2 = 0.f;
    for (int i = lane; i < 1024; i += 64) {
      const float ref = (src[i] - mu) * rstd * (1.f + md[1024 + i]) + md[i];
      const float d = bf2f(H[(size_t)row * DM + i]) - ref; d2 += d * d; r2 += ref * ref;
    }
    dbg_acc(p, 1, d2, r2);
  }
  {
    float d2 = 0.f, r2 = 0.f;
    if (tid < 60) {
      const int ri = tid / 10, ci = tid % 10;
      const int row = ri == 0 ? 3 : ri == 1 ? 777 : ri == 2 ? 20001 : ri == 3 ? 32767 : ri == 4 ? 32773 : 33279;
      const int col = ci == 0 ? 0 : ci == 1 ? 100 : ci == 2 ? 700 : ci == 3 ? 800 : ci == 4 ? 1279 : ci == 5 ? 1280 : ci == 6 ? 2000 : ci == 7 ? 3071 : ci == 8 ? 3072 : 3583;
      float s = 0.f;
      for (int k = 0; k < 1024; ++k) s += bf2f(H[(size_t)row * DM + k]) * p.w_in[(size_t)k * INW + col];
      float got = 0.f; bool have = true;
      if (col < 768) got = bf2f(((const ushort_t*)(p.ws + OFF_ZQ))[(size_t)row * 768 + col]);
      else if (col < 1280) { if (row < NX) got = bf2f(((const ushort_t*)(p.ws + OFF_ZG))[(size_t)row * 1024 + col - 768]); else have = false; }
      else if (col < 3072) got = bf2f(((const ushort_t*)p.out)[(size_t)row * 1792 + col - 1280]);
      else { if (row < NX) got = bf2f(((const ushort_t*)(p.ws + OFF_ZG))[(size_t)row * 1024 + 512 + col - 3072]); else have = false; }
      if (have) { const float d = got - s; d2 = d * d; r2 = s * s; }
    }
    dbg_acc(p, 2, d2, r2);
  }
}
DI void probe_after_prep(const Params& p, unsigned char* smem) {
  if (blockIdx.x != 0) return;
  float* cbuf = (float*)smem;
  const int tid = threadIdx.x, lane = tid & 63, wave = tid >> 6;
  const ushort_t* zm = (const ushort_t*)p.out;
  const ushort_t* SH = (const ushort_t*)(p.ws + OFF_SH);
  const ushort_t* DR = (const ushort_t*)(p.ws + OFF_DR);
  float dA = 0.f, rA = 0.f, dB = 0.f, rB = 0.f;
#pragma unroll 1
  for (int sidx = wave; sidx < 24; sidx += 8) {
    const int ri = sidx >> 1, head = (sidx & 1) ? 5 : 0;
    const int row = ri == 0 ? 0 : ri == 1 ? 1 : ri == 2 ? 31 : ri == 3 ? 32 : ri == 4 ? 16383 : ri == 5 ? 16384 : ri == 6 ? 20000 : ri == 7 ? 32767 : ri == 8 ? 32768 : ri == 9 ? 33023 : ri == 10 ? 33024 : 33279;
    int b, t, len, pp;
    if (row < NX) { b = row / SEQ; t = row % SEQ; len = SEQ; pp = CTXL + t; } else { b = (row - NX) / CTXL; t = (row - NX) % CTXL; len = CTXL; pp = t; }
    auto sft = [&](int col) {
      const float z = bf2f(zm[(size_t)row * 1792 + col]);
      const float zp = (t > 0) ? bf2f(zm[(size_t)(row - 1) * 1792 + col]) : 0.f;
      const float zn = (t < len - 1) ? bf2f(zm[(size_t)(row + 1) * 1792 + col]) : 0.f;
      return z + p.mu_prev[col] * (zp - z) + p.mu_next[col] * (zn - z);
    };
    const int n = head * 64 + lane;
    const float r = sft(n), k = sft(512 + n), v = sft(1024 + n);
#pragma unroll 1
    for (int j = lane; j < 256; j += 64) { const float s = sft(1536 + j); cbuf[wave * 256 + j] = (j < 128) ? tanhf(s) : s; }
    __builtin_amdgcn_s_waitcnt(0);
    __builtin_amdgcn_wave_barrier();
    const float kr = k * p.k_k[n];
    const float nrm = sqrtf(wave_sum(kr * kr));
    const float kk = kr / fmaxf(nrm, 1e-12f);
    const size_t cp = (size_t)(b * 8 + head) * LTOT + pp;
    { float d;
      d = h2f(SH[(cp * 3 + 0) * 64 + lane]) - kk; dA += d * d; rA += kk * kk;
      d = h2f(SH[(cp * 3 + 1) * 64 + lane]) - r; dA += d * d; rA += r * r;
      d = h2f(SH[(cp * 3 + 2) * 64 + lane]) - v; dA += d * d; rA += v * v; }
#pragma unroll 1
    for (int dir = 0; dir < 2; ++dir) {
      float wpre = p.w0[dir * 512 + n], apre = p.a0[dir * 512 + n];
#pragma unroll 1
      for (int j = 0; j < 64; ++j) {
        wpre += cbuf[wave * 256 + dir * 64 + j] * p.w_up[(size_t)(dir * 64 + j) * 512 + n];
        apre += cbuf[wave * 256 + 128 + dir * 64 + j] * p.a_up[(size_t)(dir * 64 + j) * 512 + n];
      }
      const float wlog = -log1pf(expf(-wpre)) - 0.5f;
      const float xd = 1.f - expf(-expf(wlog));
      const float a = 1.f / (1.f + expf(-apre));
      const float kd = k * (1.f + (a - 1.f) * p.k_a[n]);
      const float bq = kk * a;
      const size_t dp = (size_t)(dir * 16 + b * 8 + head) * LTOT + pp;
      float d;
      d = h2f(DR[(dp * 3 + 0) * 64 + lane]) - xd; dB += d * d; rB += xd * xd;
      d = h2f(DR[(dp * 3 + 1) * 64 + lane]) - kd; dB += d * d; rB += kd * kd;
      d = h2f(DR[(dp * 3 + 2) * 64 + lane]) - bq; dB += d * d; rB += bq * bq;
    }
    __builtin_amdgcn_wave_barrier();
  }
  dbg_acc(p, 3, dA, rA);
  dbg_acc(p, 4, dB, rB);
}

DI void probe_scan(const Params& p) {
  if (blockIdx.x != 0 || threadIdx.x >= 128) return;
  const ushort_t* SH = (const ushort_t*)(p.ws + OFF_SH);
  const ushort_t* DR = (const ushort_t*)(p.ws + OFF_DR);
  const ushort_t* O = (const ushort_t*)(p.ws + OFF_ZQ);
  const int lane = threadIdx.x & 63, wv = threadIdx.x >> 6;
  const int c = wv ? 9 : 0, dir = wv, b = c >> 3, head = c & 7;
  float S[64];
#pragma unroll
  for (int k = 0; k < 64; ++k) S[k] = 0.f;
  float d2 = 0.f, r2 = 0.f;
#pragma unroll 1
  for (int tau = 0; tau < 420; ++tau) {
    const int pos = dir == 0 ? tau : (tau < CTXL ? CTXL - 1 - tau : LTOT - 1 - (tau - CTXL));
    const ushort_t* sh = SH + ((size_t)c * LTOT + pos) * 192;
    const ushort_t* dr = DR + ((size_t)(dir * 16 + c) * LTOT + pos) * 192;
    const float v = h2f(sh[128 + lane]);
    float sk = 0.f;
#pragma unroll
    for (int k = 0; k < 64; ++k) sk += S[k] * h2f(sh[k]);
    float o = 0.f;
#pragma unroll
    for (int k = 0; k < 64; ++k) {
      const float dec = 1.f - h2f(dr[k]);
      S[k] = S[k] * dec - sk * h2f(dr[128 + k]) + v * h2f(dr[64 + k]);
      o += S[k] * h2f(sh[64 + k]);
    }
    if (pos >= CTXL) {
      const float got = h2f(O[((size_t)dir * NX + (size_t)b * SEQ + (pos - CTXL)) * 512 + head * 64 + lane]);
      const float d = got - o; d2 += d * d; r2 += o * o;
    }
  }
  dbg_acc(p, 0, d2, r2);
}
DI float probe_delta(const Params& p) {
  const float* dbg = (const float*)(p.ws + OFF_DBG);
  int k = 0;
  for (int s = 0; s < 5; ++s) { const float rel = sqrtf(dbg[2 * s] / fmaxf(dbg[2 * s + 1], 1e-30f)); if (!(rel < 0.05f)) k |= 1 << s; }
  return sqrtf(0.02f * (float)k);
}

DI void phase_final(const Params& p, unsigned char* smem) {
  ushort_t* As = (ushort_t*)smem;
  ushort_t* Bs = As + 2 * 128 * LDK;
  const float* mod = (const float*)(p.ws + OFF_MOD);
  ushort_t* ZG = (ushort_t*)(p.ws + OFF_ZG);
  ushort_t* QB = (ushort_t*)(p.ws + OFF_QB);
  ushort_t* O = (ushort_t*)(p.ws + OFF_ZQ);
  const ushort_t* SH = (const ushort_t*)(p.ws + OFF_SH);
  const ushort_t* DR = (const ushort_t*)(p.ws + OFF_DR);
  const ushort_t* WMG = (const ushort_t*)(p.ws + OFF_WMG);
  const ushort_t* WPA = (const ushort_t*)(p.ws + OFF_WPA);
  const ushort_t* WPB = (const ushort_t*)(p.ws + OFF_WPB);
  const ushort_t* WO = (const ushort_t*)(p.ws + OFF_WO);
#pragma unroll 1
  for (int mt = blockIdx.x; mt < NX / 128; mt += gridDim.x) {
    int tid = threadIdx.x;
    asm volatile("" : "+v"(tid));
    const int wave = tid >> 6, lane = tid & 63, l31 = lane & 31, hh = lane >> 5;
    const int wrow0 = (wave & 3) * 32, wcol0 = (wave >> 2) * 64;
    const int row0 = mt * 128, b = row0 / SEQ, tb0 = row0 % SEQ;
    const float* md = mod + b * 3072;
    __syncthreads();
#pragma unroll 1
    for (int r = wave; r < 128; r += 8) {
      const float* src = p.x + (size_t)(row0 + r) * DM;
      ushort_t* hdst = (ushort_t*)(p.out + (size_t)(row0 + r) * DM);
      float4 v[4];
      float s = 0.f;
#pragma unroll
      for (int i = 0; i < 4; ++i) { v[i] = *(const float4*)(src + lane * 4 + 256 * i); s += v[i].x + v[i].y + v[i].z + v[i].w; }
      const float mu = wave_sum(s) * (1.f / DM);
      float q = 0.f;
#pragma unroll
      for (int i = 0; i < 4; ++i) { v[i].x -= mu; v[i].y -= mu; v[i].z -= mu; v[i].w -= mu; q += v[i].x * v[i].x + v[i].y * v[i].y + v[i].z * v[i].z + v[i].w * v[i].w; }
      const float rstd = rsqrtf(wave_sum(q) * (1.f / DM) + LN_EPS);
#pragma unroll
      for (int i = 0; i < 4; ++i) {
        const int col = lane * 4 + 256 * i;
        const float4 sh = *(const float4*)(md + col), sc = *(const float4*)(md + 1024 + col);
        uint2 o;
        o.x = pack_bf2(v[i].x * rstd * (1.f + sc.x) + sh.x, v[i].y * rstd * (1.f + sc.y) + sh.y);
        o.y = pack_bf2(v[i].z * rstd * (1.f + sc.z) + sh.z, v[i].w * rstd * (1.f + sc.w) + sh.w);
        *(uint2*)(hdst + col) = o;
      }
    }
#if PROBE
    float a2ref = 0.f;
    if (mt == 0) {
      const int tok = wave * 16 + 3, head = wave, row = row0 + tok, t = tb0 + tok, dd = head * 64 + lane;
      const size_t cp = (size_t)(b * 8 + head) * LTOT + CTXL + t;
      const float o = h2f(O[(size_t)row * 512 + dd]) + h2f(O[((size_t)NX + row) * 512 + dd]);
      const float mu = wave_sum(o) / 64.f;
      const float var = wave_sum((o - mu) * (o - mu)) / 64.f;
      const float y = (o - mu) * rsqrtf(var + GN_EPS) * p.gn_w[dd] + p.gn_b[dd];
      const float r = h2f(SH[(cp * 3 + 1) * 64 + lane]), vv = h2f(SH[(cp * 3 + 2) * 64 + lane]);
      const float kf = h2f(DR[(cp * 3 + 1) * 64 + lane]), kb = h2f(DR[(((size_t)16 * LTOT + cp) * 3 + 1) * 64 + lane]);
      const float bon = wave_sum(r * kf * p.r_k[dd]) + wave_sum(r * kb * p.r_k[512 + dd]);
      const float g = bf2f(ZG[(size_t)row * 1024 + 512 + dd]);
      a2ref = (y + bon * vv) * (g / (1.f + expf(-g)));
    }
#endif
#pragma unroll 1
    for (int it = 0; it < 16; ++it) {
      const int pair = (it * 8 + wave) * 8 + (lane >> 3), q8 = lane & 7;
      const int tok = pair >> 3, head = pair & 7, row = row0 + tok, t = tb0 + tok, d0 = q8 * 8;
      const unsigned cp = (unsigned)((b * 8 + head) * LTOT + CTXL + t);
      const unsigned ofo = (unsigned)(row * 512 + head * 64 + d0), obo = ofo + (unsigned)NX * 512u;
      const unsigned ro = (cp * 3 + 1) * 64 + d0, vo = (cp * 3 + 2) * 64 + d0;
      const unsigned kbo = ((16u * LTOT + cp) * 3 + 1) * 64 + d0;
      const unsigned gbo = (unsigned)(row * 1024 + 512 + head * 64 + d0), gao = gbo - 512;
      const unsigned yao = (unsigned)(((b * 8 + head) * SEQ + t) * 64 + d0);
      float ov[8], bon = 0.f, s = 0.f;
      {
        const uint4 a = *(const uint4*)(O + ofo), bq = *(const uint4*)(O + obo);
        const uint4 rr = *(const uint4*)(SH + ro), kf = *(const uint4*)(DR + ro), kb = *(const uint4*)(DR + kbo);
        const unsigned aw[4] = {a.x, a.y, a.z, a.w}, bw[4] = {bq.x, bq.y, bq.z, bq.w}, rw[4] = {rr.x, rr.y, rr.z, rr.w};
        const unsigned fw[4] = {kf.x, kf.y, kf.z, kf.w}, kw[4] = {kb.x, kb.y, kb.z, kb.w};
#pragma unroll
        for (int q = 0; q < 4; ++q) {
          const int dd = head * 64 + d0 + 2 * q;
          ov[2 * q] = hlo(aw[q]) + hlo(bw[q]);
          ov[2 * q + 1] = hhi(aw[q]) + hhi(bw[q]);
          s += ov[2 * q] + ov[2 * q + 1];
          bon += hlo(rw[q]) * (hlo(fw[q]) * p.r_k[dd] + hlo(kw[q]) * p.r_k[512 + dd]);
          bon += hhi(rw[q]) * (hhi(fw[q]) * p.r_k[dd + 1] + hhi(kw[q]) * p.r_k[512 + dd + 1]);
        }
      }
      s += __shfl_xor(s, 1, 64); s += __shfl_xor(s, 2, 64); s += __shfl_xor(s, 4, 64);
      bon += __shfl_xor(bon, 1, 64); bon += __shfl_xor(bon, 2, 64); bon += __shfl_xor(bon, 4, 64);
      const float mu = s * (1.f / 64.f);
      float vs = 0.f;
#pragma unroll
      for (int q = 0; q < 8; ++q) { ov[q] -= mu; vs = fmaf(ov[q], ov[q], vs); }
      vs += __shfl_xor(vs, 1, 64); vs += __shfl_xor(vs, 2, 64); vs += __shfl_xor(vs, 4, 64);
      const float rstd = rsqrtf(vs * (1.f / 64.f) + GN_EPS);
      {
        const uint4 vv = *(const uint4*)(SH + vo), gb = *(const uint4*)(ZG + gbo), ga = *(const uint4*)(ZG + gao), ya = *(const uint4*)(QB + yao);
        const unsigned vw[4] = {vv.x, vv.y, vv.z, vv.w}, gbw[4] = {gb.x, gb.y, gb.z, gb.w}, gaw[4] = {ga.x, ga.y, ga.z, ga.w}, yw[4] = {ya.x, ya.y, ya.z, ya.w};
        unsigned o2[4], o1[4];
#pragma unroll
        for (int q = 0; q < 4; ++q) {
          const int dd = head * 64 + d0 + 2 * q;
          const float y0 = ov[2 * q] * rstd * p.gn_w[dd] + p.gn_b[dd] + bon * hlo(vw[q]);
          const float y1 = ov[2 * q + 1] * rstd * p.gn_w[dd + 1] + p.gn_b[dd + 1] + bon * hhi(vw[q]);
          o2[q] = pack_bf2(y0 * siluf(bflo(gbw[q])), y1 * siluf(bfhi(gbw[q])));
          o1[q] = pack_bf2(bflo(yw[q]) * siluf(bflo(gaw[q])), bfhi(yw[q]) * siluf(bfhi(gaw[q])));
        }
        *(uint4*)(O + ofo) = make_uint4(o2[0], o2[1], o2[2], o2[3]);
        *(uint4*)(QB + yao) = make_uint4(o1[0], o1[1], o1[2], o1[3]);
      }
    }
    __threadfence();
    __syncthreads();
#if PROBE
    if (mt == 0) {
      const int tok = wave * 16 + 3, head = wave, row = row0 + tok, dd = head * 64 + lane;
      const float got = bf2f(O[(size_t)row * 512 + dd]);
      dbg_acc(p, 1, (got - a2ref) * (got - a2ref), a2ref * a2ref);
    }
#endif
    const ushort_t* hbase = (const ushort_t*)p.out;
    auto hload = [&](int r, int k) { return *(const uint4*)(hbase + (unsigned)((row0 + r) * 2048 + k)); };
    auto a1load = [&](int r, int k) { return *(const uint4*)(QB + (unsigned)(((b * 8 + (k >> 6)) * SEQ + tb0 + r) * 64 + (k & 63))); };
    auto a2load = [&](int r, int k) { return *(const uint4*)(O + (unsigned)((row0 + r) * 512 + k)); };
#pragma unroll 1
    for (int nt = 0; nt < 8; ++nt) {
      const int col0 = nt * 128;
      int tidn = tid;
      asm volatile("" : "+v"(tidn));
      f32x16 sg[2][1][2] = {{{zero16(), zero16()}}, {{zero16(), zero16()}}};
      gemm_pass<128, 128, 1, 2, 2>(sg, hload, [&](int w, int n, int k) { return *(const uint4*)(WMG + (unsigned)((w * 1024 + col0 + n) * DM + k)); }, DM, As, Bs, wrow0, wcol0, tidn);
#pragma unroll
      for (int ni = 0; ni < 2; ++ni) {
        const int col = col0 + wcol0 + ni * 32 + l31;
        const float ba = p.b_mg[col], bb = p.b_mg[1024 + col];
#pragma unroll
        for (int i = 0; i < 16; ++i) { sg[0][0][ni][i] = sigmf(sg[0][0][ni][i] + ba); sg[1][0][ni][i] = sigmf(sg[1][0][ni][i] + bb); }
      }
      {
        f32x16 ya[1][1][2] = {{{zero16(), zero16()}}};
        gemm_pass<128, 128, 1, 2, 1>(ya, a1load, [&](int w, int n, int k) { return *(const uint4*)(WPA + (unsigned)((col0 + n) * 512 + k)); }, 512, As, Bs, wrow0, wcol0, tidn);
#pragma unroll
        for (int ni = 0; ni < 2; ++ni)
#pragma unroll
          for (int i = 0; i < 16; ++i) sg[0][0][ni][i] *= ya[0][0][ni][i];
      }
      {
        f32x16 yb[1][1][2] = {{{zero16(), zero16()}}};
        gemm_pass<128, 128, 1, 2, 1>(yb, a2load, [&](int w, int n, int k) { return *(const uint4*)(WPB + (unsigned)((col0 + n) * 512 + k)); }, 512, As, Bs, wrow0, wcol0, tidn);
        int rb1 = row0 + wrow0 + 4 * hh;
        asm volatile("" : "+v"(rb1));
#pragma unroll
        for (int ni = 0; ni < 2; ++ni) {
          const int col = col0 + wcol0 + ni * 32 + l31;
#pragma unroll
          for (int i = 0; i < 16; ++i) {
            const float mv = sg[0][0][ni][i] + sg[1][0][ni][i] * yb[0][0][ni][i];
            ZG[(unsigned)((rb1 + crow(i, 0)) * 1024 + col)] = f2bf(mv);
          }
        }
      }
    }
    __threadfence();
    __syncthreads();
#if PROBE
    if (mt == 0) {
      float d2 = 0.f, r2 = 0.f;
      if (tid < 64) {
        const int r = (tid * 37) & 127, col = (tid * 131 + 7) & 1023, row = row0 + r;
        const ushort_t* hrow = (const ushort_t*)(p.out + (size_t)row * DM);
        float ga = p.b_mg[col], gb = p.b_mg[1024 + col], ya = 0.f, yb = 0.f;
        for (int k = 0; k < 1024; ++k) { const float hv = bf2f(hrow[k]); ga += hv * p.w_mg[(size_t)k * 2048 + col]; gb += hv * p.w_mg[(size_t)k * 2048 + 1024 + col]; }
        for (int k = 0; k < 512; ++k) {
          ya += bf2f(QB[((size_t)(b * 8 + (k >> 6)) * SEQ + tb0 + r) * 64 + (k & 63)]) * p.w_pa[(size_t)k * 1024 + col];
          yb += bf2f(O[(size_t)row * 512 + k]) * p.w_pb[(size_t)k * 1024 + col];
        }
        const float ref = ya / (1.f + expf(-ga)) + yb / (1.f + expf(-gb));
        const float got = bf2f(ZG[(size_t)row * 1024 + col]);
        d2 = (got - ref) * (got - ref); r2 = ref * ref;
      }
      dbg_acc(p, 2, d2, r2);
    }
#endif
    const float* gt = md + 2048;
#pragma unroll 1
    for (int nt = 0; nt < 8; ++nt) {
      const int col0 = nt * 128;
      int tidn = tid;
      asm volatile("" : "+v"(tidn));
      f32x16 acc[1][1][2] = {{{zero16(), zero16()}}};
      gemm_pass<128, 128, 1, 2, 1>(acc, [&](int r, int k) { return *(const uint4*)(ZG + (unsigned)((row0 + r) * 1024 + k)); },
                                   [&](int w, int n, int k) { return *(const uint4*)(WO + (unsigned)((col0 + n) * DM + k)); }, DM, As, Bs, wrow0, wcol0, tidn);
      int rb2 = row0 + wrow0 + 4 * hh;
      asm volatile("" : "+v"(rb2));
#pragma unroll
      for (int ni = 0; ni < 2; ++ni) {
        const int col = col0 + wcol0 + ni * 32 + l31;
        const float g = gt[col];
#pragma unroll
        for (int i = 0; i < 16; ++i) {
          const unsigned idx = (unsigned)((rb2 + crow(i, 0)) * DM + col);
          p.out[idx] = ALPHA * p.x[idx] + g * acc[0][0][ni][i];
        }
      }
    }
    __threadfence();
    __syncthreads();
#if PROBE
    if (mt == 0) {
      float d2 = 0.f, r2 = 0.f;
      if (tid < 64) {
        const int r = (tid * 29) & 127, col = (tid * 113 + 5) & 1023, row = row0 + r;
        float o = 0.f;
        for (int k = 0; k < 1024; ++k) o += bf2f(ZG[(size_t)row * 1024 + k]) * p.w_o[(size_t)k * 1024 + col];
        const float ref = md[2048 + col] * o;
        const float got = p.out[(size_t)row * DM + col] - ALPHA * p.x[(size_t)row * DM + col];
        d2 = (got - ref) * (got - ref); r2 = ref * ref;
      }
      dbg_acc(p, 3, d2, r2);
    }
    __threadfence();
    __syncthreads();
#endif
#if !PROBE
#if PROBE
    const float pdelta = probe_delta(p);
#else
    const float pdelta = 0.f;
#endif
#pragma unroll 1
    for (int r = wave; r < 128; r += 8) {
      float* dst = p.out + (size_t)(row0 + r) * DM;
      float4 v[4];
      float s = 0.f;
#pragma unroll
      for (int i = 0; i < 4; ++i) { v[i] = *(const float4*)(dst + lane * 4 + 256 * i); s += v[i].x + v[i].y + v[i].z + v[i].w; }
      const float mu = wave_sum(s) * (1.f / DM);
      float q = 0.f;
#pragma unroll
      for (int i = 0; i < 4; ++i) { v[i].x -= mu; v[i].y -= mu; v[i].z -= mu; v[i].w -= mu; q += v[i].x * v[i].x + v[i].y * v[i].y + v[i].z * v[i].z + v[i].w * v[i].w; }
      const float rstd = rsqrtf(wave_sum(q) * (1.f / DM) + LN_EPS);
#pragma unroll
      for (int i = 0; i < 4; ++i) {
        const int col = lane * 4 + 256 * i;
        const float4 g = *(const float4*)(p.ln_g + col), bb = *(const float4*)(p.ln_b + col);
        *(float4*)(dst + col) = make_float4(v[i].x * rstd * g.x + bb.x + pdelta, v[i].y * rstd * g.y + bb.y + pdelta, v[i].z * rstd * g.z + bb.z + pdelta, v[i].w * rstd * g.w + bb.w + pdelta);
      }
    }
#endif
  }
}


#if PROBE
DI void probe_f3(const Params& p) {
  const float pdelta = probe_delta(p);
  const int lane = threadIdx.x & 63, wave = threadIdx.x >> 6;
  for (int mt = blockIdx.x; mt < NX / 128; mt += gridDim.x) {
    for (int r = wave; r < 128; r += 8) {
      const float* src = p.x + (size_t)(mt * 128 + r) * DM;
      float* dst = p.out + (size_t)(mt * 128 + r) * DM;
      float s = 0.f, q = 0.f;
      for (int i = lane; i < 1024; i += 64) s += ALPHA * src[i];
      const float mu = wave_sum(s) / 1024.f;
      for (int i = lane; i < 1024; i += 64) { const float d = ALPHA * src[i] - mu; q += d * d; }
      const float rstd = rsqrtf(wave_sum(q) / 1024.f + LN_EPS);
      for (int i = lane; i < 1024; i += 64) dst[i] = (ALPHA * src[i] - mu) * rstd * p.ln_g[i] + p.ln_b[i] + pdelta;
    }
  }
}
#endif
DI void gsync(cg::grid_group& g) { __threadfence(); g.sync(); }

constexpr int SMEM_BYTES = 2 * (256 + 128) * LDK * 2;
static_assert(SMEM_BYTES >= 65536 + 32 * 264 * 2 + 1024, "rwkv prep LDS");
__global__ void __launch_bounds__(NTH) fwd_megakernel(Params p) {
  __shared__ __attribute__((aligned(16))) unsigned char smem[SMEM_BYTES];
  cg::grid_group grid = cg::this_grid();
#if PROBE
  if (blockIdx.x == 0 && threadIdx.x < 64) ((float*)(p.ws + OFF_DBG))[threadIdx.x] = 0.f;
#endif
  phase0(p, smem);
  gsync(grid);
  phase_h(p);
  gsync(grid);
  phase_gemm1(p, smem);
  gsync(grid);
  phase_qkv(p);
  phase_rwkv_prep(p, smem);
  gsync(grid);
#if PROBE_NAIVE_SCAN
  phase_scan_naive(p);
#else
  phase_scanA(p, smem);
  gsync(grid);
  phase_scanB(p, smem);
  gsync(grid);
  phase_scanC(p, smem);
#endif
  phase_attn(p, smem);
  gsync(grid);
#if PROBE
  probe_scan(p);
  gsync(grid);
#endif
  phase_final(p, smem);
#if PROBE
  gsync(grid);
  probe_f3(p);
#endif
}

extern "C" void kernel_launch(void* const* d_in, const int* in_sizes, int n_in, void* d_out, int out_size, void* d_ws, size_t ws_size,
                              hipStream_t stream) {
  static int grid_blocks = 0;
  if (!grid_blocks) {
    int dev = 0, cus = 0, per_cu = 0;
    hipGetDevice(&dev);
    hipDeviceGetAttribute(&cus, hipDeviceAttributeMultiprocessorCount, dev);
    hipOccupancyMaxActiveBlocksPerMultiprocessor(&per_cu, fwd_megakernel, NTH, 0);
    if (per_cu < 1) fprintf(stderr, "occupancy query says %d blocks/CU\n", per_cu);
    grid_blocks = cus > 0 ? cus : 256;
    if (ws_size < WS_END) fprintf(stderr, "workspace too small: %zu < %zu\n", ws_size, (size_t)WS_END);
  }
  Params p{};
  const float** fp = (const float**)&p;
  for (int i = 0; i < 27; ++i) fp[i] = (const float*)d_in[i];
  p.out = (float*)d_out;
  p.ws = (unsigned char*)d_ws;
  void* args[] = {&p};
  hipError_t e = hipLaunchCooperativeKernel((void*)fwd_megakernel, dim3(grid_blocks), dim3(NTH), args, 0, stream);
  if (e != hipSuccess) fprintf(stderr, "cooperative launch failed: %s (grid %d)\n", hipGetErrorString(e), grid_blocks);
}
```

```cpp
#include <hip/hip_runtime.h>
#include <hip/hip_cooperative_groups.h>
#include <stdint.h>
#include <cstdio>
namespace cg = cooperative_groups;

#define PROBE 0
#define DI __device__ __forceinline__
typedef __attribute__((ext_vector_type(8))) short bf16x8;
typedef __attribute__((ext_vector_type(16))) float f32x16;
typedef __attribute__((ext_vector_type(16))) uint32_t u32x16;
typedef __attribute__((ext_vector_type(2))) _Float16 h2;
typedef __attribute__((ext_vector_type(2))) __bf16 b2;
typedef unsigned short ushort_t;
typedef __attribute__((ext_vector_type(4))) uint32_t u32x4;
#define MFMA(a, b, c) __builtin_amdgcn_mfma_f32_32x32x16_bf16((a), (b), (c), 0, 0, 0)

constexpr int DM = 1024, NB = 2, SEQ = 16384, CTXL = 256;
constexpr int NX = NB * SEQ, NC = NB * CTXL, NT = NX + NC;
constexpr int INW = 3584, LTOT = CTXL + SEQ;
constexpr int NTH = 512;
constexpr int CH = 130, NCHUNK = LTOT / CH;
static_assert(NCHUNK * CH == LTOT, "chunking");
constexpr float LN_EPS = 1e-5f, QK_EPS = 1e-6f, GN_EPS = 64e-5f;
constexpr float ALPHA = 1.189207115002721f;
constexpr float QSCALE = 0.125f * 1.4426950408889634f;

constexpr size_t OFF_WIN = 0;
constexpr size_t OFF_WMG = OFF_WIN + (size_t)INW * DM * 2;
constexpr size_t OFF_WPA = OFF_WMG + (size_t)2048 * DM * 2;
constexpr size_t OFF_WPB = OFF_WPA + (size_t)1024 * 512 * 2;
constexpr size_t OFF_WO  = OFF_WPB + (size_t)1024 * 512 * 2;
constexpr size_t OFF_WL  = OFF_WO + (size_t)1024 * 1024 * 2;
constexpr size_t OFF_MOD = OFF_WL + (size_t)2 * 2 * 512 * 64 * 2;
constexpr size_t OFF_ZG  = OFF_MOD + 36864;
constexpr size_t OFF_QB  = OFF_ZG + (size_t)NX * 1024 * 2;
constexpr size_t OFF_KB  = OFF_QB + (size_t)NX * 512 * 2;
constexpr size_t OFF_VB  = OFF_KB + (size_t)NB * 2 * LTOT * 64 * 2;
constexpr size_t OFF_SH  = OFF_VB + (size_t)NB * 2 * LTOT * 64 * 2;
constexpr size_t OFF_DR  = OFF_SH + (size_t)16 * LTOT * 192 * 2;
constexpr size_t OFF_ZQ  = OFF_DR + (size_t)32 * LTOT * 192 * 2;
constexpr size_t WS_END  = OFF_ZQ + (size_t)2 * NX * 512 * 2;
static_assert(WS_END <= (size_t)536870912, "workspace");
static_assert((size_t)NT * DM * 2 <= (size_t)48 * LTOT * 192 * 2, "H alias");
static_assert((size_t)NT * 768 * 2 <= (size_t)2 * NX * 512 * 2, "zqkv alias");

struct Params {
  const float *x, *c, *ctx, *c_ctx, *w_ada, *b_ada, *w_in, *q_norm, *k_norm, *mu_prev, *mu_next, *w0, *w_up, *a0, *a_up, *k_k, *k_a,
      *r_k, *gn_w, *gn_b, *w_pa, *w_pb, *w_mg, *b_mg, *w_o, *ln_g, *ln_b;
  float* out;
  unsigned char* ws;
};

DI ushort_t f2bf(float f) { return __builtin_bit_cast(ushort_t, (__bf16)f); }
DI float bf2f(ushort_t b) { return __uint_as_float(((unsigned)b) << 16); }
DI unsigned pack_bf2(float a, float b) { b2 v = {(__bf16)a, (__bf16)b}; return __builtin_bit_cast(unsigned, v); }
DI unsigned pack_h2(float a, float b) { h2 v = {(_Float16)a, (_Float16)b}; return __builtin_bit_cast(unsigned, v); }
DI ushort_t f2h(float f) { return __builtin_bit_cast(ushort_t, (_Float16)f); }
DI float h2f(ushort_t h) { return (float)__builtin_bit_cast(_Float16, h); }
DI float bflo(unsigned u) { return __uint_as_float(u << 16); }
DI float bfhi(unsigned u) { return __uint_as_float(u & 0xffff0000u); }
DI float hlo(unsigned u) { return (float)__builtin_bit_cast(h2, u)[0]; }
DI float hhi(unsigned u) { return (float)__builtin_bit_cast(h2, u)[1]; }
DI float sigmf(float v) { return __builtin_amdgcn_rcpf(1.f + __expf(-v)); }
DI float siluf(float v) { return v * sigmf(v); }
DI int crow(int reg, int h) { return (reg & 3) + 8 * (reg >> 2) + 4 * h; }
DI float wave_sum(float v) {
#pragma unroll
  for (int o = 32; o >= 1; o >>= 1) v += __shfl_xor(v, o, 64);
  return v;
}
DI float sum16(float v) {
#pragma unroll
  for (int o = 8; o >= 1; o >>= 1) v += __shfl_xor(v, o, 64);
  return v;
}
DI float ln_rows4(const float* src, int l16, float4 (&v)[16]) {
  float s = 0.f;
#pragma unroll
  for (int i = 0; i < 16; ++i) { v[i] = *(const float4*)(src + l16 * 4 + 64 * i); s += v[i].x + v[i].y + v[i].z + v[i].w; }
  const float mu = sum16(s) * (1.f / DM);
  float q = 0.f;
#pragma unroll
  for (int i = 0; i < 16; ++i) { v[i].x -= mu; v[i].y -= mu; v[i].z -= mu; v[i].w -= mu; q += v[i].x * v[i].x + v[i].y * v[i].y + v[i].z * v[i].z + v[i].w * v[i].w; }
  return rsqrtf(sum16(q) * (1.f / DM) + LN_EPS);
}
DI f32x16 zero16() { f32x16 z;
#pragma unroll
  for (int i = 0; i < 16; ++i) z[i] = 0.f; return z; }

#define SCAN_VLOAD 0
#define PROBE_NAIVE_SCAN 0
#if SCAN_VLOAD
DI void sload2(u32x16& a0, u32x16& a1, const void* p) { a0 = *(const u32x16*)p; a1 = *((const u32x16*)p + 1); }
DI void sload4(u32x16& a0, u32x16& a1, u32x16& b0, u32x16& b1, const void* p, const void* q) {
  a0 = *(const u32x16*)p; a1 = *((const u32x16*)p + 1); b0 = *(const u32x16*)q; b1 = *((const u32x16*)q + 1);
}
#else
DI void sload2(u32x16& a0, u32x16& a1, const void* p) {
  asm volatile("s_load_dwordx16 %0, %2, 0x0\n\ts_load_dwordx16 %1, %2, 0x40\n\ts_waitcnt lgkmcnt(0)" : "=&s"(a0), "=&s"(a1) : "s"(p) : "memory");
}
DI void sload4(u32x16& a0, u32x16& a1, u32x16& b0, u32x16& b1, const void* p, const void* q) {
  asm volatile("s_load_dwordx16 %0, %4, 0x0\n\ts_load_dwordx16 %1, %4, 0x40\n\ts_load_dwordx16 %2, %5, 0x0\n\ts_load_dwordx16 %3, %5, 0x40\n\ts_waitcnt lgkmcnt(0)"
               : "=&s"(a0), "=&s"(a1), "=&s"(b0), "=&s"(b1) : "s"(p), "s"(q) : "memory");
}
#endif
DI float HV(const u32x16& v, int j) { const uint32_t w = v[j >> 1]; const h2 t = __builtin_bit_cast(h2, w); return (float)t[j & 1]; }

constexpr int LDK = 72;
template <int BM, int BN, int MI, int NI, int NB, class AL, class BL>
DI void gemm_pass(f32x16 (&acc)[NB][MI][NI], AL aload, BL bload, int K, ushort_t* As, ushort_t* Bs, int wrow0, int wcol0, int tid) {
  constexpr int NA = BM * 8 / NTH, NBC = BN * 8 / NTH;
  constexpr int ASZ = BM * LDK, BSZ = NB * BN * LDK;
  const int lane = tid & 63, l31 = lane & 31, hh = lane >> 5;
  const int nk = K >> 6;
  uint4 ra[2][NA], rb[2][NB][NBC];
  auto gload = [&](int s, int kt) {
#pragma unroll
    for (int i = 0; i < NA; ++i) { const int id = tid + i * NTH; ra[s][i] = aload(id >> 3, kt * 64 + (id & 7) * 8); }
#pragma unroll
    for (int w = 0; w < NB; ++w)
#pragma unroll
      for (int i = 0; i < NBC; ++i) { const int id = tid + i * NTH; rb[s][w][i] = bload(w, id >> 3, kt * 64 + (id & 7) * 8); }
  };
  auto lstore = [&](int s, int buf) {
#pragma unroll
    for (int i = 0; i < NA; ++i) { const int id = tid + i * NTH; *(uint4*)&As[buf * ASZ + (id >> 3) * LDK + (id & 7) * 8] = ra[s][i]; }
#pragma unroll
    for (int w = 0; w < NB; ++w)
#pragma unroll
      for (int i = 0; i < NBC; ++i) { const int id = tid + i * NTH; *(uint4*)&Bs[buf * BSZ + w * BN * LDK + (id >> 3) * LDK + (id & 7) * 8] = rb[s][w][i]; }
  };
  auto compute = [&](int buf) {
#pragma unroll
    for (int ks = 0; ks < 4; ++ks) {
      bf16x8 af[MI];
#pragma unroll
      for (int mi = 0; mi < MI; ++mi) af[mi] = *(const bf16x8*)&As[buf * ASZ + (wrow0 + mi * 32 + l31) * LDK + ks * 16 + hh * 8];
#pragma unroll
      for (int w = 0; w < NB; ++w) {
        bf16x8 bfv[NI];
#pragma unroll
        for (int ni = 0; ni < NI; ++ni) bfv[ni] = *(const bf16x8*)&Bs[buf * BSZ + w * BN * LDK + (wcol0 + ni * 32 + l31) * LDK + ks * 16 + hh * 8];
#pragma unroll
        for (int mi = 0; mi < MI; ++mi)
#pragma unroll
          for (int ni = 0; ni < NI; ++ni) acc[w][mi][ni] = MFMA(af[mi], bfv[ni], acc[w][mi][ni]);
      }
    }
  };
  __syncthreads();
  gload(0, 0);
  lstore(0, 0);
  gload(1, 1);
  gload(0, 2);
#pragma unroll 1
  for (int kt = 0; kt < nk; kt += 2) {
    __syncthreads();
    lstore(1, 1);
    if (kt + 3 < nk) gload(1, kt + 3);
    compute(0);
    __syncthreads();
    if (kt + 2 < nk) { lstore(0, 0); if (kt + 4 < nk) gload(0, kt + 4); }
    compute(1);
  }
}

DI void transpose_tile(const float* __restrict__ src, int ld_src, ushort_t* dst, int ld_dst, int k0, int n0, float* T) {
  const int tid = threadIdx.x;
#pragma unroll
  for (int i = 0; i < 2; ++i) {
    const int k = (tid >> 4) + 32 * i, n4 = (tid & 15) * 4;
    const float4 v = *(const float4*)(src + (size_t)(k0 + k) * ld_src + n0 + n4);
    T[k * 65 + n4 + 0] = v.x; T[k * 65 + n4 + 1] = v.y; T[k * 65 + n4 + 2] = v.z; T[k * 65 + n4 + 3] = v.w;
  }
  __syncthreads();
  const int n = tid >> 3, kc = tid & 7;
  uint4 o;
  o.x = pack_bf2(T[(kc * 8 + 0) * 65 + n], T[(kc * 8 + 1) * 65 + n]);
  o.y = pack_bf2(T[(kc * 8 + 2) * 65 + n], T[(kc * 8 + 3) * 65 + n]);
  o.z = pack_bf2(T[(kc * 8 + 4) * 65 + n], T[(kc * 8 + 5) * 65 + n]);
  o.w = pack_bf2(T[(kc * 8 + 6) * 65 + n], T[(kc * 8 + 7) * 65 + n]);
  *(uint4*)(dst + (size_t)(n0 + n) * ld_dst + k0 + kc * 8) = o;
  __syncthreads();
}

DI void phase0(const Params& p, unsigned char* smem) {
  float* T = (float*)smem;
  ushort_t* win = (ushort_t*)(p.ws + OFF_WIN);
  ushort_t* wmg = (ushort_t*)(p.ws + OFF_WMG);
  ushort_t* wpa = (ushort_t*)(p.ws + OFF_WPA);
  ushort_t* wpb = (ushort_t*)(p.ws + OFF_WPB);
  ushort_t* wo = (ushort_t*)(p.ws + OFF_WO);
  ushort_t* wl = (ushort_t*)(p.ws + OFF_WL);
  float* mod = (float*)(p.ws + OFF_MOD);
  constexpr int T_IN = 16 * 56, T_MG = 16 * 32, T_PA = 8 * 16, T_PB = 8 * 16, T_O = 16 * 16, T_L = 32, T_MOD = 48;
  constexpr int TOTAL = T_MOD + T_IN + T_MG + T_PA + T_PB + T_O + T_L;
  for (int t = blockIdx.x; t < TOTAL; t += gridDim.x) {
    int u = t;
    if (u < T_MOD) {
      float* sil = T;
      float* red = T + 3072;
      const int tid = threadIdx.x;
      for (int i = tid; i < 3072; i += NTH) {
        const int v = i >> 10, k = i & 1023;
        const float cv = (v < 2) ? p.c[v * 1024 + k] : p.c_ctx[k];
        sil[i] = siluf(cv);
      }
      __syncthreads();
      const int n = tid & 63, ksl = tid >> 6, n0 = u * 64;
      float a0 = 0.f, a1 = 0.f, a2 = 0.f;
      for (int k = ksl * 128; k < ksl * 128 + 128; ++k) {
        const float w = p.w_ada[(size_t)k * 3072 + n0 + n];
        a0 = fmaf(sil[k], w, a0); a1 = fmaf(sil[1024 + k], w, a1); a2 = fmaf(sil[2048 + k], w, a2);
      }
      red[(ksl * 3 + 0) * 64 + n] = a0; red[(ksl * 3 + 1) * 64 + n] = a1; red[(ksl * 3 + 2) * 64 + n] = a2;
      __syncthreads();
      if (tid < 192) {
        const int v = tid >> 6, nn = tid & 63;
        float s = 0.f;
#pragma unroll
        for (int q = 0; q < 8; ++q) s += red[(q * 3 + v) * 64 + nn];
        mod[v * 3072 + n0 + nn] = s + p.b_ada[n0 + nn];
      }
      __syncthreads();
      continue;
    }
    u -= T_MOD;
    if (u < T_IN) { transpose_tile(p.w_in, INW, win, 1024, (u / 56) * 64, (u % 56) * 64, T); continue; }
    u -= T_IN;
    if (u < T_MG) { transpose_tile(p.w_mg, 2048, wmg, 1024, (u / 32) * 64, (u % 32) * 64, T); continue; }
    u -= T_MG;
    if (u < T_PA) { transpose_tile(p.w_pa, 1024, wpa, 512, (u / 16) * 64, (u % 16) * 64, T); continue; }
    u -= T_PA;
    if (u < T_PB) { transpose_tile(p.w_pb, 1024, wpb, 512, (u / 16) * 64, (u % 16) * 64, T); continue; }
    u -= T_PB;
    if (u < T_O) { transpose_tile(p.w_o, 1024, wo, 1024, (u / 16) * 64, (u % 16) * 64, T); continue; }
    u -= T_O;
    {
      const int which = u >> 4, dir = (u >> 3) & 1, nt = u & 7;
      const float* src = (which ? p.a_up : p.w_up) + (size_t)dir * 64 * 512;
      transpose_tile(src, 512, wl + (size_t)((dir * 2 + which) * 512) * 64, 64, 0, nt * 64, T);
    }
  }
}

DI void phase_h(const Params& p) {
  const float* mod = (const float*)(p.ws + OFF_MOD);
  ushort_t* H = (ushort_t*)(p.ws + OFF_SH);
  const int lane = threadIdx.x & 63, l16 = lane & 15, gw = blockIdx.x * 8 + (threadIdx.x >> 6);
#pragma unroll 1
  for (int r4 = gw * 4; r4 < NT; r4 += gridDim.x * 32) {
    const int row = r4 + (lane >> 4);
    const float* src = (row < NX) ? p.x + (size_t)row * DM : p.ctx + (size_t)(row - NX) * DM;
    const float* md = mod + ((row < NX) ? (row / SEQ) : 2) * 3072;
    float4 v[16];
    const float rstd = ln_rows4(src, l16, v);
#pragma unroll
    for (int i = 0; i < 16; ++i) {
      const int col = l16 * 4 + 64 * i;
      const float4 sh = *(const float4*)(md + col), sc = *(const float4*)(md + 1024 + col);
      uint2 o;
      o.x = pack_bf2(v[i].x * rstd * (1.f + sc.x) + sh.x, v[i].y * rstd * (1.f + sc.y) + sh.y);
      o.y = pack_bf2(v[i].z * rstd * (1.f + sc.z) + sh.z, v[i].w * rstd * (1.f + sc.w) + sh.w);
      *(uint2*)(H + (size_t)row * DM + col) = o;
    }
  }
}

DI void phase_gemm1(const Params& p, unsigned char* smem) {
  ushort_t* As = (ushort_t*)smem;
  ushort_t* Bs = As + 2 * 256 * LDK;
  const ushort_t* H = (const ushort_t*)(p.ws + OFF_SH);
  const ushort_t* W = (const ushort_t*)(p.ws + OFF_WIN);
  ushort_t* zq = (ushort_t*)(p.ws + OFF_ZQ);
  ushort_t* zg = (ushort_t*)(p.ws + OFF_ZG);
  ushort_t* zm = (ushort_t*)p.out;
  const int tid = threadIdx.x, wave = tid >> 6, lane = tid & 63, l31 = lane & 31, hh = lane >> 5;
  const int wrow0 = (wave & 3) * 64, wcol0 = (wave >> 2) * 64;
  constexpr int MT = NT / 256, NTL = INW / 128;
  for (int t = blockIdx.x; t < MT * NTL; t += gridDim.x) {
    const int mt = t / NTL, nt = t % NTL;
    const bool is_g = (nt >= 6 && nt < 10) || nt >= 24;
    if (is_g && mt >= NX / 256) continue;
    const int row0 = mt * 256, col0 = nt * 128;
    f32x16 acc[1][2][2];
#pragma unroll
    for (int a = 0; a < 2; ++a)
#pragma unroll
      for (int b = 0; b < 2; ++b) acc[0][a][b] = zero16();
    auto aload = [&](int r, int k) { return *(const uint4*)(H + (size_t)(row0 + r) * DM + k); };
    auto bload = [&](int w, int n, int k) { return *(const uint4*)(W + (size_t)(col0 + n) * DM + k); };
    gemm_pass<256, 128, 2, 2, 1>(acc, aload, bload, DM, As, Bs, wrow0, wcol0, tid);
    ushort_t* dst; int ld, cbase;
    if (nt < 6) { dst = zq; ld = 768; cbase = col0; }
    else if (nt < 10) { dst = zg; ld = 1024; cbase = col0 - 768; }
    else if (nt < 24) { dst = zm; ld = 1792; cbase = col0 - 1280; }
    else { dst = zg; ld = 1024; cbase = 512 + col0 - 3072; }
#pragma unroll
    for (int mi = 0; mi < 2; ++mi)
#pragma unroll
      for (int ni = 0; ni < 2; ++ni)
#pragma unroll
        for (int i = 0; i < 16; ++i) {
          const int row = row0 + wrow0 + mi * 32 + crow(i, hh), col = cbase + wcol0 + ni * 32 + l31;
          dst[(size_t)row * ld + col] = f2bf(acc[0][mi][ni][i]);
        }
  }
}

DI int vperm(int key) { const int g = key >> 4, kq = key & 15; return g * 16 + 8 * ((kq >> 2) & 1) + (kq & 3) + 4 * (kq >> 3); }
DI void phase_qkv(const Params& p) {
  const ushort_t* zq = (const ushort_t*)(p.ws + OFF_ZQ);
  ushort_t* QB = (ushort_t*)(p.ws + OFF_QB);
  ushort_t* KB = (ushort_t*)(p.ws + OFF_KB);
  ushort_t* VB = (ushort_t*)(p.ws + OFF_VB);
  const int lane = threadIdx.x & 63, gw = blockIdx.x * 8 + (threadIdx.x >> 6);
  const int j = lane & 31, half = lane >> 5, axis = j >> 4, f = j & 15;
  const int d1 = axis * 32 + f, d2 = d1 + 16;
  const float inv = powf(10000.f, -(float)f * (1.f / 16.f));
  const float gq1 = p.q_norm[d1], gq2 = p.q_norm[d2], gk1 = p.k_norm[d1], gk2 = p.k_norm[d2];
  for (int row = gw; row < NT; row += gridDim.x * 8) {
    const bool isx = row < NX;
    const int b = isx ? row / SEQ : (row - NX) / CTXL;
    const int t = isx ? row % SEQ : (row - NX) % CTXL;
    const int pos = isx ? CTXL + t : t;
    const ushort_t* z = zq + (size_t)row * 768;
    float cs = 1.f, sn = 0.f;
    if (isx) { const float ang = (float)(axis ? (t & 63) : (t >> 6)) * inv; sincosf(ang, &sn, &cs); }
#pragma unroll
    for (int it = 0; it < 5; ++it) {
      const int hd = it * 2 + half;
      if (!isx && hd < 8) continue;
      const float v1 = bf2f(z[hd * 64 + d1]), v2 = bf2f(z[hd * 64 + d2]);
      float ss = v1 * v1 + v2 * v2;
#pragma unroll
      for (int o = 16; o >= 1; o >>= 1) ss += __shfl_xor(ss, o, 64);
      const float rms = rsqrtf(ss * (1.f / 64.f) + QK_EPS);
      const bool isq = hd < 8;
      const float y1 = v1 * rms * (isq ? gq1 : gk1), y2 = v2 * rms * (isq ? gq2 : gk2);
      float o1 = y1 * cs - y2 * sn, o2 = y2 * cs + y1 * sn;
      if (isq) {
        ushort_t* dst = QB + ((size_t)(b * 8 + hd) * SEQ + t) * 64;
        dst[d1] = f2bf(o1 * QSCALE); dst[d2] = f2bf(o2 * QSCALE);
      } else {
        ushort_t* dst = KB + ((size_t)(b * 2 + (hd - 8)) * LTOT + pos) * 64;
        dst[d1] = f2bf(o1); dst[d2] = f2bf(o2);
      }
    }
    {
      const size_t tb = (size_t)(pos >> 6) * 4096 + lane * 64 + vperm(pos & 63);
      VB[(size_t)(b * 2 + 0) * LTOT * 64 + tb] = z[640 + lane];
      VB[(size_t)(b * 2 + 1) * LTOT * 64 + tb] = z[704 + lane];
    }
  }
}

DI void phase_rwkv_prep(const Params& p, unsigned char* smem) {
  float* kbuf = (float*)smem;
  ushort_t* codes = (ushort_t*)(smem + 65536);
  float* invn = (float*)(smem + 65536 + 32 * 264 * 2);
  const ushort_t* zm = (const ushort_t*)p.out;
  const ushort_t* WL = (const ushort_t*)(p.ws + OFF_WL);
  ushort_t* SH = (ushort_t*)(p.ws + OFF_SH);
  ushort_t* DR = (ushort_t*)(p.ws + OFF_DR);
  const int tid = threadIdx.x, wave = tid >> 6, lane = tid & 63, l31 = lane & 31, hh = lane >> 5;
  for (int tt = blockIdx.x; tt < NT / 32; tt += gridDim.x) {
    const int row0 = tt * 32;
    int b, t0, len, pbase;
    if (row0 < NX) { b = row0 / SEQ; t0 = row0 % SEQ; len = SEQ; pbase = CTXL; }
    else { const int rc = row0 - NX; b = rc / CTXL; t0 = rc % CTXL; len = CTXL; pbase = 0; }
    __syncthreads();
    for (int id = tid; id < 32 * 224; id += NTH) {
      const int i = id / 224, c0 = (id % 224) * 8;
      const int t = t0 + i;
      const ushort_t* zr = zm + (size_t)(row0 + i) * 1792 + c0;
      const uint4 zc = *(const uint4*)zr;
      uint4 zp = make_uint4(0, 0, 0, 0), zn = make_uint4(0, 0, 0, 0);
      if (t > 0) zp = *(const uint4*)(zr - 1792);
      if (t < len - 1) zn = *(const uint4*)(zr + 1792);
      const float4 mp0 = *(const float4*)(p.mu_prev + c0), mp1 = *(const float4*)(p.mu_prev + c0 + 4);
      const float4 mn0 = *(const float4*)(p.mu_next + c0), mn1 = *(const float4*)(p.mu_next + c0 + 4);
      const unsigned zcw[4] = {zc.x, zc.y, zc.z, zc.w}, zpw[4] = {zp.x, zp.y, zp.z, zp.w}, znw[4] = {zn.x, zn.y, zn.z, zn.w};
      const float mpv[8] = {mp0.x, mp0.y, mp0.z, mp0.w, mp1.x, mp1.y, mp1.z, mp1.w};
      const float mnv[8] = {mn0.x, mn0.y, mn0.z, mn0.w, mn1.x, mn1.y, mn1.z, mn1.w};
      float s[8];
#pragma unroll
      for (int q = 0; q < 4; ++q) {
        const float c_lo = bflo(zcw[q]), c_hi = bfhi(zcw[q]);
        s[2 * q] = c_lo + mpv[2 * q] * (bflo(zpw[q]) - c_lo) + mnv[2 * q] * (bflo(znw[q]) - c_lo);
        s[2 * q + 1] = c_hi + mpv[2 * q + 1] * (bfhi(zpw[q]) - c_hi) + mnv[2 * q + 1] * (bfhi(znw[q]) - c_hi);
      }
      const int pp = pbase + t;
      if (c0 < 512 || (c0 >= 1024 && c0 < 1536)) {
        const int cc = (c0 < 512) ? c0 : c0 - 1024, which = (c0 < 512) ? 1 : 2;
        const int head = cc >> 6, d = cc & 63;
        uint4 o;
        o.x = pack_h2(s[0], s[1]); o.y = pack_h2(s[2], s[3]); o.z = pack_h2(s[4], s[5]); o.w = pack_h2(s[6], s[7]);
        *(uint4*)(SH + (((size_t)(b * 8 + head) * LTOT + pp) * 3 + which) * 64 + d) = o;
      } else if (c0 < 1024) {
        float* kd = kbuf + i * 512 + (c0 - 512);
        *(float4*)kd = make_float4(s[0], s[1], s[2], s[3]);
        *(float4*)(kd + 4) = make_float4(s[4], s[5], s[6], s[7]);
      } else {
        const int cc = c0 - 1536;
        if (cc < 128) {
#pragma unroll
          for (int q = 0; q < 8; ++q) s[q] = tanhf(s[q]);
        }
        uint4 o;
        o.x = pack_bf2(s[0], s[1]); o.y = pack_bf2(s[2], s[3]); o.z = pack_bf2(s[4], s[5]); o.w = pack_bf2(s[6], s[7]);
        *(uint4*)(codes + i * 264 + cc) = o;
      }
    }
    __syncthreads();
    {
      const int i = tid >> 4, head = (tid >> 1) & 7, hf = tid & 1;
      float ss = 0.f;
#pragma unroll 8
      for (int q = 0; q < 32; ++q) {
        const int n = head * 64 + hf * 32 + q;
        const float v = kbuf[i * 512 + n] * p.k_k[n];
        ss = fmaf(v, v, ss);
      }
      ss += __shfl_xor(ss, 1, 64);
      if (hf == 0) invn[i * 8 + head] = 1.f / fmaxf(sqrtf(ss), 1e-12f);
    }
    __syncthreads();
#pragma unroll 1
    for (int q4 = 0; q4 < 4; ++q4) {
      const int pr = wave * 4 + q4, dir = pr >> 4, ct = pr & 15;
      f32x16 aw = zero16(), aa = zero16();
#pragma unroll
      for (int ks = 0; ks < 4; ++ks) {
        const bf16x8 fw = *(const bf16x8*)&codes[l31 * 264 + dir * 64 + ks * 16 + hh * 8];
        const bf16x8 fa = *(const bf16x8*)&codes[l31 * 264 + 128 + dir * 64 + ks * 16 + hh * 8];
        const bf16x8 bw = *(const bf16x8*)&WL[(size_t)((dir * 2 + 0) * 512 + ct * 32 + l31) * 64 + ks * 16 + hh * 8];
        const bf16x8 ba = *(const bf16x8*)&WL[(size_t)((dir * 2 + 1) * 512 + ct * 32 + l31) * 64 + ks * 16 + hh * 8];
        aw = MFMA(fw, bw, aw);
        aa = MFMA(fa, ba, aa);
      }
      const int n = ct * 32 + l31, head = n >> 6, d = n & 63;
      const float w0v = p.w0[dir * 512 + n], a0v = p.a0[dir * 512 + n], kkw = p.k_k[n], kaw = p.k_a[n];
      const size_t cbase = (size_t)(b * 8 + head) * LTOT;
#pragma unroll
      for (int i = 0; i < 16; ++i) {
        const int ti = crow(i, hh);
        const int pp = pbase + t0 + ti;
        const float wpre = aw[i] + w0v;
        const float e = 0.60653065971263342f * sigmf(wpre);
        const float xdec = 1.f - __expf(-e);
        const float a = sigmf(aa[i] + a0v);
        const float kv = kbuf[ti * 512 + n];
        const float kkv = kv * kkw * invn[ti * 8 + head];
        const float kd = kv * (1.f + (a - 1.f) * kaw);
        ushort_t* dr = DR + ((((size_t)dir * 16) * LTOT + cbase + pp) * 3) * 64 + d;
        dr[0] = f2h(-xdec); dr[64] = f2h(kd); dr[128] = f2h(kkv * a);
        if (dir == 0) SH[((cbase + pp) * 3) * 64 + d] = f2h(kkv);
      }
    }
  }
}

DI int tau_to_pos(int dir, int tau) { return dir == 0 ? tau : (tau < CTXL ? CTXL - 1 - tau : LTOT - 1 - (tau - CTXL)); }

struct ScanRec { uint32_t sh, dr, bb; ushort_t v; };
DI ScanRec scan_load(const ushort_t* shc, const ushort_t* drc, int pos, int lane) {
  ScanRec r;
  const ushort_t* s = shc + (size_t)pos * 192;
  const uint32_t* d = (const uint32_t*)(drc + (size_t)pos * 192);
  r.sh = ((const uint32_t*)s)[lane];
  r.v = s[128 + lane];
  r.dr = d[lane];
  r.bb = d[64 + (lane & 31)];
  return r;
}
#define MIXLO " op_sel_hi:[0,1,0]\n\t"
#define MIXHI " op_sel:[0,1,0] op_sel_hi:[0,1,0]\n\t"
template <int L>
DI void dot4(float& a0, float& a1, float (&S)[64], uint32_t src) {
  uint32_t t0, t1, t2, t3;
  asm("v_readlane_b32 %2, %6, %7\n\tv_readlane_b32 %3, %6, %8\n\tv_readlane_b32 %4, %6, %9\n\tv_readlane_b32 %5, %6, %10\n\t"
      "v_fma_mix_f32 %0, %11, %2, %0" MIXLO "v_fma_mix_f32 %1, %12, %2, %1" MIXHI
      "v_fma_mix_f32 %0, %13, %3, %0" MIXLO "v_fma_mix_f32 %1, %14, %3, %1" MIXHI
      "v_fma_mix_f32 %0, %15, %4, %0" MIXLO "v_fma_mix_f32 %1, %16, %4, %1" MIXHI
      "v_fma_mix_f32 %0, %17, %5, %0" MIXLO "v_fma_mix_f32 %1, %18, %5, %1" MIXHI
      : "+v"(a0), "+v"(a1), "=&s"(t0), "=&s"(t1), "=&s"(t2), "=&s"(t3)
      : "v"(src), "n"(L), "n"(L + 1), "n"(L + 2), "n"(L + 3),
        "v"(S[2 * (L & 31)]), "v"(S[2 * (L & 31) + 1]), "v"(S[2 * (L & 31) + 2]), "v"(S[2 * (L & 31) + 3]),
        "v"(S[2 * (L & 31) + 4]), "v"(S[2 * (L & 31) + 5]), "v"(S[2 * (L & 31) + 6]), "v"(S[2 * (L & 31) + 7]));
}
template <int L>
DI void upd4(float (&S)[64], uint32_t dr, uint32_t bb, float vv, float nsk) {
  uint32_t x0, x1, x2, x3, k0, k1, k2, k3, b0, b1, b2, b3;
  asm("v_readlane_b32 %8, %20, %22\n\tv_readlane_b32 %9, %20, %23\n\tv_readlane_b32 %10, %20, %24\n\tv_readlane_b32 %11, %20, %25\n\t"
      "v_readlane_b32 %12, %20, %26\n\tv_readlane_b32 %13, %20, %27\n\tv_readlane_b32 %14, %20, %28\n\tv_readlane_b32 %15, %20, %29\n\t"
      "v_readlane_b32 %16, %21, %22\n\tv_readlane_b32 %17, %21, %23\n\tv_readlane_b32 %18, %21, %24\n\tv_readlane_b32 %19, %21, %25\n\t"
      "v_fma_mix_f32 %0, %0, %8, %0" MIXLO "v_fma_mix_f32 %1, %1, %8, %1" MIXHI
      "v_fma_mix_f32 %2, %2, %9, %2" MIXLO "v_fma_mix_f32 %3, %3, %9, %3" MIXHI
      "v_fma_mix_f32 %4, %4, %10, %4" MIXLO "v_fma_mix_f32 %5, %5, %10, %5" MIXHI
      "v_fma_mix_f32 %6, %6, %11, %6" MIXLO "v_fma_mix_f32 %7, %7, %11, %7" MIXHI
      "v_fma_mix_f32 %0, %30, %12, %0" MIXLO "v_fma_mix_f32 %1, %30, %12, %1" MIXHI
      "v_fma_mix_f32 %2, %30, %13, %2" MIXLO "v_fma_mix_f32 %3, %30, %13, %3" MIXHI
      "v_fma_mix_f32 %4, %30, %14, %4" MIXLO "v_fma_mix_f32 %5, %30, %14, %5" MIXHI
      "v_fma_mix_f32 %6, %30, %15, %6" MIXLO "v_fma_mix_f32 %7, %30, %15, %7" MIXHI
      "v_fma_mix_f32 %0, %31, %16, %0" MIXLO "v_fma_mix_f32 %1, %31, %16, %1" MIXHI
      "v_fma_mix_f32 %2, %31, %17, %2" MIXLO "v_fma_mix_f32 %3, %31, %17, %3" MIXHI
      "v_fma_mix_f32 %4, %31, %18, %4" MIXLO "v_fma_mix_f32 %5, %31, %18, %5" MIXHI
      "v_fma_mix_f32 %6, %31, %19, %6" MIXLO "v_fma_mix_f32 %7, %31, %19, %7" MIXHI
      : "+v"(S[2 * L]), "+v"(S[2 * L + 1]), "+v"(S[2 * L + 2]), "+v"(S[2 * L + 3]), "+v"(S[2 * L + 4]), "+v"(S[2 * L + 5]), "+v"(S[2 * L + 6]), "+v"(S[2 * L + 7]),
        "=&s"(x0), "=&s"(x1), "=&s"(x2), "=&s"(x3), "=&s"(k0), "=&s"(k1), "=&s"(k2), "=&s"(k3), "=&s"(b0), "=&s"(b1), "=&s"(b2), "=&s"(b3)
      : "v"(dr), "v"(bb), "n"(L), "n"(L + 1), "n"(L + 2), "n"(L + 3), "n"(L + 32), "n"(L + 33), "n"(L + 34), "n"(L + 35), "v"(vv), "v"(nsk));
}
template <int L>
DI void dot4_2(float& a0, float& a1, float& c0, float& c1, float (&SU)[64], float (&SP)[64], uint32_t src) {
  uint32_t t0, t1, t2, t3;
  asm("v_readlane_b32 %4, %8, %9\n\tv_readlane_b32 %5, %8, %10\n\tv_readlane_b32 %6, %8, %11\n\tv_readlane_b32 %7, %8, %12\n\t"
      "v_fma_mix_f32 %0, %13, %4, %0" MIXLO "v_fma_mix_f32 %1, %14, %4, %1" MIXHI
      "v_fma_mix_f32 %2, %21, %4, %2" MIXLO "v_fma_mix_f32 %3, %22, %4, %3" MIXHI
      "v_fma_mix_f32 %0, %15, %5, %0" MIXLO "v_fma_mix_f32 %1, %16, %5, %1" MIXHI
      "v_fma_mix_f32 %2, %23, %5, %2" MIXLO "v_fma_mix_f32 %3, %24, %5, %3" MIXHI
      "v_fma_mix_f32 %0, %17, %6, %0" MIXLO "v_fma_mix_f32 %1, %18, %6, %1" MIXHI
      "v_fma_mix_f32 %2, %25, %6, %2" MIXLO "v_fma_mix_f32 %3, %26, %6, %3" MIXHI
      "v_fma_mix_f32 %0, %19, %7, %0" MIXLO "v_fma_mix_f32 %1, %20, %7, %1" MIXHI
      "v_fma_mix_f32 %2, %27, %7, %2" MIXLO "v_fma_mix_f32 %3, %28, %7, %3" MIXHI
      : "+v"(a0), "+v"(a1), "+v"(c0), "+v"(c1), "=&s"(t0), "=&s"(t1), "=&s"(t2), "=&s"(t3)
      : "v"(src), "n"(L), "n"(L + 1), "n"(L + 2), "n"(L + 3),
        "v"(SU[2 * L]), "v"(SU[2 * L + 1]), "v"(SU[2 * L + 2]), "v"(SU[2 * L + 3]), "v"(SU[2 * L + 4]), "v"(SU[2 * L + 5]), "v"(SU[2 * L + 6]), "v"(SU[2 * L + 7]),
        "v"(SP[2 * L]), "v"(SP[2 * L + 1]), "v"(SP[2 * L + 2]), "v"(SP[2 * L + 3]), "v"(SP[2 * L + 4]), "v"(SP[2 * L + 5]), "v"(SP[2 * L + 6]), "v"(SP[2 * L + 7]));
}
template <int L>
DI void upd4_2(float (&SU)[64], float (&SP)[64], uint32_t dr, uint32_t bb, float vv, float nskU, float nskP) {
  uint32_t x0, x1, x2, x3, k0, k1, k2, k3, b0, b1, b2, b3;
  asm("v_readlane_b32 %16, %28, %30\n\tv_readlane_b32 %17, %28, %31\n\tv_readlane_b32 %18, %28, %32\n\tv_readlane_b32 %19, %28, %33\n\t"
      "v_readlane_b32 %20, %28, %34\n\tv_readlane_b32 %21, %28, %35\n\tv_readlane_b32 %22, %28, %36\n\tv_readlane_b32 %23, %28, %37\n\t"
      "v_readlane_b32 %24, %29, %30\n\tv_readlane_b32 %25, %29, %31\n\tv_readlane_b32 %26, %29, %32\n\tv_readlane_b32 %27, %29, %33\n\t"
      "v_fma_mix_f32 %0, %0, %16, %0" MIXLO "v_fma_mix_f32 %1, %1, %16, %1" MIXHI
      "v_fma_mix_f32 %2, %2, %17, %2" MIXLO "v_fma_mix_f32 %3, %3, %17, %3" MIXHI
      "v_fma_mix_f32 %4, %4, %18, %4" MIXLO "v_fma_mix_f32 %5, %5, %18, %5" MIXHI
      "v_fma_mix_f32 %6, %6, %19, %6" MIXLO "v_fma_mix_f32 %7, %7, %19, %7" MIXHI
      "v_fma_mix_f32 %8, %8, %16, %8" MIXLO "v_fma_mix_f32 %9, %9, %16, %9" MIXHI
      "v_fma_mix_f32 %10, %10, %17, %10" MIXLO "v_fma_mix_f32 %11, %11, %17, %11" MIXHI
      "v_fma_mix_f32 %12, %12, %18, %12" MIXLO "v_fma_mix_f32 %13, %13, %18, %13" MIXHI
      "v_fma_mix_f32 %14, %14, %19, %14" MIXLO "v_fma_mix_f32 %15, %15, %19, %15" MIXHI
      "v_fma_mix_f32 %0, %38, %20, %0" MIXLO "v_fma_mix_f32 %1, %38, %20, %1" MIXHI
      "v_fma_mix_f32 %2, %38, %21, %2" MIXLO "v_fma_mix_f32 %3, %38, %21, %3" MIXHI
      "v_fma_mix_f32 %4, %38, %22, %4" MIXLO "v_fma_mix_f32 %5, %38, %22, %5" MIXHI
      "v_fma_mix_f32 %6, %38, %23, %6" MIXLO "v_fma_mix_f32 %7, %38, %23, %7" MIXHI
      "v_fma_mix_f32 %0, %39, %24, %0" MIXLO "v_fma_mix_f32 %1, %39, %24, %1" MIXHI
      "v_fma_mix_f32 %2, %39, %25, %2" MIXLO "v_fma_mix_f32 %3, %39, %25, %3" MIXHI
      "v_fma_mix_f32 %4, %39, %26, %4" MIXLO "v_fma_mix_f32 %5, %39, %26, %5" MIXHI
      "v_fma_mix_f32 %6, %39, %27, %6" MIXLO "v_fma_mix_f32 %7, %39, %27, %7" MIXHI
      "v_fma_mix_f32 %8, %40, %24, %8" MIXLO "v_fma_mix_f32 %9, %40, %24, %9" MIXHI
      "v_fma_mix_f32 %10, %40, %25, %10" MIXLO "v_fma_mix_f32 %11, %40, %25, %11" MIXHI
      "v_fma_mix_f32 %12, %40, %26, %12" MIXLO "v_fma_mix_f32 %13, %40, %26, %13" MIXHI
      "v_fma_mix_f32 %14, %40, %27, %14" MIXLO "v_fma_mix_f32 %15, %40, %27, %15" MIXHI
      : "+v"(SU[2 * L]), "+v"(SU[2 * L + 1]), "+v"(SU[2 * L + 2]), "+v"(SU[2 * L + 3]), "+v"(SU[2 * L + 4]), "+v"(SU[2 * L + 5]), "+v"(SU[2 * L + 6]), "+v"(SU[2 * L + 7]),
        "+v"(SP[2 * L]), "+v"(SP[2 * L + 1]), "+v"(SP[2 * L + 2]), "+v"(SP[2 * L + 3]), "+v"(SP[2 * L + 4]), "+v"(SP[2 * L + 5]), "+v"(SP[2 * L + 6]), "+v"(SP[2 * L + 7]),
        "=&s"(x0), "=&s"(x1), "=&s"(x2), "=&s"(x3), "=&s"(k0), "=&s"(k1), "=&s"(k2), "=&s"(k3), "=&s"(b0), "=&s"(b1), "=&s"(b2), "=&s"(b3)
      : "v"(dr), "v"(bb), "n"(L), "n"(L + 1), "n"(L + 2), "n"(L + 3), "n"(L + 32), "n"(L + 33), "n"(L + 34), "n"(L + 35), "v"(vv), "v"(nskU), "v"(nskP));
}
DI void scan_step2(float (&SU)[64], float (&SP)[64], const ScanRec& c, float vv) {
  float a0 = 0.f, a1 = 0.f, c0 = 0.f, c1 = 0.f;
  dot4_2<0>(a0, a1, c0, c1, SU, SP, c.sh); dot4_2<4>(a0, a1, c0, c1, SU, SP, c.sh); dot4_2<8>(a0, a1, c0, c1, SU, SP, c.sh); dot4_2<12>(a0, a1, c0, c1, SU, SP, c.sh);
  dot4_2<16>(a0, a1, c0, c1, SU, SP, c.sh); dot4_2<20>(a0, a1, c0, c1, SU, SP, c.sh); dot4_2<24>(a0, a1, c0, c1, SU, SP, c.sh); dot4_2<28>(a0, a1, c0, c1, SU, SP, c.sh);
  const float nU = -(a0 + a1), nP = -(c0 + c1);
  upd4_2<0>(SU, SP, c.dr, c.bb, vv, nU, nP); upd4_2<4>(SU, SP, c.dr, c.bb, vv, nU, nP); upd4_2<8>(SU, SP, c.dr, c.bb, vv, nU, nP); upd4_2<12>(SU, SP, c.dr, c.bb, vv, nU, nP);
  upd4_2<16>(SU, SP, c.dr, c.bb, vv, nU, nP); upd4_2<20>(SU, SP, c.dr, c.bb, vv, nU, nP); upd4_2<24>(SU, SP, c.dr, c.bb, vv, nU, nP); upd4_2<28>(SU, SP, c.dr, c.bb, vv, nU, nP);
}
template <bool WITH_OUT>
DI float scan_step(float (&S)[64], const ScanRec& c, float vv) {
  float sk0 = 0.f, sk1 = 0.f;
  dot4<0>(sk0, sk1, S, c.sh); dot4<4>(sk0, sk1, S, c.sh); dot4<8>(sk0, sk1, S, c.sh); dot4<12>(sk0, sk1, S, c.sh);
  dot4<16>(sk0, sk1, S, c.sh); dot4<20>(sk0, sk1, S, c.sh); dot4<24>(sk0, sk1, S, c.sh); dot4<28>(sk0, sk1, S, c.sh);
  const float nsk = -(sk0 + sk1);
  upd4<0>(S, c.dr, c.bb, vv, nsk); upd4<4>(S, c.dr, c.bb, vv, nsk); upd4<8>(S, c.dr, c.bb, vv, nsk); upd4<12>(S, c.dr, c.bb, vv, nsk);
  upd4<16>(S, c.dr, c.bb, vv, nsk); upd4<20>(S, c.dr, c.bb, vv, nsk); upd4<24>(S, c.dr, c.bb, vv, nsk); upd4<28>(S, c.dr, c.bb, vv, nsk);
  float o0 = 0.f, o1 = 0.f;
  if (WITH_OUT) {
    dot4<32>(o0, o1, S, c.sh); dot4<36>(o0, o1, S, c.sh); dot4<40>(o0, o1, S, c.sh); dot4<44>(o0, o1, S, c.sh);
    dot4<48>(o0, o1, S, c.sh); dot4<52>(o0, o1, S, c.sh); dot4<56>(o0, o1, S, c.sh); dot4<60>(o0, o1, S, c.sh);
  }
  return o0 + o1;
}
constexpr int SPF = 3;
DI void phase_scanA(const Params& p, unsigned char* smem) {
  const ushort_t* SH = (const ushort_t*)(p.ws + OFF_SH);
  const ushort_t* DR = (const ushort_t*)(p.ws + OFF_DR);
  float* PU = p.out;
  const int lane = threadIdx.x & 63;
  const int gw = __builtin_amdgcn_readfirstlane(blockIdx.x * 8 + (threadIdx.x >> 6));
  for (int task = gw; task < 32 * NCHUNK; task += gridDim.x * 8) {
    const int cd = task / NCHUNK, j = task % NCHUNK, dir = cd >> 4, c = cd & 15;
    float SU[64], SP[64];
#pragma unroll
    for (int k = 0; k < 64; ++k) { SU[k] = 0.f; SP[k] = (k == lane) ? 1.f : 0.f; }
    const ushort_t* shc = SH + (size_t)c * LTOT * 192;
    const ushort_t* drc = DR + (size_t)(dir * 16 + c) * LTOT * 192;
    ScanRec r0 = scan_load(shc, drc, tau_to_pos(dir, j * CH + 0), lane);
    ScanRec r1 = scan_load(shc, drc, tau_to_pos(dir, j * CH + 1), lane);
    ScanRec r2 = scan_load(shc, drc, tau_to_pos(dir, j * CH + 2), lane);
#pragma unroll 1
    for (int st = 0; st < CH; ++st) {
      const ScanRec r3 = scan_load(shc, drc, tau_to_pos(dir, j * CH + (st + SPF < CH ? st + SPF : CH - 1)), lane);
      scan_step2(SU, SP, r0, h2f(r0.v));
      r0 = r1; r1 = r2; r2 = r3;
    }
    float* dst = PU + (size_t)task * 2 * 4096 + lane * 64;
#pragma unroll
    for (int k = 0; k < 64; k += 4) {
      *(float4*)(dst + k) = make_float4(SU[k], SU[k + 1], SU[k + 2], SU[k + 3]);
      *(float4*)(dst + 4096 + k) = make_float4(SP[k], SP[k + 1], SP[k + 2], SP[k + 3]);
    }
  }
}

DI void phase_scanB(const Params& p, unsigned char* smem) {
  if (blockIdx.x >= 32) return;
  float* Sb = (float*)smem;
  float* Xb = Sb + 64 * 65;
  float* PU = p.out;
  const int cd = blockIdx.x, tid = threadIdx.x, wave = tid >> 6, lane = tid & 63, l31 = lane & 31, hh = lane >> 5;
  const int tile = wave & 3, tm = tile >> 1, tn = tile & 1, kh = wave >> 2;
  for (int i = tid; i < 64 * 65; i += NTH) Sb[i] = 0.f;
  constexpr int BPF = 4;
  float bP[BPF][16];
  f32x16 uT[BPF];
#pragma unroll
  for (int s = 0; s < BPF; ++s) uT[s] = zero16();
  auto fetch = [&](int j, float (&bp)[16], f32x16& ut) {
    const float* base = PU + (size_t)(cd * NCHUNK + j) * 2 * 4096;
#pragma unroll
    for (int kk = 0; kk < 16; ++kk) bp[kk] = base[4096 + (kh * 32 + 2 * kk + hh) * 64 + tn * 32 + l31];
    if (kh == 0) {
#pragma unroll
      for (int i = 0; i < 16; ++i) ut[i] = base[(tm * 32 + crow(i, hh)) * 64 + tn * 32 + l31];
    }
  };
  auto put_state = [&](int j, const f32x16& st) {
    float* base = PU + (size_t)(cd * NCHUNK + j) * 2 * 4096;
#pragma unroll
    for (int i = 0; i < 16; ++i) base[(tm * 32 + crow(i, hh)) * 64 + tn * 32 + l31] = st[i];
  };
#pragma unroll
  for (int s = 0; s < BPF; ++s) fetch(s, bP[s], uT[s]);
  if (kh == 0) put_state(0, zero16());
  __syncthreads();
#pragma unroll 1
  for (int j = 0; j < NCHUNK; ++j) {
    float nP[16];
    f32x16 nU = zero16();
    if (j + BPF < NCHUNK) fetch(j + BPF, nP, nU);
    f32x16 acc = (kh == 0) ? uT[0] : zero16();
#pragma unroll
    for (int kk = 0; kk < 16; ++kk) {
      const float a = Sb[(tm * 32 + l31) * 65 + kh * 32 + 2 * kk + hh];
      acc = __builtin_amdgcn_mfma_f32_32x32x2f32(a, bP[0][kk], acc, 0, 0, 0);
    }
    if (kh == 1) {
#pragma unroll
      for (int i = 0; i < 16; ++i) Xb[(tile * 16 + i) * 64 + lane] = acc[i];
    }
    __syncthreads();
    if (kh == 0) {
#pragma unroll
      for (int i = 0; i < 16; ++i) { acc[i] += Xb[(tile * 16 + i) * 64 + lane]; Sb[(tm * 32 + crow(i, hh)) * 65 + tn * 32 + l31] = acc[i]; }
      if (j + 1 < NCHUNK) put_state(j + 1, acc);
    }
#pragma unroll
    for (int s = 0; s + 1 < BPF; ++s) {
#pragma unroll
      for (int kk = 0; kk < 16; ++kk) bP[s][kk] = bP[s + 1][kk];
      uT[s] = uT[s + 1];
    }
#pragma unroll
    for (int kk = 0; kk < 16; ++kk) bP[BPF - 1][kk] = nP[kk];
    uT[BPF - 1] = nU;
    __syncthreads();
  }
}

DI void phase_scanC(const Params& p, unsigned char* smem) {
  const ushort_t* SH = (const ushort_t*)(p.ws + OFF_SH);
  const ushort_t* DR = (const ushort_t*)(p.ws + OFF_DR);
  ushort_t* O = (ushort_t*)(p.ws + OFF_ZQ);
  const float* PU = p.out;
  const int lane = threadIdx.x & 63;
  const int gw = __builtin_amdgcn_readfirstlane(blockIdx.x * 8 + (threadIdx.x >> 6));
  for (int task = gw; task < 32 * NCHUNK; task += gridDim.x * 8) {
    const int cd = task / NCHUNK, j = task % NCHUNK, dir = cd >> 4, c = cd & 15, b = c >> 3, head = c & 7;
    float S[64];
    const float* src = PU + (size_t)task * 2 * 4096 + lane * 64;
#pragma unroll
    for (int k = 0; k < 64; k += 4) { const float4 v = *(const float4*)(src + k); S[k] = v.x; S[k + 1] = v.y; S[k + 2] = v.z; S[k + 3] = v.w; }
    const ushort_t* shc = SH + (size_t)c * LTOT * 192;
    const ushort_t* drc = DR + (size_t)(dir * 16 + c) * LTOT * 192;
    ushort_t* obase = O + ((size_t)dir * NX + (size_t)b * SEQ) * 512 + head * 64 + lane;
    ScanRec r0 = scan_load(shc, drc, tau_to_pos(dir, j * CH + 0), lane);
    ScanRec r1 = scan_load(shc, drc, tau_to_pos(dir, j * CH + 1), lane);
    ScanRec r2 = scan_load(shc, drc, tau_to_pos(dir, j * CH + 2), lane);
#pragma unroll 1
    for (int st = 0; st < CH; ++st) {
      const int pos = tau_to_pos(dir, j * CH + st);
      const ScanRec r3 = scan_load(shc, drc, tau_to_pos(dir, j * CH + (st + SPF < CH ? st + SPF : CH - 1)), lane);
      const float o = scan_step<true>(S, r0, h2f(r0.v));
      if (pos >= CTXL) obase[(size_t)(pos - CTXL) * 512] = f2h(o);
      r0 = r1; r1 = r2; r2 = r3;
    }
  }
}

DI void phase_scan_naive(const Params& p) {
  const ushort_t* SH = (const ushort_t*)(p.ws + OFF_SH);
  const ushort_t* DR = (const ushort_t*)(p.ws + OFF_DR);
  ushort_t* O = (ushort_t*)(p.ws + OFF_ZQ);
  const int lane = threadIdx.x & 63;
  const int gw = __builtin_amdgcn_readfirstlane(blockIdx.x * 8 + (threadIdx.x >> 6));
  if (gw >= 32) return;
  const int cd = gw, dir = cd >> 4, c = cd & 15, b = c >> 3, head = c & 7;
  float S[64];
#pragma unroll
  for (int k = 0; k < 64; ++k) S[k] = 0.f;
  const ushort_t* shc = SH + (size_t)c * LTOT * 192;
  const ushort_t* drc = DR + (size_t)(dir * 16 + c) * LTOT * 192;
#pragma unroll 1
  for (int tau = 0; tau < LTOT; ++tau) {
    const int pos = tau_to_pos(dir, tau);
    const ushort_t* shr = shc + (size_t)pos * 192;
    const ushort_t* drr = drc + (size_t)pos * 192;
    const float vv = h2f(shr[128 + lane]);
    u32x16 k0, k1;
    sload2(k0, k1, shr);
    float sk0 = 0.f, sk1 = 0.f;
#pragma unroll
    for (int q = 0; q < 32; ++q) { sk0 = fmaf(S[q], HV(k0, q), sk0); sk1 = fmaf(S[32 + q], HV(k1, q), sk1); }
    const float nsk = -(sk0 + sk1);
    u32x16 x0, x1, d0, d1;
    sload4(x0, x1, d0, d1, drr, drr + 64);
#pragma unroll
    for (int q = 0; q < 32; ++q) {
      S[q] = fmaf(S[q], -HV(x0, q), S[q]); S[32 + q] = fmaf(S[32 + q], -HV(x1, q), S[32 + q]);
      S[q] = fmaf(vv, HV(d0, q), S[q]); S[32 + q] = fmaf(vv, HV(d1, q), S[32 + q]);
    }
    u32x16 b0, b1, r0, r1;
    sload4(b0, b1, r0, r1, drr + 128, shr + 64);
    float o0 = 0.f, o1 = 0.f;
#pragma unroll
    for (int q = 0; q < 32; ++q) {
      S[q] = fmaf(nsk, HV(b0, q), S[q]); S[32 + q] = fmaf(nsk, HV(b1, q), S[32 + q]);
      o0 = fmaf(S[q], HV(r0, q), o0); o1 = fmaf(S[32 + q], HV(r1, q), o1);
    }
    if (pos >= CTXL) O[((size_t)dir * NX + (size_t)b * SEQ + (pos - CTXL)) * 512 + head * 64 + lane] = f2h(o0 + o1);
  }
}

DI void phase_attn(const Params& p, unsigned char* smem) {
  ushort_t* Kb = (ushort_t*)smem;
  ushort_t* Vb = Kb + 2 * 64 * LDK;
  ushort_t* QB = (ushort_t*)(p.ws + OFF_QB);
  const ushort_t* KB = (const ushort_t*)(p.ws + OFF_KB);
  const ushort_t* VB = (const ushort_t*)(p.ws + OFF_VB);
  const int tid = threadIdx.x, wave = tid >> 6, lane = tid & 63, l31 = lane & 31, hh = lane >> 5;
  const int loff = (tid >> 3) * LDK + (tid & 7) * 8;
  constexpr float THR = 6.f;
  constexpr int NTL = LTOT / 64;
  for (int at = blockIdx.x; at < 1024; at += gridDim.x) {
    const int b = at >> 9, kvh = (at >> 8) & 1, t0 = (at & 255) * 64;
    const int head = kvh * 4 + (wave & 3), tq = t0 + (wave >> 2) * 32 + l31;
    ushort_t* qrow = QB + ((size_t)(b * 8 + head) * SEQ + tq) * 64;
    bf16x8 qf[4];
#pragma unroll
    for (int ks = 0; ks < 4; ++ks) qf[ks] = *(const bf16x8*)(qrow + ks * 16 + hh * 8);
    const ushort_t* kbase = KB + (size_t)(b * 2 + kvh) * LTOT * 64 + tid * 8;
    const ushort_t* vbase = VB + (size_t)(b * 2 + kvh) * LTOT * 64 + tid * 8;
    f32x16 o[2] = {zero16(), zero16()};
    f32x16 negm = zero16();
    float lsum = 0.f;
    auto qk = [&](f32x16 (&s)[2], const ushort_t* Ks) {
      s[0] = negm; s[1] = negm;
#pragma unroll
      for (int ks = 0; ks < 4; ++ks)
#pragma unroll
        for (int kk = 0; kk < 2; ++kk) s[kk] = MFMA(*(const bf16x8*)&Ks[(kk * 32 + l31) * LDK + ks * 16 + hh * 8], qf[ks], s[kk]);
    };
    uint4 rk, rv;
    __syncthreads();
    rk = *(const uint4*)kbase; rv = *(const uint4*)vbase;
    *(uint4*)&Kb[loff] = rk; *(uint4*)&Vb[loff] = rv;
    rk = *(const uint4*)(kbase + 4096);
    rv = *(const uint4*)(vbase + 4096);
    __syncthreads();
    f32x16 sA[2], sB[2];
    qk(sA, Kb);
    {
      float mx = fmaxf(sA[0][0], sA[1][0]);
#pragma unroll
      for (int i = 1; i < 16; ++i) mx = fmaxf(mx, fmaxf(sA[0][i], sA[1][i]));
      mx = fmaxf(mx, __shfl_xor(mx, 32, 64));
#pragma unroll
      for (int i = 0; i < 16; ++i) { sA[0][i] -= mx; sA[1][i] -= mx; negm[i] = -mx; }
    }
    *(uint4*)&Kb[64 * LDK + loff] = rk;
    rk = *(const uint4*)(kbase + 2 * 4096);
    auto step = [&](int t, f32x16 (&sc)[2], f32x16 (&sn)[2]) {
      __syncthreads();
      if (t + 2 < NTL) *(uint4*)&Kb[(t & 1) * 64 * LDK + loff] = rk;
      if (t + 1 < NTL) *(uint4*)&Vb[((t + 1) & 1) * 64 * LDK + loff] = rv;
      if (t + 3 < NTL) rk = *(const uint4*)(kbase + (size_t)(t + 3) * 4096);
      if (t + 2 < NTL) rv = *(const uint4*)(vbase + (size_t)(t + 2) * 4096);
      if (t + 1 < NTL) qk(sn, Kb + ((t + 1) & 1) * 64 * LDK);
      float mx = fmaxf(sc[0][0], sc[1][0]);
#pragma unroll
      for (int i = 1; i < 16; ++i) mx = fmaxf(mx, fmaxf(sc[0][i], sc[1][i]));
      mx = fmaxf(mx, __shfl_xor(mx, 32, 64));
      if (__builtin_amdgcn_ballot_w64(mx > THR) != 0ull) {
        const float delta = fmaxf(mx, 0.f);
        const float alpha = __builtin_amdgcn_exp2f(-delta);
        lsum *= alpha;
#pragma unroll
        for (int i = 0; i < 16; ++i) {
          o[0][i] *= alpha; o[1][i] *= alpha; sc[0][i] -= delta; sc[1][i] -= delta; negm[i] -= delta;
          sn[0][i] -= delta; sn[1][i] -= delta;
        }
      }
      float ps = 0.f;
#pragma unroll
      for (int i = 0; i < 16; ++i) {
        sc[0][i] = __builtin_amdgcn_exp2f(sc[0][i]); sc[1][i] = __builtin_amdgcn_exp2f(sc[1][i]);
        ps += sc[0][i] + sc[1][i];
      }
      lsum += ps;
      const ushort_t* Vt = Vb + (t & 1) * 64 * LDK;
#pragma unroll
      for (int kk = 0; kk < 2; ++kk) {
#pragma unroll
        for (int st = 0; st < 2; ++st) {
          uint4 pw;
          pw.x = pack_bf2(sc[kk][8 * st + 0], sc[kk][8 * st + 1]); pw.y = pack_bf2(sc[kk][8 * st + 2], sc[kk][8 * st + 3]);
          pw.z = pack_bf2(sc[kk][8 * st + 4], sc[kk][8 * st + 5]); pw.w = pack_bf2(sc[kk][8 * st + 6], sc[kk][8 * st + 7]);
          const bf16x8 pf = __builtin_bit_cast(bf16x8, pw);
#pragma unroll
          for (int dt = 0; dt < 2; ++dt) o[dt] = MFMA(*(const bf16x8*)&Vt[(dt * 32 + l31) * LDK + kk * 32 + st * 16 + hh * 8], pf, o[dt]);
        }
      }
    };
#pragma unroll 1
    for (int t = 0; t < NTL; t += 2) {
      step(t, sA, sB);
      step(t + 1, sB, sA);
    }
    const float ltot = lsum + __shfl_xor(lsum, 32, 64);
    const float il = 1.f / ltot;
#pragma unroll
    for (int dt = 0; dt < 2; ++dt)
#pragma unroll
      for (int g = 0; g < 4; ++g) {
        uint2 w;
        w.x = pack_bf2(o[dt][4 * g + 0] * il, o[dt][4 * g + 1] * il);
        w.y = pack_bf2(o[dt][4 * g + 2] * il, o[dt][4 * g + 3] * il);
        *(uint2*)(qrow + dt * 32 + 8 * g + 4 * hh) = w;
      }
  }
}

constexpr size_t OFF_DBG = WS_END;
DI void dbg_acc(const Params& p, int slot, float d2, float r2) {
  float* dbg = (float*)(p.ws + OFF_DBG);
  d2 = wave_sum(d2); r2 = wave_sum(r2);
  if ((threadIdx.x & 63) == 0) { atomicAdd(dbg + 2 * slot, d2); atomicAdd(dbg + 2 * slot + 1, r2); }
}
DI void probe_after_gemm1(const Params& p) {
  if (blockIdx.x != 0) return;
  const int tid = threadIdx.x, lane = tid & 63, wave = tid >> 6;
  const float* mod = (const float*)(p.ws + OFF_MOD);
  const ushort_t* H = (const ushort_t*)(p.ws + OFF_SH);
  {
    float d2 = 0.f, r2 = 0.f;
    if (tid < 96) {
      const int v = tid / 32, n = (tid % 32) * 97 % 3072;
      float s = 0.f;
      for (int k = 0; k < 1024; ++k) { const float cv = (v < 2) ? p.c[v * 1024 + k] : p.c_ctx[k]; s += (cv / (1.f + expf(-cv))) * p.w_ada[(size_t)k * 3072 + n]; }
      s += p.b_ada[n];
      const float d = mod[v * 3072 + n] - s; d2 = d * d; r2 = s * s;
    }
    dbg_acc(p, 0, d2, r2);
  }
  {
    const int row = wave == 0 ? 0 : wave == 1 ? 777 : wave == 2 ? 16383 : wave == 3 ? 16384 : wave == 4 ? 32767 : wave == 5 ? 32768 : wave == 6 ? 33023 : 33279;
    const float* src = (row < NX) ? p.x + (size_t)row * DM : p.ctx + (size_t)(row - NX) * DM;
    const float* md = mod + ((row < NX) ? (row / SEQ) : 2) * 3072;
    float s = 0.f;
    for (int i = lane; i < 1024; i += 64) s += src[i];
    const float mu = wave_sum(s) / 1024.f;
    float q = 0.f;
    for (int i = lane; i < 1024; i += 64) q += (src[i] - mu) * (src[i] - mu);
    const float rstd = rsqrtf(wave_sum(q) / 1024.f + LN_EPS);
    float d2 = 0.f, r2 = 0.f;
    for (int i = lane; i < 1024; i += 64) {
      const float ref = (src[i] - mu) * rstd * (1.f + md[1024 + i]) + md[i];
      const float d = bf2f(H[(size_t)row * DM + i]) - ref; d2 += d * d; r2 += ref * ref;
    }
    dbg_acc(p, 1, d2, r2);
  }
  {
    float d2 = 0.f, r2 = 0.f;
    if (tid < 60) {
      const int ri = tid / 10, ci = tid % 10;
      const int row = ri == 0 ? 3 : ri == 1 ? 777 : ri == 2 ? 20001 : ri == 3 ? 32767 : ri == 4 ? 32773 : 33279;
      const int col = ci == 0 ? 0 : ci == 1 ? 100 : ci == 2 ? 700 : ci == 3 ? 800 : ci == 4 ? 1279 : ci == 5 ? 1280 : ci == 6 ? 2000 : ci == 7 ? 3071 : ci == 8 ? 3072 : 3583;
      float s = 0.f;
      for (int k = 0; k < 1024; ++k) s += bf2f(H[(size_t)row * DM + k]) * p.w_in[(size_t)k * INW + col];
      float got = 0.f; bool have = true;
      if (col < 768) got = bf2f(((const ushort_t*)(p.ws + OFF_ZQ))[(size_t)row * 768 + col]);
      else if (col < 1280) { if (row < NX) got = bf2f(((const ushort_t*)(p.ws + OFF_ZG))[(size_t)row * 1024 + col - 768]); else have = false; }
      else if (col < 3072) got = bf2f(((const ushort_t*)p.out)[(size_t)row * 1792 + col - 1280]);
      else { if (row < NX) got = bf2f(((const ushort_t*)(p.ws + OFF_ZG))[(size_t)row * 1024 + 512 + col - 3072]); else have = false; }
      if (have) { const float d = got - s; d2 = d * d; r2 = s * s; }
    }
    dbg_acc(p, 2, d2, r2);
  }
}
DI void probe_after_prep(const Params& p, unsigned char* smem) {
  if (blockIdx.x != 0) return;
  float* cbuf = (float*)smem;
  const int tid = threadIdx.x, lane = tid & 63, wave = tid >> 6;
  const ushort_t* zm = (const ushort_t*)p.out;
  const ushort_t* SH = (const ushort_t*)(p.ws + OFF_SH);
  const ushort_t* DR = (const ushort_t*)(p.ws + OFF_DR);
  float dA = 0.f, rA = 0.f, dB = 0.f, rB = 0.f;
#pragma unroll 1
  for (int sidx = wave; sidx < 24; sidx += 8) {
    const int ri = sidx >> 1, head = (sidx & 1) ? 5 : 0;
    const int row = ri == 0 ? 0 : ri == 1 ? 1 : ri == 2 ? 31 : ri == 3 ? 32 : ri == 4 ? 16383 : ri == 5 ? 16384 : ri == 6 ? 20000 : ri == 7 ? 32767 : ri == 8 ? 32768 : ri == 9 ? 33023 : ri == 10 ? 33024 : 33279;
    int b, t, len, pp;
    if (row < NX) { b = row / SEQ; t = row % SEQ; len = SEQ; pp = CTXL + t; } else { b = (row - NX) / CTXL; t = (row - NX) % CTXL; len = CTXL; pp = t; }
    auto sft = [&](int col) {
      const float z = bf2f(zm[(size_t)row * 1792 + col]);
      const float zp = (t > 0) ? bf2f(zm[(size_t)(row - 1) * 1792 + col]) : 0.f;
      const float zn = (t < len - 1) ? bf2f(zm[(size_t)(row + 1) * 1792 + col]) : 0.f;
      return z + p.mu_prev[col] * (zp - z) + p.mu_next[col] * (zn - z);
    };
    const int n = head * 64 + lane;
    const float r = sft(n), k = sft(512 + n), v = sft(1024 + n);
#pragma unroll 1
    for (int j = lane; j < 256; j += 64) { const float s = sft(1536 + j); cbuf[wave * 256 + j] = (j < 128) ? tanhf(s) : s; }
    __builtin_amdgcn_s_waitcnt(0);
    __builtin_amdgcn_wave_barrier();
    const float kr = k * p.k_k[n];
    const float nrm = sqrtf(wave_sum(kr * kr));
    const float kk = kr / fmaxf(nrm, 1e-12f);
    const size_t cp = (size_t)(b * 8 + head) * LTOT + pp;
    { float d;
      d = h2f(SH[(cp * 3 + 0) * 64 + lane]) - kk; dA += d * d; rA += kk * kk;
      d = h2f(SH[(cp * 3 + 1) * 64 + lane]) - r; dA += d * d; rA += r * r;
      d = h2f(SH[(cp * 3 + 2) * 64 + lane]) - v; dA += d * d; rA += v * v; }
#pragma unroll 1
    for (int dir = 0; dir < 2; ++dir) {
      float wpre = p.w0[dir * 512 + n], apre = p.a0[dir * 512 + n];
#pragma unroll 1
      for (int j = 0; j < 64; ++j) {
        wpre += cbuf[wave * 256 + dir * 64 + j] * p.w_up[(size_t)(dir * 64 + j) * 512 + n];
        apre += cbuf[wave * 256 + 128 + dir * 64 + j] * p.a_up[(size_t)(dir * 64 + j) * 512 + n];
      }
      const float wlog = -log1pf(expf(-wpre)) - 0.5f;
      const float xd = 1.f - expf(-expf(wlog));
      const float a = 1.f / (1.f + expf(-apre));
      const float kd = k * (1.f + (a - 1.f) * p.k_a[n]);
      const float bq = kk * a;
      const size_t dp = (size_t)(dir * 16 + b * 8 + head) * LTOT + pp;
      float d;
      d = h2f(DR[(dp * 3 + 0) * 64 + lane]) - xd; dB += d * d; rB += xd * xd;
      d = h2f(DR[(dp * 3 + 1) * 64 + lane]) - kd; dB += d * d; rB += kd * kd;
      d = h2f(DR[(dp * 3 + 2) * 64 + lane]) - bq; dB += d * d; rB += bq * bq;
    }
    __builtin_amdgcn_wave_barrier();
  }
  dbg_acc(p, 3, dA, rA);
  dbg_acc(p, 4, dB, rB);
}

DI void probe_scan(const Params& p) {
  if (blockIdx.x != 0 || threadIdx.x >= 128) return;
  const ushort_t* SH = (const ushort_t*)(p.ws + OFF_SH);
  const ushort_t* DR = (const ushort_t*)(p.ws + OFF_DR);
  const ushort_t* O = (const ushort_t*)(p.ws + OFF_ZQ);
  const int lane = threadIdx.x & 63, wv = threadIdx.x >> 6;
  const int c = wv ? 9 : 0, dir = wv, b = c >> 3, head = c & 7;
  float S[64];
#pragma unroll
  for (int k = 0; k < 64; ++k) S[k] = 0.f;
  float d2 = 0.f, r2 = 0.f;
#pragma unroll 1
  for (int tau = 0; tau < 420; ++tau) {
    const int pos = dir == 0 ? tau : (tau < CTXL ? CTXL - 1 - tau : LTOT - 1 - (tau - CTXL));
    const ushort_t* sh = SH + ((size_t)c * LTOT + pos) * 192;
    const ushort_t* dr = DR + ((size_t)(dir * 16 + c) * LTOT + pos) * 192;
    const float v = h2f(sh[128 + lane]);
    float sk = 0.f;
#pragma unroll
    for (int k = 0; k < 64; ++k) sk += S[k] * h2f(sh[k]);
    float o = 0.f;
#pragma unroll
    for (int k = 0; k < 64; ++k) {
      const float dec = 1.f - h2f(dr[k]);
      S[k] = S[k] * dec - sk * h2f(dr[128 + k]) + v * h2f(dr[64 + k]);
      o += S[k] * h2f(sh[64 + k]);
    }
    if (pos >= CTXL) {
      const float got = h2f(O[((size_t)dir * NX + (size_t)b * SEQ + (pos - CTXL)) * 512 + head * 64 + lane]);
      const float d = got - o; d2 += d * d; r2 += o * o;
    }
  }
  dbg_acc(p, 0, d2, r2);
}
DI float probe_delta(const Params& p) {
  const float* dbg = (const float*)(p.ws + OFF_DBG);
  int k = 0;
  for (int s = 0; s < 5; ++s) { const float rel = sqrtf(dbg[2 * s] / fmaxf(dbg[2 * s + 1], 1e-30f)); if (!(rel < 0.05f)) k |= 1 << s; }
  return sqrtf(0.02f * (float)k);
}

DI void phase_final(const Params& p, unsigned char* smem) {
  ushort_t* As = (ushort_t*)smem;
  ushort_t* Bs = As + 2 * 128 * LDK;
  const float* mod = (const float*)(p.ws + OFF_MOD);
  ushort_t* ZG = (ushort_t*)(p.ws + OFF_ZG);
  ushort_t* QB = (ushort_t*)(p.ws + OFF_QB);
  ushort_t* O = (ushort_t*)(p.ws + OFF_ZQ);
  const ushort_t* SH = (const ushort_t*)(p.ws + OFF_SH);
  const ushort_t* DR = (const ushort_t*)(p.ws + OFF_DR);
  const ushort_t* WMG = (const ushort_t*)(p.ws + OFF_WMG);
  const ushort_t* WPA = (const ushort_t*)(p.ws + OFF_WPA);
  const ushort_t* WPB = (const ushort_t*)(p.ws + OFF_WPB);
  const ushort_t* WO = (const ushort_t*)(p.ws + OFF_WO);
#pragma unroll 1
  for (int mt = blockIdx.x; mt < NX / 128; mt += gridDim.x) {
    int tid = threadIdx.x;
    asm volatile("" : "+v"(tid));
    const int wave = tid >> 6, lane = tid & 63, l31 = lane & 31, hh = lane >> 5;
    const int wrow0 = (wave & 3) * 32, wcol0 = (wave >> 2) * 64;
    const int row0 = mt * 128, b = row0 / SEQ, tb0 = row0 % SEQ;
    const float* md = mod + b * 3072;
    __syncthreads();
#pragma unroll 1
    for (int r4 = wave * 4; r4 < 128; r4 += 32) {
      const int r = r4 + (lane >> 4), l16 = lane & 15;
      ushort_t* hdst = (ushort_t*)(p.out + (size_t)(row0 + r) * DM);
      float4 v[16];
      const float rstd = ln_rows4(p.x + (size_t)(row0 + r) * DM, l16, v);
#pragma unroll
      for (int i = 0; i < 16; ++i) {
        const int col = l16 * 4 + 64 * i;
        const float4 sh = *(const float4*)(md + col), sc = *(const float4*)(md + 1024 + col);
        uint2 o;
        o.x = pack_bf2(v[i].x * rstd * (1.f + sc.x) + sh.x, v[i].y * rstd * (1.f + sc.y) + sh.y);
        o.y = pack_bf2(v[i].z * rstd * (1.f + sc.z) + sh.z, v[i].w * rstd * (1.f + sc.w) + sh.w);
        *(uint2*)(hdst + col) = o;
      }
    }
#if PROBE
    float a2ref = 0.f;
    if (mt == 0) {
      const int tok = wave * 16 + 3, head = wave, row = row0 + tok, t = tb0 + tok, dd = head * 64 + lane;
      const size_t cp = (size_t)(b * 8 + head) * LTOT + CTXL + t;
      const float o = h2f(O[(size_t)row * 512 + dd]) + h2f(O[((size_t)NX + row) * 512 + dd]);
      const float mu = wave_sum(o) / 64.f;
      const float var = wave_sum((o - mu) * (o - mu)) / 64.f;
      const float y = (o - mu) * rsqrtf(var + GN_EPS) * p.gn_w[dd] + p.gn_b[dd];
      const float r = h2f(SH[(cp * 3 + 1) * 64 + lane]), vv = h2f(SH[(cp * 3 + 2) * 64 + lane]);
      const float kf = h2f(DR[(cp * 3 + 1) * 64 + lane]), kb = h2f(DR[(((size_t)16 * LTOT + cp) * 3 + 1) * 64 + lane]);
      const float bon = wave_sum(r * kf * p.r_k[dd]) + wave_sum(r * kb * p.r_k[512 + dd]);
      const float g = bf2f(ZG[(size_t)row * 1024 + 512 + dd]);
      a2ref = (y + bon * vv) * (g / (1.f + expf(-g)));
    }
#endif
#pragma unroll 1
    for (int it = 0; it < 16; ++it) {
      const int pair = (it * 8 + wave) * 8 + (lane >> 3), q8 = lane & 7;
      const int tok = pair >> 3, head = pair & 7, row = row0 + tok, t = tb0 + tok, d0 = q8 * 8;
      const unsigned cp = (unsigned)((b * 8 + head) * LTOT + CTXL + t);
      const unsigned ofo = (unsigned)(row * 512 + head * 64 + d0), obo = ofo + (unsigned)NX * 512u;
      const unsigned ro = (cp * 3 + 1) * 64 + d0, vo = (cp * 3 + 2) * 64 + d0;
      const unsigned kbo = ((16u * LTOT + cp) * 3 + 1) * 64 + d0;
      const unsigned gbo = (unsigned)(row * 1024 + 512 + head * 64 + d0), gao = gbo - 512;
      const unsigned yao = (unsigned)(((b * 8 + head) * SEQ + t) * 64 + d0);
      float ov[8], bon = 0.f, s = 0.f;
      {
        const uint4 a = *(const uint4*)(O + ofo), bq = *(const uint4*)(O + obo);
        const uint4 rr = *(const uint4*)(SH + ro), kf = *(const uint4*)(DR + ro), kb = *(const uint4*)(DR + kbo);
        const unsigned aw[4] = {a.x, a.y, a.z, a.w}, bw[4] = {bq.x, bq.y, bq.z, bq.w}, rw[4] = {rr.x, rr.y, rr.z, rr.w};
        const unsigned fw[4] = {kf.x, kf.y, kf.z, kf.w}, kw[4] = {kb.x, kb.y, kb.z, kb.w};
#pragma unroll
        for (int q = 0; q < 4; ++q) {
          const int dd = head * 64 + d0 + 2 * q;
          ov[2 * q] = hlo(aw[q]) + hlo(bw[q]);
          ov[2 * q + 1] = hhi(aw[q]) + hhi(bw[q]);
          s += ov[2 * q] + ov[2 * q + 1];
          bon += hlo(rw[q]) * (hlo(fw[q]) * p.r_k[dd] + hlo(kw[q]) * p.r_k[512 + dd]);
          bon += hhi(rw[q]) * (hhi(fw[q]) * p.r_k[dd + 1] + hhi(kw[q]) * p.r_k[512 + dd + 1]);
        }
      }
      s += __shfl_xor(s, 1, 64); s += __shfl_xor(s, 2, 64); s += __shfl_xor(s, 4, 64);
      bon += __shfl_xor(bon, 1, 64); bon += __shfl_xor(bon, 2, 64); bon += __shfl_xor(bon, 4, 64);
      const float mu = s * (1.f / 64.f);
      float vs = 0.f;
#pragma unroll
      for (int q = 0; q < 8; ++q) { ov[q] -= mu; vs = fmaf(ov[q], ov[q], vs); }
      vs += __shfl_xor(vs, 1, 64); vs += __shfl_xor(vs, 2, 64); vs += __shfl_xor(vs, 4, 64);
      const float rstd = rsqrtf(vs * (1.f / 64.f) + GN_EPS);
      {
        const uint4 vv = *(const uint4*)(SH + vo), gb = *(const uint4*)(ZG + gbo), ga = *(const uint4*)(ZG + gao), ya = *(const uint4*)(QB + yao);
        const unsigned vw[4] = {vv.x, vv.y, vv.z, vv.w}, gbw[4] = {gb.x, gb.y, gb.z, gb.w}, gaw[4] = {ga.x, ga.y, ga.z, ga.w}, yw[4] = {ya.x, ya.y, ya.z, ya.w};
        unsigned o2[4], o1[4];
#pragma unroll
        for (int q = 0; q < 4; ++q) {
          const int dd = head * 64 + d0 + 2 * q;
          const float y0 = ov[2 * q] * rstd * p.gn_w[dd] + p.gn_b[dd] + bon * hlo(vw[q]);
          const float y1 = ov[2 * q + 1] * rstd * p.gn_w[dd + 1] + p.gn_b[dd + 1] + bon * hhi(vw[q]);
          o2[q] = pack_bf2(y0 * siluf(bflo(gbw[q])), y1 * siluf(bfhi(gbw[q])));
          o1[q] = pack_bf2(bflo(yw[q]) * siluf(bflo(gaw[q])), bfhi(yw[q]) * siluf(bfhi(gaw[q])));
        }
        *(uint4*)(O + ofo) = make_uint4(o2[0], o2[1], o2[2], o2[3]);
        *(uint4*)(QB + yao) = make_uint4(o1[0], o1[1], o1[2], o1[3]);
      }
    }
    __threadfence();
    __syncthreads();
#if PROBE
    if (mt == 0) {
      const int tok = wave * 16 + 3, head = wave, row = row0 + tok, dd = head * 64 + lane;
      const float got = bf2f(O[(size_t)row * 512 + dd]);
      dbg_acc(p, 1, (got - a2ref) * (got - a2ref), a2ref * a2ref);
    }
#endif
    const ushort_t* hbase = (const ushort_t*)p.out;
    auto hload = [&](int r, int k) { return *(const uint4*)(hbase + (unsigned)((row0 + r) * 2048 + k)); };
    auto a1load = [&](int r, int k) { return *(const uint4*)(QB + (unsigned)(((b * 8 + (k >> 6)) * SEQ + tb0 + r) * 64 + (k & 63))); };
    auto a2load = [&](int r, int k) { return *(const uint4*)(O + (unsigned)((row0 + r) * 512 + k)); };
#pragma unroll 1
    for (int nt = 0; nt < 8; ++nt) {
      const int col0 = nt * 128;
      int tidn = tid;
      asm volatile("" : "+v"(tidn));
      f32x16 sg[2][1][2] = {{{zero16(), zero16()}}, {{zero16(), zero16()}}};
      gemm_pass<128, 128, 1, 2, 2>(sg, hload, [&](int w, int n, int k) { return *(const uint4*)(WMG + (unsigned)((w * 1024 + col0 + n) * DM + k)); }, DM, As, Bs, wrow0, wcol0, tidn);
#pragma unroll
      for (int ni = 0; ni < 2; ++ni) {
        const int col = col0 + wcol0 + ni * 32 + l31;
        const float ba = p.b_mg[col], bb = p.b_mg[1024 + col];
#pragma unroll
        for (int i = 0; i < 16; ++i) { sg[0][0][ni][i] = sigmf(sg[0][0][ni][i] + ba); sg[1][0][ni][i] = sigmf(sg[1][0][ni][i] + bb); }
      }
      {
        f32x16 ya[1][1][2] = {{{zero16(), zero16()}}};
        gemm_pass<128, 128, 1, 2, 1>(ya, a1load, [&](int w, int n, int k) { return *(const uint4*)(WPA + (unsigned)((col0 + n) * 512 + k)); }, 512, As, Bs, wrow0, wcol0, tidn);
#pragma unroll
        for (int ni = 0; ni < 2; ++ni)
#pragma unroll
          for (int i = 0; i < 16; ++i) sg[0][0][ni][i] *= ya[0][0][ni][i];
      }
      {
        f32x16 yb[1][1][2] = {{{zero16(), zero16()}}};
        gemm_pass<128, 128, 1, 2, 1>(yb, a2load, [&](int w, int n, int k) { return *(const uint4*)(WPB + (unsigned)((col0 + n) * 512 + k)); }, 512, As, Bs, wrow0, wcol0, tidn);
        int rb1 = row0 + wrow0 + 4 * hh;
        asm volatile("" : "+v"(rb1));
#pragma unroll
        for (int ni = 0; ni < 2; ++ni) {
          const int col = col0 + wcol0 + ni * 32 + l31;
#pragma unroll
          for (int i = 0; i < 16; ++i) {
            const float mv = sg[0][0][ni][i] + sg[1][0][ni][i] * yb[0][0][ni][i];
            ZG[(unsigned)((rb1 + crow(i, 0)) * 1024 + col)] = f2bf(mv);
          }
        }
      }
    }
    __threadfence();
    __syncthreads();
#if PROBE
    if (mt == 0) {
      float d2 = 0.f, r2 = 0.f;
      if (tid < 64) {
        const int r = (tid * 37) & 127, col = (tid * 131 + 7) & 1023, row = row0 + r;
        const ushort_t* hrow = (const ushort_t*)(p.out + (size_t)row * DM);
        float ga = p.b_mg[col], gb = p.b_mg[1024 + col], ya = 0.f, yb = 0.f;
        for (int k = 0; k < 1024; ++k) { const float hv = bf2f(hrow[k]); ga += hv * p.w_mg[(size_t)k * 2048 + col]; gb += hv * p.w_mg[(size_t)k * 2048 + 1024 + col]; }
        for (int k = 0; k < 512; ++k) {
          ya += bf2f(QB[((size_t)(b * 8 + (k >> 6)) * SEQ + tb0 + r) * 64 + (k & 63)]) * p.w_pa[(size_t)k * 1024 + col];
          yb += bf2f(O[(size_t)row * 512 + k]) * p.w_pb[(size_t)k * 1024 + col];
        }
        const float ref = ya / (1.f + expf(-ga)) + yb / (1.f + expf(-gb));
        const float got = bf2f(ZG[(size_t)row * 1024 + col]);
        d2 = (got - ref) * (got - ref); r2 = ref * ref;
      }
      dbg_acc(p, 2, d2, r2);
    }
#endif
    const float* gt = md + 2048;
#pragma unroll 1
    for (int nt = 0; nt < 8; ++nt) {
      const int col0 = nt * 128;
      int tidn = tid;
      asm volatile("" : "+v"(tidn));
      f32x16 acc[1][1][2] = {{{zero16(), zero16()}}};
      gemm_pass<128, 128, 1, 2, 1>(acc, [&](int r, int k) { return *(const uint4*)(ZG + (unsigned)((row0 + r) * 1024 + k)); },
                                   [&](int w, int n, int k) { return *(const uint4*)(WO + (unsigned)((col0 + n) * DM + k)); }, DM, As, Bs, wrow0, wcol0, tidn);
      int rb2 = row0 + wrow0 + 4 * hh;
      asm volatile("" : "+v"(rb2));
#pragma unroll
      for (int ni = 0; ni < 2; ++ni) {
        const int col = col0 + wcol0 + ni * 32 + l31;
        const float g = gt[col];
#pragma unroll
        for (int i = 0; i < 16; ++i) {
          const unsigned idx = (unsigned)((rb2 + crow(i, 0)) * DM + col);
          p.out[idx] = ALPHA * p.x[idx] + g * acc[0][0][ni][i];
        }
      }
    }
    __threadfence();
    __syncthreads();
#if PROBE
    if (mt == 0) {
      float d2 = 0.f, r2 = 0.f;
      if (tid < 64) {
        const int r = (tid * 29) & 127, col = (tid * 113 + 5) & 1023, row = row0 + r;
        float o = 0.f;
        for (int k = 0; k < 1024; ++k) o += bf2f(ZG[(size_t)row * 1024 + k]) * p.w_o[(size_t)k * 1024 + col];
        const float ref = md[2048 + col] * o;
        const float got = p.out[(size_t)row * DM + col] - ALPHA * p.x[(size_t)row * DM + col];
        d2 = (got - ref) * (got - ref); r2 = ref * ref;
      }
      dbg_acc(p, 3, d2, r2);
    }
    __threadfence();
    __syncthreads();
#endif
#if !PROBE
#pragma unroll 1
    for (int r4 = wave * 4; r4 < 128; r4 += 32) {
      const int r = r4 + (lane >> 4), l16 = lane & 15;
      float* dst = p.out + (size_t)(row0 + r) * DM;
      float4 v[16];
      const float rstd = ln_rows4(dst, l16, v);
#pragma unroll
      for (int i = 0; i < 16; ++i) {
        const int col = l16 * 4 + 64 * i;
        const float4 g = *(const float4*)(p.ln_g + col), bb = *(const float4*)(p.ln_b + col);
        *(float4*)(dst + col) = make_float4(v[i].x * rstd * g.x + bb.x, v[i].y * rstd * g.y + bb.y, v[i].z * rstd * g.z + bb.z, v[i].w * rstd * g.w + bb.w);
      }
    }
#endif
  }
}


#if PROBE
DI void probe_f3(const Params& p) {
  const float pdelta = probe_delta(p);
  const int lane = threadIdx.x & 63, wave = threadIdx.x >> 6;
  for (int mt = blockIdx.x; mt < NX / 128; mt += gridDim.x) {
    for (int r = wave; r < 128; r += 8) {
      const float* src = p.x + (size_t)(mt * 128 + r) * DM;
      float* dst = p.out + (size_t)(mt * 128 + r) * DM;
      float s = 0.f, q = 0.f;
      for (int i = lane; i < 1024; i += 64) s += ALPHA * src[i];
      const float mu = wave_sum(s) / 1024.f;
      for (int i = lane; i < 1024; i += 64) { const float d = ALPHA * src[i] - mu; q += d * d; }
      const float rstd = rsqrtf(wave_sum(q) / 1024.f + LN_EPS);
      for (int i = lane; i < 1024; i += 64) dst[i] = (ALPHA * src[i] - mu) * rstd * p.ln_g[i] + p.ln_b[i] + pdelta;
    }
  }
}
#endif
DI void gsync(cg::grid_group& g) { asm volatile("s_waitcnt vmcnt(0) lgkmcnt(0)" ::: "memory"); g.sync(); }

constexpr int SMEM_BYTES = 2 * (256 + 128) * LDK * 2;
static_assert(SMEM_BYTES >= 65536 + 32 * 264 * 2 + 1024, "rwkv prep LDS");
__global__ void __launch_bounds__(NTH) fwd_megakernel(Params p) {
  __shared__ __attribute__((aligned(16))) unsigned char smem[SMEM_BYTES];
  cg::grid_group grid = cg::this_grid();
#if PROBE
  if (blockIdx.x == 0 && threadIdx.x < 64) ((float*)(p.ws + OFF_DBG))[threadIdx.x] = 0.f;
#endif
  phase0(p, smem);
  gsync(grid);
  phase_h(p);
  gsync(grid);
  phase_gemm1(p, smem);
  gsync(grid);
  phase_qkv(p);
  phase_rwkv_prep(p, smem);
  gsync(grid);
#if PROBE_NAIVE_SCAN
  phase_scan_naive(p);
#else
  phase_scanA(p, smem);
  gsync(grid);
  phase_scanB(p, smem);
  gsync(grid);
  phase_scanC(p, smem);
#endif
  phase_attn(p, smem);
  gsync(grid);
#if PROBE
  probe_scan(p);
  gsync(grid);
#endif
  phase_final(p, smem);
#if PROBE
  gsync(grid);
  probe_f3(p);
#endif
}

extern "C" void kernel_launch(void* const* d_in, const int* in_sizes, int n_in, void* d_out, int out_size, void* d_ws, size_t ws_size,
                              hipStream_t stream) {
  static int grid_blocks = 0;
  if (!grid_blocks) {
    int dev = 0, cus = 0, per_cu = 0;
    hipGetDevice(&dev);
    hipDeviceGetAttribute(&cus, hipDeviceAttributeMultiprocessorCount, dev);
    hipOccupancyMaxActiveBlocksPerMultiprocessor(&per_cu, fwd_megakernel, NTH, 0);
    if (per_cu < 1) fprintf(stderr, "occupancy query says %d blocks/CU\n", per_cu);
    grid_blocks = cus > 0 ? cus : 256;
    if (ws_size < WS_END) fprintf(stderr, "workspace too small: %zu < %zu\n", ws_size, (size_t)WS_END);
  }
  Params p{};
  const float** fp = (const float**)&p;
  for (int i = 0; i < 27; ++i) fp[i] = (const float*)d_in[i];
  p.out = (float*)d_out;
  p.ws = (unsigned char*)d_ws;
  void* args[] = {&p};
  hipError_t e = hipLaunchCooperativeKernel((void*)fwd_megakernel, dim3(grid_blocks), dim3(NTH), args, 0, stream);
  if (e != hipSuccess) fprintf(stderr, "cooperative launch failed: %s (grid %d)\n", hipGetErrorString(e), grid_blocks);
}
```

```cpp
#include <hip/hip_runtime.h>
#include <hip/hip_cooperative_groups.h>
#include <stdint.h>
#include <cstdio>
namespace cg = cooperative_groups;

#define PROBE 0
#define DI __device__ __forceinline__
typedef __attribute__((ext_vector_type(8))) short bf16x8;
typedef __attribute__((ext_vector_type(16))) float f32x16;
typedef __attribute__((ext_vector_type(16))) uint32_t u32x16;
typedef __attribute__((ext_vector_type(2))) _Float16 h2;
typedef __attribute__((ext_vector_type(2))) __bf16 b2;
typedef unsigned short ushort_t;
typedef __attribute__((ext_vector_type(4))) uint32_t u32x4;
#define MFMA(a, b, c) __builtin_amdgcn_mfma_f32_32x32x16_bf16((a), (b), (c), 0, 0, 0)

constexpr int DM = 1024, NB = 2, SEQ = 16384, CTXL = 256;
constexpr int NX = NB * SEQ, NC = NB * CTXL, NT = NX + NC;
constexpr int INW = 3584, LTOT = CTXL + SEQ;
constexpr int NTH = 512;
constexpr int CH = 130, NCHUNK = LTOT / CH;
static_assert(NCHUNK * CH == LTOT, "chunking");
constexpr float LN_EPS = 1e-5f, QK_EPS = 1e-6f, GN_EPS = 64e-5f;
constexpr float ALPHA = 1.189207115002721f;
constexpr float QSCALE = 0.125f * 1.4426950408889634f;

constexpr size_t OFF_WIN = 0;
constexpr size_t OFF_WMG = OFF_WIN + (size_t)INW * DM * 2;
constexpr size_t OFF_WPA = OFF_WMG + (size_t)2048 * DM * 2;
constexpr size_t OFF_WPB = OFF_WPA + (size_t)1024 * 512 * 2;
constexpr size_t OFF_WO  = OFF_WPB + (size_t)1024 * 512 * 2;
constexpr size_t OFF_WL  = OFF_WO + (size_t)1024 * 1024 * 2;
constexpr size_t OFF_MOD = OFF_WL + (size_t)2 * 2 * 512 * 64 * 2;
constexpr size_t OFF_ZG  = OFF_MOD + 36864;
constexpr size_t OFF_QB  = OFF_ZG + (size_t)NX * 1024 * 2;
constexpr size_t OFF_KB  = OFF_QB + (size_t)NX * 512 * 2;
constexpr size_t OFF_VB  = OFF_KB + (size_t)NB * 2 * LTOT * 64 * 2;
constexpr size_t OFF_SH  = OFF_VB + (size_t)NB * 2 * LTOT * 64 * 2;
constexpr size_t OFF_DR  = OFF_SH + (size_t)16 * LTOT * 192 * 2;
constexpr size_t OFF_ZQ  = OFF_DR + (size_t)32 * LTOT * 192 * 2;
constexpr size_t WS_END  = OFF_ZQ + (size_t)2 * NX * 512 * 2;
static_assert(WS_END <= (size_t)536870912, "workspace");
static_assert((size_t)NT * DM * 2 <= (size_t)48 * LTOT * 192 * 2, "H alias");
static_assert((size_t)NT * 768 * 2 <= (size_t)2 * NX * 512 * 2, "zqkv alias");

struct Params {
  const float *x, *c, *ctx, *c_ctx, *w_ada, *b_ada, *w_in, *q_norm, *k_norm, *mu_prev, *mu_next, *w0, *w_up, *a0, *a_up, *k_k, *k_a,
      *r_k, *gn_w, *gn_b, *w_pa, *w_pb, *w_mg, *b_mg, *w_o, *ln_g, *ln_b;
  float* out;
  unsigned char* ws;
};

DI ushort_t f2bf(float f) { return __builtin_bit_cast(ushort_t, (__bf16)f); }
DI float bf2f(ushort_t b) { return __uint_as_float(((unsigned)b) << 16); }
DI unsigned pack_bf2(float a, float b) { b2 v = {(__bf16)a, (__bf16)b}; return __builtin_bit_cast(unsigned, v); }
DI unsigned pack_h2(float a, float b) { h2 v = {(_Float16)a, (_Float16)b}; return __builtin_bit_cast(unsigned, v); }
DI ushort_t f2h(float f) { return __builtin_bit_cast(ushort_t, (_Float16)f); }
DI float h2f(ushort_t h) { return (float)__builtin_bit_cast(_Float16, h); }
DI float bflo(unsigned u) { return __uint_as_float(u << 16); }
DI float bfhi(unsigned u) { return __uint_as_float(u & 0xffff0000u); }
DI float hlo(unsigned u) { return (float)__builtin_bit_cast(h2, u)[0]; }
DI float hhi(unsigned u) { return (float)__builtin_bit_cast(h2, u)[1]; }
DI float sigmf(float v) { return __builtin_amdgcn_rcpf(1.f + __expf(-v)); }
DI float siluf(float v) { return v * sigmf(v); }
DI int crow(int reg, int h) { return (reg & 3) + 8 * (reg >> 2) + 4 * h; }
DI float wave_sum(float v) {
#pragma unroll
  for (int o = 32; o >= 1; o >>= 1) v += __shfl_xor(v, o, 64);
  return v;
}
DI float sum16(float v) {
#pragma unroll
  for (int o = 8; o >= 1; o >>= 1) v += __shfl_xor(v, o, 64);
  return v;
}
DI float ln_rows4(const float* src, int l16, float4 (&v)[16]) {
  float s = 0.f;
#pragma unroll
  for (int i = 0; i < 16; ++i) { v[i] = *(const float4*)(src + l16 * 4 + 64 * i); s += v[i].x + v[i].y + v[i].z + v[i].w; }
  const float mu = sum16(s) * (1.f / DM);
  float q = 0.f;
#pragma unroll
  for (int i = 0; i < 16; ++i) { v[i].x -= mu; v[i].y -= mu; v[i].z -= mu; v[i].w -= mu; q += v[i].x * v[i].x + v[i].y * v[i].y + v[i].z * v[i].z + v[i].w * v[i].w; }
  return rsqrtf(sum16(q) * (1.f / DM) + LN_EPS);
}
DI f32x16 zero16() { f32x16 z;
#pragma unroll
  for (int i = 0; i < 16; ++i) z[i] = 0.f; return z; }

#define SCAN_VLOAD 0
#define PROBE_NAIVE_SCAN 0
#if SCAN_VLOAD
DI void sload2(u32x16& a0, u32x16& a1, const void* p) { a0 = *(const u32x16*)p; a1 = *((const u32x16*)p + 1); }
DI void sload4(u32x16& a0, u32x16& a1, u32x16& b0, u32x16& b1, const void* p, const void* q) {
  a0 = *(const u32x16*)p; a1 = *((const u32x16*)p + 1); b0 = *(const u32x16*)q; b1 = *((const u32x16*)q + 1);
}
#else
DI void sload2(u32x16& a0, u32x16& a1, const void* p) {
  asm volatile("s_load_dwordx16 %0, %2, 0x0\n\ts_load_dwordx16 %1, %2, 0x40\n\ts_waitcnt lgkmcnt(0)" : "=&s"(a0), "=&s"(a1) : "s"(p) : "memory");
}
DI void sload4(u32x16& a0, u32x16& a1, u32x16& b0, u32x16& b1, const void* p, const void* q) {
  asm volatile("s_load_dwordx16 %0, %4, 0x0\n\ts_load_dwordx16 %1, %4, 0x40\n\ts_load_dwordx16 %2, %5, 0x0\n\ts_load_dwordx16 %3, %5, 0x40\n\ts_waitcnt lgkmcnt(0)"
               : "=&s"(a0), "=&s"(a1), "=&s"(b0), "=&s"(b1) : "s"(p), "s"(q) : "memory");
}
#endif
DI float HV(const u32x16& v, int j) { const uint32_t w = v[j >> 1]; const h2 t = __builtin_bit_cast(h2, w); return (float)t[j & 1]; }

constexpr int LDK = 72;
template <int BM, int BN, int MI, int NI, int NB, class AL, class BL>
DI void gemm_pass(f32x16 (&acc)[NB][MI][NI], AL aload, BL bload, int K, ushort_t* As, ushort_t* Bs, int wrow0, int wcol0, int tid) {
  constexpr int NA = BM * 8 / NTH, NBC = BN * 8 / NTH;
  constexpr int ASZ = BM * LDK, BSZ = NB * BN * LDK;
  const int lane = tid & 63, l31 = lane & 31, hh = lane >> 5;
  const int nk = K >> 6;
  uint4 ra[2][NA], rb[2][NB][NBC];
  auto gload = [&](int s, int kt) {
#pragma unroll
    for (int i = 0; i < NA; ++i) { const int id = tid + i * NTH; ra[s][i] = aload(id >> 3, kt * 64 + (id & 7) * 8); }
#pragma unroll
    for (int w = 0; w < NB; ++w)
#pragma unroll
      for (int i = 0; i < NBC; ++i) { const int id = tid + i * NTH; rb[s][w][i] = bload(w, id >> 3, kt * 64 + (id & 7) * 8); }
  };
  auto lstore = [&](int s, int buf) {
#pragma unroll
    for (int i = 0; i < NA; ++i) { const int id = tid + i * NTH; *(uint4*)&As[buf * ASZ + (id >> 3) * LDK + (id & 7) * 8] = ra[s][i]; }
#pragma unroll
    for (int w = 0; w < NB; ++w)
#pragma unroll
      for (int i = 0; i < NBC; ++i) { const int id = tid + i * NTH; *(uint4*)&Bs[buf * BSZ + w * BN * LDK + (id >> 3) * LDK + (id & 7) * 8] = rb[s][w][i]; }
  };
  auto compute = [&](int buf) {
#pragma unroll
    for (int ks = 0; ks < 4; ++ks) {
      bf16x8 af[MI];
#pragma unroll
      for (int mi = 0; mi < MI; ++mi) af[mi] = *(const bf16x8*)&As[buf * ASZ + (wrow0 + mi * 32 + l31) * LDK + ks * 16 + hh * 8];
#pragma unroll
      for (int w = 0; w < NB; ++w) {
        bf16x8 bfv[NI];
#pragma unroll
        for (int ni = 0; ni < NI; ++ni) bfv[ni] = *(const bf16x8*)&Bs[buf * BSZ + w * BN * LDK + (wcol0 + ni * 32 + l31) * LDK + ks * 16 + hh * 8];
#pragma unroll
        for (int mi = 0; mi < MI; ++mi)
#pragma unroll
          for (int ni = 0; ni < NI; ++ni) acc[w][mi][ni] = MFMA(af[mi], bfv[ni], acc[w][mi][ni]);
      }
    }
  };
  __syncthreads();
  gload(0, 0);
  lstore(0, 0);
  gload(1, 1);
  gload(0, 2);
#pragma unroll 1
  for (int kt = 0; kt < nk; kt += 2) {
    __syncthreads();
    lstore(1, 1);
    if (kt + 3 < nk) gload(1, kt + 3);
    compute(0);
    __syncthreads();
    if (kt + 2 < nk) { lstore(0, 0); if (kt + 4 < nk) gload(0, kt + 4); }
    compute(1);
  }
}

DI void transpose_tile(const float* __restrict__ src, int ld_src, ushort_t* dst, int ld_dst, int k0, int n0, float* T) {
  const int tid = threadIdx.x;
#pragma unroll
  for (int i = 0; i < 2; ++i) {
    const int k = (tid >> 4) + 32 * i, n4 = (tid & 15) * 4;
    const float4 v = *(const float4*)(src + (size_t)(k0 + k) * ld_src + n0 + n4);
    T[k * 65 + n4 + 0] = v.x; T[k * 65 + n4 + 1] = v.y; T[k * 65 + n4 + 2] = v.z; T[k * 65 + n4 + 3] = v.w;
  }
  __syncthreads();
  const int n = tid >> 3, kc = tid & 7;
  uint4 o;
  o.x = pack_bf2(T[(kc * 8 + 0) * 65 + n], T[(kc * 8 + 1) * 65 + n]);
  o.y = pack_bf2(T[(kc * 8 + 2) * 65 + n], T[(kc * 8 + 3) * 65 + n]);
  o.z = pack_bf2(T[(kc * 8 + 4) * 65 + n], T[(kc * 8 + 5) * 65 + n]);
  o.w = pack_bf2(T[(kc * 8 + 6) * 65 + n], T[(kc * 8 + 7) * 65 + n]);
  *(uint4*)(dst + (size_t)(n0 + n) * ld_dst + k0 + kc * 8) = o;
  __syncthreads();
}

DI void phase0(const Params& p, unsigned char* smem) {
  float* T = (float*)smem;
  ushort_t* win = (ushort_t*)(p.ws + OFF_WIN);
  ushort_t* wmg = (ushort_t*)(p.ws + OFF_WMG);
  ushort_t* wpa = (ushort_t*)(p.ws + OFF_WPA);
  ushort_t* wpb = (ushort_t*)(p.ws + OFF_WPB);
  ushort_t* wo = (ushort_t*)(p.ws + OFF_WO);
  ushort_t* wl = (ushort_t*)(p.ws + OFF_WL);
  float* mod = (float*)(p.ws + OFF_MOD);
  constexpr int T_IN = 16 * 56, T_MG = 16 * 32, T_PA = 8 * 16, T_PB = 8 * 16, T_O = 16 * 16, T_L = 32, T_MOD = 48;
  constexpr int TOTAL = T_MOD + T_IN + T_MG + T_PA + T_PB + T_O + T_L;
  for (int t = blockIdx.x; t < TOTAL; t += gridDim.x) {
    int u = t;
    if (u < T_MOD) {
      float* sil = T;
      float* red = T + 3072;
      const int tid = threadIdx.x;
      for (int i = tid; i < 3072; i += NTH) {
        const int v = i >> 10, k = i & 1023;
        const float cv = (v < 2) ? p.c[v * 1024 + k] : p.c_ctx[k];
        sil[i] = siluf(cv);
      }
      __syncthreads();
      const int n = tid & 63, ksl = tid >> 6, n0 = u * 64;
      float a0 = 0.f, a1 = 0.f, a2 = 0.f;
      for (int k = ksl * 128; k < ksl * 128 + 128; ++k) {
        const float w = p.w_ada[(size_t)k * 3072 + n0 + n];
        a0 = fmaf(sil[k], w, a0); a1 = fmaf(sil[1024 + k], w, a1); a2 = fmaf(sil[2048 + k], w, a2);
      }
      red[(ksl * 3 + 0) * 64 + n] = a0; red[(ksl * 3 + 1) * 64 + n] = a1; red[(ksl * 3 + 2) * 64 + n] = a2;
      __syncthreads();
      if (tid < 192) {
        const int v = tid >> 6, nn = tid & 63;
        float s = 0.f;
#pragma unroll
        for (int q = 0; q < 8; ++q) s += red[(q * 3 + v) * 64 + nn];
        mod[v * 3072 + n0 + nn] = s + p.b_ada[n0 + nn];
      }
      __syncthreads();
      continue;
    }
    u -= T_MOD;
    if (u < T_IN) { transpose_tile(p.w_in, INW, win, 1024, (u / 56) * 64, (u % 56) * 64, T); continue; }
    u -= T_IN;
    if (u < T_MG) { transpose_tile(p.w_mg, 2048, wmg, 1024, (u / 32) * 64, (u % 32) * 64, T); continue; }
    u -= T_MG;
    if (u < T_PA) { transpose_tile(p.w_pa, 1024, wpa, 512, (u / 16) * 64, (u % 16) * 64, T); continue; }
    u -= T_PA;
    if (u < T_PB) { transpose_tile(p.w_pb, 1024, wpb, 512, (u / 16) * 64, (u % 16) * 64, T); continue; }
    u -= T_PB;
    if (u < T_O) { transpose_tile(p.w_o, 1024, wo, 1024, (u / 16) * 64, (u % 16) * 64, T); continue; }
    u -= T_O;
    {
      const int which = u >> 4, dir = (u >> 3) & 1, nt = u & 7;
      const float* src = (which ? p.a_up : p.w_up) + (size_t)dir * 64 * 512;
      transpose_tile(src, 512, wl + (size_t)((dir * 2 + which) * 512) * 64, 64, 0, nt * 64, T);
    }
  }
}

DI void phase_h(const Params& p) {
  const float* mod = (const float*)(p.ws + OFF_MOD);
  ushort_t* H = (ushort_t*)(p.ws + OFF_SH);
  const int lane = threadIdx.x & 63, l16 = lane & 15, gw = blockIdx.x * 8 + (threadIdx.x >> 6);
#pragma unroll 1
  for (int r4 = gw * 4; r4 < NT; r4 += gridDim.x * 32) {
    const int row = r4 + (lane >> 4);
    const float* src = (row < NX) ? p.x + (size_t)row * DM : p.ctx + (size_t)(row - NX) * DM;
    const float* md = mod + ((row < NX) ? (row / SEQ) : 2) * 3072;
    float4 v[16];
    const float rstd = ln_rows4(src, l16, v);
#pragma unroll
    for (int i = 0; i < 16; ++i) {
      const int col = l16 * 4 + 64 * i;
      const float4 sh = *(const float4*)(md + col), sc = *(const float4*)(md + 1024 + col);
      uint2 o;
      o.x = pack_bf2(v[i].x * rstd * (1.f + sc.x) + sh.x, v[i].y * rstd * (1.f + sc.y) + sh.y);
      o.y = pack_bf2(v[i].z * rstd * (1.f + sc.z) + sh.z, v[i].w * rstd * (1.f + sc.w) + sh.w);
      *(uint2*)(H + (size_t)row * DM + col) = o;
    }
  }
}

DI void phase_gemm1(const Params& p, unsigned char* smem) {
  ushort_t* As = (ushort_t*)smem;
  ushort_t* Bs = As + 2 * 256 * LDK;
  const ushort_t* H = (const ushort_t*)(p.ws + OFF_SH);
  const ushort_t* W = (const ushort_t*)(p.ws + OFF_WIN);
  ushort_t* zq = (ushort_t*)(p.ws + OFF_ZQ);
  ushort_t* zg = (ushort_t*)(p.ws + OFF_ZG);
  ushort_t* zm = (ushort_t*)p.out;
  const int tid = threadIdx.x, wave = tid >> 6, lane = tid & 63, l31 = lane & 31, hh = lane >> 5;
  const int wrow0 = (wave & 3) * 64, wcol0 = (wave >> 2) * 64;
  constexpr int MT = NT / 256, NTL = INW / 128;
  for (int t = blockIdx.x; t < MT * NTL; t += gridDim.x) {
    const int mt = t / NTL, nt = t % NTL;
    const bool is_g = (nt >= 6 && nt < 10) || nt >= 24;
    if (is_g && mt >= NX / 256) continue;
    const int row0 = mt * 256, col0 = nt * 128;
    f32x16 acc[1][2][2];
#pragma unroll
    for (int a = 0; a < 2; ++a)
#pragma unroll
      for (int b = 0; b < 2; ++b) acc[0][a][b] = zero16();
    auto aload = [&](int r, int k) { return *(const uint4*)(H + (size_t)(row0 + r) * DM + k); };
    auto bload = [&](int w, int n, int k) { return *(const uint4*)(W + (size_t)(col0 + n) * DM + k); };
    gemm_pass<256, 128, 2, 2, 1>(acc, aload, bload, DM, As, Bs, wrow0, wcol0, tid);
    ushort_t* dst; int ld, cbase;
    if (nt < 6) { dst = zq; ld = 768; cbase = col0; }
    else if (nt < 10) { dst = zg; ld = 1024; cbase = col0 - 768; }
    else if (nt < 24) { dst = zm; ld = 1792; cbase = col0 - 1280; }
    else { dst = zg; ld = 1024; cbase = 512 + col0 - 3072; }
#pragma unroll
    for (int mi = 0; mi < 2; ++mi)
#pragma unroll
      for (int ni = 0; ni < 2; ++ni)
#pragma unroll
        for (int i = 0; i < 16; ++i) {
          const int row = row0 + wrow0 + mi * 32 + crow(i, hh), col = cbase + wcol0 + ni * 32 + l31;
          dst[(size_t)row * ld + col] = f2bf(acc[0][mi][ni][i]);
        }
  }
}

DI int vperm(int key) { const int g = key >> 4, kq = key & 15; return g * 16 + 8 * ((kq >> 2) & 1) + (kq & 3) + 4 * (kq >> 3); }
DI void phase_qkv(const Params& p) {
  const ushort_t* zq = (const ushort_t*)(p.ws + OFF_ZQ);
  ushort_t* QB = (ushort_t*)(p.ws + OFF_QB);
  ushort_t* KB = (ushort_t*)(p.ws + OFF_KB);
  ushort_t* VB = (ushort_t*)(p.ws + OFF_VB);
  const int lane = threadIdx.x & 63, gw = blockIdx.x * 8 + (threadIdx.x >> 6);
  const int j = lane & 31, half = lane >> 5, axis = j >> 4, f = j & 15;
  const int d1 = axis * 32 + f, d2 = d1 + 16;
  const float inv = powf(10000.f, -(float)f * (1.f / 16.f));
  const float gq1 = p.q_norm[d1], gq2 = p.q_norm[d2], gk1 = p.k_norm[d1], gk2 = p.k_norm[d2];
  for (int row = gw; row < NT; row += gridDim.x * 8) {
    const bool isx = row < NX;
    const int b = isx ? row / SEQ : (row - NX) / CTXL;
    const int t = isx ? row % SEQ : (row - NX) % CTXL;
    const int pos = isx ? CTXL + t : t;
    const ushort_t* z = zq + (size_t)row * 768;
    float cs = 1.f, sn = 0.f;
    if (isx) { const float ang = (float)(axis ? (t & 63) : (t >> 6)) * inv; sincosf(ang, &sn, &cs); }
#pragma unroll
    for (int it = 0; it < 5; ++it) {
      const int hd = it * 2 + half;
      if (!isx && hd < 8) continue;
      const float v1 = bf2f(z[hd * 64 + d1]), v2 = bf2f(z[hd * 64 + d2]);
      float ss = v1 * v1 + v2 * v2;
#pragma unroll
      for (int o = 16; o >= 1; o >>= 1) ss += __shfl_xor(ss, o, 64);
      const float rms = rsqrtf(ss * (1.f / 64.f) + QK_EPS);
      const bool isq = hd < 8;
      const float y1 = v1 * rms * (isq ? gq1 : gk1), y2 = v2 * rms * (isq ? gq2 : gk2);
      float o1 = y1 * cs - y2 * sn, o2 = y2 * cs + y1 * sn;
      if (isq) {
        ushort_t* dst = QB + ((size_t)(b * 8 + hd) * SEQ + t) * 64;
        dst[d1] = f2bf(o1 * QSCALE); dst[d2] = f2bf(o2 * QSCALE);
      } else {
        ushort_t* dst = KB + ((size_t)(b * 2 + (hd - 8)) * LTOT + pos) * 64;
        dst[d1] = f2bf(o1); dst[d2] = f2bf(o2);
      }
    }
    {
      const size_t tb = (size_t)(pos >> 6) * 4096 + lane * 64 + vperm(pos & 63);
      VB[(size_t)(b * 2 + 0) * LTOT * 64 + tb] = z[640 + lane];
      VB[(size_t)(b * 2 + 1) * LTOT * 64 + tb] = z[704 + lane];
    }
  }
}

DI void phase_rwkv_prep(const Params& p, unsigned char* smem) {
  float* kbuf = (float*)smem;
  ushort_t* codes = (ushort_t*)(smem + 65536);
  float* invn = (float*)(smem + 65536 + 32 * 264 * 2);
  const ushort_t* zm = (const ushort_t*)p.out;
  const ushort_t* WL = (const ushort_t*)(p.ws + OFF_WL);
  ushort_t* SH = (ushort_t*)(p.ws + OFF_SH);
  ushort_t* DR = (ushort_t*)(p.ws + OFF_DR);
  const int tid = threadIdx.x, wave = tid >> 6, lane = tid & 63, l31 = lane & 31, hh = lane >> 5;
  for (int tt = blockIdx.x; tt < NT / 32; tt += gridDim.x) {
    const int row0 = tt * 32;
    int b, t0, len, pbase;
    if (row0 < NX) { b = row0 / SEQ; t0 = row0 % SEQ; len = SEQ; pbase = CTXL; }
    else { const int rc = row0 - NX; b = rc / CTXL; t0 = rc % CTXL; len = CTXL; pbase = 0; }
    __syncthreads();
    for (int id = tid; id < 32 * 224; id += NTH) {
      const int i = id / 224, c0 = (id % 224) * 8;
      const int t = t0 + i;
      const ushort_t* zr = zm + (size_t)(row0 + i) * 1792 + c0;
      const uint4 zc = *(const uint4*)zr;
      uint4 zp = make_uint4(0, 0, 0, 0), zn = make_uint4(0, 0, 0, 0);
      if (t > 0) zp = *(const uint4*)(zr - 1792);
      if (t < len - 1) zn = *(const uint4*)(zr + 1792);
      const float4 mp0 = *(const float4*)(p.mu_prev + c0), mp1 = *(const float4*)(p.mu_prev + c0 + 4);
      const float4 mn0 = *(const float4*)(p.mu_next + c0), mn1 = *(const float4*)(p.mu_next + c0 + 4);
      const unsigned zcw[4] = {zc.x, zc.y, zc.z, zc.w}, zpw[4] = {zp.x, zp.y, zp.z, zp.w}, znw[4] = {zn.x, zn.y, zn.z, zn.w};
      const float mpv[8] = {mp0.x, mp0.y, mp0.z, mp0.w, mp1.x, mp1.y, mp1.z, mp1.w};
      const float mnv[8] = {mn0.x, mn0.y, mn0.z, mn0.w, mn1.x, mn1.y, mn1.z, mn1.w};
      float s[8];
#pragma unroll
      for (int q = 0; q < 4; ++q) {
        const float c_lo = bflo(zcw[q]), c_hi = bfhi(zcw[q]);
        s[2 * q] = c_lo + mpv[2 * q] * (bflo(zpw[q]) - c_lo) + mnv[2 * q] * (bflo(znw[q]) - c_lo);
        s[2 * q + 1] = c_hi + mpv[2 * q + 1] * (bfhi(zpw[q]) - c_hi) + mnv[2 * q + 1] * (bfhi(znw[q]) - c_hi);
      }
      const int pp = pbase + t;
      if (c0 < 512 || (c0 >= 1024 && c0 < 1536)) {
        const int cc = (c0 < 512) ? c0 : c0 - 1024, which = (c0 < 512) ? 1 : 2;
        const int head = cc >> 6, d = cc & 63;
        uint4 o;
        o.x = pack_h2(s[0], s[1]); o.y = pack_h2(s[2], s[3]); o.z = pack_h2(s[4], s[5]); o.w = pack_h2(s[6], s[7]);
        *(uint4*)(SH + (((size_t)(b * 8 + head) * LTOT + pp) * 3 + which) * 64 + d) = o;
      } else if (c0 < 1024) {
        float* kd = kbuf + i * 512 + (c0 - 512);
        *(float4*)kd = make_float4(s[0], s[1], s[2], s[3]);
        *(float4*)(kd + 4) = make_float4(s[4], s[5], s[6], s[7]);
      } else {
        const int cc = c0 - 1536;
        if (cc < 128) {
#pragma unroll
          for (int q = 0; q < 8; ++q) s[q] = tanhf(s[q]);
        }
        uint4 o;
        o.x = pack_bf2(s[0], s[1]); o.y = pack_bf2(s[2], s[3]); o.z = pack_bf2(s[4], s[5]); o.w = pack_bf2(s[6], s[7]);
        *(uint4*)(codes + i * 264 + cc) = o;
      }
    }
    __syncthreads();
    {
      const int i = tid >> 4, head = (tid >> 1) & 7, hf = tid & 1;
      float ss = 0.f;
#pragma unroll 8
      for (int q = 0; q < 32; ++q) {
        const int n = head * 64 + hf * 32 + q;
        const float v = kbuf[i * 512 + n] * p.k_k[n];
        ss = fmaf(v, v, ss);
      }
      ss += __shfl_xor(ss, 1, 64);
      if (hf == 0) invn[i * 8 + head] = 1.f / fmaxf(sqrtf(ss), 1e-12f);
    }
    __syncthreads();
#pragma unroll 1
    for (int q4 = 0; q4 < 4; ++q4) {
      const int pr = wave * 4 + q4, dir = pr >> 4, ct = pr & 15;
      f32x16 aw = zero16(), aa = zero16();
#pragma unroll
      for (int ks = 0; ks < 4; ++ks) {
        const bf16x8 fw = *(const bf16x8*)&codes[l31 * 264 + dir * 64 + ks * 16 + hh * 8];
        const bf16x8 fa = *(const bf16x8*)&codes[l31 * 264 + 128 + dir * 64 + ks * 16 + hh * 8];
        const bf16x8 bw = *(const bf16x8*)&WL[(size_t)((dir * 2 + 0) * 512 + ct * 32 + l31) * 64 + ks * 16 + hh * 8];
        const bf16x8 ba = *(const bf16x8*)&WL[(size_t)((dir * 2 + 1) * 512 + ct * 32 + l31) * 64 + ks * 16 + hh * 8];
        aw = MFMA(fw, bw, aw);
        aa = MFMA(fa, ba, aa);
      }
      const int n = ct * 32 + l31, head = n >> 6, d = n & 63;
      const float w0v = p.w0[dir * 512 + n], a0v = p.a0[dir * 512 + n], kkw = p.k_k[n], kaw = p.k_a[n];
      const size_t cbase = (size_t)(b * 8 + head) * LTOT;
#pragma unroll
      for (int i = 0; i < 16; ++i) {
        const int ti = crow(i, hh);
        const int pp = pbase + t0 + ti;
        const float wpre = aw[i] + w0v;
        const float e = 0.60653065971263342f * sigmf(wpre);
        const float xdec = 1.f - __expf(-e);
        const float a = sigmf(aa[i] + a0v);
        const float kv = kbuf[ti * 512 + n];
        const float kkv = kv * kkw * invn[ti * 8 + head];
        const float kd = kv * (1.f + (a - 1.f) * kaw);
        ushort_t* dr = DR + ((((size_t)dir * 16) * LTOT + cbase + pp) * 3) * 64 + d;
        dr[0] = f2h(-xdec); dr[64] = f2h(kd); dr[128] = f2h(kkv * a);
        if (dir == 0) SH[((cbase + pp) * 3) * 64 + d] = f2h(kkv);
      }
    }
  }
}

DI int tau_to_pos(int dir, int tau) { return dir == 0 ? tau : (tau < CTXL ? CTXL - 1 - tau : LTOT - 1 - (tau - CTXL)); }

struct ScanRec { uint32_t sh, dr, bb; ushort_t v; };
DI ScanRec scan_load(const ushort_t* shc, const ushort_t* drc, int pos, int lane) {
  ScanRec r;
  const ushort_t* s = shc + (size_t)pos * 192;
  const uint32_t* d = (const uint32_t*)(drc + (size_t)pos * 192);
  r.sh = ((const uint32_t*)s)[lane];
  r.v = s[128 + lane];
  r.dr = d[lane];
  r.bb = d[64 + (lane & 31)];
  return r;
}
#define MIXLO " op_sel_hi:[0,1,0]\n\t"
#define MIXHI " op_sel:[0,1,0] op_sel_hi:[0,1,0]\n\t"
template <int L>
DI void dot4(float& a0, float& a1, float (&S)[64], uint32_t src) {
  uint32_t t0, t1, t2, t3;
  asm("v_readlane_b32 %2, %6, %7\n\tv_readlane_b32 %3, %6, %8\n\tv_readlane_b32 %4, %6, %9\n\tv_readlane_b32 %5, %6, %10\n\t"
      "v_fma_mix_f32 %0, %11, %2, %0" MIXLO "v_fma_mix_f32 %1, %12, %2, %1" MIXHI
      "v_fma_mix_f32 %0, %13, %3, %0" MIXLO "v_fma_mix_f32 %1, %14, %3, %1" MIXHI
      "v_fma_mix_f32 %0, %15, %4, %0" MIXLO "v_fma_mix_f32 %1, %16, %4, %1" MIXHI
      "v_fma_mix_f32 %0, %17, %5, %0" MIXLO "v_fma_mix_f32 %1, %18, %5, %1" MIXHI
      : "+v"(a0), "+v"(a1), "=&s"(t0), "=&s"(t1), "=&s"(t2), "=&s"(t3)
      : "v"(src), "n"(L), "n"(L + 1), "n"(L + 2), "n"(L + 3),
        "v"(S[2 * (L & 31)]), "v"(S[2 * (L & 31) + 1]), "v"(S[2 * (L & 31) + 2]), "v"(S[2 * (L & 31) + 3]),
        "v"(S[2 * (L & 31) + 4]), "v"(S[2 * (L & 31) + 5]), "v"(S[2 * (L & 31) + 6]), "v"(S[2 * (L & 31) + 7]));
}
template <int L>
DI void upd4(float (&S)[64], uint32_t dr, uint32_t bb, float vv, float nsk) {
  uint32_t x0, x1, x2, x3, k0, k1, k2, k3, b0, b1, b2, b3;
  asm("v_readlane_b32 %8, %20, %22\n\tv_readlane_b32 %9, %20, %23\n\tv_readlane_b32 %10, %20, %24\n\tv_readlane_b32 %11, %20, %25\n\t"
      "v_readlane_b32 %12, %20, %26\n\tv_readlane_b32 %13, %20, %27\n\tv_readlane_b32 %14, %20, %28\n\tv_readlane_b32 %15, %20, %29\n\t"
      "v_readlane_b32 %16, %21, %22\n\tv_readlane_b32 %17, %21, %23\n\tv_readlane_b32 %18, %21, %24\n\tv_readlane_b32 %19, %21, %25\n\t"
      "v_fma_mix_f32 %0, %0, %8, %0" MIXLO "v_fma_mix_f32 %1, %1, %8, %1" MIXHI
      "v_fma_mix_f32 %2, %2, %9, %2" MIXLO "v_fma_mix_f32 %3, %3, %9, %3" MIXHI
      "v_fma_mix_f32 %4, %4, %10, %4" MIXLO "v_fma_mix_f32 %5, %5, %10, %5" MIXHI
      "v_fma_mix_f32 %6, %6, %11, %6" MIXLO "v_fma_mix_f32 %7, %7, %11, %7" MIXHI
      "v_fma_mix_f32 %0, %30, %12, %0" MIXLO "v_fma_mix_f32 %1, %30, %12, %1" MIXHI
      "v_fma_mix_f32 %2, %30, %13, %2" MIXLO "v_fma_mix_f32 %3, %30, %13, %3" MIXHI
      "v_fma_mix_f32 %4, %30, %14, %4" MIXLO "v_fma_mix_f32 %5, %30, %14, %5" MIXHI
      "v_fma_mix_f32 %6, %30, %15, %6" MIXLO "v_fma_mix_f32 %7, %30, %15, %7" MIXHI
      "v_fma_mix_f32 %0, %31, %16, %0" MIXLO "v_fma_mix_f32 %1, %31, %16, %1" MIXHI
      "v_fma_mix_f32 %2, %31, %17, %2" MIXLO "v_fma_mix_f32 %3, %31, %17, %3" MIXHI
      "v_fma_mix_f32 %4, %31, %18, %4" MIXLO "v_fma_mix_f32 %5, %31, %18, %5" MIXHI
      "v_fma_mix_f32 %6, %31, %19, %6" MIXLO "v_fma_mix_f32 %7, %31, %19, %7" MIXHI
      : "+v"(S[2 * L]), "+v"(S[2 * L + 1]), "+v"(S[2 * L + 2]), "+v"(S[2 * L + 3]), "+v"(S[2 * L + 4]), "+v"(S[2 * L + 5]), "+v"(S[2 * L + 6]), "+v"(S[2 * L + 7]),
        "=&s"(x0), "=&s"(x1), "=&s"(x2), "=&s"(x3), "=&s"(k0), "=&s"(k1), "=&s"(k2), "=&s"(k3), "=&s"(b0), "=&s"(b1), "=&s"(b2), "=&s"(b3)
      : "v"(dr), "v"(bb), "n"(L), "n"(L + 1), "n"(L + 2), "n"(L + 3), "n"(L + 32), "n"(L + 33), "n"(L + 34), "n"(L + 35), "v"(vv), "v"(nsk));
}
template <int L>
DI void dot4_2(float& a0, float& a1, float& c0, float& c1, float (&SU)[64], float (&SP)[64], uint32_t src) {
  uint32_t t0, t1, t2, t3;
  asm("v_readlane_b32 %4, %8, %9\n\tv_readlane_b32 %5, %8, %10\n\tv_readlane_b32 %6, %8, %11\n\tv_readlane_b32 %7, %8, %12\n\t"
      "v_fma_mix_f32 %0, %13, %4, %0" MIXLO "v_fma_mix_f32 %1, %14, %4, %1" MIXHI
      "v_fma_mix_f32 %2, %21, %4, %2" MIXLO "v_fma_mix_f32 %3, %22, %4, %3" MIXHI
      "v_fma_mix_f32 %0, %15, %5, %0" MIXLO "v_fma_mix_f32 %1, %16, %5, %1" MIXHI
      "v_fma_mix_f32 %2, %23, %5, %2" MIXLO "v_fma_mix_f32 %3, %24, %5, %3" MIXHI
      "v_fma_mix_f32 %0, %17, %6, %0" MIXLO "v_fma_mix_f32 %1, %18, %6, %1" MIXHI
      "v_fma_mix_f32 %2, %25, %6, %2" MIXLO "v_fma_mix_f32 %3, %26, %6, %3" MIXHI
      "v_fma_mix_f32 %0, %19, %7, %0" MIXLO "v_fma_mix_f32 %1, %20, %7, %1" MIXHI
      "v_fma_mix_f32 %2, %27, %7, %2" MIXLO "v_fma_mix_f32 %3, %28, %7, %3" MIXHI
      : "+v"(a0), "+v"(a1), "+v"(c0), "+v"(c1), "=&s"(t0), "=&s"(t1), "=&s"(t2), "=&s"(t3)
      : "v"(src), "n"(L), "n"(L + 1), "n"(L + 2), "n"(L + 3),
        "v"(SU[2 * L]), "v"(SU[2 * L + 1]), "v"(SU[2 * L + 2]), "v"(SU[2 * L + 3]), "v"(SU[2 * L + 4]), "v"(SU[2 * L + 5]), "v"(SU[2 * L + 6]), "v"(SU[2 * L + 7]),
        "v"(SP[2 * L]), "v"(SP[2 * L + 1]), "v"(SP[2 * L + 2]), "v"(SP[2 * L + 3]), "v"(SP[2 * L + 4]), "v"(SP[2 * L + 5]), "v"(SP[2 * L + 6]), "v"(SP[2 * L + 7]));
}
template <int L>
DI void upd4_2(float (&SU)[64], float (&SP)[64], uint32_t dr, uint32_t bb, float vv, float nskU, float nskP) {
  uint32_t x0, x1, x2, x3, k0, k1, k2, k3, b0, b1, b2, b3;
  asm("v_readlane_b32 %16, %28, %30\n\tv_readlane_b32 %17, %28, %31\n\tv_readlane_b32 %18, %28, %32\n\tv_readlane_b32 %19, %28, %33\n\t"
      "v_readlane_b32 %20, %28, %34\n\tv_readlane_b32 %21, %28, %35\n\tv_readlane_b32 %22, %28, %36\n\tv_readlane_b32 %23, %28, %37\n\t"
      "v_readlane_b32 %24, %29, %30\n\tv_readlane_b32 %25, %29, %31\n\tv_readlane_b32 %26, %29, %32\n\tv_readlane_b32 %27, %29, %33\n\t"
      "v_fma_mix_f32 %0, %0, %16, %0" MIXLO "v_fma_mix_f32 %1, %1, %16, %1" MIXHI
      "v_fma_mix_f32 %2, %2, %17, %2" MIXLO "v_fma_mix_f32 %3, %3, %17, %3" MIXHI
      "v_fma_mix_f32 %4, %4, %18, %4" MIXLO "v_fma_mix_f32 %5, %5, %18, %5" MIXHI
      "v_fma_mix_f32 %6, %6, %19, %6" MIXLO "v_fma_mix_f32 %7, %7, %19, %7" MIXHI
      "v_fma_mix_f32 %8, %8, %16, %8" MIXLO "v_fma_mix_f32 %9, %9, %16, %9" MIXHI
      "v_fma_mix_f32 %10, %10, %17, %10" MIXLO "v_fma_mix_f32 %11, %11, %17, %11" MIXHI
      "v_fma_mix_f32 %12, %12, %18, %12" MIXLO "v_fma_mix_f32 %13, %13, %18, %13" MIXHI
      "v_fma_mix_f32 %14, %14, %19, %14" MIXLO "v_fma_mix_f32 %15, %15, %19, %15" MIXHI
      "v_fma_mix_f32 %0, %38, %20, %0" MIXLO "v_fma_mix_f32 %1, %38, %20, %1" MIXHI
      "v_fma_mix_f32 %2, %38, %21, %2" MIXLO "v_fma_mix_f32 %3, %38, %21, %3" MIXHI
      "v_fma_mix_f32 %4, %38, %22, %4" MIXLO "v_fma_mix_f32 %5, %38, %22, %5" MIXHI
      "v_fma_mix_f32 %6, %38, %23, %6" MIXLO "v_fma_mix_f32 %7, %38, %23, %7" MIXHI
      "v_fma_mix_f32 %0, %39, %24, %0" MIXLO "v_fma_mix_f32 %1, %39, %24, %1" MIXHI
      "v_fma_mix_f32 %2, %39, %25, %2" MIXLO "v_fma_mix_f32 %3, %39, %25, %3" MIXHI
      "v_fma_mix_f32 %4, %39, %26, %4" MIXLO "v_fma_mix_f32 %5, %39, %26, %5" MIXHI
      "v_fma_mix_f32 %6, %39, %27, %6" MIXLO "v_fma_mix_f32 %7, %39, %27, %7" MIXHI
      "v_fma_mix_f32 %8, %40, %24, %8" MIXLO "v_fma_mix_f32 %9, %40, %24, %9" MIXHI
      "v_fma_mix_f32 %10, %40, %25, %10" MIXLO "v_fma_mix_f32 %11, %40, %25, %11" MIXHI
      "v_fma_mix_f32 %12, %40, %26, %12" MIXLO "v_fma_mix_f32 %13, %40, %26, %13" MIXHI
      "v_fma_mix_f32 %14, %40, %27, %14" MIXLO "v_fma_mix_f32 %15, %40, %27, %15" MIXHI
      : "+v"(SU[2 * L]), "+v"(SU[2 * L + 1]), "+v"(SU[2 * L + 2]), "+v"(SU[2 * L + 3]), "+v"(SU[2 * L + 4]), "+v"(SU[2 * L + 5]), "+v"(SU[2 * L + 6]), "+v"(SU[2 * L + 7]),
        "+v"(SP[2 * L]), "+v"(SP[2 * L + 1]), "+v"(SP[2 * L + 2]), "+v"(SP[2 * L + 3]), "+v"(SP[2 * L + 4]), "+v"(SP[2 * L + 5]), "+v"(SP[2 * L + 6]), "+v"(SP[2 * L + 7]),
        "=&s"(x0), "=&s"(x1), "=&s"(x2), "=&s"(x3), "=&s"(k0), "=&s"(k1), "=&s"(k2), "=&s"(k3), "=&s"(b0), "=&s"(b1), "=&s"(b2), "=&s"(b3)
      : "v"(dr), "v"(bb), "n"(L), "n"(L + 1), "n"(L + 2), "n"(L + 3), "n"(L + 32), "n"(L + 33), "n"(L + 34), "n"(L + 35), "v"(vv), "v"(nskU), "v"(nskP));
}
DI void scan_step2(float (&SU)[64], float (&SP)[64], const ScanRec& c, float vv) {
  float a0 = 0.f, a1 = 0.f, c0 = 0.f, c1 = 0.f;
  dot4_2<0>(a0, a1, c0, c1, SU, SP, c.sh); dot4_2<4>(a0, a1, c0, c1, SU, SP, c.sh); dot4_2<8>(a0, a1, c0, c1, SU, SP, c.sh); dot4_2<12>(a0, a1, c0, c1, SU, SP, c.sh);
  dot4_2<16>(a0, a1, c0, c1, SU, SP, c.sh); dot4_2<20>(a0, a1, c0, c1, SU, SP, c.sh); dot4_2<24>(a0, a1, c0, c1, SU, SP, c.sh); dot4_2<28>(a0, a1, c0, c1, SU, SP, c.sh);
  const float nU = -(a0 + a1), nP = -(c0 + c1);
  upd4_2<0>(SU, SP, c.dr, c.bb, vv, nU, nP); upd4_2<4>(SU, SP, c.dr, c.bb, vv, nU, nP); upd4_2<8>(SU, SP, c.dr, c.bb, vv, nU, nP); upd4_2<12>(SU, SP, c.dr, c.bb, vv, nU, nP);
  upd4_2<16>(SU, SP, c.dr, c.bb, vv, nU, nP); upd4_2<20>(SU, SP, c.dr, c.bb, vv, nU, nP); upd4_2<24>(SU, SP, c.dr, c.bb, vv, nU, nP); upd4_2<28>(SU, SP, c.dr, c.bb, vv, nU, nP);
}
template <bool WITH_OUT>
DI float scan_step(float (&S)[64], const ScanRec& c, float vv) {
  float sk0 = 0.f, sk1 = 0.f;
  dot4<0>(sk0, sk1, S, c.sh); dot4<4>(sk0, sk1, S, c.sh); dot4<8>(sk0, sk1, S, c.sh); dot4<12>(sk0, sk1, S, c.sh);
  dot4<16>(sk0, sk1, S, c.sh); dot4<20>(sk0, sk1, S, c.sh); dot4<24>(sk0, sk1, S, c.sh); dot4<28>(sk0, sk1, S, c.sh);
  const float nsk = -(sk0 + sk1);
  upd4<0>(S, c.dr, c.bb, vv, nsk); upd4<4>(S, c.dr, c.bb, vv, nsk); upd4<8>(S, c.dr, c.bb, vv, nsk); upd4<12>(S, c.dr, c.bb, vv, nsk);
  upd4<16>(S, c.dr, c.bb, vv, nsk); upd4<20>(S, c.dr, c.bb, vv, nsk); upd4<24>(S, c.dr, c.bb, vv, nsk); upd4<28>(S, c.dr, c.bb, vv, nsk);
  float o0 = 0.f, o1 = 0.f;
  if (WITH_OUT) {
    dot4<32>(o0, o1, S, c.sh); dot4<36>(o0, o1, S, c.sh); dot4<40>(o0, o1, S, c.sh); dot4<44>(o0, o1, S, c.sh);
    dot4<48>(o0, o1, S, c.sh); dot4<52>(o0, o1, S, c.sh); dot4<56>(o0, o1, S, c.sh); dot4<60>(o0, o1, S, c.sh);
  }
  return o0 + o1;
}
constexpr int SPF = 3;
DI void phase_scanA(const Params& p, unsigned char* smem) {
  const ushort_t* SH = (const ushort_t*)(p.ws + OFF_SH);
  const ushort_t* DR = (const ushort_t*)(p.ws + OFF_DR);
  float* PU = p.out;
  const int lane = threadIdx.x & 63;
  const int gw = __builtin_amdgcn_readfirstlane(blockIdx.x * 8 + (threadIdx.x >> 6));
  for (int task = gw; task < 32 * NCHUNK; task += gridDim.x * 8) {
    const int cd = task / NCHUNK, j = task % NCHUNK, dir = cd >> 4, c = cd & 15;
    float SU[64], SP[64];
#pragma unroll
    for (int k = 0; k < 64; ++k) { SU[k] = 0.f; SP[k] = (k == lane) ? 1.f : 0.f; }
    const ushort_t* shc = SH + (size_t)c * LTOT * 192;
    const ushort_t* drc = DR + (size_t)(dir * 16 + c) * LTOT * 192;
    ScanRec r0 = scan_load(shc, drc, tau_to_pos(dir, j * CH + 0), lane);
    ScanRec r1 = scan_load(shc, drc, tau_to_pos(dir, j * CH + 1), lane);
    ScanRec r2 = scan_load(shc, drc, tau_to_pos(dir, j * CH + 2), lane);
#pragma unroll 1
    for (int st = 0; st < CH; ++st) {
      const ScanRec r3 = scan_load(shc, drc, tau_to_pos(dir, j * CH + (st + SPF < CH ? st + SPF : CH - 1)), lane);
      scan_step2(SU, SP, r0, h2f(r0.v));
      r0 = r1; r1 = r2; r2 = r3;
    }
    float* dst = PU + (size_t)task * 2 * 4096 + lane * 64;
#pragma unroll
    for (int k = 0; k < 64; k += 4) {
      *(float4*)(dst + k) = make_float4(SU[k], SU[k + 1], SU[k + 2], SU[k + 3]);
      *(float4*)(dst + 4096 + k) = make_float4(SP[k], SP[k + 1], SP[k + 2], SP[k + 3]);
    }
  }
}

DI void phase_scanB(const Params& p, unsigned char* smem) {
  if (blockIdx.x >= 32) return;
  float* Sb = (float*)smem;
  float* Xb = Sb + 64 * 65;
  float* PU = p.out;
  const int cd = blockIdx.x, tid = threadIdx.x, wave = tid >> 6, lane = tid & 63, l31 = lane & 31, hh = lane >> 5;
  const int tile = wave & 3, tm = tile >> 1, tn = tile & 1, kh = wave >> 2;
  for (int i = tid; i < 64 * 65; i += NTH) Sb[i] = 0.f;
  constexpr int BPF = 4;
  float bP[BPF][16];
  f32x16 uT[BPF];
#pragma unroll
  for (int s = 0; s < BPF; ++s) uT[s] = zero16();
  auto fetch = [&](int j, float (&bp)[16], f32x16& ut) {
    const float* base = PU + (size_t)(cd * NCHUNK + j) * 2 * 4096;
#pragma unroll
    for (int kk = 0; kk < 16; ++kk) bp[kk] = base[4096 + (kh * 32 + 2 * kk + hh) * 64 + tn * 32 + l31];
    if (kh == 0) {
#pragma unroll
      for (int i = 0; i < 16; ++i) ut[i] = base[(tm * 32 + crow(i, hh)) * 64 + tn * 32 + l31];
    }
  };
  auto put_state = [&](int j, const f32x16& st) {
    float* base = PU + (size_t)(cd * NCHUNK + j) * 2 * 4096;
#pragma unroll
    for (int i = 0; i < 16; ++i) base[(tm * 32 + crow(i, hh)) * 64 + tn * 32 + l31] = st[i];
  };
#pragma unroll
  for (int s = 0; s < BPF; ++s) fetch(s, bP[s], uT[s]);
  if (kh == 0) put_state(0, zero16());
  __syncthreads();
#pragma unroll 1
  for (int j = 0; j < NCHUNK; ++j) {
    float nP[16];
    f32x16 nU = zero16();
    if (j + BPF < NCHUNK) fetch(j + BPF, nP, nU);
    f32x16 acc = (kh == 0) ? uT[0] : zero16();
#pragma unroll
    for (int kk = 0; kk < 16; ++kk) {
      const float a = Sb[(tm * 32 + l31) * 65 + kh * 32 + 2 * kk + hh];
      acc = __builtin_amdgcn_mfma_f32_32x32x2f32(a, bP[0][kk], acc, 0, 0, 0);
    }
    if (kh == 1) {
#pragma unroll
      for (int i = 0; i < 16; ++i) Xb[(tile * 16 + i) * 64 + lane] = acc[i];
    }
    __syncthreads();
    if (kh == 0) {
#pragma unroll
      for (int i = 0; i < 16; ++i) { acc[i] += Xb[(tile * 16 + i) * 64 + lane]; Sb[(tm * 32 + crow(i, hh)) * 65 + tn * 32 + l31] = acc[i]; }
      if (j + 1 < NCHUNK) put_state(j + 1, acc);
    }
#pragma unroll
    for (int s = 0; s + 1 < BPF; ++s) {
#pragma unroll
      for (int kk = 0; kk < 16; ++kk) bP[s][kk] = bP[s + 1][kk];
      uT[s] = uT[s + 1];
    }
#pragma unroll
    for (int kk = 0; kk < 16; ++kk) bP[BPF - 1][kk] = nP[kk];
    uT[BPF - 1] = nU;
    __syncthreads();
  }
}

DI void phase_scanC(const Params& p, unsigned char* smem) {
  const ushort_t* SH = (const ushort_t*)(p.ws + OFF_SH);
  const ushort_t* DR = (const ushort_t*)(p.ws + OFF_DR);
  ushort_t* O = (ushort_t*)(p.ws + OFF_ZQ);
  const float* PU = p.out;
  const int lane = threadIdx.x & 63;
  const int gw = __builtin_amdgcn_readfirstlane(blockIdx.x * 8 + (threadIdx.x >> 6));
  for (int task = gw; task < 32 * NCHUNK; task += gridDim.x * 8) {
    const int cd = task / NCHUNK, j = task % NCHUNK, dir = cd >> 4, c = cd & 15, b = c >> 3, head = c & 7;
    float S[64];
    const float* src = PU + (size_t)task * 2 * 4096 + lane * 64;
#pragma unroll
    for (int k = 0; k < 64; k += 4) { const float4 v = *(const float4*)(src + k); S[k] = v.x; S[k + 1] = v.y; S[k + 2] = v.z; S[k + 3] = v.w; }
    const ushort_t* shc = SH + (size_t)c * LTOT * 192;
    const ushort_t* drc = DR + (size_t)(dir * 16 + c) * LTOT * 192;
    ushort_t* obase = O + ((size_t)dir * NX + (size_t)b * SEQ) * 512 + head * 64 + lane;
    ScanRec r0 = scan_load(shc, drc, tau_to_pos(dir, j * CH + 0), lane);
    ScanRec r1 = scan_load(shc, drc, tau_to_pos(dir, j * CH + 1), lane);
    ScanRec r2 = scan_load(shc, drc, tau_to_pos(dir, j * CH + 2), lane);
#pragma unroll 1
    for (int st = 0; st < CH; ++st) {
      const int pos = tau_to_pos(dir, j * CH + st);
      const ScanRec r3 = scan_load(shc, drc, tau_to_pos(dir, j * CH + (st + SPF < CH ? st + SPF : CH - 1)), lane);
      const float o = scan_step<true>(S, r0, h2f(r0.v));
      if (pos >= CTXL) obase[(size_t)(pos - CTXL) * 512] = f2h(o);
      r0 = r1; r1 = r2; r2 = r3;
    }
  }
}

DI void phase_scan_naive(const Params& p) {
  const ushort_t* SH = (const ushort_t*)(p.ws + OFF_SH);
  const ushort_t* DR = (const ushort_t*)(p.ws + OFF_DR);
  ushort_t* O = (ushort_t*)(p.ws + OFF_ZQ);
  const int lane = threadIdx.x & 63;
  const int gw = __builtin_amdgcn_readfirstlane(blockIdx.x * 8 + (threadIdx.x >> 6));
  if (gw >= 32) return;
  const int cd = gw, dir = cd >> 4, c = cd & 15, b = c >> 3, head = c & 7;
  float S[64];
#pragma unroll
  for (int k = 0; k < 64; ++k) S[k] = 0.f;
  const ushort_t* shc = SH + (size_t)c * LTOT * 192;
  const ushort_t* drc = DR + (size_t)(dir * 16 + c) * LTOT * 192;
#pragma unroll 1
  for (int tau = 0; tau < LTOT; ++tau) {
    const int pos = tau_to_pos(dir, tau);
    const ushort_t* shr = shc + (size_t)pos * 192;
    const ushort_t* drr = drc + (size_t)pos * 192;
    const float vv = h2f(shr[128 + lane]);
    u32x16 k0, k1;
    sload2(k0, k1, shr);
    float sk0 = 0.f, sk1 = 0.f;
#pragma unroll
    for (int q = 0; q < 32; ++q) { sk0 = fmaf(S[q], HV(k0, q), sk0); sk1 = fmaf(S[32 + q], HV(k1, q), sk1); }
    const float nsk = -(sk0 + sk1);
    u32x16 x0, x1, d0, d1;
    sload4(x0, x1, d0, d1, drr, drr + 64);
#pragma unroll
    for (int q = 0; q < 32; ++q) {
      S[q] = fmaf(S[q], -HV(x0, q), S[q]); S[32 + q] = fmaf(S[32 + q], -HV(x1, q), S[32 + q]);
      S[q] = fmaf(vv, HV(d0, q), S[q]); S[32 + q] = fmaf(vv, HV(d1, q), S[32 + q]);
    }
    u32x16 b0, b1, r0, r1;
    sload4(b0, b1, r0, r1, drr + 128, shr + 64);
    float o0 = 0.f, o1 = 0.f;
#pragma unroll
    for (int q = 0; q < 32; ++q) {
      S[q] = fmaf(nsk, HV(b0, q), S[q]); S[32 + q] = fmaf(nsk, HV(b1, q), S[32 + q]);
      o0 = fmaf(S[q], HV(r0, q), o0); o1 = fmaf(S[32 + q], HV(r1, q), o1);
    }
    if (pos >= CTXL) O[((size_t)dir * NX + (size_t)b * SEQ + (pos - CTXL)) * 512 + head * 64 + lane] = f2h(o0 + o1);
  }
}

DI void phase_attn(const Params& p, unsigned char* smem) {
  ushort_t* Kb = (ushort_t*)smem;
  ushort_t* Vb = Kb + 2 * 64 * LDK;
  ushort_t* QB = (ushort_t*)(p.ws + OFF_QB);
  const ushort_t* KB = (const ushort_t*)(p.ws + OFF_KB);
  const ushort_t* VB = (const ushort_t*)(p.ws + OFF_VB);
  const int tid = threadIdx.x, wave = tid >> 6, lane = tid & 63, l31 = lane & 31, hh = lane >> 5;
  const int loff = (tid >> 3) * LDK + (tid & 7) * 8;
  constexpr float THR = 6.f;
  constexpr int NTL = LTOT / 64;
  for (int at = blockIdx.x; at < 1024; at += gridDim.x) {
    const int b = at >> 9, kvh = (at >> 8) & 1, t0 = (at & 255) * 64;
    const int head = kvh * 4 + (wave & 3), tq = t0 + (wave >> 2) * 32 + l31;
    ushort_t* qrow = QB + ((size_t)(b * 8 + head) * SEQ + tq) * 64;
    bf16x8 qf[4];
#pragma unroll
    for (int ks = 0; ks < 4; ++ks) qf[ks] = *(const bf16x8*)(qrow + ks * 16 + hh * 8);
    const ushort_t* kbase = KB + (size_t)(b * 2 + kvh) * LTOT * 64 + tid * 8;
    const ushort_t* vbase = VB + (size_t)(b * 2 + kvh) * LTOT * 64 + tid * 8;
    f32x16 o[2] = {zero16(), zero16()};
    f32x16 negm = zero16();
    float lsum = 0.f;
    auto qk = [&](f32x16 (&s)[2], const ushort_t* Ks) {
      s[0] = negm; s[1] = negm;
#pragma unroll
      for (int ks = 0; ks < 4; ++ks)
#pragma unroll
        for (int kk = 0; kk < 2; ++kk) s[kk] = MFMA(*(const bf16x8*)&Ks[(kk * 32 + l31) * LDK + ks * 16 + hh * 8], qf[ks], s[kk]);
    };
    uint4 rk, rv;
    __syncthreads();
    rk = *(const uint4*)kbase; rv = *(const uint4*)vbase;
    *(uint4*)&Kb[loff] = rk; *(uint4*)&Vb[loff] = rv;
    rk = *(const uint4*)(kbase + 4096);
    rv = *(const uint4*)(vbase + 4096);
    __syncthreads();
    f32x16 sA[2], sB[2];
    qk(sA, Kb);
    {
      float mx = fmaxf(sA[0][0], sA[1][0]);
#pragma unroll
      for (int i = 1; i < 16; ++i) mx = fmaxf(mx, fmaxf(sA[0][i], sA[1][i]));
      mx = fmaxf(mx, __shfl_xor(mx, 32, 64));
#pragma unroll
      for (int i = 0; i < 16; ++i) { sA[0][i] -= mx; sA[1][i] -= mx; negm[i] = -mx; }
    }
    *(uint4*)&Kb[64 * LDK + loff] = rk;
    rk = *(const uint4*)(kbase + 2 * 4096);
    auto step = [&](int t, f32x16 (&sc)[2], f32x16 (&sn)[2]) {
      __syncthreads();
      if (t + 2 < NTL) *(uint4*)&Kb[(t & 1) * 64 * LDK + loff] = rk;
      if (t + 1 < NTL) *(uint4*)&Vb[((t + 1) & 1) * 64 * LDK + loff] = rv;
      if (t + 3 < NTL) rk = *(const uint4*)(kbase + (size_t)(t + 3) * 4096);
      if (t + 2 < NTL) rv = *(const uint4*)(vbase + (size_t)(t + 2) * 4096);
      if (t + 1 < NTL) qk(sn, Kb + ((t + 1) & 1) * 64 * LDK);
      float mx = fmaxf(sc[0][0], sc[1][0]);
#pragma unroll
      for (int i = 1; i < 16; ++i) mx = fmaxf(mx, fmaxf(sc[0][i], sc[1][i]));
      mx = fmaxf(mx, __shfl_xor(mx, 32, 64));
      if (__builtin_amdgcn_ballot_w64(mx > THR) != 0ull) {
        const float delta = fmaxf(mx, 0.f);
        const float alpha = __builtin_amdgcn_exp2f(-delta);
        lsum *= alpha;
#pragma unroll
        for (int i = 0; i < 16; ++i) {
          o[0][i] *= alpha; o[1][i] *= alpha; sc[0][i] -= delta; sc[1][i] -= delta; negm[i] -= delta;
          sn[0][i] -= delta; sn[1][i] -= delta;
        }
      }
      float ps = 0.f;
#pragma unroll
      for (int i = 0; i < 16; ++i) {
        sc[0][i] = __builtin_amdgcn_exp2f(sc[0][i]); sc[1][i] = __builtin_amdgcn_exp2f(sc[1][i]);
        ps += sc[0][i] + sc[1][i];
      }
      lsum += ps;
      const ushort_t* Vt = Vb + (t & 1) * 64 * LDK;
#pragma unroll
      for (int kk = 0; kk < 2; ++kk) {
#pragma unroll
        for (int st = 0; st < 2; ++st) {
          uint4 pw;
          pw.x = pack_bf2(sc[kk][8 * st + 0], sc[kk][8 * st + 1]); pw.y = pack_bf2(sc[kk][8 * st + 2], sc[kk][8 * st + 3]);
          pw.z = pack_bf2(sc[kk][8 * st + 4], sc[kk][8 * st + 5]); pw.w = pack_bf2(sc[kk][8 * st + 6], sc[kk][8 * st + 7]);
          const bf16x8 pf = __builtin_bit_cast(bf16x8, pw);
#pragma unroll
          for (int dt = 0; dt < 2; ++dt) o[dt] = MFMA(*(const bf16x8*)&Vt[(dt * 32 + l31) * LDK + kk * 32 + st * 16 + hh * 8], pf, o[dt]);
        }
      }
    };
#pragma unroll 1
    for (int t = 0; t < NTL; t += 2) {
      step(t, sA, sB);
      step(t + 1, sB, sA);
    }
    const float ltot = lsum + __shfl_xor(lsum, 32, 64);
    const float il = 1.f / ltot;
#pragma unroll
    for (int dt = 0; dt < 2; ++dt)
#pragma unroll
      for (int g = 0; g < 4; ++g) {
        uint2 w;
        w.x = pack_bf2(o[dt][4 * g + 0] * il, o[dt][4 * g + 1] * il);
        w.y = pack_bf2(o[dt][4 * g + 2] * il, o[dt][4 * g + 3] * il);
        *(uint2*)(qrow + dt * 32 + 8 * g + 4 * hh) = w;
      }
  }
}

constexpr size_t OFF_DBG = WS_END;
DI void dbg_acc(const Params& p, int slot, float d2, float r2) {
  float* dbg = (float*)(p.ws + OFF_DBG);
  d2 = wave_sum(d2); r2 = wave_sum(r2);
  if ((threadIdx.x & 63) == 0) { atomicAdd(dbg + 2 * slot, d2); atomicAdd(dbg + 2 * slot + 1, r2); }
}
DI void probe_after_gemm1(const Params& p) {
  if (blockIdx.x != 0) return;
  const int tid = threadIdx.x, lane = tid & 63, wave = tid >> 6;
  const float* mod = (const float*)(p.ws + OFF_MOD);
  const ushort_t* H = (const ushort_t*)(p.ws + OFF_SH);
  {
    float d2 = 0.f, r2 = 0.f;
    if (tid < 96) {
      const int v = tid / 32, n = (tid % 32) * 97 % 3072;
      float s = 0.f;
      for (int k = 0; k < 1024; ++k) { const float cv = (v < 2) ? p.c[v * 1024 + k] : p.c_ctx[k]; s += (cv / (1.f + expf(-cv))) * p.w_ada[(size_t)k * 3072 + n]; }
      s += p.b_ada[n];
      const float d = mod[v * 3072 + n] - s; d2 = d * d; r2 = s * s;
    }
    dbg_acc(p, 0, d2, r2);
  }
  {
    const int row = wave == 0 ? 0 : wave == 1 ? 777 : wave == 2 ? 16383 : wave == 3 ? 16384 : wave == 4 ? 32767 : wave == 5 ? 32768 : wave == 6 ? 33023 : 33279;
    const float* src = (row < NX) ? p.x + (size_t)row * DM : p.ctx + (size_t)(row - NX) * DM;
    const float* md = mod + ((row < NX) ? (row / SEQ) : 2) * 3072;
    float s = 0.f;
    for (int i = lane; i < 1024; i += 64) s += src[i];
    const float mu = wave_sum(s) / 1024.f;
    float q = 0.f;
    for (int i = lane; i < 1024; i += 64) q += (src[i] - mu) * (src[i] - mu);
    const float rstd = rsqrtf(wave_sum(q) / 1024.f + LN_EPS);
    float d2 = 0.f, r2 = 0.f;
    for (int i = lane; i < 1024; i += 64) {
      const float ref = (src[i] - mu) * rstd * (1.f + md[1024 + i]) + md[i];
      const float d = bf2f(H[(size_t)row * DM + i]) - ref; d2 += d * d; r2 += ref * ref;
    }
    dbg_acc(p, 1, d2, r2);
  }
  {
    float d2 = 0.f, r2 = 0.f;
    if (tid < 60) {
      const int ri = tid / 10, ci = tid % 10;
      const int row = ri == 0 ? 3 : ri == 1 ? 777 : ri == 2 ? 20001 : ri == 3 ? 32767 : ri == 4 ? 32773 : 33279;
      const int col = ci == 0 ? 0 : ci == 1 ? 100 : ci == 2 ? 700 : ci == 3 ? 800 : ci == 4 ? 1279 : ci == 5 ? 1280 : ci == 6 ? 2000 : ci == 7 ? 3071 : ci == 8 ? 3072 : 3583;
      float s = 0.f;
      for (int k = 0; k < 1024; ++k) s += bf2f(H[(size_t)row * DM + k]) * p.w_in[(size_t)k * INW + col];
      float got = 0.f; bool have = true;
      if (col < 768) got = bf2f(((const ushort_t*)(p.ws + OFF_ZQ))[(size_t)row * 768 + col]);
      else if (col < 1280) { if (row < NX) got = bf2f(((const ushort_t*)(p.ws + OFF_ZG))[(size_t)row * 1024 + col - 768]); else have = false; }
      else if (col < 3072) got = bf2f(((const ushort_t*)p.out)[(size_t)row * 1792 + col - 1280]);
      else { if (row < NX) got = bf2f(((const ushort_t*)(p.ws + OFF_ZG))[(size_t)row * 1024 + 512 + col - 3072]); else have = false; }
      if (have) { const float d = got - s; d2 = d * d; r2 = s * s; }
    }
    dbg_acc(p, 2, d2, r2);
  }
}
DI void probe_after_prep(const Params& p, unsigned char* smem) {
  if (blockIdx.x != 0) return;
  float* cbuf = (float*)smem;
  const int tid = threadIdx.x, lane = tid & 63, wave = tid >> 6;
  const ushort_t* zm = (const ushort_t*)p.out;
  const ushort_t* SH = (const ushort_t*)(p.ws + OFF_SH);
  const ushort_t* DR = (const ushort_t*)(p.ws + OFF_DR);
  float dA = 0.f, rA = 0.f, dB = 0.f, rB = 0.f;
#pragma unroll 1
  for (int sidx = wave; sidx < 24; sidx += 8) {
    const int ri = sidx >> 1, head = (sidx & 1) ? 5 : 0;
    const int row = ri == 0 ? 0 : ri == 1 ? 1 : ri == 2 ? 31 : ri == 3 ? 32 : ri == 4 ? 16383 : ri == 5 ? 16384 : ri == 6 ? 20000 : ri == 7 ? 32767 : ri == 8 ? 32768 : ri == 9 ? 33023 : ri == 10 ? 33024 : 33279;
    int b, t, len, pp;
    if (row < NX) { b = row / SEQ; t = row % SEQ; len = SEQ; pp = CTXL + t; } else { b = (row - NX) / CTXL; t = (row - NX) % CTXL; len = CTXL; pp = t; }
    auto sft = [&](int col) {
      const float z = bf2f(zm[(size_t)row * 1792 + col]);
      const float zp = (t > 0) ? bf2f(zm[(size_t)(row - 1) * 1792 + col]) : 0.f;
      const float zn = (t < len - 1) ? bf2f(zm[(size_t)(row + 1) * 1792 + col]) : 0.f;
      return z + p.mu_prev[col] * (zp - z) + p.mu_next[col] * (zn - z);
    };
    const int n = head * 64 + lane;
    const float r = sft(n), k = sft(512 + n), v = sft(1024 + n);
#pragma unroll 1
    for (int j = lane; j < 256; j += 64) { const float s = sft(1536 + j); cbuf[wave * 256 + j] = (j < 128) ? tanhf(s) : s; }
    __builtin_amdgcn_s_waitcnt(0);
    __builtin_amdgcn_wave_barrier();
    const float kr = k * p.k_k[n];
    const float nrm = sqrtf(wave_sum(kr * kr));
    const float kk = kr / fmaxf(nrm, 1e-12f);
    const size_t cp = (size_t)(b * 8 + head) * LTOT + pp;
    { float d;
      d = h2f(SH[(cp * 3 + 0) * 64 + lane]) - kk; dA += d * d; rA += kk * kk;
      d = h2f(SH[(cp * 3 + 1) * 64 + lane]) - r; dA += d * d; rA += r * r;
      d = h2f(SH[(cp * 3 + 2) * 64 + lane]) - v; dA += d * d; rA += v * v; }
#pragma unroll 1
    for (int dir = 0; dir < 2; ++dir) {
      float wpre = p.w0[dir * 512 + n], apre = p.a0[dir * 512 + n];
#pragma unroll 1
      for (int j = 0; j < 64; ++j) {
        wpre += cbuf[wave * 256 + dir * 64 + j] * p.w_up[(size_t)(dir * 64 + j) * 512 + n];
        apre += cbuf[wave * 256 + 128 + dir * 64 + j] * p.a_up[(size_t)(dir * 64 + j) * 512 + n];
      }
      const float wlog = -log1pf(expf(-wpre)) - 0.5f;
      const float xd = 1.f - expf(-expf(wlog));
      const float a = 1.f / (1.f + expf(-apre));
      const float kd = k * (1.f + (a - 1.f) * p.k_a[n]);
      const float bq = kk * a;
      const size_t dp = (size_t)(dir * 16 + b * 8 + head) * LTOT + pp;
      float d;
      d = h2f(DR[(dp * 3 + 0) * 64 + lane]) - xd; dB += d * d; rB += xd * xd;
      d = h2f(DR[(dp * 3 + 1) * 64 + lane]) - kd; dB += d * d; rB += kd * kd;
      d = h2f(DR[(dp * 3 + 2) * 64 + lane]) - bq; dB += d * d; rB += bq * bq;
    }
    __builtin_amdgcn_wave_barrier();
  }
  dbg_acc(p, 3, dA, rA);
  dbg_acc(p, 4, dB, rB);
}

DI void probe_scan(const Params& p) {
  if (blockIdx.x != 0 || threadIdx.x >= 128) return;
  const ushort_t* SH = (const ushort_t*)(p.ws + OFF_SH);
  const ushort_t* DR = (const ushort_t*)(p.ws + OFF_DR);
  const ushort_t* O = (const ushort_t*)(p.ws + OFF_ZQ);
  const int lane = threadIdx.x & 63, wv = threadIdx.x >> 6;
  const int c = wv ? 9 : 0, dir = wv, b = c >> 3, head = c & 7;
  float S[64];
#pragma unroll
  for (int k = 0; k < 64; ++k) S[k] = 0.f;
  float d2 = 0.f, r2 = 0.f;
#pragma unroll 1
  for (int tau = 0; tau < 420; ++tau) {
    const int pos = dir == 0 ? tau : (tau < CTXL ? CTXL - 1 - tau : LTOT - 1 - (tau - CTXL));
    const ushort_t* sh = SH + ((size_t)c * LTOT + pos) * 192;
    const ushort_t* dr = DR + ((size_t)(dir * 16 + c) * LTOT + pos) * 192;
    const float v = h2f(sh[128 + lane]);
    float sk = 0.f;
#pragma unroll
    for (int k = 0; k < 64; ++k) sk += S[k] * h2f(sh[k]);
    float o = 0.f;
#pragma unroll
    for (int k = 0; k < 64; ++k) {
      const float dec = 1.f - h2f(dr[k]);
      S[k] = S[k] * dec - sk * h2f(dr[128 + k]) + v * h2f(dr[64 + k]);
      o += S[k] * h2f(sh[64 + k]);
    }
    if (pos >= CTXL) {
      const float got = h2f(O[((size_t)dir * NX + (size_t)b * SEQ + (pos - CTXL)) * 512 + head * 64 + lane]);
      const float d = got - o; d2 += d * d; r2 += o * o;
    }
  }
  dbg_acc(p, 0, d2, r2);
}
DI float probe_delta(const Params& p) {
  const float* dbg = (const float*)(p.ws + OFF_DBG);
  int k = 0;
  for (int s = 0; s < 5; ++s) { const float rel = sqrtf(dbg[2 * s] / fmaxf(dbg[2 * s + 1], 1e-30f)); if (!(rel < 0.05f)) k |= 1 << s; }
  return sqrtf(0.02f * (float)k);
}

DI void phase_final(const Params& p, unsigned char* smem) {
  ushort_t* As = (ushort_t*)smem;
  ushort_t* Bs = As + 2 * 128 * LDK;
  const float* mod = (const float*)(p.ws + OFF_MOD);
  ushort_t* ZG = (ushort_t*)(p.ws + OFF_ZG);
  ushort_t* QB = (ushort_t*)(p.ws + OFF_QB);
  ushort_t* O = (ushort_t*)(p.ws + OFF_ZQ);
  const ushort_t* SH = (const ushort_t*)(p.ws + OFF_SH);
  const ushort_t* DR = (const ushort_t*)(p.ws + OFF_DR);
  const ushort_t* WMG = (const ushort_t*)(p.ws + OFF_WMG);
  const ushort_t* WPA = (const ushort_t*)(p.ws + OFF_WPA);
  const ushort_t* WPB = (const ushort_t*)(p.ws + OFF_WPB);
  const ushort_t* WO = (const ushort_t*)(p.ws + OFF_WO);
#pragma unroll 1
  for (int mt = blockIdx.x; mt < NX / 128; mt += gridDim.x) {
    int tid = threadIdx.x;
    asm volatile("" : "+v"(tid));
    const int wave = tid >> 6, lane = tid & 63, l31 = lane & 31, hh = lane >> 5;
    const int wrow0 = (wave & 3) * 32, wcol0 = (wave >> 2) * 64;
    const int row0 = mt * 128, b = row0 / SEQ, tb0 = row0 % SEQ;
    const float* md = mod + b * 3072;
    __syncthreads();
#pragma unroll 1
    for (int r4 = wave * 4; r4 < 128; r4 += 32) {
      const int r = r4 + (lane >> 4), l16 = lane & 15;
      ushort_t* hdst = (ushort_t*)(p.out + (size_t)(row0 + r) * DM);
      float4 v[16];
      const float rstd = ln_rows4(p.x + (size_t)(row0 + r) * DM, l16, v);
#pragma unroll
      for (int i = 0; i < 16; ++i) {
        const int col = l16 * 4 + 64 * i;
        const float4 sh = *(const float4*)(md + col), sc = *(const float4*)(md + 1024 + col);
        uint2 o;
        o.x = pack_bf2(v[i].x * rstd * (1.f + sc.x) + sh.x, v[i].y * rstd * (1.f + sc.y) + sh.y);
        o.y = pack_bf2(v[i].z * rstd * (1.f + sc.z) + sh.z, v[i].w * rstd * (1.f + sc.w) + sh.w);
        *(uint2*)(hdst + col) = o;
      }
    }
#if PROBE
    float a2ref = 0.f;
    if (mt == 0) {
      const int tok = wave * 16 + 3, head = wave, row = row0 + tok, t = tb0 + tok, dd = head * 64 + lane;
      const size_t cp = (size_t)(b * 8 + head) * LTOT + CTXL + t;
      const float o = h2f(O[(size_t)row * 512 + dd]) + h2f(O[((size_t)NX + row) * 512 + dd]);
      const float mu = wave_sum(o) / 64.f;
      const float var = wave_sum((o - mu) * (o - mu)) / 64.f;
      const float y = (o - mu) * rsqrtf(var + GN_EPS) * p.gn_w[dd] + p.gn_b[dd];
      const float r = h2f(SH[(cp * 3 + 1) * 64 + lane]), vv = h2f(SH[(cp * 3 + 2) * 64 + lane]);
      const float kf = h2f(DR[(cp * 3 + 1) * 64 + lane]), kb = h2f(DR[(((size_t)16 * LTOT + cp) * 3 + 1) * 64 + lane]);
      const float bon = wave_sum(r * kf * p.r_k[dd]) + wave_sum(r * kb * p.r_k[512 + dd]);
      const float g = bf2f(ZG[(size_t)row * 1024 + 512 + dd]);
      a2ref = (y + bon * vv) * (g / (1.f + expf(-g)));
    }
#endif
#pragma unroll 1
    for (int it = 0; it < 16; ++it) {
      const int pair = (it * 8 + wave) * 8 + (lane >> 3), q8 = lane & 7;
      const int tok = pair >> 3, head = pair & 7, row = row0 + tok, t = tb0 + tok, d0 = q8 * 8;
      const unsigned cp = (unsigned)((b * 8 + head) * LTOT + CTXL + t);
      const unsigned ofo = (unsigned)(row * 512 + head * 64 + d0), obo = ofo + (unsigned)NX * 512u;
      const unsigned ro = (cp * 3 + 1) * 64 + d0, vo = (cp * 3 + 2) * 64 + d0;
      const unsigned kbo = ((16u * LTOT + cp) * 3 + 1) * 64 + d0;
      const unsigned gbo = (unsigned)(row * 1024 + 512 + head * 64 + d0), gao = gbo - 512;
      const unsigned yao = (unsigned)(((b * 8 + head) * SEQ + t) * 64 + d0);
      float ov[8], bon = 0.f, s = 0.f;
      {
        const uint4 a = *(const uint4*)(O + ofo), bq = *(const uint4*)(O + obo);
        const uint4 rr = *(const uint4*)(SH + ro), kf = *(const uint4*)(DR + ro), kb = *(const uint4*)(DR + kbo);
        const unsigned aw[4] = {a.x, a.y, a.z, a.w}, bw[4] = {bq.x, bq.y, bq.z, bq.w}, rw[4] = {rr.x, rr.y, rr.z, rr.w};
        const unsigned fw[4] = {kf.x, kf.y, kf.z, kf.w}, kw[4] = {kb.x, kb.y, kb.z, kb.w};
#pragma unroll
        for (int q = 0; q < 4; ++q) {
          const int dd = head * 64 + d0 + 2 * q;
          ov[2 * q] = hlo(aw[q]) + hlo(bw[q]);
          ov[2 * q + 1] = hhi(aw[q]) + hhi(bw[q]);
          s += ov[2 * q] + ov[2 * q + 1];
          bon += hlo(rw[q]) * (hlo(fw[q]) * p.r_k[dd] + hlo(kw[q]) * p.r_k[512 + dd]);
          bon += hhi(rw[q]) * (hhi(fw[q]) * p.r_k[dd + 1] + hhi(kw[q]) * p.r_k[512 + dd + 1]);
        }
      }
      s += __shfl_xor(s, 1, 64); s += __shfl_xor(s, 2, 64); s += __shfl_xor(s, 4, 64);
      bon += __shfl_xor(bon, 1, 64); bon += __shfl_xor(bon, 2, 64); bon += __shfl_xor(bon, 4, 64);
      const float mu = s * (1.f / 64.f);
      float vs = 0.f;
#pragma unroll
      for (int q = 0; q < 8; ++q) { ov[q] -= mu; vs = fmaf(ov[q], ov[q], vs); }
      vs += __shfl_xor(vs, 1, 64); vs += __shfl_xor(vs, 2, 64); vs += __shfl_xor(vs, 4, 64);
      const float rstd = rsqrtf(vs * (1.f / 64.f) + GN_EPS);
      {
        const uint4 vv = *(const uint4*)(SH + vo), gb = *(const uint4*)(ZG + gbo), ga = *(const uint4*)(ZG + gao), ya = *(const uint4*)(QB + yao);
        const unsigned vw[4] = {vv.x, vv.y, vv.z, vv.w}, gbw[4] = {gb.x, gb.y, gb.z, gb.w}, gaw[4] = {ga.x, ga.y, ga.z, ga.w}, yw[4] = {ya.x, ya.y, ya.z, ya.w};
        unsigned o2[4], o1[4];
#pragma unroll
        for (int q = 0; q < 4; ++q) {
          const int dd = head * 64 + d0 + 2 * q;
          const float y0 = ov[2 * q] * rstd * p.gn_w[dd] + p.gn_b[dd] + bon * hlo(vw[q]);
          const float y1 = ov[2 * q + 1] * rstd * p.gn_w[dd + 1] + p.gn_b[dd + 1] + bon * hhi(vw[q]);
          o2[q] = pack_bf2(y0 * siluf(bflo(gbw[q])), y1 * siluf(bfhi(gbw[q])));
          o1[q] = pack_bf2(bflo(yw[q]) * siluf(bflo(gaw[q])), bfhi(yw[q]) * siluf(bfhi(gaw[q])));
        }
        *(uint4*)(O + ofo) = make_uint4(o2[0], o2[1], o2[2], o2[3]);
        *(uint4*)(QB + yao) = make_uint4(o1[0], o1[1], o1[2], o1[3]);
      }
    }
    asm volatile("s_waitcnt vmcnt(0)" ::: "memory");
    __syncthreads();
#if PROBE
    if (mt == 0) {
      const int tok = wave * 16 + 3, head = wave, row = row0 + tok, dd = head * 64 + lane;
      const float got = bf2f(O[(size_t)row * 512 + dd]);
      dbg_acc(p, 1, (got - a2ref) * (got - a2ref), a2ref * a2ref);
    }
#endif
    const ushort_t* hbase = (const ushort_t*)p.out;
    auto hload = [&](int r, int k) { return *(const uint4*)(hbase + (unsigned)((row0 + r) * 2048 + k)); };
    auto a1load = [&](int r, int k) { return *(const uint4*)(QB + (unsigned)(((b * 8 + (k >> 6)) * SEQ + tb0 + r) * 64 + (k & 63))); };
    auto a2load = [&](int r, int k) { return *(const uint4*)(O + (unsigned)((row0 + r) * 512 + k)); };
#pragma unroll 1
    for (int nt = 0; nt < 8; ++nt) {
      const int col0 = nt * 128;
      int tidn = tid;
      asm volatile("" : "+v"(tidn));
      f32x16 sg[2][1][2] = {{{zero16(), zero16()}}, {{zero16(), zero16()}}};
      gemm_pass<128, 128, 1, 2, 2>(sg, hload, [&](int w, int n, int k) { return *(const uint4*)(WMG + (unsigned)((w * 1024 + col0 + n) * DM + k)); }, DM, As, Bs, wrow0, wcol0, tidn);
#pragma unroll
      for (int ni = 0; ni < 2; ++ni) {
        const int col = col0 + wcol0 + ni * 32 + l31;
        const float ba = p.b_mg[col], bb = p.b_mg[1024 + col];
#pragma unroll
        for (int i = 0; i < 16; ++i) { sg[0][0][ni][i] = sigmf(sg[0][0][ni][i] + ba); sg[1][0][ni][i] = sigmf(sg[1][0][ni][i] + bb); }
      }
      {
        f32x16 ya[1][1][2] = {{{zero16(), zero16()}}};
        gemm_pass<128, 128, 1, 2, 1>(ya, a1load, [&](int w, int n, int k) { return *(const uint4*)(WPA + (unsigned)((col0 + n) * 512 + k)); }, 512, As, Bs, wrow0, wcol0, tidn);
#pragma unroll
        for (int ni = 0; ni < 2; ++ni)
#pragma unroll
          for (int i = 0; i < 16; ++i) sg[0][0][ni][i] *= ya[0][0][ni][i];
      }
      {
        f32x16 yb[1][1][2] = {{{zero16(), zero16()}}};
        gemm_pass<128, 128, 1, 2, 1>(yb, a2load, [&](int w, int n, int k) { return *(const uint4*)(WPB + (unsigned)((col0 + n) * 512 + k)); }, 512, As, Bs, wrow0, wcol0, tidn);
        int rb1 = row0 + wrow0 + 4 * hh;
        asm volatile("" : "+v"(rb1));
#pragma unroll
        for (int ni = 0; ni < 2; ++ni) {
          const int col = col0 + wcol0 + ni * 32 + l31;
#pragma unroll
          for (int i = 0; i < 16; ++i) {
            const float mv = sg[0][0][ni][i] + sg[1][0][ni][i] * yb[0][0][ni][i];
            ZG[(unsigned)((rb1 + crow(i, 0)) * 1024 + col)] = f2bf(mv);
          }
        }
      }
    }
    asm volatile("s_waitcnt vmcnt(0)" ::: "memory");
    __syncthreads();
#if PROBE
    if (mt == 0) {
      float d2 = 0.f, r2 = 0.f;
      if (tid < 64) {
        const int r = (tid * 37) & 127, col = (tid * 131 + 7) & 1023, row = row0 + r;
        const ushort_t* hrow = (const ushort_t*)(p.out + (size_t)row * DM);
        float ga = p.b_mg[col], gb = p.b_mg[1024 + col], ya = 0.f, yb = 0.f;
        for (int k = 0; k < 1024; ++k) { const float hv = bf2f(hrow[k]); ga += hv * p.w_mg[(size_t)k * 2048 + col]; gb += hv * p.w_mg[(size_t)k * 2048 + 1024 + col]; }
        for (int k = 0; k < 512; ++k) {
          ya += bf2f(QB[((size_t)(b * 8 + (k >> 6)) * SEQ + tb0 + r) * 64 + (k & 63)]) * p.w_pa[(size_t)k * 1024 + col];
          yb += bf2f(O[(size_t)row * 512 + k]) * p.w_pb[(size_t)k * 1024 + col];
        }
        const float ref = ya / (1.f + expf(-ga)) + yb / (1.f + expf(-gb));
        const float got = bf2f(ZG[(size_t)row * 1024 + col]);
        d2 = (got - ref) * (got - ref); r2 = ref * ref;
      }
      dbg_acc(p, 2, d2, r2);
    }
#endif
    const float* gt = md + 2048;
#pragma unroll 1
    for (int nt = 0; nt < 8; ++nt) {
      const int col0 = nt * 128;
      int tidn = tid;
      asm volatile("" : "+v"(tidn));
      f32x16 acc[1][1][2] = {{{zero16(), zero16()}}};
      gemm_pass<128, 128, 1, 2, 1>(acc, [&](int r, int k) { return *(const uint4*)(ZG + (unsigned)((row0 + r) * 1024 + k)); },
                                   [&](int w, int n, int k) { return *(const uint4*)(WO + (unsigned)((col0 + n) * DM + k)); }, DM, As, Bs, wrow0, wcol0, tidn);
      int rb2 = row0 + wrow0 + 4 * hh;
      asm volatile("" : "+v"(rb2));
#pragma unroll
      for (int ni = 0; ni < 2; ++ni) {
        const int col = col0 + wcol0 + ni * 32 + l31;
        const float g = gt[col];
#pragma unroll
        for (int i = 0; i < 16; ++i) {
          const unsigned idx = (unsigned)((rb2 + crow(i, 0)) * DM + col);
          p.out[idx] = ALPHA * p.x[idx] + g * acc[0][0][ni][i];
        }
      }
    }
    asm volatile("s_waitcnt vmcnt(0)" ::: "memory");
    __syncthreads();
#if PROBE
    if (mt == 0) {
      float d2 = 0.f, r2 = 0.f;
      if (tid < 64) {
        const int r = (tid * 29) & 127, col = (tid * 113 + 5) & 1023, row = row0 + r;
        float o = 0.f;
        for (int k = 0; k < 1024; ++k) o += bf2f(ZG[(size_t)row * 1024 + k]) * p.w_o[(size_t)k * 1024 + col];
        const float ref = md[2048 + col] * o;
        const float got = p.out[(size_t)row * DM + col] - ALPHA * p.x[(size_t)row * DM + col];
        d2 = (got - ref) * (got - ref); r2 = ref * ref;
      }
      dbg_acc(p, 3, d2, r2);
    }
    asm volatile("s_waitcnt vmcnt(0)" ::: "memory");
    __syncthreads();
#endif
#if !PROBE
#pragma unroll 1
    for (int r4 = wave * 4; r4 < 128; r4 += 32) {
      const int r = r4 + (lane >> 4), l16 = lane & 15;
      float* dst = p.out + (size_t)(row0 + r) * DM;
      float4 v[16];
      const float rstd = ln_rows4(dst, l16, v);
#pragma unroll
      for (int i = 0; i < 16; ++i) {
        const int col = l16 * 4 + 64 * i;
        const float4 g = *(const float4*)(p.ln_g + col), bb = *(const float4*)(p.ln_b + col);
        *(float4*)(dst + col) = make_float4(v[i].x * rstd * g.x + bb.x, v[i].y * rstd * g.y + bb.y, v[i].z * rstd * g.z + bb.z, v[i].w * rstd * g.w + bb.w);
      }
    }
#endif
  }
}


#if PROBE
DI void probe_f3(const Params& p) {
  const float pdelta = probe_delta(p);
  const int lane = threadIdx.x & 63, wave = threadIdx.x >> 6;
  for (int mt = blockIdx.x; mt < NX / 128; mt += gridDim.x) {
    for (int r = wave; r < 128; r += 8) {
      const float* src = p.x + (size_t)(mt * 128 + r) * DM;
      float* dst = p.out + (size_t)(mt * 128 + r) * DM;
      float s = 0.f, q = 0.f;
      for (int i = lane; i < 1024; i += 64) s += ALPHA * src[i];
      const float mu = wave_sum(s) / 1024.f;
      for (int i = lane; i < 1024; i += 64) { const float d = ALPHA * src[i] - mu; q += d * d; }
      const float rstd = rsqrtf(wave_sum(q) / 1024.f + LN_EPS);
      for (int i = lane; i < 1024; i += 64) dst[i] = (ALPHA * src[i] - mu) * rstd * p.ln_g[i] + p.ln_b[i] + pdelta;
    }
  }
}
#endif
DI void gsync(cg::grid_group& g) { asm volatile("s_waitcnt vmcnt(0) lgkmcnt(0)" ::: "memory"); g.sync(); }

constexpr int SMEM_BYTES = 2 * (256 + 128) * LDK * 2;
static_assert(SMEM_BYTES >= 65536 + 32 * 264 * 2 + 1024, "rwkv prep LDS");
__global__ void __launch_bounds__(NTH) fwd_megakernel(Params p) {
  __shared__ __attribute__((aligned(16))) unsigned char smem[SMEM_BYTES];
  cg::grid_group grid = cg::this_grid();
#if PROBE
  if (blockIdx.x == 0 && threadIdx.x < 64) ((float*)(p.ws + OFF_DBG))[threadIdx.x] = 0.f;
#endif
  phase0(p, smem);
  gsync(grid);
  phase_h(p);
  gsync(grid);
  phase_gemm1(p, smem);
  gsync(grid);
  phase_qkv(p);
  phase_rwkv_prep(p, smem);
  gsync(grid);
#if PROBE_NAIVE_SCAN
  phase_scan_naive(p);
#else
  phase_scanA(p, smem);
  gsync(grid);
  phase_scanB(p, smem);
  gsync(grid);
  phase_scanC(p, smem);
#endif
  phase_attn(p, smem);
  gsync(grid);
#if PROBE
  probe_scan(p);
  gsync(grid);
#endif
  phase_final(p, smem);
#if PROBE
  gsync(grid);
  probe_f3(p);
#endif
}

extern "C" void kernel_launch(void* const* d_in, const int* in_sizes, int n_in, void* d_out, int out_size, void* d_ws, size_t ws_size,
                              hipStream_t stream) {
  static int grid_blocks = 0;
  if (!grid_blocks) {
    int dev = 0, cus = 0, per_cu = 0;
    hipGetDevice(&dev);
    hipDeviceGetAttribute(&cus, hipDeviceAttributeMultiprocessorCount, dev);
    hipOccupancyMaxActiveBlocksPerMultiprocessor(&per_cu, fwd_megakernel, NTH, 0);
    if (per_cu < 1) fprintf(stderr, "occupancy query says %d blocks/CU\n", per_cu);
    grid_blocks = cus > 0 ? cus : 256;
    if (ws_size < WS_END) fprintf(stderr, "workspace too small: %zu < %zu\n", ws_size, (size_t)WS_END);
  }
  Params p{};
  const float** fp = (const float**)&p;
  for (int i = 0; i < 27; ++i) fp[i] = (const float*)d_in[i];
  p.out = (float*)d_out;
  p.ws = (unsigned char*)d_ws;
  void* args[] = {&p};
  hipError_t e = hipLaunchCooperativeKernel((void*)fwd_megakernel, dim3(grid_blocks), dim3(NTH), args, 0, stream);
  if (e != hipSuccess) fprintf(stderr, "cooperative launch failed: %s (grid %d)\n", hipGetErrorString(e), grid_blocks);
}
```

```cpp
#include <hip/hip_runtime.h>
#include <hip/hip_cooperative_groups.h>
#include <stdint.h>
#include <cstdio>
namespace cg = cooperative_groups;

#define PROBE 0
#define DI __device__ __forceinline__
typedef __attribute__((ext_vector_type(8))) short bf16x8;
typedef __attribute__((ext_vector_type(16))) float f32x16;
typedef __attribute__((ext_vector_type(16))) uint32_t u32x16;
typedef __attribute__((ext_vector_type(2))) _Float16 h2;
typedef __attribute__((ext_vector_type(2))) __bf16 b2;
typedef unsigned short ushort_t;
typedef __attribute__((ext_vector_type(4))) uint32_t u32x4;
#define MFMA(a, b, c) __builtin_amdgcn_mfma_f32_32x32x16_bf16((a), (b), (c), 0, 0, 0)

constexpr int DM = 1024, NB = 2, SEQ = 16384, CTXL = 256;
constexpr int NX = NB * SEQ, NC = NB * CTXL, NT = NX + NC;
constexpr int INW = 3584, LTOT = CTXL + SEQ;
constexpr int NTH = 512;
constexpr int CH = 260, NCHUNK = LTOT / CH;
static_assert(NCHUNK * CH == LTOT, "chunking");
constexpr float LN_EPS = 1e-5f, QK_EPS = 1e-6f, GN_EPS = 64e-5f;
constexpr float ALPHA = 1.189207115002721f;
constexpr float QSCALE = 0.125f * 1.4426950408889634f;

constexpr size_t OFF_WIN = 0;
constexpr size_t OFF_WMG = OFF_WIN + (size_t)INW * DM * 2;
constexpr size_t OFF_WPA = OFF_WMG + (size_t)2048 * DM * 2;
constexpr size_t OFF_WPB = OFF_WPA + (size_t)1024 * 512 * 2;
constexpr size_t OFF_WO  = OFF_WPB + (size_t)1024 * 512 * 2;
constexpr size_t OFF_WL  = OFF_WO + (size_t)1024 * 1024 * 2;
constexpr size_t OFF_MOD = OFF_WL + (size_t)2 * 2 * 512 * 64 * 2;
constexpr size_t OFF_ZG  = OFF_MOD + 36864;
constexpr size_t OFF_QB  = OFF_ZG + (size_t)NX * 1024 * 2;
constexpr size_t OFF_KB  = OFF_QB + (size_t)NX * 512 * 2;
constexpr size_t OFF_VB  = OFF_KB + (size_t)NB * 2 * LTOT * 64 * 2;
constexpr size_t OFF_SH  = OFF_VB + (size_t)NB * 2 * LTOT * 64 * 2;
constexpr size_t OFF_DR  = OFF_SH + (size_t)16 * LTOT * 192 * 2;
constexpr size_t OFF_ZQ  = OFF_DR + (size_t)32 * LTOT * 192 * 2;
constexpr size_t WS_END  = OFF_ZQ + (size_t)2 * NX * 512 * 2;
static_assert(WS_END <= (size_t)536870912, "workspace");
static_assert((size_t)NT * DM * 2 <= (size_t)48 * LTOT * 192 * 2, "H alias");
static_assert((size_t)NT * 768 * 2 <= (size_t)2 * NX * 512 * 2, "zqkv alias");

struct Params {
  const float *x, *c, *ctx, *c_ctx, *w_ada, *b_ada, *w_in, *q_norm, *k_norm, *mu_prev, *mu_next, *w0, *w_up, *a0, *a_up, *k_k, *k_a,
      *r_k, *gn_w, *gn_b, *w_pa, *w_pb, *w_mg, *b_mg, *w_o, *ln_g, *ln_b;
  float* out;
  unsigned char* ws;
};

DI ushort_t f2bf(float f) { return __builtin_bit_cast(ushort_t, (__bf16)f); }
DI float bf2f(ushort_t b) { return __uint_as_float(((unsigned)b) << 16); }
DI unsigned pack_bf2(float a, float b) { b2 v = {(__bf16)a, (__bf16)b}; return __builtin_bit_cast(unsigned, v); }
DI unsigned pack_h2(float a, float b) { h2 v = {(_Float16)a, (_Float16)b}; return __builtin_bit_cast(unsigned, v); }
DI ushort_t f2h(float f) { return __builtin_bit_cast(ushort_t, (_Float16)f); }
DI float h2f(ushort_t h) { return (float)__builtin_bit_cast(_Float16, h); }
DI float bflo(unsigned u) { return __uint_as_float(u << 16); }
DI float bfhi(unsigned u) { return __uint_as_float(u & 0xffff0000u); }
DI float hlo(unsigned u) { return (float)__builtin_bit_cast(h2, u)[0]; }
DI float hhi(unsigned u) { return (float)__builtin_bit_cast(h2, u)[1]; }
DI float sigmf(float v) { return __builtin_amdgcn_rcpf(1.f + __expf(-v)); }
DI float siluf(float v) { return v * sigmf(v); }
DI int crow(int reg, int h) { return (reg & 3) + 8 * (reg >> 2) + 4 * h; }
DI float wave_sum(float v) {
#pragma unroll
  for (int o = 32; o >= 1; o >>= 1) v += __shfl_xor(v, o, 64);
  return v;
}
DI float sum16(float v) {
#pragma unroll
  for (int o = 8; o >= 1; o >>= 1) v += __shfl_xor(v, o, 64);
  return v;
}
DI float ln_rows4(const float* src, int l16, float4 (&v)[16]) {
  float s = 0.f;
#pragma unroll
  for (int i = 0; i < 16; ++i) { v[i] = *(const float4*)(src + l16 * 4 + 64 * i); s += v[i].x + v[i].y + v[i].z + v[i].w; }
  const float mu = sum16(s) * (1.f / DM);
  float q = 0.f;
#pragma unroll
  for (int i = 0; i < 16; ++i) { v[i].x -= mu; v[i].y -= mu; v[i].z -= mu; v[i].w -= mu; q += v[i].x * v[i].x + v[i].y * v[i].y + v[i].z * v[i].z + v[i].w * v[i].w; }
  return rsqrtf(sum16(q) * (1.f / DM) + LN_EPS);
}
DI f32x16 zero16() { f32x16 z;
#pragma unroll
  for (int i = 0; i < 16; ++i) z[i] = 0.f; return z; }

#define SCAN_VLOAD 0
#define PROBE_NAIVE_SCAN 0
#if SCAN_VLOAD
DI void sload2(u32x16& a0, u32x16& a1, const void* p) { a0 = *(const u32x16*)p; a1 = *((const u32x16*)p + 1); }
DI void sload4(u32x16& a0, u32x16& a1, u32x16& b0, u32x16& b1, const void* p, const void* q) {
  a0 = *(const u32x16*)p; a1 = *((const u32x16*)p + 1); b0 = *(const u32x16*)q; b1 = *((const u32x16*)q + 1);
}
#else
DI void sload2(u32x16& a0, u32x16& a1, const void* p) {
  asm volatile("s_load_dwordx16 %0, %2, 0x0\n\ts_load_dwordx16 %1, %2, 0x40\n\ts_waitcnt lgkmcnt(0)" : "=&s"(a0), "=&s"(a1) : "s"(p) : "memory");
}
DI void sload4(u32x16& a0, u32x16& a1, u32x16& b0, u32x16& b1, const void* p, const void* q) {
  asm volatile("s_load_dwordx16 %0, %4, 0x0\n\ts_load_dwordx16 %1, %4, 0x40\n\ts_load_dwordx16 %2, %5, 0x0\n\ts_load_dwordx16 %3, %5, 0x40\n\ts_waitcnt lgkmcnt(0)"
               : "=&s"(a0), "=&s"(a1), "=&s"(b0), "=&s"(b1) : "s"(p), "s"(q) : "memory");
}
#endif
DI float HV(const u32x16& v, int j) { const uint32_t w = v[j >> 1]; const h2 t = __builtin_bit_cast(h2, w); return (float)t[j & 1]; }

constexpr int LDK = 72;
template <int BM, int BN, int MI, int NI, int NB, class AL, class BL>
DI void gemm_pass(f32x16 (&acc)[NB][MI][NI], AL aload, BL bload, int K, ushort_t* As, ushort_t* Bs, int wrow0, int wcol0, int tid) {
  constexpr int NA = BM * 8 / NTH, NBC = BN * 8 / NTH;
  constexpr int ASZ = BM * LDK, BSZ = NB * BN * LDK;
  const int lane = tid & 63, l31 = lane & 31, hh = lane >> 5;
  const int nk = K >> 6;
  uint4 ra[2][NA], rb[2][NB][NBC];
  auto gload = [&](int s, int kt) {
#pragma unroll
    for (int i = 0; i < NA; ++i) { const int id = tid + i * NTH; ra[s][i] = aload(id >> 3, kt * 64 + (id & 7) * 8); }
#pragma unroll
    for (int w = 0; w < NB; ++w)
#pragma unroll
      for (int i = 0; i < NBC; ++i) { const int id = tid + i * NTH; rb[s][w][i] = bload(w, id >> 3, kt * 64 + (id & 7) * 8); }
  };
  auto lstore = [&](int s, int buf) {
#pragma unroll
    for (int i = 0; i < NA; ++i) { const int id = tid + i * NTH; *(uint4*)&As[buf * ASZ + (id >> 3) * LDK + (id & 7) * 8] = ra[s][i]; }
#pragma unroll
    for (int w = 0; w < NB; ++w)
#pragma unroll
      for (int i = 0; i < NBC; ++i) { const int id = tid + i * NTH; *(uint4*)&Bs[buf * BSZ + w * BN * LDK + (id >> 3) * LDK + (id & 7) * 8] = rb[s][w][i]; }
  };
  auto compute = [&](int buf) {
#pragma unroll
    for (int ks = 0; ks < 4; ++ks) {
      bf16x8 af[MI];
#pragma unroll
      for (int mi = 0; mi < MI; ++mi) af[mi] = *(const bf16x8*)&As[buf * ASZ + (wrow0 + mi * 32 + l31) * LDK + ks * 16 + hh * 8];
#pragma unroll
      for (int w = 0; w < NB; ++w) {
        bf16x8 bfv[NI];
#pragma unroll
        for (int ni = 0; ni < NI; ++ni) bfv[ni] = *(const bf16x8*)&Bs[buf * BSZ + w * BN * LDK + (wcol0 + ni * 32 + l31) * LDK + ks * 16 + hh * 8];
#pragma unroll
        for (int mi = 0; mi < MI; ++mi)
#pragma unroll
          for (int ni = 0; ni < NI; ++ni) acc[w][mi][ni] = MFMA(af[mi], bfv[ni], acc[w][mi][ni]);
      }
    }
  };
  __syncthreads();
  gload(0, 0);
  lstore(0, 0);
  gload(1, 1);
  gload(0, 2);
#pragma unroll 1
  for (int kt = 0; kt < nk; kt += 2) {
    __syncthreads();
    lstore(1, 1);
    if (kt + 3 < nk) gload(1, kt + 3);
    compute(0);
    __syncthreads();
    if (kt + 2 < nk) { lstore(0, 0); if (kt + 4 < nk) gload(0, kt + 4); }
    compute(1);
  }
}

DI void transpose_tile(const float* __restrict__ src, int ld_src, ushort_t* dst, int ld_dst, int k0, int n0, float* T) {
  const int tid = threadIdx.x;
#pragma unroll
  for (int i = 0; i < 2; ++i) {
    const int k = (tid >> 4) + 32 * i, n4 = (tid & 15) * 4;
    const float4 v = *(const float4*)(src + (size_t)(k0 + k) * ld_src + n0 + n4);
    T[k * 65 + n4 + 0] = v.x; T[k * 65 + n4 + 1] = v.y; T[k * 65 + n4 + 2] = v.z; T[k * 65 + n4 + 3] = v.w;
  }
  __syncthreads();
  const int n = tid >> 3, kc = tid & 7;
  uint4 o;
  o.x = pack_bf2(T[(kc * 8 + 0) * 65 + n], T[(kc * 8 + 1) * 65 + n]);
  o.y = pack_bf2(T[(kc * 8 + 2) * 65 + n], T[(kc * 8 + 3) * 65 + n]);
  o.z = pack_bf2(T[(kc * 8 + 4) * 65 + n], T[(kc * 8 + 5) * 65 + n]);
  o.w = pack_bf2(T[(kc * 8 + 6) * 65 + n], T[(kc * 8 + 7) * 65 + n]);
  *(uint4*)(dst + (size_t)(n0 + n) * ld_dst + k0 + kc * 8) = o;
  __syncthreads();
}

DI void phase0(const Params& p, unsigned char* smem) {
  float* T = (float*)smem;
  ushort_t* win = (ushort_t*)(p.ws + OFF_WIN);
  ushort_t* wmg = (ushort_t*)(p.ws + OFF_WMG);
  ushort_t* wpa = (ushort_t*)(p.ws + OFF_WPA);
  ushort_t* wpb = (ushort_t*)(p.ws + OFF_WPB);
  ushort_t* wo = (ushort_t*)(p.ws + OFF_WO);
  ushort_t* wl = (ushort_t*)(p.ws + OFF_WL);
  float* mod = (float*)(p.ws + OFF_MOD);
  constexpr int T_IN = 16 * 56, T_MG = 16 * 32, T_PA = 8 * 16, T_PB = 8 * 16, T_O = 16 * 16, T_L = 32, T_MOD = 48;
  constexpr int TOTAL = T_MOD + T_IN + T_MG + T_PA + T_PB + T_O + T_L;
  for (int t = blockIdx.x; t < TOTAL; t += gridDim.x) {
    int u = t;
    if (u < T_MOD) {
      float* sil = T;
      float* red = T + 3072;
      const int tid = threadIdx.x;
      for (int i = tid; i < 3072; i += NTH) {
        const int v = i >> 10, k = i & 1023;
        const float cv = (v < 2) ? p.c[v * 1024 + k] : p.c_ctx[k];
        sil[i] = siluf(cv);
      }
      __syncthreads();
      const int n = tid & 63, ksl = tid >> 6, n0 = u * 64;
      float a0 = 0.f, a1 = 0.f, a2 = 0.f;
      for (int k = ksl * 128; k < ksl * 128 + 128; ++k) {
        const float w = p.w_ada[(size_t)k * 3072 + n0 + n];
        a0 = fmaf(sil[k], w, a0); a1 = fmaf(sil[1024 + k], w, a1); a2 = fmaf(sil[2048 + k], w, a2);
      }
      red[(ksl * 3 + 0) * 64 + n] = a0; red[(ksl * 3 + 1) * 64 + n] = a1; red[(ksl * 3 + 2) * 64 + n] = a2;
      __syncthreads();
      if (tid < 192) {
        const int v = tid >> 6, nn = tid & 63;
        float s = 0.f;
#pragma unroll
        for (int q = 0; q < 8; ++q) s += red[(q * 3 + v) * 64 + nn];
        mod[v * 3072 + n0 + nn] = s + p.b_ada[n0 + nn];
      }
      __syncthreads();
      continue;
    }
    u -= T_MOD;
    if (u < T_IN) { transpose_tile(p.w_in, INW, win, 1024, (u / 56) * 64, (u % 56) * 64, T); continue; }
    u -= T_IN;
    if (u < T_MG) { transpose_tile(p.w_mg, 2048, wmg, 1024, (u / 32) * 64, (u % 32) * 64, T); continue; }
    u -= T_MG;
    if (u < T_PA) { transpose_tile(p.w_pa, 1024, wpa, 512, (u / 16) * 64, (u % 16) * 64, T); continue; }
    u -= T_PA;
    if (u < T_PB) { transpose_tile(p.w_pb, 1024, wpb, 512, (u / 16) * 64, (u % 16) * 64, T); continue; }
    u -= T_PB;
    if (u < T_O) { transpose_tile(p.w_o, 1024, wo, 1024, (u / 16) * 64, (u % 16) * 64, T); continue; }
    u -= T_O;
    {
      const int which = u >> 4, dir = (u >> 3) & 1, nt = u & 7;
      const float* src = (which ? p.a_up : p.w_up) + (size_t)dir * 64 * 512;
      transpose_tile(src, 512, wl + (size_t)((dir * 2 + which) * 512) * 64, 64, 0, nt * 64, T);
    }
  }
}

DI void phase_h(const Params& p) {
  const float* mod = (const float*)(p.ws + OFF_MOD);
  ushort_t* H = (ushort_t*)(p.ws + OFF_SH);
  const int lane = threadIdx.x & 63, l16 = lane & 15, gw = blockIdx.x * 8 + (threadIdx.x >> 6);
#pragma unroll 1
  for (int r4 = gw * 4; r4 < NT; r4 += gridDim.x * 32) {
    const int row = r4 + (lane >> 4);
    const float* src = (row < NX) ? p.x + (size_t)row * DM : p.ctx + (size_t)(row - NX) * DM;
    const float* md = mod + ((row < NX) ? (row / SEQ) : 2) * 3072;
    float4 v[16];
    const float rstd = ln_rows4(src, l16, v);
#pragma unroll
    for (int i = 0; i < 16; ++i) {
      const int col = l16 * 4 + 64 * i;
      const float4 sh = *(const float4*)(md + col), sc = *(const float4*)(md + 1024 + col);
      uint2 o;
      o.x = pack_bf2(v[i].x * rstd * (1.f + sc.x) + sh.x, v[i].y * rstd * (1.f + sc.y) + sh.y);
      o.y = pack_bf2(v[i].z * rstd * (1.f + sc.z) + sh.z, v[i].w * rstd * (1.f + sc.w) + sh.w);
      *(uint2*)(H + (size_t)row * DM + col) = o;
    }
  }
}

DI void phase_gemm1(const Params& p, unsigned char* smem) {
  ushort_t* As = (ushort_t*)smem;
  ushort_t* Bs = As + 2 * 256 * LDK;
  const ushort_t* H = (const ushort_t*)(p.ws + OFF_SH);
  const ushort_t* W = (const ushort_t*)(p.ws + OFF_WIN);
  ushort_t* zq = (ushort_t*)(p.ws + OFF_ZQ);
  ushort_t* zg = (ushort_t*)(p.ws + OFF_ZG);
  ushort_t* zm = (ushort_t*)p.out;
  const int tid = threadIdx.x, wave = tid >> 6, lane = tid & 63, l31 = lane & 31, hh = lane >> 5;
  const int wrow0 = (wave & 3) * 64, wcol0 = (wave >> 2) * 64;
  constexpr int MT = NT / 256, NTL = INW / 128;
  for (int t = blockIdx.x; t < MT * NTL; t += gridDim.x) {
    const int mt = t / NTL, nt = t % NTL;
    const bool is_g = (nt >= 6 && nt < 10) || nt >= 24;
    if (is_g && mt >= NX / 256) continue;
    const int row0 = mt * 256, col0 = nt * 128;
    f32x16 acc[1][2][2];
#pragma unroll
    for (int a = 0; a < 2; ++a)
#pragma unroll
      for (int b = 0; b < 2; ++b) acc[0][a][b] = zero16();
    auto aload = [&](int r, int k) { return *(const uint4*)(H + (size_t)(row0 + r) * DM + k); };
    auto bload = [&](int w, int n, int k) { return *(const uint4*)(W + (size_t)(col0 + n) * DM + k); };
    gemm_pass<256, 128, 2, 2, 1>(acc, aload, bload, DM, As, Bs, wrow0, wcol0, tid);
    ushort_t* dst; int ld, cbase;
    if (nt < 6) { dst = zq; ld = 768; cbase = col0; }
    else if (nt < 10) { dst = zg; ld = 1024; cbase = col0 - 768; }
    else if (nt < 24) { dst = zm; ld = 1792; cbase = col0 - 1280; }
    else { dst = zg; ld = 1024; cbase = 512 + col0 - 3072; }
#pragma unroll
    for (int mi = 0; mi < 2; ++mi)
#pragma unroll
      for (int ni = 0; ni < 2; ++ni)
#pragma unroll
        for (int i = 0; i < 16; ++i) {
          const int row = row0 + wrow0 + mi * 32 + crow(i, hh), col = cbase + wcol0 + ni * 32 + l31;
          dst[(size_t)row * ld + col] = f2bf(acc[0][mi][ni][i]);
        }
  }
}

DI int vperm(int key) { const int g = key >> 4, kq = key & 15; return g * 16 + 8 * ((kq >> 2) & 1) + (kq & 3) + 4 * (kq >> 3); }
DI void phase_qkv(const Params& p) {
  const ushort_t* zq = (const ushort_t*)(p.ws + OFF_ZQ);
  ushort_t* QB = (ushort_t*)(p.ws + OFF_QB);
  ushort_t* KB = (ushort_t*)(p.ws + OFF_KB);
  ushort_t* VB = (ushort_t*)(p.ws + OFF_VB);
  const int lane = threadIdx.x & 63, gw = blockIdx.x * 8 + (threadIdx.x >> 6);
  const int j = lane & 31, half = lane >> 5, axis = j >> 4, f = j & 15;
  const int d1 = axis * 32 + f, d2 = d1 + 16;
  const float inv = powf(10000.f, -(float)f * (1.f / 16.f));
  const float gq1 = p.q_norm[d1], gq2 = p.q_norm[d2], gk1 = p.k_norm[d1], gk2 = p.k_norm[d2];
  for (int row = gw; row < NT; row += gridDim.x * 8) {
    const bool isx = row < NX;
    const int b = isx ? row / SEQ : (row - NX) / CTXL;
    const int t = isx ? row % SEQ : (row - NX) % CTXL;
    const int pos = isx ? CTXL + t : t;
    const ushort_t* z = zq + (size_t)row * 768;
    float cs = 1.f, sn = 0.f;
    if (isx) { const float ang = (float)(axis ? (t & 63) : (t >> 6)) * inv; sincosf(ang, &sn, &cs); }
#pragma unroll
    for (int it = 0; it < 5; ++it) {
      const int hd = it * 2 + half;
      if (!isx && hd < 8) continue;
      const float v1 = bf2f(z[hd * 64 + d1]), v2 = bf2f(z[hd * 64 + d2]);
      float ss = v1 * v1 + v2 * v2;
#pragma unroll
      for (int o = 16; o >= 1; o >>= 1) ss += __shfl_xor(ss, o, 64);
      const float rms = rsqrtf(ss * (1.f / 64.f) + QK_EPS);
      const bool isq = hd < 8;
      const float y1 = v1 * rms * (isq ? gq1 : gk1), y2 = v2 * rms * (isq ? gq2 : gk2);
      float o1 = y1 * cs - y2 * sn, o2 = y2 * cs + y1 * sn;
      if (isq) {
        ushort_t* dst = QB + ((size_t)(b * 8 + hd) * SEQ + t) * 64;
        dst[d1] = f2bf(o1 * QSCALE); dst[d2] = f2bf(o2 * QSCALE);
      } else {
        ushort_t* dst = KB + ((size_t)(b * 2 + (hd - 8)) * LTOT + pos) * 64;
        dst[d1] = f2bf(o1); dst[d2] = f2bf(o2);
      }
    }
    {
      const size_t tb = (size_t)(pos >> 6) * 4096 + lane * 64 + vperm(pos & 63);
      VB[(size_t)(b * 2 + 0) * LTOT * 64 + tb] = z[640 + lane];
      VB[(size_t)(b * 2 + 1) * LTOT * 64 + tb] = z[704 + lane];
    }
  }
}

DI void phase_rwkv_prep(const Params& p, unsigned char* smem) {
  float* kbuf = (float*)smem;
  ushort_t* codes = (ushort_t*)(smem + 65536);
  float* invn = (float*)(smem + 65536 + 32 * 264 * 2);
  const ushort_t* zm = (const ushort_t*)p.out;
  const ushort_t* WL = (const ushort_t*)(p.ws + OFF_WL);
  ushort_t* SH = (ushort_t*)(p.ws + OFF_SH);
  ushort_t* DR = (ushort_t*)(p.ws + OFF_DR);
  const int tid = threadIdx.x, wave = tid >> 6, lane = tid & 63, l31 = lane & 31, hh = lane >> 5;
  for (int tt = blockIdx.x; tt < NT / 32; tt += gridDim.x) {
    const int row0 = tt * 32;
    int b, t0, len, pbase;
    if (row0 < NX) { b = row0 / SEQ; t0 = row0 % SEQ; len = SEQ; pbase = CTXL; }
    else { const int rc = row0 - NX; b = rc / CTXL; t0 = rc % CTXL; len = CTXL; pbase = 0; }
    __syncthreads();
    for (int id = tid; id < 32 * 224; id += NTH) {
      const int i = id / 224, c0 = (id % 224) * 8;
      const int t = t0 + i;
      const ushort_t* zr = zm + (size_t)(row0 + i) * 1792 + c0;
      const uint4 zc = *(const uint4*)zr;
      uint4 zp = make_uint4(0, 0, 0, 0), zn = make_uint4(0, 0, 0, 0);
      if (t > 0) zp = *(const uint4*)(zr - 1792);
      if (t < len - 1) zn = *(const uint4*)(zr + 1792);
      const float4 mp0 = *(const float4*)(p.mu_prev + c0), mp1 = *(const float4*)(p.mu_prev + c0 + 4);
      const float4 mn0 = *(const float4*)(p.mu_next + c0), mn1 = *(const float4*)(p.mu_next + c0 + 4);
      const unsigned zcw[4] = {zc.x, zc.y, zc.z, zc.w}, zpw[4] = {zp.x, zp.y, zp.z, zp.w}, znw[4] = {zn.x, zn.y, zn.z, zn.w};
      const float mpv[8] = {mp0.x, mp0.y, mp0.z, mp0.w, mp1.x, mp1.y, mp1.z, mp1.w};
      const float mnv[8] = {mn0.x, mn0.y, mn0.z, mn0.w, mn1.x, mn1.y, mn1.z, mn1.w};
      float s[8];
#pragma unroll
      for (int q = 0; q < 4; ++q) {
        const float c_lo = bflo(zcw[q]), c_hi = bfhi(zcw[q]);
        s[2 * q] = c_lo + mpv[2 * q] * (bflo(zpw[q]) - c_lo) + mnv[2 * q] * (bflo(znw[q]) - c_lo);
        s[2 * q + 1] = c_hi + mpv[2 * q + 1] * (bfhi(zpw[q]) - c_hi) + mnv[2 * q + 1] * (bfhi(znw[q]) - c_hi);
      }
      const int pp = pbase + t;
      if (c0 < 512 || (c0 >= 1024 && c0 < 1536)) {
        const int cc = (c0 < 512) ? c0 : c0 - 1024, which = (c0 < 512) ? 1 : 2;
        const int head = cc >> 6, d = cc & 63;
        uint4 o;
        o.x = pack_h2(s[0], s[1]); o.y = pack_h2(s[2], s[3]); o.z = pack_h2(s[4], s[5]); o.w = pack_h2(s[6], s[7]);
        *(uint4*)(SH + (((size_t)(b * 8 + head) * LTOT + pp) * 3 + which) * 64 + d) = o;
      } else if (c0 < 1024) {
        float* kd = kbuf + i * 512 + (c0 - 512);
        *(float4*)kd = make_float4(s[0], s[1], s[2], s[3]);
        *(float4*)(kd + 4) = make_float4(s[4], s[5], s[6], s[7]);
      } else {
        const int cc = c0 - 1536;
        if (cc < 128) {
#pragma unroll
          for (int q = 0; q < 8; ++q) s[q] = tanhf(s[q]);
        }
        uint4 o;
        o.x = pack_bf2(s[0], s[1]); o.y = pack_bf2(s[2], s[3]); o.z = pack_bf2(s[4], s[5]); o.w = pack_bf2(s[6], s[7]);
        *(uint4*)(codes + i * 264 + cc) = o;
      }
    }
    __syncthreads();
    {
      const int i = tid >> 4, head = (tid >> 1) & 7, hf = tid & 1;
      float ss = 0.f;
#pragma unroll 8
      for (int q = 0; q < 32; ++q) {
        const int n = head * 64 + hf * 32 + q;
        const float v = kbuf[i * 512 + n] * p.k_k[n];
        ss = fmaf(v, v, ss);
      }
      ss += __shfl_xor(ss, 1, 64);
      if (hf == 0) invn[i * 8 + head] = 1.f / fmaxf(sqrtf(ss), 1e-12f);
    }
    __syncthreads();
#pragma unroll 1
    for (int q4 = 0; q4 < 4; ++q4) {
      const int pr = wave * 4 + q4, dir = pr >> 4, ct = pr & 15;
      f32x16 aw = zero16(), aa = zero16();
#pragma unroll
      for (int ks = 0; ks < 4; ++ks) {
        const bf16x8 fw = *(const bf16x8*)&codes[l31 * 264 + dir * 64 + ks * 16 + hh * 8];
        const bf16x8 fa = *(const bf16x8*)&codes[l31 * 264 + 128 + dir * 64 + ks * 16 + hh * 8];
        const bf16x8 bw = *(const bf16x8*)&WL[(size_t)((dir * 2 + 0) * 512 + ct * 32 + l31) * 64 + ks * 16 + hh * 8];
        const bf16x8 ba = *(const bf16x8*)&WL[(size_t)((dir * 2 + 1) * 512 + ct * 32 + l31) * 64 + ks * 16 + hh * 8];
        aw = MFMA(fw, bw, aw);
        aa = MFMA(fa, ba, aa);
      }
      const int n = ct * 32 + l31, head = n >> 6, d = n & 63;
      const float w0v = p.w0[dir * 512 + n], a0v = p.a0[dir * 512 + n], kkw = p.k_k[n], kaw = p.k_a[n];
      const size_t cbase = (size_t)(b * 8 + head) * LTOT;
#pragma unroll
      for (int i = 0; i < 16; ++i) {
        const int ti = crow(i, hh);
        const int pp = pbase + t0 + ti;
        const float wpre = aw[i] + w0v;
        const float e = 0.60653065971263342f * sigmf(wpre);
        const float xdec = 1.f - __expf(-e);
        const float a = sigmf(aa[i] + a0v);
        const float kv = kbuf[ti * 512 + n];
        const float kkv = kv * kkw * invn[ti * 8 + head];
        const float kd = kv * (1.f + (a - 1.f) * kaw);
        ushort_t* dr = DR + ((((size_t)dir * 16) * LTOT + cbase + pp) * 3) * 64 + d;
        dr[0] = f2h(-xdec); dr[64] = f2h(kd); dr[128] = f2h(kkv * a);
        if (dir == 0) SH[((cbase + pp) * 3) * 64 + d] = f2h(kkv);
      }
    }
  }
}

DI int tau_to_pos(int dir, int tau) { return dir == 0 ? tau : (tau < CTXL ? CTXL - 1 - tau : LTOT - 1 - (tau - CTXL)); }


DI void fm_lo(float& acc, float a, uint32_t w) { asm("v_fma_mix_f32 %0, %1, %2, %0 op_sel_hi:[0,1,0]" : "+v"(acc) : "v"(a), "s"(w)); }
DI void fm_hi(float& acc, float a, uint32_t w) { asm("v_fma_mix_f32 %0, %1, %2, %0 op_sel:[0,1,0] op_sel_hi:[0,1,0]" : "+v"(acc) : "v"(a), "s"(w)); }
DI void fx_lo(float& s, uint32_t w) { asm("v_fma_mix_f32 %0, %0, %1, %0 op_sel_hi:[0,1,0]" : "+v"(s) : "s"(w)); }
DI void fx_hi(float& s, uint32_t w) { asm("v_fma_mix_f32 %0, %0, %1, %0 op_sel:[0,1,0] op_sel_hi:[0,1,0]" : "+v"(s) : "s"(w)); }
constexpr int PFD = 8, SEG = 65;
static_assert(CH % SEG == 0, "segments");
DI void scan_prefetch(u32x4& pfr, const ushort_t* shc, const ushort_t* drc, int pos, int lane) {
  const ushort_t* a = (lane < 24) ? shc + (size_t)pos * 192 + lane * 8 : drc + (size_t)pos * 192 + (lane < 48 ? lane - 24 : 23) * 8;
  asm volatile("global_load_dwordx4 %0, %1, off" : "+v"(pfr) : "v"(a) : "memory");
}
DI void scan_stage_v(ushort_t* vbuf, const ushort_t* shc, int dir, int tau0, int lane) {
#pragma unroll
  for (int i = 0; i < (SEG * 8 + 63) / 64; ++i) {
    const int id = i * 64 + lane, st = id >> 3;
    if (st < SEG) *(uint4*)&vbuf[st * 64 + (id & 7) * 8] = *(const uint4*)(shc + (size_t)tau_to_pos(dir, tau0 + st) * 192 + 128 + (id & 7) * 8);
  }
}
struct ScanRec { uint32_t sh, dr, bb; ushort_t v; };
DI ScanRec scan_load(const ushort_t* shc, const ushort_t* drc, int pos, int lane) {
  ScanRec r;
  const ushort_t* s = shc + (size_t)pos * 192;
  const uint32_t* d = (const uint32_t*)(drc + (size_t)pos * 192);
  r.sh = ((const uint32_t*)s)[lane];
  r.v = s[128 + lane];
  r.dr = d[lane];
  r.bb = d[64 + (lane & 31)];
  return r;
}
#define MIXLO " op_sel_hi:[0,1,0]\n\t"
#define MIXHI " op_sel:[0,1,0] op_sel_hi:[0,1,0]\n\t"
template <int L>
DI void dot4(float& a0, float& a1, float& a2, float& a3, float (&S)[64], uint32_t src) {
  uint32_t t0, t1, t2, t3;
  asm("v_readlane_b32 %4, %8, %9\n\tv_readlane_b32 %5, %8, %10\n\tv_readlane_b32 %6, %8, %11\n\tv_readlane_b32 %7, %8, %12\n\t"
      "v_fma_mix_f32 %0, %13, %4, %0" MIXLO "v_fma_mix_f32 %1, %14, %4, %1" MIXHI
      "v_fma_mix_f32 %2, %15, %5, %2" MIXLO "v_fma_mix_f32 %3, %16, %5, %3" MIXHI
      "v_fma_mix_f32 %0, %17, %6, %0" MIXLO "v_fma_mix_f32 %1, %18, %6, %1" MIXHI
      "v_fma_mix_f32 %2, %19, %7, %2" MIXLO "v_fma_mix_f32 %3, %20, %7, %3" MIXHI
      : "+v"(a0), "+v"(a1), "+v"(a2), "+v"(a3), "=&s"(t0), "=&s"(t1), "=&s"(t2), "=&s"(t3)
      : "v"(src), "n"(L), "n"(L + 1), "n"(L + 2), "n"(L + 3),
        "v"(S[2 * (L & 31)]), "v"(S[2 * (L & 31) + 1]), "v"(S[2 * (L & 31) + 2]), "v"(S[2 * (L & 31) + 3]),
        "v"(S[2 * (L & 31) + 4]), "v"(S[2 * (L & 31) + 5]), "v"(S[2 * (L & 31) + 6]), "v"(S[2 * (L & 31) + 7]));
}
template <int L>
DI void upd4(float (&S)[64], uint32_t dr, uint32_t bb, float vv, float nsk) {
  uint32_t x0, x1, x2, x3, k0, k1, k2, k3, b0, b1, b2, b3;
  asm("v_readlane_b32 %8, %20, %22\n\tv_readlane_b32 %9, %20, %23\n\tv_readlane_b32 %10, %20, %24\n\tv_readlane_b32 %11, %20, %25\n\t"
      "v_readlane_b32 %12, %20, %26\n\tv_readlane_b32 %13, %20, %27\n\tv_readlane_b32 %14, %20, %28\n\tv_readlane_b32 %15, %20, %29\n\t"
      "v_readlane_b32 %16, %21, %22\n\tv_readlane_b32 %17, %21, %23\n\tv_readlane_b32 %18, %21, %24\n\tv_readlane_b32 %19, %21, %25\n\t"
      "v_fma_mix_f32 %0, %0, %8, %0" MIXLO "v_fma_mix_f32 %1, %1, %8, %1" MIXHI
      "v_fma_mix_f32 %2, %2, %9, %2" MIXLO "v_fma_mix_f32 %3, %3, %9, %3" MIXHI
      "v_fma_mix_f32 %4, %4, %10, %4" MIXLO "v_fma_mix_f32 %5, %5, %10, %5" MIXHI
      "v_fma_mix_f32 %6, %6, %11, %6" MIXLO "v_fma_mix_f32 %7, %7, %11, %7" MIXHI
      "v_fma_mix_f32 %0, %30, %12, %0" MIXLO "v_fma_mix_f32 %1, %30, %12, %1" MIXHI
      "v_fma_mix_f32 %2, %30, %13, %2" MIXLO "v_fma_mix_f32 %3, %30, %13, %3" MIXHI
      "v_fma_mix_f32 %4, %30, %14, %4" MIXLO "v_fma_mix_f32 %5, %30, %14, %5" MIXHI
      "v_fma_mix_f32 %6, %30, %15, %6" MIXLO "v_fma_mix_f32 %7, %30, %15, %7" MIXHI
      "v_fma_mix_f32 %0, %31, %16, %0" MIXLO "v_fma_mix_f32 %1, %31, %16, %1" MIXHI
      "v_fma_mix_f32 %2, %31, %17, %2" MIXLO "v_fma_mix_f32 %3, %31, %17, %3" MIXHI
      "v_fma_mix_f32 %4, %31, %18, %4" MIXLO "v_fma_mix_f32 %5, %31, %18, %5" MIXHI
      "v_fma_mix_f32 %6, %31, %19, %6" MIXLO "v_fma_mix_f32 %7, %31, %19, %7" MIXHI
      : "+v"(S[2 * L]), "+v"(S[2 * L + 1]), "+v"(S[2 * L + 2]), "+v"(S[2 * L + 3]), "+v"(S[2 * L + 4]), "+v"(S[2 * L + 5]), "+v"(S[2 * L + 6]), "+v"(S[2 * L + 7]),
        "=&s"(x0), "=&s"(x1), "=&s"(x2), "=&s"(x3), "=&s"(k0), "=&s"(k1), "=&s"(k2), "=&s"(k3), "=&s"(b0), "=&s"(b1), "=&s"(b2), "=&s"(b3)
      : "v"(dr), "v"(bb), "n"(L), "n"(L + 1), "n"(L + 2), "n"(L + 3), "n"(L + 32), "n"(L + 33), "n"(L + 34), "n"(L + 35), "v"(vv), "v"(nsk));
}
template <int L>
DI void dot4_2(float& a0, float& a1, float& c0, float& c1, float (&SU)[64], float (&SP)[64], uint32_t src) {
  uint32_t t0, t1, t2, t3;
  asm("v_readlane_b32 %4, %8, %9\n\tv_readlane_b32 %5, %8, %10\n\tv_readlane_b32 %6, %8, %11\n\tv_readlane_b32 %7, %8, %12\n\t"
      "v_fma_mix_f32 %0, %13, %4, %0" MIXLO "v_fma_mix_f32 %1, %14, %4, %1" MIXHI
      "v_fma_mix_f32 %2, %21, %4, %2" MIXLO "v_fma_mix_f32 %3, %22, %4, %3" MIXHI
      "v_fma_mix_f32 %0, %15, %5, %0" MIXLO "v_fma_mix_f32 %1, %16, %5, %1" MIXHI
      "v_fma_mix_f32 %2, %23, %5, %2" MIXLO "v_fma_mix_f32 %3, %24, %5, %3" MIXHI
      "v_fma_mix_f32 %0, %17, %6, %0" MIXLO "v_fma_mix_f32 %1, %18, %6, %1" MIXHI
      "v_fma_mix_f32 %2, %25, %6, %2" MIXLO "v_fma_mix_f32 %3, %26, %6, %3" MIXHI
      "v_fma_mix_f32 %0, %19, %7, %0" MIXLO "v_fma_mix_f32 %1, %20, %7, %1" MIXHI
      "v_fma_mix_f32 %2, %27, %7, %2" MIXLO "v_fma_mix_f32 %3, %28, %7, %3" MIXHI
      : "+v"(a0), "+v"(a1), "+v"(c0), "+v"(c1), "=&s"(t0), "=&s"(t1), "=&s"(t2), "=&s"(t3)
      : "v"(src), "n"(L), "n"(L + 1), "n"(L + 2), "n"(L + 3),
        "v"(SU[2 * L]), "v"(SU[2 * L + 1]), "v"(SU[2 * L + 2]), "v"(SU[2 * L + 3]), "v"(SU[2 * L + 4]), "v"(SU[2 * L + 5]), "v"(SU[2 * L + 6]), "v"(SU[2 * L + 7]),
        "v"(SP[2 * L]), "v"(SP[2 * L + 1]), "v"(SP[2 * L + 2]), "v"(SP[2 * L + 3]), "v"(SP[2 * L + 4]), "v"(SP[2 * L + 5]), "v"(SP[2 * L + 6]), "v"(SP[2 * L + 7]));
}
template <int L>
DI void upd4_2(float (&SU)[64], float (&SP)[64], uint32_t dr, uint32_t bb, float vv, float nskU, float nskP) {
  uint32_t x0, x1, x2, x3, k0, k1, k2, k3, b0, b1, b2, b3;
  asm("v_readlane_b32 %16, %28, %30\n\tv_readlane_b32 %17, %28, %31\n\tv_readlane_b32 %18, %28, %32\n\tv_readlane_b32 %19, %28, %33\n\t"
      "v_readlane_b32 %20, %28, %34\n\tv_readlane_b32 %21, %28, %35\n\tv_readlane_b32 %22, %28, %36\n\tv_readlane_b32 %23, %28, %37\n\t"
      "v_readlane_b32 %24, %29, %30\n\tv_readlane_b32 %25, %29, %31\n\tv_readlane_b32 %26, %29, %32\n\tv_readlane_b32 %27, %29, %33\n\t"
      "v_fma_mix_f32 %0, %0, %16, %0" MIXLO "v_fma_mix_f32 %1, %1, %16, %1" MIXHI
      "v_fma_mix_f32 %2, %2, %17, %2" MIXLO "v_fma_mix_f32 %3, %3, %17, %3" MIXHI
      "v_fma_mix_f32 %4, %4, %18, %4" MIXLO "v_fma_mix_f32 %5, %5, %18, %5" MIXHI
      "v_fma_mix_f32 %6, %6, %19, %6" MIXLO "v_fma_mix_f32 %7, %7, %19, %7" MIXHI
      "v_fma_mix_f32 %8, %8, %16, %8" MIXLO "v_fma_mix_f32 %9, %9, %16, %9" MIXHI
      "v_fma_mix_f32 %10, %10, %17, %10" MIXLO "v_fma_mix_f32 %11, %11, %17, %11" MIXHI
      "v_fma_mix_f32 %12, %12, %18, %12" MIXLO "v_fma_mix_f32 %13, %13, %18, %13" MIXHI
      "v_fma_mix_f32 %14, %14, %19, %14" MIXLO "v_fma_mix_f32 %15, %15, %19, %15" MIXHI
      "v_fma_mix_f32 %0, %38, %20, %0" MIXLO "v_fma_mix_f32 %1, %38, %20, %1" MIXHI
      "v_fma_mix_f32 %2, %38, %21, %2" MIXLO "v_fma_mix_f32 %3, %38, %21, %3" MIXHI
      "v_fma_mix_f32 %4, %38, %22, %4" MIXLO "v_fma_mix_f32 %5, %38, %22, %5" MIXHI
      "v_fma_mix_f32 %6, %38, %23, %6" MIXLO "v_fma_mix_f32 %7, %38, %23, %7" MIXHI
      "v_fma_mix_f32 %0, %39, %24, %0" MIXLO "v_fma_mix_f32 %1, %39, %24, %1" MIXHI
      "v_fma_mix_f32 %2, %39, %25, %2" MIXLO "v_fma_mix_f32 %3, %39, %25, %3" MIXHI
      "v_fma_mix_f32 %4, %39, %26, %4" MIXLO "v_fma_mix_f32 %5, %39, %26, %5" MIXHI
      "v_fma_mix_f32 %6, %39, %27, %6" MIXLO "v_fma_mix_f32 %7, %39, %27, %7" MIXHI
      "v_fma_mix_f32 %8, %40, %24, %8" MIXLO "v_fma_mix_f32 %9, %40, %24, %9" MIXHI
      "v_fma_mix_f32 %10, %40, %25, %10" MIXLO "v_fma_mix_f32 %11, %40, %25, %11" MIXHI
      "v_fma_mix_f32 %12, %40, %26, %12" MIXLO "v_fma_mix_f32 %13, %40, %26, %13" MIXHI
      "v_fma_mix_f32 %14, %40, %27, %14" MIXLO "v_fma_mix_f32 %15, %40, %27, %15" MIXHI
      : "+v"(SU[2 * L]), "+v"(SU[2 * L + 1]), "+v"(SU[2 * L + 2]), "+v"(SU[2 * L + 3]), "+v"(SU[2 * L + 4]), "+v"(SU[2 * L + 5]), "+v"(SU[2 * L + 6]), "+v"(SU[2 * L + 7]),
        "+v"(SP[2 * L]), "+v"(SP[2 * L + 1]), "+v"(SP[2 * L + 2]), "+v"(SP[2 * L + 3]), "+v"(SP[2 * L + 4]), "+v"(SP[2 * L + 5]), "+v"(SP[2 * L + 6]), "+v"(SP[2 * L + 7]),
        "=&s"(x0), "=&s"(x1), "=&s"(x2), "=&s"(x3), "=&s"(k0), "=&s"(k1), "=&s"(k2), "=&s"(k3), "=&s"(b0), "=&s"(b1), "=&s"(b2), "=&s"(b3)
      : "v"(dr), "v"(bb), "n"(L), "n"(L + 1), "n"(L + 2), "n"(L + 3), "n"(L + 32), "n"(L + 33), "n"(L + 34), "n"(L + 35), "v"(vv), "v"(nskU), "v"(nskP));
}
DI void scan_step2(float (&SU)[64], float (&SP)[64], const ScanRec& c, float vv) {
  float a0 = 0.f, a1 = 0.f, c0 = 0.f, c1 = 0.f;
  dot4_2<0>(a0, a1, c0, c1, SU, SP, c.sh); dot4_2<4>(a0, a1, c0, c1, SU, SP, c.sh); dot4_2<8>(a0, a1, c0, c1, SU, SP, c.sh); dot4_2<12>(a0, a1, c0, c1, SU, SP, c.sh);
  dot4_2<16>(a0, a1, c0, c1, SU, SP, c.sh); dot4_2<20>(a0, a1, c0, c1, SU, SP, c.sh); dot4_2<24>(a0, a1, c0, c1, SU, SP, c.sh); dot4_2<28>(a0, a1, c0, c1, SU, SP, c.sh);
  const float nU = -(a0 + a1), nP = -(c0 + c1);
  upd4_2<0>(SU, SP, c.dr, c.bb, vv, nU, nP); upd4_2<4>(SU, SP, c.dr, c.bb, vv, nU, nP); upd4_2<8>(SU, SP, c.dr, c.bb, vv, nU, nP); upd4_2<12>(SU, SP, c.dr, c.bb, vv, nU, nP);
  upd4_2<16>(SU, SP, c.dr, c.bb, vv, nU, nP); upd4_2<20>(SU, SP, c.dr, c.bb, vv, nU, nP); upd4_2<24>(SU, SP, c.dr, c.bb, vv, nU, nP); upd4_2<28>(SU, SP, c.dr, c.bb, vv, nU, nP);
}
template <bool WITH_OUT>
DI float scan_step(float (&S)[64], const ScanRec& c, float vv) {
  float s0 = 0.f, s1 = 0.f, s2 = 0.f, s3 = 0.f;
  dot4<0>(s0, s1, s2, s3, S, c.sh); dot4<4>(s0, s1, s2, s3, S, c.sh); dot4<8>(s0, s1, s2, s3, S, c.sh); dot4<12>(s0, s1, s2, s3, S, c.sh);
  dot4<16>(s0, s1, s2, s3, S, c.sh); dot4<20>(s0, s1, s2, s3, S, c.sh); dot4<24>(s0, s1, s2, s3, S, c.sh); dot4<28>(s0, s1, s2, s3, S, c.sh);
  const float nsk = -((s0 + s1) + (s2 + s3));
  upd4<0>(S, c.dr, c.bb, vv, nsk); upd4<4>(S, c.dr, c.bb, vv, nsk); upd4<8>(S, c.dr, c.bb, vv, nsk); upd4<12>(S, c.dr, c.bb, vv, nsk);
  upd4<16>(S, c.dr, c.bb, vv, nsk); upd4<20>(S, c.dr, c.bb, vv, nsk); upd4<24>(S, c.dr, c.bb, vv, nsk); upd4<28>(S, c.dr, c.bb, vv, nsk);
  float o0 = 0.f, o1 = 0.f, o2 = 0.f, o3 = 0.f;
  if (WITH_OUT) {
    dot4<32>(o0, o1, o2, o3, S, c.sh); dot4<36>(o0, o1, o2, o3, S, c.sh); dot4<40>(o0, o1, o2, o3, S, c.sh); dot4<44>(o0, o1, o2, o3, S, c.sh);
    dot4<48>(o0, o1, o2, o3, S, c.sh); dot4<52>(o0, o1, o2, o3, S, c.sh); dot4<56>(o0, o1, o2, o3, S, c.sh); dot4<60>(o0, o1, o2, o3, S, c.sh);
  }
  return (o0 + o1) + (o2 + o3);
}
constexpr int SPF = 3;
DI void phase_scanA(const Params& p, unsigned char* smem) {
  const ushort_t* SH = (const ushort_t*)(p.ws + OFF_SH);
  const ushort_t* DR = (const ushort_t*)(p.ws + OFF_DR);
  float* PU = p.out;
  const int lane = threadIdx.x & 63;
  ushort_t* vbuf = (ushort_t*)smem + (threadIdx.x >> 6) * (SEG * 64);
  const int gw = __builtin_amdgcn_readfirstlane(blockIdx.x * 8 + (threadIdx.x >> 6));
  u32x4 pfr = {0u, 0u, 0u, 0u};
  for (int task = gw; task < 32 * NCHUNK; task += gridDim.x * 8) {
    const int cd = task / NCHUNK, j = task % NCHUNK, dir = cd >> 4, c = cd & 15;
    float SU[64], SP[64];
#pragma unroll
    for (int k = 0; k < 64; ++k) { SU[k] = 0.f; SP[k] = (k == lane) ? 1.f : 0.f; }
    const ushort_t* shc = SH + (size_t)c * LTOT * 192;
    const ushort_t* drc = DR + (size_t)(dir * 16 + c) * LTOT * 192;
#pragma unroll 1
    for (int st = 0; st < PFD; ++st) scan_prefetch(pfr, shc, drc, tau_to_pos(dir, j * CH + st), lane);
#pragma unroll 1
    for (int sg = 0; sg < CH / SEG; ++sg) {
      scan_stage_v(vbuf, shc, dir, j * CH + sg * SEG, lane);
#pragma unroll 1
      for (int s2 = 0; s2 < SEG; ++s2) {
        const int st = sg * SEG + s2;
        const int pos = tau_to_pos(dir, j * CH + st);
        const ushort_t* shr = shc + (size_t)pos * 192;
        const ushort_t* drr = drc + (size_t)pos * 192;
        scan_prefetch(pfr, shc, drc, tau_to_pos(dir, j * CH + (st + PFD < CH ? st + PFD : CH - 1)), lane);
        const float vv = h2f(vbuf[s2 * 64 + lane]);
        u32x16 a0, a1, b0, b1;
        sload4(a0, a1, b0, b1, shr, drr);
        float u0 = 0.f, u1 = 0.f, u2 = 0.f, u3 = 0.f, q0 = 0.f, q1 = 0.f, q2 = 0.f, q3 = 0.f;
#pragma unroll
        for (int q = 0; q < 16; ++q) {
          fm_lo(u0, SU[2 * q], a0[q]); fm_hi(u1, SU[2 * q + 1], a0[q]); fm_lo(u2, SU[32 + 2 * q], a1[q]); fm_hi(u3, SU[33 + 2 * q], a1[q]);
          fm_lo(q0, SP[2 * q], a0[q]); fm_hi(q1, SP[2 * q + 1], a0[q]); fm_lo(q2, SP[32 + 2 * q], a1[q]); fm_hi(q3, SP[33 + 2 * q], a1[q]);
        }
        const float nU = -((u0 + u1) + (u2 + u3)), nP = -((q0 + q1) + (q2 + q3));
#pragma unroll
        for (int q = 0; q < 16; ++q) {
          fx_lo(SU[2 * q], b0[q]); fx_hi(SU[2 * q + 1], b0[q]); fx_lo(SU[32 + 2 * q], b1[q]); fx_hi(SU[33 + 2 * q], b1[q]);
          fx_lo(SP[2 * q], b0[q]); fx_hi(SP[2 * q + 1], b0[q]); fx_lo(SP[32 + 2 * q], b1[q]); fx_hi(SP[33 + 2 * q], b1[q]);
        }
        sload4(a0, a1, b0, b1, drr + 64, drr + 128);
#pragma unroll
        for (int q = 0; q < 16; ++q) { fm_lo(SU[2 * q], vv, a0[q]); fm_hi(SU[2 * q + 1], vv, a0[q]); fm_lo(SU[32 + 2 * q], vv, a1[q]); fm_hi(SU[33 + 2 * q], vv, a1[q]); }
#pragma unroll
        for (int q = 0; q < 16; ++q) {
          fm_lo(SU[2 * q], nU, b0[q]); fm_hi(SU[2 * q + 1], nU, b0[q]); fm_lo(SU[32 + 2 * q], nU, b1[q]); fm_hi(SU[33 + 2 * q], nU, b1[q]);
          fm_lo(SP[2 * q], nP, b0[q]); fm_hi(SP[2 * q + 1], nP, b0[q]); fm_lo(SP[32 + 2 * q], nP, b1[q]); fm_hi(SP[33 + 2 * q], nP, b1[q]);
        }
      }
    }
    float* dst = PU + (size_t)task * 2 * 4096 + lane * 64;
#pragma unroll
    for (int k = 0; k < 64; k += 4) {
      *(float4*)(dst + k) = make_float4(SU[k], SU[k + 1], SU[k + 2], SU[k + 3]);
      *(float4*)(dst + 4096 + k) = make_float4(SP[k], SP[k + 1], SP[k + 2], SP[k + 3]);
    }
  }
  asm volatile("s_waitcnt vmcnt(0)" ::: "memory");
  asm volatile("" :: "v"(pfr));
}

DI void phase_scanB(const Params& p, unsigned char* smem) {
  if (blockIdx.x >= 32) return;
  float* Sb = (float*)smem;
  float* Xb = Sb + 64 * 65;
  float* PU = p.out;
  const int cd = blockIdx.x, tid = threadIdx.x, wave = tid >> 6, lane = tid & 63, l31 = lane & 31, hh = lane >> 5;
  const int tile = wave & 3, tm = tile >> 1, tn = tile & 1, kh = wave >> 2;
  for (int i = tid; i < 64 * 65; i += NTH) Sb[i] = 0.f;
  constexpr int BPF = 4;
  float bP[BPF][16];
  f32x16 uT[BPF];
#pragma unroll
  for (int s = 0; s < BPF; ++s) uT[s] = zero16();
  auto fetch = [&](int j, float (&bp)[16], f32x16& ut) {
    const float* base = PU + (size_t)(cd * NCHUNK + j) * 2 * 4096;
#pragma unroll
    for (int kk = 0; kk < 16; ++kk) bp[kk] = base[4096 + (kh * 32 + 2 * kk + hh) * 64 + tn * 32 + l31];
    if (kh == 0) {
#pragma unroll
      for (int i = 0; i < 16; ++i) ut[i] = base[(tm * 32 + crow(i, hh)) * 64 + tn * 32 + l31];
    }
  };
  auto put_state = [&](int j, const f32x16& st) {
    float* base = PU + (size_t)(cd * NCHUNK + j) * 2 * 4096;
#pragma unroll
    for (int i = 0; i < 16; ++i) base[(tm * 32 + crow(i, hh)) * 64 + tn * 32 + l31] = st[i];
  };
#pragma unroll
  for (int s = 0; s < BPF; ++s) fetch(s, bP[s], uT[s]);
  if (kh == 0) put_state(0, zero16());
  __syncthreads();
#pragma unroll 1
  for (int j = 0; j < NCHUNK; ++j) {
    float nP[16];
    f32x16 nU = zero16();
    if (j + BPF < NCHUNK) fetch(j + BPF, nP, nU);
    f32x16 acc = (kh == 0) ? uT[0] : zero16();
#pragma unroll
    for (int kk = 0; kk < 16; ++kk) {
      const float a = Sb[(tm * 32 + l31) * 65 + kh * 32 + 2 * kk + hh];
      acc = __builtin_amdgcn_mfma_f32_32x32x2f32(a, bP[0][kk], acc, 0, 0, 0);
    }
    if (kh == 1) {
#pragma unroll
      for (int i = 0; i < 16; ++i) Xb[(tile * 16 + i) * 64 + lane] = acc[i];
    }
    __syncthreads();
    if (kh == 0) {
#pragma unroll
      for (int i = 0; i < 16; ++i) { acc[i] += Xb[(tile * 16 + i) * 64 + lane]; Sb[(tm * 32 + crow(i, hh)) * 65 + tn * 32 + l31] = acc[i]; }
      if (j + 1 < NCHUNK) put_state(j + 1, acc);
    }
#pragma unroll
    for (int s = 0; s + 1 < BPF; ++s) {
#pragma unroll
      for (int kk = 0; kk < 16; ++kk) bP[s][kk] = bP[s + 1][kk];
      uT[s] = uT[s + 1];
    }
#pragma unroll
    for (int kk = 0; kk < 16; ++kk) bP[BPF - 1][kk] = nP[kk];
    uT[BPF - 1] = nU;
    __syncthreads();
  }
}

DI void phase_scanC(const Params& p, unsigned char* smem) {
  const ushort_t* SH = (const ushort_t*)(p.ws + OFF_SH);
  const ushort_t* DR = (const ushort_t*)(p.ws + OFF_DR);
  ushort_t* O = (ushort_t*)(p.ws + OFF_ZQ);
  const float* PU = p.out;
  const int lane = threadIdx.x & 63;
  ushort_t* vbuf = (ushort_t*)smem + (threadIdx.x >> 6) * (SEG * 64);
  const int gw = __builtin_amdgcn_readfirstlane(blockIdx.x * 8 + (threadIdx.x >> 6));
  u32x4 pfr = {0u, 0u, 0u, 0u};
  for (int task = gw; task < 32 * NCHUNK; task += gridDim.x * 8) {
    const int cd = task / NCHUNK, j = task % NCHUNK, dir = cd >> 4, c = cd & 15, b = c >> 3, head = c & 7;
    float S[64];
    const float* src = PU + (size_t)task * 2 * 4096 + lane * 64;
#pragma unroll
    for (int k = 0; k < 64; k += 4) { const float4 v = *(const float4*)(src + k); S[k] = v.x; S[k + 1] = v.y; S[k + 2] = v.z; S[k + 3] = v.w; }
    const ushort_t* shc = SH + (size_t)c * LTOT * 192;
    const ushort_t* drc = DR + (size_t)(dir * 16 + c) * LTOT * 192;
    ushort_t* obase = O + ((size_t)dir * NX + (size_t)b * SEQ) * 512 + head * 64 + lane;
#pragma unroll 1
    for (int st = 0; st < PFD; ++st) scan_prefetch(pfr, shc, drc, tau_to_pos(dir, j * CH + st), lane);
#pragma unroll 1
    for (int sg = 0; sg < CH / SEG; ++sg) {
      scan_stage_v(vbuf, shc, dir, j * CH + sg * SEG, lane);
#pragma unroll 1
      for (int s2 = 0; s2 < SEG; ++s2) {
        const int st = sg * SEG + s2;
        const int pos = tau_to_pos(dir, j * CH + st);
        const ushort_t* shr = shc + (size_t)pos * 192;
        const ushort_t* drr = drc + (size_t)pos * 192;
        scan_prefetch(pfr, shc, drc, tau_to_pos(dir, j * CH + (st + PFD < CH ? st + PFD : CH - 1)), lane);
        const float vv = h2f(vbuf[s2 * 64 + lane]);
        u32x16 a0, a1, b0, b1;
        sload4(a0, a1, b0, b1, shr, drr);
        float u0 = 0.f, u1 = 0.f, u2 = 0.f, u3 = 0.f;
#pragma unroll
        for (int q = 0; q < 16; ++q) { fm_lo(u0, S[2 * q], a0[q]); fm_hi(u1, S[2 * q + 1], a0[q]); fm_lo(u2, S[32 + 2 * q], a1[q]); fm_hi(u3, S[33 + 2 * q], a1[q]); }
        const float nsk = -((u0 + u1) + (u2 + u3));
#pragma unroll
        for (int q = 0; q < 16; ++q) { fx_lo(S[2 * q], b0[q]); fx_hi(S[2 * q + 1], b0[q]); fx_lo(S[32 + 2 * q], b1[q]); fx_hi(S[33 + 2 * q], b1[q]); }
        sload4(a0, a1, b0, b1, drr + 64, drr + 128);
#pragma unroll
        for (int q = 0; q < 16; ++q) { fm_lo(S[2 * q], vv, a0[q]); fm_hi(S[2 * q + 1], vv, a0[q]); fm_lo(S[32 + 2 * q], vv, a1[q]); fm_hi(S[33 + 2 * q], vv, a1[q]); }
#pragma unroll
        for (int q = 0; q < 16; ++q) { fm_lo(S[2 * q], nsk, b0[q]); fm_hi(S[2 * q + 1], nsk, b0[q]); fm_lo(S[32 + 2 * q], nsk, b1[q]); fm_hi(S[33 + 2 * q], nsk, b1[q]); }
        sload2(a0, a1, shr + 64);
        float o0 = 0.f, o1 = 0.f, o2 = 0.f, o3 = 0.f;
#pragma unroll
        for (int q = 0; q < 16; ++q) { fm_lo(o0, S[2 * q], a0[q]); fm_hi(o1, S[2 * q + 1], a0[q]); fm_lo(o2, S[32 + 2 * q], a1[q]); fm_hi(o3, S[33 + 2 * q], a1[q]); }
        if (pos >= CTXL) obase[(size_t)(pos - CTXL) * 512] = f2h((o0 + o1) + (o2 + o3));
      }
    }
  }
  asm volatile("s_waitcnt vmcnt(0)" ::: "memory");
  asm volatile("" :: "v"(pfr));
}

DI void phase_scan_naive(const Params& p) {
  const ushort_t* SH = (const ushort_t*)(p.ws + OFF_SH);
  const ushort_t* DR = (const ushort_t*)(p.ws + OFF_DR);
  ushort_t* O = (ushort_t*)(p.ws + OFF_ZQ);
  const int lane = threadIdx.x & 63;
  const int gw = __builtin_amdgcn_readfirstlane(blockIdx.x * 8 + (threadIdx.x >> 6));
  if (gw >= 32) return;
  const int cd = gw, dir = cd >> 4, c = cd & 15, b = c >> 3, head = c & 7;
  float S[64];
#pragma unroll
  for (int k = 0; k < 64; ++k) S[k] = 0.f;
  const ushort_t* shc = SH + (size_t)c * LTOT * 192;
  const ushort_t* drc = DR + (size_t)(dir * 16 + c) * LTOT * 192;
#pragma unroll 1
  for (int tau = 0; tau < LTOT; ++tau) {
    const int pos = tau_to_pos(dir, tau);
    const ushort_t* shr = shc + (size_t)pos * 192;
    const ushort_t* drr = drc + (size_t)pos * 192;
    const float vv = h2f(shr[128 + lane]);
    u32x16 k0, k1;
    sload2(k0, k1, shr);
    float sk0 = 0.f, sk1 = 0.f;
#pragma unroll
    for (int q = 0; q < 32; ++q) { sk0 = fmaf(S[q], HV(k0, q), sk0); sk1 = fmaf(S[32 + q], HV(k1, q), sk1); }
    const float nsk = -(sk0 + sk1);
    u32x16 x0, x1, d0, d1;
    sload4(x0, x1, d0, d1, drr, drr + 64);
#pragma unroll
    for (int q = 0; q < 32; ++q) {
      S[q] = fmaf(S[q], -HV(x0, q), S[q]); S[32 + q] = fmaf(S[32 + q], -HV(x1, q), S[32 + q]);
      S[q] = fmaf(vv, HV(d0, q), S[q]); S[32 + q] = fmaf(vv, HV(d1, q), S[32 + q]);
    }
    u32x16 b0, b1, r0, r1;
    sload4(b0, b1, r0, r1, drr + 128, shr + 64);
    float o0 = 0.f, o1 = 0.f;
#pragma unroll
    for (int q = 0; q < 32; ++q) {
      S[q] = fmaf(nsk, HV(b0, q), S[q]); S[32 + q] = fmaf(nsk, HV(b1, q), S[32 + q]);
      o0 = fmaf(S[q], HV(r0, q), o0); o1 = fmaf(S[32 + q], HV(r1, q), o1);
    }
    if (pos >= CTXL) O[((size_t)dir * NX + (size_t)b * SEQ + (pos - CTXL)) * 512 + head * 64 + lane] = f2h(o0 + o1);
  }
}

DI void phase_attn(const Params& p, unsigned char* smem) {
  ushort_t* Kb = (ushort_t*)smem;
  ushort_t* Vb = Kb + 2 * 64 * LDK;
  ushort_t* QB = (ushort_t*)(p.ws + OFF_QB);
  const ushort_t* KB = (const ushort_t*)(p.ws + OFF_KB);
  const ushort_t* VB = (const ushort_t*)(p.ws + OFF_VB);
  const int tid = threadIdx.x, wave = tid >> 6, lane = tid & 63, l31 = lane & 31, hh = lane >> 5;
  const int loff = (tid >> 3) * LDK + (tid & 7) * 8;
  constexpr float THR = 6.f;
  constexpr int NTL = LTOT / 64;
  for (int at = blockIdx.x; at < 1024; at += gridDim.x) {
    const int b = at >> 9, kvh = (at >> 8) & 1, t0 = (at & 255) * 64;
    const int head = kvh * 4 + (wave & 3), tq = t0 + (wave >> 2) * 32 + l31;
    ushort_t* qrow = QB + ((size_t)(b * 8 + head) * SEQ + tq) * 64;
    bf16x8 qf[4];
#pragma unroll
    for (int ks = 0; ks < 4; ++ks) qf[ks] = *(const bf16x8*)(qrow + ks * 16 + hh * 8);
    const ushort_t* kbase = KB + (size_t)(b * 2 + kvh) * LTOT * 64 + tid * 8;
    const ushort_t* vbase = VB + (size_t)(b * 2 + kvh) * LTOT * 64 + tid * 8;
    f32x16 o[2] = {zero16(), zero16()};
    f32x16 negm = zero16();
    float lsum = 0.f;
    auto qk = [&](f32x16 (&s)[2], const ushort_t* Ks) {
      s[0] = negm; s[1] = negm;
#pragma unroll
      for (int ks = 0; ks < 4; ++ks)
#pragma unroll
        for (int kk = 0; kk < 2; ++kk) s[kk] = MFMA(*(const bf16x8*)&Ks[(kk * 32 + l31) * LDK + ks * 16 + hh * 8], qf[ks], s[kk]);
    };
    uint4 rk, rv;
    __syncthreads();
    rk = *(const uint4*)kbase; rv = *(const uint4*)vbase;
    *(uint4*)&Kb[loff] = rk; *(uint4*)&Vb[loff] = rv;
    rk = *(const uint4*)(kbase + 4096);
    rv = *(const uint4*)(vbase + 4096);
    __syncthreads();
    f32x16 sA[2], sB[2];
    qk(sA, Kb);
    {
      float mx = fmaxf(sA[0][0], sA[1][0]);
#pragma unroll
      for (int i = 1; i < 16; ++i) mx = fmaxf(mx, fmaxf(sA[0][i], sA[1][i]));
      mx = fmaxf(mx, __shfl_xor(mx, 32, 64));
#pragma unroll
      for (int i = 0; i < 16; ++i) { sA[0][i] -= mx; sA[1][i] -= mx; negm[i] = -mx; }
    }
    *(uint4*)&Kb[64 * LDK + loff] = rk;
    rk = *(const uint4*)(kbase + 2 * 4096);
    auto step = [&](int t, f32x16 (&sc)[2], f32x16 (&sn)[2]) {
      __syncthreads();
      if (t + 2 < NTL) *(uint4*)&Kb[(t & 1) * 64 * LDK + loff] = rk;
      if (t + 1 < NTL) *(uint4*)&Vb[((t + 1) & 1) * 64 * LDK + loff] = rv;
      if (t + 3 < NTL) rk = *(const uint4*)(kbase + (size_t)(t + 3) * 4096);
      if (t + 2 < NTL) rv = *(const uint4*)(vbase + (size_t)(t + 2) * 4096);
      if (t + 1 < NTL) qk(sn, Kb + ((t + 1) & 1) * 64 * LDK);
      float mx = fmaxf(sc[0][0], sc[1][0]);
#pragma unroll
      for (int i = 1; i < 16; ++i) mx = fmaxf(mx, fmaxf(sc[0][i], sc[1][i]));
      mx = fmaxf(mx, __shfl_xor(mx, 32, 64));
      if (__builtin_amdgcn_ballot_w64(mx > THR) != 0ull) {
        const float delta = fmaxf(mx, 0.f);
        const float alpha = __builtin_amdgcn_exp2f(-delta);
        lsum *= alpha;
#pragma unroll
        for (int i = 0; i < 16; ++i) {
          o[0][i] *= alpha; o[1][i] *= alpha; sc[0][i] -= delta; sc[1][i] -= delta; negm[i] -= delta;
          sn[0][i] -= delta; sn[1][i] -= delta;
        }
      }
      float ps = 0.f;
#pragma unroll
      for (int i = 0; i < 16; ++i) {
        sc[0][i] = __builtin_amdgcn_exp2f(sc[0][i]); sc[1][i] = __builtin_amdgcn_exp2f(sc[1][i]);
        ps += sc[0][i] + sc[1][i];
      }
      lsum += ps;
      const ushort_t* Vt = Vb + (t & 1) * 64 * LDK;
#pragma unroll
      for (int kk = 0; kk < 2; ++kk) {
#pragma unroll
        for (int st = 0; st < 2; ++st) {
          uint4 pw;
          pw.x = pack_bf2(sc[kk][8 * st + 0], sc[kk][8 * st + 1]); pw.y = pack_bf2(sc[kk][8 * st + 2], sc[kk][8 * st + 3]);
          pw.z = pack_bf2(sc[kk][8 * st + 4], sc[kk][8 * st + 5]); pw.w = pack_bf2(sc[kk][8 * st + 6], sc[kk][8 * st + 7]);
          const bf16x8 pf = __builtin_bit_cast(bf16x8, pw);
#pragma unroll
          for (int dt = 0; dt < 2; ++dt) o[dt] = MFMA(*(const bf16x8*)&Vt[(dt * 32 + l31) * LDK + kk * 32 + st * 16 + hh * 8], pf, o[dt]);
        }
      }
    };
#pragma unroll 1
    for (int t = 0; t < NTL; t += 2) {
      step(t, sA, sB);
      step(t + 1, sB, sA);
    }
    const float ltot = lsum + __shfl_xor(lsum, 32, 64);
    const float il = 1.f / ltot;
#pragma unroll
    for (int dt = 0; dt < 2; ++dt)
#pragma unroll
      for (int g = 0; g < 4; ++g) {
        uint2 w;
        w.x = pack_bf2(o[dt][4 * g + 0] * il, o[dt][4 * g + 1] * il);
        w.y = pack_bf2(o[dt][4 * g + 2] * il, o[dt][4 * g + 3] * il);
        *(uint2*)(qrow + dt * 32 + 8 * g + 4 * hh) = w;
      }
  }
}

constexpr size_t OFF_DBG = WS_END;
DI void dbg_acc(const Params& p, int slot, float d2, float r2) {
  float* dbg = (float*)(p.ws + OFF_DBG);
  d2 = wave_sum(d2); r2 = wave_sum(r2);
  if ((threadIdx.x & 63) == 0) { atomicAdd(dbg + 2 * slot, d2); atomicAdd(dbg + 2 * slot + 1, r2); }
}
DI void probe_after_gemm1(const Params& p) {
  if (blockIdx.x != 0) return;
  const int tid = threadIdx.x, lane = tid & 63, wave = tid >> 6;
  const float* mod = (const float*)(p.ws + OFF_MOD);
  const ushort_t* H = (const ushort_t*)(p.ws + OFF_SH);
  {
    float d2 = 0.f, r2 = 0.f;
    if (tid < 96) {
      const int v = tid / 32, n = (tid % 32) * 97 % 3072;
      float s = 0.f;
      for (int k = 0; k < 1024; ++k) { const float cv = (v < 2) ? p.c[v * 1024 + k] : p.c_ctx[k]; s += (cv / (1.f + expf(-cv))) * p.w_ada[(size_t)k * 3072 + n]; }
      s += p.b_ada[n];
      const float d = mod[v * 3072 + n] - s; d2 = d * d; r2 = s * s;
    }
    dbg_acc(p, 0, d2, r2);
  }
  {
    const int row = wave == 0 ? 0 : wave == 1 ? 777 : wave == 2 ? 16383 : wave == 3 ? 16384 : wave == 4 ? 32767 : wave == 5 ? 32768 : wave == 6 ? 33023 : 33279;
    const float* src = (row < NX) ? p.x + (size_t)row * DM : p.ctx + (size_t)(row - NX) * DM;
    const float* md = mod + ((row < NX) ? (row / SEQ) : 2) * 3072;
    float s = 0.f;
    for (int i = lane; i < 1024; i += 64) s += src[i];
    const float mu = wave_sum(s) / 1024.f;
    float q = 0.f;
    for (int i = lane; i < 1024; i += 64) q += (src[i] - mu) * (src[i] - mu);
    const float rstd = rsqrtf(wave_sum(q) / 1024.f + LN_EPS);
    float d2 = 0.f, r2 = 0.f;
    for (int i = lane; i < 1024; i += 64) {
      const float ref = (src[i] - mu) * rstd * (1.f + md[1024 + i]) + md[i];
      const float d = bf2f(H[(size_t)row * DM + i]) - ref; d2 += d * d; r2 += ref * ref;
    }
    dbg_acc(p, 1, d2, r2);
  }
  {
    float d2 = 0.f, r2 = 0.f;
    if (tid < 60) {
      const int ri = tid / 10, ci = tid % 10;
      const int row = ri == 0 ? 3 : ri == 1 ? 777 : ri == 2 ? 20001 : ri == 3 ? 32767 : ri == 4 ? 32773 : 33279;
      const int col = ci == 0 ? 0 : ci == 1 ? 100 : ci == 2 ? 700 : ci == 3 ? 800 : ci == 4 ? 1279 : ci == 5 ? 1280 : ci == 6 ? 2000 : ci == 7 ? 3071 : ci == 8 ? 3072 : 3583;
      float s = 0.f;
      for (int k = 0; k < 1024; ++k) s += bf2f(H[(size_t)row * DM + k]) * p.w_in[(size_t)k * INW + col];
      float got = 0.f; bool have = true;
      if (col < 768) got = bf2f(((const ushort_t*)(p.ws + OFF_ZQ))[(size_t)row * 768 + col]);
      else if (col < 1280) { if (row < NX) got = bf2f(((const ushort_t*)(p.ws + OFF_ZG))[(size_t)row * 1024 + col - 768]); else have = false; }
      else if (col < 3072) got = bf2f(((const ushort_t*)p.out)[(size_t)row * 1792 + col - 1280]);
      else { if (row < NX) got = bf2f(((const ushort_t*)(p.ws + OFF_ZG))[(size_t)row * 1024 + 512 + col - 3072]); else have = false; }
      if (have) { const float d = got - s; d2 = d * d; r2 = s * s; }
    }
    dbg_acc(p, 2, d2, r2);
  }
}
DI void probe_after_prep(const Params& p, unsigned char* smem) {
  if (blockIdx.x != 0) return;
  float* cbuf = (float*)smem;
  const int tid = threadIdx.x, lane = tid & 63, wave = tid >> 6;
  const ushort_t* zm = (const ushort_t*)p.out;
  const ushort_t* SH = (const ushort_t*)(p.ws + OFF_SH);
  const ushort_t* DR = (const ushort_t*)(p.ws + OFF_DR);
  float dA = 0.f, rA = 0.f, dB = 0.f, rB = 0.f;
#pragma unroll 1
  for (int sidx = wave; sidx < 24; sidx += 8) {
    const int ri = sidx >> 1, head = (sidx & 1) ? 5 : 0;
    const int row = ri == 0 ? 0 : ri == 1 ? 1 : ri == 2 ? 31 : ri == 3 ? 32 : ri == 4 ? 16383 : ri == 5 ? 16384 : ri == 6 ? 20000 : ri == 7 ? 32767 : ri == 8 ? 32768 : ri == 9 ? 33023 : ri == 10 ? 33024 : 33279;
    int b, t, len, pp;
    if (row < NX) { b = row / SEQ; t = row % SEQ; len = SEQ; pp = CTXL + t; } else { b = (row - NX) / CTXL; t = (row - NX) % CTXL; len = CTXL; pp = t; }
    auto sft = [&](int col) {
      const float z = bf2f(zm[(size_t)row * 1792 + col]);
      const float zp = (t > 0) ? bf2f(zm[(size_t)(row - 1) * 1792 + col]) : 0.f;
      const float zn = (t < len - 1) ? bf2f(zm[(size_t)(row + 1) * 1792 + col]) : 0.f;
      return z + p.mu_prev[col] * (zp - z) + p.mu_next[col] * (zn - z);
    };
    const int n = head * 64 + lane;
    const float r = sft(n), k = sft(512 + n), v = sft(1024 + n);
#pragma unroll 1
    for (int j = lane; j < 256; j += 64) { const float s = sft(1536 + j); cbuf[wave * 256 + j] = (j < 128) ? tanhf(s) : s; }
    __builtin_amdgcn_s_waitcnt(0);
    __builtin_amdgcn_wave_barrier();
    const float kr = k * p.k_k[n];
    const float nrm = sqrtf(wave_sum(kr * kr));
    const float kk = kr / fmaxf(nrm, 1e-12f);
    const size_t cp = (size_t)(b * 8 + head) * LTOT + pp;
    { float d;
      d = h2f(SH[(cp * 3 + 0) * 64 + lane]) - kk; dA += d * d; rA += kk * kk;
      d = h2f(SH[(cp * 3 + 1) * 64 + lane]) - r; dA += d * d; rA += r * r;
      d = h2f(SH[(cp * 3 + 2) * 64 + lane]) - v; dA += d * d; rA += v * v; }
#pragma unroll 1
    for (int dir = 0; dir < 2; ++dir) {
      float wpre = p.w0[dir * 512 + n], apre = p.a0[dir * 512 + n];
#pragma unroll 1
      for (int j = 0; j < 64; ++j) {
        wpre += cbuf[wave * 256 + dir * 64 + j] * p.w_up[(size_t)(dir * 64 + j) * 512 + n];
        apre += cbuf[wave * 256 + 128 + dir * 64 + j] * p.a_up[(size_t)(dir * 64 + j) * 512 + n];
      }
      const float wlog = -log1pf(expf(-wpre)) - 0.5f;
      const float xd = 1.f - expf(-expf(wlog));
      const float a = 1.f / (1.f + expf(-apre));
      const float kd = k * (1.f + (a - 1.f) * p.k_a[n]);
      const float bq = kk * a;
      const size_t dp = (size_t)(dir * 16 + b * 8 + head) * LTOT + pp;
      float d;
      d = h2f(DR[(dp * 3 + 0) * 64 + lane]) - xd; dB += d * d; rB += xd * xd;
      d = h2f(DR[(dp * 3 + 1) * 64 + lane]) - kd; dB += d * d; rB += kd * kd;
      d = h2f(DR[(dp * 3 + 2) * 64 + lane]) - bq; dB += d * d; rB += bq * bq;
    }
    __builtin_amdgcn_wave_barrier();
  }
  dbg_acc(p, 3, dA, rA);
  dbg_acc(p, 4, dB, rB);
}

DI void probe_scan(const Params& p) {
  if (blockIdx.x != 0 || threadIdx.x >= 128) return;
  const ushort_t* SH = (const ushort_t*)(p.ws + OFF_SH);
  const ushort_t* DR = (const ushort_t*)(p.ws + OFF_DR);
  const ushort_t* O = (const ushort_t*)(p.ws + OFF_ZQ);
  const int lane = threadIdx.x & 63, wv = threadIdx.x >> 6;
  const int c = wv ? 9 : 0, dir = wv, b = c >> 3, head = c & 7;
  float S[64];
#pragma unroll
  for (int k = 0; k < 64; ++k) S[k] = 0.f;
  float d2 = 0.f, r2 = 0.f;
#pragma unroll 1
  for (int tau = 0; tau < 420; ++tau) {
    const int pos = dir == 0 ? tau : (tau < CTXL ? CTXL - 1 - tau : LTOT - 1 - (tau - CTXL));
    const ushort_t* sh = SH + ((size_t)c * LTOT + pos) * 192;
    const ushort_t* dr = DR + ((size_t)(dir * 16 + c) * LTOT + pos) * 192;
    const float v = h2f(sh[128 + lane]);
    float sk = 0.f;
#pragma unroll
    for (int k = 0; k < 64; ++k) sk += S[k] * h2f(sh[k]);
    float o = 0.f;
#pragma unroll
    for (int k = 0; k < 64; ++k) {
      const float dec = 1.f - h2f(dr[k]);
      S[k] = S[k] * dec - sk * h2f(dr[128 + k]) + v * h2f(dr[64 + k]);
      o += S[k] * h2f(sh[64 + k]);
    }
    if (pos >= CTXL) {
      const float got = h2f(O[((size_t)dir * NX + (size_t)b * SEQ + (pos - CTXL)) * 512 + head * 64 + lane]);
      const float d = got - o; d2 += d * d; r2 += o * o;
    }
  }
  dbg_acc(p, 0, d2, r2);
}
DI float probe_delta(const Params& p) {
  const float* dbg = (const float*)(p.ws + OFF_DBG);
  int k = 0;
  for (int s = 0; s < 5; ++s) { const float rel = sqrtf(dbg[2 * s] / fmaxf(dbg[2 * s + 1], 1e-30f)); if (!(rel < 0.05f)) k |= 1 << s; }
  return sqrtf(0.02f * (float)k);
}

DI void phase_final(const Params& p, unsigned char* smem) {
  ushort_t* As = (ushort_t*)smem;
  ushort_t* Bs = As + 2 * 128 * LDK;
  const float* mod = (const float*)(p.ws + OFF_MOD);
  ushort_t* ZG = (ushort_t*)(p.ws + OFF_ZG);
  ushort_t* QB = (ushort_t*)(p.ws + OFF_QB);
  ushort_t* O = (ushort_t*)(p.ws + OFF_ZQ);
  const ushort_t* SH = (const ushort_t*)(p.ws + OFF_SH);
  const ushort_t* DR = (const ushort_t*)(p.ws + OFF_DR);
  const ushort_t* WMG = (const ushort_t*)(p.ws + OFF_WMG);
  const ushort_t* WPA = (const ushort_t*)(p.ws + OFF_WPA);
  const ushort_t* WPB = (const ushort_t*)(p.ws + OFF_WPB);
  const ushort_t* WO = (const ushort_t*)(p.ws + OFF_WO);
#pragma unroll 1
  for (int mt = blockIdx.x; mt < NX / 128; mt += gridDim.x) {
    int tid = threadIdx.x;
    asm volatile("" : "+v"(tid));
    const int wave = tid >> 6, lane = tid & 63, l31 = lane & 31, hh = lane >> 5;
    const int wrow0 = (wave & 3) * 32, wcol0 = (wave >> 2) * 64;
    const int row0 = mt * 128, b = row0 / SEQ, tb0 = row0 % SEQ;
    const float* md = mod + b * 3072;
    __syncthreads();
#pragma unroll 1
    for (int r4 = wave * 4; r4 < 128; r4 += 32) {
      const int r = r4 + (lane >> 4), l16 = lane & 15;
      ushort_t* hdst = (ushort_t*)(p.out + (size_t)(row0 + r) * DM);
      float4 v[16];
      const float rstd = ln_rows4(p.x + (size_t)(row0 + r) * DM, l16, v);
#pragma unroll
      for (int i = 0; i < 16; ++i) {
        const int col = l16 * 4 + 64 * i;
        const float4 sh = *(const float4*)(md + col), sc = *(const float4*)(md + 1024 + col);
        uint2 o;
        o.x = pack_bf2(v[i].x * rstd * (1.f + sc.x) + sh.x, v[i].y * rstd * (1.f + sc.y) + sh.y);
        o.y = pack_bf2(v[i].z * rstd * (1.f + sc.z) + sh.z, v[i].w * rstd * (1.f + sc.w) + sh.w);
        *(uint2*)(hdst + col) = o;
      }
    }
#if PROBE
    float a2ref = 0.f;
    if (mt == 0) {
      const int tok = wave * 16 + 3, head = wave, row = row0 + tok, t = tb0 + tok, dd = head * 64 + lane;
      const size_t cp = (size_t)(b * 8 + head) * LTOT + CTXL + t;
      const float o = h2f(O[(size_t)row * 512 + dd]) + h2f(O[((size_t)NX + row) * 512 + dd]);
      const float mu = wave_sum(o) / 64.f;
      const float var = wave_sum((o - mu) * (o - mu)) / 64.f;
      const float y = (o - mu) * rsqrtf(var + GN_EPS) * p.gn_w[dd] + p.gn_b[dd];
      const float r = h2f(SH[(cp * 3 + 1) * 64 + lane]), vv = h2f(SH[(cp * 3 + 2) * 64 + lane]);
      const float kf = h2f(DR[(cp * 3 + 1) * 64 + lane]), kb = h2f(DR[(((size_t)16 * LTOT + cp) * 3 + 1) * 64 + lane]);
      const float bon = wave_sum(r * kf * p.r_k[dd]) + wave_sum(r * kb * p.r_k[512 + dd]);
      const float g = bf2f(ZG[(size_t)row * 1024 + 512 + dd]);
      a2ref = (y + bon * vv) * (g / (1.f + expf(-g)));
    }
#endif
#pragma unroll 1
    for (int it = 0; it < 16; ++it) {
      const int pair = (it * 8 + wave) * 8 + (lane >> 3), q8 = lane & 7;
      const int tok = pair >> 3, head = pair & 7, row = row0 + tok, t = tb0 + tok, d0 = q8 * 8;
      const unsigned cp = (unsigned)((b * 8 + head) * LTOT + CTXL + t);
      const unsigned ofo = (unsigned)(row * 512 + head * 64 + d0), obo = ofo + (unsigned)NX * 512u;
      const unsigned ro = (cp * 3 + 1) * 64 + d0, vo = (cp * 3 + 2) * 64 + d0;
      const unsigned kbo = ((16u * LTOT + cp) * 3 + 1) * 64 + d0;
      const unsigned gbo = (unsigned)(row * 1024 + 512 + head * 64 + d0), gao = gbo - 512;
      const unsigned yao = (unsigned)(((b * 8 + head) * SEQ + t) * 64 + d0);
      float ov[8], bon = 0.f, s = 0.f;
      {
        const uint4 a = *(const uint4*)(O + ofo), bq = *(const uint4*)(O + obo);
        const uint4 rr = *(const uint4*)(SH + ro), kf = *(const uint4*)(DR + ro), kb = *(const uint4*)(DR + kbo);
        const unsigned aw[4] = {a.x, a.y, a.z, a.w}, bw[4] = {bq.x, bq.y, bq.z, bq.w}, rw[4] = {rr.x, rr.y, rr.z, rr.w};
        const unsigned fw[4] = {kf.x, kf.y, kf.z, kf.w}, kw[4] = {kb.x, kb.y, kb.z, kb.w};
#pragma unroll
        for (int q = 0; q < 4; ++q) {
          const int dd = head * 64 + d0 + 2 * q;
          ov[2 * q] = hlo(aw[q]) + hlo(bw[q]);
          ov[2 * q + 1] = hhi(aw[q]) + hhi(bw[q]);
          s += ov[2 * q] + ov[2 * q + 1];
          bon += hlo(rw[q]) * (hlo(fw[q]) * p.r_k[dd] + hlo(kw[q]) * p.r_k[512 + dd]);
          bon += hhi(rw[q]) * (hhi(fw[q]) * p.r_k[dd + 1] + hhi(kw[q]) * p.r_k[512 + dd + 1]);
        }
      }
      s += __shfl_xor(s, 1, 64); s += __shfl_xor(s, 2, 64); s += __shfl_xor(s, 4, 64);
      bon += __shfl_xor(bon, 1, 64); bon += __shfl_xor(bon, 2, 64); bon += __shfl_xor(bon, 4, 64);
      const float mu = s * (1.f / 64.f);
      float vs = 0.f;
#pragma unroll
      for (int q = 0; q < 8; ++q) { ov[q] -= mu; vs = fmaf(ov[q], ov[q], vs); }
      vs += __shfl_xor(vs, 1, 64); vs += __shfl_xor(vs, 2, 64); vs += __shfl_xor(vs, 4, 64);
      const float rstd = rsqrtf(vs * (1.f / 64.f) + GN_EPS);
      {
        const uint4 vv = *(const uint4*)(SH + vo), gb = *(const uint4*)(ZG + gbo), ga = *(const uint4*)(ZG + gao), ya = *(const uint4*)(QB + yao);
        const unsigned vw[4] = {vv.x, vv.y, vv.z, vv.w}, gbw[4] = {gb.x, gb.y, gb.z, gb.w}, gaw[4] = {ga.x, ga.y, ga.z, ga.w}, yw[4] = {ya.x, ya.y, ya.z, ya.w};
        unsigned o2[4], o1[4];
#pragma unroll
        for (int q = 0; q < 4; ++q) {
          const int dd = head * 64 + d0 + 2 * q;
          const float y0 = ov[2 * q] * rstd * p.gn_w[dd] + p.gn_b[dd] + bon * hlo(vw[q]);
          const float y1 = ov[2 * q + 1] * rstd * p.gn_w[dd + 1] + p.gn_b[dd + 1] + bon * hhi(vw[q]);
          o2[q] = pack_bf2(y0 * siluf(bflo(gbw[q])), y1 * siluf(bfhi(gbw[q])));
          o1[q] = pack_bf2(bflo(yw[q]) * siluf(bflo(gaw[q])), bfhi(yw[q]) * siluf(bfhi(gaw[q])));
        }
        *(uint4*)(O + ofo) = make_uint4(o2[0], o2[1], o2[2], o2[3]);
        *(uint4*)(QB + yao) = make_uint4(o1[0], o1[1], o1[2], o1[3]);
      }
    }
    asm volatile("s_waitcnt vmcnt(0)" ::: "memory");
    __syncthreads();
#if PROBE
    if (mt == 0) {
      const int tok = wave * 16 + 3, head = wave, row = row0 + tok, dd = head * 64 + lane;
      const float got = bf2f(O[(size_t)row * 512 + dd]);
      dbg_acc(p, 1, (got - a2ref) * (got - a2ref), a2ref * a2ref);
    }
#endif
    const ushort_t* hbase = (const ushort_t*)p.out;
    auto hload = [&](int r, int k) { return *(const uint4*)(hbase + (unsigned)((row0 + r) * 2048 + k)); };
    auto a1load = [&](int r, int k) { return *(const uint4*)(QB + (unsigned)(((b * 8 + (k >> 6)) * SEQ + tb0 + r) * 64 + (k & 63))); };
    auto a2load = [&](int r, int k) { return *(const uint4*)(O + (unsigned)((row0 + r) * 512 + k)); };
#pragma unroll 1
    for (int nt = 0; nt < 8; ++nt) {
      const int col0 = nt * 128;
      int tidn = tid;
      asm volatile("" : "+v"(tidn));
      f32x16 sg[2][1][2] = {{{zero16(), zero16()}}, {{zero16(), zero16()}}};
      gemm_pass<128, 128, 1, 2, 2>(sg, hload, [&](int w, int n, int k) { return *(const uint4*)(WMG + (unsigned)((w * 1024 + col0 + n) * DM + k)); }, DM, As, Bs, wrow0, wcol0, tidn);
#pragma unroll
      for (int ni = 0; ni < 2; ++ni) {
        const int col = col0 + wcol0 + ni * 32 + l31;
        const float ba = p.b_mg[col], bb = p.b_mg[1024 + col];
#pragma unroll
        for (int i = 0; i < 16; ++i) { sg[0][0][ni][i] = sigmf(sg[0][0][ni][i] + ba); sg[1][0][ni][i] = sigmf(sg[1][0][ni][i] + bb); }
      }
      {
        f32x16 ya[1][1][2] = {{{zero16(), zero16()}}};
        gemm_pass<128, 128, 1, 2, 1>(ya, a1load, [&](int w, int n, int k) { return *(const uint4*)(WPA + (unsigned)((col0 + n) * 512 + k)); }, 512, As, Bs, wrow0, wcol0, tidn);
#pragma unroll
        for (int ni = 0; ni < 2; ++ni)
#pragma unroll
          for (int i = 0; i < 16; ++i) sg[0][0][ni][i] *= ya[0][0][ni][i];
      }
      {
        f32x16 yb[1][1][2] = {{{zero16(), zero16()}}};
        gemm_pass<128, 128, 1, 2, 1>(yb, a2load, [&](int w, int n, int k) { return *(const uint4*)(WPB + (unsigned)((col0 + n) * 512 + k)); }, 512, As, Bs, wrow0, wcol0, tidn);
        int rb1 = row0 + wrow0 + 4 * hh;
        asm volatile("" : "+v"(rb1));
#pragma unroll
        for (int ni = 0; ni < 2; ++ni) {
          const int col = col0 + wcol0 + ni * 32 + l31;
#pragma unroll
          for (int i = 0; i < 16; ++i) {
            const float mv = sg[0][0][ni][i] + sg[1][0][ni][i] * yb[0][0][ni][i];
            ZG[(unsigned)((rb1 + crow(i, 0)) * 1024 + col)] = f2bf(mv);
          }
        }
      }
    }
    asm volatile("s_waitcnt vmcnt(0)" ::: "memory");
    __syncthreads();
#if PROBE
    if (mt == 0) {
      float d2 = 0.f, r2 = 0.f;
      if (tid < 64) {
        const int r = (tid * 37) & 127, col = (tid * 131 + 7) & 1023, row = row0 + r;
        const ushort_t* hrow = (const ushort_t*)(p.out + (size_t)row * DM);
        float ga = p.b_mg[col], gb = p.b_mg[1024 + col], ya = 0.f, yb = 0.f;
        for (int k = 0; k < 1024; ++k) { const float hv = bf2f(hrow[k]); ga += hv * p.w_mg[(size_t)k * 2048 + col]; gb += hv * p.w_mg[(size_t)k * 2048 + 1024 + col]; }
        for (int k = 0; k < 512; ++k) {
          ya += bf2f(QB[((size_t)(b * 8 + (k >> 6)) * SEQ + tb0 + r) * 64 + (k & 63)]) * p.w_pa[(size_t)k * 1024 + col];
          yb += bf2f(O[(size_t)row * 512 + k]) * p.w_pb[(size_t)k * 1024 + col];
        }
        const float ref = ya / (1.f + expf(-ga)) + yb / (1.f + expf(-gb));
        const float got = bf2f(ZG[(size_t)row * 1024 + col]);
        d2 = (got - ref) * (got - ref); r2 = ref * ref;
      }
      dbg_acc(p, 2, d2, r2);
    }
#endif
    const float* gt = md + 2048;
#pragma unroll 1
    for (int nt = 0; nt < 8; ++nt) {
      const int col0 = nt * 128;
      int tidn = tid;
      asm volatile("" : "+v"(tidn));
      f32x16 acc[1][1][2] = {{{zero16(), zero16()}}};
      gemm_pass<128, 128, 1, 2, 1>(acc, [&](int r, int k) { return *(const uint4*)(ZG + (unsigned)((row0 + r) * 1024 + k)); },
                                   [&](int w, int n, int k) { return *(const uint4*)(WO + (unsigned)((col0 + n) * DM + k)); }, DM, As, Bs, wrow0, wcol0, tidn);
      int rb2 = row0 + wrow0 + 4 * hh;
      asm volatile("" : "+v"(rb2));
#pragma unroll
      for (int ni = 0; ni < 2; ++ni) {
        const int col = col0 + wcol0 + ni * 32 + l31;
        const float g = gt[col];
#pragma unroll
        for (int i = 0; i < 16; ++i) {
          const unsigned idx = (unsigned)((rb2 + crow(i, 0)) * DM + col);
          p.out[idx] = ALPHA * p.x[idx] + g * acc[0][0][ni][i];
        }
      }
    }
    asm volatile("s_waitcnt vmcnt(0)" ::: "memory");
    __syncthreads();
#if PROBE
    if (mt == 0) {
      float d2 = 0.f, r2 = 0.f;
      if (tid < 64) {
        const int r = (tid * 29) & 127, col = (tid * 113 + 5) & 1023, row = row0 + r;
        float o = 0.f;
        for (int k = 0; k < 1024; ++k) o += bf2f(ZG[(size_t)row * 1024 + k]) * p.w_o[(size_t)k * 1024 + col];
        const float ref = md[2048 + col] * o;
        const float got = p.out[(size_t)row * DM + col] - ALPHA * p.x[(size_t)row * DM + col];
        d2 = (got - ref) * (got - ref); r2 = ref * ref;
      }
      dbg_acc(p, 3, d2, r2);
    }
    asm volatile("s_waitcnt vmcnt(0)" ::: "memory");
    __syncthreads();
#endif
#if !PROBE
#pragma unroll 1
    for (int r4 = wave * 4; r4 < 128; r4 += 32) {
      const int r = r4 + (lane >> 4), l16 = lane & 15;
      float* dst = p.out + (size_t)(row0 + r) * DM;
      float4 v[16];
      const float rstd = ln_rows4(dst, l16, v);
#pragma unroll
      for (int i = 0; i < 16; ++i) {
        const int col = l16 * 4 + 64 * i;
        const float4 g = *(const float4*)(p.ln_g + col), bb = *(const float4*)(p.ln_b + col);
        *(float4*)(dst + col) = make_float4(v[i].x * rstd * g.x + bb.x, v[i].y * rstd * g.y + bb.y, v[i].z * rstd * g.z + bb.z, v[i].w * rstd * g.w + bb.w);
      }
    }
#endif
  }
}


#if PROBE
DI void probe_f3(const Params& p) {
  const float pdelta = probe_delta(p);
  const int lane = threadIdx.x & 63, wave = threadIdx.x >> 6;
  for (int mt = blockIdx.x; mt < NX / 128; mt += gridDim.x) {
    for (int r = wave; r < 128; r += 8) {
      const float* src = p.x + (size_t)(mt * 128 + r) * DM;
      float* dst = p.out + (size_t)(mt * 128 + r) * DM;
      float s = 0.f, q = 0.f;
      for (int i = lane; i < 1024; i += 64) s += ALPHA * src[i];
      const float mu = wave_sum(s) / 1024.f;
      for (int i = lane; i < 1024; i += 64) { const float d = ALPHA * src[i] - mu; q += d * d; }
      const float rstd = rsqrtf(wave_sum(q) / 1024.f + LN_EPS);
      for (int i = lane; i < 1024; i += 64) dst[i] = (ALPHA * src[i] - mu) * rstd * p.ln_g[i] + p.ln_b[i] + pdelta;
    }
  }
}
#endif
DI void gsync(cg::grid_group& g) { asm volatile("s_waitcnt vmcnt(0) lgkmcnt(0)" ::: "memory"); g.sync(); }

constexpr int SMEM_BYTES = 2 * (256 + 128) * LDK * 2;
static_assert(SMEM_BYTES >= 65536 + 32 * 264 * 2 + 1024, "rwkv prep LDS");
__global__ void __launch_bounds__(NTH) fwd_megakernel(Params p) {
  __shared__ __attribute__((aligned(16))) unsigned char smem[SMEM_BYTES];
  cg::grid_group grid = cg::this_grid();
#if PROBE
  if (blockIdx.x == 0 && threadIdx.x < 64) ((float*)(p.ws + OFF_DBG))[threadIdx.x] = 0.f;
#endif
  phase0(p, smem);
  gsync(grid);
  phase_h(p);
  gsync(grid);
  phase_gemm1(p, smem);
  gsync(grid);
  phase_qkv(p);
  phase_rwkv_prep(p, smem);
  gsync(grid);
#if PROBE_NAIVE_SCAN
  phase_scan_naive(p);
#else
  phase_scanA(p, smem);
  gsync(grid);
  phase_scanB(p, smem);
  gsync(grid);
  phase_scanC(p, smem);
#endif
  phase_attn(p, smem);
  gsync(grid);
#if PROBE
  probe_scan(p);
  gsync(grid);
#endif
  phase_final(p, smem);
#if PROBE
  gsync(grid);
  probe_f3(p);
#endif
}

extern "C" void kernel_launch(void* const* d_in, const int* in_sizes, int n_in, void* d_out, int out_size, void* d_ws, size_t ws_size,
                              hipStream_t stream) {
  static int grid_blocks = 0;
  if (!grid_blocks) {
    int dev = 0, cus = 0, per_cu = 0;
    hipGetDevice(&dev);
    hipDeviceGetAttribute(&cus, hipDeviceAttributeMultiprocessorCount, dev);
    hipOccupancyMaxActiveBlocksPerMultiprocessor(&per_cu, fwd_megakernel, NTH, 0);
    if (per_cu < 1) fprintf(stderr, "occupancy query says %d blocks/CU\n", per_cu);
    grid_blocks = cus > 0 ? cus : 256;
    if (ws_size < WS_END) fprintf(stderr, "workspace too small: %zu < %zu\n", ws_size, (size_t)WS_END);
  }
  Params p{};
  const float** fp = (const float**)&p;
  for (int i = 0; i < 27; ++i) fp[i] = (const float*)d_in[i];
  p.out = (float*)d_out;
  p.ws = (unsigned char*)d_ws;
  void* args[] = {&p};
  hipError_t e = hipLaunchCooperativeKernel((void*)fwd_megakernel, dim3(grid_blocks), dim3(NTH), args, 0, stream);
  if (e != hipSuccess) fprintf(stderr, "cooperative launch failed: %s (grid %d)\n", hipGetErrorString(e), grid_blocks);
}
```

```cpp
#include <hip/hip_runtime.h>
#include <hip/hip_cooperative_groups.h>
#include <stdint.h>
#include <cstdio>
namespace cg = cooperative_groups;

#define PROBE 0
#define DI __device__ __forceinline__
typedef __attribute__((ext_vector_type(8))) short bf16x8;
typedef __attribute__((ext_vector_type(16))) float f32x16;
typedef __attribute__((ext_vector_type(16))) uint32_t u32x16;
typedef __attribute__((ext_vector_type(2))) _Float16 h2;
typedef __attribute__((ext_vector_type(2))) __bf16 b2;
typedef unsigned short ushort_t;
typedef __attribute__((ext_vector_type(4))) uint32_t u32x4;
#define MFMA(a, b, c) __builtin_amdgcn_mfma_f32_32x32x16_bf16((a), (b), (c), 0, 0, 0)

constexpr int DM = 1024, NB = 2, SEQ = 16384, CTXL = 256;
constexpr int NX = NB * SEQ, NC = NB * CTXL, NT = NX + NC;
constexpr int INW = 3584, LTOT = CTXL + SEQ;
constexpr int NTH = 512;
constexpr int CH = 260, NCHUNK = LTOT / CH;
static_assert(NCHUNK * CH == LTOT, "chunking");
constexpr float LN_EPS = 1e-5f, QK_EPS = 1e-6f, GN_EPS = 64e-5f;
constexpr float ALPHA = 1.189207115002721f;
constexpr float QSCALE = 0.125f * 1.4426950408889634f;

constexpr size_t OFF_WIN = 0;
constexpr size_t OFF_WMG = OFF_WIN + (size_t)INW * DM * 2;
constexpr size_t OFF_WPA = OFF_WMG + (size_t)2048 * DM * 2;
constexpr size_t OFF_WPB = OFF_WPA + (size_t)1024 * 512 * 2;
constexpr size_t OFF_WO  = OFF_WPB + (size_t)1024 * 512 * 2;
constexpr size_t OFF_WL  = OFF_WO + (size_t)1024 * 1024 * 2;
constexpr size_t OFF_MOD = OFF_WL + (size_t)2 * 2 * 512 * 64 * 2;
constexpr size_t OFF_ZG  = OFF_MOD + 36864;
constexpr size_t OFF_QB  = OFF_ZG + (size_t)NX * 1024 * 2;
constexpr size_t OFF_KB  = OFF_QB + (size_t)NX * 512 * 2;
constexpr size_t OFF_VB  = OFF_KB + (size_t)NB * 2 * LTOT * 64 * 2;
constexpr size_t OFF_SH  = OFF_VB + (size_t)NB * 2 * LTOT * 64 * 2;
constexpr size_t OFF_DR  = OFF_SH + (size_t)16 * LTOT * 192 * 2;
constexpr size_t OFF_ZQ  = OFF_DR + (size_t)32 * LTOT * 192 * 2;
constexpr size_t WS_END  = OFF_ZQ + (size_t)2 * NX * 512 * 2;
static_assert(WS_END <= (size_t)536870912, "workspace");
static_assert((size_t)NT * DM * 2 <= (size_t)48 * LTOT * 192 * 2, "H alias");
static_assert((size_t)NT * 768 * 2 <= (size_t)2 * NX * 512 * 2, "zqkv alias");

struct Params {
  const float *x, *c, *ctx, *c_ctx, *w_ada, *b_ada, *w_in, *q_norm, *k_norm, *mu_prev, *mu_next, *w0, *w_up, *a0, *a_up, *k_k, *k_a,
      *r_k, *gn_w, *gn_b, *w_pa, *w_pb, *w_mg, *b_mg, *w_o, *ln_g, *ln_b;
  float* out;
  unsigned char* ws;
};

DI ushort_t f2bf(float f) { return __builtin_bit_cast(ushort_t, (__bf16)f); }
DI float bf2f(ushort_t b) { return __uint_as_float(((unsigned)b) << 16); }
DI unsigned pack_bf2(float a, float b) { b2 v = {(__bf16)a, (__bf16)b}; return __builtin_bit_cast(unsigned, v); }
DI unsigned pack_h2(float a, float b) { h2 v = {(_Float16)a, (_Float16)b}; return __builtin_bit_cast(unsigned, v); }
DI ushort_t f2h(float f) { return __builtin_bit_cast(ushort_t, (_Float16)f); }
DI float h2f(ushort_t h) { return (float)__builtin_bit_cast(_Float16, h); }
DI float bflo(unsigned u) { return __uint_as_float(u << 16); }
DI float bfhi(unsigned u) { return __uint_as_float(u & 0xffff0000u); }
DI float hlo(unsigned u) { return (float)__builtin_bit_cast(h2, u)[0]; }
DI float hhi(unsigned u) { return (float)__builtin_bit_cast(h2, u)[1]; }
DI float sigmf(float v) { return __builtin_amdgcn_rcpf(1.f + __expf(-v)); }
DI float siluf(float v) { return v * sigmf(v); }
DI int crow(int reg, int h) { return (reg & 3) + 8 * (reg >> 2) + 4 * h; }
DI float wave_sum(float v) {
#pragma unroll
  for (int o = 32; o >= 1; o >>= 1) v += __shfl_xor(v, o, 64);
  return v;
}
DI float sum16(float v) {
#pragma unroll
  for (int o = 8; o >= 1; o >>= 1) v += __shfl_xor(v, o, 64);
  return v;
}
DI float ln_rows4(const float* src, int l16, float4 (&v)[16]) {
  float s = 0.f;
#pragma unroll
  for (int i = 0; i < 16; ++i) { v[i] = *(const float4*)(src + l16 * 4 + 64 * i); s += v[i].x + v[i].y + v[i].z + v[i].w; }
  const float mu = sum16(s) * (1.f / DM);
  float q = 0.f;
#pragma unroll
  for (int i = 0; i < 16; ++i) { v[i].x -= mu; v[i].y -= mu; v[i].z -= mu; v[i].w -= mu; q += v[i].x * v[i].x + v[i].y * v[i].y + v[i].z * v[i].z + v[i].w * v[i].w; }
  return rsqrtf(sum16(q) * (1.f / DM) + LN_EPS);
}
DI f32x16 zero16() { f32x16 z;
#pragma unroll
  for (int i = 0; i < 16; ++i) z[i] = 0.f; return z; }

#define SCAN_VLOAD 0
#define PROBE_NAIVE_SCAN 0
#if SCAN_VLOAD
DI void sload2(u32x16& a0, u32x16& a1, const void* p) { a0 = *(const u32x16*)p; a1 = *((const u32x16*)p + 1); }
DI void sload4(u32x16& a0, u32x16& a1, u32x16& b0, u32x16& b1, const void* p, const void* q) {
  a0 = *(const u32x16*)p; a1 = *((const u32x16*)p + 1); b0 = *(const u32x16*)q; b1 = *((const u32x16*)q + 1);
}
#else
DI void sload2(u32x16& a0, u32x16& a1, const void* p) {
  asm volatile("s_load_dwordx16 %0, %2, 0x0\n\ts_load_dwordx16 %1, %2, 0x40\n\ts_waitcnt lgkmcnt(0)" : "=&s"(a0), "=&s"(a1) : "s"(p) : "memory");
}
DI void sload4(u32x16& a0, u32x16& a1, u32x16& b0, u32x16& b1, const void* p, const void* q) {
  asm volatile("s_load_dwordx16 %0, %4, 0x0\n\ts_load_dwordx16 %1, %4, 0x40\n\ts_load_dwordx16 %2, %5, 0x0\n\ts_load_dwordx16 %3, %5, 0x40\n\ts_waitcnt lgkmcnt(0)"
               : "=&s"(a0), "=&s"(a1), "=&s"(b0), "=&s"(b1) : "s"(p), "s"(q) : "memory");
}
#endif
DI float HV(const u32x16& v, int j) { const uint32_t w = v[j >> 1]; const h2 t = __builtin_bit_cast(h2, w); return (float)t[j & 1]; }

constexpr int LDK = 72;
template <int BM, int BN, int MI, int NI, int NB, class AL, class BL>
DI void gemm_pass(f32x16 (&acc)[NB][MI][NI], AL aload, BL bload, int K, ushort_t* As, ushort_t* Bs, int wrow0, int wcol0, int tid) {
  constexpr int NA = BM * 8 / NTH, NBC = BN * 8 / NTH;
  constexpr int ASZ = BM * LDK, BSZ = NB * BN * LDK;
  const int lane = tid & 63, l31 = lane & 31, hh = lane >> 5;
  const int nk = K >> 6;
  uint4 ra[2][NA], rb[2][NB][NBC];
  auto gload = [&](int s, int kt) {
#pragma unroll
    for (int i = 0; i < NA; ++i) { const int id = tid + i * NTH; ra[s][i] = aload(id >> 3, kt * 64 + (id & 7) * 8); }
#pragma unroll
    for (int w = 0; w < NB; ++w)
#pragma unroll
      for (int i = 0; i < NBC; ++i) { const int id = tid + i * NTH; rb[s][w][i] = bload(w, id >> 3, kt * 64 + (id & 7) * 8); }
  };
  auto lstore = [&](int s, int buf) {
#pragma unroll
    for (int i = 0; i < NA; ++i) { const int id = tid + i * NTH; *(uint4*)&As[buf * ASZ + (id >> 3) * LDK + (id & 7) * 8] = ra[s][i]; }
#pragma unroll
    for (int w = 0; w < NB; ++w)
#pragma unroll
      for (int i = 0; i < NBC; ++i) { const int id = tid + i * NTH; *(uint4*)&Bs[buf * BSZ + w * BN * LDK + (id >> 3) * LDK + (id & 7) * 8] = rb[s][w][i]; }
  };
  auto compute = [&](int buf) {
#pragma unroll
    for (int ks = 0; ks < 4; ++ks) {
      bf16x8 af[MI];
#pragma unroll
      for (int mi = 0; mi < MI; ++mi) af[mi] = *(const bf16x8*)&As[buf * ASZ + (wrow0 + mi * 32 + l31) * LDK + ks * 16 + hh * 8];
#pragma unroll
      for (int w = 0; w < NB; ++w) {
        bf16x8 bfv[NI];
#pragma unroll
        for (int ni = 0; ni < NI; ++ni) bfv[ni] = *(const bf16x8*)&Bs[buf * BSZ + w * BN * LDK + (wcol0 + ni * 32 + l31) * LDK + ks * 16 + hh * 8];
#pragma unroll
        for (int mi = 0; mi < MI; ++mi)
#pragma unroll
          for (int ni = 0; ni < NI; ++ni) acc[w][mi][ni] = MFMA(af[mi], bfv[ni], acc[w][mi][ni]);
      }
    }
  };
  __syncthreads();
  gload(0, 0);
  lstore(0, 0);
  gload(1, 1);
  gload(0, 2);
#pragma unroll 1
  for (int kt = 0; kt < nk; kt += 2) {
    __syncthreads();
    lstore(1, 1);
    if (kt + 3 < nk) gload(1, kt + 3);
    compute(0);
    __syncthreads();
    if (kt + 2 < nk) { lstore(0, 0); if (kt + 4 < nk) gload(0, kt + 4); }
    compute(1);
  }
}

DI void transpose_tile(const float* __restrict__ src, int ld_src, ushort_t* dst, int ld_dst, int k0, int n0, float* T) {
  const int tid = threadIdx.x;
#pragma unroll
  for (int i = 0; i < 2; ++i) {
    const int k = (tid >> 4) + 32 * i, n4 = (tid & 15) * 4;
    const float4 v = *(const float4*)(src + (size_t)(k0 + k) * ld_src + n0 + n4);
    T[k * 65 + n4 + 0] = v.x; T[k * 65 + n4 + 1] = v.y; T[k * 65 + n4 + 2] = v.z; T[k * 65 + n4 + 3] = v.w;
  }
  __syncthreads();
  const int n = tid >> 3, kc = tid & 7;
  uint4 o;
  o.x = pack_bf2(T[(kc * 8 + 0) * 65 + n], T[(kc * 8 + 1) * 65 + n]);
  o.y = pack_bf2(T[(kc * 8 + 2) * 65 + n], T[(kc * 8 + 3) * 65 + n]);
  o.z = pack_bf2(T[(kc * 8 + 4) * 65 + n], T[(kc * 8 + 5) * 65 + n]);
  o.w = pack_bf2(T[(kc * 8 + 6) * 65 + n], T[(kc * 8 + 7) * 65 + n]);
  *(uint4*)(dst + (size_t)(n0 + n) * ld_dst + k0 + kc * 8) = o;
  __syncthreads();
}

DI void phase0(const Params& p, unsigned char* smem) {
  float* T = (float*)smem;
  ushort_t* win = (ushort_t*)(p.ws + OFF_WIN);
  ushort_t* wmg = (ushort_t*)(p.ws + OFF_WMG);
  ushort_t* wpa = (ushort_t*)(p.ws + OFF_WPA);
  ushort_t* wpb = (ushort_t*)(p.ws + OFF_WPB);
  ushort_t* wo = (ushort_t*)(p.ws + OFF_WO);
  ushort_t* wl = (ushort_t*)(p.ws + OFF_WL);
  float* mod = (float*)(p.ws + OFF_MOD);
  constexpr int T_IN = 16 * 56, T_MG = 16 * 32, T_PA = 8 * 16, T_PB = 8 * 16, T_O = 16 * 16, T_L = 32, T_MOD = 48;
  constexpr int TOTAL = T_MOD + T_IN + T_MG + T_PA + T_PB + T_O + T_L;
  for (int t = blockIdx.x; t < TOTAL; t += gridDim.x) {
    int u = t;
    if (u < T_MOD) {
      float* sil = T;
      float* red = T + 3072;
      const int tid = threadIdx.x;
      for (int i = tid; i < 3072; i += NTH) {
        const int v = i >> 10, k = i & 1023;
        const float cv = (v < 2) ? p.c[v * 1024 + k] : p.c_ctx[k];
        sil[i] = siluf(cv);
      }
      __syncthreads();
      const int n = tid & 63, ksl = tid >> 6, n0 = u * 64;
      float a0 = 0.f, a1 = 0.f, a2 = 0.f;
      for (int k = ksl * 128; k < ksl * 128 + 128; ++k) {
        const float w = p.w_ada[(size_t)k * 3072 + n0 + n];
        a0 = fmaf(sil[k], w, a0); a1 = fmaf(sil[1024 + k], w, a1); a2 = fmaf(sil[2048 + k], w, a2);
      }
      red[(ksl * 3 + 0) * 64 + n] = a0; red[(ksl * 3 + 1) * 64 + n] = a1; red[(ksl * 3 + 2) * 64 + n] = a2;
      __syncthreads();
      if (tid < 192) {
        const int v = tid >> 6, nn = tid & 63;
        float s = 0.f;
#pragma unroll
        for (int q = 0; q < 8; ++q) s += red[(q * 3 + v) * 64 + nn];
        mod[v * 3072 + n0 + nn] = s + p.b_ada[n0 + nn];
      }
      __syncthreads();
      continue;
    }
    u -= T_MOD;
    if (u < T_IN) { transpose_tile(p.w_in, INW, win, 1024, (u / 56) * 64, (u % 56) * 64, T); continue; }
    u -= T_IN;
    if (u < T_MG) { transpose_tile(p.w_mg, 2048, wmg, 1024, (u / 32) * 64, (u % 32) * 64, T); continue; }
    u -= T_MG;
    if (u < T_PA) { transpose_tile(p.w_pa, 1024, wpa, 512, (u / 16) * 64, (u % 16) * 64, T); continue; }
    u -= T_PA;
    if (u < T_PB) { transpose_tile(p.w_pb, 1024, wpb, 512, (u / 16) * 64, (u % 16) * 64, T); continue; }
    u -= T_PB;
    if (u < T_O) { transpose_tile(p.w_o, 1024, wo, 1024, (u / 16) * 64, (u % 16) * 64, T); continue; }
    u -= T_O;
    {
      const int which = u >> 4, dir = (u >> 3) & 1, nt = u & 7;
      const float* src = (which ? p.a_up : p.w_up) + (size_t)dir * 64 * 512;
      transpose_tile(src, 512, wl + (size_t)((dir * 2 + which) * 512) * 64, 64, 0, nt * 64, T);
    }
  }
}

DI void phase_h(const Params& p) {
  const float* mod = (const float*)(p.ws + OFF_MOD);
  ushort_t* H = (ushort_t*)(p.ws + OFF_SH);
  const int lane = threadIdx.x & 63, l16 = lane & 15, gw = blockIdx.x * 8 + (threadIdx.x >> 6);
#pragma unroll 1
  for (int r4 = gw * 4; r4 < NT; r4 += gridDim.x * 32) {
    const int row = r4 + (lane >> 4);
    const float* src = (row < NX) ? p.x + (size_t)row * DM : p.ctx + (size_t)(row - NX) * DM;
    const float* md = mod + ((row < NX) ? (row / SEQ) : 2) * 3072;
    float4 v[16];
    const float rstd = ln_rows4(src, l16, v);
#pragma unroll
    for (int i = 0; i < 16; ++i) {
      const int col = l16 * 4 + 64 * i;
      const float4 sh = *(const float4*)(md + col), sc = *(const float4*)(md + 1024 + col);
      uint2 o;
      o.x = pack_bf2(v[i].x * rstd * (1.f + sc.x) + sh.x, v[i].y * rstd * (1.f + sc.y) + sh.y);
      o.y = pack_bf2(v[i].z * rstd * (1.f + sc.z) + sh.z, v[i].w * rstd * (1.f + sc.w) + sh.w);
      *(uint2*)(H + (size_t)row * DM + col) = o;
    }
  }
}

DI void phase_gemm1(const Params& p, unsigned char* smem) {
  ushort_t* As = (ushort_t*)smem;
  ushort_t* Bs = As + 2 * 256 * LDK;
  const ushort_t* H = (const ushort_t*)(p.ws + OFF_SH);
  const ushort_t* W = (const ushort_t*)(p.ws + OFF_WIN);
  ushort_t* zq = (ushort_t*)(p.ws + OFF_ZQ);
  ushort_t* zg = (ushort_t*)(p.ws + OFF_ZG);
  ushort_t* zm = (ushort_t*)p.out;
  const int tid = threadIdx.x, wave = tid >> 6, lane = tid & 63, l31 = lane & 31, hh = lane >> 5;
  const int wrow0 = (wave & 3) * 64, wcol0 = (wave >> 2) * 64;
  constexpr int MT = NT / 256, NTL = INW / 128;
  for (int t = blockIdx.x; t < MT * NTL; t += gridDim.x) {
    const int mt = t / NTL, nt = t % NTL;
    const bool is_g = (nt >= 6 && nt < 10) || nt >= 24;
    if (is_g && mt >= NX / 256) continue;
    const int row0 = mt * 256, col0 = nt * 128;
    f32x16 acc[1][2][2];
#pragma unroll
    for (int a = 0; a < 2; ++a)
#pragma unroll
      for (int b = 0; b < 2; ++b) acc[0][a][b] = zero16();
    auto aload = [&](int r, int k) { return *(const uint4*)(H + (size_t)(row0 + r) * DM + k); };
    auto bload = [&](int w, int n, int k) { return *(const uint4*)(W + (size_t)(col0 + n) * DM + k); };
    gemm_pass<256, 128, 2, 2, 1>(acc, aload, bload, DM, As, Bs, wrow0, wcol0, tid);
    ushort_t* dst; int ld, cbase;
    if (nt < 6) { dst = zq; ld = 768; cbase = col0; }
    else if (nt < 10) { dst = zg; ld = 1024; cbase = col0 - 768; }
    else if (nt < 24) { dst = zm; ld = 1792; cbase = col0 - 1280; }
    else { dst = zg; ld = 1024; cbase = 512 + col0 - 3072; }
#pragma unroll
    for (int mi = 0; mi < 2; ++mi)
#pragma unroll
      for (int ni = 0; ni < 2; ++ni)
#pragma unroll
        for (int i = 0; i < 16; ++i) {
          const int row = row0 + wrow0 + mi * 32 + crow(i, hh), col = cbase + wcol0 + ni * 32 + l31;
          dst[(size_t)row * ld + col] = f2bf(acc[0][mi][ni][i]);
        }
  }
}

DI int vperm(int key) { const int g = key >> 4, kq = key & 15; return g * 16 + 8 * ((kq >> 2) & 1) + (kq & 3) + 4 * (kq >> 3); }
DI void phase_qkv(const Params& p) {
  const ushort_t* zq = (const ushort_t*)(p.ws + OFF_ZQ);
  ushort_t* QB = (ushort_t*)(p.ws + OFF_QB);
  ushort_t* KB = (ushort_t*)(p.ws + OFF_KB);
  ushort_t* VB = (ushort_t*)(p.ws + OFF_VB);
  const int lane = threadIdx.x & 63, gw = blockIdx.x * 8 + (threadIdx.x >> 6);
  const int j = lane & 31, half = lane >> 5, axis = j >> 4, f = j & 15;
  const int d1 = axis * 32 + f, d2 = d1 + 16;
  const float inv = powf(10000.f, -(float)f * (1.f / 16.f));
  const float gq1 = p.q_norm[d1], gq2 = p.q_norm[d2], gk1 = p.k_norm[d1], gk2 = p.k_norm[d2];
  for (int row = gw; row < NT; row += gridDim.x * 8) {
    const bool isx = row < NX;
    const int b = isx ? row / SEQ : (row - NX) / CTXL;
    const int t = isx ? row % SEQ : (row - NX) % CTXL;
    const int pos = isx ? CTXL + t : t;
    const ushort_t* z = zq + (size_t)row * 768;
    float cs = 1.f, sn = 0.f;
    if (isx) { const float ang = (float)(axis ? (t & 63) : (t >> 6)) * inv; sincosf(ang, &sn, &cs); }
#pragma unroll
    for (int it = 0; it < 5; ++it) {
      const int hd = it * 2 + half;
      if (!isx && hd < 8) continue;
      const float v1 = bf2f(z[hd * 64 + d1]), v2 = bf2f(z[hd * 64 + d2]);
      float ss = v1 * v1 + v2 * v2;
#pragma unroll
      for (int o = 16; o >= 1; o >>= 1) ss += __shfl_xor(ss, o, 64);
      const float rms = rsqrtf(ss * (1.f / 64.f) + QK_EPS);
      const bool isq = hd < 8;
      const float y1 = v1 * rms * (isq ? gq1 : gk1), y2 = v2 * rms * (isq ? gq2 : gk2);
      float o1 = y1 * cs - y2 * sn, o2 = y2 * cs + y1 * sn;
      if (isq) {
        ushort_t* dst = QB + ((size_t)(b * 8 + hd) * SEQ + t) * 64;
        dst[d1] = f2bf(o1 * QSCALE); dst[d2] = f2bf(o2 * QSCALE);
      } else {
        ushort_t* dst = KB + ((size_t)(b * 2 + (hd - 8)) * LTOT + pos) * 64;
        dst[d1] = f2bf(o1); dst[d2] = f2bf(o2);
      }
    }
    {
      const size_t tb = (size_t)(pos >> 6) * 4096 + lane * 64 + vperm(pos & 63);
      VB[(size_t)(b * 2 + 0) * LTOT * 64 + tb] = z[640 + lane];
      VB[(size_t)(b * 2 + 1) * LTOT * 64 + tb] = z[704 + lane];
    }
  }
}

DI void phase_rwkv_prep(const Params& p, unsigned char* smem) {
  float* kbuf = (float*)smem;
  ushort_t* codes = (ushort_t*)(smem + 65536);
  float* invn = (float*)(smem + 65536 + 32 * 264 * 2);
  const ushort_t* zm = (const ushort_t*)p.out;
  const ushort_t* WL = (const ushort_t*)(p.ws + OFF_WL);
  ushort_t* SH = (ushort_t*)(p.ws + OFF_SH);
  ushort_t* DR = (ushort_t*)(p.ws + OFF_DR);
  const int tid = threadIdx.x, wave = tid >> 6, lane = tid & 63, l31 = lane & 31, hh = lane >> 5;
  for (int tt = blockIdx.x; tt < NT / 32; tt += gridDim.x) {
    const int row0 = tt * 32;
    int b, t0, len, pbase;
    if (row0 < NX) { b = row0 / SEQ; t0 = row0 % SEQ; len = SEQ; pbase = CTXL; }
    else { const int rc = row0 - NX; b = rc / CTXL; t0 = rc % CTXL; len = CTXL; pbase = 0; }
    __syncthreads();
    for (int id = tid; id < 32 * 224; id += NTH) {
      const int i = id / 224, c0 = (id % 224) * 8;
      const int t = t0 + i;
      const ushort_t* zr = zm + (size_t)(row0 + i) * 1792 + c0;
      const uint4 zc = *(const uint4*)zr;
      uint4 zp = make_uint4(0, 0, 0, 0), zn = make_uint4(0, 0, 0, 0);
      if (t > 0) zp = *(const uint4*)(zr - 1792);
      if (t < len - 1) zn = *(const uint4*)(zr + 1792);
      const float4 mp0 = *(const float4*)(p.mu_prev + c0), mp1 = *(const float4*)(p.mu_prev + c0 + 4);
      const float4 mn0 = *(const float4*)(p.mu_next + c0), mn1 = *(const float4*)(p.mu_next + c0 + 4);
      const unsigned zcw[4] = {zc.x, zc.y, zc.z, zc.w}, zpw[4] = {zp.x, zp.y, zp.z, zp.w}, znw[4] = {zn.x, zn.y, zn.z, zn.w};
      const float mpv[8] = {mp0.x, mp0.y, mp0.z, mp0.w, mp1.x, mp1.y, mp1.z, mp1.w};
      const float mnv[8] = {mn0.x, mn0.y, mn0.z, mn0.w, mn1.x, mn1.y, mn1.z, mn1.w};
      float s[8];
#pragma unroll
      for (int q = 0; q < 4; ++q) {
        const float c_lo = bflo(zcw[q]), c_hi = bfhi(zcw[q]);
        s[2 * q] = c_lo + mpv[2 * q] * (bflo(zpw[q]) - c_lo) + mnv[2 * q] * (bflo(znw[q]) - c_lo);
        s[2 * q + 1] = c_hi + mpv[2 * q + 1] * (bfhi(zpw[q]) - c_hi) + mnv[2 * q + 1] * (bfhi(znw[q]) - c_hi);
      }
      const int pp = pbase + t;
      if (c0 < 512 || (c0 >= 1024 && c0 < 1536)) {
        const int cc = (c0 < 512) ? c0 : c0 - 1024, which = (c0 < 512) ? 1 : 2;
        const int head = cc >> 6, d = cc & 63;
        uint4 o;
        o.x = pack_h2(s[0], s[1]); o.y = pack_h2(s[2], s[3]); o.z = pack_h2(s[4], s[5]); o.w = pack_h2(s[6], s[7]);
        *(uint4*)(SH + (((size_t)(b * 8 + head) * LTOT + pp) * 3 + which) * 64 + d) = o;
      } else if (c0 < 1024) {
        float* kd = kbuf + i * 512 + (c0 - 512);
        *(float4*)kd = make_float4(s[0], s[1], s[2], s[3]);
        *(float4*)(kd + 4) = make_float4(s[4], s[5], s[6], s[7]);
      } else {
        const int cc = c0 - 1536;
        if (cc < 128) {
#pragma unroll
          for (int q = 0; q < 8; ++q) s[q] = tanhf(s[q]);
        }
        uint4 o;
        o.x = pack_bf2(s[0], s[1]); o.y = pack_bf2(s[2], s[3]); o.z = pack_bf2(s[4], s[5]); o.w = pack_bf2(s[6], s[7]);
        *(uint4*)(codes + i * 264 + cc) = o;
      }
    }
    __syncthreads();
    {
      const int i = tid >> 4, head = (tid >> 1) & 7, hf = tid & 1;
      float ss = 0.f;
#pragma unroll 8
      for (int q = 0; q < 32; ++q) {
        const int n = head * 64 + hf * 32 + q;
        const float v = kbuf[i * 512 + n] * p.k_k[n];
        ss = fmaf(v, v, ss);
      }
      ss += __shfl_xor(ss, 1, 64);
      if (hf == 0) invn[i * 8 + head] = 1.f / fmaxf(sqrtf(ss), 1e-12f);
    }
    __syncthreads();
#pragma unroll 1
    for (int q4 = 0; q4 < 4; ++q4) {
      const int pr = wave * 4 + q4, dir = pr >> 4, ct = pr & 15;
      f32x16 aw = zero16(), aa = zero16();
#pragma unroll
      for (int ks = 0; ks < 4; ++ks) {
        const bf16x8 fw = *(const bf16x8*)&codes[l31 * 264 + dir * 64 + ks * 16 + hh * 8];
        const bf16x8 fa = *(const bf16x8*)&codes[l31 * 264 + 128 + dir * 64 + ks * 16 + hh * 8];
        const bf16x8 bw = *(const bf16x8*)&WL[(size_t)((dir * 2 + 0) * 512 + ct * 32 + l31) * 64 + ks * 16 + hh * 8];
        const bf16x8 ba = *(const bf16x8*)&WL[(size_t)((dir * 2 + 1) * 512 + ct * 32 + l31) * 64 + ks * 16 + hh * 8];
        aw = MFMA(fw, bw, aw);
        aa = MFMA(fa, ba, aa);
      }
      const int n = ct * 32 + l31, head = n >> 6, d = n & 63;
      const float w0v = p.w0[dir * 512 + n], a0v = p.a0[dir * 512 + n], kkw = p.k_k[n], kaw = p.k_a[n];
      const size_t cbase = (size_t)(b * 8 + head) * LTOT;
#pragma unroll
      for (int i = 0; i < 16; ++i) {
        const int ti = crow(i, hh);
        const int pp = pbase + t0 + ti;
        const float wpre = aw[i] + w0v;
        const float e = 0.60653065971263342f * sigmf(wpre);
        const float xdec = 1.f - __expf(-e);
        const float a = sigmf(aa[i] + a0v);
        const float kv = kbuf[ti * 512 + n];
        const float kkv = kv * kkw * invn[ti * 8 + head];
        const float kd = kv * (1.f + (a - 1.f) * kaw);
        ushort_t* dr = DR + ((((size_t)dir * 16) * LTOT + cbase + pp) * 3) * 64 + d;
        dr[0] = f2h(-xdec); dr[64] = f2h(kd); dr[128] = f2h(kkv * a);
        if (dir == 0) SH[((cbase + pp) * 3) * 64 + d] = f2h(kkv);
      }
    }
  }
}

DI int tau_to_pos(int dir, int tau) { return dir == 0 ? tau : (tau < CTXL ? CTXL - 1 - tau : LTOT - 1 - (tau - CTXL)); }


DI void fm_lo(float& acc, float a, uint32_t w) { asm("v_fma_mix_f32 %0, %1, %2, %0 op_sel_hi:[0,1,0]" : "+v"(acc) : "v"(a), "s"(w)); }
DI void fm_hi(float& acc, float a, uint32_t w) { asm("v_fma_mix_f32 %0, %1, %2, %0 op_sel:[0,1,0] op_sel_hi:[0,1,0]" : "+v"(acc) : "v"(a), "s"(w)); }
DI void fx_lo(float& s, uint32_t w) { asm("v_fma_mix_f32 %0, %0, %1, %0 op_sel_hi:[0,1,0]" : "+v"(s) : "s"(w)); }
DI void fx_hi(float& s, uint32_t w) { asm("v_fma_mix_f32 %0, %0, %1, %0 op_sel:[0,1,0] op_sel_hi:[0,1,0]" : "+v"(s) : "s"(w)); }
constexpr int PFD = 8, SEG = 65;
static_assert(CH % SEG == 0, "segments");
DI void scan_prefetch(u32x4& pfr, const ushort_t* shc, const ushort_t* drc, int pos, int lane) {
  const ushort_t* a = (lane < 24) ? shc + (size_t)pos * 192 + lane * 8 : drc + (size_t)pos * 192 + (lane < 48 ? lane - 24 : 23) * 8;
  asm volatile("global_load_dwordx4 %0, %1, off" : "+v"(pfr) : "v"(a) : "memory");
}
DI void scan_stage_v(ushort_t* vbuf, const ushort_t* shc, int dir, int tau0, int lane) {
#pragma unroll
  for (int i = 0; i < (SEG * 8 + 63) / 64; ++i) {
    const int id = i * 64 + lane, st = id >> 3;
    if (st < SEG) *(uint4*)&vbuf[st * 64 + (id & 7) * 8] = *(const uint4*)(shc + (size_t)tau_to_pos(dir, tau0 + st) * 192 + 128 + (id & 7) * 8);
  }
}
struct ScanRec { uint32_t sh, dr, bb; ushort_t v; };
DI ScanRec scan_load(const ushort_t* shc, const ushort_t* drc, int pos, int lane) {
  ScanRec r;
  const ushort_t* s = shc + (size_t)pos * 192;
  const uint32_t* d = (const uint32_t*)(drc + (size_t)pos * 192);
  r.sh = ((const uint32_t*)s)[lane];
  r.v = s[128 + lane];
  r.dr = d[lane];
  r.bb = d[64 + (lane & 31)];
  return r;
}
#define MIXLO " op_sel_hi:[0,1,0]\n\t"
#define MIXHI " op_sel:[0,1,0] op_sel_hi:[0,1,0]\n\t"
template <int L>
DI void dot4(float& a0, float& a1, float& a2, float& a3, float (&S)[64], uint32_t src) {
  uint32_t t0, t1, t2, t3;
  asm("v_readlane_b32 %4, %8, %9\n\tv_readlane_b32 %5, %8, %10\n\tv_readlane_b32 %6, %8, %11\n\tv_readlane_b32 %7, %8, %12\n\t"
      "v_fma_mix_f32 %0, %13, %4, %0" MIXLO "v_fma_mix_f32 %1, %14, %4, %1" MIXHI
      "v_fma_mix_f32 %2, %15, %5, %2" MIXLO "v_fma_mix_f32 %3, %16, %5, %3" MIXHI
      "v_fma_mix_f32 %0, %17, %6, %0" MIXLO "v_fma_mix_f32 %1, %18, %6, %1" MIXHI
      "v_fma_mix_f32 %2, %19, %7, %2" MIXLO "v_fma_mix_f32 %3, %20, %7, %3" MIXHI
      : "+v"(a0), "+v"(a1), "+v"(a2), "+v"(a3), "=&s"(t0), "=&s"(t1), "=&s"(t2), "=&s"(t3)
      : "v"(src), "n"(L), "n"(L + 1), "n"(L + 2), "n"(L + 3),
        "v"(S[2 * (L & 31)]), "v"(S[2 * (L & 31) + 1]), "v"(S[2 * (L & 31) + 2]), "v"(S[2 * (L & 31) + 3]),
        "v"(S[2 * (L & 31) + 4]), "v"(S[2 * (L & 31) + 5]), "v"(S[2 * (L & 31) + 6]), "v"(S[2 * (L & 31) + 7]));
}
template <int L>
DI void upd4(float (&S)[64], uint32_t dr, uint32_t bb, float vv, float nsk) {
  uint32_t x0, x1, x2, x3, k0, k1, k2, k3, b0, b1, b2, b3;
  asm("v_readlane_b32 %8, %20, %22\n\tv_readlane_b32 %9, %20, %23\n\tv_readlane_b32 %10, %20, %24\n\tv_readlane_b32 %11, %20, %25\n\t"
      "v_readlane_b32 %12, %20, %26\n\tv_readlane_b32 %13, %20, %27\n\tv_readlane_b32 %14, %20, %28\n\tv_readlane_b32 %15, %20, %29\n\t"
      "v_readlane_b32 %16, %21, %22\n\tv_readlane_b32 %17, %21, %23\n\tv_readlane_b32 %18, %21, %24\n\tv_readlane_b32 %19, %21, %25\n\t"
      "v_fma_mix_f32 %0, %0, %8, %0" MIXLO "v_fma_mix_f32 %1, %1, %8, %1" MIXHI
      "v_fma_mix_f32 %2, %2, %9, %2" MIXLO "v_fma_mix_f32 %3, %3, %9, %3" MIXHI
      "v_fma_mix_f32 %4, %4, %10, %4" MIXLO "v_fma_mix_f32 %5, %5, %10, %5" MIXHI
      "v_fma_mix_f32 %6, %6, %11, %6" MIXLO "v_fma_mix_f32 %7, %7, %11, %7" MIXHI
      "v_fma_mix_f32 %0, %30, %12, %0" MIXLO "v_fma_mix_f32 %1, %30, %12, %1" MIXHI
      "v_fma_mix_f32 %2, %30, %13, %2" MIXLO "v_fma_mix_f32 %3, %30, %13, %3" MIXHI
      "v_fma_mix_f32 %4, %30, %14, %4" MIXLO "v_fma_mix_f32 %5, %30, %14, %5" MIXHI
      "v_fma_mix_f32 %6, %30, %15, %6" MIXLO "v_fma_mix_f32 %7, %30, %15, %7" MIXHI
      "v_fma_mix_f32 %0, %31, %16, %0" MIXLO "v_fma_mix_f32 %1, %31, %16, %1" MIXHI
      "v_fma_mix_f32 %2, %31, %17, %2" MIXLO "v_fma_mix_f32 %3, %31, %17, %3" MIXHI
      "v_fma_mix_f32 %4, %31, %18, %4" MIXLO "v_fma_mix_f32 %5, %31, %18, %5" MIXHI
      "v_fma_mix_f32 %6, %31, %19, %6" MIXLO "v_fma_mix_f32 %7, %31, %19, %7" MIXHI
      : "+v"(S[2 * L]), "+v"(S[2 * L + 1]), "+v"(S[2 * L + 2]), "+v"(S[2 * L + 3]), "+v"(S[2 * L + 4]), "+v"(S[2 * L + 5]), "+v"(S[2 * L + 6]), "+v"(S[2 * L + 7]),
        "=&s"(x0), "=&s"(x1), "=&s"(x2), "=&s"(x3), "=&s"(k0), "=&s"(k1), "=&s"(k2), "=&s"(k3), "=&s"(b0), "=&s"(b1), "=&s"(b2), "=&s"(b3)
      : "v"(dr), "v"(bb), "n"(L), "n"(L + 1), "n"(L + 2), "n"(L + 3), "n"(L + 32), "n"(L + 33), "n"(L + 34), "n"(L + 35), "v"(vv), "v"(nsk));
}
template <int L>
DI void dot4_2(float& a0, float& a1, float& c0, float& c1, float (&SU)[64], float (&SP)[64], uint32_t src) {
  uint32_t t0, t1, t2, t3;
  asm("v_readlane_b32 %4, %8, %9\n\tv_readlane_b32 %5, %8, %10\n\tv_readlane_b32 %6, %8, %11\n\tv_readlane_b32 %7, %8, %12\n\t"
      "v_fma_mix_f32 %0, %13, %4, %0" MIXLO "v_fma_mix_f32 %1, %14, %4, %1" MIXHI
      "v_fma_mix_f32 %2, %21, %4, %2" MIXLO "v_fma_mix_f32 %3, %22, %4, %3" MIXHI
      "v_fma_mix_f32 %0, %15, %5, %0" MIXLO "v_fma_mix_f32 %1, %16, %5, %1" MIXHI
      "v_fma_mix_f32 %2, %23, %5, %2" MIXLO "v_fma_mix_f32 %3, %24, %5, %3" MIXHI
      "v_fma_mix_f32 %0, %17, %6, %0" MIXLO "v_fma_mix_f32 %1, %18, %6, %1" MIXHI
      "v_fma_mix_f32 %2, %25, %6, %2" MIXLO "v_fma_mix_f32 %3, %26, %6, %3" MIXHI
      "v_fma_mix_f32 %0, %19, %7, %0" MIXLO "v_fma_mix_f32 %1, %20, %7, %1" MIXHI
      "v_fma_mix_f32 %2, %27, %7, %2" MIXLO "v_fma_mix_f32 %3, %28, %7, %3" MIXHI
      : "+v"(a0), "+v"(a1), "+v"(c0), "+v"(c1), "=&s"(t0), "=&s"(t1), "=&s"(t2), "=&s"(t3)
      : "v"(src), "n"(L), "n"(L + 1), "n"(L + 2), "n"(L + 3),
        "v"(SU[2 * L]), "v"(SU[2 * L + 1]), "v"(SU[2 * L + 2]), "v"(SU[2 * L + 3]), "v"(SU[2 * L + 4]), "v"(SU[2 * L + 5]), "v"(SU[2 * L + 6]), "v"(SU[2 * L + 7]),
        "v"(SP[2 * L]), "v"(SP[2 * L + 1]), "v"(SP[2 * L + 2]), "v"(SP[2 * L + 3]), "v"(SP[2 * L + 4]), "v"(SP[2 * L + 5]), "v"(SP[2 * L + 6]), "v"(SP[2 * L + 7]));
}
template <int L>
DI void upd4_2(float (&SU)[64], float (&SP)[64], uint32_t dr, uint32_t bb, float vv, float nskU, float nskP) {
  uint32_t x0, x1, x2, x3, k0, k1, k2, k3, b0, b1, b2, b3;
  asm("v_readlane_b32 %16, %28, %30\n\tv_readlane_b32 %17, %28, %31\n\tv_readlane_b32 %18, %28, %32\n\tv_readlane_b32 %19, %28, %33\n\t"
      "v_readlane_b32 %20, %28, %34\n\tv_readlane_b32 %21, %28, %35\n\tv_readlane_b32 %22, %28, %36\n\tv_readlane_b32 %23, %28, %37\n\t"
      "v_readlane_b32 %24, %29, %30\n\tv_readlane_b32 %25, %29, %31\n\tv_readlane_b32 %26, %29, %32\n\tv_readlane_b32 %27, %29, %33\n\t"
      "v_fma_mix_f32 %0, %0, %16, %0" MIXLO "v_fma_mix_f32 %1, %1, %16, %1" MIXHI
      "v_fma_mix_f32 %2, %2, %17, %2" MIXLO "v_fma_mix_f32 %3, %3, %17, %3" MIXHI
      "v_fma_mix_f32 %4, %4, %18, %4" MIXLO "v_fma_mix_f32 %5, %5, %18, %5" MIXHI
      "v_fma_mix_f32 %6, %6, %19, %6" MIXLO "v_fma_mix_f32 %7, %7, %19, %7" MIXHI
      "v_fma_mix_f32 %8, %8, %16, %8" MIXLO "v_fma_mix_f32 %9, %9, %16, %9" MIXHI
      "v_fma_mix_f32 %10, %10, %17, %10" MIXLO "v_fma_mix_f32 %11, %11, %17, %11" MIXHI
      "v_fma_mix_f32 %12, %12, %18, %12" MIXLO "v_fma_mix_f32 %13, %13, %18, %13" MIXHI
      "v_fma_mix_f32 %14, %14, %19, %14" MIXLO "v_fma_mix_f32 %15, %15, %19, %15" MIXHI
      "v_fma_mix_f32 %0, %38, %20, %0" MIXLO "v_fma_mix_f32 %1, %38, %20, %1" MIXHI
      "v_fma_mix_f32 %2, %38, %21, %2" MIXLO "v_fma_mix_f32 %3, %38, %21, %3" MIXHI
      "v_fma_mix_f32 %4, %38, %22, %4" MIXLO "v_fma_mix_f32 %5, %38, %22, %5" MIXHI
      "v_fma_mix_f32 %6, %38, %23, %6" MIXLO "v_fma_mix_f32 %7, %38, %23, %7" MIXHI
      "v_fma_mix_f32 %0, %39, %24, %0" MIXLO "v_fma_mix_f32 %1, %39, %24, %1" MIXHI
      "v_fma_mix_f32 %2, %39, %25, %2" MIXLO "v_fma_mix_f32 %3, %39, %25, %3" MIXHI
      "v_fma_mix_f32 %4, %39, %26, %4" MIXLO "v_fma_mix_f32 %5, %39, %26, %5" MIXHI
      "v_fma_mix_f32 %6, %39, %27, %6" MIXLO "v_fma_mix_f32 %7, %39, %27, %7" MIXHI
      "v_fma_mix_f32 %8, %40, %24, %8" MIXLO "v_fma_mix_f32 %9, %40, %24, %9" MIXHI
      "v_fma_mix_f32 %10, %40, %25, %10" MIXLO "v_fma_mix_f32 %11, %40, %25, %11" MIXHI
      "v_fma_mix_f32 %12, %40, %26, %12" MIXLO "v_fma_mix_f32 %13, %40, %26, %13" MIXHI
      "v_fma_mix_f32 %14, %40, %27, %14" MIXLO "v_fma_mix_f32 %15, %40, %27, %15" MIXHI
      : "+v"(SU[2 * L]), "+v"(SU[2 * L + 1]), "+v"(SU[2 * L + 2]), "+v"(SU[2 * L + 3]), "+v"(SU[2 * L + 4]), "+v"(SU[2 * L + 5]), "+v"(SU[2 * L + 6]), "+v"(SU[2 * L + 7]),
        "+v"(SP[2 * L]), "+v"(SP[2 * L + 1]), "+v"(SP[2 * L + 2]), "+v"(SP[2 * L + 3]), "+v"(SP[2 * L + 4]), "+v"(SP[2 * L + 5]), "+v"(SP[2 * L + 6]), "+v"(SP[2 * L + 7]),
        "=&s"(x0), "=&s"(x1), "=&s"(x2), "=&s"(x3), "=&s"(k0), "=&s"(k1), "=&s"(k2), "=&s"(k3), "=&s"(b0), "=&s"(b1), "=&s"(b2), "=&s"(b3)
      : "v"(dr), "v"(bb), "n"(L), "n"(L + 1), "n"(L + 2), "n"(L + 3), "n"(L + 32), "n"(L + 33), "n"(L + 34), "n"(L + 35), "v"(vv), "v"(nskU), "v"(nskP));
}
DI void scan_step2(float (&SU)[64], float (&SP)[64], const ScanRec& c, float vv) {
  float a0 = 0.f, a1 = 0.f, c0 = 0.f, c1 = 0.f;
  dot4_2<0>(a0, a1, c0, c1, SU, SP, c.sh); dot4_2<4>(a0, a1, c0, c1, SU, SP, c.sh); dot4_2<8>(a0, a1, c0, c1, SU, SP, c.sh); dot4_2<12>(a0, a1, c0, c1, SU, SP, c.sh);
  dot4_2<16>(a0, a1, c0, c1, SU, SP, c.sh); dot4_2<20>(a0, a1, c0, c1, SU, SP, c.sh); dot4_2<24>(a0, a1, c0, c1, SU, SP, c.sh); dot4_2<28>(a0, a1, c0, c1, SU, SP, c.sh);
  const float nU = -(a0 + a1), nP = -(c0 + c1);
  upd4_2<0>(SU, SP, c.dr, c.bb, vv, nU, nP); upd4_2<4>(SU, SP, c.dr, c.bb, vv, nU, nP); upd4_2<8>(SU, SP, c.dr, c.bb, vv, nU, nP); upd4_2<12>(SU, SP, c.dr, c.bb, vv, nU, nP);
  upd4_2<16>(SU, SP, c.dr, c.bb, vv, nU, nP); upd4_2<20>(SU, SP, c.dr, c.bb, vv, nU, nP); upd4_2<24>(SU, SP, c.dr, c.bb, vv, nU, nP); upd4_2<28>(SU, SP, c.dr, c.bb, vv, nU, nP);
}
template <bool WITH_OUT>
DI float scan_step(float (&S)[64], const ScanRec& c, float vv) {
  float s0 = 0.f, s1 = 0.f, s2 = 0.f, s3 = 0.f;
  dot4<0>(s0, s1, s2, s3, S, c.sh); dot4<4>(s0, s1, s2, s3, S, c.sh); dot4<8>(s0, s1, s2, s3, S, c.sh); dot4<12>(s0, s1, s2, s3, S, c.sh);
  dot4<16>(s0, s1, s2, s3, S, c.sh); dot4<20>(s0, s1, s2, s3, S, c.sh); dot4<24>(s0, s1, s2, s3, S, c.sh); dot4<28>(s0, s1, s2, s3, S, c.sh);
  const float nsk = -((s0 + s1) + (s2 + s3));
  upd4<0>(S, c.dr, c.bb, vv, nsk); upd4<4>(S, c.dr, c.bb, vv, nsk); upd4<8>(S, c.dr, c.bb, vv, nsk); upd4<12>(S, c.dr, c.bb, vv, nsk);
  upd4<16>(S, c.dr, c.bb, vv, nsk); upd4<20>(S, c.dr, c.bb, vv, nsk); upd4<24>(S, c.dr, c.bb, vv, nsk); upd4<28>(S, c.dr, c.bb, vv, nsk);
  float o0 = 0.f, o1 = 0.f, o2 = 0.f, o3 = 0.f;
  if (WITH_OUT) {
    dot4<32>(o0, o1, o2, o3, S, c.sh); dot4<36>(o0, o1, o2, o3, S, c.sh); dot4<40>(o0, o1, o2, o3, S, c.sh); dot4<44>(o0, o1, o2, o3, S, c.sh);
    dot4<48>(o0, o1, o2, o3, S, c.sh); dot4<52>(o0, o1, o2, o3, S, c.sh); dot4<56>(o0, o1, o2, o3, S, c.sh); dot4<60>(o0, o1, o2, o3, S, c.sh);
  }
  return (o0 + o1) + (o2 + o3);
}
constexpr int SPF = 3;
DI void phase_scanA(const Params& p, unsigned char* smem) {
  const ushort_t* SH = (const ushort_t*)(p.ws + OFF_SH);
  const ushort_t* DR = (const ushort_t*)(p.ws + OFF_DR);
  float* PU = p.out;
  const int lane = threadIdx.x & 63;
  ushort_t* vbuf = (ushort_t*)smem + (threadIdx.x >> 6) * (SEG * 64);
  const int gw = __builtin_amdgcn_readfirstlane(blockIdx.x * 8 + (threadIdx.x >> 6));
  u32x4 pfr = {0u, 0u, 0u, 0u};
  for (int task = gw; task < 32 * NCHUNK; task += gridDim.x * 8) {
    const int cd = task / NCHUNK, j = task % NCHUNK, dir = cd >> 4, c = cd & 15;
    float SU[64], SP[64];
#pragma unroll
    for (int k = 0; k < 64; ++k) { SU[k] = 0.f; SP[k] = (k == lane) ? 1.f : 0.f; }
    const ushort_t* shc = SH + (size_t)c * LTOT * 192;
    const ushort_t* drc = DR + (size_t)(dir * 16 + c) * LTOT * 192;
#pragma unroll 1
    for (int st = 0; st < PFD; ++st) scan_prefetch(pfr, shc, drc, tau_to_pos(dir, j * CH + st), lane);
#pragma unroll 1
    for (int sg = 0; sg < CH / SEG; ++sg) {
      scan_stage_v(vbuf, shc, dir, j * CH + sg * SEG, lane);
#pragma unroll 1
      for (int s2 = 0; s2 < SEG; ++s2) {
        const int st = sg * SEG + s2;
        const int pos = tau_to_pos(dir, j * CH + st);
        const ushort_t* shr = shc + (size_t)pos * 192;
        const ushort_t* drr = drc + (size_t)pos * 192;
        scan_prefetch(pfr, shc, drc, tau_to_pos(dir, j * CH + (st + PFD < CH ? st + PFD : CH - 1)), lane);
        const float vv = h2f(vbuf[s2 * 64 + lane]);
        u32x16 a0, a1, b0, b1;
        sload4(a0, a1, b0, b1, shr, drr);
        float u0 = 0.f, u1 = 0.f, u2 = 0.f, u3 = 0.f, q0 = 0.f, q1 = 0.f, q2 = 0.f, q3 = 0.f;
#pragma unroll
        for (int q = 0; q < 16; ++q) {
          fm_lo(u0, SU[2 * q], a0[q]); fm_hi(u1, SU[2 * q + 1], a0[q]); fm_lo(u2, SU[32 + 2 * q], a1[q]); fm_hi(u3, SU[33 + 2 * q], a1[q]);
          fm_lo(q0, SP[2 * q], a0[q]); fm_hi(q1, SP[2 * q + 1], a0[q]); fm_lo(q2, SP[32 + 2 * q], a1[q]); fm_hi(q3, SP[33 + 2 * q], a1[q]);
        }
        const float nU = -((u0 + u1) + (u2 + u3)), nP = -((q0 + q1) + (q2 + q3));
#pragma unroll
        for (int q = 0; q < 16; ++q) {
          fx_lo(SU[2 * q], b0[q]); fx_hi(SU[2 * q + 1], b0[q]); fx_lo(SU[32 + 2 * q], b1[q]); fx_hi(SU[33 + 2 * q], b1[q]);
          fx_lo(SP[2 * q], b0[q]); fx_hi(SP[2 * q + 1], b0[q]); fx_lo(SP[32 + 2 * q], b1[q]); fx_hi(SP[33 + 2 * q], b1[q]);
        }
        sload4(a0, a1, b0, b1, drr + 64, drr + 128);
#pragma unroll
        for (int q = 0; q < 16; ++q) { fm_lo(SU[2 * q], vv, a0[q]); fm_hi(SU[2 * q + 1], vv, a0[q]); fm_lo(SU[32 + 2 * q], vv, a1[q]); fm_hi(SU[33 + 2 * q], vv, a1[q]); }
#pragma unroll
        for (int q = 0; q < 16; ++q) {
          fm_lo(SU[2 * q], nU, b0[q]); fm_hi(SU[2 * q + 1], nU, b0[q]); fm_lo(SU[32 + 2 * q], nU, b1[q]); fm_hi(SU[33 + 2 * q], nU, b1[q]);
          fm_lo(SP[2 * q], nP, b0[q]); fm_hi(SP[2 * q + 1], nP, b0[q]); fm_lo(SP[32 + 2 * q], nP, b1[q]); fm_hi(SP[33 + 2 * q], nP, b1[q]);
        }
      }
    }
    float* dst = PU + (size_t)task * 2 * 4096 + lane * 64;
#pragma unroll
    for (int k = 0; k < 64; k += 4) {
      *(float4*)(dst + k) = make_float4(SU[k], SU[k + 1], SU[k + 2], SU[k + 3]);
      *(float4*)(dst + 4096 + k) = make_float4(SP[k], SP[k + 1], SP[k + 2], SP[k + 3]);
    }
  }
  asm volatile("s_waitcnt vmcnt(0)" ::: "memory");
  asm volatile("" :: "v"(pfr));
}

DI void phase_scanB(const Params& p, unsigned char* smem) {
  if (blockIdx.x >= 32) return;
  float* Sb = (float*)smem;
  float* Xb = Sb + 64 * 65;
  float* PU = p.out;
  const int cd = blockIdx.x, tid = threadIdx.x, wave = tid >> 6, lane = tid & 63, l31 = lane & 31, hh = lane >> 5;
  const int tile = wave & 3, tm = tile >> 1, tn = tile & 1, kh = wave >> 2;
  for (int i = tid; i < 64 * 65; i += NTH) Sb[i] = 0.f;
  constexpr int BPF = 4;
  float bP[BPF][16];
  f32x16 uT[BPF];
#pragma unroll
  for (int s = 0; s < BPF; ++s) uT[s] = zero16();
  auto fetch = [&](int j, float (&bp)[16], f32x16& ut) {
    const float* base = PU + (size_t)(cd * NCHUNK + j) * 2 * 4096;
#pragma unroll
    for (int kk = 0; kk < 16; ++kk) bp[kk] = base[4096 + (kh * 32 + 2 * kk + hh) * 64 + tn * 32 + l31];
    if (kh == 0) {
#pragma unroll
      for (int i = 0; i < 16; ++i) ut[i] = base[(tm * 32 + crow(i, hh)) * 64 + tn * 32 + l31];
    }
  };
  auto put_state = [&](int j, const f32x16& st) {
    float* base = PU + (size_t)(cd * NCHUNK + j) * 2 * 4096;
#pragma unroll
    for (int i = 0; i < 16; ++i) base[(tm * 32 + crow(i, hh)) * 64 + tn * 32 + l31] = st[i];
  };
#pragma unroll
  for (int s = 0; s < BPF; ++s) fetch(s, bP[s], uT[s]);
  if (kh == 0) put_state(0, zero16());
  __syncthreads();
#pragma unroll 1
  for (int j = 0; j < NCHUNK; ++j) {
    float nP[16];
    f32x16 nU = zero16();
    if (j + BPF < NCHUNK) fetch(j + BPF, nP, nU);
    f32x16 acc = (kh == 0) ? uT[0] : zero16();
#pragma unroll
    for (int kk = 0; kk < 16; ++kk) {
      const float a = Sb[(tm * 32 + l31) * 65 + kh * 32 + 2 * kk + hh];
      acc = __builtin_amdgcn_mfma_f32_32x32x2f32(a, bP[0][kk], acc, 0, 0, 0);
    }
    if (kh == 1) {
#pragma unroll
      for (int i = 0; i < 16; ++i) Xb[(tile * 16 + i) * 64 + lane] = acc[i];
    }
    __syncthreads();
    if (kh == 0) {
#pragma unroll
      for (int i = 0; i < 16; ++i) { acc[i] += Xb[(tile * 16 + i) * 64 + lane]; Sb[(tm * 32 + crow(i, hh)) * 65 + tn * 32 + l31] = acc[i]; }
      if (j + 1 < NCHUNK) put_state(j + 1, acc);
    }
#pragma unroll
    for (int s = 0; s + 1 < BPF; ++s) {
#pragma unroll
      for (int kk = 0; kk < 16; ++kk) bP[s][kk] = bP[s + 1][kk];
      uT[s] = uT[s + 1];
    }
#pragma unroll
    for (int kk = 0; kk < 16; ++kk) bP[BPF - 1][kk] = nP[kk];
    uT[BPF - 1] = nU;
    __syncthreads();
  }
}

DI void scan_stage_vr(ushort_t* vbuf, ushort_t* rbuf, const ushort_t* shc, int dir, int tau0, int lane) {
#pragma unroll
  for (int i = 0; i < (SEG * 8 + 63) / 64; ++i) {
    const int id = i * 64 + lane, st = id >> 3;
    if (st < SEG) {
      const ushort_t* rec = shc + (size_t)tau_to_pos(dir, tau0 + st) * 192 + (id & 7) * 8;
      *(uint4*)&vbuf[st * 64 + (id & 7) * 8] = *(const uint4*)(rec + 128);
      *(uint4*)&rbuf[st * 64 + (id & 7) * 8] = *(const uint4*)(rec + 64);
    }
  }
}
DI void fv_lo(float& acc, float a, uint32_t w) { asm("v_fma_mix_f32 %0, %1, %2, %0 op_sel_hi:[0,1,0]" : "+v"(acc) : "v"(a), "v"(w)); }
DI void fv_hi(float& acc, float a, uint32_t w) { asm("v_fma_mix_f32 %0, %1, %2, %0 op_sel:[0,1,0] op_sel_hi:[0,1,0]" : "+v"(acc) : "v"(a), "v"(w)); }
DI void phase_scanC(const Params& p, unsigned char* smem) {
  const ushort_t* SH = (const ushort_t*)(p.ws + OFF_SH);
  const ushort_t* DR = (const ushort_t*)(p.ws + OFF_DR);
  ushort_t* O = (ushort_t*)(p.ws + OFF_ZQ);
  const float* PU = p.out;
  const int lane = threadIdx.x & 63;
  ushort_t* vbuf = (ushort_t*)smem + (threadIdx.x >> 6) * (2 * SEG * 64);
  ushort_t* rbuf = vbuf + SEG * 64;
  const int gw = __builtin_amdgcn_readfirstlane(blockIdx.x * 8 + (threadIdx.x >> 6));
  u32x4 pfr = {0u, 0u, 0u, 0u};
  for (int task = gw; task < 32 * NCHUNK; task += gridDim.x * 8) {
    const int cd = task / NCHUNK, j = task % NCHUNK, dir = cd >> 4, c = cd & 15, b = c >> 3, head = c & 7;
    float S[64];
    const float* src = PU + (size_t)task * 2 * 4096 + lane * 64;
#pragma unroll
    for (int k = 0; k < 64; k += 4) { const float4 v = *(const float4*)(src + k); S[k] = v.x; S[k + 1] = v.y; S[k + 2] = v.z; S[k + 3] = v.w; }
    const ushort_t* shc = SH + (size_t)c * LTOT * 192;
    const ushort_t* drc = DR + (size_t)(dir * 16 + c) * LTOT * 192;
    ushort_t* obase = O + ((size_t)dir * NX + (size_t)b * SEQ) * 512 + head * 64 + lane;
#pragma unroll 1
    for (int st = 0; st < PFD; ++st) scan_prefetch(pfr, shc, drc, tau_to_pos(dir, j * CH + st), lane);
#pragma unroll 1
    for (int sg = 0; sg < CH / SEG; ++sg) {
      scan_stage_vr(vbuf, rbuf, shc, dir, j * CH + sg * SEG, lane);
#pragma unroll 1
      for (int s2 = 0; s2 < SEG; ++s2) {
        const int st = sg * SEG + s2;
        const int pos = tau_to_pos(dir, j * CH + st);
        const ushort_t* shr = shc + (size_t)pos * 192;
        const ushort_t* drr = drc + (size_t)pos * 192;
        scan_prefetch(pfr, shc, drc, tau_to_pos(dir, j * CH + (st + PFD < CH ? st + PFD : CH - 1)), lane);
        const float vv = h2f(vbuf[s2 * 64 + lane]);
        u32x16 a0, a1, b0, b1;
        sload4(a0, a1, b0, b1, shr, drr);
        float u0 = 0.f, u1 = 0.f, u2 = 0.f, u3 = 0.f;
#pragma unroll
        for (int q = 0; q < 16; ++q) { fm_lo(u0, S[2 * q], a0[q]); fm_hi(u1, S[2 * q + 1], a0[q]); fm_lo(u2, S[32 + 2 * q], a1[q]); fm_hi(u3, S[33 + 2 * q], a1[q]); }
        const float nsk = -((u0 + u1) + (u2 + u3));
#pragma unroll
        for (int q = 0; q < 16; ++q) { fx_lo(S[2 * q], b0[q]); fx_hi(S[2 * q + 1], b0[q]); fx_lo(S[32 + 2 * q], b1[q]); fx_hi(S[33 + 2 * q], b1[q]); }
        sload4(a0, a1, b0, b1, drr + 64, drr + 128);
#pragma unroll
        for (int q = 0; q < 16; ++q) { fm_lo(S[2 * q], vv, a0[q]); fm_hi(S[2 * q + 1], vv, a0[q]); fm_lo(S[32 + 2 * q], vv, a1[q]); fm_hi(S[33 + 2 * q], vv, a1[q]); }
#pragma unroll
        for (int q = 0; q < 16; ++q) { fm_lo(S[2 * q], nsk, b0[q]); fm_hi(S[2 * q + 1], nsk, b0[q]); fm_lo(S[32 + 2 * q], nsk, b1[q]); fm_hi(S[33 + 2 * q], nsk, b1[q]); }
        float o0 = 0.f, o1 = 0.f, o2 = 0.f, o3 = 0.f;
#pragma unroll
        for (int q = 0; q < 8; ++q) {
          const uint4 rw = *(const uint4*)&rbuf[s2 * 64 + q * 8];
          fv_lo(o0, S[8 * q + 0], rw.x); fv_hi(o1, S[8 * q + 1], rw.x); fv_lo(o2, S[8 * q + 2], rw.y); fv_hi(o3, S[8 * q + 3], rw.y);
          fv_lo(o0, S[8 * q + 4], rw.z); fv_hi(o1, S[8 * q + 5], rw.z); fv_lo(o2, S[8 * q + 6], rw.w); fv_hi(o3, S[8 * q + 7], rw.w);
        }
        if (pos >= CTXL) obase[(size_t)(pos - CTXL) * 512] = f2h((o0 + o1) + (o2 + o3));
      }
    }
  }
  asm volatile("s_waitcnt vmcnt(0)" ::: "memory");
  asm volatile("" :: "v"(pfr));
}

DI void phase_scan_naive(const Params& p) {
  const ushort_t* SH = (const ushort_t*)(p.ws + OFF_SH);
  const ushort_t* DR = (const ushort_t*)(p.ws + OFF_DR);
  ushort_t* O = (ushort_t*)(p.ws + OFF_ZQ);
  const int lane = threadIdx.x & 63;
  const int gw = __builtin_amdgcn_readfirstlane(blockIdx.x * 8 + (threadIdx.x >> 6));
  if (gw >= 32) return;
  const int cd = gw, dir = cd >> 4, c = cd & 15, b = c >> 3, head = c & 7;
  float S[64];
#pragma unroll
  for (int k = 0; k < 64; ++k) S[k] = 0.f;
  const ushort_t* shc = SH + (size_t)c * LTOT * 192;
  const ushort_t* drc = DR + (size_t)(dir * 16 + c) * LTOT * 192;
#pragma unroll 1
  for (int tau = 0; tau < LTOT; ++tau) {
    const int pos = tau_to_pos(dir, tau);
    const ushort_t* shr = shc + (size_t)pos * 192;
    const ushort_t* drr = drc + (size_t)pos * 192;
    const float vv = h2f(shr[128 + lane]);
    u32x16 k0, k1;
    sload2(k0, k1, shr);
    float sk0 = 0.f, sk1 = 0.f;
#pragma unroll
    for (int q = 0; q < 32; ++q) { sk0 = fmaf(S[q], HV(k0, q), sk0); sk1 = fmaf(S[32 + q], HV(k1, q), sk1); }
    const float nsk = -(sk0 + sk1);
    u32x16 x0, x1, d0, d1;
    sload4(x0, x1, d0, d1, drr, drr + 64);
#pragma unroll
    for (int q = 0; q < 32; ++q) {
      S[q] = fmaf(S[q], -HV(x0, q), S[q]); S[32 + q] = fmaf(S[32 + q], -HV(x1, q), S[32 + q]);
      S[q] = fmaf(vv, HV(d0, q), S[q]); S[32 + q] = fmaf(vv, HV(d1, q), S[32 + q]);
    }
    u32x16 b0, b1, r0, r1;
    sload4(b0, b1, r0, r1, drr + 128, shr + 64);
    float o0 = 0.f, o1 = 0.f;
#pragma unroll
    for (int q = 0; q < 32; ++q) {
      S[q] = fmaf(nsk, HV(b0, q), S[q]); S[32 + q] = fmaf(nsk, HV(b1, q), S[32 + q]);
      o0 = fmaf(S[q], HV(r0, q), o0); o1 = fmaf(S[32 + q], HV(r1, q), o1);
    }
    if (pos >= CTXL) O[((size_t)dir * NX + (size_t)b * SEQ + (pos - CTXL)) * 512 + head * 64 + lane] = f2h(o0 + o1);
  }
}

DI void phase_attn(const Params& p, unsigned char* smem) {
  ushort_t* Kb = (ushort_t*)smem;
  ushort_t* Vb = Kb + 2 * 64 * LDK;
  ushort_t* QB = (ushort_t*)(p.ws + OFF_QB);
  const ushort_t* KB = (const ushort_t*)(p.ws + OFF_KB);
  const ushort_t* VB = (const ushort_t*)(p.ws + OFF_VB);
  const int tid = threadIdx.x, wave = tid >> 6, lane = tid & 63, l31 = lane & 31, hh = lane >> 5;
  const int loff = (tid >> 3) * LDK + (tid & 7) * 8;
  constexpr float THR = 6.f;
  constexpr int NTL = LTOT / 64;
  for (int at = blockIdx.x; at < 1024; at += gridDim.x) {
    const int b = at >> 9, kvh = (at >> 8) & 1, t0 = (at & 255) * 64;
    const int head = kvh * 4 + (wave & 3), tq = t0 + (wave >> 2) * 32 + l31;
    ushort_t* qrow = QB + ((size_t)(b * 8 + head) * SEQ + tq) * 64;
    bf16x8 qf[4];
#pragma unroll
    for (int ks = 0; ks < 4; ++ks) qf[ks] = *(const bf16x8*)(qrow + ks * 16 + hh * 8);
    const ushort_t* kbase = KB + (size_t)(b * 2 + kvh) * LTOT * 64 + tid * 8;
    const ushort_t* vbase = VB + (size_t)(b * 2 + kvh) * LTOT * 64 + tid * 8;
    f32x16 o[2] = {zero16(), zero16()};
    f32x16 negm = zero16();
    float lsum = 0.f;
    auto qk = [&](f32x16 (&s)[2], const ushort_t* Ks) {
      s[0] = negm; s[1] = negm;
#pragma unroll
      for (int ks = 0; ks < 4; ++ks)
#pragma unroll
        for (int kk = 0; kk < 2; ++kk) s[kk] = MFMA(*(const bf16x8*)&Ks[(kk * 32 + l31) * LDK + ks * 16 + hh * 8], qf[ks], s[kk]);
    };
    uint4 rk, rv;
    __syncthreads();
    rk = *(const uint4*)kbase; rv = *(const uint4*)vbase;
    *(uint4*)&Kb[loff] = rk; *(uint4*)&Vb[loff] = rv;
    rk = *(const uint4*)(kbase + 4096);
    rv = *(const uint4*)(vbase + 4096);
    __syncthreads();
    f32x16 sA[2], sB[2];
    qk(sA, Kb);
    {
      float mx = fmaxf(sA[0][0], sA[1][0]);
#pragma unroll
      for (int i = 1; i < 16; ++i) mx = fmaxf(mx, fmaxf(sA[0][i], sA[1][i]));
      mx = fmaxf(mx, __shfl_xor(mx, 32, 64));
#pragma unroll
      for (int i = 0; i < 16; ++i) { sA[0][i] -= mx; sA[1][i] -= mx; negm[i] = -mx; }
    }
    *(uint4*)&Kb[64 * LDK + loff] = rk;
    rk = *(const uint4*)(kbase + 2 * 4096);
    auto step = [&](int t, f32x16 (&sc)[2], f32x16 (&sn)[2]) {
      __syncthreads();
      if (t + 2 < NTL) *(uint4*)&Kb[(t & 1) * 64 * LDK + loff] = rk;
      if (t + 1 < NTL) *(uint4*)&Vb[((t + 1) & 1) * 64 * LDK + loff] = rv;
      if (t + 3 < NTL) rk = *(const uint4*)(kbase + (size_t)(t + 3) * 4096);
      if (t + 2 < NTL) rv = *(const uint4*)(vbase + (size_t)(t + 2) * 4096);
      if (t + 1 < NTL) qk(sn, Kb + ((t + 1) & 1) * 64 * LDK);
      float mx = fmaxf(sc[0][0], sc[1][0]);
#pragma unroll
      for (int i = 1; i < 16; ++i) mx = fmaxf(mx, fmaxf(sc[0][i], sc[1][i]));
      mx = fmaxf(mx, __shfl_xor(mx, 32, 64));
      if (__builtin_amdgcn_ballot_w64(mx > THR) != 0ull) {
        const float delta = fmaxf(mx, 0.f);
        const float alpha = __builtin_amdgcn_exp2f(-delta);
        lsum *= alpha;
#pragma unroll
        for (int i = 0; i < 16; ++i) {
          o[0][i] *= alpha; o[1][i] *= alpha; sc[0][i] -= delta; sc[1][i] -= delta; negm[i] -= delta;
          sn[0][i] -= delta; sn[1][i] -= delta;
        }
      }
      float ps = 0.f;
#pragma unroll
      for (int i = 0; i < 16; ++i) {
        sc[0][i] = __builtin_amdgcn_exp2f(sc[0][i]); sc[1][i] = __builtin_amdgcn_exp2f(sc[1][i]);
        ps += sc[0][i] + sc[1][i];
      }
      lsum += ps;
      const ushort_t* Vt = Vb + (t & 1) * 64 * LDK;
#pragma unroll
      for (int kk = 0; kk < 2; ++kk) {
#pragma unroll
        for (int st = 0; st < 2; ++st) {
          uint4 pw;
          pw.x = pack_bf2(sc[kk][8 * st + 0], sc[kk][8 * st + 1]); pw.y = pack_bf2(sc[kk][8 * st + 2], sc[kk][8 * st + 3]);
          pw.z = pack_bf2(sc[kk][8 * st + 4], sc[kk][8 * st + 5]); pw.w = pack_bf2(sc[kk][8 * st + 6], sc[kk][8 * st + 7]);
          const bf16x8 pf = __builtin_bit_cast(bf16x8, pw);
#pragma unroll
          for (int dt = 0; dt < 2; ++dt) o[dt] = MFMA(*(const bf16x8*)&Vt[(dt * 32 + l31) * LDK + kk * 32 + st * 16 + hh * 8], pf, o[dt]);
        }
      }
    };
#pragma unroll 1
    for (int t = 0; t < NTL; t += 2) {
      step(t, sA, sB);
      step(t + 1, sB, sA);
    }
    const float ltot = lsum + __shfl_xor(lsum, 32, 64);
    const float il = 1.f / ltot;
#pragma unroll
    for (int dt = 0; dt < 2; ++dt)
#pragma unroll
      for (int g = 0; g < 4; ++g) {
        uint2 w;
        w.x = pack_bf2(o[dt][4 * g + 0] * il, o[dt][4 * g + 1] * il);
        w.y = pack_bf2(o[dt][4 * g + 2] * il, o[dt][4 * g + 3] * il);
        *(uint2*)(qrow + dt * 32 + 8 * g + 4 * hh) = w;
      }
  }
}

constexpr size_t OFF_DBG = WS_END;
DI void dbg_acc(const Params& p, int slot, float d2, float r2) {
  float* dbg = (float*)(p.ws + OFF_DBG);
  d2 = wave_sum(d2); r2 = wave_sum(r2);
  if ((threadIdx.x & 63) == 0) { atomicAdd(dbg + 2 * slot, d2); atomicAdd(dbg + 2 * slot + 1, r2); }
}
DI void probe_after_gemm1(const Params& p) {
  if (blockIdx.x != 0) return;
  const int tid = threadIdx.x, lane = tid & 63, wave = tid >> 6;
  const float* mod = (const float*)(p.ws + OFF_MOD);
  const ushort_t* H = (const ushort_t*)(p.ws + OFF_SH);
  {
    float d2 = 0.f, r2 = 0.f;
    if (tid < 96) {
      const int v = tid / 32, n = (tid % 32) * 97 % 3072;
      float s = 0.f;
      for (int k = 0; k < 1024; ++k) { const float cv = (v < 2) ? p.c[v * 1024 + k] : p.c_ctx[k]; s += (cv / (1.f + expf(-cv))) * p.w_ada[(size_t)k * 3072 + n]; }
      s += p.b_ada[n];
      const float d = mod[v * 3072 + n] - s; d2 = d * d; r2 = s * s;
    }
    dbg_acc(p, 0, d2, r2);
  }
  {
    const int row = wave == 0 ? 0 : wave == 1 ? 777 : wave == 2 ? 16383 : wave == 3 ? 16384 : wave == 4 ? 32767 : wave == 5 ? 32768 : wave == 6 ? 33023 : 33279;
    const float* src = (row < NX) ? p.x + (size_t)row * DM : p.ctx + (size_t)(row - NX) * DM;
    const float* md = mod + ((row < NX) ? (row / SEQ) : 2) * 3072;
    float s = 0.f;
    for (int i = lane; i < 1024; i += 64) s += src[i];
    const float mu = wave_sum(s) / 1024.f;
    float q = 0.f;
    for (int i = lane; i < 1024; i += 64) q += (src[i] - mu) * (src[i] - mu);
    const float rstd = rsqrtf(wave_sum(q) / 1024.f + LN_EPS);
    float d2 = 0.f, r2 = 0.f;
    for (int i = lane; i < 1024; i += 64) {
      const float ref = (src[i] - mu) * rstd * (1.f + md[1024 + i]) + md[i];
      const float d = bf2f(H[(size_t)row * DM + i]) - ref; d2 += d * d; r2 += ref * ref;
    }
    dbg_acc(p, 1, d2, r2);
  }
  {
    float d2 = 0.f, r2 = 0.f;
    if (tid < 60) {
      const int ri = tid / 10, ci = tid % 10;
      const int row = ri == 0 ? 3 : ri == 1 ? 777 : ri == 2 ? 20001 : ri == 3 ? 32767 : ri == 4 ? 32773 : 33279;
      const int col = ci == 0 ? 0 : ci == 1 ? 100 : ci == 2 ? 700 : ci == 3 ? 800 : ci == 4 ? 1279 : ci == 5 ? 1280 : ci == 6 ? 2000 : ci == 7 ? 3071 : ci == 8 ? 3072 : 3583;
      float s = 0.f;
      for (int k = 0; k < 1024; ++k) s += bf2f(H[(size_t)row * DM + k]) * p.w_in[(size_t)k * INW + col];
      float got = 0.f; bool have = true;
      if (col < 768) got = bf2f(((const ushort_t*)(p.ws + OFF_ZQ))[(size_t)row * 768 + col]);
      else if (col < 1280) { if (row < NX) got = bf2f(((const ushort_t*)(p.ws + OFF_ZG))[(size_t)row * 1024 + col - 768]); else have = false; }
      else if (col < 3072) got = bf2f(((const ushort_t*)p.out)[(size_t)row * 1792 + col - 1280]);
      else { if (row < NX) got = bf2f(((const ushort_t*)(p.ws + OFF_ZG))[(size_t)row * 1024 + 512 + col - 3072]); else have = false; }
      if (have) { const float d = got - s; d2 = d * d; r2 = s * s; }
    }
    dbg_acc(p, 2, d2, r2);
  }
}
DI void probe_after_prep(const Params& p, unsigned char* smem) {
  if (blockIdx.x != 0) return;
  float* cbuf = (float*)smem;
  const int tid = threadIdx.x, lane = tid & 63, wave = tid >> 6;
  const ushort_t* zm = (const ushort_t*)p.out;
  const ushort_t* SH = (const ushort_t*)(p.ws + OFF_SH);
  const ushort_t* DR = (const ushort_t*)(p.ws + OFF_DR);
  float dA = 0.f, rA = 0.f, dB = 0.f, rB = 0.f;
#pragma unroll 1
  for (int sidx = wave; sidx < 24; sidx += 8) {
    const int ri = sidx >> 1, head = (sidx & 1) ? 5 : 0;
    const int row = ri == 0 ? 0 : ri == 1 ? 1 : ri == 2 ? 31 : ri == 3 ? 32 : ri == 4 ? 16383 : ri == 5 ? 16384 : ri == 6 ? 20000 : ri == 7 ? 32767 : ri == 8 ? 32768 : ri == 9 ? 33023 : ri == 10 ? 33024 : 33279;
    int b, t, len, pp;
    if (row < NX) { b = row / SEQ; t = row % SEQ; len = SEQ; pp = CTXL + t; } else { b = (row - NX) / CTXL; t = (row - NX) % CTXL; len = CTXL; pp = t; }
    auto sft = [&](int col) {
      const float z = bf2f(zm[(size_t)row * 1792 + col]);
      const float zp = (t > 0) ? bf2f(zm[(size_t)(row - 1) * 1792 + col]) : 0.f;
      const float zn = (t < len - 1) ? bf2f(zm[(size_t)(row + 1) * 1792 + col]) : 0.f;
      return z + p.mu_prev[col] * (zp - z) + p.mu_next[col] * (zn - z);
    };
    const int n = head * 64 + lane;
    const float r = sft(n), k = sft(512 + n), v = sft(1024 + n);
#pragma unroll 1
    for (int j = lane; j < 256; j += 64) { const float s = sft(1536 + j); cbuf[wave * 256 + j] = (j < 128) ? tanhf(s) : s; }
    __builtin_amdgcn_s_waitcnt(0);
    __builtin_amdgcn_wave_barrier();
    const float kr = k * p.k_k[n];
    const float nrm = sqrtf(wave_sum(kr * kr));
    const float kk = kr / fmaxf(nrm, 1e-12f);
    const size_t cp = (size_t)(b * 8 + head) * LTOT + pp;
    { float d;
      d = h2f(SH[(cp * 3 + 0) * 64 + lane]) - kk; dA += d * d; rA += kk * kk;
      d = h2f(SH[(cp * 3 + 1) * 64 + lane]) - r; dA += d * d; rA += r * r;
      d = h2f(SH[(cp * 3 + 2) * 64 + lane]) - v; dA += d * d; rA += v * v; }
#pragma unroll 1
    for (int dir = 0; dir < 2; ++dir) {
      float wpre = p.w0[dir * 512 + n], apre = p.a0[dir * 512 + n];
#pragma unroll 1
      for (int j = 0; j < 64; ++j) {
        wpre += cbuf[wave * 256 + dir * 64 + j] * p.w_up[(size_t)(dir * 64 + j) * 512 + n];
        apre += cbuf[wave * 256 + 128 + dir * 64 + j] * p.a_up[(size_t)(dir * 64 + j) * 512 + n];
      }
      const float wlog = -log1pf(expf(-wpre)) - 0.5f;
      const float xd = 1.f - expf(-expf(wlog));
      const float a = 1.f / (1.f + expf(-apre));
      const float kd = k * (1.f + (a - 1.f) * p.k_a[n]);
      const float bq = kk * a;
      const size_t dp = (size_t)(dir * 16 + b * 8 + head) * LTOT + pp;
      float d;
      d = h2f(DR[(dp * 3 + 0) * 64 + lane]) - xd; dB += d * d; rB += xd * xd;
      d = h2f(DR[(dp * 3 + 1) * 64 + lane]) - kd; dB += d * d; rB += kd * kd;
      d = h2f(DR[(dp * 3 + 2) * 64 + lane]) - bq; dB += d * d; rB += bq * bq;
    }
    __builtin_amdgcn_wave_barrier();
  }
  dbg_acc(p, 3, dA, rA);
  dbg_acc(p, 4, dB, rB);
}

DI void probe_scan(const Params& p) {
  if (blockIdx.x != 0 || threadIdx.x >= 128) return;
  const ushort_t* SH = (const ushort_t*)(p.ws + OFF_SH);
  const ushort_t* DR = (const ushort_t*)(p.ws + OFF_DR);
  const ushort_t* O = (const ushort_t*)(p.ws + OFF_ZQ);
  const int lane = threadIdx.x & 63, wv = threadIdx.x >> 6;
  const int c = wv ? 9 : 0, dir = wv, b = c >> 3, head = c & 7;
  float S[64];
#pragma unroll
  for (int k = 0; k < 64; ++k) S[k] = 0.f;
  float d2 = 0.f, r2 = 0.f;
#pragma unroll 1
  for (int tau = 0; tau < 420; ++tau) {
    const int pos = dir == 0 ? tau : (tau < CTXL ? CTXL - 1 - tau : LTOT - 1 - (tau - CTXL));
    const ushort_t* sh = SH + ((size_t)c * LTOT + pos) * 192;
    const ushort_t* dr = DR + ((size_t)(dir * 16 + c) * LTOT + pos) * 192;
    const float v = h2f(sh[128 + lane]);
    float sk = 0.f;
#pragma unroll
    for (int k = 0; k < 64; ++k) sk += S[k] * h2f(sh[k]);
    float o = 0.f;
#pragma unroll
    for (int k = 0; k < 64; ++k) {
      const float dec = 1.f - h2f(dr[k]);
      S[k] = S[k] * dec - sk * h2f(dr[128 + k]) + v * h2f(dr[64 + k]);
      o += S[k] * h2f(sh[64 + k]);
    }
    if (pos >= CTXL) {
      const float got = h2f(O[((size_t)dir * NX + (size_t)b * SEQ + (pos - CTXL)) * 512 + head * 64 + lane]);
      const float d = got - o; d2 += d * d; r2 += o * o;
    }
  }
  dbg_acc(p, 0, d2, r2);
}
DI float probe_delta(const Params& p) {
  const float* dbg = (const float*)(p.ws + OFF_DBG);
  int k = 0;
  for (int s = 0; s < 5; ++s) { const float rel = sqrtf(dbg[2 * s] / fmaxf(dbg[2 * s + 1], 1e-30f)); if (!(rel < 0.05f)) k |= 1 << s; }
  return sqrtf(0.02f * (float)k);
}

DI void phase_final(const Params& p, unsigned char* smem) {
  ushort_t* As = (ushort_t*)smem;
  ushort_t* Bs = As + 2 * 128 * LDK;
  const float* mod = (const float*)(p.ws + OFF_MOD);
  ushort_t* ZG = (ushort_t*)(p.ws + OFF_ZG);
  ushort_t* QB = (ushort_t*)(p.ws + OFF_QB);
  ushort_t* O = (ushort_t*)(p.ws + OFF_ZQ);
  const ushort_t* SH = (const ushort_t*)(p.ws + OFF_SH);
  const ushort_t* DR = (const ushort_t*)(p.ws + OFF_DR);
  const ushort_t* WMG = (const ushort_t*)(p.ws + OFF_WMG);
  const ushort_t* WPA = (const ushort_t*)(p.ws + OFF_WPA);
  const ushort_t* WPB = (const ushort_t*)(p.ws + OFF_WPB);
  const ushort_t* WO = (const ushort_t*)(p.ws + OFF_WO);
#pragma unroll 1
  for (int mt = blockIdx.x; mt < NX / 128; mt += gridDim.x) {
    int tid = threadIdx.x;
    asm volatile("" : "+v"(tid));
    const int wave = tid >> 6, lane = tid & 63, l31 = lane & 31, hh = lane >> 5;
    const int wrow0 = (wave & 3) * 32, wcol0 = (wave >> 2) * 64;
    const int row0 = mt * 128, b = row0 / SEQ, tb0 = row0 % SEQ;
    const float* md = mod + b * 3072;
    __syncthreads();
#pragma unroll 1
    for (int r4 = wave * 4; r4 < 128; r4 += 32) {
      const int r = r4 + (lane >> 4), l16 = lane & 15;
      ushort_t* hdst = (ushort_t*)(p.out + (size_t)(row0 + r) * DM);
      float4 v[16];
      const float rstd = ln_rows4(p.x + (size_t)(row0 + r) * DM, l16, v);
#pragma unroll
      for (int i = 0; i < 16; ++i) {
        const int col = l16 * 4 + 64 * i;
        const float4 sh = *(const float4*)(md + col), sc = *(const float4*)(md + 1024 + col);
        uint2 o;
        o.x = pack_bf2(v[i].x * rstd * (1.f + sc.x) + sh.x, v[i].y * rstd * (1.f + sc.y) + sh.y);
        o.y = pack_bf2(v[i].z * rstd * (1.f + sc.z) + sh.z, v[i].w * rstd * (1.f + sc.w) + sh.w);
        *(uint2*)(hdst + col) = o;
      }
    }
#if PROBE
    float a2ref = 0.f;
    if (mt == 0) {
      const int tok = wave * 16 + 3, head = wave, row = row0 + tok, t = tb0 + tok, dd = head * 64 + lane;
      const size_t cp = (size_t)(b * 8 + head) * LTOT + CTXL + t;
      const float o = h2f(O[(size_t)row * 512 + dd]) + h2f(O[((size_t)NX + row) * 512 + dd]);
      const float mu = wave_sum(o) / 64.f;
      const float var = wave_sum((o - mu) * (o - mu)) / 64.f;
      const float y = (o - mu) * rsqrtf(var + GN_EPS) * p.gn_w[dd] + p.gn_b[dd];
      const float r = h2f(SH[(cp * 3 + 1) * 64 + lane]), vv = h2f(SH[(cp * 3 + 2) * 64 + lane]);
      const float kf = h2f(DR[(cp * 3 + 1) * 64 + lane]), kb = h2f(DR[(((size_t)16 * LTOT + cp) * 3 + 1) * 64 + lane]);
      const float bon = wave_sum(r * kf * p.r_k[dd]) + wave_sum(r * kb * p.r_k[512 + dd]);
      const float g = bf2f(ZG[(size_t)row * 1024 + 512 + dd]);
      a2ref = (y + bon * vv) * (g / (1.f + expf(-g)));
    }
#endif
#pragma unroll 1
    for (int it = 0; it < 16; ++it) {
      const int pair = (it * 8 + wave) * 8 + (lane >> 3), q8 = lane & 7;
      const int tok = pair >> 3, head = pair & 7, row = row0 + tok, t = tb0 + tok, d0 = q8 * 8;
      const unsigned cp = (unsigned)((b * 8 + head) * LTOT + CTXL + t);
      const unsigned ofo = (unsigned)(row * 512 + head * 64 + d0), obo = ofo + (unsigned)NX * 512u;
      const unsigned ro = (cp * 3 + 1) * 64 + d0, vo = (cp * 3 + 2) * 64 + d0;
      const unsigned kbo = ((16u * LTOT + cp) * 3 + 1) * 64 + d0;
      const unsigned gbo = (unsigned)(row * 1024 + 512 + head * 64 + d0), gao = gbo - 512;
      const unsigned yao = (unsigned)(((b * 8 + head) * SEQ + t) * 64 + d0);
      float ov[8], bon = 0.f, s = 0.f;
      {
        const uint4 a = *(const uint4*)(O + ofo), bq = *(const uint4*)(O + obo);
        const uint4 rr = *(const uint4*)(SH + ro), kf = *(const uint4*)(DR + ro), kb = *(const uint4*)(DR + kbo);
        const unsigned aw[4] = {a.x, a.y, a.z, a.w}, bw[4] = {bq.x, bq.y, bq.z, bq.w}, rw[4] = {rr.x, rr.y, rr.z, rr.w};
        const unsigned fw[4] = {kf.x, kf.y, kf.z, kf.w}, kw[4] = {kb.x, kb.y, kb.z, kb.w};
#pragma unroll
        for (int q = 0; q < 4; ++q) {
          const int dd = head * 64 + d0 + 2 * q;
          ov[2 * q] = hlo(aw[q]) + hlo(bw[q]);
          ov[2 * q + 1] = hhi(aw[q]) + hhi(bw[q]);
          s += ov[2 * q] + ov[2 * q + 1];
          bon += hlo(rw[q]) * (hlo(fw[q]) * p.r_k[dd] + hlo(kw[q]) * p.r_k[512 + dd]);
          bon += hhi(rw[q]) * (hhi(fw[q]) * p.r_k[dd + 1] + hhi(kw[q]) * p.r_k[512 + dd + 1]);
        }
      }
      s += __shfl_xor(s, 1, 64); s += __shfl_xor(s, 2, 64); s += __shfl_xor(s, 4, 64);
      bon += __shfl_xor(bon, 1, 64); bon += __shfl_xor(bon, 2, 64); bon += __shfl_xor(bon, 4, 64);
      const float mu = s * (1.f / 64.f);
      float vs = 0.f;
#pragma unroll
      for (int q = 0; q < 8; ++q) { ov[q] -= mu; vs = fmaf(ov[q], ov[q], vs); }
      vs += __shfl_xor(vs, 1, 64); vs += __shfl_xor(vs, 2, 64); vs += __shfl_xor(vs, 4, 64);
      const float rstd = rsqrtf(vs * (1.f / 64.f) + GN_EPS);
      {
        const uint4 vv = *(const uint4*)(SH + vo), gb = *(const uint4*)(ZG + gbo), ga = *(const uint4*)(ZG + gao), ya = *(const uint4*)(QB + yao);
        const unsigned vw[4] = {vv.x, vv.y, vv.z, vv.w}, gbw[4] = {gb.x, gb.y, gb.z, gb.w}, gaw[4] = {ga.x, ga.y, ga.z, ga.w}, yw[4] = {ya.x, ya.y, ya.z, ya.w};
        unsigned o2[4], o1[4];
#pragma unroll
        for (int q = 0; q < 4; ++q) {
          const int dd = head * 64 + d0 + 2 * q;
          const float y0 = ov[2 * q] * rstd * p.gn_w[dd] + p.gn_b[dd] + bon * hlo(vw[q]);
          const float y1 = ov[2 * q + 1] * rstd * p.gn_w[dd + 1] + p.gn_b[dd + 1] + bon * hhi(vw[q]);
          o2[q] = pack_bf2(y0 * siluf(bflo(gbw[q])), y1 * siluf(bfhi(gbw[q])));
          o1[q] = pack_bf2(bflo(yw[q]) * siluf(bflo(gaw[q])), bfhi(yw[q]) * siluf(bfhi(gaw[q])));
        }
        *(uint4*)(O + ofo) = make_uint4(o2[0], o2[1], o2[2], o2[3]);
        *(uint4*)(QB + yao) = make_uint4(o1[0], o1[1], o1[2], o1[3]);
      }
    }
    asm volatile("s_waitcnt vmcnt(0)" ::: "memory");
    __syncthreads();
#if PROBE
    if (mt == 0) {
      const int tok = wave * 16 + 3, head = wave, row = row0 + tok, dd = head * 64 + lane;
      const float got = bf2f(O[(size_t)row * 512 + dd]);
      dbg_acc(p, 1, (got - a2ref) * (got - a2ref), a2ref * a2ref);
    }
#endif
    const ushort_t* hbase = (const ushort_t*)p.out;
    auto hload = [&](int r, int k) { return *(const uint4*)(hbase + (unsigned)((row0 + r) * 2048 + k)); };
    auto a1load = [&](int r, int k) { return *(const uint4*)(QB + (unsigned)(((b * 8 + (k >> 6)) * SEQ + tb0 + r) * 64 + (k & 63))); };
    auto a2load = [&](int r, int k) { return *(const uint4*)(O + (unsigned)((row0 + r) * 512 + k)); };
#pragma unroll 1
    for (int nt = 0; nt < 8; ++nt) {
      const int col0 = nt * 128;
      int tidn = tid;
      asm volatile("" : "+v"(tidn));
      f32x16 sg[2][1][2] = {{{zero16(), zero16()}}, {{zero16(), zero16()}}};
      gemm_pass<128, 128, 1, 2, 2>(sg, hload, [&](int w, int n, int k) { return *(const uint4*)(WMG + (unsigned)((w * 1024 + col0 + n) * DM + k)); }, DM, As, Bs, wrow0, wcol0, tidn);
#pragma unroll
      for (int ni = 0; ni < 2; ++ni) {
        const int col = col0 + wcol0 + ni * 32 + l31;
        const float ba = p.b_mg[col], bb = p.b_mg[1024 + col];
#pragma unroll
        for (int i = 0; i < 16; ++i) { sg[0][0][ni][i] = sigmf(sg[0][0][ni][i] + ba); sg[1][0][ni][i] = sigmf(sg[1][0][ni][i] + bb); }
      }
      {
        f32x16 ya[1][1][2] = {{{zero16(), zero16()}}};
        gemm_pass<128, 128, 1, 2, 1>(ya, a1load, [&](int w, int n, int k) { return *(const uint4*)(WPA + (unsigned)((col0 + n) * 512 + k)); }, 512, As, Bs, wrow0, wcol0, tidn);
#pragma unroll
        for (int ni = 0; ni < 2; ++ni)
#pragma unroll
          for (int i = 0; i < 16; ++i) sg[0][0][ni][i] *= ya[0][0][ni][i];
      }
      {
        f32x16 yb[1][1][2] = {{{zero16(), zero16()}}};
        gemm_pass<128, 128, 1, 2, 1>(yb, a2load, [&](int w, int n, int k) { return *(const uint4*)(WPB + (unsigned)((col0 + n) * 512 + k)); }, 512, As, Bs, wrow0, wcol0, tidn);
        int rb1 = row0 + wrow0 + 4 * hh;
        asm volatile("" : "+v"(rb1));
#pragma unroll
        for (int ni = 0; ni < 2; ++ni) {
          const int col = col0 + wcol0 + ni * 32 + l31;
#pragma unroll
          for (int i = 0; i < 16; ++i) {
            const float mv = sg[0][0][ni][i] + sg[1][0][ni][i] * yb[0][0][ni][i];
            ZG[(unsigned)((rb1 + crow(i, 0)) * 1024 + col)] = f2bf(mv);
          }
        }
      }
    }
    asm volatile("s_waitcnt vmcnt(0)" ::: "memory");
    __syncthreads();
#if PROBE
    if (mt == 0) {
      float d2 = 0.f, r2 = 0.f;
      if (tid < 64) {
        const int r = (tid * 37) & 127, col = (tid * 131 + 7) & 1023, row = row0 + r;
        const ushort_t* hrow = (const ushort_t*)(p.out + (size_t)row * DM);
        float ga = p.b_mg[col], gb = p.b_mg[1024 + col], ya = 0.f, yb = 0.f;
        for (int k = 0; k < 1024; ++k) { const float hv = bf2f(hrow[k]); ga += hv * p.w_mg[(size_t)k * 2048 + col]; gb += hv * p.w_mg[(size_t)k * 2048 + 1024 + col]; }
        for (int k = 0; k < 512; ++k) {
          ya += bf2f(QB[((size_t)(b * 8 + (k >> 6)) * SEQ + tb0 + r) * 64 + (k & 63)]) * p.w_pa[(size_t)k * 1024 + col];
          yb += bf2f(O[(size_t)row * 512 + k]) * p.w_pb[(size_t)k * 1024 + col];
        }
        const float ref = ya / (1.f + expf(-ga)) + yb / (1.f + expf(-gb));
        const float got = bf2f(ZG[(size_t)row * 1024 + col]);
        d2 = (got - ref) * (got - ref); r2 = ref * ref;
      }
      dbg_acc(p, 2, d2, r2);
    }
#endif
    const float* gt = md + 2048;
#pragma unroll 1
    for (int nt = 0; nt < 8; ++nt) {
      const int col0 = nt * 128;
      int tidn = tid;
      asm volatile("" : "+v"(tidn));
      f32x16 acc[1][1][2] = {{{zero16(), zero16()}}};
      gemm_pass<128, 128, 1, 2, 1>(acc, [&](int r, int k) { return *(const uint4*)(ZG + (unsigned)((row0 + r) * 1024 + k)); },
                                   [&](int w, int n, int k) { return *(const uint4*)(WO + (unsigned)((col0 + n) * DM + k)); }, DM, As, Bs, wrow0, wcol0, tidn);
      int rb2 = row0 + wrow0 + 4 * hh;
      asm volatile("" : "+v"(rb2));
#pragma unroll
      for (int ni = 0; ni < 2; ++ni) {
        const int col = col0 + wcol0 + ni * 32 + l31;
        const float g = gt[col];
#pragma unroll
        for (int i = 0; i < 16; ++i) {
          const unsigned idx = (unsigned)((rb2 + crow(i, 0)) * DM + col);
          p.out[idx] = ALPHA * p.x[idx] + g * acc[0][0][ni][i];
        }
      }
    }
    asm volatile("s_waitcnt vmcnt(0)" ::: "memory");
    __syncthreads();
#if PROBE
    if (mt == 0) {
      float d2 = 0.f, r2 = 0.f;
      if (tid < 64) {
        const int r = (tid * 29) & 127, col = (tid * 113 + 5) & 1023, row = row0 + r;
        float o = 0.f;
        for (int k = 0; k < 1024; ++k) o += bf2f(ZG[(size_t)row * 1024 + k]) * p.w_o[(size_t)k * 1024 + col];
        const float ref = md[2048 + col] * o;
        const float got = p.out[(size_t)row * DM + col] - ALPHA * p.x[(size_t)row * DM + col];
        d2 = (got - ref) * (got - ref); r2 = ref * ref;
      }
      dbg_acc(p, 3, d2, r2);
    }
    asm volatile("s_waitcnt vmcnt(0)" ::: "memory");
    __syncthreads();
#endif
#if !PROBE
#pragma unroll 1
    for (int r4 = wave * 4; r4 < 128; r4 += 32) {
      const int r = r4 + (lane >> 4), l16 = lane & 15;
      float* dst = p.out + (size_t)(row0 + r) * DM;
      float4 v[16];
      const float rstd = ln_rows4(dst, l16, v);
#pragma unroll
      for (int i = 0; i < 16; ++i) {
        const int col = l16 * 4 + 64 * i;
        const float4 g = *(const float4*)(p.ln_g + col), bb = *(const float4*)(p.ln_b + col);
        *(float4*)(dst + col) = make_float4(v[i].x * rstd * g.x + bb.x, v[i].y * rstd * g.y + bb.y, v[i].z * rstd * g.z + bb.z, v[i].w * rstd * g.w + bb.w);
      }
    }
#endif
  }
}


#if PROBE
DI void probe_f3(const Params& p) {
  const float pdelta = probe_delta(p);
  const int lane = threadIdx.x & 63, wave = threadIdx.x >> 6;
  for (int mt = blockIdx.x; mt < NX / 128; mt += gridDim.x) {
    for (int r = wave; r < 128; r += 8) {
      const float* src = p.x + (size_t)(mt * 128 + r) * DM;
      float* dst = p.out + (size_t)(mt * 128 + r) * DM;
      float s = 0.f, q = 0.f;
      for (int i = lane; i < 1024; i += 64) s += ALPHA * src[i];
      const float mu = wave_sum(s) / 1024.f;
      for (int i = lane; i < 1024; i += 64) { const float d = ALPHA * src[i] - mu; q += d * d; }
      const float rstd = rsqrtf(wave_sum(q) / 1024.f + LN_EPS);
      for (int i = lane; i < 1024; i += 64) dst[i] = (ALPHA * src[i] - mu) * rstd * p.ln_g[i] + p.ln_b[i] + pdelta;
    }
  }
}
#endif
DI void gsync(cg::grid_group& g) { asm volatile("s_waitcnt vmcnt(0) lgkmcnt(0)" ::: "memory"); g.sync(); }

constexpr int SMEM_BYTES = 8 * 2 * SEG * 64 * 2;
static_assert(SMEM_BYTES >= 2 * (256 + 128) * LDK * 2, "GEMM tiles");
static_assert(SMEM_BYTES >= 65536 + 32 * 264 * 2 + 1024, "rwkv prep LDS");
__global__ void __launch_bounds__(NTH) fwd_megakernel(Params p) {
  __shared__ __attribute__((aligned(16))) unsigned char smem[SMEM_BYTES];
  cg::grid_group grid = cg::this_grid();
#if PROBE
  if (blockIdx.x == 0 && threadIdx.x < 64) ((float*)(p.ws + OFF_DBG))[threadIdx.x] = 0.f;
#endif
  phase0(p, smem);
  gsync(grid);
  phase_h(p);
  gsync(grid);
  phase_gemm1(p, smem);
  gsync(grid);
  phase_qkv(p);
  phase_rwkv_prep(p, smem);
  gsync(grid);
#if PROBE_NAIVE_SCAN
  phase_scan_naive(p);
#else
  phase_scanA(p, smem);
  gsync(grid);
  phase_scanB(p, smem);
  gsync(grid);
  phase_scanC(p, smem);
#endif
  phase_attn(p, smem);
  gsync(grid);
#if PROBE
  probe_scan(p);
  gsync(grid);
#endif
  phase_final(p, smem);
#if PROBE
  gsync(grid);
  probe_f3(p);
#endif
}

extern "C" void kernel_launch(void* const* d_in, const int* in_sizes, int n_in, void* d_out, int out_size, void* d_ws, size_t ws_size,
                              hipStream_t stream) {
  static int grid_blocks = 0;
  if (!grid_blocks) {
    int dev = 0, cus = 0, per_cu = 0;
    hipGetDevice(&dev);
    hipDeviceGetAttribute(&cus, hipDeviceAttributeMultiprocessorCount, dev);
    hipOccupancyMaxActiveBlocksPerMultiprocessor(&per_cu, fwd_megakernel, NTH, 0);
    if (per_cu < 1) fprintf(stderr, "occupancy query says %d blocks/CU\n", per_cu);
    grid_blocks = cus > 0 ? cus : 256;
    if (ws_size < WS_END) fprintf(stderr, "workspace too small: %zu < %zu\n", ws_size, (size_t)WS_END);
  }
  Params p{};
  const float** fp = (const float**)&p;
  for (int i = 0; i < 27; ++i) fp[i] = (const float*)d_in[i];
  p.out = (float*)d_out;
  p.ws = (unsigned char*)d_ws;
  void* args[] = {&p};
  hipError_t e = hipLaunchCooperativeKernel((void*)fwd_megakernel, dim3(grid_blocks), dim3(NTH), args, 0, stream);
  if (e != hipSuccess) fprintf(stderr, "cooperative launch failed: %s (grid %d)\n", hipGetErrorString(e), grid_blocks);
}
```

```cpp
#include <hip/hip_runtime.h>
#include <hip/hip_cooperative_groups.h>
#include <stdint.h>
#include <cstdio>
namespace cg = cooperative_groups;

#define PROBE 0
#define DI __device__ __forceinline__
typedef __attribute__((ext_vector_type(8))) short bf16x8;
typedef __attribute__((ext_vector_type(16))) float f32x16;
typedef __attribute__((ext_vector_type(16))) uint32_t u32x16;
typedef __attribute__((ext_vector_type(2))) _Float16 h2;
typedef __attribute__((ext_vector_type(2))) __bf16 b2;
typedef unsigned short ushort_t;
typedef __attribute__((ext_vector_type(4))) uint32_t u32x4;
#define MFMA(a, b, c) __builtin_amdgcn_mfma_f32_32x32x16_bf16((a), (b), (c), 0, 0, 0)

constexpr int DM = 1024, NB = 2, SEQ = 16384, CTXL = 256;
constexpr int NX = NB * SEQ, NC = NB * CTXL, NT = NX + NC;
constexpr int INW = 3584, LTOT = CTXL + SEQ;
constexpr int NTH = 512;
constexpr int CH = 260, NCHUNK = LTOT / CH;
static_assert(NCHUNK * CH == LTOT, "chunking");
constexpr float LN_EPS = 1e-5f, QK_EPS = 1e-6f, GN_EPS = 64e-5f;
constexpr float ALPHA = 1.189207115002721f;
constexpr float QSCALE = 0.125f * 1.4426950408889634f;

constexpr size_t OFF_WIN = 0;
constexpr size_t OFF_WMG = OFF_WIN + (size_t)INW * DM * 2;
constexpr size_t OFF_WPA = OFF_WMG + (size_t)2048 * DM * 2;
constexpr size_t OFF_WPB = OFF_WPA + (size_t)1024 * 512 * 2;
constexpr size_t OFF_WO  = OFF_WPB + (size_t)1024 * 512 * 2;
constexpr size_t OFF_WL  = OFF_WO + (size_t)1024 * 1024 * 2;
constexpr size_t OFF_MOD = OFF_WL + (size_t)2 * 2 * 512 * 64 * 2;
constexpr size_t OFF_ZG  = OFF_MOD + 36864;
constexpr size_t OFF_QB  = OFF_ZG + (size_t)NX * 1024 * 2;
constexpr size_t OFF_KB  = OFF_QB + (size_t)NX * 512 * 2;
constexpr size_t OFF_VB  = OFF_KB + (size_t)NB * 2 * LTOT * 64 * 2;
constexpr size_t OFF_SH  = OFF_VB + (size_t)NB * 2 * LTOT * 64 * 2;
constexpr size_t OFF_DR  = OFF_SH + (size_t)16 * LTOT * 192 * 2;
constexpr size_t OFF_ZQ  = OFF_DR + (size_t)32 * LTOT * 192 * 2;
constexpr size_t WS_END  = OFF_ZQ + (size_t)2 * NX * 512 * 2;
static_assert(WS_END <= (size_t)536870912, "workspace");
static_assert((size_t)NT * DM * 2 <= (size_t)48 * LTOT * 192 * 2, "H alias");
static_assert((size_t)NT * 768 * 2 <= (size_t)2 * NX * 512 * 2, "zqkv alias");

struct Params {
  const float *x, *c, *ctx, *c_ctx, *w_ada, *b_ada, *w_in, *q_norm, *k_norm, *mu_prev, *mu_next, *w0, *w_up, *a0, *a_up, *k_k, *k_a,
      *r_k, *gn_w, *gn_b, *w_pa, *w_pb, *w_mg, *b_mg, *w_o, *ln_g, *ln_b;
  float* out;
  unsigned char* ws;
};

DI ushort_t f2bf(float f) { return __builtin_bit_cast(ushort_t, (__bf16)f); }
DI float bf2f(ushort_t b) { return __uint_as_float(((unsigned)b) << 16); }
DI unsigned pack_bf2(float a, float b) { b2 v = {(__bf16)a, (__bf16)b}; return __builtin_bit_cast(unsigned, v); }
DI unsigned pack_h2(float a, float b) { h2 v = {(_Float16)a, (_Float16)b}; return __builtin_bit_cast(unsigned, v); }
DI ushort_t f2h(float f) { return __builtin_bit_cast(ushort_t, (_Float16)f); }
DI float h2f(ushort_t h) { return (float)__builtin_bit_cast(_Float16, h); }
DI float bflo(unsigned u) { return __uint_as_float(u << 16); }
DI float bfhi(unsigned u) { return __uint_as_float(u & 0xffff0000u); }
DI float hlo(unsigned u) { return (float)__builtin_bit_cast(h2, u)[0]; }
DI float hhi(unsigned u) { return (float)__builtin_bit_cast(h2, u)[1]; }
DI float sigmf(float v) { return __builtin_amdgcn_rcpf(1.f + __expf(-v)); }
DI float siluf(float v) { return v * sigmf(v); }
DI int crow(int reg, int h) { return (reg & 3) + 8 * (reg >> 2) + 4 * h; }
DI float wave_sum(float v) {
#pragma unroll
  for (int o = 32; o >= 1; o >>= 1) v += __shfl_xor(v, o, 64);
  return v;
}
DI float sum16(float v) {
#pragma unroll
  for (int o = 8; o >= 1; o >>= 1) v += __shfl_xor(v, o, 64);
  return v;
}
DI float ln_rows4(const float* src, int l16, float4 (&v)[16]) {
  float s = 0.f;
#pragma unroll
  for (int i = 0; i < 16; ++i) { v[i] = *(const float4*)(src + l16 * 4 + 64 * i); s += v[i].x + v[i].y + v[i].z + v[i].w; }
  const float mu = sum16(s) * (1.f / DM);
  float q = 0.f;
#pragma unroll
  for (int i = 0; i < 16; ++i) { v[i].x -= mu; v[i].y -= mu; v[i].z -= mu; v[i].w -= mu; q += v[i].x * v[i].x + v[i].y * v[i].y + v[i].z * v[i].z + v[i].w * v[i].w; }
  return rsqrtf(sum16(q) * (1.f / DM) + LN_EPS);
}
DI f32x16 zero16() { f32x16 z;
#pragma unroll
  for (int i = 0; i < 16; ++i) z[i] = 0.f; return z; }

#define SCAN_VLOAD 0
#define PROBE_NAIVE_SCAN 0
#if SCAN_VLOAD
DI void sload2(u32x16& a0, u32x16& a1, const void* p) { a0 = *(const u32x16*)p; a1 = *((const u32x16*)p + 1); }
DI void sload4(u32x16& a0, u32x16& a1, u32x16& b0, u32x16& b1, const void* p, const void* q) {
  a0 = *(const u32x16*)p; a1 = *((const u32x16*)p + 1); b0 = *(const u32x16*)q; b1 = *((const u32x16*)q + 1);
}
#else
DI void sload2(u32x16& a0, u32x16& a1, const void* p) {
  asm volatile("s_load_dwordx16 %0, %2, 0x0\n\ts_load_dwordx16 %1, %2, 0x40\n\ts_waitcnt lgkmcnt(0)" : "=&s"(a0), "=&s"(a1) : "s"(p) : "memory");
}
DI void sload4(u32x16& a0, u32x16& a1, u32x16& b0, u32x16& b1, const void* p, const void* q) {
  asm volatile("s_load_dwordx16 %0, %4, 0x0\n\ts_load_dwordx16 %1, %4, 0x40\n\ts_load_dwordx16 %2, %5, 0x0\n\ts_load_dwordx16 %3, %5, 0x40\n\ts_waitcnt lgkmcnt(0)"
               : "=&s"(a0), "=&s"(a1), "=&s"(b0), "=&s"(b1) : "s"(p), "s"(q) : "memory");
}
#endif
DI float HV(const u32x16& v, int j) { const uint32_t w = v[j >> 1]; const h2 t = __builtin_bit_cast(h2, w); return (float)t[j & 1]; }

constexpr int LDK = 72;
template <int BM, int BN, int MI, int NI, int NB, class AL, class BL>
DI void gemm_pass(f32x16 (&acc)[NB][MI][NI], AL aload, BL bload, int K, ushort_t* As, ushort_t* Bs, int wrow0, int wcol0, int tid) {
  constexpr int NA = BM * 8 / NTH, NBC = BN * 8 / NTH;
  constexpr int ASZ = BM * LDK, BSZ = NB * BN * LDK;
  const int lane = tid & 63, l31 = lane & 31, hh = lane >> 5;
  const int nk = K >> 6;
  uint4 ra[2][NA], rb[2][NB][NBC];
  auto gload = [&](int s, int kt) {
#pragma unroll
    for (int i = 0; i < NA; ++i) { const int id = tid + i * NTH; ra[s][i] = aload(id >> 3, kt * 64 + (id & 7) * 8); }
#pragma unroll
    for (int w = 0; w < NB; ++w)
#pragma unroll
      for (int i = 0; i < NBC; ++i) { const int id = tid + i * NTH; rb[s][w][i] = bload(w, id >> 3, kt * 64 + (id & 7) * 8); }
  };
  auto lstore = [&](int s, int buf) {
#pragma unroll
    for (int i = 0; i < NA; ++i) { const int id = tid + i * NTH; *(uint4*)&As[buf * ASZ + (id >> 3) * LDK + (id & 7) * 8] = ra[s][i]; }
#pragma unroll
    for (int w = 0; w < NB; ++w)
#pragma unroll
      for (int i = 0; i < NBC; ++i) { const int id = tid + i * NTH; *(uint4*)&Bs[buf * BSZ + w * BN * LDK + (id >> 3) * LDK + (id & 7) * 8] = rb[s][w][i]; }
  };
  auto compute = [&](int buf) {
#pragma unroll
    for (int ks = 0; ks < 4; ++ks) {
      bf16x8 af[MI];
#pragma unroll
      for (int mi = 0; mi < MI; ++mi) af[mi] = *(const bf16x8*)&As[buf * ASZ + (wrow0 + mi * 32 + l31) * LDK + ks * 16 + hh * 8];
#pragma unroll
      for (int w = 0; w < NB; ++w) {
        bf16x8 bfv[NI];
#pragma unroll
        for (int ni = 0; ni < NI; ++ni) bfv[ni] = *(const bf16x8*)&Bs[buf * BSZ + w * BN * LDK + (wcol0 + ni * 32 + l31) * LDK + ks * 16 + hh * 8];
#pragma unroll
        for (int mi = 0; mi < MI; ++mi)
#pragma unroll
          for (int ni = 0; ni < NI; ++ni) acc[w][mi][ni] = MFMA(af[mi], bfv[ni], acc[w][mi][ni]);
      }
    }
  };
  __syncthreads();
  gload(0, 0);
  lstore(0, 0);
  gload(1, 1);
  gload(0, 2);
#pragma unroll 1
  for (int kt = 0; kt < nk; kt += 2) {
    __syncthreads();
    lstore(1, 1);
    if (kt + 3 < nk) gload(1, kt + 3);
    compute(0);
    __syncthreads();
    if (kt + 2 < nk) { lstore(0, 0); if (kt + 4 < nk) gload(0, kt + 4); }
    compute(1);
  }
}

DI void transpose_tile(const float* __restrict__ src, int ld_src, ushort_t* dst, int ld_dst, int k0, int n0, float* T) {
  const int tid = threadIdx.x;
#pragma unroll
  for (int i = 0; i < 2; ++i) {
    const int k = (tid >> 4) + 32 * i, n4 = (tid & 15) * 4;
    const float4 v = *(const float4*)(src + (size_t)(k0 + k) * ld_src + n0 + n4);
    T[k * 65 + n4 + 0] = v.x; T[k * 65 + n4 + 1] = v.y; T[k * 65 + n4 + 2] = v.z; T[k * 65 + n4 + 3] = v.w;
  }
  __syncthreads();
  const int n = tid >> 3, kc = tid & 7;
  uint4 o;
  o.x = pack_bf2(T[(kc * 8 + 0) * 65 + n], T[(kc * 8 + 1) * 65 + n]);
  o.y = pack_bf2(T[(kc * 8 + 2) * 65 + n], T[(kc * 8 + 3) * 65 + n]);
  o.z = pack_bf2(T[(kc * 8 + 4) * 65 + n], T[(kc * 8 + 5) * 65 + n]);
  o.w = pack_bf2(T[(kc * 8 + 6) * 65 + n], T[(kc * 8 + 7) * 65 + n]);
  *(uint4*)(dst + (size_t)(n0 + n) * ld_dst + k0 + kc * 8) = o;
  __syncthreads();
}

DI void phase0(const Params& p, unsigned char* smem) {
  float* T = (float*)smem;
  ushort_t* win = (ushort_t*)(p.ws + OFF_WIN);
  ushort_t* wmg = (ushort_t*)(p.ws + OFF_WMG);
  ushort_t* wpa = (ushort_t*)(p.ws + OFF_WPA);
  ushort_t* wpb = (ushort_t*)(p.ws + OFF_WPB);
  ushort_t* wo = (ushort_t*)(p.ws + OFF_WO);
  ushort_t* wl = (ushort_t*)(p.ws + OFF_WL);
  float* mod = (float*)(p.ws + OFF_MOD);
  constexpr int T_IN = 16 * 56, T_MG = 16 * 32, T_PA = 8 * 16, T_PB = 8 * 16, T_O = 16 * 16, T_L = 32, T_MOD = 48;
  constexpr int TOTAL = T_MOD + T_IN + T_MG + T_PA + T_PB + T_O + T_L;
  for (int t = blockIdx.x; t < TOTAL; t += gridDim.x) {
    int u = t;
    if (u < T_MOD) {
      float* sil = T;
      float* red = T + 3072;
      const int tid = threadIdx.x;
      for (int i = tid; i < 3072; i += NTH) {
        const int v = i >> 10, k = i & 1023;
        const float cv = (v < 2) ? p.c[v * 1024 + k] : p.c_ctx[k];
        sil[i] = siluf(cv);
      }
      __syncthreads();
      const int n = tid & 63, ksl = tid >> 6, n0 = u * 64;
      float a0 = 0.f, a1 = 0.f, a2 = 0.f;
      for (int k = ksl * 128; k < ksl * 128 + 128; ++k) {
        const float w = p.w_ada[(size_t)k * 3072 + n0 + n];
        a0 = fmaf(sil[k], w, a0); a1 = fmaf(sil[1024 + k], w, a1); a2 = fmaf(sil[2048 + k], w, a2);
      }
      red[(ksl * 3 + 0) * 64 + n] = a0; red[(ksl * 3 + 1) * 64 + n] = a1; red[(ksl * 3 + 2) * 64 + n] = a2;
      __syncthreads();
      if (tid < 192) {
        const int v = tid >> 6, nn = tid & 63;
        float s = 0.f;
#pragma unroll
        for (int q = 0; q < 8; ++q) s += red[(q * 3 + v) * 64 + nn];
        mod[v * 3072 + n0 + nn] = s + p.b_ada[n0 + nn];
      }
      __syncthreads();
      continue;
    }
    u -= T_MOD;
    if (u < T_IN) { transpose_tile(p.w_in, INW, win, 1024, (u / 56) * 64, (u % 56) * 64, T); continue; }
    u -= T_IN;
    if (u < T_MG) { transpose_tile(p.w_mg, 2048, wmg, 1024, (u / 32) * 64, (u % 32) * 64, T); continue; }
    u -= T_MG;
    if (u < T_PA) { transpose_tile(p.w_pa, 1024, wpa, 512, (u / 16) * 64, (u % 16) * 64, T); continue; }
    u -= T_PA;
    if (u < T_PB) { transpose_tile(p.w_pb, 1024, wpb, 512, (u / 16) * 64, (u % 16) * 64, T); continue; }
    u -= T_PB;
    if (u < T_O) { transpose_tile(p.w_o, 1024, wo, 1024, (u / 16) * 64, (u % 16) * 64, T); continue; }
    u -= T_O;
    {
      const int which = u >> 4, dir = (u >> 3) & 1, nt = u & 7;
      const float* src = (which ? p.a_up : p.w_up) + (size_t)dir * 64 * 512;
      transpose_tile(src, 512, wl + (size_t)((dir * 2 + which) * 512) * 64, 64, 0, nt * 64, T);
    }
  }
}

DI void phase_h(const Params& p) {
  const float* mod = (const float*)(p.ws + OFF_MOD);
  ushort_t* H = (ushort_t*)(p.ws + OFF_SH);
  const int lane = threadIdx.x & 63, l16 = lane & 15, gw = blockIdx.x * 8 + (threadIdx.x >> 6);
#pragma unroll 1
  for (int r4 = gw * 4; r4 < NT; r4 += gridDim.x * 32) {
    const int row = r4 + (lane >> 4);
    const float* src = (row < NX) ? p.x + (size_t)row * DM : p.ctx + (size_t)(row - NX) * DM;
    const float* md = mod + ((row < NX) ? (row / SEQ) : 2) * 3072;
    float4 v[16];
    const float rstd = ln_rows4(src, l16, v);
#pragma unroll
    for (int i = 0; i < 16; ++i) {
      const int col = l16 * 4 + 64 * i;
      const float4 sh = *(const float4*)(md + col), sc = *(const float4*)(md + 1024 + col);
      uint2 o;
      o.x = pack_bf2(v[i].x * rstd * (1.f + sc.x) + sh.x, v[i].y * rstd * (1.f + sc.y) + sh.y);
      o.y = pack_bf2(v[i].z * rstd * (1.f + sc.z) + sh.z, v[i].w * rstd * (1.f + sc.w) + sh.w);
      *(uint2*)(H + (size_t)row * DM + col) = o;
    }
  }
}

DI void phase_gemm1(const Params& p, unsigned char* smem) {
  ushort_t* As = (ushort_t*)smem;
  ushort_t* Bs = As + 2 * 256 * LDK;
  const ushort_t* H = (const ushort_t*)(p.ws + OFF_SH);
  const ushort_t* W = (const ushort_t*)(p.ws + OFF_WIN);
  ushort_t* zq = (ushort_t*)(p.ws + OFF_ZQ);
  ushort_t* zg = (ushort_t*)(p.ws + OFF_ZG);
  ushort_t* zm = (ushort_t*)p.out;
  const int tid = threadIdx.x, wave = tid >> 6, lane = tid & 63, l31 = lane & 31, hh = lane >> 5;
  const int wrow0 = (wave & 3) * 64, wcol0 = (wave >> 2) * 64;
  constexpr int MT = NT / 256, NTL = INW / 128;
  for (int t = blockIdx.x; t < MT * NTL; t += gridDim.x) {
    const int mt = t / NTL, nt = t % NTL;
    const bool is_g = (nt >= 6 && nt < 10) || nt >= 24;
    if (is_g && mt >= NX / 256) continue;
    const int row0 = mt * 256, col0 = nt * 128;
    f32x16 acc[1][2][2];
#pragma unroll
    for (int a = 0; a < 2; ++a)
#pragma unroll
      for (int b = 0; b < 2; ++b) acc[0][a][b] = zero16();
    auto aload = [&](int r, int k) { return *(const uint4*)(H + (size_t)(row0 + r) * DM + k); };
    auto bload = [&](int w, int n, int k) { return *(const uint4*)(W + (size_t)(col0 + n) * DM + k); };
    gemm_pass<256, 128, 2, 2, 1>(acc, aload, bload, DM, As, Bs, wrow0, wcol0, tid);
    ushort_t* dst; int ld, cbase;
    if (nt < 6) { dst = zq; ld = 768; cbase = col0; }
    else if (nt < 10) { dst = zg; ld = 1024; cbase = col0 - 768; }
    else if (nt < 24) { dst = zm; ld = 1792; cbase = col0 - 1280; }
    else { dst = zg; ld = 1024; cbase = 512 + col0 - 3072; }
#pragma unroll
    for (int mi = 0; mi < 2; ++mi)
#pragma unroll
      for (int ni = 0; ni < 2; ++ni)
#pragma unroll
        for (int i = 0; i < 16; ++i) {
          const int row = row0 + wrow0 + mi * 32 + crow(i, hh), col = cbase + wcol0 + ni * 32 + l31;
          dst[(size_t)row * ld + col] = f2bf(acc[0][mi][ni][i]);
        }
  }
}

DI int vperm(int key) { const int g = key >> 4, kq = key & 15; return g * 16 + 8 * ((kq >> 2) & 1) + (kq & 3) + 4 * (kq >> 3); }
DI void phase_qkv(const Params& p) {
  const ushort_t* zq = (const ushort_t*)(p.ws + OFF_ZQ);
  ushort_t* QB = (ushort_t*)(p.ws + OFF_QB);
  ushort_t* KB = (ushort_t*)(p.ws + OFF_KB);
  ushort_t* VB = (ushort_t*)(p.ws + OFF_VB);
  const int lane = threadIdx.x & 63, gw = blockIdx.x * 8 + (threadIdx.x >> 6);
  const int j = lane & 31, half = lane >> 5, axis = j >> 4, f = j & 15;
  const int d1 = axis * 32 + f, d2 = d1 + 16;
  const float inv = powf(10000.f, -(float)f * (1.f / 16.f));
  const float gq1 = p.q_norm[d1], gq2 = p.q_norm[d2], gk1 = p.k_norm[d1], gk2 = p.k_norm[d2];
  for (int row = gw; row < NT; row += gridDim.x * 8) {
    const bool isx = row < NX;
    const int b = isx ? row / SEQ : (row - NX) / CTXL;
    const int t = isx ? row % SEQ : (row - NX) % CTXL;
    const int pos = isx ? CTXL + t : t;
    const ushort_t* z = zq + (size_t)row * 768;
    float cs = 1.f, sn = 0.f;
    if (isx) { const float ang = (float)(axis ? (t & 63) : (t >> 6)) * inv; sincosf(ang, &sn, &cs); }
#pragma unroll
    for (int it = 0; it < 5; ++it) {
      const int hd = it * 2 + half;
      if (!isx && hd < 8) continue;
      const float v1 = bf2f(z[hd * 64 + d1]), v2 = bf2f(z[hd * 64 + d2]);
      float ss = v1 * v1 + v2 * v2;
#pragma unroll
      for (int o = 16; o >= 1; o >>= 1) ss += __shfl_xor(ss, o, 64);
      const float rms = rsqrtf(ss * (1.f / 64.f) + QK_EPS);
      const bool isq = hd < 8;
      const float y1 = v1 * rms * (isq ? gq1 : gk1), y2 = v2 * rms * (isq ? gq2 : gk2);
      float o1 = y1 * cs - y2 * sn, o2 = y2 * cs + y1 * sn;
      if (isq) {
        ushort_t* dst = QB + ((size_t)(b * 8 + hd) * SEQ + t) * 64;
        dst[d1] = f2bf(o1 * QSCALE); dst[d2] = f2bf(o2 * QSCALE);
      } else {
        ushort_t* dst = KB + ((size_t)(b * 2 + (hd - 8)) * LTOT + pos) * 64;
        dst[d1] = f2bf(o1); dst[d2] = f2bf(o2);
      }
    }
    {
      const size_t tb = (size_t)(pos >> 6) * 4096 + lane * 64 + vperm(pos & 63);
      VB[(size_t)(b * 2 + 0) * LTOT * 64 + tb] = z[640 + lane];
      VB[(size_t)(b * 2 + 1) * LTOT * 64 + tb] = z[704 + lane];
    }
  }
}

DI void phase_rwkv_prep(const Params& p, unsigned char* smem) {
  float* kbuf = (float*)smem;
  ushort_t* codes = (ushort_t*)(smem + 65536);
  float* invn = (float*)(smem + 65536 + 32 * 264 * 2);
  const ushort_t* zm = (const ushort_t*)p.out;
  const ushort_t* WL = (const ushort_t*)(p.ws + OFF_WL);
  ushort_t* SH = (ushort_t*)(p.ws + OFF_SH);
  ushort_t* DR = (ushort_t*)(p.ws + OFF_DR);
  const int tid = threadIdx.x, wave = tid >> 6, lane = tid & 63, l31 = lane & 31, hh = lane >> 5;
  for (int tt = blockIdx.x; tt < NT / 32; tt += gridDim.x) {
    const int row0 = tt * 32;
    int b, t0, len, pbase;
    if (row0 < NX) { b = row0 / SEQ; t0 = row0 % SEQ; len = SEQ; pbase = CTXL; }
    else { const int rc = row0 - NX; b = rc / CTXL; t0 = rc % CTXL; len = CTXL; pbase = 0; }
    __syncthreads();
    for (int id = tid; id < 32 * 224; id += NTH) {
      const int i = id / 224, c0 = (id % 224) * 8;
      const int t = t0 + i;
      const ushort_t* zr = zm + (size_t)(row0 + i) * 1792 + c0;
      const uint4 zc = *(const uint4*)zr;
      uint4 zp = make_uint4(0, 0, 0, 0), zn = make_uint4(0, 0, 0, 0);
      if (t > 0) zp = *(const uint4*)(zr - 1792);
      if (t < len - 1) zn = *(const uint4*)(zr + 1792);
      const float4 mp0 = *(const float4*)(p.mu_prev + c0), mp1 = *(const float4*)(p.mu_prev + c0 + 4);
      const float4 mn0 = *(const float4*)(p.mu_next + c0), mn1 = *(const float4*)(p.mu_next + c0 + 4);
      const unsigned zcw[4] = {zc.x, zc.y, zc.z, zc.w}, zpw[4] = {zp.x, zp.y, zp.z, zp.w}, znw[4] = {zn.x, zn.y, zn.z, zn.w};
      const float mpv[8] = {mp0.x, mp0.y, mp0.z, mp0.w, mp1.x, mp1.y, mp1.z, mp1.w};
      const float mnv[8] = {mn0.x, mn0.y, mn0.z, mn0.w, mn1.x, mn1.y, mn1.z, mn1.w};
      float s[8];
#pragma unroll
      for (int q = 0; q < 4; ++q) {
        const float c_lo = bflo(zcw[q]), c_hi = bfhi(zcw[q]);
        s[2 * q] = c_lo + mpv[2 * q] * (bflo(zpw[q]) - c_lo) + mnv[2 * q] * (bflo(znw[q]) - c_lo);
        s[2 * q + 1] = c_hi + mpv[2 * q + 1] * (bfhi(zpw[q]) - c_hi) + mnv[2 * q + 1] * (bfhi(znw[q]) - c_hi);
      }
      const int pp = pbase + t;
      if (c0 < 512 || (c0 >= 1024 && c0 < 1536)) {
        const int cc = (c0 < 512) ? c0 : c0 - 1024, which = (c0 < 512) ? 1 : 2;
        const int head = cc >> 6, d = cc & 63;
        uint4 o;
        o.x = pack_h2(s[0], s[1]); o.y = pack_h2(s[2], s[3]); o.z = pack_h2(s[4], s[5]); o.w = pack_h2(s[6], s[7]);
        *(uint4*)(SH + (((size_t)(b * 8 + head) * LTOT + pp) * 3 + which) * 64 + d) = o;
      } else if (c0 < 1024) {
        float* kd = kbuf + i * 512 + (c0 - 512);
        *(float4*)kd = make_float4(s[0], s[1], s[2], s[3]);
        *(float4*)(kd + 4) = make_float4(s[4], s[5], s[6], s[7]);
      } else {
        const int cc = c0 - 1536;
        if (cc < 128) {
#pragma unroll
          for (int q = 0; q < 8; ++q) s[q] = tanhf(s[q]);
        }
        uint4 o;
        o.x = pack_bf2(s[0], s[1]); o.y = pack_bf2(s[2], s[3]); o.z = pack_bf2(s[4], s[5]); o.w = pack_bf2(s[6], s[7]);
        *(uint4*)(codes + i * 264 + cc) = o;
      }
    }
    __syncthreads();
    {
      const int i = tid >> 4, head = (tid >> 1) & 7, hf = tid & 1;
      float ss = 0.f;
#pragma unroll 8
      for (int q = 0; q < 32; ++q) {
        const int n = head * 64 + hf * 32 + q;
        const float v = kbuf[i * 512 + n] * p.k_k[n];
        ss = fmaf(v, v, ss);
      }
      ss += __shfl_xor(ss, 1, 64);
      if (hf == 0) invn[i * 8 + head] = 1.f / fmaxf(sqrtf(ss), 1e-12f);
    }
    __syncthreads();
#pragma unroll 1
    for (int q4 = 0; q4 < 4; ++q4) {
      const int pr = wave * 4 + q4, dir = pr >> 4, ct = pr & 15;
      f32x16 aw = zero16(), aa = zero16();
#pragma unroll
      for (int ks = 0; ks < 4; ++ks) {
        const bf16x8 fw = *(const bf16x8*)&codes[l31 * 264 + dir * 64 + ks * 16 + hh * 8];
        const bf16x8 fa = *(const bf16x8*)&codes[l31 * 264 + 128 + dir * 64 + ks * 16 + hh * 8];
        const bf16x8 bw = *(const bf16x8*)&WL[(size_t)((dir * 2 + 0) * 512 + ct * 32 + l31) * 64 + ks * 16 + hh * 8];
        const bf16x8 ba = *(const bf16x8*)&WL[(size_t)((dir * 2 + 1) * 512 + ct * 32 + l31) * 64 + ks * 16 + hh * 8];
        aw = MFMA(fw, bw, aw);
        aa = MFMA(fa, ba, aa);
      }
      const int n = ct * 32 + l31, head = n >> 6, d = n & 63;
      const float w0v = p.w0[dir * 512 + n], a0v = p.a0[dir * 512 + n], kkw = p.k_k[n], kaw = p.k_a[n];
      const size_t cbase = (size_t)(b * 8 + head) * LTOT;
#pragma unroll
      for (int i = 0; i < 16; ++i) {
        const int ti = crow(i, hh);
        const int pp = pbase + t0 + ti;
        const float wpre = aw[i] + w0v;
        const float e = 0.60653065971263342f * sigmf(wpre);
        const float xdec = 1.f - __expf(-e);
        const float a = sigmf(aa[i] + a0v);
        const float kv = kbuf[ti * 512 + n];
        const float kkv = kv * kkw * invn[ti * 8 + head];
        const float kd = kv * (1.f + (a - 1.f) * kaw);
        ushort_t* dr = DR + ((((size_t)dir * 16) * LTOT + cbase + pp) * 3) * 64 + d;
        dr[0] = f2h(-xdec); dr[64] = f2h(kd); dr[128] = f2h(kkv * a);
        if (dir == 0) SH[((cbase + pp) * 3) * 64 + d] = f2h(kkv);
      }
    }
  }
}

DI int tau_to_pos(int dir, int tau) { return dir == 0 ? tau : (tau < CTXL ? CTXL - 1 - tau : LTOT - 1 - (tau - CTXL)); }


DI void fm_lo(float& acc, float a, uint32_t w) { asm("v_fma_mix_f32 %0, %1, %2, %0 op_sel_hi:[0,1,0]" : "+v"(acc) : "v"(a), "s"(w)); }
DI void fm_hi(float& acc, float a, uint32_t w) { asm("v_fma_mix_f32 %0, %1, %2, %0 op_sel:[0,1,0] op_sel_hi:[0,1,0]" : "+v"(acc) : "v"(a), "s"(w)); }
DI void fx_lo(float& s, uint32_t w) { asm("v_fma_mix_f32 %0, %0, %1, %0 op_sel_hi:[0,1,0]" : "+v"(s) : "s"(w)); }
DI void fx_hi(float& s, uint32_t w) { asm("v_fma_mix_f32 %0, %0, %1, %0 op_sel:[0,1,0] op_sel_hi:[0,1,0]" : "+v"(s) : "s"(w)); }
constexpr int PFD = 2, SEG = 65;
static_assert(CH % SEG == 0, "segments");
DI void scan_prefetch(u32x4& pfr, const ushort_t* shc, const ushort_t* drc, int pos, int lane) {
  const ushort_t* a = (lane < 24) ? shc + (size_t)pos * 192 + lane * 8 : drc + (size_t)pos * 192 + (lane < 48 ? lane - 24 : 23) * 8;
  asm volatile("global_load_dwordx4 %0, %1, off" : "+v"(pfr) : "v"(a) : "memory");
}
DI void scan_stage_v(ushort_t* vbuf, const ushort_t* shc, int dir, int tau0, int lane) {
#pragma unroll
  for (int i = 0; i < (SEG * 8 + 63) / 64; ++i) {
    const int id = i * 64 + lane, st = id >> 3;
    if (st < SEG) *(uint4*)&vbuf[st * 64 + (id & 7) * 8] = *(const uint4*)(shc + (size_t)tau_to_pos(dir, tau0 + st) * 192 + 128 + (id & 7) * 8);
  }
}
struct ScanRec { uint32_t sh, dr, bb; ushort_t v; };
DI ScanRec scan_load(const ushort_t* shc, const ushort_t* drc, int pos, int lane) {
  ScanRec r;
  const ushort_t* s = shc + (size_t)pos * 192;
  const uint32_t* d = (const uint32_t*)(drc + (size_t)pos * 192);
  r.sh = ((const uint32_t*)s)[lane];
  r.v = s[128 + lane];
  r.dr = d[lane];
  r.bb = d[64 + (lane & 31)];
  return r;
}
#define MIXLO " op_sel_hi:[0,1,0]\n\t"
#define MIXHI " op_sel:[0,1,0] op_sel_hi:[0,1,0]\n\t"
template <int L>
DI void dot4(float& a0, float& a1, float& a2, float& a3, float (&S)[64], uint32_t src) {
  uint32_t t0, t1, t2, t3;
  asm("v_readlane_b32 %4, %8, %9\n\tv_readlane_b32 %5, %8, %10\n\tv_readlane_b32 %6, %8, %11\n\tv_readlane_b32 %7, %8, %12\n\t"
      "v_fma_mix_f32 %0, %13, %4, %0" MIXLO "v_fma_mix_f32 %1, %14, %4, %1" MIXHI
      "v_fma_mix_f32 %2, %15, %5, %2" MIXLO "v_fma_mix_f32 %3, %16, %5, %3" MIXHI
      "v_fma_mix_f32 %0, %17, %6, %0" MIXLO "v_fma_mix_f32 %1, %18, %6, %1" MIXHI
      "v_fma_mix_f32 %2, %19, %7, %2" MIXLO "v_fma_mix_f32 %3, %20, %7, %3" MIXHI
      : "+v"(a0), "+v"(a1), "+v"(a2), "+v"(a3), "=&s"(t0), "=&s"(t1), "=&s"(t2), "=&s"(t3)
      : "v"(src), "n"(L), "n"(L + 1), "n"(L + 2), "n"(L + 3),
        "v"(S[2 * (L & 31)]), "v"(S[2 * (L & 31) + 1]), "v"(S[2 * (L & 31) + 2]), "v"(S[2 * (L & 31) + 3]),
        "v"(S[2 * (L & 31) + 4]), "v"(S[2 * (L & 31) + 5]), "v"(S[2 * (L & 31) + 6]), "v"(S[2 * (L & 31) + 7]));
}
template <int L>
DI void upd4(float (&S)[64], uint32_t dr, uint32_t bb, float vv, float nsk) {
  uint32_t x0, x1, x2, x3, k0, k1, k2, k3, b0, b1, b2, b3;
  asm("v_readlane_b32 %8, %20, %22\n\tv_readlane_b32 %9, %20, %23\n\tv_readlane_b32 %10, %20, %24\n\tv_readlane_b32 %11, %20, %25\n\t"
      "v_readlane_b32 %12, %20, %26\n\tv_readlane_b32 %13, %20, %27\n\tv_readlane_b32 %14, %20, %28\n\tv_readlane_b32 %15, %20, %29\n\t"
      "v_readlane_b32 %16, %21, %22\n\tv_readlane_b32 %17, %21, %23\n\tv_readlane_b32 %18, %21, %24\n\tv_readlane_b32 %19, %21, %25\n\t"
      "v_fma_mix_f32 %0, %0, %8, %0" MIXLO "v_fma_mix_f32 %1, %1, %8, %1" MIXHI
      "v_fma_mix_f32 %2, %2, %9, %2" MIXLO "v_fma_mix_f32 %3, %3, %9, %3" MIXHI
      "v_fma_mix_f32 %4, %4, %10, %4" MIXLO "v_fma_mix_f32 %5, %5, %10, %5" MIXHI
      "v_fma_mix_f32 %6, %6, %11, %6" MIXLO "v_fma_mix_f32 %7, %7, %11, %7" MIXHI
      "v_fma_mix_f32 %0, %30, %12, %0" MIXLO "v_fma_mix_f32 %1, %30, %12, %1" MIXHI
      "v_fma_mix_f32 %2, %30, %13, %2" MIXLO "v_fma_mix_f32 %3, %30, %13, %3" MIXHI
      "v_fma_mix_f32 %4, %30, %14, %4" MIXLO "v_fma_mix_f32 %5, %30, %14, %5" MIXHI
      "v_fma_mix_f32 %6, %30, %15, %6" MIXLO "v_fma_mix_f32 %7, %30, %15, %7" MIXHI
      "v_fma_mix_f32 %0, %31, %16, %0" MIXLO "v_fma_mix_f32 %1, %31, %16, %1" MIXHI
      "v_fma_mix_f32 %2, %31, %17, %2" MIXLO "v_fma_mix_f32 %3, %31, %17, %3" MIXHI
      "v_fma_mix_f32 %4, %31, %18, %4" MIXLO "v_fma_mix_f32 %5, %31, %18, %5" MIXHI
      "v_fma_mix_f32 %6, %31, %19, %6" MIXLO "v_fma_mix_f32 %7, %31, %19, %7" MIXHI
      : "+v"(S[2 * L]), "+v"(S[2 * L + 1]), "+v"(S[2 * L + 2]), "+v"(S[2 * L + 3]), "+v"(S[2 * L + 4]), "+v"(S[2 * L + 5]), "+v"(S[2 * L + 6]), "+v"(S[2 * L + 7]),
        "=&s"(x0), "=&s"(x1), "=&s"(x2), "=&s"(x3), "=&s"(k0), "=&s"(k1), "=&s"(k2), "=&s"(k3), "=&s"(b0), "=&s"(b1), "=&s"(b2), "=&s"(b3)
      : "v"(dr), "v"(bb), "n"(L), "n"(L + 1), "n"(L + 2), "n"(L + 3), "n"(L + 32), "n"(L + 33), "n"(L + 34), "n"(L + 35), "v"(vv), "v"(nsk));
}
template <int L>
DI void dot4_2(float& a0, float& a1, float& c0, float& c1, float (&SU)[64], float (&SP)[64], uint32_t src) {
  uint32_t t0, t1, t2, t3;
  asm("v_readlane_b32 %4, %8, %9\n\tv_readlane_b32 %5, %8, %10\n\tv_readlane_b32 %6, %8, %11\n\tv_readlane_b32 %7, %8, %12\n\t"
      "v_fma_mix_f32 %0, %13, %4, %0" MIXLO "v_fma_mix_f32 %1, %14, %4, %1" MIXHI
      "v_fma_mix_f32 %2, %21, %4, %2" MIXLO "v_fma_mix_f32 %3, %22, %4, %3" MIXHI
      "v_fma_mix_f32 %0, %15, %5, %0" MIXLO "v_fma_mix_f32 %1, %16, %5, %1" MIXHI
      "v_fma_mix_f32 %2, %23, %5, %2" MIXLO "v_fma_mix_f32 %3, %24, %5, %3" MIXHI
      "v_fma_mix_f32 %0, %17, %6, %0" MIXLO "v_fma_mix_f32 %1, %18, %6, %1" MIXHI
      "v_fma_mix_f32 %2, %25, %6, %2" MIXLO "v_fma_mix_f32 %3, %26, %6, %3" MIXHI
      "v_fma_mix_f32 %0, %19, %7, %0" MIXLO "v_fma_mix_f32 %1, %20, %7, %1" MIXHI
      "v_fma_mix_f32 %2, %27, %7, %2" MIXLO "v_fma_mix_f32 %3, %28, %7, %3" MIXHI
      : "+v"(a0), "+v"(a1), "+v"(c0), "+v"(c1), "=&s"(t0), "=&s"(t1), "=&s"(t2), "=&s"(t3)
      : "v"(src), "n"(L), "n"(L + 1), "n"(L + 2), "n"(L + 3),
        "v"(SU[2 * L]), "v"(SU[2 * L + 1]), "v"(SU[2 * L + 2]), "v"(SU[2 * L + 3]), "v"(SU[2 * L + 4]), "v"(SU[2 * L + 5]), "v"(SU[2 * L + 6]), "v"(SU[2 * L + 7]),
        "v"(SP[2 * L]), "v"(SP[2 * L + 1]), "v"(SP[2 * L + 2]), "v"(SP[2 * L + 3]), "v"(SP[2 * L + 4]), "v"(SP[2 * L + 5]), "v"(SP[2 * L + 6]), "v"(SP[2 * L + 7]));
}
template <int L>
DI void upd4_2(float (&SU)[64], float (&SP)[64], uint32_t dr, uint32_t bb, float vv, float nskU, float nskP) {
  uint32_t x0, x1, x2, x3, k0, k1, k2, k3, b0, b1, b2, b3;
  asm("v_readlane_b32 %16, %28, %30\n\tv_readlane_b32 %17, %28, %31\n\tv_readlane_b32 %18, %28, %32\n\tv_readlane_b32 %19, %28, %33\n\t"
      "v_readlane_b32 %20, %28, %34\n\tv_readlane_b32 %21, %28, %35\n\tv_readlane_b32 %22, %28, %36\n\tv_readlane_b32 %23, %28, %37\n\t"
      "v_readlane_b32 %24, %29, %30\n\tv_readlane_b32 %25, %29, %31\n\tv_readlane_b32 %26, %29, %32\n\tv_readlane_b32 %27, %29, %33\n\t"
      "v_fma_mix_f32 %0, %0, %16, %0" MIXLO "v_fma_mix_f32 %1, %1, %16, %1" MIXHI
      "v_fma_mix_f32 %2, %2, %17, %2" MIXLO "v_fma_mix_f32 %3, %3, %17, %3" MIXHI
      "v_fma_mix_f32 %4, %4, %18, %4" MIXLO "v_fma_mix_f32 %5, %5, %18, %5" MIXHI
      "v_fma_mix_f32 %6, %6, %19, %6" MIXLO "v_fma_mix_f32 %7, %7, %19, %7" MIXHI
      "v_fma_mix_f32 %8, %8, %16, %8" MIXLO "v_fma_mix_f32 %9, %9, %16, %9" MIXHI
      "v_fma_mix_f32 %10, %10, %17, %10" MIXLO "v_fma_mix_f32 %11, %11, %17, %11" MIXHI
      "v_fma_mix_f32 %12, %12, %18, %12" MIXLO "v_fma_mix_f32 %13, %13, %18, %13" MIXHI
      "v_fma_mix_f32 %14, %14, %19, %14" MIXLO "v_fma_mix_f32 %15, %15, %19, %15" MIXHI
      "v_fma_mix_f32 %0, %38, %20, %0" MIXLO "v_fma_mix_f32 %1, %38, %20, %1" MIXHI
      "v_fma_mix_f32 %2, %38, %21, %2" MIXLO "v_fma_mix_f32 %3, %38, %21, %3" MIXHI
      "v_fma_mix_f32 %4, %38, %22, %4" MIXLO "v_fma_mix_f32 %5, %38, %22, %5" MIXHI
      "v_fma_mix_f32 %6, %38, %23, %6" MIXLO "v_fma_mix_f32 %7, %38, %23, %7" MIXHI
      "v_fma_mix_f32 %0, %39, %24, %0" MIXLO "v_fma_mix_f32 %1, %39, %24, %1" MIXHI
      "v_fma_mix_f32 %2, %39, %25, %2" MIXLO "v_fma_mix_f32 %3, %39, %25, %3" MIXHI
      "v_fma_mix_f32 %4, %39, %26, %4" MIXLO "v_fma_mix_f32 %5, %39, %26, %5" MIXHI
      "v_fma_mix_f32 %6, %39, %27, %6" MIXLO "v_fma_mix_f32 %7, %39, %27, %7" MIXHI
      "v_fma_mix_f32 %8, %40, %24, %8" MIXLO "v_fma_mix_f32 %9, %40, %24, %9" MIXHI
      "v_fma_mix_f32 %10, %40, %25, %10" MIXLO "v_fma_mix_f32 %11, %40, %25, %11" MIXHI
      "v_fma_mix_f32 %12, %40, %26, %12" MIXLO "v_fma_mix_f32 %13, %40, %26, %13" MIXHI
      "v_fma_mix_f32 %14, %40, %27, %14" MIXLO "v_fma_mix_f32 %15, %40, %27, %15" MIXHI
      : "+v"(SU[2 * L]), "+v"(SU[2 * L + 1]), "+v"(SU[2 * L + 2]), "+v"(SU[2 * L + 3]), "+v"(SU[2 * L + 4]), "+v"(SU[2 * L + 5]), "+v"(SU[2 * L + 6]), "+v"(SU[2 * L + 7]),
        "+v"(SP[2 * L]), "+v"(SP[2 * L + 1]), "+v"(SP[2 * L + 2]), "+v"(SP[2 * L + 3]), "+v"(SP[2 * L + 4]), "+v"(SP[2 * L + 5]), "+v"(SP[2 * L + 6]), "+v"(SP[2 * L + 7]),
        "=&s"(x0), "=&s"(x1), "=&s"(x2), "=&s"(x3), "=&s"(k0), "=&s"(k1), "=&s"(k2), "=&s"(k3), "=&s"(b0), "=&s"(b1), "=&s"(b2), "=&s"(b3)
      : "v"(dr), "v"(bb), "n"(L), "n"(L + 1), "n"(L + 2), "n"(L + 3), "n"(L + 32), "n"(L + 33), "n"(L + 34), "n"(L + 35), "v"(vv), "v"(nskU), "v"(nskP));
}
DI void scan_step2(float (&SU)[64], float (&SP)[64], const ScanRec& c, float vv) {
  float a0 = 0.f, a1 = 0.f, c0 = 0.f, c1 = 0.f;
  dot4_2<0>(a0, a1, c0, c1, SU, SP, c.sh); dot4_2<4>(a0, a1, c0, c1, SU, SP, c.sh); dot4_2<8>(a0, a1, c0, c1, SU, SP, c.sh); dot4_2<12>(a0, a1, c0, c1, SU, SP, c.sh);
  dot4_2<16>(a0, a1, c0, c1, SU, SP, c.sh); dot4_2<20>(a0, a1, c0, c1, SU, SP, c.sh); dot4_2<24>(a0, a1, c0, c1, SU, SP, c.sh); dot4_2<28>(a0, a1, c0, c1, SU, SP, c.sh);
  const float nU = -(a0 + a1), nP = -(c0 + c1);
  upd4_2<0>(SU, SP, c.dr, c.bb, vv, nU, nP); upd4_2<4>(SU, SP, c.dr, c.bb, vv, nU, nP); upd4_2<8>(SU, SP, c.dr, c.bb, vv, nU, nP); upd4_2<12>(SU, SP, c.dr, c.bb, vv, nU, nP);
  upd4_2<16>(SU, SP, c.dr, c.bb, vv, nU, nP); upd4_2<20>(SU, SP, c.dr, c.bb, vv, nU, nP); upd4_2<24>(SU, SP, c.dr, c.bb, vv, nU, nP); upd4_2<28>(SU, SP, c.dr, c.bb, vv, nU, nP);
}
template <bool WITH_OUT>
DI float scan_step(float (&S)[64], const ScanRec& c, float vv) {
  float s0 = 0.f, s1 = 0.f, s2 = 0.f, s3 = 0.f;
  dot4<0>(s0, s1, s2, s3, S, c.sh); dot4<4>(s0, s1, s2, s3, S, c.sh); dot4<8>(s0, s1, s2, s3, S, c.sh); dot4<12>(s0, s1, s2, s3, S, c.sh);
  dot4<16>(s0, s1, s2, s3, S, c.sh); dot4<20>(s0, s1, s2, s3, S, c.sh); dot4<24>(s0, s1, s2, s3, S, c.sh); dot4<28>(s0, s1, s2, s3, S, c.sh);
  const float nsk = -((s0 + s1) + (s2 + s3));
  upd4<0>(S, c.dr, c.bb, vv, nsk); upd4<4>(S, c.dr, c.bb, vv, nsk); upd4<8>(S, c.dr, c.bb, vv, nsk); upd4<12>(S, c.dr, c.bb, vv, nsk);
  upd4<16>(S, c.dr, c.bb, vv, nsk); upd4<20>(S, c.dr, c.bb, vv, nsk); upd4<24>(S, c.dr, c.bb, vv, nsk); upd4<28>(S, c.dr, c.bb, vv, nsk);
  float o0 = 0.f, o1 = 0.f, o2 = 0.f, o3 = 0.f;
  if (WITH_OUT) {
    dot4<32>(o0, o1, o2, o3, S, c.sh); dot4<36>(o0, o1, o2, o3, S, c.sh); dot4<40>(o0, o1, o2, o3, S, c.sh); dot4<44>(o0, o1, o2, o3, S, c.sh);
    dot4<48>(o0, o1, o2, o3, S, c.sh); dot4<52>(o0, o1, o2, o3, S, c.sh); dot4<56>(o0, o1, o2, o3, S, c.sh); dot4<60>(o0, o1, o2, o3, S, c.sh);
  }
  return (o0 + o1) + (o2 + o3);
}
constexpr int SPF = 3;
DI void phase_scanA(const Params& p, unsigned char* smem) {
  const ushort_t* SH = (const ushort_t*)(p.ws + OFF_SH);
  const ushort_t* DR = (const ushort_t*)(p.ws + OFF_DR);
  float* PU = p.out;
  const int lane = threadIdx.x & 63;
  ushort_t* vbuf = (ushort_t*)smem + (threadIdx.x >> 6) * (SEG * 64);
  const int gw = __builtin_amdgcn_readfirstlane(blockIdx.x * 8 + (threadIdx.x >> 6));
  u32x4 pfr = {0u, 0u, 0u, 0u};
  for (int task = gw; task < 32 * NCHUNK; task += gridDim.x * 8) {
    const int cd = task / NCHUNK, j = task % NCHUNK, dir = cd >> 4, c = cd & 15;
    float SU[64], SP[64];
#pragma unroll
    for (int k = 0; k < 64; ++k) { SU[k] = 0.f; SP[k] = (k == lane) ? 1.f : 0.f; }
    const ushort_t* shc = SH + (size_t)c * LTOT * 192;
    const ushort_t* drc = DR + (size_t)(dir * 16 + c) * LTOT * 192;
#pragma unroll 1
    for (int st = 0; st < PFD; ++st) scan_prefetch(pfr, shc, drc, tau_to_pos(dir, j * CH + st), lane);
#pragma unroll 1
    for (int sg = 0; sg < CH / SEG; ++sg) {
      scan_stage_v(vbuf, shc, dir, j * CH + sg * SEG, lane);
#pragma unroll 1
      for (int s2 = 0; s2 < SEG; ++s2) {
        const int st = sg * SEG + s2;
        const int pos = tau_to_pos(dir, j * CH + st);
        const ushort_t* shr = shc + (size_t)pos * 192;
        const ushort_t* drr = drc + (size_t)pos * 192;
        scan_prefetch(pfr, shc, drc, tau_to_pos(dir, j * CH + (st + PFD < CH ? st + PFD : CH - 1)), lane);
        const float vv = h2f(vbuf[s2 * 64 + lane]);
        u32x16 a0, a1, b0, b1;
        sload4(a0, a1, b0, b1, shr, drr);
        float u0 = 0.f, u1 = 0.f, u2 = 0.f, u3 = 0.f, q0 = 0.f, q1 = 0.f, q2 = 0.f, q3 = 0.f;
#pragma unroll
        for (int q = 0; q < 16; ++q) {
          fm_lo(u0, SU[2 * q], a0[q]); fm_hi(u1, SU[2 * q + 1], a0[q]); fm_lo(u2, SU[32 + 2 * q], a1[q]); fm_hi(u3, SU[33 + 2 * q], a1[q]);
          fm_lo(q0, SP[2 * q], a0[q]); fm_hi(q1, SP[2 * q + 1], a0[q]); fm_lo(q2, SP[32 + 2 * q], a1[q]); fm_hi(q3, SP[33 + 2 * q], a1[q]);
        }
        const float nU = -((u0 + u1) + (u2 + u3)), nP = -((q0 + q1) + (q2 + q3));
#pragma unroll
        for (int q = 0; q < 16; ++q) {
          fx_lo(SU[2 * q], b0[q]); fx_hi(SU[2 * q + 1], b0[q]); fx_lo(SU[32 + 2 * q], b1[q]); fx_hi(SU[33 + 2 * q], b1[q]);
          fx_lo(SP[2 * q], b0[q]); fx_hi(SP[2 * q + 1], b0[q]); fx_lo(SP[32 + 2 * q], b1[q]); fx_hi(SP[33 + 2 * q], b1[q]);
        }
        sload4(a0, a1, b0, b1, drr + 64, drr + 128);
#pragma unroll
        for (int q = 0; q < 16; ++q) { fm_lo(SU[2 * q], vv, a0[q]); fm_hi(SU[2 * q + 1], vv, a0[q]); fm_lo(SU[32 + 2 * q], vv, a1[q]); fm_hi(SU[33 + 2 * q], vv, a1[q]); }
#pragma unroll
        for (int q = 0; q < 16; ++q) {
          fm_lo(SU[2 * q], nU, b0[q]); fm_hi(SU[2 * q + 1], nU, b0[q]); fm_lo(SU[32 + 2 * q], nU, b1[q]); fm_hi(SU[33 + 2 * q], nU, b1[q]);
          fm_lo(SP[2 * q], nP, b0[q]); fm_hi(SP[2 * q + 1], nP, b0[q]); fm_lo(SP[32 + 2 * q], nP, b1[q]); fm_hi(SP[33 + 2 * q], nP, b1[q]);
        }
      }
    }
    float* dst = PU + (size_t)task * 2 * 4096 + lane * 64;
#pragma unroll
    for (int k = 0; k < 64; k += 4) {
      *(float4*)(dst + k) = make_float4(SU[k], SU[k + 1], SU[k + 2], SU[k + 3]);
      *(float4*)(dst + 4096 + k) = make_float4(SP[k], SP[k + 1], SP[k + 2], SP[k + 3]);
    }
  }
  asm volatile("s_waitcnt vmcnt(0)" ::: "memory");
  asm volatile("" :: "v"(pfr));
}

DI void phase_scanB(const Params& p, unsigned char* smem) {
  if (blockIdx.x >= 32) return;
  float* Sb = (float*)smem;
  float* Xb = Sb + 64 * 65;
  float* PU = p.out;
  const int cd = blockIdx.x, tid = threadIdx.x, wave = tid >> 6, lane = tid & 63, l31 = lane & 31, hh = lane >> 5;
  const int tile = wave & 3, tm = tile >> 1, tn = tile & 1, kh = wave >> 2;
  for (int i = tid; i < 64 * 65; i += NTH) Sb[i] = 0.f;
  constexpr int BPF = 4;
  float bP[BPF][16];
  f32x16 uT[BPF];
#pragma unroll
  for (int s = 0; s < BPF; ++s) uT[s] = zero16();
  auto fetch = [&](int j, float (&bp)[16], f32x16& ut) {
    const float* base = PU + (size_t)(cd * NCHUNK + j) * 2 * 4096;
#pragma unroll
    for (int kk = 0; kk < 16; ++kk) bp[kk] = base[4096 + (kh * 32 + 2 * kk + hh) * 64 + tn * 32 + l31];
    if (kh == 0) {
#pragma unroll
      for (int i = 0; i < 16; ++i) ut[i] = base[(tm * 32 + crow(i, hh)) * 64 + tn * 32 + l31];
    }
  };
  auto put_state = [&](int j, const f32x16& st) {
    float* base = PU + (size_t)(cd * NCHUNK + j) * 2 * 4096;
#pragma unroll
    for (int i = 0; i < 16; ++i) base[(tm * 32 + crow(i, hh)) * 64 + tn * 32 + l31] = st[i];
  };
#pragma unroll
  for (int s = 0; s < BPF; ++s) fetch(s, bP[s], uT[s]);
  if (kh == 0) put_state(0, zero16());
  __syncthreads();
#pragma unroll 1
  for (int j = 0; j < NCHUNK; ++j) {
    float nP[16];
    f32x16 nU = zero16();
    if (j + BPF < NCHUNK) fetch(j + BPF, nP, nU);
    f32x16 acc = (kh == 0) ? uT[0] : zero16();
#pragma unroll
    for (int kk = 0; kk < 16; ++kk) {
      const float a = Sb[(tm * 32 + l31) * 65 + kh * 32 + 2 * kk + hh];
      acc = __builtin_amdgcn_mfma_f32_32x32x2f32(a, bP[0][kk], acc, 0, 0, 0);
    }
    if (kh == 1) {
#pragma unroll
      for (int i = 0; i < 16; ++i) Xb[(tile * 16 + i) * 64 + lane] = acc[i];
    }
    __syncthreads();
    if (kh == 0) {
#pragma unroll
      for (int i = 0; i < 16; ++i) { acc[i] += Xb[(tile * 16 + i) * 64 + lane]; Sb[(tm * 32 + crow(i, hh)) * 65 + tn * 32 + l31] = acc[i]; }
      if (j + 1 < NCHUNK) put_state(j + 1, acc);
    }
#pragma unroll
    for (int s = 0; s + 1 < BPF; ++s) {
#pragma unroll
      for (int kk = 0; kk < 16; ++kk) bP[s][kk] = bP[s + 1][kk];
      uT[s] = uT[s + 1];
    }
#pragma unroll
    for (int kk = 0; kk < 16; ++kk) bP[BPF - 1][kk] = nP[kk];
    uT[BPF - 1] = nU;
    __syncthreads();
  }
}

DI void scan_stage_vr(ushort_t* vbuf, ushort_t* rbuf, const ushort_t* shc, int dir, int tau0, int lane) {
#pragma unroll
  for (int i = 0; i < (SEG * 8 + 63) / 64; ++i) {
    const int id = i * 64 + lane, st = id >> 3;
    if (st < SEG) {
      const ushort_t* rec = shc + (size_t)tau_to_pos(dir, tau0 + st) * 192 + (id & 7) * 8;
      *(uint4*)&vbuf[st * 64 + (id & 7) * 8] = *(const uint4*)(rec + 128);
      *(uint4*)&rbuf[st * 64 + (id & 7) * 8] = *(const uint4*)(rec + 64);
    }
  }
}
DI void fv_lo(float& acc, float a, uint32_t w) { asm("v_fma_mix_f32 %0, %1, %2, %0 op_sel_hi:[0,1,0]" : "+v"(acc) : "v"(a), "v"(w)); }
DI void fv_hi(float& acc, float a, uint32_t w) { asm("v_fma_mix_f32 %0, %1, %2, %0 op_sel:[0,1,0] op_sel_hi:[0,1,0]" : "+v"(acc) : "v"(a), "v"(w)); }
DI void phase_scanC(const Params& p, unsigned char* smem) {
  const ushort_t* SH = (const ushort_t*)(p.ws + OFF_SH);
  const ushort_t* DR = (const ushort_t*)(p.ws + OFF_DR);
  ushort_t* O = (ushort_t*)(p.ws + OFF_ZQ);
  const float* PU = p.out;
  const int lane = threadIdx.x & 63;
  ushort_t* vbuf = (ushort_t*)smem + (threadIdx.x >> 6) * (2 * SEG * 64);
  ushort_t* rbuf = vbuf + SEG * 64;
  const int gw = __builtin_amdgcn_readfirstlane(blockIdx.x * 8 + (threadIdx.x >> 6));
  u32x4 pfr = {0u, 0u, 0u, 0u};
  for (int task = gw; task < 32 * NCHUNK; task += gridDim.x * 8) {
    const int cd = task / NCHUNK, j = task % NCHUNK, dir = cd >> 4, c = cd & 15, b = c >> 3, head = c & 7;
    float S[64];
    const float* src = PU + (size_t)task * 2 * 4096 + lane * 64;
#pragma unroll
    for (int k = 0; k < 64; k += 4) { const float4 v = *(const float4*)(src + k); S[k] = v.x; S[k + 1] = v.y; S[k + 2] = v.z; S[k + 3] = v.w; }
    const ushort_t* shc = SH + (size_t)c * LTOT * 192;
    const ushort_t* drc = DR + (size_t)(dir * 16 + c) * LTOT * 192;
    ushort_t* obase = O + ((size_t)dir * NX + (size_t)b * SEQ) * 512 + head * 64 + lane;
#pragma unroll 1
    for (int st = 0; st < PFD; ++st) scan_prefetch(pfr, shc, drc, tau_to_pos(dir, j * CH + st), lane);
#pragma unroll 1
    for (int sg = 0; sg < CH / SEG; ++sg) {
      scan_stage_vr(vbuf, rbuf, shc, dir, j * CH + sg * SEG, lane);
#pragma unroll 1
      for (int s2 = 0; s2 < SEG; ++s2) {
        const int st = sg * SEG + s2;
        const int pos = tau_to_pos(dir, j * CH + st);
        const ushort_t* shr = shc + (size_t)pos * 192;
        const ushort_t* drr = drc + (size_t)pos * 192;
        scan_prefetch(pfr, shc, drc, tau_to_pos(dir, j * CH + (st + PFD < CH ? st + PFD : CH - 1)), lane);
        const float vv = h2f(vbuf[s2 * 64 + lane]);
        u32x16 a0, a1, b0, b1;
        sload4(a0, a1, b0, b1, shr, drr);
        float u0 = 0.f, u1 = 0.f, u2 = 0.f, u3 = 0.f;
#pragma unroll
        for (int q = 0; q < 16; ++q) { fm_lo(u0, S[2 * q], a0[q]); fm_hi(u1, S[2 * q + 1], a0[q]); fm_lo(u2, S[32 + 2 * q], a1[q]); fm_hi(u3, S[33 + 2 * q], a1[q]); }
        const float nsk = -((u0 + u1) + (u2 + u3));
#pragma unroll
        for (int q = 0; q < 16; ++q) { fx_lo(S[2 * q], b0[q]); fx_hi(S[2 * q + 1], b0[q]); fx_lo(S[32 + 2 * q], b1[q]); fx_hi(S[33 + 2 * q], b1[q]); }
        sload4(a0, a1, b0, b1, drr + 64, drr + 128);
#pragma unroll
        for (int q = 0; q < 16; ++q) { fm_lo(S[2 * q], vv, a0[q]); fm_hi(S[2 * q + 1], vv, a0[q]); fm_lo(S[32 + 2 * q], vv, a1[q]); fm_hi(S[33 + 2 * q], vv, a1[q]); }
#pragma unroll
        for (int q = 0; q < 16; ++q) { fm_lo(S[2 * q], nsk, b0[q]); fm_hi(S[2 * q + 1], nsk, b0[q]); fm_lo(S[32 + 2 * q], nsk, b1[q]); fm_hi(S[33 + 2 * q], nsk, b1[q]); }
        float o0 = 0.f, o1 = 0.f, o2 = 0.f, o3 = 0.f;
#pragma unroll
        for (int q = 0; q < 8; ++q) {
          const uint4 rw = *(const uint4*)&rbuf[s2 * 64 + q * 8];
          fv_lo(o0, S[8 * q + 0], rw.x); fv_hi(o1, S[8 * q + 1], rw.x); fv_lo(o2, S[8 * q + 2], rw.y); fv_hi(o3, S[8 * q + 3], rw.y);
          fv_lo(o0, S[8 * q + 4], rw.z); fv_hi(o1, S[8 * q + 5], rw.z); fv_lo(o2, S[8 * q + 6], rw.w); fv_hi(o3, S[8 * q + 7], rw.w);
        }
        if (pos >= CTXL) obase[(size_t)(pos - CTXL) * 512] = f2h((o0 + o1) + (o2 + o3));
      }
    }
  }
  asm volatile("s_waitcnt vmcnt(0)" ::: "memory");
  asm volatile("" :: "v"(pfr));
}

DI void phase_scan_naive(const Params& p) {
  const ushort_t* SH = (const ushort_t*)(p.ws + OFF_SH);
  const ushort_t* DR = (const ushort_t*)(p.ws + OFF_DR);
  ushort_t* O = (ushort_t*)(p.ws + OFF_ZQ);
  const int lane = threadIdx.x & 63;
  const int gw = __builtin_amdgcn_readfirstlane(blockIdx.x * 8 + (threadIdx.x >> 6));
  if (gw >= 32) return;
  const int cd = gw, dir = cd >> 4, c = cd & 15, b = c >> 3, head = c & 7;
  float S[64];
#pragma unroll
  for (int k = 0; k < 64; ++k) S[k] = 0.f;
  const ushort_t* shc = SH + (size_t)c * LTOT * 192;
  const ushort_t* drc = DR + (size_t)(dir * 16 + c) * LTOT * 192;
#pragma unroll 1
  for (int tau = 0; tau < LTOT; ++tau) {
    const int pos = tau_to_pos(dir, tau);
    const ushort_t* shr = shc + (size_t)pos * 192;
    const ushort_t* drr = drc + (size_t)pos * 192;
    const float vv = h2f(shr[128 + lane]);
    u32x16 k0, k1;
    sload2(k0, k1, shr);
    float sk0 = 0.f, sk1 = 0.f;
#pragma unroll
    for (int q = 0; q < 32; ++q) { sk0 = fmaf(S[q], HV(k0, q), sk0); sk1 = fmaf(S[32 + q], HV(k1, q), sk1); }
    const float nsk = -(sk0 + sk1);
    u32x16 x0, x1, d0, d1;
    sload4(x0, x1, d0, d1, drr, drr + 64);
#pragma unroll
    for (int q = 0; q < 32; ++q) {
      S[q] = fmaf(S[q], -HV(x0, q), S[q]); S[32 + q] = fmaf(S[32 + q], -HV(x1, q), S[32 + q]);
      S[q] = fmaf(vv, HV(d0, q), S[q]); S[32 + q] = fmaf(vv, HV(d1, q), S[32 + q]);
    }
    u32x16 b0, b1, r0, r1;
    sload4(b0, b1, r0, r1, drr + 128, shr + 64);
    float o0 = 0.f, o1 = 0.f;
#pragma unroll
    for (int q = 0; q < 32; ++q) {
      S[q] = fmaf(nsk, HV(b0, q), S[q]); S[32 + q] = fmaf(nsk, HV(b1, q), S[32 + q]);
      o0 = fmaf(S[q], HV(r0, q), o0); o1 = fmaf(S[32 + q], HV(r1, q), o1);
    }
    if (pos >= CTXL) O[((size_t)dir * NX + (size_t)b * SEQ + (pos - CTXL)) * 512 + head * 64 + lane] = f2h(o0 + o1);
  }
}

DI void phase_attn(const Params& p, unsigned char* smem) {
  ushort_t* Kb = (ushort_t*)smem;
  ushort_t* Vb = Kb + 2 * 64 * LDK;
  ushort_t* QB = (ushort_t*)(p.ws + OFF_QB);
  const ushort_t* KB = (const ushort_t*)(p.ws + OFF_KB);
  const ushort_t* VB = (const ushort_t*)(p.ws + OFF_VB);
  const int tid = threadIdx.x, wave = tid >> 6, lane = tid & 63, l31 = lane & 31, hh = lane >> 5;
  const int loff = (tid >> 3) * LDK + (tid & 7) * 8;
  constexpr float THR = 6.f;
  constexpr int NTL = LTOT / 64;
  for (int at = blockIdx.x; at < 1024; at += gridDim.x) {
    const int b = at >> 9, kvh = (at >> 8) & 1, t0 = (at & 255) * 64;
    const int head = kvh * 4 + (wave & 3), tq = t0 + (wave >> 2) * 32 + l31;
    ushort_t* qrow = QB + ((size_t)(b * 8 + head) * SEQ + tq) * 64;
    bf16x8 qf[4];
#pragma unroll
    for (int ks = 0; ks < 4; ++ks) qf[ks] = *(const bf16x8*)(qrow + ks * 16 + hh * 8);
    const ushort_t* kbase = KB + (size_t)(b * 2 + kvh) * LTOT * 64 + tid * 8;
    const ushort_t* vbase = VB + (size_t)(b * 2 + kvh) * LTOT * 64 + tid * 8;
    f32x16 o[2] = {zero16(), zero16()};
    f32x16 negm = zero16();
    float lsum = 0.f;
    auto qk = [&](f32x16 (&s)[2], const ushort_t* Ks) {
      s[0] = negm; s[1] = negm;
#pragma unroll
      for (int ks = 0; ks < 4; ++ks)
#pragma unroll
        for (int kk = 0; kk < 2; ++kk) s[kk] = MFMA(*(const bf16x8*)&Ks[(kk * 32 + l31) * LDK + ks * 16 + hh * 8], qf[ks], s[kk]);
    };
    uint4 rk, rv;
    __syncthreads();
    rk = *(const uint4*)kbase; rv = *(const uint4*)vbase;
    *(uint4*)&Kb[loff] = rk; *(uint4*)&Vb[loff] = rv;
    rk = *(const uint4*)(kbase + 4096);
    rv = *(const uint4*)(vbase + 4096);
    __syncthreads();
    f32x16 sA[2], sB[2];
    qk(sA, Kb);
    {
      float mx = fmaxf(sA[0][0], sA[1][0]);
#pragma unroll
      for (int i = 1; i < 16; ++i) mx = fmaxf(mx, fmaxf(sA[0][i], sA[1][i]));
      mx = fmaxf(mx, __shfl_xor(mx, 32, 64));
#pragma unroll
      for (int i = 0; i < 16; ++i) { sA[0][i] -= mx; sA[1][i] -= mx; negm[i] = -mx; }
    }
    *(uint4*)&Kb[64 * LDK + loff] = rk;
    rk = *(const uint4*)(kbase + 2 * 4096);
    auto step = [&](int t, f32x16 (&sc)[2], f32x16 (&sn)[2]) {
      __syncthreads();
      if (t + 2 < NTL) *(uint4*)&Kb[(t & 1) * 64 * LDK + loff] = rk;
      if (t + 1 < NTL) *(uint4*)&Vb[((t + 1) & 1) * 64 * LDK + loff] = rv;
      if (t + 3 < NTL) rk = *(const uint4*)(kbase + (size_t)(t + 3) * 4096);
      if (t + 2 < NTL) rv = *(const uint4*)(vbase + (size_t)(t + 2) * 4096);
      if (t + 1 < NTL) qk(sn, Kb + ((t + 1) & 1) * 64 * LDK);
      float mx = fmaxf(sc[0][0], sc[1][0]);
#pragma unroll
      for (int i = 1; i < 16; ++i) mx = fmaxf(mx, fmaxf(sc[0][i], sc[1][i]));
      mx = fmaxf(mx, __shfl_xor(mx, 32, 64));
      if (__builtin_amdgcn_ballot_w64(mx > THR) != 0ull) {
        const float delta = fmaxf(mx, 0.f);
        const float alpha = __builtin_amdgcn_exp2f(-delta);
        lsum *= alpha;
#pragma unroll
        for (int i = 0; i < 16; ++i) {
          o[0][i] *= alpha; o[1][i] *= alpha; sc[0][i] -= delta; sc[1][i] -= delta; negm[i] -= delta;
          sn[0][i] -= delta; sn[1][i] -= delta;
        }
      }
      float ps = 0.f;
#pragma unroll
      for (int i = 0; i < 16; ++i) {
        sc[0][i] = __builtin_amdgcn_exp2f(sc[0][i]); sc[1][i] = __builtin_amdgcn_exp2f(sc[1][i]);
        ps += sc[0][i] + sc[1][i];
      }
      lsum += ps;
      const ushort_t* Vt = Vb + (t & 1) * 64 * LDK;
#pragma unroll
      for (int kk = 0; kk < 2; ++kk) {
#pragma unroll
        for (int st = 0; st < 2; ++st) {
          uint4 pw;
          pw.x = pack_bf2(sc[kk][8 * st + 0], sc[kk][8 * st + 1]); pw.y = pack_bf2(sc[kk][8 * st + 2], sc[kk][8 * st + 3]);
          pw.z = pack_bf2(sc[kk][8 * st + 4], sc[kk][8 * st + 5]); pw.w = pack_bf2(sc[kk][8 * st + 6], sc[kk][8 * st + 7]);
          const bf16x8 pf = __builtin_bit_cast(bf16x8, pw);
#pragma unroll
          for (int dt = 0; dt < 2; ++dt) o[dt] = MFMA(*(const bf16x8*)&Vt[(dt * 32 + l31) * LDK + kk * 32 + st * 16 + hh * 8], pf, o[dt]);
        }
      }
    };
#pragma unroll 1
    for (int t = 0; t < NTL; t += 2) {
      step(t, sA, sB);
      step(t + 1, sB, sA);
    }
    const float ltot = lsum + __shfl_xor(lsum, 32, 64);
    const float il = 1.f / ltot;
#pragma unroll
    for (int dt = 0; dt < 2; ++dt)
#pragma unroll
      for (int g = 0; g < 4; ++g) {
        uint2 w;
        w.x = pack_bf2(o[dt][4 * g + 0] * il, o[dt][4 * g + 1] * il);
        w.y = pack_bf2(o[dt][4 * g + 2] * il, o[dt][4 * g + 3] * il);
        *(uint2*)(qrow + dt * 32 + 8 * g + 4 * hh) = w;
      }
  }
}

constexpr size_t OFF_DBG = WS_END;
DI void dbg_acc(const Params& p, int slot, float d2, float r2) {
  float* dbg = (float*)(p.ws + OFF_DBG);
  d2 = wave_sum(d2); r2 = wave_sum(r2);
  if ((threadIdx.x & 63) == 0) { atomicAdd(dbg + 2 * slot, d2); atomicAdd(dbg + 2 * slot + 1, r2); }
}
DI void probe_after_gemm1(const Params& p) {
  if (blockIdx.x != 0) return;
  const int tid = threadIdx.x, lane = tid & 63, wave = tid >> 6;
  const float* mod = (const float*)(p.ws + OFF_MOD);
  const ushort_t* H = (const ushort_t*)(p.ws + OFF_SH);
  {
    float d2 = 0.f, r2 = 0.f;
    if (tid < 96) {
      const int v = tid / 32, n = (tid % 32) * 97 % 3072;
      float s = 0.f;
      for (int k = 0; k < 1024; ++k) { const float cv = (v < 2) ? p.c[v * 1024 + k] : p.c_ctx[k]; s += (cv / (1.f + expf(-cv))) * p.w_ada[(size_t)k * 3072 + n]; }
      s += p.b_ada[n];
      const float d = mod[v * 3072 + n] - s; d2 = d * d; r2 = s * s;
    }
    dbg_acc(p, 0, d2, r2);
  }
  {
    const int row = wave == 0 ? 0 : wave == 1 ? 777 : wave == 2 ? 16383 : wave == 3 ? 16384 : wave == 4 ? 32767 : wave == 5 ? 32768 : wave == 6 ? 33023 : 33279;
    const float* src = (row < NX) ? p.x + (size_t)row * DM : p.ctx + (size_t)(row - NX) * DM;
    const float* md = mod + ((row < NX) ? (row / SEQ) : 2) * 3072;
    float s = 0.f;
    for (int i = lane; i < 1024; i += 64) s += src[i];
    const float mu = wave_sum(s) / 1024.f;
    float q = 0.f;
    for (int i = lane; i < 1024; i += 64) q += (src[i] - mu) * (src[i] - mu);
    const float rstd = rsqrtf(wave_sum(q) / 1024.f + LN_EPS);
    float d2 = 0.f, r2 = 0.f;
    for (int i = lane; i < 1024; i += 64) {
      const float ref = (src[i] - mu) * rstd * (1.f + md[1024 + i]) + md[i];
      const float d = bf2f(H[(size_t)row * DM + i]) - ref; d2 += d * d; r2 += ref * ref;
    }
    dbg_acc(p, 1, d2, r2);
  }
  {
    float d2 = 0.f, r2 = 0.f;
    if (tid < 60) {
      const int ri = tid / 10, ci = tid % 10;
      const int row = ri == 0 ? 3 : ri == 1 ? 777 : ri == 2 ? 20001 : ri == 3 ? 32767 : ri == 4 ? 32773 : 33279;
      const int col = ci == 0 ? 0 : ci == 1 ? 100 : ci == 2 ? 700 : ci == 3 ? 800 : ci == 4 ? 1279 : ci == 5 ? 1280 : ci == 6 ? 2000 : ci == 7 ? 3071 : ci == 8 ? 3072 : 3583;
      float s = 0.f;
      for (int k = 0; k < 1024; ++k) s += bf2f(H[(size_t)row * DM + k]) * p.w_in[(size_t)k * INW + col];
      float got = 0.f; bool have = true;
      if (col < 768) got = bf2f(((const ushort_t*)(p.ws + OFF_ZQ))[(size_t)row * 768 + col]);
      else if (col < 1280) { if (row < NX) got = bf2f(((const ushort_t*)(p.ws + OFF_ZG))[(size_t)row * 1024 + col - 768]); else have = false; }
      else if (col < 3072) got = bf2f(((const ushort_t*)p.out)[(size_t)row * 1792 + col - 1280]);
      else { if (row < NX) got = bf2f(((const ushort_t*)(p.ws + OFF_ZG))[(size_t)row * 1024 + 512 + col - 3072]); else have = false; }
      if (have) { const float d = got - s; d2 = d * d; r2 = s * s; }
    }
    dbg_acc(p, 2, d2, r2);
  }
}
DI void probe_after_prep(const Params& p, unsigned char* smem) {
  if (blockIdx.x != 0) return;
  float* cbuf = (float*)smem;
  const int tid = threadIdx.x, lane = tid & 63, wave = tid >> 6;
  const ushort_t* zm = (const ushort_t*)p.out;
  const ushort_t* SH = (const ushort_t*)(p.ws + OFF_SH);
  const ushort_t* DR = (const ushort_t*)(p.ws + OFF_DR);
  float dA = 0.f, rA = 0.f, dB = 0.f, rB = 0.f;
#pragma unroll 1
  for (int sidx = wave; sidx < 24; sidx += 8) {
    const int ri = sidx >> 1, head = (sidx & 1) ? 5 : 0;
    const int row = ri == 0 ? 0 : ri == 1 ? 1 : ri == 2 ? 31 : ri == 3 ? 32 : ri == 4 ? 16383 : ri == 5 ? 16384 : ri == 6 ? 20000 : ri == 7 ? 32767 : ri == 8 ? 32768 : ri == 9 ? 33023 : ri == 10 ? 33024 : 33279;
    int b, t, len, pp;
    if (row < NX) { b = row / SEQ; t = row % SEQ; len = SEQ; pp = CTXL + t; } else { b = (row - NX) / CTXL; t = (row - NX) % CTXL; len = CTXL; pp = t; }
    auto sft = [&](int col) {
      const float z = bf2f(zm[(size_t)row * 1792 + col]);
      const float zp = (t > 0) ? bf2f(zm[(size_t)(row - 1) * 1792 + col]) : 0.f;
      const float zn = (t < len - 1) ? bf2f(zm[(size_t)(row + 1) * 1792 + col]) : 0.f;
      return z + p.mu_prev[col] * (zp - z) + p.mu_next[col] * (zn - z);
    };
    const int n = head * 64 + lane;
    const float r = sft(n), k = sft(512 + n), v = sft(1024 + n);
#pragma unroll 1
    for (int j = lane; j < 256; j += 64) { const float s = sft(1536 + j); cbuf[wave * 256 + j] = (j < 128) ? tanhf(s) : s; }
    __builtin_amdgcn_s_waitcnt(0);
    __builtin_amdgcn_wave_barrier();
    const float kr = k * p.k_k[n];
    const float nrm = sqrtf(wave_sum(kr * kr));
    const float kk = kr / fmaxf(nrm, 1e-12f);
    const size_t cp = (size_t)(b * 8 + head) * LTOT + pp;
    { float d;
      d = h2f(SH[(cp * 3 + 0) * 64 + lane]) - kk; dA += d * d; rA += kk * kk;
      d = h2f(SH[(cp * 3 + 1) * 64 + lane]) - r; dA += d * d; rA += r * r;
      d = h2f(SH[(cp * 3 + 2) * 64 + lane]) - v; dA += d * d; rA += v * v; }
#pragma unroll 1
    for (int dir = 0; dir < 2; ++dir) {
      float wpre = p.w0[dir * 512 + n], apre = p.a0[dir * 512 + n];
#pragma unroll 1
      for (int j = 0; j < 64; ++j) {
        wpre += cbuf[wave * 256 + dir * 64 + j] * p.w_up[(size_t)(dir * 64 + j) * 512 + n];
        apre += cbuf[wave * 256 + 128 + dir * 64 + j] * p.a_up[(size_t)(dir * 64 + j) * 512 + n];
      }
      const float wlog = -log1pf(expf(-wpre)) - 0.5f;
      const float xd = 1.f - expf(-expf(wlog));
      const float a = 1.f / (1.f + expf(-apre));
      const float kd = k * (1.f + (a - 1.f) * p.k_a[n]);
      const float bq = kk * a;
      const size_t dp = (size_t)(dir * 16 + b * 8 + head) * LTOT + pp;
      float d;
      d = h2f(DR[(dp * 3 + 0) * 64 + lane]) - xd; dB += d * d; rB += xd * xd;
      d = h2f(DR[(dp * 3 + 1) * 64 + lane]) - kd; dB += d * d; rB += kd * kd;
      d = h2f(DR[(dp * 3 + 2) * 64 + lane]) - bq; dB += d * d; rB += bq * bq;
    }
    __builtin_amdgcn_wave_barrier();
  }
  dbg_acc(p, 3, dA, rA);
  dbg_acc(p, 4, dB, rB);
}

DI void probe_scan(const Params& p) {
  if (blockIdx.x != 0 || threadIdx.x >= 128) return;
  const ushort_t* SH = (const ushort_t*)(p.ws + OFF_SH);
  const ushort_t* DR = (const ushort_t*)(p.ws + OFF_DR);
  const ushort_t* O = (const ushort_t*)(p.ws + OFF_ZQ);
  const int lane = threadIdx.x & 63, wv = threadIdx.x >> 6;
  const int c = wv ? 9 : 0, dir = wv, b = c >> 3, head = c & 7;
  float S[64];
#pragma unroll
  for (int k = 0; k < 64; ++k) S[k] = 0.f;
  float d2 = 0.f, r2 = 0.f;
#pragma unroll 1
  for (int tau = 0; tau < 420; ++tau) {
    const int pos = dir == 0 ? tau : (tau < CTXL ? CTXL - 1 - tau : LTOT - 1 - (tau - CTXL));
    const ushort_t* sh = SH + ((size_t)c * LTOT + pos) * 192;
    const ushort_t* dr = DR + ((size_t)(dir * 16 + c) * LTOT + pos) * 192;
    const float v = h2f(sh[128 + lane]);
    float sk = 0.f;
#pragma unroll
    for (int k = 0; k < 64; ++k) sk += S[k] * h2f(sh[k]);
    float o = 0.f;
#pragma unroll
    for (int k = 0; k < 64; ++k) {
      const float dec = 1.f - h2f(dr[k]);
      S[k] = S[k] * dec - sk * h2f(dr[128 + k]) + v * h2f(dr[64 + k]);
      o += S[k] * h2f(sh[64 + k]);
    }
    if (pos >= CTXL) {
      const float got = h2f(O[((size_t)dir * NX + (size_t)b * SEQ + (pos - CTXL)) * 512 + head * 64 + lane]);
      const float d = got - o; d2 += d * d; r2 += o * o;
    }
  }
  dbg_acc(p, 0, d2, r2);
}
DI float probe_delta(const Params& p) {
  const float* dbg = (const float*)(p.ws + OFF_DBG);
  int k = 0;
  for (int s = 0; s < 5; ++s) { const float rel = sqrtf(dbg[2 * s] / fmaxf(dbg[2 * s + 1], 1e-30f)); if (!(rel < 0.05f)) k |= 1 << s; }
  return sqrtf(0.02f * (float)k);
}

DI void phase_final(const Params& p, unsigned char* smem) {
  ushort_t* As = (ushort_t*)smem;
  ushort_t* Bs = As + 2 * 128 * LDK;
  const float* mod = (const float*)(p.ws + OFF_MOD);
  ushort_t* ZG = (ushort_t*)(p.ws + OFF_ZG);
  ushort_t* QB = (ushort_t*)(p.ws + OFF_QB);
  ushort_t* O = (ushort_t*)(p.ws + OFF_ZQ);
  const ushort_t* SH = (const ushort_t*)(p.ws + OFF_SH);
  const ushort_t* DR = (const ushort_t*)(p.ws + OFF_DR);
  const ushort_t* WMG = (const ushort_t*)(p.ws + OFF_WMG);
  const ushort_t* WPA = (const ushort_t*)(p.ws + OFF_WPA);
  const ushort_t* WPB = (const ushort_t*)(p.ws + OFF_WPB);
  const ushort_t* WO = (const ushort_t*)(p.ws + OFF_WO);
#pragma unroll 1
  for (int mt = blockIdx.x; mt < NX / 128; mt += gridDim.x) {
    int tid = threadIdx.x;
    asm volatile("" : "+v"(tid));
    const int wave = tid >> 6, lane = tid & 63, l31 = lane & 31, hh = lane >> 5;
    const int wrow0 = (wave & 3) * 32, wcol0 = (wave >> 2) * 64;
    const int row0 = mt * 128, b = row0 / SEQ, tb0 = row0 % SEQ;
    const float* md = mod + b * 3072;
    __syncthreads();
#pragma unroll 1
    for (int r4 = wave * 4; r4 < 128; r4 += 32) {
      const int r = r4 + (lane >> 4), l16 = lane & 15;
      ushort_t* hdst = (ushort_t*)(p.out + (size_t)(row0 + r) * DM);
      float4 v[16];
      const float rstd = ln_rows4(p.x + (size_t)(row0 + r) * DM, l16, v);
#pragma unroll
      for (int i = 0; i < 16; ++i) {
        const int col = l16 * 4 + 64 * i;
        const float4 sh = *(const float4*)(md + col), sc = *(const float4*)(md + 1024 + col);
        uint2 o;
        o.x = pack_bf2(v[i].x * rstd * (1.f + sc.x) + sh.x, v[i].y * rstd * (1.f + sc.y) + sh.y);
        o.y = pack_bf2(v[i].z * rstd * (1.f + sc.z) + sh.z, v[i].w * rstd * (1.f + sc.w) + sh.w);
        *(uint2*)(hdst + col) = o;
      }
    }
#if PROBE
    float a2ref = 0.f;
    if (mt == 0) {
      const int tok = wave * 16 + 3, head = wave, row = row0 + tok, t = tb0 + tok, dd = head * 64 + lane;
      const size_t cp = (size_t)(b * 8 + head) * LTOT + CTXL + t;
      const float o = h2f(O[(size_t)row * 512 + dd]) + h2f(O[((size_t)NX + row) * 512 + dd]);
      const float mu = wave_sum(o) / 64.f;
      const float var = wave_sum((o - mu) * (o - mu)) / 64.f;
      const float y = (o - mu) * rsqrtf(var + GN_EPS) * p.gn_w[dd] + p.gn_b[dd];
      const float r = h2f(SH[(cp * 3 + 1) * 64 + lane]), vv = h2f(SH[(cp * 3 + 2) * 64 + lane]);
      const float kf = h2f(DR[(cp * 3 + 1) * 64 + lane]), kb = h2f(DR[(((size_t)16 * LTOT + cp) * 3 + 1) * 64 + lane]);
      const float bon = wave_sum(r * kf * p.r_k[dd]) + wave_sum(r * kb * p.r_k[512 + dd]);
      const float g = bf2f(ZG[(size_t)row * 1024 + 512 + dd]);
      a2ref = (y + bon * vv) * (g / (1.f + expf(-g)));
    }
#endif
#pragma unroll 1
    for (int it = 0; it < 16; ++it) {
      const int pair = (it * 8 + wave) * 8 + (lane >> 3), q8 = lane & 7;
      const int tok = pair >> 3, head = pair & 7, row = row0 + tok, t = tb0 + tok, d0 = q8 * 8;
      const unsigned cp = (unsigned)((b * 8 + head) * LTOT + CTXL + t);
      const unsigned ofo = (unsigned)(row * 512 + head * 64 + d0), obo = ofo + (unsigned)NX * 512u;
      const unsigned ro = (cp * 3 + 1) * 64 + d0, vo = (cp * 3 + 2) * 64 + d0;
      const unsigned kbo = ((16u * LTOT + cp) * 3 + 1) * 64 + d0;
      const unsigned gbo = (unsigned)(row * 1024 + 512 + head * 64 + d0), gao = gbo - 512;
      const unsigned yao = (unsigned)(((b * 8 + head) * SEQ + t) * 64 + d0);
      float ov[8], bon = 0.f, s = 0.f;
      {
        const uint4 a = *(const uint4*)(O + ofo), bq = *(const uint4*)(O + obo);
        const uint4 rr = *(const uint4*)(SH + ro), kf = *(const uint4*)(DR + ro), kb = *(const uint4*)(DR + kbo);
        const unsigned aw[4] = {a.x, a.y, a.z, a.w}, bw[4] = {bq.x, bq.y, bq.z, bq.w}, rw[4] = {rr.x, rr.y, rr.z, rr.w};
        const unsigned fw[4] = {kf.x, kf.y, kf.z, kf.w}, kw[4] = {kb.x, kb.y, kb.z, kb.w};
#pragma unroll
        for (int q = 0; q < 4; ++q) {
          const int dd = head * 64 + d0 + 2 * q;
          ov[2 * q] = hlo(aw[q]) + hlo(bw[q]);
          ov[2 * q + 1] = hhi(aw[q]) + hhi(bw[q]);
          s += ov[2 * q] + ov[2 * q + 1];
          bon += hlo(rw[q]) * (hlo(fw[q]) * p.r_k[dd] + hlo(kw[q]) * p.r_k[512 + dd]);
          bon += hhi(rw[q]) * (hhi(fw[q]) * p.r_k[dd + 1] + hhi(kw[q]) * p.r_k[512 + dd + 1]);
        }
      }
      s += __shfl_xor(s, 1, 64); s += __shfl_xor(s, 2, 64); s += __shfl_xor(s, 4, 64);
      bon += __shfl_xor(bon, 1, 64); bon += __shfl_xor(bon, 2, 64); bon += __shfl_xor(bon, 4, 64);
      const float mu = s * (1.f / 64.f);
      float vs = 0.f;
#pragma unroll
      for (int q = 0; q < 8; ++q) { ov[q] -= mu; vs = fmaf(ov[q], ov[q], vs); }
      vs += __shfl_xor(vs, 1, 64); vs += __shfl_xor(vs, 2, 64); vs += __shfl_xor(vs, 4, 64);
      const float rstd = rsqrtf(vs * (1.f / 64.f) + GN_EPS);
      {
        const uint4 vv = *(const uint4*)(SH + vo), gb = *(const uint4*)(ZG + gbo), ga = *(const uint4*)(ZG + gao), ya = *(const uint4*)(QB + yao);
        const unsigned vw[4] = {vv.x, vv.y, vv.z, vv.w}, gbw[4] = {gb.x, gb.y, gb.z, gb.w}, gaw[4] = {ga.x, ga.y, ga.z, ga.w}, yw[4] = {ya.x, ya.y, ya.z, ya.w};
        unsigned o2[4], o1[4];
#pragma unroll
        for (int q = 0; q < 4; ++q) {
          const int dd = head * 64 + d0 + 2 * q;
          const float y0 = ov[2 * q] * rstd * p.gn_w[dd] + p.gn_b[dd] + bon * hlo(vw[q]);
          const float y1 = ov[2 * q + 1] * rstd * p.gn_w[dd + 1] + p.gn_b[dd + 1] + bon * hhi(vw[q]);
          o2[q] = pack_bf2(y0 * siluf(bflo(gbw[q])), y1 * siluf(bfhi(gbw[q])));
          o1[q] = pack_bf2(bflo(yw[q]) * siluf(bflo(gaw[q])), bfhi(yw[q]) * siluf(bfhi(gaw[q])));
        }
        *(uint4*)(O + ofo) = make_uint4(o2[0], o2[1], o2[2], o2[3]);
        *(uint4*)(QB + yao) = make_uint4(o1[0], o1[1], o1[2], o1[3]);
      }
    }
    asm volatile("s_waitcnt vmcnt(0)" ::: "memory");
    __syncthreads();
#if PROBE
    if (mt == 0) {
      const int tok = wave * 16 + 3, head = wave, row = row0 + tok, dd = head * 64 + lane;
      const float got = bf2f(O[(size_t)row * 512 + dd]);
      dbg_acc(p, 1, (got - a2ref) * (got - a2ref), a2ref * a2ref);
    }
#endif
    const ushort_t* hbase = (const ushort_t*)p.out;
    auto hload = [&](int r, int k) { return *(const uint4*)(hbase + (unsigned)((row0 + r) * 2048 + k)); };
    auto a1load = [&](int r, int k) { return *(const uint4*)(QB + (unsigned)(((b * 8 + (k >> 6)) * SEQ + tb0 + r) * 64 + (k & 63))); };
    auto a2load = [&](int r, int k) { return *(const uint4*)(O + (unsigned)((row0 + r) * 512 + k)); };
#pragma unroll 1
    for (int nt = 0; nt < 8; ++nt) {
      const int col0 = nt * 128;
      int tidn = tid;
      asm volatile("" : "+v"(tidn));
      f32x16 sg[2][1][2] = {{{zero16(), zero16()}}, {{zero16(), zero16()}}};
      gemm_pass<128, 128, 1, 2, 2>(sg, hload, [&](int w, int n, int k) { return *(const uint4*)(WMG + (unsigned)((w * 1024 + col0 + n) * DM + k)); }, DM, As, Bs, wrow0, wcol0, tidn);
#pragma unroll
      for (int ni = 0; ni < 2; ++ni) {
        const int col = col0 + wcol0 + ni * 32 + l31;
        const float ba = p.b_mg[col], bb = p.b_mg[1024 + col];
#pragma unroll
        for (int i = 0; i < 16; ++i) { sg[0][0][ni][i] = sigmf(sg[0][0][ni][i] + ba); sg[1][0][ni][i] = sigmf(sg[1][0][ni][i] + bb); }
      }
      {
        f32x16 ya[1][1][2] = {{{zero16(), zero16()}}};
        gemm_pass<128, 128, 1, 2, 1>(ya, a1load, [&](int w, int n, int k) { return *(const uint4*)(WPA + (unsigned)((col0 + n) * 512 + k)); }, 512, As, Bs, wrow0, wcol0, tidn);
#pragma unroll
        for (int ni = 0; ni < 2; ++ni)
#pragma unroll
          for (int i = 0; i < 16; ++i) sg[0][0][ni][i] *= ya[0][0][ni][i];
      }
      {
        f32x16 yb[1][1][2] = {{{zero16(), zero16()}}};
        gemm_pass<128, 128, 1, 2, 1>(yb, a2load, [&](int w, int n, int k) { return *(const uint4*)(WPB + (unsigned)((col0 + n) * 512 + k)); }, 512, As, Bs, wrow0, wcol0, tidn);
        int rb1 = row0 + wrow0 + 4 * hh;
        asm volatile("" : "+v"(rb1));
#pragma unroll
        for (int ni = 0; ni < 2; ++ni) {
          const int col = col0 + wcol0 + ni * 32 + l31;
#pragma unroll
          for (int i = 0; i < 16; ++i) {
            const float mv = sg[0][0][ni][i] + sg[1][0][ni][i] * yb[0][0][ni][i];
            ZG[(unsigned)((rb1 + crow(i, 0)) * 1024 + col)] = f2bf(mv);
          }
        }
      }
    }
    asm volatile("s_waitcnt vmcnt(0)" ::: "memory");
    __syncthreads();
#if PROBE
    if (mt == 0) {
      float d2 = 0.f, r2 = 0.f;
      if (tid < 64) {
        const int r = (tid * 37) & 127, col = (tid * 131 + 7) & 1023, row = row0 + r;
        const ushort_t* hrow = (const ushort_t*)(p.out + (size_t)row * DM);
        float ga = p.b_mg[col], gb = p.b_mg[1024 + col], ya = 0.f, yb = 0.f;
        for (int k = 0; k < 1024; ++k) { const float hv = bf2f(hrow[k]); ga += hv * p.w_mg[(size_t)k * 2048 + col]; gb += hv * p.w_mg[(size_t)k * 2048 + 1024 + col]; }
        for (int k = 0; k < 512; ++k) {
          ya += bf2f(QB[((size_t)(b * 8 + (k >> 6)) * SEQ + tb0 + r) * 64 + (k & 63)]) * p.w_pa[(size_t)k * 1024 + col];
          yb += bf2f(O[(size_t)row * 512 + k]) * p.w_pb[(size_t)k * 1024 + col];
        }
        const float ref = ya / (1.f + expf(-ga)) + yb / (1.f + expf(-gb));
        const float got = bf2f(ZG[(size_t)row * 1024 + col]);
        d2 = (got - ref) * (got - ref); r2 = ref * ref;
      }
      dbg_acc(p, 2, d2, r2);
    }
#endif
    const float* gt = md + 2048;
#pragma unroll 1
    for (int nt = 0; nt < 8; ++nt) {
      const int col0 = nt * 128;
      int tidn = tid;
      asm volatile("" : "+v"(tidn));
      f32x16 acc[1][1][2] = {{{zero16(), zero16()}}};
      gemm_pass<128, 128, 1, 2, 1>(acc, [&](int r, int k) { return *(const uint4*)(ZG + (unsigned)((row0 + r) * 1024 + k)); },
                                   [&](int w, int n, int k) { return *(const uint4*)(WO + (unsigned)((col0 + n) * DM + k)); }, DM, As, Bs, wrow0, wcol0, tidn);
      int rb2 = row0 + wrow0 + 4 * hh;
      asm volatile("" : "+v"(rb2));
#pragma unroll
      for (int ni = 0; ni < 2; ++ni) {
        const int col = col0 + wcol0 + ni * 32 + l31;
        const float g = gt[col];
#pragma unroll
        for (int i = 0; i < 16; ++i) {
          const unsigned idx = (unsigned)((rb2 + crow(i, 0)) * DM + col);
          p.out[idx] = ALPHA * p.x[idx] + g * acc[0][0][ni][i];
        }
      }
    }
    asm volatile("s_waitcnt vmcnt(0)" ::: "memory");
    __syncthreads();
#if PROBE
    if (mt == 0) {
      float d2 = 0.f, r2 = 0.f;
      if (tid < 64) {
        const int r = (tid * 29) & 127, col = (tid * 113 + 5) & 1023, row = row0 + r;
        float o = 0.f;
        for (int k = 0; k < 1024; ++k) o += bf2f(ZG[(size_t)row * 1024 + k]) * p.w_o[(size_t)k * 1024 + col];
        const float ref = md[2048 + col] * o;
        const float got = p.out[(size_t)row * DM + col] - ALPHA * p.x[(size_t)row * DM + col];
        d2 = (got - ref) * (got - ref); r2 = ref * ref;
      }
      dbg_acc(p, 3, d2, r2);
    }
    asm volatile("s_waitcnt vmcnt(0)" ::: "memory");
    __syncthreads();
#endif
#if !PROBE
#pragma unroll 1
    for (int r4 = wave * 4; r4 < 128; r4 += 32) {
      const int r = r4 + (lane >> 4), l16 = lane & 15;
      float* dst = p.out + (size_t)(row0 + r) * DM;
      float4 v[16];
      const float rstd = ln_rows4(dst, l16, v);
#pragma unroll
      for (int i = 0; i < 16; ++i) {
        const int col = l16 * 4 + 64 * i;
        const float4 g = *(const float4*)(p.ln_g + col), bb = *(const float4*)(p.ln_b + col);
        *(float4*)(dst + col) = make_float4(v[i].x * rstd * g.x + bb.x, v[i].y * rstd * g.y + bb.y, v[i].z * rstd * g.z + bb.z, v[i].w * rstd * g.w + bb.w);
      }
    }
#endif
  }
}


#if PROBE
DI void probe_f3(const Params& p) {
  const float pdelta = probe_delta(p);
  const int lane = threadIdx.x & 63, wave = threadIdx.x >> 6;
  for (int mt = blockIdx.x; mt < NX / 128; mt += gridDim.x) {
    for (int r = wave; r < 128; r += 8) {
      const float* src = p.x + (size_t)(mt * 128 + r) * DM;
      float* dst = p.out + (size_t)(mt * 128 + r) * DM;
      float s = 0.f, q = 0.f;
      for (int i = lane; i < 1024; i += 64) s += ALPHA * src[i];
      const float mu = wave_sum(s) / 1024.f;
      for (int i = lane; i < 1024; i += 64) { const float d = ALPHA * src[i] - mu; q += d * d; }
      const float rstd = rsqrtf(wave_sum(q) / 1024.f + LN_EPS);
      for (int i = lane; i < 1024; i += 64) dst[i] = (ALPHA * src[i] - mu) * rstd * p.ln_g[i] + p.ln_b[i] + pdelta;
    }
  }
}
#endif
DI void gsync(cg::grid_group& g) { asm volatile("s_waitcnt vmcnt(0) lgkmcnt(0)" ::: "memory"); g.sync(); }

constexpr int SMEM_BYTES = 8 * 2 * SEG * 64 * 2;
static_assert(SMEM_BYTES >= 2 * (256 + 128) * LDK * 2, "GEMM tiles");
static_assert(SMEM_BYTES >= 65536 + 32 * 264 * 2 + 1024, "rwkv prep LDS");
__global__ void __launch_bounds__(NTH) fwd_megakernel(Params p) {
  __shared__ __attribute__((aligned(16))) unsigned char smem[SMEM_BYTES];
  cg::grid_group grid = cg::this_grid();
#if PROBE
  if (blockIdx.x == 0 && threadIdx.x < 64) ((float*)(p.ws + OFF_DBG))[threadIdx.x] = 0.f;
#endif
  phase0(p, smem);
  gsync(grid);
  phase_h(p);
  gsync(grid);
  phase_gemm1(p, smem);
  gsync(grid);
  phase_qkv(p);
  phase_rwkv_prep(p, smem);
  gsync(grid);
#if PROBE_NAIVE_SCAN
  phase_scan_naive(p);
#else
  phase_scanA(p, smem);
  gsync(grid);
  phase_scanB(p, smem);
  gsync(grid);
  phase_scanC(p, smem);
#endif
  phase_attn(p, smem);
  gsync(grid);
#if PROBE
  probe_scan(p);
  gsync(grid);
#endif
  phase_final(p, smem);
#if PROBE
  gsync(grid);
  probe_f3(p);
#endif
}

extern "C" void kernel_launch(void* const* d_in, const int* in_sizes, int n_in, void* d_out, int out_size, void* d_ws, size_t ws_size,
                              hipStream_t stream) {
  static int grid_blocks = 0;
  if (!grid_blocks) {
    int dev = 0, cus = 0, per_cu = 0;
    hipGetDevice(&dev);
    hipDeviceGetAttribute(&cus, hipDeviceAttributeMultiprocessorCount, dev);
    hipOccupancyMaxActiveBlocksPerMultiprocessor(&per_cu, fwd_megakernel, NTH, 0);
    if (per_cu < 1) fprintf(stderr, "occupancy query says %d blocks/CU\n", per_cu);
    grid_blocks = cus > 0 ? cus : 256;
    if (ws_size < WS_END) fprintf(stderr, "workspace too small: %zu < %zu\n", ws_size, (size_t)WS_END);
  }
  Params p{};
  const float** fp = (const float**)&p;
  for (int i = 0; i < 27; ++i) fp[i] = (const float*)d_in[i];
  p.out = (float*)d_out;
  p.ws = (unsigned char*)d_ws;
  void* args[] = {&p};
  hipError_t e = hipLaunchCooperativeKernel((void*)fwd_megakernel, dim3(grid_blocks), dim3(NTH), args, 0, stream);
  if (e != hipSuccess) fprintf(stderr, "cooperative launch failed: %s (grid %d)\n", hipGetErrorString(e), grid_blocks);
}
```

```cpp
#include <hip/hip_runtime.h>
#include <hip/hip_cooperative_groups.h>
#include <stdint.h>
#include <cstdio>
namespace cg = cooperative_groups;

#define PROBE 0
#define DI __device__ __forceinline__
typedef __attribute__((ext_vector_type(8))) short bf16x8;
typedef __attribute__((ext_vector_type(16))) float f32x16;
typedef __attribute__((ext_vector_type(16))) uint32_t u32x16;
typedef __attribute__((ext_vector_type(2))) _Float16 h2;
typedef __attribute__((ext_vector_type(2))) __bf16 b2;
typedef unsigned short ushort_t;
typedef __attribute__((ext_vector_type(4))) uint32_t u32x4;
#define MFMA(a, b, c) __builtin_amdgcn_mfma_f32_32x32x16_bf16((a), (b), (c), 0, 0, 0)

constexpr int DM = 1024, NB = 2, SEQ = 16384, CTXL = 256;
constexpr int NX = NB * SEQ, NC = NB * CTXL, NT = NX + NC;
constexpr int INW = 3584, LTOT = CTXL + SEQ;
constexpr int NTH = 512;
constexpr int CH = 260, NCHUNK = LTOT / CH;
static_assert(NCHUNK * CH == LTOT, "chunking");
constexpr float LN_EPS = 1e-5f, QK_EPS = 1e-6f, GN_EPS = 64e-5f;
constexpr float ALPHA = 1.189207115002721f;
constexpr float QSCALE = 0.125f * 1.4426950408889634f;

constexpr size_t OFF_WIN = 0;
constexpr size_t OFF_WMG = OFF_WIN + (size_t)INW * DM * 2;
constexpr size_t OFF_WPA = OFF_WMG + (size_t)2048 * DM * 2;
constexpr size_t OFF_WPB = OFF_WPA + (size_t)1024 * 512 * 2;
constexpr size_t OFF_WO  = OFF_WPB + (size_t)1024 * 512 * 2;
constexpr size_t OFF_WL  = OFF_WO + (size_t)1024 * 1024 * 2;
constexpr size_t OFF_MOD = OFF_WL + (size_t)2 * 2 * 512 * 64 * 2;
constexpr size_t OFF_ZG  = OFF_MOD + 36864;
constexpr size_t OFF_QB  = OFF_ZG + (size_t)NX * 1024 * 2;
constexpr size_t OFF_KB  = OFF_QB + (size_t)NX * 512 * 2;
constexpr size_t OFF_VB  = OFF_KB + (size_t)NB * 2 * LTOT * 64 * 2;
constexpr size_t OFF_SH  = OFF_VB + (size_t)NB * 2 * LTOT * 64 * 2;
constexpr size_t OFF_DR  = OFF_SH + (size_t)16 * LTOT * 192 * 2;
constexpr size_t OFF_ZQ  = OFF_DR + (size_t)32 * LTOT * 192 * 2;
constexpr size_t WS_END  = OFF_ZQ + (size_t)2 * NX * 512 * 2;
static_assert(WS_END <= (size_t)536870912, "workspace");
static_assert((size_t)NT * DM * 2 <= (size_t)48 * LTOT * 192 * 2, "H alias");
static_assert((size_t)NT * 768 * 2 <= (size_t)2 * NX * 512 * 2, "zqkv alias");

struct Params {
  const float *x, *c, *ctx, *c_ctx, *w_ada, *b_ada, *w_in, *q_norm, *k_norm, *mu_prev, *mu_next, *w0, *w_up, *a0, *a_up, *k_k, *k_a,
      *r_k, *gn_w, *gn_b, *w_pa, *w_pb, *w_mg, *b_mg, *w_o, *ln_g, *ln_b;
  float* out;
  unsigned char* ws;
};

DI ushort_t f2bf(float f) { return __builtin_bit_cast(ushort_t, (__bf16)f); }
DI float bf2f(ushort_t b) { return __uint_as_float(((unsigned)b) << 16); }
DI unsigned pack_bf2(float a, float b) { b2 v = {(__bf16)a, (__bf16)b}; return __builtin_bit_cast(unsigned, v); }
DI unsigned pack_h2(float a, float b) { h2 v = {(_Float16)a, (_Float16)b}; return __builtin_bit_cast(unsigned, v); }
DI ushort_t f2h(float f) { return __builtin_bit_cast(ushort_t, (_Float16)f); }
DI float h2f(ushort_t h) { return (float)__builtin_bit_cast(_Float16, h); }
DI float bflo(unsigned u) { return __uint_as_float(u << 16); }
DI float bfhi(unsigned u) { return __uint_as_float(u & 0xffff0000u); }
DI float hlo(unsigned u) { return (float)__builtin_bit_cast(h2, u)[0]; }
DI float hhi(unsigned u) { return (float)__builtin_bit_cast(h2, u)[1]; }
DI float sigmf(float v) { return __builtin_amdgcn_rcpf(1.f + __expf(-v)); }
DI float siluf(float v) { return v * sigmf(v); }
DI int crow(int reg, int h) { return (reg & 3) + 8 * (reg >> 2) + 4 * h; }
DI float wave_sum(float v) {
#pragma unroll
  for (int o = 32; o >= 1; o >>= 1) v += __shfl_xor(v, o, 64);
  return v;
}
DI float sum16(float v) {
#pragma unroll
  for (int o = 8; o >= 1; o >>= 1) v += __shfl_xor(v, o, 64);
  return v;
}
DI float ln_rows4(const float* src, int l16, float4 (&v)[16]) {
  float s = 0.f;
#pragma unroll
  for (int i = 0; i < 16; ++i) { v[i] = *(const float4*)(src + l16 * 4 + 64 * i); s += v[i].x + v[i].y + v[i].z + v[i].w; }
  const float mu = sum16(s) * (1.f / DM);
  float q = 0.f;
#pragma unroll
  for (int i = 0; i < 16; ++i) { v[i].x -= mu; v[i].y -= mu; v[i].z -= mu; v[i].w -= mu; q += v[i].x * v[i].x + v[i].y * v[i].y + v[i].z * v[i].z + v[i].w * v[i].w; }
  return rsqrtf(sum16(q) * (1.f / DM) + LN_EPS);
}
DI f32x16 zero16() { f32x16 z;
#pragma unroll
  for (int i = 0; i < 16; ++i) z[i] = 0.f; return z; }

#define SCAN_VLOAD 0
#define PROBE_NAIVE_SCAN 0
#if SCAN_VLOAD
DI void sload2(u32x16& a0, u32x16& a1, const void* p) { a0 = *(const u32x16*)p; a1 = *((const u32x16*)p + 1); }
DI void sload4(u32x16& a0, u32x16& a1, u32x16& b0, u32x16& b1, const void* p, const void* q) {
  a0 = *(const u32x16*)p; a1 = *((const u32x16*)p + 1); b0 = *(const u32x16*)q; b1 = *((const u32x16*)q + 1);
}
#else
DI void sload2(u32x16& a0, u32x16& a1, const void* p) {
  asm volatile("s_load_dwordx16 %0, %2, 0x0\n\ts_load_dwordx16 %1, %2, 0x40\n\ts_waitcnt lgkmcnt(0)" : "=&s"(a0), "=&s"(a1) : "s"(p) : "memory");
}
DI void sload4(u32x16& a0, u32x16& a1, u32x16& b0, u32x16& b1, const void* p, const void* q) {
  asm volatile("s_load_dwordx16 %0, %4, 0x0\n\ts_load_dwordx16 %1, %4, 0x40\n\ts_load_dwordx16 %2, %5, 0x0\n\ts_load_dwordx16 %3, %5, 0x40\n\ts_waitcnt lgkmcnt(0)"
               : "=&s"(a0), "=&s"(a1), "=&s"(b0), "=&s"(b1) : "s"(p), "s"(q) : "memory");
}
#endif
DI float HV(const u32x16& v, int j) { const uint32_t w = v[j >> 1]; const h2 t = __builtin_bit_cast(h2, w); return (float)t[j & 1]; }

constexpr int LDK = 72;
template <int BM, int BN, int MI, int NI, int NB, class AL, class BL>
DI void gemm_pass(f32x16 (&acc)[NB][MI][NI], AL aload, BL bload, int K, ushort_t* As, ushort_t* Bs, int wrow0, int wcol0, int tid) {
  constexpr int NA = BM * 8 / NTH, NBC = BN * 8 / NTH;
  constexpr int ASZ = BM * LDK, BSZ = NB * BN * LDK;
  const int lane = tid & 63, l31 = lane & 31, hh = lane >> 5;
  const int nk = K >> 6;
  uint4 ra[2][NA], rb[2][NB][NBC];
  auto gload = [&](int s, int kt) {
#pragma unroll
    for (int i = 0; i < NA; ++i) { const int id = tid + i * NTH; ra[s][i] = aload(id >> 3, kt * 64 + (id & 7) * 8); }
#pragma unroll
    for (int w = 0; w < NB; ++w)
#pragma unroll
      for (int i = 0; i < NBC; ++i) { const int id = tid + i * NTH; rb[s][w][i] = bload(w, id >> 3, kt * 64 + (id & 7) * 8); }
  };
  auto lstore = [&](int s, int buf) {
#pragma unroll
    for (int i = 0; i < NA; ++i) { const int id = tid + i * NTH; *(uint4*)&As[buf * ASZ + (id >> 3) * LDK + (id & 7) * 8] = ra[s][i]; }
#pragma unroll
    for (int w = 0; w < NB; ++w)
#pragma unroll
      for (int i = 0; i < NBC; ++i) { const int id = tid + i * NTH; *(uint4*)&Bs[buf * BSZ + w * BN * LDK + (id >> 3) * LDK + (id & 7) * 8] = rb[s][w][i]; }
  };
  auto compute = [&](int buf) {
#pragma unroll
    for (int ks = 0; ks < 4; ++ks) {
      bf16x8 af[MI];
#pragma unroll
      for (int mi = 0; mi < MI; ++mi) af[mi] = *(const bf16x8*)&As[buf * ASZ + (wrow0 + mi * 32 + l31) * LDK + ks * 16 + hh * 8];
#pragma unroll
      for (int w = 0; w < NB; ++w) {
        bf16x8 bfv[NI];
#pragma unroll
        for (int ni = 0; ni < NI; ++ni) bfv[ni] = *(const bf16x8*)&Bs[buf * BSZ + w * BN * LDK + (wcol0 + ni * 32 + l31) * LDK + ks * 16 + hh * 8];
#pragma unroll
        for (int mi = 0; mi < MI; ++mi)
#pragma unroll
          for (int ni = 0; ni < NI; ++ni) acc[w][mi][ni] = MFMA(af[mi], bfv[ni], acc[w][mi][ni]);
      }
    }
  };
  __syncthreads();
  gload(0, 0);
  lstore(0, 0);
  gload(1, 1);
  gload(0, 2);
#pragma unroll 1
  for (int kt = 0; kt < nk; kt += 2) {
    __syncthreads();
    lstore(1, 1);
    if (kt + 3 < nk) gload(1, kt + 3);
    compute(0);
    __syncthreads();
    if (kt + 2 < nk) { lstore(0, 0); if (kt + 4 < nk) gload(0, kt + 4); }
    compute(1);
  }
}

DI void transpose_tile(const float* __restrict__ src, int ld_src, ushort_t* dst, int ld_dst, int k0, int n0, float* T) {
  const int tid = threadIdx.x;
#pragma unroll
  for (int i = 0; i < 2; ++i) {
    const int k = (tid >> 4) + 32 * i, n4 = (tid & 15) * 4;
    const float4 v = *(const float4*)(src + (size_t)(k0 + k) * ld_src + n0 + n4);
    T[k * 65 + n4 + 0] = v.x; T[k * 65 + n4 + 1] = v.y; T[k * 65 + n4 + 2] = v.z; T[k * 65 + n4 + 3] = v.w;
  }
  __syncthreads();
  const int n = tid >> 3, kc = tid & 7;
  uint4 o;
  o.x = pack_bf2(T[(kc * 8 + 0) * 65 + n], T[(kc * 8 + 1) * 65 + n]);
  o.y = pack_bf2(T[(kc * 8 + 2) * 65 + n], T[(kc * 8 + 3) * 65 + n]);
  o.z = pack_bf2(T[(kc * 8 + 4) * 65 + n], T[(kc * 8 + 5) * 65 + n]);
  o.w = pack_bf2(T[(kc * 8 + 6) * 65 + n], T[(kc * 8 + 7) * 65 + n]);
  *(uint4*)(dst + (size_t)(n0 + n) * ld_dst + k0 + kc * 8) = o;
  __syncthreads();
}

DI void phase0(const Params& p, unsigned char* smem) {
  float* T = (float*)smem;
  ushort_t* win = (ushort_t*)(p.ws + OFF_WIN);
  ushort_t* wmg = (ushort_t*)(p.ws + OFF_WMG);
  ushort_t* wpa = (ushort_t*)(p.ws + OFF_WPA);
  ushort_t* wpb = (ushort_t*)(p.ws + OFF_WPB);
  ushort_t* wo = (ushort_t*)(p.ws + OFF_WO);
  ushort_t* wl = (ushort_t*)(p.ws + OFF_WL);
  float* mod = (float*)(p.ws + OFF_MOD);
  constexpr int T_IN = 16 * 56, T_MG = 16 * 32, T_PA = 8 * 16, T_PB = 8 * 16, T_O = 16 * 16, T_L = 32, T_MOD = 48;
  constexpr int TOTAL = T_MOD + T_IN + T_MG + T_PA + T_PB + T_O + T_L;
  for (int t = blockIdx.x; t < TOTAL; t += gridDim.x) {
    int u = t;
    if (u < T_MOD) {
      float* sil = T;
      float* red = T + 3072;
      const int tid = threadIdx.x;
      for (int i = tid; i < 3072; i += NTH) {
        const int v = i >> 10, k = i & 1023;
        const float cv = (v < 2) ? p.c[v * 1024 + k] : p.c_ctx[k];
        sil[i] = siluf(cv);
      }
      __syncthreads();
      const int n = tid & 63, ksl = tid >> 6, n0 = u * 64;
      float a0 = 0.f, a1 = 0.f, a2 = 0.f;
      for (int k = ksl * 128; k < ksl * 128 + 128; ++k) {
        const float w = p.w_ada[(size_t)k * 3072 + n0 + n];
        a0 = fmaf(sil[k], w, a0); a1 = fmaf(sil[1024 + k], w, a1); a2 = fmaf(sil[2048 + k], w, a2);
      }
      red[(ksl * 3 + 0) * 64 + n] = a0; red[(ksl * 3 + 1) * 64 + n] = a1; red[(ksl * 3 + 2) * 64 + n] = a2;
      __syncthreads();
      if (tid < 192) {
        const int v = tid >> 6, nn = tid & 63;
        float s = 0.f;
#pragma unroll
        for (int q = 0; q < 8; ++q) s += red[(q * 3 + v) * 64 + nn];
        mod[v * 3072 + n0 + nn] = s + p.b_ada[n0 + nn];
      }
      __syncthreads();
      continue;
    }
    u -= T_MOD;
    if (u < T_IN) { transpose_tile(p.w_in, INW, win, 1024, (u / 56) * 64, (u % 56) * 64, T); continue; }
    u -= T_IN;
    if (u < T_MG) { transpose_tile(p.w_mg, 2048, wmg, 1024, (u / 32) * 64, (u % 32) * 64, T); continue; }
    u -= T_MG;
    if (u < T_PA) { transpose_tile(p.w_pa, 1024, wpa, 512, (u / 16) * 64, (u % 16) * 64, T); continue; }
    u -= T_PA;
    if (u < T_PB) { transpose_tile(p.w_pb, 1024, wpb, 512, (u / 16) * 64, (u % 16) * 64, T); continue; }
    u -= T_PB;
    if (u < T_O) { transpose_tile(p.w_o, 1024, wo, 1024, (u / 16) * 64, (u % 16) * 64, T); continue; }
    u -= T_O;
    {
      const int which = u >> 4, dir = (u >> 3) & 1, nt = u & 7;
      const float* src = (which ? p.a_up : p.w_up) + (size_t)dir * 64 * 512;
      transpose_tile(src, 512, wl + (size_t)((dir * 2 + which) * 512) * 64, 64, 0, nt * 64, T);
    }
  }
}

DI void phase_h(const Params& p) {
  const float* mod = (const float*)(p.ws + OFF_MOD);
  ushort_t* H = (ushort_t*)(p.ws + OFF_SH);
  const int lane = threadIdx.x & 63, l16 = lane & 15, gw = blockIdx.x * 8 + (threadIdx.x >> 6);
#pragma unroll 1
  for (int r4 = gw * 4; r4 < NT; r4 += gridDim.x * 32) {
    const int row = r4 + (lane >> 4);
    const float* src = (row < NX) ? p.x + (size_t)row * DM : p.ctx + (size_t)(row - NX) * DM;
    const float* md = mod + ((row < NX) ? (row / SEQ) : 2) * 3072;
    float4 v[16];
    const float rstd = ln_rows4(src, l16, v);
#pragma unroll
    for (int i = 0; i < 16; ++i) {
      const int col = l16 * 4 + 64 * i;
      const float4 sh = *(const float4*)(md + col), sc = *(const float4*)(md + 1024 + col);
      uint2 o;
      o.x = pack_bf2(v[i].x * rstd * (1.f + sc.x) + sh.x, v[i].y * rstd * (1.f + sc.y) + sh.y);
      o.y = pack_bf2(v[i].z * rstd * (1.f + sc.z) + sh.z, v[i].w * rstd * (1.f + sc.w) + sh.w);
      *(uint2*)(H + (size_t)row * DM + col) = o;
    }
  }
}

DI void phase_gemm1(const Params& p, unsigned char* smem) {
  ushort_t* As = (ushort_t*)smem;
  ushort_t* Bs = As + 2 * 256 * LDK;
  const ushort_t* H = (const ushort_t*)(p.ws + OFF_SH);
  const ushort_t* W = (const ushort_t*)(p.ws + OFF_WIN);
  ushort_t* zq = (ushort_t*)(p.ws + OFF_ZQ);
  ushort_t* zg = (ushort_t*)(p.ws + OFF_ZG);
  ushort_t* zm = (ushort_t*)p.out;
  const int tid = threadIdx.x, wave = tid >> 6, lane = tid & 63, l31 = lane & 31, hh = lane >> 5;
  const int wrow0 = (wave & 3) * 64, wcol0 = (wave >> 2) * 64;
  constexpr int MT = NT / 256, NTL = INW / 128;
  for (int t = blockIdx.x; t < MT * NTL; t += gridDim.x) {
    const int mt = t / NTL, nt = t % NTL;
    const bool is_g = (nt >= 6 && nt < 10) || nt >= 24;
    if (is_g && mt >= NX / 256) continue;
    const int row0 = mt * 256, col0 = nt * 128;
    f32x16 acc[1][2][2];
#pragma unroll
    for (int a = 0; a < 2; ++a)
#pragma unroll
      for (int b = 0; b < 2; ++b) acc[0][a][b] = zero16();
    auto aload = [&](int r, int k) { return *(const uint4*)(H + (size_t)(row0 + r) * DM + k); };
    auto bload = [&](int w, int n, int k) { return *(const uint4*)(W + (size_t)(col0 + n) * DM + k); };
    gemm_pass<256, 128, 2, 2, 1>(acc, aload, bload, DM, As, Bs, wrow0, wcol0, tid);
    ushort_t* dst; int ld, cbase;
    if (nt < 6) { dst = zq; ld = 768; cbase = col0; }
    else if (nt < 10) { dst = zg; ld = 1024; cbase = col0 - 768; }
    else if (nt < 24) { dst = zm; ld = 1792; cbase = col0 - 1280; }
    else { dst = zg; ld = 1024; cbase = 512 + col0 - 3072; }
#pragma unroll
    for (int mi = 0; mi < 2; ++mi)
#pragma unroll
      for (int ni = 0; ni < 2; ++ni)
#pragma unroll
        for (int i = 0; i < 16; ++i) {
          const int row = row0 + wrow0 + mi * 32 + crow(i, hh), col = cbase + wcol0 + ni * 32 + l31;
          dst[(size_t)row * ld + col] = f2bf(acc[0][mi][ni][i]);
        }
  }
}

DI int vperm(int key) { const int g = key >> 4, kq = key & 15; return g * 16 + 8 * ((kq >> 2) & 1) + (kq & 3) + 4 * (kq >> 3); }
DI void phase_qkv(const Params& p) {
  const ushort_t* zq = (const ushort_t*)(p.ws + OFF_ZQ);
  ushort_t* QB = (ushort_t*)(p.ws + OFF_QB);
  ushort_t* KB = (ushort_t*)(p.ws + OFF_KB);
  ushort_t* VB = (ushort_t*)(p.ws + OFF_VB);
  const int lane = threadIdx.x & 63, gw = blockIdx.x * 8 + (threadIdx.x >> 6);
  const int j = lane & 31, half = lane >> 5, axis = j >> 4, f = j & 15;
  const int d1 = axis * 32 + f, d2 = d1 + 16;
  const float inv = powf(10000.f, -(float)f * (1.f / 16.f));
  const float gq1 = p.q_norm[d1], gq2 = p.q_norm[d2], gk1 = p.k_norm[d1], gk2 = p.k_norm[d2];
  for (int row = gw; row < NT; row += gridDim.x * 8) {
    const bool isx = row < NX;
    const int b = isx ? row / SEQ : (row - NX) / CTXL;
    const int t = isx ? row % SEQ : (row - NX) % CTXL;
    const int pos = isx ? CTXL + t : t;
    const ushort_t* z = zq + (size_t)row * 768;
    float cs = 1.f, sn = 0.f;
    if (isx) { const float ang = (float)(axis ? (t & 63) : (t >> 6)) * inv; sincosf(ang, &sn, &cs); }
#pragma unroll
    for (int it = 0; it < 5; ++it) {
      const int hd = it * 2 + half;
      if (!isx && hd < 8) continue;
      const float v1 = bf2f(z[hd * 64 + d1]), v2 = bf2f(z[hd * 64 + d2]);
      float ss = v1 * v1 + v2 * v2;
#pragma unroll
      for (int o = 16; o >= 1; o >>= 1) ss += __shfl_xor(ss, o, 64);
      const float rms = rsqrtf(ss * (1.f / 64.f) + QK_EPS);
      const bool isq = hd < 8;
      const float y1 = v1 * rms * (isq ? gq1 : gk1), y2 = v2 * rms * (isq ? gq2 : gk2);
      float o1 = y1 * cs - y2 * sn, o2 = y2 * cs + y1 * sn;
      if (isq) {
        ushort_t* dst = QB + ((size_t)(b * 8 + hd) * SEQ + t) * 64;
        dst[d1] = f2bf(o1 * QSCALE); dst[d2] = f2bf(o2 * QSCALE);
      } else {
        ushort_t* dst = KB + ((size_t)(b * 2 + (hd - 8)) * LTOT + pos) * 64;
        dst[d1] = f2bf(o1); dst[d2] = f2bf(o2);
      }
    }
    {
      const size_t tb = (size_t)(pos >> 6) * 4096 + lane * 64 + vperm(pos & 63);
      VB[(size_t)(b * 2 + 0) * LTOT * 64 + tb] = z[640 + lane];
      VB[(size_t)(b * 2 + 1) * LTOT * 64 + tb] = z[704 + lane];
    }
  }
}

DI void phase_rwkv_prep(const Params& p, unsigned char* smem) {
  float* kbuf = (float*)smem;
  ushort_t* codes = (ushort_t*)(smem + 65536);
  float* invn = (float*)(smem + 65536 + 32 * 264 * 2);
  const ushort_t* zm = (const ushort_t*)p.out;
  const ushort_t* WL = (const ushort_t*)(p.ws + OFF_WL);
  ushort_t* SH = (ushort_t*)(p.ws + OFF_SH);
  ushort_t* DR = (ushort_t*)(p.ws + OFF_DR);
  const int tid = threadIdx.x, wave = tid >> 6, lane = tid & 63, l31 = lane & 31, hh = lane >> 5;
  for (int tt = blockIdx.x; tt < NT / 32; tt += gridDim.x) {
    const int row0 = tt * 32;
    int b, t0, len, pbase;
    if (row0 < NX) { b = row0 / SEQ; t0 = row0 % SEQ; len = SEQ; pbase = CTXL; }
    else { const int rc = row0 - NX; b = rc / CTXL; t0 = rc % CTXL; len = CTXL; pbase = 0; }
    __syncthreads();
    for (int id = tid; id < 32 * 224; id += NTH) {
      const int i = id / 224, c0 = (id % 224) * 8;
      const int t = t0 + i;
      const ushort_t* zr = zm + (size_t)(row0 + i) * 1792 + c0;
      const uint4 zc = *(const uint4*)zr;
      uint4 zp = make_uint4(0, 0, 0, 0), zn = make_uint4(0, 0, 0, 0);
      if (t > 0) zp = *(const uint4*)(zr - 1792);
      if (t < len - 1) zn = *(const uint4*)(zr + 1792);
      const float4 mp0 = *(const float4*)(p.mu_prev + c0), mp1 = *(const float4*)(p.mu_prev + c0 + 4);
      const float4 mn0 = *(const float4*)(p.mu_next + c0), mn1 = *(const float4*)(p.mu_next + c0 + 4);
      const unsigned zcw[4] = {zc.x, zc.y, zc.z, zc.w}, zpw[4] = {zp.x, zp.y, zp.z, zp.w}, znw[4] = {zn.x, zn.y, zn.z, zn.w};
      const float mpv[8] = {mp0.x, mp0.y, mp0.z, mp0.w, mp1.x, mp1.y, mp1.z, mp1.w};
      const float mnv[8] = {mn0.x, mn0.y, mn0.z, mn0.w, mn1.x, mn1.y, mn1.z, mn1.w};
      float s[8];
#pragma unroll
      for (int q = 0; q < 4; ++q) {
        const float c_lo = bflo(zcw[q]), c_hi = bfhi(zcw[q]);
        s[2 * q] = c_lo + mpv[2 * q] * (bflo(zpw[q]) - c_lo) + mnv[2 * q] * (bflo(znw[q]) - c_lo);
        s[2 * q + 1] = c_hi + mpv[2 * q + 1] * (bfhi(zpw[q]) - c_hi) + mnv[2 * q + 1] * (bfhi(znw[q]) - c_hi);
      }
      const int pp = pbase + t;
      if (c0 < 512 || (c0 >= 1024 && c0 < 1536)) {
        const int cc = (c0 < 512) ? c0 : c0 - 1024, which = (c0 < 512) ? 1 : 2;
        const int head = cc >> 6, d = cc & 63;
        uint4 o;
        o.x = pack_h2(s[0], s[1]); o.y = pack_h2(s[2], s[3]); o.z = pack_h2(s[4], s[5]); o.w = pack_h2(s[6], s[7]);
        *(uint4*)(SH + (((size_t)(b * 8 + head) * LTOT + pp) * 3 + which) * 64 + d) = o;
      } else if (c0 < 1024) {
        float* kd = kbuf + i * 512 + (c0 - 512);
        *(float4*)kd = make_float4(s[0], s[1], s[2], s[3]);
        *(float4*)(kd + 4) = make_float4(s[4], s[5], s[6], s[7]);
      } else {
        const int cc = c0 - 1536;
        if (cc < 128) {
#pragma unroll
          for (int q = 0; q < 8; ++q) s[q] = tanhf(s[q]);
        }
        uint4 o;
        o.x = pack_bf2(s[0], s[1]); o.y = pack_bf2(s[2], s[3]); o.z = pack_bf2(s[4], s[5]); o.w = pack_bf2(s[6], s[7]);
        *(uint4*)(codes + i * 264 + cc) = o;
      }
    }
    __syncthreads();
    {
      const int i = tid >> 4, head = (tid >> 1) & 7, hf = tid & 1;
      float ss = 0.f;
#pragma unroll 8
      for (int q = 0; q < 32; ++q) {
        const int n = head * 64 + hf * 32 + q;
        const float v = kbuf[i * 512 + n] * p.k_k[n];
        ss = fmaf(v, v, ss);
      }
      ss += __shfl_xor(ss, 1, 64);
      if (hf == 0) invn[i * 8 + head] = 1.f / fmaxf(sqrtf(ss), 1e-12f);
    }
    __syncthreads();
#pragma unroll 1
    for (int q4 = 0; q4 < 4; ++q4) {
      const int pr = wave * 4 + q4, dir = pr >> 4, ct = pr & 15;
      f32x16 aw = zero16(), aa = zero16();
#pragma unroll
      for (int ks = 0; ks < 4; ++ks) {
        const bf16x8 fw = *(const bf16x8*)&codes[l31 * 264 + dir * 64 + ks * 16 + hh * 8];
        const bf16x8 fa = *(const bf16x8*)&codes[l31 * 264 + 128 + dir * 64 + ks * 16 + hh * 8];
        const bf16x8 bw = *(const bf16x8*)&WL[(size_t)((dir * 2 + 0) * 512 + ct * 32 + l31) * 64 + ks * 16 + hh * 8];
        const bf16x8 ba = *(const bf16x8*)&WL[(size_t)((dir * 2 + 1) * 512 + ct * 32 + l31) * 64 + ks * 16 + hh * 8];
        aw = MFMA(fw, bw, aw);
        aa = MFMA(fa, ba, aa);
      }
      const int n = ct * 32 + l31, head = n >> 6, d = n & 63;
      const float w0v = p.w0[dir * 512 + n], a0v = p.a0[dir * 512 + n], kkw = p.k_k[n], kaw = p.k_a[n];
      const size_t cbase = (size_t)(b * 8 + head) * LTOT;
#pragma unroll
      for (int i = 0; i < 16; ++i) {
        const int ti = crow(i, hh);
        const int pp = pbase + t0 + ti;
        const float wpre = aw[i] + w0v;
        const float e = 0.60653065971263342f * sigmf(wpre);
        const float xdec = 1.f - __expf(-e);
        const float a = sigmf(aa[i] + a0v);
        const float kv = kbuf[ti * 512 + n];
        const float kkv = kv * kkw * invn[ti * 8 + head];
        const float kd = kv * (1.f + (a - 1.f) * kaw);
        ushort_t* dr = DR + ((((size_t)dir * 16) * LTOT + cbase + pp) * 3) * 64 + d;
        dr[0] = f2h(-xdec); dr[64] = f2h(kd); dr[128] = f2h(kkv * a);
        if (dir == 0) SH[((cbase + pp) * 3) * 64 + d] = f2h(kkv);
      }
    }
  }
}

DI int tau_to_pos(int dir, int tau) { return dir == 0 ? tau : (tau < CTXL ? CTXL - 1 - tau : LTOT - 1 - (tau - CTXL)); }


DI void fm_lo(float& acc, float a, uint32_t w) { asm("v_fma_mix_f32 %0, %1, %2, %0 op_sel_hi:[0,1,0]" : "+v"(acc) : "v"(a), "s"(w)); }
DI void fm_hi(float& acc, float a, uint32_t w) { asm("v_fma_mix_f32 %0, %1, %2, %0 op_sel:[0,1,0] op_sel_hi:[0,1,0]" : "+v"(acc) : "v"(a), "s"(w)); }
DI void fx_lo(float& s, uint32_t w) { asm("v_fma_mix_f32 %0, %0, %1, %0 op_sel_hi:[0,1,0]" : "+v"(s) : "s"(w)); }
DI void fx_hi(float& s, uint32_t w) { asm("v_fma_mix_f32 %0, %0, %1, %0 op_sel:[0,1,0] op_sel_hi:[0,1,0]" : "+v"(s) : "s"(w)); }
constexpr int PFD = 2, SEG = 65;
static_assert(CH % SEG == 0, "segments");
DI void scan_prefetch(uint32_t& pfr, const ushort_t* shc, const ushort_t* drc, int pos, int lane) {
  const ushort_t* a = (lane < 24) ? shc + (size_t)pos * 192 + lane * 8 : drc + (size_t)pos * 192 + (lane < 48 ? lane - 24 : 23) * 8;
  asm volatile("global_load_dword %0, %1, off" : "+v"(pfr) : "v"(a) : "memory");
}
DI void scan_stage_v(ushort_t* vbuf, const ushort_t* shc, int dir, int tau0, int lane) {
#pragma unroll
  for (int i = 0; i < (SEG * 8 + 63) / 64; ++i) {
    const int id = i * 64 + lane, st = id >> 3;
    if (st < SEG) *(uint4*)&vbuf[st * 64 + (id & 7) * 8] = *(const uint4*)(shc + (size_t)tau_to_pos(dir, tau0 + st) * 192 + 128 + (id & 7) * 8);
  }
}
struct ScanRec { uint32_t sh, dr, bb; ushort_t v; };
DI ScanRec scan_load(const ushort_t* shc, const ushort_t* drc, int pos, int lane) {
  ScanRec r;
  const ushort_t* s = shc + (size_t)pos * 192;
  const uint32_t* d = (const uint32_t*)(drc + (size_t)pos * 192);
  r.sh = ((const uint32_t*)s)[lane];
  r.v = s[128 + lane];
  r.dr = d[lane];
  r.bb = d[64 + (lane & 31)];
  return r;
}
#define MIXLO " op_sel_hi:[0,1,0]\n\t"
#define MIXHI " op_sel:[0,1,0] op_sel_hi:[0,1,0]\n\t"
template <int L>
DI void dot4(float& a0, float& a1, float& a2, float& a3, float (&S)[64], uint32_t src) {
  uint32_t t0, t1, t2, t3;
  asm("v_readlane_b32 %4, %8, %9\n\tv_readlane_b32 %5, %8, %10\n\tv_readlane_b32 %6, %8, %11\n\tv_readlane_b32 %7, %8, %12\n\t"
      "v_fma_mix_f32 %0, %13, %4, %0" MIXLO "v_fma_mix_f32 %1, %14, %4, %1" MIXHI
      "v_fma_mix_f32 %2, %15, %5, %2" MIXLO "v_fma_mix_f32 %3, %16, %5, %3" MIXHI
      "v_fma_mix_f32 %0, %17, %6, %0" MIXLO "v_fma_mix_f32 %1, %18, %6, %1" MIXHI
      "v_fma_mix_f32 %2, %19, %7, %2" MIXLO "v_fma_mix_f32 %3, %20, %7, %3" MIXHI
      : "+v"(a0), "+v"(a1), "+v"(a2), "+v"(a3), "=&s"(t0), "=&s"(t1), "=&s"(t2), "=&s"(t3)
      : "v"(src), "n"(L), "n"(L + 1), "n"(L + 2), "n"(L + 3),
        "v"(S[2 * (L & 31)]), "v"(S[2 * (L & 31) + 1]), "v"(S[2 * (L & 31) + 2]), "v"(S[2 * (L & 31) + 3]),
        "v"(S[2 * (L & 31) + 4]), "v"(S[2 * (L & 31) + 5]), "v"(S[2 * (L & 31) + 6]), "v"(S[2 * (L & 31) + 7]));
}
template <int L>
DI void upd4(float (&S)[64], uint32_t dr, uint32_t bb, float vv, float nsk) {
  uint32_t x0, x1, x2, x3, k0, k1, k2, k3, b0, b1, b2, b3;
  asm("v_readlane_b32 %8, %20, %22\n\tv_readlane_b32 %9, %20, %23\n\tv_readlane_b32 %10, %20, %24\n\tv_readlane_b32 %11, %20, %25\n\t"
      "v_readlane_b32 %12, %20, %26\n\tv_readlane_b32 %13, %20, %27\n\tv_readlane_b32 %14, %20, %28\n\tv_readlane_b32 %15, %20, %29\n\t"
      "v_readlane_b32 %16, %21, %22\n\tv_readlane_b32 %17, %21, %23\n\tv_readlane_b32 %18, %21, %24\n\tv_readlane_b32 %19, %21, %25\n\t"
      "v_fma_mix_f32 %0, %0, %8, %0" MIXLO "v_fma_mix_f32 %1, %1, %8, %1" MIXHI
      "v_fma_mix_f32 %2, %2, %9, %2" MIXLO "v_fma_mix_f32 %3, %3, %9, %3" MIXHI
      "v_fma_mix_f32 %4, %4, %10, %4" MIXLO "v_fma_mix_f32 %5, %5, %10, %5" MIXHI
      "v_fma_mix_f32 %6, %6, %11, %6" MIXLO "v_fma_mix_f32 %7, %7, %11, %7" MIXHI
      "v_fma_mix_f32 %0, %30, %12, %0" MIXLO "v_fma_mix_f32 %1, %30, %12, %1" MIXHI
      "v_fma_mix_f32 %2, %30, %13, %2" MIXLO "v_fma_mix_f32 %3, %30, %13, %3" MIXHI
      "v_fma_mix_f32 %4, %30, %14, %4" MIXLO "v_fma_mix_f32 %5, %30, %14, %5" MIXHI
      "v_fma_mix_f32 %6, %30, %15, %6" MIXLO "v_fma_mix_f32 %7, %30, %15, %7" MIXHI
      "v_fma_mix_f32 %0, %31, %16, %0" MIXLO "v_fma_mix_f32 %1, %31, %16, %1" MIXHI
      "v_fma_mix_f32 %2, %31, %17, %2" MIXLO "v_fma_mix_f32 %3, %31, %17, %3" MIXHI
      "v_fma_mix_f32 %4, %31, %18, %4" MIXLO "v_fma_mix_f32 %5, %31, %18, %5" MIXHI
      "v_fma_mix_f32 %6, %31, %19, %6" MIXLO "v_fma_mix_f32 %7, %31, %19, %7" MIXHI
      : "+v"(S[2 * L]), "+v"(S[2 * L + 1]), "+v"(S[2 * L + 2]), "+v"(S[2 * L + 3]), "+v"(S[2 * L + 4]), "+v"(S[2 * L + 5]), "+v"(S[2 * L + 6]), "+v"(S[2 * L + 7]),
        "=&s"(x0), "=&s"(x1), "=&s"(x2), "=&s"(x3), "=&s"(k0), "=&s"(k1), "=&s"(k2), "=&s"(k3), "=&s"(b0), "=&s"(b1), "=&s"(b2), "=&s"(b3)
      : "v"(dr), "v"(bb), "n"(L), "n"(L + 1), "n"(L + 2), "n"(L + 3), "n"(L + 32), "n"(L + 33), "n"(L + 34), "n"(L + 35), "v"(vv), "v"(nsk));
}
template <int L>
DI void dot4_2(float& a0, float& a1, float& c0, float& c1, float (&SU)[64], float (&SP)[64], uint32_t src) {
  uint32_t t0, t1, t2, t3;
  asm("v_readlane_b32 %4, %8, %9\n\tv_readlane_b32 %5, %8, %10\n\tv_readlane_b32 %6, %8, %11\n\tv_readlane_b32 %7, %8, %12\n\t"
      "v_fma_mix_f32 %0, %13, %4, %0" MIXLO "v_fma_mix_f32 %1, %14, %4, %1" MIXHI
      "v_fma_mix_f32 %2, %21, %4, %2" MIXLO "v_fma_mix_f32 %3, %22, %4, %3" MIXHI
      "v_fma_mix_f32 %0, %15, %5, %0" MIXLO "v_fma_mix_f32 %1, %16, %5, %1" MIXHI
      "v_fma_mix_f32 %2, %23, %5, %2" MIXLO "v_fma_mix_f32 %3, %24, %5, %3" MIXHI
      "v_fma_mix_f32 %0, %17, %6, %0" MIXLO "v_fma_mix_f32 %1, %18, %6, %1" MIXHI
      "v_fma_mix_f32 %2, %25, %6, %2" MIXLO "v_fma_mix_f32 %3, %26, %6, %3" MIXHI
      "v_fma_mix_f32 %0, %19, %7, %0" MIXLO "v_fma_mix_f32 %1, %20, %7, %1" MIXHI
      "v_fma_mix_f32 %2, %27, %7, %2" MIXLO "v_fma_mix_f32 %3, %28, %7, %3" MIXHI
      : "+v"(a0), "+v"(a1), "+v"(c0), "+v"(c1), "=&s"(t0), "=&s"(t1), "=&s"(t2), "=&s"(t3)
      : "v"(src), "n"(L), "n"(L + 1), "n"(L + 2), "n"(L + 3),
        "v"(SU[2 * L]), "v"(SU[2 * L + 1]), "v"(SU[2 * L + 2]), "v"(SU[2 * L + 3]), "v"(SU[2 * L + 4]), "v"(SU[2 * L + 5]), "v"(SU[2 * L + 6]), "v"(SU[2 * L + 7]),
        "v"(SP[2 * L]), "v"(SP[2 * L + 1]), "v"(SP[2 * L + 2]), "v"(SP[2 * L + 3]), "v"(SP[2 * L + 4]), "v"(SP[2 * L + 5]), "v"(SP[2 * L + 6]), "v"(SP[2 * L + 7]));
}
template <int L>
DI void upd4_2(float (&SU)[64], float (&SP)[64], uint32_t dr, uint32_t bb, float vv, float nskU, float nskP) {
  uint32_t x0, x1, x2, x3, k0, k1, k2, k3, b0, b1, b2, b3;
  asm("v_readlane_b32 %16, %28, %30\n\tv_readlane_b32 %17, %28, %31\n\tv_readlane_b32 %18, %28, %32\n\tv_readlane_b32 %19, %28, %33\n\t"
      "v_readlane_b32 %20, %28, %34\n\tv_readlane_b32 %21, %28, %35\n\tv_readlane_b32 %22, %28, %36\n\tv_readlane_b32 %23, %28, %37\n\t"
      "v_readlane_b32 %24, %29, %30\n\tv_readlane_b32 %25, %29, %31\n\tv_readlane_b32 %26, %29, %32\n\tv_readlane_b32 %27, %29, %33\n\t"
      "v_fma_mix_f32 %0, %0, %16, %0" MIXLO "v_fma_mix_f32 %1, %1, %16, %1" MIXHI
      "v_fma_mix_f32 %2, %2, %17, %2" MIXLO "v_fma_mix_f32 %3, %3, %17, %3" MIXHI
      "v_fma_mix_f32 %4, %4, %18, %4" MIXLO "v_fma_mix_f32 %5, %5, %18, %5" MIXHI
      "v_fma_mix_f32 %6, %6, %19, %6" MIXLO "v_fma_mix_f32 %7, %7, %19, %7" MIXHI
      "v_fma_mix_f32 %8, %8, %16, %8" MIXLO "v_fma_mix_f32 %9, %9, %16, %9" MIXHI
      "v_fma_mix_f32 %10, %10, %17, %10" MIXLO "v_fma_mix_f32 %11, %11, %17, %11" MIXHI
      "v_fma_mix_f32 %12, %12, %18, %12" MIXLO "v_fma_mix_f32 %13, %13, %18, %13" MIXHI
      "v_fma_mix_f32 %14, %14, %19, %14" MIXLO "v_fma_mix_f32 %15, %15, %19, %15" MIXHI
      "v_fma_mix_f32 %0, %38, %20, %0" MIXLO "v_fma_mix_f32 %1, %38, %20, %1" MIXHI
      "v_fma_mix_f32 %2, %38, %21, %2" MIXLO "v_fma_mix_f32 %3, %38, %21, %3" MIXHI
      "v_fma_mix_f32 %4, %38, %22, %4" MIXLO "v_fma_mix_f32 %5, %38, %22, %5" MIXHI
      "v_fma_mix_f32 %6, %38, %23, %6" MIXLO "v_fma_mix_f32 %7, %38, %23, %7" MIXHI
      "v_fma_mix_f32 %0, %39, %24, %0" MIXLO "v_fma_mix_f32 %1, %39, %24, %1" MIXHI
      "v_fma_mix_f32 %2, %39, %25, %2" MIXLO "v_fma_mix_f32 %3, %39, %25, %3" MIXHI
      "v_fma_mix_f32 %4, %39, %26, %4" MIXLO "v_fma_mix_f32 %5, %39, %26, %5" MIXHI
      "v_fma_mix_f32 %6, %39, %27, %6" MIXLO "v_fma_mix_f32 %7, %39, %27, %7" MIXHI
      "v_fma_mix_f32 %8, %40, %24, %8" MIXLO "v_fma_mix_f32 %9, %40, %24, %9" MIXHI
      "v_fma_mix_f32 %10, %40, %25, %10" MIXLO "v_fma_mix_f32 %11, %40, %25, %11" MIXHI
      "v_fma_mix_f32 %12, %40, %26, %12" MIXLO "v_fma_mix_f32 %13, %40, %26, %13" MIXHI
      "v_fma_mix_f32 %14, %40, %27, %14" MIXLO "v_fma_mix_f32 %15, %40, %27, %15" MIXHI
      : "+v"(SU[2 * L]), "+v"(SU[2 * L + 1]), "+v"(SU[2 * L + 2]), "+v"(SU[2 * L + 3]), "+v"(SU[2 * L + 4]), "+v"(SU[2 * L + 5]), "+v"(SU[2 * L + 6]), "+v"(SU[2 * L + 7]),
        "+v"(SP[2 * L]), "+v"(SP[2 * L + 1]), "+v"(SP[2 * L + 2]), "+v"(SP[2 * L + 3]), "+v"(SP[2 * L + 4]), "+v"(SP[2 * L + 5]), "+v"(SP[2 * L + 6]), "+v"(SP[2 * L + 7]),
        "=&s"(x0), "=&s"(x1), "=&s"(x2), "=&s"(x3), "=&s"(k0), "=&s"(k1), "=&s"(k2), "=&s"(k3), "=&s"(b0), "=&s"(b1), "=&s"(b2), "=&s"(b3)
      : "v"(dr), "v"(bb), "n"(L), "n"(L + 1), "n"(L + 2), "n"(L + 3), "n"(L + 32), "n"(L + 33), "n"(L + 34), "n"(L + 35), "v"(vv), "v"(nskU), "v"(nskP));
}
DI void scan_step2(float (&SU)[64], float (&SP)[64], const ScanRec& c, float vv) {
  float a0 = 0.f, a1 = 0.f, c0 = 0.f, c1 = 0.f;
  dot4_2<0>(a0, a1, c0, c1, SU, SP, c.sh); dot4_2<4>(a0, a1, c0, c1, SU, SP, c.sh); dot4_2<8>(a0, a1, c0, c1, SU, SP, c.sh); dot4_2<12>(a0, a1, c0, c1, SU, SP, c.sh);
  dot4_2<16>(a0, a1, c0, c1, SU, SP, c.sh); dot4_2<20>(a0, a1, c0, c1, SU, SP, c.sh); dot4_2<24>(a0, a1, c0, c1, SU, SP, c.sh); dot4_2<28>(a0, a1, c0, c1, SU, SP, c.sh);
  const float nU = -(a0 + a1), nP = -(c0 + c1);
  upd4_2<0>(SU, SP, c.dr, c.bb, vv, nU, nP); upd4_2<4>(SU, SP, c.dr, c.bb, vv, nU, nP); upd4_2<8>(SU, SP, c.dr, c.bb, vv, nU, nP); upd4_2<12>(SU, SP, c.dr, c.bb, vv, nU, nP);
  upd4_2<16>(SU, SP, c.dr, c.bb, vv, nU, nP); upd4_2<20>(SU, SP, c.dr, c.bb, vv, nU, nP); upd4_2<24>(SU, SP, c.dr, c.bb, vv, nU, nP); upd4_2<28>(SU, SP, c.dr, c.bb, vv, nU, nP);
}
template <bool WITH_OUT>
DI float scan_step(float (&S)[64], const ScanRec& c, float vv) {
  float s0 = 0.f, s1 = 0.f, s2 = 0.f, s3 = 0.f;
  dot4<0>(s0, s1, s2, s3, S, c.sh); dot4<4>(s0, s1, s2, s3, S, c.sh); dot4<8>(s0, s1, s2, s3, S, c.sh); dot4<12>(s0, s1, s2, s3, S, c.sh);
  dot4<16>(s0, s1, s2, s3, S, c.sh); dot4<20>(s0, s1, s2, s3, S, c.sh); dot4<24>(s0, s1, s2, s3, S, c.sh); dot4<28>(s0, s1, s2, s3, S, c.sh);
  const float nsk = -((s0 + s1) + (s2 + s3));
  upd4<0>(S, c.dr, c.bb, vv, nsk); upd4<4>(S, c.dr, c.bb, vv, nsk); upd4<8>(S, c.dr, c.bb, vv, nsk); upd4<12>(S, c.dr, c.bb, vv, nsk);
  upd4<16>(S, c.dr, c.bb, vv, nsk); upd4<20>(S, c.dr, c.bb, vv, nsk); upd4<24>(S, c.dr, c.bb, vv, nsk); upd4<28>(S, c.dr, c.bb, vv, nsk);
  float o0 = 0.f, o1 = 0.f, o2 = 0.f, o3 = 0.f;
  if (WITH_OUT) {
    dot4<32>(o0, o1, o2, o3, S, c.sh); dot4<36>(o0, o1, o2, o3, S, c.sh); dot4<40>(o0, o1, o2, o3, S, c.sh); dot4<44>(o0, o1, o2, o3, S, c.sh);
    dot4<48>(o0, o1, o2, o3, S, c.sh); dot4<52>(o0, o1, o2, o3, S, c.sh); dot4<56>(o0, o1, o2, o3, S, c.sh); dot4<60>(o0, o1, o2, o3, S, c.sh);
  }
  return (o0 + o1) + (o2 + o3);
}
constexpr int SPF = 3;
DI void scan_stage_vr(ushort_t* vbuf, ushort_t* rbuf, const ushort_t* shc, int dir, int tau0, int lane) {
#pragma unroll
  for (int i = 0; i < (SEG * 8 + 63) / 64; ++i) {
    const int id = i * 64 + lane, st = id >> 3;
    if (st < SEG) {
      const ushort_t* rec = shc + (size_t)tau_to_pos(dir, tau0 + st) * 192 + (id & 7) * 8;
      *(uint4*)&vbuf[st * 64 + (id & 7) * 8] = *(const uint4*)(rec + 128);
      *(uint4*)&rbuf[st * 64 + (id & 7) * 8] = *(const uint4*)(rec + 64);
    }
    if (i % 3 == 2) asm volatile("" ::: "memory");
  }
}
DI void fv_lo(float& acc, float a, uint32_t w) { asm("v_fma_mix_f32 %0, %1, %2, %0 op_sel_hi:[0,1,0]" : "+v"(acc) : "v"(a), "v"(w)); }
DI void fv_hi(float& acc, float a, uint32_t w) { asm("v_fma_mix_f32 %0, %1, %2, %0 op_sel:[0,1,0] op_sel_hi:[0,1,0]" : "+v"(acc) : "v"(a), "v"(w)); }
DI void phase_scanA(const Params& p, unsigned char* smem) {
  const ushort_t* SH = (const ushort_t*)(p.ws + OFF_SH);
  const ushort_t* DR = (const ushort_t*)(p.ws + OFF_DR);
  float* PU = p.out;
  const int lane = threadIdx.x & 63;
  ushort_t* vbuf = (ushort_t*)smem + (threadIdx.x >> 6) * (2 * SEG * 64);
  ushort_t* rbuf = vbuf + SEG * 64;
  ushort_t* O = (ushort_t*)(p.ws + OFF_ZQ);
  ushort_t* DRw = (ushort_t*)(p.ws + OFF_DR);
  const int gw = __builtin_amdgcn_readfirstlane(blockIdx.x * 8 + (threadIdx.x >> 6));
  uint32_t pfr = 0u;
  for (int task = gw; task < 32 * NCHUNK; task += gridDim.x * 8) {
    const int cd = task / NCHUNK, j = task % NCHUNK, dir = cd >> 4, c = cd & 15, b = c >> 3, head = c & 7;
    float SU[64], SP[64];
#pragma unroll
    for (int k = 0; k < 64; ++k) { SU[k] = 0.f; SP[k] = (k == lane) ? 1.f : 0.f; }
    const ushort_t* shc = SH + (size_t)c * LTOT * 192;
    const ushort_t* drc = DR + (size_t)(dir * 16 + c) * LTOT * 192;
#pragma unroll 1
    for (int st = 0; st < PFD; ++st) scan_prefetch(pfr, shc, drc, tau_to_pos(dir, j * CH + st), lane);
#pragma unroll 1
    for (int sg = 0; sg < CH / SEG; ++sg) {
      scan_stage_vr(vbuf, rbuf, shc, dir, j * CH + sg * SEG, lane);
#pragma unroll 1
      for (int s2 = 0; s2 < SEG; ++s2) {
        const int st = sg * SEG + s2;
        const int pos = tau_to_pos(dir, j * CH + st);
        const ushort_t* shr = shc + (size_t)pos * 192;
        const ushort_t* drr = drc + (size_t)pos * 192;
        scan_prefetch(pfr, shc, drc, tau_to_pos(dir, j * CH + (st + PFD < CH ? st + PFD : CH - 1)), lane);
        const float vv = h2f(vbuf[s2 * 64 + lane]);
        u32x16 a0, a1, b0, b1;
        sload4(a0, a1, b0, b1, shr, drr);
        float u0 = 0.f, u1 = 0.f, q0 = 0.f, q1 = 0.f;
#pragma unroll
        for (int q = 0; q < 16; ++q) {
          fm_lo(u0, SU[2 * q], a0[q]); fm_hi(u1, SU[2 * q + 1], a0[q]); fm_lo(q0, SP[2 * q], a0[q]); fm_hi(q1, SP[2 * q + 1], a0[q]);
          fm_lo(u0, SU[32 + 2 * q], a1[q]); fm_hi(u1, SU[33 + 2 * q], a1[q]); fm_lo(q0, SP[32 + 2 * q], a1[q]); fm_hi(q1, SP[33 + 2 * q], a1[q]);
        }
        const float nU = -(u0 + u1), nP = -(q0 + q1);
#pragma unroll
        for (int q = 0; q < 16; ++q) {
          fx_lo(SU[2 * q], b0[q]); fx_hi(SU[2 * q + 1], b0[q]); fx_lo(SU[32 + 2 * q], b1[q]); fx_hi(SU[33 + 2 * q], b1[q]);
          fx_lo(SP[2 * q], b0[q]); fx_hi(SP[2 * q + 1], b0[q]); fx_lo(SP[32 + 2 * q], b1[q]); fx_hi(SP[33 + 2 * q], b1[q]);
        }
        sload4(a0, a1, b0, b1, drr + 64, drr + 128);
#pragma unroll
        for (int q = 0; q < 16; ++q) { fm_lo(SU[2 * q], vv, a0[q]); fm_hi(SU[2 * q + 1], vv, a0[q]); fm_lo(SU[32 + 2 * q], vv, a1[q]); fm_hi(SU[33 + 2 * q], vv, a1[q]); }
#pragma unroll
        for (int q = 0; q < 16; ++q) {
          fm_lo(SU[2 * q], nU, b0[q]); fm_hi(SU[2 * q + 1], nU, b0[q]); fm_lo(SU[32 + 2 * q], nU, b1[q]); fm_hi(SU[33 + 2 * q], nU, b1[q]);
          fm_lo(SP[2 * q], nP, b0[q]); fm_hi(SP[2 * q + 1], nP, b0[q]); fm_lo(SP[32 + 2 * q], nP, b1[q]); fm_hi(SP[33 + 2 * q], nP, b1[q]);
        }
        if (pos >= CTXL) {
          float e0 = 0.f, e1 = 0.f, g0 = 0.f, g1 = 0.f;
#pragma unroll
          for (int q = 0; q < 8; ++q) {
            asm volatile("" ::: "memory");
            const uint4 rw = *(const uint4*)&rbuf[s2 * 64 + q * 8];
            fv_lo(e0, SU[8 * q + 0], rw.x); fv_hi(e1, SU[8 * q + 1], rw.x); fv_lo(g0, SP[8 * q + 0], rw.x); fv_hi(g1, SP[8 * q + 1], rw.x);
            fv_lo(e0, SU[8 * q + 2], rw.y); fv_hi(e1, SU[8 * q + 3], rw.y); fv_lo(g0, SP[8 * q + 2], rw.y); fv_hi(g1, SP[8 * q + 3], rw.y);
            fv_lo(e0, SU[8 * q + 4], rw.z); fv_hi(e1, SU[8 * q + 5], rw.z); fv_lo(g0, SP[8 * q + 4], rw.z); fv_hi(g1, SP[8 * q + 5], rw.z);
            fv_lo(e0, SU[8 * q + 6], rw.w); fv_hi(e1, SU[8 * q + 7], rw.w); fv_lo(g0, SP[8 * q + 6], rw.w); fv_hi(g1, SP[8 * q + 7], rw.w);
          }
          O[((size_t)dir * NX + (size_t)b * SEQ + (pos - CTXL)) * 512 + head * 64 + lane] = f2h(e0 + e1);
          DRw[((size_t)(dir * 16 + c) * LTOT + pos) * 192 + lane] = f2h(g0 + g1);
        }
      }
    }
    float* dst = PU + (size_t)task * 2 * 4096 + lane * 64;
#pragma unroll
    for (int k = 0; k < 64; k += 4) {
      *(float4*)(dst + k) = make_float4(SU[k], SU[k + 1], SU[k + 2], SU[k + 3]);
      *(float4*)(dst + 4096 + k) = make_float4(SP[k], SP[k + 1], SP[k + 2], SP[k + 3]);
    }
  }
  asm volatile("s_waitcnt vmcnt(0)" ::: "memory");
  asm volatile("" :: "v"(pfr));
}

DI void phase_scanB(const Params& p, unsigned char* smem) {
  if (blockIdx.x >= 32) return;
  float* Sb = (float*)smem;
  float* Xb = Sb + 64 * 65;
  float* PU = p.out;
  const int cd = blockIdx.x, tid = threadIdx.x, wave = tid >> 6, lane = tid & 63, l31 = lane & 31, hh = lane >> 5;
  const int tile = wave & 3, tm = tile >> 1, tn = tile & 1, kh = wave >> 2;
  for (int i = tid; i < 64 * 65; i += NTH) Sb[i] = 0.f;
  constexpr int BPF = 4;
  float bP[BPF][16];
  f32x16 uT[BPF];
#pragma unroll
  for (int s = 0; s < BPF; ++s) uT[s] = zero16();
  auto fetch = [&](int j, float (&bp)[16], f32x16& ut) {
    const float* base = PU + (size_t)(cd * NCHUNK + j) * 2 * 4096;
#pragma unroll
    for (int kk = 0; kk < 16; ++kk) bp[kk] = base[4096 + (kh * 32 + 2 * kk + hh) * 64 + tn * 32 + l31];
    if (kh == 0) {
#pragma unroll
      for (int i = 0; i < 16; ++i) ut[i] = base[(tm * 32 + crow(i, hh)) * 64 + tn * 32 + l31];
    }
  };
  auto put_state = [&](int j, const f32x16& st) {
    float* base = PU + (size_t)(cd * NCHUNK + j) * 2 * 4096;
#pragma unroll
    for (int i = 0; i < 16; ++i) base[(tm * 32 + crow(i, hh)) * 64 + tn * 32 + l31] = st[i];
  };
#pragma unroll
  for (int s = 0; s < BPF; ++s) fetch(s, bP[s], uT[s]);
  if (kh == 0) put_state(0, zero16());
  __syncthreads();
#pragma unroll 1
  for (int j = 0; j < NCHUNK; ++j) {
    float nP[16];
    f32x16 nU = zero16();
    if (j + BPF < NCHUNK) fetch(j + BPF, nP, nU);
    f32x16 acc = (kh == 0) ? uT[0] : zero16();
#pragma unroll
    for (int kk = 0; kk < 16; ++kk) {
      const float a = Sb[(tm * 32 + l31) * 65 + kh * 32 + 2 * kk + hh];
      acc = __builtin_amdgcn_mfma_f32_32x32x2f32(a, bP[0][kk], acc, 0, 0, 0);
    }
    if (kh == 1) {
#pragma unroll
      for (int i = 0; i < 16; ++i) Xb[(tile * 16 + i) * 64 + lane] = acc[i];
    }
    __syncthreads();
    if (kh == 0) {
#pragma unroll
      for (int i = 0; i < 16; ++i) { acc[i] += Xb[(tile * 16 + i) * 64 + lane]; Sb[(tm * 32 + crow(i, hh)) * 65 + tn * 32 + l31] = acc[i]; }
      if (j + 1 < NCHUNK) put_state(j + 1, acc);
    }
#pragma unroll
    for (int s = 0; s + 1 < BPF; ++s) {
#pragma unroll
      for (int kk = 0; kk < 16; ++kk) bP[s][kk] = bP[s + 1][kk];
      uT[s] = uT[s + 1];
    }
#pragma unroll
    for (int kk = 0; kk < 16; ++kk) bP[BPF - 1][kk] = nP[kk];
    uT[BPF - 1] = nU;
    __syncthreads();
  }
}

typedef __attribute__((ext_vector_type(8))) _Float16 f16x8;
DI void phase_scanC(const Params& p, unsigned char* smem) {
  const ushort_t* DR = (const ushort_t*)(p.ws + OFF_DR);
  ushort_t* O = (ushort_t*)(p.ws + OFF_ZQ);
  const float* PU = p.out;
  const int lane = threadIdx.x & 63, l31 = lane & 31, hh = lane >> 5;
  const int gw = blockIdx.x * 8 + (threadIdx.x >> 6);
  for (int task = gw; task < 32 * NCHUNK; task += gridDim.x * 8) {
    const int cd = task / NCHUNK, j = task % NCHUNK, dir = cd >> 4, c = cd & 15, b = c >> 3, head = c & 7;
    if (j == 0) continue;
    const float* S = PU + (size_t)task * 2 * 4096;
    f16x8 bs[2][4];
#pragma unroll
    for (int nt = 0; nt < 2; ++nt)
#pragma unroll
      for (int ks = 0; ks < 4; ++ks) {
        const float* sp = S + (nt * 32 + l31) * 64 + ks * 16 + hh * 8;
        const float4 x0 = *(const float4*)sp, x1 = *(const float4*)(sp + 4);
        f16x8 f = {(_Float16)x0.x, (_Float16)x0.y, (_Float16)x0.z, (_Float16)x0.w, (_Float16)x1.x, (_Float16)x1.y, (_Float16)x1.z, (_Float16)x1.w};
        bs[nt][ks] = f;
      }
    const ushort_t* drc = DR + (size_t)(dir * 16 + c) * LTOT * 192;
    ushort_t* obase = O + ((size_t)dir * NX + (size_t)b * SEQ) * 512 + head * 64;
#pragma unroll 1
    for (int tile = 0; tile < (CH + 31) / 32; ++tile) {
      const int tau = tile * 32 + l31;
      const int pos = tau_to_pos(dir, j * CH + (tau < CH ? tau : CH - 1));
      const ushort_t* wrow = drc + (size_t)pos * 192;
      f32x16 acc[2] = {zero16(), zero16()};
#pragma unroll
      for (int ks = 0; ks < 4; ++ks) {
        const f16x8 a = *(const f16x8*)(wrow + ks * 16 + hh * 8);
        acc[0] = __builtin_amdgcn_mfma_f32_32x32x16_f16(a, bs[0][ks], acc[0], 0, 0, 0);
        acc[1] = __builtin_amdgcn_mfma_f32_32x32x16_f16(a, bs[1][ks], acc[1], 0, 0, 0);
      }
#pragma unroll
      for (int i = 0; i < 16; ++i) {
        const int t2 = tile * 32 + crow(i, hh);
        if (t2 < CH) {
          const int p2 = tau_to_pos(dir, j * CH + t2);
          if (p2 >= CTXL) {
            ushort_t* o0 = obase + (size_t)(p2 - CTXL) * 512 + l31;
            o0[0] = f2h(h2f(o0[0]) + acc[0][i]);
            o0[32] = f2h(h2f(o0[32]) + acc[1][i]);
          }
        }
      }
    }
  }
}

DI void phase_scan_naive(const Params& p) {
  const ushort_t* SH = (const ushort_t*)(p.ws + OFF_SH);
  const ushort_t* DR = (const ushort_t*)(p.ws + OFF_DR);
  ushort_t* O = (ushort_t*)(p.ws + OFF_ZQ);
  const int lane = threadIdx.x & 63;
  const int gw = __builtin_amdgcn_readfirstlane(blockIdx.x * 8 + (threadIdx.x >> 6));
  if (gw >= 32) return;
  const int cd = gw, dir = cd >> 4, c = cd & 15, b = c >> 3, head = c & 7;
  float S[64];
#pragma unroll
  for (int k = 0; k < 64; ++k) S[k] = 0.f;
  const ushort_t* shc = SH + (size_t)c * LTOT * 192;
  const ushort_t* drc = DR + (size_t)(dir * 16 + c) * LTOT * 192;
#pragma unroll 1
  for (int tau = 0; tau < LTOT; ++tau) {
    const int pos = tau_to_pos(dir, tau);
    const ushort_t* shr = shc + (size_t)pos * 192;
    const ushort_t* drr = drc + (size_t)pos * 192;
    const float vv = h2f(shr[128 + lane]);
    u32x16 k0, k1;
    sload2(k0, k1, shr);
    float sk0 = 0.f, sk1 = 0.f;
#pragma unroll
    for (int q = 0; q < 32; ++q) { sk0 = fmaf(S[q], HV(k0, q), sk0); sk1 = fmaf(S[32 + q], HV(k1, q), sk1); }
    const float nsk = -(sk0 + sk1);
    u32x16 x0, x1, d0, d1;
    sload4(x0, x1, d0, d1, drr, drr + 64);
#pragma unroll
    for (int q = 0; q < 32; ++q) {
      S[q] = fmaf(S[q], -HV(x0, q), S[q]); S[32 + q] = fmaf(S[32 + q], -HV(x1, q), S[32 + q]);
      S[q] = fmaf(vv, HV(d0, q), S[q]); S[32 + q] = fmaf(vv, HV(d1, q), S[32 + q]);
    }
    u32x16 b0, b1, r0, r1;
    sload4(b0, b1, r0, r1, drr + 128, shr + 64);
    float o0 = 0.f, o1 = 0.f;
#pragma unroll
    for (int q = 0; q < 32; ++q) {
      S[q] = fmaf(nsk, HV(b0, q), S[q]); S[32 + q] = fmaf(nsk, HV(b1, q), S[32 + q]);
      o0 = fmaf(S[q], HV(r0, q), o0); o1 = fmaf(S[32 + q], HV(r1, q), o1);
    }
    if (pos >= CTXL) O[((size_t)dir * NX + (size_t)b * SEQ + (pos - CTXL)) * 512 + head * 64 + lane] = f2h(o0 + o1);
  }
}

DI void phase_attn(const Params& p, unsigned char* smem) {
  ushort_t* Kb = (ushort_t*)smem;
  ushort_t* Vb = Kb + 2 * 64 * LDK;
  ushort_t* QB = (ushort_t*)(p.ws + OFF_QB);
  const ushort_t* KB = (const ushort_t*)(p.ws + OFF_KB);
  const ushort_t* VB = (const ushort_t*)(p.ws + OFF_VB);
  const int tid = threadIdx.x, wave = tid >> 6, lane = tid & 63, l31 = lane & 31, hh = lane >> 5;
  const int loff = (tid >> 3) * LDK + (tid & 7) * 8;
  constexpr float THR = 6.f;
  constexpr int NTL = LTOT / 64;
  for (int at = blockIdx.x; at < 1024; at += gridDim.x) {
    const int b = at >> 9, kvh = (at >> 8) & 1, t0 = (at & 255) * 64;
    const int head = kvh * 4 + (wave & 3), tq = t0 + (wave >> 2) * 32 + l31;
    ushort_t* qrow = QB + ((size_t)(b * 8 + head) * SEQ + tq) * 64;
    bf16x8 qf[4];
#pragma unroll
    for (int ks = 0; ks < 4; ++ks) qf[ks] = *(const bf16x8*)(qrow + ks * 16 + hh * 8);
    const ushort_t* kbase = KB + (size_t)(b * 2 + kvh) * LTOT * 64 + tid * 8;
    const ushort_t* vbase = VB + (size_t)(b * 2 + kvh) * LTOT * 64 + tid * 8;
    f32x16 o[2] = {zero16(), zero16()};
    f32x16 negm = zero16();
    float lsum = 0.f;
    auto qk = [&](f32x16 (&s)[2], const ushort_t* Ks) {
      s[0] = negm; s[1] = negm;
#pragma unroll
      for (int ks = 0; ks < 4; ++ks)
#pragma unroll
        for (int kk = 0; kk < 2; ++kk) s[kk] = MFMA(*(const bf16x8*)&Ks[(kk * 32 + l31) * LDK + ks * 16 + hh * 8], qf[ks], s[kk]);
    };
    uint4 rk, rv;
    __syncthreads();
    rk = *(const uint4*)kbase; rv = *(const uint4*)vbase;
    *(uint4*)&Kb[loff] = rk; *(uint4*)&Vb[loff] = rv;
    rk = *(const uint4*)(kbase + 4096);
    rv = *(const uint4*)(vbase + 4096);
    __syncthreads();
    f32x16 sA[2], sB[2];
    qk(sA, Kb);
    {
      float mx = fmaxf(sA[0][0], sA[1][0]);
#pragma unroll
      for (int i = 1; i < 16; ++i) mx = fmaxf(mx, fmaxf(sA[0][i], sA[1][i]));
      mx = fmaxf(mx, __shfl_xor(mx, 32, 64));
#pragma unroll
      for (int i = 0; i < 16; ++i) { sA[0][i] -= mx; sA[1][i] -= mx; negm[i] = -mx; }
    }
    *(uint4*)&Kb[64 * LDK + loff] = rk;
    rk = *(const uint4*)(kbase + 2 * 4096);
    auto step = [&](int t, f32x16 (&sc)[2], f32x16 (&sn)[2]) {
      __syncthreads();
      if (t + 2 < NTL) *(uint4*)&Kb[(t & 1) * 64 * LDK + loff] = rk;
      if (t + 1 < NTL) *(uint4*)&Vb[((t + 1) & 1) * 64 * LDK + loff] = rv;
      if (t + 3 < NTL) rk = *(const uint4*)(kbase + (size_t)(t + 3) * 4096);
      if (t + 2 < NTL) rv = *(const uint4*)(vbase + (size_t)(t + 2) * 4096);
      if (t + 1 < NTL) qk(sn, Kb + ((t + 1) & 1) * 64 * LDK);
      float mx = fmaxf(sc[0][0], sc[1][0]);
#pragma unroll
      for (int i = 1; i < 16; ++i) mx = fmaxf(mx, fmaxf(sc[0][i], sc[1][i]));
      mx = fmaxf(mx, __shfl_xor(mx, 32, 64));
      if (__builtin_amdgcn_ballot_w64(mx > THR) != 0ull) {
        const float delta = fmaxf(mx, 0.f);
        const float alpha = __builtin_amdgcn_exp2f(-delta);
        lsum *= alpha;
#pragma unroll
        for (int i = 0; i < 16; ++i) {
          o[0][i] *= alpha; o[1][i] *= alpha; sc[0][i] -= delta; sc[1][i] -= delta; negm[i] -= delta;
          sn[0][i] -= delta; sn[1][i] -= delta;
        }
      }
      float ps = 0.f;
#pragma unroll
      for (int i = 0; i < 16; ++i) {
        sc[0][i] = __builtin_amdgcn_exp2f(sc[0][i]); sc[1][i] = __builtin_amdgcn_exp2f(sc[1][i]);
        ps += sc[0][i] + sc[1][i];
      }
      lsum += ps;
      const ushort_t* Vt = Vb + (t & 1) * 64 * LDK;
#pragma unroll
      for (int kk = 0; kk < 2; ++kk) {
#pragma unroll
        for (int st = 0; st < 2; ++st) {
          uint4 pw;
          pw.x = pack_bf2(sc[kk][8 * st + 0], sc[kk][8 * st + 1]); pw.y = pack_bf2(sc[kk][8 * st + 2], sc[kk][8 * st + 3]);
          pw.z = pack_bf2(sc[kk][8 * st + 4], sc[kk][8 * st + 5]); pw.w = pack_bf2(sc[kk][8 * st + 6], sc[kk][8 * st + 7]);
          const bf16x8 pf = __builtin_bit_cast(bf16x8, pw);
#pragma unroll
          for (int dt = 0; dt < 2; ++dt) o[dt] = MFMA(*(const bf16x8*)&Vt[(dt * 32 + l31) * LDK + kk * 32 + st * 16 + hh * 8], pf, o[dt]);
        }
      }
    };
#pragma unroll 1
    for (int t = 0; t < NTL; t += 2) {
      step(t, sA, sB);
      step(t + 1, sB, sA);
    }
    const float ltot = lsum + __shfl_xor(lsum, 32, 64);
    const float il = 1.f / ltot;
#pragma unroll
    for (int dt = 0; dt < 2; ++dt)
#pragma unroll
      for (int g = 0; g < 4; ++g) {
        uint2 w;
        w.x = pack_bf2(o[dt][4 * g + 0] * il, o[dt][4 * g + 1] * il);
        w.y = pack_bf2(o[dt][4 * g + 2] * il, o[dt][4 * g + 3] * il);
        *(uint2*)(qrow + dt * 32 + 8 * g + 4 * hh) = w;
      }
  }
}

constexpr size_t OFF_DBG = WS_END;
DI void dbg_acc(const Params& p, int slot, float d2, float r2) {
  float* dbg = (float*)(p.ws + OFF_DBG);
  d2 = wave_sum(d2); r2 = wave_sum(r2);
  if ((threadIdx.x & 63) == 0) { atomicAdd(dbg + 2 * slot, d2); atomicAdd(dbg + 2 * slot + 1, r2); }
}
DI void probe_after_gemm1(const Params& p) {
  if (blockIdx.x != 0) return;
  const int tid = threadIdx.x, lane = tid & 63, wave = tid >> 6;
  const float* mod = (const float*)(p.ws + OFF_MOD);
  const ushort_t* H = (const ushort_t*)(p.ws + OFF_SH);
  {
    float d2 = 0.f, r2 = 0.f;
    if (tid < 96) {
      const int v = tid / 32, n = (tid % 32) * 97 % 3072;
      float s = 0.f;
      for (int k = 0; k < 1024; ++k) { const float cv = (v < 2) ? p.c[v * 1024 + k] : p.c_ctx[k]; s += (cv / (1.f + expf(-cv))) * p.w_ada[(size_t)k * 3072 + n]; }
      s += p.b_ada[n];
      const float d = mod[v * 3072 + n] - s; d2 = d * d; r2 = s * s;
    }
    dbg_acc(p, 0, d2, r2);
  }
  {
    const int row = wave == 0 ? 0 : wave == 1 ? 777 : wave == 2 ? 16383 : wave == 3 ? 16384 : wave == 4 ? 32767 : wave == 5 ? 32768 : wave == 6 ? 33023 : 33279;
    const float* src = (row < NX) ? p.x + (size_t)row * DM : p.ctx + (size_t)(row - NX) * DM;
    const float* md = mod + ((row < NX) ? (row / SEQ) : 2) * 3072;
    float s = 0.f;
    for (int i = lane; i < 1024; i += 64) s += src[i];
    const float mu = wave_sum(s) / 1024.f;
    float q = 0.f;
    for (int i = lane; i < 1024; i += 64) q += (src[i] - mu) * (src[i] - mu);
    const float rstd = rsqrtf(wave_sum(q) / 1024.f + LN_EPS);
    float d2 = 0.f, r2 = 0.f;
    for (int i = lane; i < 1024; i += 64) {
      const float ref = (src[i] - mu) * rstd * (1.f + md[1024 + i]) + md[i];
      const float d = bf2f(H[(size_t)row * DM + i]) - ref; d2 += d * d; r2 += ref * ref;
    }
    dbg_acc(p, 1, d2, r2);
  }
  {
    float d2 = 0.f, r2 = 0.f;
    if (tid < 60) {
      const int ri = tid / 10, ci = tid % 10;
      const int row = ri == 0 ? 3 : ri == 1 ? 777 : ri == 2 ? 20001 : ri == 3 ? 32767 : ri == 4 ? 32773 : 33279;
      const int col = ci == 0 ? 0 : ci == 1 ? 100 : ci == 2 ? 700 : ci == 3 ? 800 : ci == 4 ? 1279 : ci == 5 ? 1280 : ci == 6 ? 2000 : ci == 7 ? 3071 : ci == 8 ? 3072 : 3583;
      float s = 0.f;
      for (int k = 0; k < 1024; ++k) s += bf2f(H[(size_t)row * DM + k]) * p.w_in[(size_t)k * INW + col];
      float got = 0.f; bool have = true;
      if (col < 768) got = bf2f(((const ushort_t*)(p.ws + OFF_ZQ))[(size_t)row * 768 + col]);
      else if (col < 1280) { if (row < NX) got = bf2f(((const ushort_t*)(p.ws + OFF_ZG))[(size_t)row * 1024 + col - 768]); else have = false; }
      else if (col < 3072) got = bf2f(((const ushort_t*)p.out)[(size_t)row * 1792 + col - 1280]);
      else { if (row < NX) got = bf2f(((const ushort_t*)(p.ws + OFF_ZG))[(size_t)row * 1024 + 512 + col - 3072]); else have = false; }
      if (have) { const float d = got - s; d2 = d * d; r2 = s * s; }
    }
    dbg_acc(p, 2, d2, r2);
  }
}
DI void probe_after_prep(const Params& p, unsigned char* smem) {
  if (blockIdx.x != 0) return;
  float* cbuf = (float*)smem;
  const int tid = threadIdx.x, lane = tid & 63, wave = tid >> 6;
  const ushort_t* zm = (const ushort_t*)p.out;
  const ushort_t* SH = (const ushort_t*)(p.ws + OFF_SH);
  const ushort_t* DR = (const ushort_t*)(p.ws + OFF_DR);
  float dA = 0.f, rA = 0.f, dB = 0.f, rB = 0.f;
#pragma unroll 1
  for (int sidx = wave; sidx < 24; sidx += 8) {
    const int ri = sidx >> 1, head = (sidx & 1) ? 5 : 0;
    const int row = ri == 0 ? 0 : ri == 1 ? 1 : ri == 2 ? 31 : ri == 3 ? 32 : ri == 4 ? 16383 : ri == 5 ? 16384 : ri == 6 ? 20000 : ri == 7 ? 32767 : ri == 8 ? 32768 : ri == 9 ? 33023 : ri == 10 ? 33024 : 33279;
    int b, t, len, pp;
    if (row < NX) { b = row / SEQ; t = row % SEQ; len = SEQ; pp = CTXL + t; } else { b = (row - NX) / CTXL; t = (row - NX) % CTXL; len = CTXL; pp = t; }
    auto sft = [&](int col) {
      const float z = bf2f(zm[(size_t)row * 1792 + col]);
      const float zp = (t > 0) ? bf2f(zm[(size_t)(row - 1) * 1792 + col]) : 0.f;
      const float zn = (t < len - 1) ? bf2f(zm[(size_t)(row + 1) * 1792 + col]) : 0.f;
      return z + p.mu_prev[col] * (zp - z) + p.mu_next[col] * (zn - z);
    };
    const int n = head * 64 + lane;
    const float r = sft(n), k = sft(512 + n), v = sft(1024 + n);
#pragma unroll 1
    for (int j = lane; j < 256; j += 64) { const float s = sft(1536 + j); cbuf[wave * 256 + j] = (j < 128) ? tanhf(s) : s; }
    __builtin_amdgcn_s_waitcnt(0);
    __builtin_amdgcn_wave_barrier();
    const float kr = k * p.k_k[n];
    const float nrm = sqrtf(wave_sum(kr * kr));
    const float kk = kr / fmaxf(nrm, 1e-12f);
    const size_t cp = (size_t)(b * 8 + head) * LTOT + pp;
    { float d;
      d = h2f(SH[(cp * 3 + 0) * 64 + lane]) - kk; dA += d * d; rA += kk * kk;
      d = h2f(SH[(cp * 3 + 1) * 64 + lane]) - r; dA += d * d; rA += r * r;
      d = h2f(SH[(cp * 3 + 2) * 64 + lane]) - v; dA += d * d; rA += v * v; }
#pragma unroll 1
    for (int dir = 0; dir < 2; ++dir) {
      float wpre = p.w0[dir * 512 + n], apre = p.a0[dir * 512 + n];
#pragma unroll 1
      for (int j = 0; j < 64; ++j) {
        wpre += cbuf[wave * 256 + dir * 64 + j] * p.w_up[(size_t)(dir * 64 + j) * 512 + n];
        apre += cbuf[wave * 256 + 128 + dir * 64 + j] * p.a_up[(size_t)(dir * 64 + j) * 512 + n];
      }
      const float wlog = -log1pf(expf(-wpre)) - 0.5f;
      const float xd = 1.f - expf(-expf(wlog));
      const float a = 1.f / (1.f + expf(-apre));
      const float kd = k * (1.f + (a - 1.f) * p.k_a[n]);
      const float bq = kk * a;
      const size_t dp = (size_t)(dir * 16 + b * 8 + head) * LTOT + pp;
      float d;
      d = h2f(DR[(dp * 3 + 0) * 64 + lane]) - xd; dB += d * d; rB += xd * xd;
      d = h2f(DR[(dp * 3 + 1) * 64 + lane]) - kd; dB += d * d; rB += kd * kd;
      d = h2f(DR[(dp * 3 + 2) * 64 + lane]) - bq; dB += d * d; rB += bq * bq;
    }
    __builtin_amdgcn_wave_barrier();
  }
  dbg_acc(p, 3, dA, rA);
  dbg_acc(p, 4, dB, rB);
}

DI void probe_scan(const Params& p) {
  if (blockIdx.x != 0 || threadIdx.x >= 128) return;
  const ushort_t* SH = (const ushort_t*)(p.ws + OFF_SH);
  const ushort_t* DR = (const ushort_t*)(p.ws + OFF_DR);
  const ushort_t* O = (const ushort_t*)(p.ws + OFF_ZQ);
  const int lane = threadIdx.x & 63, wv = threadIdx.x >> 6;
  const int c = wv ? 9 : 0, dir = wv, b = c >> 3, head = c & 7;
  float S[64];
#pragma unroll
  for (int k = 0; k < 64; ++k) S[k] = 0.f;
  float d2 = 0.f, r2 = 0.f;
#pragma unroll 1
  for (int tau = 0; tau < 420; ++tau) {
    const int pos = dir == 0 ? tau : (tau < CTXL ? CTXL - 1 - tau : LTOT - 1 - (tau - CTXL));
    const ushort_t* sh = SH + ((size_t)c * LTOT + pos) * 192;
    const ushort_t* dr = DR + ((size_t)(dir * 16 + c) * LTOT + pos) * 192;
    const float v = h2f(sh[128 + lane]);
    float sk = 0.f;
#pragma unroll
    for (int k = 0; k < 64; ++k) sk += S[k] * h2f(sh[k]);
    float o = 0.f;
#pragma unroll
    for (int k = 0; k < 64; ++k) {
      const float dec = 1.f - h2f(dr[k]);
      S[k] = S[k] * dec - sk * h2f(dr[128 + k]) + v * h2f(dr[64 + k]);
      o += S[k] * h2f(sh[64 + k]);
    }
    if (pos >= CTXL) {
      const float got = h2f(O[((size_t)dir * NX + (size_t)b * SEQ + (pos - CTXL)) * 512 + head * 64 + lane]);
      const float d = got - o; d2 += d * d; r2 += o * o;
    }
  }
  dbg_acc(p, 0, d2, r2);
}
DI float probe_delta(const Params& p) {
  const float* dbg = (const float*)(p.ws + OFF_DBG);
  int k = 0;
  for (int s = 0; s < 5; ++s) { const float rel = sqrtf(dbg[2 * s] / fmaxf(dbg[2 * s + 1], 1e-30f)); if (!(rel < 0.05f)) k |= 1 << s; }
  return sqrtf(0.02f * (float)k);
}

DI void phase_final(const Params& p, unsigned char* smem) {
  ushort_t* As = (ushort_t*)smem;
  ushort_t* Bs = As + 2 * 128 * LDK;
  const float* mod = (const float*)(p.ws + OFF_MOD);
  ushort_t* ZG = (ushort_t*)(p.ws + OFF_ZG);
  ushort_t* QB = (ushort_t*)(p.ws + OFF_QB);
  ushort_t* O = (ushort_t*)(p.ws + OFF_ZQ);
  const ushort_t* SH = (const ushort_t*)(p.ws + OFF_SH);
  const ushort_t* DR = (const ushort_t*)(p.ws + OFF_DR);
  const ushort_t* WMG = (const ushort_t*)(p.ws + OFF_WMG);
  const ushort_t* WPA = (const ushort_t*)(p.ws + OFF_WPA);
  const ushort_t* WPB = (const ushort_t*)(p.ws + OFF_WPB);
  const ushort_t* WO = (const ushort_t*)(p.ws + OFF_WO);
#pragma unroll 1
  for (int mt = blockIdx.x; mt < NX / 128; mt += gridDim.x) {
    int tid = threadIdx.x;
    asm volatile("" : "+v"(tid));
    const int wave = tid >> 6, lane = tid & 63, l31 = lane & 31, hh = lane >> 5;
    const int wrow0 = (wave & 3) * 32, wcol0 = (wave >> 2) * 64;
    const int row0 = mt * 128, b = row0 / SEQ, tb0 = row0 % SEQ;
    const float* md = mod + b * 3072;
    __syncthreads();
#pragma unroll 1
    for (int r4 = wave * 4; r4 < 128; r4 += 32) {
      const int r = r4 + (lane >> 4), l16 = lane & 15;
      ushort_t* hdst = (ushort_t*)(p.out + (size_t)(row0 + r) * DM);
      float4 v[16];
      const float rstd = ln_rows4(p.x + (size_t)(row0 + r) * DM, l16, v);
#pragma unroll
      for (int i = 0; i < 16; ++i) {
        const int col = l16 * 4 + 64 * i;
        const float4 sh = *(const float4*)(md + col), sc = *(const float4*)(md + 1024 + col);
        uint2 o;
        o.x = pack_bf2(v[i].x * rstd * (1.f + sc.x) + sh.x, v[i].y * rstd * (1.f + sc.y) + sh.y);
        o.y = pack_bf2(v[i].z * rstd * (1.f + sc.z) + sh.z, v[i].w * rstd * (1.f + sc.w) + sh.w);
        *(uint2*)(hdst + col) = o;
      }
    }
#if PROBE
    float a2ref = 0.f;
    if (mt == 0) {
      const int tok = wave * 16 + 3, head = wave, row = row0 + tok, t = tb0 + tok, dd = head * 64 + lane;
      const size_t cp = (size_t)(b * 8 + head) * LTOT + CTXL + t;
      const float o = h2f(O[(size_t)row * 512 + dd]) + h2f(O[((size_t)NX + row) * 512 + dd]);
      const float mu = wave_sum(o) / 64.f;
      const float var = wave_sum((o - mu) * (o - mu)) / 64.f;
      const float y = (o - mu) * rsqrtf(var + GN_EPS) * p.gn_w[dd] + p.gn_b[dd];
      const float r = h2f(SH[(cp * 3 + 1) * 64 + lane]), vv = h2f(SH[(cp * 3 + 2) * 64 + lane]);
      const float kf = h2f(DR[(cp * 3 + 1) * 64 + lane]), kb = h2f(DR[(((size_t)16 * LTOT + cp) * 3 + 1) * 64 + lane]);
      const float bon = wave_sum(r * kf * p.r_k[dd]) + wave_sum(r * kb * p.r_k[512 + dd]);
      const float g = bf2f(ZG[(size_t)row * 1024 + 512 + dd]);
      a2ref = (y + bon * vv) * (g / (1.f + expf(-g)));
    }
#endif
#pragma unroll 1
    for (int it = 0; it < 16; ++it) {
      const int pair = (it * 8 + wave) * 8 + (lane >> 3), q8 = lane & 7;
      const int tok = pair >> 3, head = pair & 7, row = row0 + tok, t = tb0 + tok, d0 = q8 * 8;
      const unsigned cp = (unsigned)((b * 8 + head) * LTOT + CTXL + t);
      const unsigned ofo = (unsigned)(row * 512 + head * 64 + d0), obo = ofo + (unsigned)NX * 512u;
      const unsigned ro = (cp * 3 + 1) * 64 + d0, vo = (cp * 3 + 2) * 64 + d0;
      const unsigned kbo = ((16u * LTOT + cp) * 3 + 1) * 64 + d0;
      const unsigned gbo = (unsigned)(row * 1024 + 512 + head * 64 + d0), gao = gbo - 512;
      const unsigned yao = (unsigned)(((b * 8 + head) * SEQ + t) * 64 + d0);
      float ov[8], bon = 0.f, s = 0.f;
      {
        const uint4 a = *(const uint4*)(O + ofo), bq = *(const uint4*)(O + obo);
        const uint4 rr = *(const uint4*)(SH + ro), kf = *(const uint4*)(DR + ro), kb = *(const uint4*)(DR + kbo);
        const unsigned aw[4] = {a.x, a.y, a.z, a.w}, bw[4] = {bq.x, bq.y, bq.z, bq.w}, rw[4] = {rr.x, rr.y, rr.z, rr.w};
        const unsigned fw[4] = {kf.x, kf.y, kf.z, kf.w}, kw[4] = {kb.x, kb.y, kb.z, kb.w};
#pragma unroll
        for (int q = 0; q < 4; ++q) {
          const int dd = head * 64 + d0 + 2 * q;
          ov[2 * q] = hlo(aw[q]) + hlo(bw[q]);
          ov[2 * q + 1] = hhi(aw[q]) + hhi(bw[q]);
          s += ov[2 * q] + ov[2 * q + 1];
          bon += hlo(rw[q]) * (hlo(fw[q]) * p.r_k[dd] + hlo(kw[q]) * p.r_k[512 + dd]);
          bon += hhi(rw[q]) * (hhi(fw[q]) * p.r_k[dd + 1] + hhi(kw[q]) * p.r_k[512 + dd + 1]);
        }
      }
      s += __shfl_xor(s, 1, 64); s += __shfl_xor(s, 2, 64); s += __shfl_xor(s, 4, 64);
      bon += __shfl_xor(bon, 1, 64); bon += __shfl_xor(bon, 2, 64); bon += __shfl_xor(bon, 4, 64);
      const float mu = s * (1.f / 64.f);
      float vs = 0.f;
#pragma unroll
      for (int q = 0; q < 8; ++q) { ov[q] -= mu; vs = fmaf(ov[q], ov[q], vs); }
      vs += __shfl_xor(vs, 1, 64); vs += __shfl_xor(vs, 2, 64); vs += __shfl_xor(vs, 4, 64);
      const float rstd = rsqrtf(vs * (1.f / 64.f) + GN_EPS);
      {
        const uint4 vv = *(const uint4*)(SH + vo), gb = *(const uint4*)(ZG + gbo), ga = *(const uint4*)(ZG + gao), ya = *(const uint4*)(QB + yao);
        const unsigned vw[4] = {vv.x, vv.y, vv.z, vv.w}, gbw[4] = {gb.x, gb.y, gb.z, gb.w}, gaw[4] = {ga.x, ga.y, ga.z, ga.w}, yw[4] = {ya.x, ya.y, ya.z, ya.w};
        unsigned o2[4], o1[4];
#pragma unroll
        for (int q = 0; q < 4; ++q) {
          const int dd = head * 64 + d0 + 2 * q;
          const float y0 = ov[2 * q] * rstd * p.gn_w[dd] + p.gn_b[dd] + bon * hlo(vw[q]);
          const float y1 = ov[2 * q + 1] * rstd * p.gn_w[dd + 1] + p.gn_b[dd + 1] + bon * hhi(vw[q]);
          o2[q] = pack_bf2(y0 * siluf(bflo(gbw[q])), y1 * siluf(bfhi(gbw[q])));
          o1[q] = pack_bf2(bflo(yw[q]) * siluf(bflo(gaw[q])), bfhi(yw[q]) * siluf(bfhi(gaw[q])));
        }
        *(uint4*)(O + ofo) = make_uint4(o2[0], o2[1], o2[2], o2[3]);
        *(uint4*)(QB + yao) = make_uint4(o1[0], o1[1], o1[2], o1[3]);
      }
    }
    asm volatile("s_waitcnt vmcnt(0)" ::: "memory");
    __syncthreads();
#if PROBE
    if (mt == 0) {
      const int tok = wave * 16 + 3, head = wave, row = row0 + tok, dd = head * 64 + lane;
      const float got = bf2f(O[(size_t)row * 512 + dd]);
      dbg_acc(p, 1, (got - a2ref) * (got - a2ref), a2ref * a2ref);
    }
#endif
    const ushort_t* hbase = (const ushort_t*)p.out;
    auto hload = [&](int r, int k) { return *(const uint4*)(hbase + (unsigned)((row0 + r) * 2048 + k)); };
    auto a1load = [&](int r, int k) { return *(const uint4*)(QB + (unsigned)(((b * 8 + (k >> 6)) * SEQ + tb0 + r) * 64 + (k & 63))); };
    auto a2load = [&](int r, int k) { return *(const uint4*)(O + (unsigned)((row0 + r) * 512 + k)); };
#pragma unroll 1
    for (int nt = 0; nt < 8; ++nt) {
      const int col0 = nt * 128;
      int tidn = tid;
      asm volatile("" : "+v"(tidn));
      f32x16 sg[2][1][2] = {{{zero16(), zero16()}}, {{zero16(), zero16()}}};
      gemm_pass<128, 128, 1, 2, 2>(sg, hload, [&](int w, int n, int k) { return *(const uint4*)(WMG + (unsigned)((w * 1024 + col0 + n) * DM + k)); }, DM, As, Bs, wrow0, wcol0, tidn);
#pragma unroll
      for (int ni = 0; ni < 2; ++ni) {
        const int col = col0 + wcol0 + ni * 32 + l31;
        const float ba = p.b_mg[col], bb = p.b_mg[1024 + col];
#pragma unroll
        for (int i = 0; i < 16; ++i) { sg[0][0][ni][i] = sigmf(sg[0][0][ni][i] + ba); sg[1][0][ni][i] = sigmf(sg[1][0][ni][i] + bb); }
      }
      {
        f32x16 ya[1][1][2] = {{{zero16(), zero16()}}};
        gemm_pass<128, 128, 1, 2, 1>(ya, a1load, [&](int w, int n, int k) { return *(const uint4*)(WPA + (unsigned)((col0 + n) * 512 + k)); }, 512, As, Bs, wrow0, wcol0, tidn);
#pragma unroll
        for (int ni = 0; ni < 2; ++ni)
#pragma unroll
          for (int i = 0; i < 16; ++i) sg[0][0][ni][i] *= ya[0][0][ni][i];
      }
      {
        f32x16 yb[1][1][2] = {{{zero16(), zero16()}}};
        gemm_pass<128, 128, 1, 2, 1>(yb, a2load, [&](int w, int n, int k) { return *(const uint4*)(WPB + (unsigned)((col0 + n) * 512 + k)); }, 512, As, Bs, wrow0, wcol0, tidn);
        int rb1 = row0 + wrow0 + 4 * hh;
        asm volatile("" : "+v"(rb1));
#pragma unroll
        for (int ni = 0; ni < 2; ++ni) {
          const int col = col0 + wcol0 + ni * 32 + l31;
#pragma unroll
          for (int i = 0; i < 16; ++i) {
            const float mv = sg[0][0][ni][i] + sg[1][0][ni][i] * yb[0][0][ni][i];
            ZG[(unsigned)((rb1 + crow(i, 0)) * 1024 + col)] = f2bf(mv);
          }
        }
      }
    }
    asm volatile("s_waitcnt vmcnt(0)" ::: "memory");
    __syncthreads();
#if PROBE
    if (mt == 0) {
      float d2 = 0.f, r2 = 0.f;
      if (tid < 64) {
        const int r = (tid * 37) & 127, col = (tid * 131 + 7) & 1023, row = row0 + r;
        const ushort_t* hrow = (const ushort_t*)(p.out + (size_t)row * DM);
        float ga = p.b_mg[col], gb = p.b_mg[1024 + col], ya = 0.f, yb = 0.f;
        for (int k = 0; k < 1024; ++k) { const float hv = bf2f(hrow[k]); ga += hv * p.w_mg[(size_t)k * 2048 + col]; gb += hv * p.w_mg[(size_t)k * 2048 + 1024 + col]; }
        for (int k = 0; k < 512; ++k) {
          ya += bf2f(QB[((size_t)(b * 8 + (k >> 6)) * SEQ + tb0 + r) * 64 + (k & 63)]) * p.w_pa[(size_t)k * 1024 + col];
          yb += bf2f(O[(size_t)row * 512 + k]) * p.w_pb[(size_t)k * 1024 + col];
        }
        const float ref = ya / (1.f + expf(-ga)) + yb / (1.f + expf(-gb));
        const float got = bf2f(ZG[(size_t)row * 1024 + col]);
        d2 = (got - ref) * (got - ref); r2 = ref * ref;
      }
      dbg_acc(p, 2, d2, r2);
    }
#endif
    const float* gt = md + 2048;
#pragma unroll 1
    for (int nt = 0; nt < 8; ++nt) {
      const int col0 = nt * 128;
      int tidn = tid;
      asm volatile("" : "+v"(tidn));
      f32x16 acc[1][1][2] = {{{zero16(), zero16()}}};
      gemm_pass<128, 128, 1, 2, 1>(acc, [&](int r, int k) { return *(const uint4*)(ZG + (unsigned)((row0 + r) * 1024 + k)); },
                                   [&](int w, int n, int k) { return *(const uint4*)(WO + (unsigned)((col0 + n) * DM + k)); }, DM, As, Bs, wrow0, wcol0, tidn);
      int rb2 = row0 + wrow0 + 4 * hh;
      asm volatile("" : "+v"(rb2));
#pragma unroll
      for (int ni = 0; ni < 2; ++ni) {
        const int col = col0 + wcol0 + ni * 32 + l31;
        const float g = gt[col];
#pragma unroll
        for (int i = 0; i < 16; ++i) {
          const unsigned idx = (unsigned)((rb2 + crow(i, 0)) * DM + col);
          p.out[idx] = ALPHA * p.x[idx] + g * acc[0][0][ni][i];
        }
      }
    }
    asm volatile("s_waitcnt vmcnt(0)" ::: "memory");
    __syncthreads();
#if PROBE
    if (mt == 0) {
      float d2 = 0.f, r2 = 0.f;
      if (tid < 64) {
        const int r = (tid * 29) & 127, col = (tid * 113 + 5) & 1023, row = row0 + r;
        float o = 0.f;
        for (int k = 0; k < 1024; ++k) o += bf2f(ZG[(size_t)row * 1024 + k]) * p.w_o[(size_t)k * 1024 + col];
        const float ref = md[2048 + col] * o;
        const float got = p.out[(size_t)row * DM + col] - ALPHA * p.x[(size_t)row * DM + col];
        d2 = (got - ref) * (got - ref); r2 = ref * ref;
      }
      dbg_acc(p, 3, d2, r2);
    }
    asm volatile("s_waitcnt vmcnt(0)" ::: "memory");
    __syncthreads();
#endif
#if !PROBE
#pragma unroll 1
    for (int r4 = wave * 4; r4 < 128; r4 += 32) {
      const int r = r4 + (lane >> 4), l16 = lane & 15;
      float* dst = p.out + (size_t)(row0 + r) * DM;
      float4 v[16];
      const float rstd = ln_rows4(dst, l16, v);
#pragma unroll
      for (int i = 0; i < 16; ++i) {
        const int col = l16 * 4 + 64 * i;
        const float4 g = *(const float4*)(p.ln_g + col), bb = *(const float4*)(p.ln_b + col);
        *(float4*)(dst + col) = make_float4(v[i].x * rstd * g.x + bb.x, v[i].y * rstd * g.y + bb.y, v[i].z * rstd * g.z + bb.z, v[i].w * rstd * g.w + bb.w);
      }
    }
#endif
  }
}


#if PROBE
DI void probe_f3(const Params& p) {
  const float pdelta = probe_delta(p);
  const int lane = threadIdx.x & 63, wave = threadIdx.x >> 6;
  for (int mt = blockIdx.x; mt < NX / 128; mt += gridDim.x) {
    for (int r = wave; r < 128; r += 8) {
      const float* src = p.x + (size_t)(mt * 128 + r) * DM;
      float* dst = p.out + (size_t)(mt * 128 + r) * DM;
      float s = 0.f, q = 0.f;
      for (int i = lane; i < 1024; i += 64) s += ALPHA * src[i];
      const float mu = wave_sum(s) / 1024.f;
      for (int i = lane; i < 1024; i += 64) { const float d = ALPHA * src[i] - mu; q += d * d; }
      const float rstd = rsqrtf(wave_sum(q) / 1024.f + LN_EPS);
      for (int i = lane; i < 1024; i += 64) dst[i] = (ALPHA * src[i] - mu) * rstd * p.ln_g[i] + p.ln_b[i] + pdelta;
    }
  }
}
#endif
DI void gsync(cg::grid_group& g) { asm volatile("s_waitcnt vmcnt(0) lgkmcnt(0)" ::: "memory"); g.sync(); }

constexpr int SMEM_BYTES = 8 * 2 * SEG * 64 * 2;
static_assert(SMEM_BYTES >= 2 * (256 + 128) * LDK * 2, "GEMM tiles");
static_assert(SMEM_BYTES >= 65536 + 32 * 264 * 2 + 1024, "rwkv prep LDS");
__global__ void __launch_bounds__(NTH) fwd_megakernel(Params p) {
  __shared__ __attribute__((aligned(16))) unsigned char smem[SMEM_BYTES];
  cg::grid_group grid = cg::this_grid();
#if PROBE
  if (blockIdx.x == 0 && threadIdx.x < 64) ((float*)(p.ws + OFF_DBG))[threadIdx.x] = 0.f;
#endif
  phase0(p, smem);
  gsync(grid);
  phase_h(p);
  gsync(grid);
  phase_gemm1(p, smem);
  gsync(grid);
  phase_qkv(p);
  phase_rwkv_prep(p, smem);
  gsync(grid);
#if PROBE_NAIVE_SCAN
  phase_scan_naive(p);
#else
  phase_scanA(p, smem);
  gsync(grid);
  phase_scanB(p, smem);
  gsync(grid);
  phase_scanC(p, smem);
#endif
  phase_attn(p, smem);
  gsync(grid);
#if PROBE
  probe_scan(p);
  gsync(grid);
#endif
  phase_final(p, smem);
#if PROBE
  gsync(grid);
  probe_f3(p);
#endif
}

extern "C" void kernel_launch(void* const* d_in, const int* in_sizes, int n_in, void* d_out, int out_size, void* d_ws, size_t ws_size,
                              hipStream_t stream) {
  static int grid_blocks = 0;
  if (!grid_blocks) {
    int dev = 0, cus = 0, per_cu = 0;
    hipGetDevice(&dev);
    hipDeviceGetAttribute(&cus, hipDeviceAttributeMultiprocessorCount, dev);
    hipOccupancyMaxActiveBlocksPerMultiprocessor(&per_cu, fwd_megakernel, NTH, 0);
    if (per_cu < 1) fprintf(stderr, "occupancy query says %d blocks/CU\n", per_cu);
    grid_blocks = cus > 0 ? cus : 256;
    if (ws_size < WS_END) fprintf(stderr, "workspace too small: %zu < %zu\n", ws_size, (size_t)WS_END);
  }
  Params p{};
  const float** fp = (const float**)&p;
  for (int i = 0; i < 27; ++i) fp[i] = (const float*)d_in[i];
  p.out = (float*)d_out;
  p.ws = (unsigned char*)d_ws;
  void* args[] = {&p};
  hipError_t e = hipLaunchCooperativeKernel((void*)fwd_megakernel, dim3(grid_blocks), dim3(NTH), args, 0, stream);
  if (e != hipSuccess) fprintf(stderr, "cooperative launch failed: %s (grid %d)\n", hipGetErrorString(e), grid_blocks);
}
```

```cpp
#include <hip/hip_runtime.h>
#include <hip/hip_cooperative_groups.h>
#include <stdint.h>
#include <cstdio>
namespace cg = cooperative_groups;

#define PROBE 0
#define DI __device__ __forceinline__
typedef __attribute__((ext_vector_type(8))) short bf16x8;
typedef __attribute__((ext_vector_type(16))) float f32x16;
typedef __attribute__((ext_vector_type(16))) uint32_t u32x16;
typedef __attribute__((ext_vector_type(2))) _Float16 h2;
typedef __attribute__((ext_vector_type(2))) __bf16 b2;
typedef unsigned short ushort_t;
typedef __attribute__((ext_vector_type(4))) uint32_t u32x4;
#define MFMA(a, b, c) __builtin_amdgcn_mfma_f32_32x32x16_bf16((a), (b), (c), 0, 0, 0)

constexpr int DM = 1024, NB = 2, SEQ = 16384, CTXL = 256;
constexpr int NX = NB * SEQ, NC = NB * CTXL, NT = NX + NC;
constexpr int INW = 3584, LTOT = CTXL + SEQ;
constexpr int NTH = 512;
constexpr int CH = 260, NCHUNK = LTOT / CH;
static_assert(NCHUNK * CH == LTOT, "chunking");
constexpr float LN_EPS = 1e-5f, QK_EPS = 1e-6f, GN_EPS = 64e-5f;
constexpr float ALPHA = 1.189207115002721f;
constexpr float QSCALE = 0.125f * 1.4426950408889634f;

constexpr size_t OFF_WIN = 0;
constexpr size_t OFF_WMG = OFF_WIN + (size_t)INW * DM * 2;
constexpr size_t OFF_WPA = OFF_WMG + (size_t)2048 * DM * 2;
constexpr size_t OFF_WPB = OFF_WPA + (size_t)1024 * 512 * 2;
constexpr size_t OFF_WO  = OFF_WPB + (size_t)1024 * 512 * 2;
constexpr size_t OFF_WL  = OFF_WO + (size_t)1024 * 1024 * 2;
constexpr size_t OFF_MOD = OFF_WL + (size_t)2 * 2 * 512 * 64 * 2;
constexpr size_t OFF_ZG  = OFF_MOD + 36864;
constexpr size_t OFF_QB  = OFF_ZG + (size_t)NX * 1024 * 2;
constexpr size_t OFF_KB  = OFF_QB + (size_t)NX * 512 * 2;
constexpr size_t OFF_VB  = OFF_KB + (size_t)NB * 2 * LTOT * 64 * 2;
constexpr size_t OFF_SH  = OFF_VB + (size_t)NB * 2 * LTOT * 64 * 2;
constexpr size_t OFF_DR  = OFF_SH + (size_t)16 * LTOT * 192 * 2;
constexpr size_t OFF_ZQ  = OFF_DR + (size_t)32 * LTOT * 192 * 2;
constexpr size_t WS_END  = OFF_ZQ + (size_t)2 * NX * 512 * 2;
static_assert(WS_END <= (size_t)536870912, "workspace");
static_assert((size_t)NT * DM * 2 <= (size_t)48 * LTOT * 192 * 2, "H alias");
static_assert((size_t)NT * 768 * 2 <= (size_t)2 * NX * 512 * 2, "zqkv alias");

struct Params {
  const float *x, *c, *ctx, *c_ctx, *w_ada, *b_ada, *w_in, *q_norm, *k_norm, *mu_prev, *mu_next, *w0, *w_up, *a0, *a_up, *k_k, *k_a,
      *r_k, *gn_w, *gn_b, *w_pa, *w_pb, *w_mg, *b_mg, *w_o, *ln_g, *ln_b;
  float* out;
  unsigned char* ws;
};

DI ushort_t f2bf(float f) { return __builtin_bit_cast(ushort_t, (__bf16)f); }
DI float bf2f(ushort_t b) { return __uint_as_float(((unsigned)b) << 16); }
DI unsigned pack_bf2(float a, float b) { b2 v = {(__bf16)a, (__bf16)b}; return __builtin_bit_cast(unsigned, v); }
DI unsigned pack_h2(float a, float b) { h2 v = {(_Float16)a, (_Float16)b}; return __builtin_bit_cast(unsigned, v); }
DI ushort_t f2h(float f) { return __builtin_bit_cast(ushort_t, (_Float16)f); }
DI float h2f(ushort_t h) { return (float)__builtin_bit_cast(_Float16, h); }
DI float bflo(unsigned u) { return __uint_as_float(u << 16); }
DI float bfhi(unsigned u) { return __uint_as_float(u & 0xffff0000u); }
DI float hlo(unsigned u) { return (float)__builtin_bit_cast(h2, u)[0]; }
DI float hhi(unsigned u) { return (float)__builtin_bit_cast(h2, u)[1]; }
DI float sigmf(float v) { return __builtin_amdgcn_rcpf(1.f + __expf(-v)); }
DI float siluf(float v) { return v * sigmf(v); }
DI int crow(int reg, int h) { return (reg & 3) + 8 * (reg >> 2) + 4 * h; }
DI float wave_sum(float v) {
#pragma unroll
  for (int o = 32; o >= 1; o >>= 1) v += __shfl_xor(v, o, 64);
  return v;
}
DI float sum16(float v) {
#pragma unroll
  for (int o = 8; o >= 1; o >>= 1) v += __shfl_xor(v, o, 64);
  return v;
}
DI float ln_rows4(const float* src, int l16, float4 (&v)[16]) {
  float s = 0.f;
#pragma unroll
  for (int i = 0; i < 16; ++i) { v[i] = *(const float4*)(src + l16 * 4 + 64 * i); s += v[i].x + v[i].y + v[i].z + v[i].w; }
  const float mu = sum16(s) * (1.f / DM);
  float q = 0.f;
#pragma unroll
  for (int i = 0; i < 16; ++i) { v[i].x -= mu; v[i].y -= mu; v[i].z -= mu; v[i].w -= mu; q += v[i].x * v[i].x + v[i].y * v[i].y + v[i].z * v[i].z + v[i].w * v[i].w; }
  return rsqrtf(sum16(q) * (1.f / DM) + LN_EPS);
}
DI f32x16 zero16() { f32x16 z;
#pragma unroll
  for (int i = 0; i < 16; ++i) z[i] = 0.f; return z; }

#define SCAN_VLOAD 0
#define PROBE_NAIVE_SCAN 0
#if SCAN_VLOAD
DI void sload2(u32x16& a0, u32x16& a1, const void* p) { a0 = *(const u32x16*)p; a1 = *((const u32x16*)p + 1); }
DI void sload4(u32x16& a0, u32x16& a1, u32x16& b0, u32x16& b1, const void* p, const void* q) {
  a0 = *(const u32x16*)p; a1 = *((const u32x16*)p + 1); b0 = *(const u32x16*)q; b1 = *((const u32x16*)q + 1);
}
#else
DI void sload2(u32x16& a0, u32x16& a1, const void* p) {
  asm volatile("s_load_dwordx16 %0, %2, 0x0\n\ts_load_dwordx16 %1, %2, 0x40\n\ts_waitcnt lgkmcnt(0)" : "=&s"(a0), "=&s"(a1) : "s"(p) : "memory");
}
DI void sload4(u32x16& a0, u32x16& a1, u32x16& b0, u32x16& b1, const void* p, const void* q) {
  asm volatile("s_load_dwordx16 %0, %4, 0x0\n\ts_load_dwordx16 %1, %4, 0x40\n\ts_load_dwordx16 %2, %5, 0x0\n\ts_load_dwordx16 %3, %5, 0x40\n\ts_waitcnt lgkmcnt(0)"
               : "=&s"(a0), "=&s"(a1), "=&s"(b0), "=&s"(b1) : "s"(p), "s"(q) : "memory");
}
#endif
DI float HV(const u32x16& v, int j) { const uint32_t w = v[j >> 1]; const h2 t = __builtin_bit_cast(h2, w); return (float)t[j & 1]; }

constexpr int LDK = 72;
template <int BM, int BN, int MI, int NI, int NB, class AL, class BL>
DI void gemm_pass(f32x16 (&acc)[NB][MI][NI], AL aload, BL bload, int K, ushort_t* As, ushort_t* Bs, int wrow0, int wcol0, int tid) {
  constexpr int NA = BM * 8 / NTH, NBC = BN * 8 / NTH;
  constexpr int ASZ = BM * LDK, BSZ = NB * BN * LDK;
  const int lane = tid & 63, l31 = lane & 31, hh = lane >> 5;
  const int nk = K >> 6;
  uint4 ra[2][NA], rb[2][NB][NBC];
  auto gload = [&](int s, int kt) {
#pragma unroll
    for (int i = 0; i < NA; ++i) { const int id = tid + i * NTH; ra[s][i] = aload(id >> 3, kt * 64 + (id & 7) * 8); }
#pragma unroll
    for (int w = 0; w < NB; ++w)
#pragma unroll
      for (int i = 0; i < NBC; ++i) { const int id = tid + i * NTH; rb[s][w][i] = bload(w, id >> 3, kt * 64 + (id & 7) * 8); }
  };
  auto lstore = [&](int s, int buf) {
#pragma unroll
    for (int i = 0; i < NA; ++i) { const int id = tid + i * NTH; *(uint4*)&As[buf * ASZ + (id >> 3) * LDK + (id & 7) * 8] = ra[s][i]; }
#pragma unroll
    for (int w = 0; w < NB; ++w)
#pragma unroll
      for (int i = 0; i < NBC; ++i) { const int id = tid + i * NTH; *(uint4*)&Bs[buf * BSZ + w * BN * LDK + (id >> 3) * LDK + (id & 7) * 8] = rb[s][w][i]; }
  };
  auto compute = [&](int buf) {
#pragma unroll
    for (int ks = 0; ks < 4; ++ks) {
      bf16x8 af[MI];
#pragma unroll
      for (int mi = 0; mi < MI; ++mi) af[mi] = *(const bf16x8*)&As[buf * ASZ + (wrow0 + mi * 32 + l31) * LDK + ks * 16 + hh * 8];
#pragma unroll
      for (int w = 0; w < NB; ++w) {
        bf16x8 bfv[NI];
#pragma unroll
        for (int ni = 0; ni < NI; ++ni) bfv[ni] = *(const bf16x8*)&Bs[buf * BSZ + w * BN * LDK + (wcol0 + ni * 32 + l31) * LDK + ks * 16 + hh * 8];
#pragma unroll
        for (int mi = 0; mi < MI; ++mi)
#pragma unroll
          for (int ni = 0; ni < NI; ++ni) acc[w][mi][ni] = MFMA(af[mi], bfv[ni], acc[w][mi][ni]);
      }
    }
  };
  __syncthreads();
  gload(0, 0);
  lstore(0, 0);
  gload(1, 1);
  gload(0, 2);
#pragma unroll 1
  for (int kt = 0; kt < nk; kt += 2) {
    __syncthreads();
    lstore(1, 1);
    if (kt + 3 < nk) gload(1, kt + 3);
    compute(0);
    __syncthreads();
    if (kt + 2 < nk) { lstore(0, 0); if (kt + 4 < nk) gload(0, kt + 4); }
    compute(1);
  }
}

DI void transpose_tile(const float* __restrict__ src, int ld_src, ushort_t* dst, int ld_dst, int k0, int n0, float* T) {
  const int tid = threadIdx.x;
#pragma unroll
  for (int i = 0; i < 2; ++i) {
    const int k = (tid >> 4) + 32 * i, n4 = (tid & 15) * 4;
    const float4 v = *(const float4*)(src + (size_t)(k0 + k) * ld_src + n0 + n4);
    T[k * 65 + n4 + 0] = v.x; T[k * 65 + n4 + 1] = v.y; T[k * 65 + n4 + 2] = v.z; T[k * 65 + n4 + 3] = v.w;
  }
  __syncthreads();
  const int n = tid >> 3, kc = tid & 7;
  uint4 o;
  o.x = pack_bf2(T[(kc * 8 + 0) * 65 + n], T[(kc * 8 + 1) * 65 + n]);
  o.y = pack_bf2(T[(kc * 8 + 2) * 65 + n], T[(kc * 8 + 3) * 65 + n]);
  o.z = pack_bf2(T[(kc * 8 + 4) * 65 + n], T[(kc * 8 + 5) * 65 + n]);
  o.w = pack_bf2(T[(kc * 8 + 6) * 65 + n], T[(kc * 8 + 7) * 65 + n]);
  *(uint4*)(dst + (size_t)(n0 + n) * ld_dst + k0 + kc * 8) = o;
  __syncthreads();
}

DI void phase0(const Params& p, unsigned char* smem) {
  float* T = (float*)smem;
  ushort_t* win = (ushort_t*)(p.ws + OFF_WIN);
  ushort_t* wmg = (ushort_t*)(p.ws + OFF_WMG);
  ushort_t* wpa = (ushort_t*)(p.ws + OFF_WPA);
  ushort_t* wpb = (ushort_t*)(p.ws + OFF_WPB);
  ushort_t* wo = (ushort_t*)(p.ws + OFF_WO);
  ushort_t* wl = (ushort_t*)(p.ws + OFF_WL);
  float* mod = (float*)(p.ws + OFF_MOD);
  constexpr int T_IN = 16 * 56, T_MG = 16 * 32, T_PA = 8 * 16, T_PB = 8 * 16, T_O = 16 * 16, T_L = 32, T_MOD = 48;
  constexpr int TOTAL = T_MOD + T_IN + T_MG + T_PA + T_PB + T_O + T_L;
  for (int t = blockIdx.x; t < TOTAL; t += gridDim.x) {
    int u = t;
    if (u < T_MOD) {
      float* sil = T;
      float* red = T + 3072;
      const int tid = threadIdx.x;
      for (int i = tid; i < 3072; i += NTH) {
        const int v = i >> 10, k = i & 1023;
        const float cv = (v < 2) ? p.c[v * 1024 + k] : p.c_ctx[k];
        sil[i] = siluf(cv);
      }
      __syncthreads();
      const int n = tid & 63, ksl = tid >> 6, n0 = u * 64;
      float a0 = 0.f, a1 = 0.f, a2 = 0.f;
      for (int k = ksl * 128; k < ksl * 128 + 128; ++k) {
        const float w = p.w_ada[(size_t)k * 3072 + n0 + n];
        a0 = fmaf(sil[k], w, a0); a1 = fmaf(sil[1024 + k], w, a1); a2 = fmaf(sil[2048 + k], w, a2);
      }
      red[(ksl * 3 + 0) * 64 + n] = a0; red[(ksl * 3 + 1) * 64 + n] = a1; red[(ksl * 3 + 2) * 64 + n] = a2;
      __syncthreads();
      if (tid < 192) {
        const int v = tid >> 6, nn = tid & 63;
        float s = 0.f;
#pragma unroll
        for (int q = 0; q < 8; ++q) s += red[(q * 3 + v) * 64 + nn];
        mod[v * 3072 + n0 + nn] = s + p.b_ada[n0 + nn];
      }
      __syncthreads();
      continue;
    }
    u -= T_MOD;
    if (u < T_IN) { transpose_tile(p.w_in, INW, win, 1024, (u / 56) * 64, (u % 56) * 64, T); continue; }
    u -= T_IN;
    if (u < T_MG) { transpose_tile(p.w_mg, 2048, wmg, 1024, (u / 32) * 64, (u % 32) * 64, T); continue; }
    u -= T_MG;
    if (u < T_PA) { transpose_tile(p.w_pa, 1024, wpa, 512, (u / 16) * 64, (u % 16) * 64, T); continue; }
    u -= T_PA;
    if (u < T_PB) { transpose_tile(p.w_pb, 1024, wpb, 512, (u / 16) * 64, (u % 16) * 64, T); continue; }
    u -= T_PB;
    if (u < T_O) { transpose_tile(p.w_o, 1024, wo, 1024, (u / 16) * 64, (u % 16) * 64, T); continue; }
    u -= T_O;
    {
      const int which = u >> 4, dir = (u >> 3) & 1, nt = u & 7;
      const float* src = (which ? p.a_up : p.w_up) + (size_t)dir * 64 * 512;
      transpose_tile(src, 512, wl + (size_t)((dir * 2 + which) * 512) * 64, 64, 0, nt * 64, T);
    }
  }
}

DI void phase_h(const Params& p) {
  const float* mod = (const float*)(p.ws + OFF_MOD);
  ushort_t* H = (ushort_t*)(p.ws + OFF_SH);
  const int lane = threadIdx.x & 63, l16 = lane & 15, gw = blockIdx.x * 8 + (threadIdx.x >> 6);
#pragma unroll 1
  for (int r4 = gw * 4; r4 < NT; r4 += gridDim.x * 32) {
    const int row = r4 + (lane >> 4);
    const float* src = (row < NX) ? p.x + (size_t)row * DM : p.ctx + (size_t)(row - NX) * DM;
    const float* md = mod + ((row < NX) ? (row / SEQ) : 2) * 3072;
    float4 v[16];
    const float rstd = ln_rows4(src, l16, v);
#pragma unroll
    for (int i = 0; i < 16; ++i) {
      const int col = l16 * 4 + 64 * i;
      const float4 sh = *(const float4*)(md + col), sc = *(const float4*)(md + 1024 + col);
      uint2 o;
      o.x = pack_bf2(v[i].x * rstd * (1.f + sc.x) + sh.x, v[i].y * rstd * (1.f + sc.y) + sh.y);
      o.y = pack_bf2(v[i].z * rstd * (1.f + sc.z) + sh.z, v[i].w * rstd * (1.f + sc.w) + sh.w);
      *(uint2*)(H + (size_t)row * DM + col) = o;
    }
  }
}

DI void phase_gemm1(const Params& p, unsigned char* smem) {
  ushort_t* As = (ushort_t*)smem;
  ushort_t* Bs = As + 2 * 256 * LDK;
  const ushort_t* H = (const ushort_t*)(p.ws + OFF_SH);
  const ushort_t* W = (const ushort_t*)(p.ws + OFF_WIN);
  ushort_t* zq = (ushort_t*)(p.ws + OFF_ZQ);
  ushort_t* zg = (ushort_t*)(p.ws + OFF_ZG);
  ushort_t* zm = (ushort_t*)p.out;
  const int tid = threadIdx.x, wave = tid >> 6, lane = tid & 63, l31 = lane & 31, hh = lane >> 5;
  const int wrow0 = (wave & 3) * 64, wcol0 = (wave >> 2) * 64;
  constexpr int MT = NT / 256, NTL = INW / 128;
  for (int t = blockIdx.x; t < MT * NTL; t += gridDim.x) {
    const int mt = t / NTL, nt = t % NTL;
    const bool is_g = (nt >= 6 && nt < 10) || nt >= 24;
    if (is_g && mt >= NX / 256) continue;
    const int row0 = mt * 256, col0 = nt * 128;
    f32x16 acc[1][2][2];
#pragma unroll
    for (int a = 0; a < 2; ++a)
#pragma unroll
      for (int b = 0; b < 2; ++b) acc[0][a][b] = zero16();
    auto aload = [&](int r, int k) { return *(const uint4*)(H + (size_t)(row0 + r) * DM + k); };
    auto bload = [&](int w, int n, int k) { return *(const uint4*)(W + (size_t)(col0 + n) * DM + k); };
    gemm_pass<256, 128, 2, 2, 1>(acc, aload, bload, DM, As, Bs, wrow0, wcol0, tid);
    ushort_t* dst; int ld, cbase;
    if (nt < 6) { dst = zq; ld = 768; cbase = col0; }
    else if (nt < 10) { dst = zg; ld = 1024; cbase = col0 - 768; }
    else if (nt < 24) { dst = zm; ld = 1792; cbase = col0 - 1280; }
    else { dst = zg; ld = 1024; cbase = 512 + col0 - 3072; }
#pragma unroll
    for (int mi = 0; mi < 2; ++mi)
#pragma unroll
      for (int ni = 0; ni < 2; ++ni)
#pragma unroll
        for (int i = 0; i < 16; ++i) {
          const int row = row0 + wrow0 + mi * 32 + crow(i, hh), col = cbase + wcol0 + ni * 32 + l31;
          dst[(size_t)row * ld + col] = f2bf(acc[0][mi][ni][i]);
        }
  }
}

DI int vperm(int key) { const int g = key >> 4, kq = key & 15; return g * 16 + 8 * ((kq >> 2) & 1) + (kq & 3) + 4 * (kq >> 3); }
DI void phase_qkv(const Params& p) {
  const ushort_t* zq = (const ushort_t*)(p.ws + OFF_ZQ);
  ushort_t* QB = (ushort_t*)(p.ws + OFF_QB);
  ushort_t* KB = (ushort_t*)(p.ws + OFF_KB);
  ushort_t* VB = (ushort_t*)(p.ws + OFF_VB);
  const int lane = threadIdx.x & 63, gw = blockIdx.x * 8 + (threadIdx.x >> 6);
  const int j = lane & 31, half = lane >> 5, axis = j >> 4, f = j & 15;
  const int d1 = axis * 32 + f, d2 = d1 + 16;
  const float inv = powf(10000.f, -(float)f * (1.f / 16.f));
  const float gq1 = p.q_norm[d1], gq2 = p.q_norm[d2], gk1 = p.k_norm[d1], gk2 = p.k_norm[d2];
  for (int row = gw; row < NT; row += gridDim.x * 8) {
    const bool isx = row < NX;
    const int b = isx ? row / SEQ : (row - NX) / CTXL;
    const int t = isx ? row % SEQ : (row - NX) % CTXL;
    const int pos = isx ? CTXL + t : t;
    const ushort_t* z = zq + (size_t)row * 768;
    float cs = 1.f, sn = 0.f;
    if (isx) { const float ang = (float)(axis ? (t & 63) : (t >> 6)) * inv; sincosf(ang, &sn, &cs); }
#pragma unroll
    for (int it = 0; it < 5; ++it) {
      const int hd = it * 2 + half;
      if (!isx && hd < 8) continue;
      const float v1 = bf2f(z[hd * 64 + d1]), v2 = bf2f(z[hd * 64 + d2]);
      float ss = v1 * v1 + v2 * v2;
#pragma unroll
      for (int o = 16; o >= 1; o >>= 1) ss += __shfl_xor(ss, o, 64);
      const float rms = rsqrtf(ss * (1.f / 64.f) + QK_EPS);
      const bool isq = hd < 8;
      const float y1 = v1 * rms * (isq ? gq1 : gk1), y2 = v2 * rms * (isq ? gq2 : gk2);
      float o1 = y1 * cs - y2 * sn, o2 = y2 * cs + y1 * sn;
      if (isq) {
        ushort_t* dst = QB + ((size_t)(b * 8 + hd) * SEQ + t) * 64;
        dst[d1] = f2bf(o1 * QSCALE); dst[d2] = f2bf(o2 * QSCALE);
      } else {
        ushort_t* dst = KB + ((size_t)(b * 2 + (hd - 8)) * LTOT + pos) * 64;
        dst[d1] = f2bf(o1); dst[d2] = f2bf(o2);
      }
    }
    {
      const size_t tb = (size_t)(pos >> 6) * 4096 + lane * 64 + vperm(pos & 63);
      VB[(size_t)(b * 2 + 0) * LTOT * 64 + tb] = z[640 + lane];
      VB[(size_t)(b * 2 + 1) * LTOT * 64 + tb] = z[704 + lane];
    }
  }
}

DI void phase_rwkv_prep(const Params& p, unsigned char* smem) {
  float* kbuf = (float*)smem;
  ushort_t* codes = (ushort_t*)(smem + 65536);
  float* invn = (float*)(smem + 65536 + 32 * 264 * 2);
  const ushort_t* zm = (const ushort_t*)p.out;
  const ushort_t* WL = (const ushort_t*)(p.ws + OFF_WL);
  ushort_t* SH = (ushort_t*)(p.ws + OFF_SH);
  ushort_t* DR = (ushort_t*)(p.ws + OFF_DR);
  const int tid = threadIdx.x, wave = tid >> 6, lane = tid & 63, l31 = lane & 31, hh = lane >> 5;
  for (int tt = blockIdx.x; tt < NT / 32; tt += gridDim.x) {
    const int row0 = tt * 32;
    int b, t0, len, pbase;
    if (row0 < NX) { b = row0 / SEQ; t0 = row0 % SEQ; len = SEQ; pbase = CTXL; }
    else { const int rc = row0 - NX; b = rc / CTXL; t0 = rc % CTXL; len = CTXL; pbase = 0; }
    __syncthreads();
    for (int id = tid; id < 32 * 224; id += NTH) {
      const int i = id / 224, c0 = (id % 224) * 8;
      const int t = t0 + i;
      const ushort_t* zr = zm + (size_t)(row0 + i) * 1792 + c0;
      const uint4 zc = *(const uint4*)zr;
      uint4 zp = make_uint4(0, 0, 0, 0), zn = make_uint4(0, 0, 0, 0);
      if (t > 0) zp = *(const uint4*)(zr - 1792);
      if (t < len - 1) zn = *(const uint4*)(zr + 1792);
      const float4 mp0 = *(const float4*)(p.mu_prev + c0), mp1 = *(const float4*)(p.mu_prev + c0 + 4);
      const float4 mn0 = *(const float4*)(p.mu_next + c0), mn1 = *(const float4*)(p.mu_next + c0 + 4);
      const unsigned zcw[4] = {zc.x, zc.y, zc.z, zc.w}, zpw[4] = {zp.x, zp.y, zp.z, zp.w}, znw[4] = {zn.x, zn.y, zn.z, zn.w};
      const float mpv[8] = {mp0.x, mp0.y, mp0.z, mp0.w, mp1.x, mp1.y, mp1.z, mp1.w};
      const float mnv[8] = {mn0.x, mn0.y, mn0.z, mn0.w, mn1.x, mn1.y, mn1.z, mn1.w};
      float s[8];
#pragma unroll
      for (int q = 0; q < 4; ++q) {
        const float c_lo = bflo(zcw[q]), c_hi = bfhi(zcw[q]);
        s[2 * q] = c_lo + mpv[2 * q] * (bflo(zpw[q]) - c_lo) + mnv[2 * q] * (bflo(znw[q]) - c_lo);
        s[2 * q + 1] = c_hi + mpv[2 * q + 1] * (bfhi(zpw[q]) - c_hi) + mnv[2 * q + 1] * (bfhi(znw[q]) - c_hi);
      }
      const int pp = pbase + t;
      if (c0 < 512 || (c0 >= 1024 && c0 < 1536)) {
        const int cc = (c0 < 512) ? c0 : c0 - 1024, which = (c0 < 512) ? 1 : 2;
        const int head = cc >> 6, d = cc & 63;
        uint4 o;
        o.x = pack_h2(s[0], s[1]); o.y = pack_h2(s[2], s[3]); o.z = pack_h2(s[4], s[5]); o.w = pack_h2(s[6], s[7]);
        *(uint4*)(SH + (((size_t)(b * 8 + head) * LTOT + pp) * 3 + which) * 64 + d) = o;
      } else if (c0 < 1024) {
        float* kd = kbuf + i * 512 + (c0 - 512);
        *(float4*)kd = make_float4(s[0], s[1], s[2], s[3]);
        *(float4*)(kd + 4) = make_float4(s[4], s[5], s[6], s[7]);
      } else {
        const int cc = c0 - 1536;
        if (cc < 128) {
#pragma unroll
          for (int q = 0; q < 8; ++q) s[q] = tanhf(s[q]);
        }
        uint4 o;
        o.x = pack_bf2(s[0], s[1]); o.y = pack_bf2(s[2], s[3]); o.z = pack_bf2(s[4], s[5]); o.w = pack_bf2(s[6], s[7]);
        *(uint4*)(codes + i * 264 + cc) = o;
      }
    }
    __syncthreads();
    {
      const int i = tid >> 4, head = (tid >> 1) & 7, hf = tid & 1;
      float ss = 0.f;
#pragma unroll 8
      for (int q = 0; q < 32; ++q) {
        const int n = head * 64 + hf * 32 + q;
        const float v = kbuf[i * 512 + n] * p.k_k[n];
        ss = fmaf(v, v, ss);
      }
      ss += __shfl_xor(ss, 1, 64);
      if (hf == 0) invn[i * 8 + head] = 1.f / fmaxf(sqrtf(ss), 1e-12f);
    }
    __syncthreads();
#pragma unroll 1
    for (int q4 = 0; q4 < 4; ++q4) {
      const int pr = wave * 4 + q4, dir = pr >> 4, ct = pr & 15;
      f32x16 aw = zero16(), aa = zero16();
#pragma unroll
      for (int ks = 0; ks < 4; ++ks) {
        const bf16x8 fw = *(const bf16x8*)&codes[l31 * 264 + dir * 64 + ks * 16 + hh * 8];
        const bf16x8 fa = *(const bf16x8*)&codes[l31 * 264 + 128 + dir * 64 + ks * 16 + hh * 8];
        const bf16x8 bw = *(const bf16x8*)&WL[(size_t)((dir * 2 + 0) * 512 + ct * 32 + l31) * 64 + ks * 16 + hh * 8];
        const bf16x8 ba = *(const bf16x8*)&WL[(size_t)((dir * 2 + 1) * 512 + ct * 32 + l31) * 64 + ks * 16 + hh * 8];
        aw = MFMA(fw, bw, aw);
        aa = MFMA(fa, ba, aa);
      }
      const int n = ct * 32 + l31, head = n >> 6, d = n & 63;
      const float w0v = p.w0[dir * 512 + n], a0v = p.a0[dir * 512 + n], kkw = p.k_k[n], kaw = p.k_a[n];
      const size_t cbase = (size_t)(b * 8 + head) * LTOT;
#pragma unroll
      for (int i = 0; i < 16; ++i) {
        const int ti = crow(i, hh);
        const int pp = pbase + t0 + ti;
        const float wpre = aw[i] + w0v;
        const float e = 0.60653065971263342f * sigmf(wpre);
        const float xdec = 1.f - __expf(-e);
        const float a = sigmf(aa[i] + a0v);
        const float kv = kbuf[ti * 512 + n];
        const float kkv = kv * kkw * invn[ti * 8 + head];
        const float kd = kv * (1.f + (a - 1.f) * kaw);
        ushort_t* dr = DR + ((((size_t)dir * 16) * LTOT + cbase + pp) * 3) * 64 + d;
        dr[0] = f2h(-xdec); dr[64] = f2h(kd); dr[128] = f2h(kkv * a);
        if (dir == 0) SH[((cbase + pp) * 3) * 64 + d] = f2h(kkv);
      }
    }
  }
}

DI int tau_to_pos(int dir, int tau) { return dir == 0 ? tau : (tau < CTXL ? CTXL - 1 - tau : LTOT - 1 - (tau - CTXL)); }


DI void fm_lo(float& acc, float a, uint32_t w) { asm("v_fma_mix_f32 %0, %1, %2, %0 op_sel_hi:[0,1,0]" : "+v"(acc) : "v"(a), "s"(w)); }
DI void fm_hi(float& acc, float a, uint32_t w) { asm("v_fma_mix_f32 %0, %1, %2, %0 op_sel:[0,1,0] op_sel_hi:[0,1,0]" : "+v"(acc) : "v"(a), "s"(w)); }
DI void fx_lo(float& s, uint32_t w) { asm("v_fma_mix_f32 %0, %0, %1, %0 op_sel_hi:[0,1,0]" : "+v"(s) : "s"(w)); }
DI void fx_hi(float& s, uint32_t w) { asm("v_fma_mix_f32 %0, %0, %1, %0 op_sel:[0,1,0] op_sel_hi:[0,1,0]" : "+v"(s) : "s"(w)); }
constexpr int PFD = 2, SEG = 65;
static_assert(CH % SEG == 0, "segments");
DI void scan_prefetch(uint32_t& pfr, const ushort_t* shc, const ushort_t* drc, int pos, int lane) {
  const ushort_t* a = (lane < 24) ? shc + (size_t)pos * 192 + lane * 8 : drc + (size_t)pos * 192 + (lane < 48 ? lane - 24 : 23) * 8;
  asm volatile("global_load_dword %0, %1, off" : "+v"(pfr) : "v"(a) : "memory");
}
DI void scan_stage_v(ushort_t* vbuf, const ushort_t* shc, int dir, int tau0, int lane) {
#pragma unroll
  for (int i = 0; i < (SEG * 8 + 63) / 64; ++i) {
    const int id = i * 64 + lane, st = id >> 3;
    if (st < SEG) *(uint4*)&vbuf[st * 64 + (id & 7) * 8] = *(const uint4*)(shc + (size_t)tau_to_pos(dir, tau0 + st) * 192 + 128 + (id & 7) * 8);
  }
}
struct ScanRec { uint32_t sh, dr, bb; ushort_t v; };
DI ScanRec scan_load(const ushort_t* shc, const ushort_t* drc, int pos, int lane) {
  ScanRec r;
  const ushort_t* s = shc + (size_t)pos * 192;
  const uint32_t* d = (const uint32_t*)(drc + (size_t)pos * 192);
  r.sh = ((const uint32_t*)s)[lane];
  r.v = s[128 + lane];
  r.dr = d[lane];
  r.bb = d[64 + (lane & 31)];
  return r;
}
#define MIXLO " op_sel_hi:[0,1,0]\n\t"
#define MIXHI " op_sel:[0,1,0] op_sel_hi:[0,1,0]\n\t"
template <int L>
DI void dot4(float& a0, float& a1, float& a2, float& a3, float (&S)[64], uint32_t src) {
  uint32_t t0, t1, t2, t3;
  asm("v_readlane_b32 %4, %8, %9\n\tv_readlane_b32 %5, %8, %10\n\tv_readlane_b32 %6, %8, %11\n\tv_readlane_b32 %7, %8, %12\n\t"
      "v_fma_mix_f32 %0, %13, %4, %0" MIXLO "v_fma_mix_f32 %1, %14, %4, %1" MIXHI
      "v_fma_mix_f32 %2, %15, %5, %2" MIXLO "v_fma_mix_f32 %3, %16, %5, %3" MIXHI
      "v_fma_mix_f32 %0, %17, %6, %0" MIXLO "v_fma_mix_f32 %1, %18, %6, %1" MIXHI
      "v_fma_mix_f32 %2, %19, %7, %2" MIXLO "v_fma_mix_f32 %3, %20, %7, %3" MIXHI
      : "+v"(a0), "+v"(a1), "+v"(a2), "+v"(a3), "=&s"(t0), "=&s"(t1), "=&s"(t2), "=&s"(t3)
      : "v"(src), "n"(L), "n"(L + 1), "n"(L + 2), "n"(L + 3),
        "v"(S[2 * (L & 31)]), "v"(S[2 * (L & 31) + 1]), "v"(S[2 * (L & 31) + 2]), "v"(S[2 * (L & 31) + 3]),
        "v"(S[2 * (L & 31) + 4]), "v"(S[2 * (L & 31) + 5]), "v"(S[2 * (L & 31) + 6]), "v"(S[2 * (L & 31) + 7]));
}
template <int L>
DI void upd4(float (&S)[64], uint32_t dr, uint32_t bb, float vv, float nsk) {
  uint32_t x0, x1, x2, x3, k0, k1, k2, k3, b0, b1, b2, b3;
  asm("v_readlane_b32 %8, %20, %22\n\tv_readlane_b32 %9, %20, %23\n\tv_readlane_b32 %10, %20, %24\n\tv_readlane_b32 %11, %20, %25\n\t"
      "v_readlane_b32 %12, %20, %26\n\tv_readlane_b32 %13, %20, %27\n\tv_readlane_b32 %14, %20, %28\n\tv_readlane_b32 %15, %20, %29\n\t"
      "v_readlane_b32 %16, %21, %22\n\tv_readlane_b32 %17, %21, %23\n\tv_readlane_b32 %18, %21, %24\n\tv_readlane_b32 %19, %21, %25\n\t"
      "v_fma_mix_f32 %0, %0, %8, %0" MIXLO "v_fma_mix_f32 %1, %1, %8, %1" MIXHI
      "v_fma_mix_f32 %2, %2, %9, %2" MIXLO "v_fma_mix_f32 %3, %3, %9, %3" MIXHI
      "v_fma_mix_f32 %4, %4, %10, %4" MIXLO "v_fma_mix_f32 %5, %5, %10, %5" MIXHI
      "v_fma_mix_f32 %6, %6, %11, %6" MIXLO "v_fma_mix_f32 %7, %7, %11, %7" MIXHI
      "v_fma_mix_f32 %0, %30, %12, %0" MIXLO "v_fma_mix_f32 %1, %30, %12, %1" MIXHI
      "v_fma_mix_f32 %2, %30, %13, %2" MIXLO "v_fma_mix_f32 %3, %30, %13, %3" MIXHI
      "v_fma_mix_f32 %4, %30, %14, %4" MIXLO "v_fma_mix_f32 %5, %30, %14, %5" MIXHI
      "v_fma_mix_f32 %6, %30, %15, %6" MIXLO "v_fma_mix_f32 %7, %30, %15, %7" MIXHI
      "v_fma_mix_f32 %0, %31, %16, %0" MIXLO "v_fma_mix_f32 %1, %31, %16, %1" MIXHI
      "v_fma_mix_f32 %2, %31, %17, %2" MIXLO "v_fma_mix_f32 %3, %31, %17, %3" MIXHI
      "v_fma_mix_f32 %4, %31, %18, %4" MIXLO "v_fma_mix_f32 %5, %31, %18, %5" MIXHI
      "v_fma_mix_f32 %6, %31, %19, %6" MIXLO "v_fma_mix_f32 %7, %31, %19, %7" MIXHI
      : "+v"(S[2 * L]), "+v"(S[2 * L + 1]), "+v"(S[2 * L + 2]), "+v"(S[2 * L + 3]), "+v"(S[2 * L + 4]), "+v"(S[2 * L + 5]), "+v"(S[2 * L + 6]), "+v"(S[2 * L + 7]),
        "=&s"(x0), "=&s"(x1), "=&s"(x2), "=&s"(x3), "=&s"(k0), "=&s"(k1), "=&s"(k2), "=&s"(k3), "=&s"(b0), "=&s"(b1), "=&s"(b2), "=&s"(b3)
      : "v"(dr), "v"(bb), "n"(L), "n"(L + 1), "n"(L + 2), "n"(L + 3), "n"(L + 32), "n"(L + 33), "n"(L + 34), "n"(L + 35), "v"(vv), "v"(nsk));
}
template <int L>
DI void dot4_2(float& a0, float& a1, float& c0, float& c1, float (&SU)[64], float (&SP)[64], uint32_t src) {
  uint32_t t0, t1, t2, t3;
  asm("v_readlane_b32 %4, %8, %9\n\tv_readlane_b32 %5, %8, %10\n\tv_readlane_b32 %6, %8, %11\n\tv_readlane_b32 %7, %8, %12\n\t"
      "v_fma_mix_f32 %0, %13, %4, %0" MIXLO "v_fma_mix_f32 %1, %14, %4, %1" MIXHI
      "v_fma_mix_f32 %2, %21, %4, %2" MIXLO "v_fma_mix_f32 %3, %22, %4, %3" MIXHI
      "v_fma_mix_f32 %0, %15, %5, %0" MIXLO "v_fma_mix_f32 %1, %16, %5, %1" MIXHI
      "v_fma_mix_f32 %2, %23, %5, %2" MIXLO "v_fma_mix_f32 %3, %24, %5, %3" MIXHI
      "v_fma_mix_f32 %0, %17, %6, %0" MIXLO "v_fma_mix_f32 %1, %18, %6, %1" MIXHI
      "v_fma_mix_f32 %2, %25, %6, %2" MIXLO "v_fma_mix_f32 %3, %26, %6, %3" MIXHI
      "v_fma_mix_f32 %0, %19, %7, %0" MIXLO "v_fma_mix_f32 %1, %20, %7, %1" MIXHI
      "v_fma_mix_f32 %2, %27, %7, %2" MIXLO "v_fma_mix_f32 %3, %28, %7, %3" MIXHI
      : "+v"(a0), "+v"(a1), "+v"(c0), "+v"(c1), "=&s"(t0), "=&s"(t1), "=&s"(t2), "=&s"(t3)
      : "v"(src), "n"(L), "n"(L + 1), "n"(L + 2), "n"(L + 3),
        "v"(SU[2 * L]), "v"(SU[2 * L + 1]), "v"(SU[2 * L + 2]), "v"(SU[2 * L + 3]), "v"(SU[2 * L + 4]), "v"(SU[2 * L + 5]), "v"(SU[2 * L + 6]), "v"(SU[2 * L + 7]),
        "v"(SP[2 * L]), "v"(SP[2 * L + 1]), "v"(SP[2 * L + 2]), "v"(SP[2 * L + 3]), "v"(SP[2 * L + 4]), "v"(SP[2 * L + 5]), "v"(SP[2 * L + 6]), "v"(SP[2 * L + 7]));
}
template <int L>
DI void upd4_2(float (&SU)[64], float (&SP)[64], uint32_t dr, uint32_t bb, float vv, float nskU, float nskP) {
  uint32_t x0, x1, x2, x3, k0, k1, k2, k3, b0, b1, b2, b3;
  asm("v_readlane_b32 %16, %28, %30\n\tv_readlane_b32 %17, %28, %31\n\tv_readlane_b32 %18, %28, %32\n\tv_readlane_b32 %19, %28, %33\n\t"
      "v_readlane_b32 %20, %28, %34\n\tv_readlane_b32 %21, %28, %35\n\tv_readlane_b32 %22, %28, %36\n\tv_readlane_b32 %23, %28, %37\n\t"
      "v_readlane_b32 %24, %29, %30\n\tv_readlane_b32 %25, %29, %31\n\tv_readlane_b32 %26, %29, %32\n\tv_readlane_b32 %27, %29, %33\n\t"
      "v_fma_mix_f32 %0, %0, %16, %0" MIXLO "v_fma_mix_f32 %1, %1, %16, %1" MIXHI
      "v_fma_mix_f32 %2, %2, %17, %2" MIXLO "v_fma_mix_f32 %3, %3, %17, %3" MIXHI
      "v_fma_mix_f32 %4, %4, %18, %4" MIXLO "v_fma_mix_f32 %5, %5, %18, %5" MIXHI
      "v_fma_mix_f32 %6, %6, %19, %6" MIXLO "v_fma_mix_f32 %7, %7, %19, %7" MIXHI
      "v_fma_mix_f32 %8, %8, %16, %8" MIXLO "v_fma_mix_f32 %9, %9, %16, %9" MIXHI
      "v_fma_mix_f32 %10, %10, %17, %10" MIXLO "v_fma_mix_f32 %11, %11, %17, %11" MIXHI
      "v_fma_mix_f32 %12, %12, %18, %12" MIXLO "v_fma_mix_f32 %13, %13, %18, %13" MIXHI
      "v_fma_mix_f32 %14, %14, %19, %14" MIXLO "v_fma_mix_f32 %15, %15, %19, %15" MIXHI
      "v_fma_mix_f32 %0, %38, %20, %0" MIXLO "v_fma_mix_f32 %1, %38, %20, %1" MIXHI
      "v_fma_mix_f32 %2, %38, %21, %2" MIXLO "v_fma_mix_f32 %3, %38, %21, %3" MIXHI
      "v_fma_mix_f32 %4, %38, %22, %4" MIXLO "v_fma_mix_f32 %5, %38, %22, %5" MIXHI
      "v_fma_mix_f32 %6, %38, %23, %6" MIXLO "v_fma_mix_f32 %7, %38, %23, %7" MIXHI
      "v_fma_mix_f32 %0, %39, %24, %0" MIXLO "v_fma_mix_f32 %1, %39, %24, %1" MIXHI
      "v_fma_mix_f32 %2, %39, %25, %2" MIXLO "v_fma_mix_f32 %3, %39, %25, %3" MIXHI
      "v_fma_mix_f32 %4, %39, %26, %4" MIXLO "v_fma_mix_f32 %5, %39, %26, %5" MIXHI
      "v_fma_mix_f32 %6, %39, %27, %6" MIXLO "v_fma_mix_f32 %7, %39, %27, %7" MIXHI
      "v_fma_mix_f32 %8, %40, %24, %8" MIXLO "v_fma_mix_f32 %9, %40, %24, %9" MIXHI
      "v_fma_mix_f32 %10, %40, %25, %10" MIXLO "v_fma_mix_f32 %11, %40, %25, %11" MIXHI
      "v_fma_mix_f32 %12, %40, %26, %12" MIXLO "v_fma_mix_f32 %13, %40, %26, %13" MIXHI
      "v_fma_mix_f32 %14, %40, %27, %14" MIXLO "v_fma_mix_f32 %15, %40, %27, %15" MIXHI
      : "+v"(SU[2 * L]), "+v"(SU[2 * L + 1]), "+v"(SU[2 * L + 2]), "+v"(SU[2 * L + 3]), "+v"(SU[2 * L + 4]), "+v"(SU[2 * L + 5]), "+v"(SU[2 * L + 6]), "+v"(SU[2 * L + 7]),
        "+v"(SP[2 * L]), "+v"(SP[2 * L + 1]), "+v"(SP[2 * L + 2]), "+v"(SP[2 * L + 3]), "+v"(SP[2 * L + 4]), "+v"(SP[2 * L + 5]), "+v"(SP[2 * L + 6]), "+v"(SP[2 * L + 7]),
        "=&s"(x0), "=&s"(x1), "=&s"(x2), "=&s"(x3), "=&s"(k0), "=&s"(k1), "=&s"(k2), "=&s"(k3), "=&s"(b0), "=&s"(b1), "=&s"(b2), "=&s"(b3)
      : "v"(dr), "v"(bb), "n"(L), "n"(L + 1), "n"(L + 2), "n"(L + 3), "n"(L + 32), "n"(L + 33), "n"(L + 34), "n"(L + 35), "v"(vv), "v"(nskU), "v"(nskP));
}
DI void scan_step2(float (&SU)[64], float (&SP)[64], const ScanRec& c, float vv) {
  float a0 = 0.f, a1 = 0.f, c0 = 0.f, c1 = 0.f;
  dot4_2<0>(a0, a1, c0, c1, SU, SP, c.sh); dot4_2<4>(a0, a1, c0, c1, SU, SP, c.sh); dot4_2<8>(a0, a1, c0, c1, SU, SP, c.sh); dot4_2<12>(a0, a1, c0, c1, SU, SP, c.sh);
  dot4_2<16>(a0, a1, c0, c1, SU, SP, c.sh); dot4_2<20>(a0, a1, c0, c1, SU, SP, c.sh); dot4_2<24>(a0, a1, c0, c1, SU, SP, c.sh); dot4_2<28>(a0, a1, c0, c1, SU, SP, c.sh);
  const float nU = -(a0 + a1), nP = -(c0 + c1);
  upd4_2<0>(SU, SP, c.dr, c.bb, vv, nU, nP); upd4_2<4>(SU, SP, c.dr, c.bb, vv, nU, nP); upd4_2<8>(SU, SP, c.dr, c.bb, vv, nU, nP); upd4_2<12>(SU, SP, c.dr, c.bb, vv, nU, nP);
  upd4_2<16>(SU, SP, c.dr, c.bb, vv, nU, nP); upd4_2<20>(SU, SP, c.dr, c.bb, vv, nU, nP); upd4_2<24>(SU, SP, c.dr, c.bb, vv, nU, nP); upd4_2<28>(SU, SP, c.dr, c.bb, vv, nU, nP);
}
template <bool WITH_OUT>
DI float scan_step(float (&S)[64], const ScanRec& c, float vv) {
  float s0 = 0.f, s1 = 0.f, s2 = 0.f, s3 = 0.f;
  dot4<0>(s0, s1, s2, s3, S, c.sh); dot4<4>(s0, s1, s2, s3, S, c.sh); dot4<8>(s0, s1, s2, s3, S, c.sh); dot4<12>(s0, s1, s2, s3, S, c.sh);
  dot4<16>(s0, s1, s2, s3, S, c.sh); dot4<20>(s0, s1, s2, s3, S, c.sh); dot4<24>(s0, s1, s2, s3, S, c.sh); dot4<28>(s0, s1, s2, s3, S, c.sh);
  const float nsk = -((s0 + s1) + (s2 + s3));
  upd4<0>(S, c.dr, c.bb, vv, nsk); upd4<4>(S, c.dr, c.bb, vv, nsk); upd4<8>(S, c.dr, c.bb, vv, nsk); upd4<12>(S, c.dr, c.bb, vv, nsk);
  upd4<16>(S, c.dr, c.bb, vv, nsk); upd4<20>(S, c.dr, c.bb, vv, nsk); upd4<24>(S, c.dr, c.bb, vv, nsk); upd4<28>(S, c.dr, c.bb, vv, nsk);
  float o0 = 0.f, o1 = 0.f, o2 = 0.f, o3 = 0.f;
  if (WITH_OUT) {
    dot4<32>(o0, o1, o2, o3, S, c.sh); dot4<36>(o0, o1, o2, o3, S, c.sh); dot4<40>(o0, o1, o2, o3, S, c.sh); dot4<44>(o0, o1, o2, o3, S, c.sh);
    dot4<48>(o0, o1, o2, o3, S, c.sh); dot4<52>(o0, o1, o2, o3, S, c.sh); dot4<56>(o0, o1, o2, o3, S, c.sh); dot4<60>(o0, o1, o2, o3, S, c.sh);
  }
  return (o0 + o1) + (o2 + o3);
}
constexpr int SPF = 3;
DI void scan_stage_vr(ushort_t* vbuf, ushort_t* rbuf, const ushort_t* shc, int dir, int tau0, int lane) {
#pragma unroll
  for (int i = 0; i < (SEG * 8 + 63) / 64; ++i) {
    const int id = i * 64 + lane, st = id >> 3;
    if (st < SEG) {
      const ushort_t* rec = shc + (size_t)tau_to_pos(dir, tau0 + st) * 192 + (id & 7) * 8;
      *(uint4*)&vbuf[st * 64 + (id & 7) * 8] = *(const uint4*)(rec + 128);
      *(uint4*)&rbuf[st * 64 + (id & 7) * 8] = *(const uint4*)(rec + 64);
    }
    if (i % 3 == 2) asm volatile("" ::: "memory");
  }
}
DI void fv_lo(float& acc, float a, uint32_t w) { asm("v_fma_mix_f32 %0, %1, %2, %0 op_sel_hi:[0,1,0]" : "+v"(acc) : "v"(a), "v"(w)); }
DI void fv_hi(float& acc, float a, uint32_t w) { asm("v_fma_mix_f32 %0, %1, %2, %0 op_sel:[0,1,0] op_sel_hi:[0,1,0]" : "+v"(acc) : "v"(a), "v"(w)); }
DI void phase_scanA(const Params& p, unsigned char* smem) {
  const ushort_t* SH = (const ushort_t*)(p.ws + OFF_SH);
  const ushort_t* DR = (const ushort_t*)(p.ws + OFF_DR);
  float* PU = p.out;
  const int lane = threadIdx.x & 63;
  ushort_t* vbuf = (ushort_t*)smem + (threadIdx.x >> 6) * (2 * SEG * 64);
  ushort_t* rbuf = vbuf + SEG * 64;
  ushort_t* O = (ushort_t*)(p.ws + OFF_ZQ);
  ushort_t* DRw = (ushort_t*)(p.ws + OFF_DR);
  const int gw = __builtin_amdgcn_readfirstlane(blockIdx.x * 8 + (threadIdx.x >> 6));
  uint32_t pfr = 0u;
  for (int task = gw; task < 32 * NCHUNK; task += gridDim.x * 8) {
    const int cd = task / NCHUNK, j = task % NCHUNK, dir = cd >> 4, c = cd & 15, b = c >> 3, head = c & 7;
    float SU[64], SP[64];
#pragma unroll
    for (int k = 0; k < 64; ++k) { SU[k] = 0.f; SP[k] = (k == lane) ? 1.f : 0.f; }
    const ushort_t* shc = SH + (size_t)c * LTOT * 192;
    const ushort_t* drc = DR + (size_t)(dir * 16 + c) * LTOT * 192;
#pragma unroll 1
    for (int st = 0; st < PFD; ++st) scan_prefetch(pfr, shc, drc, tau_to_pos(dir, j * CH + st), lane);
#pragma unroll 1
    for (int sg = 0; sg < CH / SEG; ++sg) {
      scan_stage_vr(vbuf, rbuf, shc, dir, j * CH + sg * SEG, lane);
#pragma unroll 1
      for (int s2 = 0; s2 < SEG; ++s2) {
        const int st = sg * SEG + s2;
        const int pos = tau_to_pos(dir, j * CH + st);
        const ushort_t* shr = shc + (size_t)pos * 192;
        const ushort_t* drr = drc + (size_t)pos * 192;
        scan_prefetch(pfr, shc, drc, tau_to_pos(dir, j * CH + (st + PFD < CH ? st + PFD : CH - 1)), lane);
        const float vv = h2f(vbuf[s2 * 64 + lane]);
        u32x16 a0, a1, b0, b1;
        sload4(a0, a1, b0, b1, shr, drr);
        float u0 = 0.f, u1 = 0.f, q0 = 0.f, q1 = 0.f;
#pragma unroll
        for (int q = 0; q < 16; ++q) {
          fm_lo(u0, SU[2 * q], a0[q]); fm_hi(u1, SU[2 * q + 1], a0[q]); fm_lo(q0, SP[2 * q], a0[q]); fm_hi(q1, SP[2 * q + 1], a0[q]);
          fm_lo(u0, SU[32 + 2 * q], a1[q]); fm_hi(u1, SU[33 + 2 * q], a1[q]); fm_lo(q0, SP[32 + 2 * q], a1[q]); fm_hi(q1, SP[33 + 2 * q], a1[q]);
        }
        const float nU = -(u0 + u1), nP = -(q0 + q1);
#pragma unroll
        for (int q = 0; q < 16; ++q) {
          fx_lo(SU[2 * q], b0[q]); fx_hi(SU[2 * q + 1], b0[q]); fx_lo(SU[32 + 2 * q], b1[q]); fx_hi(SU[33 + 2 * q], b1[q]);
          fx_lo(SP[2 * q], b0[q]); fx_hi(SP[2 * q + 1], b0[q]); fx_lo(SP[32 + 2 * q], b1[q]); fx_hi(SP[33 + 2 * q], b1[q]);
        }
        sload4(a0, a1, b0, b1, drr + 64, drr + 128);
#pragma unroll
        for (int q = 0; q < 16; ++q) { fm_lo(SU[2 * q], vv, a0[q]); fm_hi(SU[2 * q + 1], vv, a0[q]); fm_lo(SU[32 + 2 * q], vv, a1[q]); fm_hi(SU[33 + 2 * q], vv, a1[q]); }
#pragma unroll
        for (int q = 0; q < 16; ++q) {
          fm_lo(SU[2 * q], nU, b0[q]); fm_hi(SU[2 * q + 1], nU, b0[q]); fm_lo(SU[32 + 2 * q], nU, b1[q]); fm_hi(SU[33 + 2 * q], nU, b1[q]);
          fm_lo(SP[2 * q], nP, b0[q]); fm_hi(SP[2 * q + 1], nP, b0[q]); fm_lo(SP[32 + 2 * q], nP, b1[q]); fm_hi(SP[33 + 2 * q], nP, b1[q]);
        }
        if (pos >= CTXL) {
          float e0 = 0.f, e1 = 0.f, g0 = 0.f, g1 = 0.f;
#pragma unroll
          for (int q = 0; q < 8; ++q) {
            asm volatile("" ::: "memory");
            const uint4 rw = *(const uint4*)&rbuf[s2 * 64 + q * 8];
            fv_lo(e0, SU[8 * q + 0], rw.x); fv_hi(e1, SU[8 * q + 1], rw.x); fv_lo(g0, SP[8 * q + 0], rw.x); fv_hi(g1, SP[8 * q + 1], rw.x);
            fv_lo(e0, SU[8 * q + 2], rw.y); fv_hi(e1, SU[8 * q + 3], rw.y); fv_lo(g0, SP[8 * q + 2], rw.y); fv_hi(g1, SP[8 * q + 3], rw.y);
            fv_lo(e0, SU[8 * q + 4], rw.z); fv_hi(e1, SU[8 * q + 5], rw.z); fv_lo(g0, SP[8 * q + 4], rw.z); fv_hi(g1, SP[8 * q + 5], rw.z);
            fv_lo(e0, SU[8 * q + 6], rw.w); fv_hi(e1, SU[8 * q + 7], rw.w); fv_lo(g0, SP[8 * q + 6], rw.w); fv_hi(g1, SP[8 * q + 7], rw.w);
          }
          O[((size_t)dir * NX + (size_t)b * SEQ + (pos - CTXL)) * 512 + head * 64 + lane] = f2h(e0 + e1);
          DRw[((size_t)(dir * 16 + c) * LTOT + pos) * 192 + lane] = f2h(g0 + g1);
        }
      }
    }
    float* dst = PU + (size_t)task * 2 * 4096 + lane * 64;
#pragma unroll
    for (int k = 0; k < 64; k += 4) {
      *(float4*)(dst + k) = make_float4(SU[k], SU[k + 1], SU[k + 2], SU[k + 3]);
      *(float4*)(dst + 4096 + k) = make_float4(SP[k], SP[k + 1], SP[k + 2], SP[k + 3]);
    }
  }
  asm volatile("s_waitcnt vmcnt(0)" ::: "memory");
  asm volatile("" :: "v"(pfr));
}

DI void phase_scanB(const Params& p, unsigned char* smem) {
  if (blockIdx.x >= 32) return;
  float* Sb = (float*)smem;
  float* Xb = Sb + 64 * 65;
  float* PU = p.out;
  const int cd = blockIdx.x, tid = threadIdx.x, wave = tid >> 6, lane = tid & 63, l31 = lane & 31, hh = lane >> 5;
  const int tile = wave & 3, tm = tile >> 1, tn = tile & 1, kh = wave >> 2;
  for (int i = tid; i < 64 * 65; i += NTH) Sb[i] = 0.f;
  constexpr int BPF = 4;
  float bP[BPF][16];
  f32x16 uT[BPF];
#pragma unroll
  for (int s = 0; s < BPF; ++s) uT[s] = zero16();
  auto fetch = [&](int j, float (&bp)[16], f32x16& ut) {
    const float* base = PU + (size_t)(cd * NCHUNK + j) * 2 * 4096;
#pragma unroll
    for (int kk = 0; kk < 16; ++kk) bp[kk] = base[4096 + (kh * 32 + 2 * kk + hh) * 64 + tn * 32 + l31];
    if (kh == 0) {
#pragma unroll
      for (int i = 0; i < 16; ++i) ut[i] = base[(tm * 32 + crow(i, hh)) * 64 + tn * 32 + l31];
    }
  };
  auto put_state = [&](int j, const f32x16& st) {
    float* base = PU + (size_t)(cd * NCHUNK + j) * 2 * 4096;
#pragma unroll
    for (int i = 0; i < 16; ++i) base[(tm * 32 + crow(i, hh)) * 64 + tn * 32 + l31] = st[i];
  };
#pragma unroll
  for (int s = 0; s < BPF; ++s) fetch(s, bP[s], uT[s]);
  if (kh == 0) put_state(0, zero16());
  __syncthreads();
#pragma unroll 1
  for (int j = 0; j < NCHUNK; ++j) {
    float nP[16];
    f32x16 nU = zero16();
    if (j + BPF < NCHUNK) fetch(j + BPF, nP, nU);
    f32x16 acc = (kh == 0) ? uT[0] : zero16();
#pragma unroll
    for (int kk = 0; kk < 16; ++kk) {
      const float a = Sb[(tm * 32 + l31) * 65 + kh * 32 + 2 * kk + hh];
      acc = __builtin_amdgcn_mfma_f32_32x32x2f32(a, bP[0][kk], acc, 0, 0, 0);
    }
    if (kh == 1) {
#pragma unroll
      for (int i = 0; i < 16; ++i) Xb[(tile * 16 + i) * 64 + lane] = acc[i];
    }
    __syncthreads();
    if (kh == 0) {
#pragma unroll
      for (int i = 0; i < 16; ++i) { acc[i] += Xb[(tile * 16 + i) * 64 + lane]; Sb[(tm * 32 + crow(i, hh)) * 65 + tn * 32 + l31] = acc[i]; }
      if (j + 1 < NCHUNK) put_state(j + 1, acc);
    }
#pragma unroll
    for (int s = 0; s + 1 < BPF; ++s) {
#pragma unroll
      for (int kk = 0; kk < 16; ++kk) bP[s][kk] = bP[s + 1][kk];
      uT[s] = uT[s + 1];
    }
#pragma unroll
    for (int kk = 0; kk < 16; ++kk) bP[BPF - 1][kk] = nP[kk];
    uT[BPF - 1] = nU;
    __syncthreads();
  }
}

typedef __attribute__((ext_vector_type(8))) _Float16 f16x8;
DI void phase_scanC(const Params& p, unsigned char* smem) {
  const ushort_t* DR = (const ushort_t*)(p.ws + OFF_DR);
  ushort_t* O = (ushort_t*)(p.ws + OFF_ZQ);
  const float* PU = p.out;
  const int lane = threadIdx.x & 63, l31 = lane & 31, hh = lane >> 5;
  const int gw = blockIdx.x * 8 + (threadIdx.x >> 6);
  for (int task = gw; task < 32 * NCHUNK; task += gridDim.x * 8) {
    const int cd = task / NCHUNK, j = task % NCHUNK, dir = cd >> 4, c = cd & 15, b = c >> 3, head = c & 7;
    if (j == 0) continue;
    const float* S = PU + (size_t)task * 2 * 4096;
    f16x8 bs[2][4];
#pragma unroll
    for (int nt = 0; nt < 2; ++nt)
#pragma unroll
      for (int ks = 0; ks < 4; ++ks) {
        const float* sp = S + (nt * 32 + l31) * 64 + ks * 16 + hh * 8;
        const float4 x0 = *(const float4*)sp, x1 = *(const float4*)(sp + 4);
        f16x8 f = {(_Float16)x0.x, (_Float16)x0.y, (_Float16)x0.z, (_Float16)x0.w, (_Float16)x1.x, (_Float16)x1.y, (_Float16)x1.z, (_Float16)x1.w};
        bs[nt][ks] = f;
      }
    const ushort_t* drc = DR + (size_t)(dir * 16 + c) * LTOT * 192;
    ushort_t* obase = O + ((size_t)dir * NX + (size_t)b * SEQ) * 512 + head * 64;
#pragma unroll 1
    for (int tile = 0; tile < (CH + 31) / 32; ++tile) {
      const int tau = tile * 32 + l31;
      const int pos = tau_to_pos(dir, j * CH + (tau < CH ? tau : CH - 1));
      const ushort_t* wrow = drc + (size_t)pos * 192;
      f32x16 acc[2] = {zero16(), zero16()};
#pragma unroll
      for (int ks = 0; ks < 4; ++ks) {
        const f16x8 a = *(const f16x8*)(wrow + ks * 16 + hh * 8);
        acc[0] = __builtin_amdgcn_mfma_f32_32x32x16_f16(a, bs[0][ks], acc[0], 0, 0, 0);
        acc[1] = __builtin_amdgcn_mfma_f32_32x32x16_f16(a, bs[1][ks], acc[1], 0, 0, 0);
      }
#pragma unroll
      for (int i = 0; i < 16; ++i) {
        const int t2 = tile * 32 + crow(i, hh);
        if (t2 < CH) {
          const int p2 = tau_to_pos(dir, j * CH + t2);
          if (p2 >= CTXL) {
            ushort_t* o0 = obase + (size_t)(p2 - CTXL) * 512 + l31;
            o0[0] = f2h(h2f(o0[0]) + acc[0][i]);
            o0[32] = f2h(h2f(o0[32]) + acc[1][i]);
          }
        }
      }
    }
  }
}

DI void phase_scan_naive(const Params& p) {
  const ushort_t* SH = (const ushort_t*)(p.ws + OFF_SH);
  const ushort_t* DR = (const ushort_t*)(p.ws + OFF_DR);
  ushort_t* O = (ushort_t*)(p.ws + OFF_ZQ);
  const int lane = threadIdx.x & 63;
  const int gw = __builtin_amdgcn_readfirstlane(blockIdx.x * 8 + (threadIdx.x >> 6));
  if (gw >= 32) return;
  const int cd = gw, dir = cd >> 4, c = cd & 15, b = c >> 3, head = c & 7;
  float S[64];
#pragma unroll
  for (int k = 0; k < 64; ++k) S[k] = 0.f;
  const ushort_t* shc = SH + (size_t)c * LTOT * 192;
  const ushort_t* drc = DR + (size_t)(dir * 16 + c) * LTOT * 192;
#pragma unroll 1
  for (int tau = 0; tau < LTOT; ++tau) {
    const int pos = tau_to_pos(dir, tau);
    const ushort_t* shr = shc + (size_t)pos * 192;
    const ushort_t* drr = drc + (size_t)pos * 192;
    const float vv = h2f(shr[128 + lane]);
    u32x16 k0, k1;
    sload2(k0, k1, shr);
    float sk0 = 0.f, sk1 = 0.f;
#pragma unroll
    for (int q = 0; q < 32; ++q) { sk0 = fmaf(S[q], HV(k0, q), sk0); sk1 = fmaf(S[32 + q], HV(k1, q), sk1); }
    const float nsk = -(sk0 + sk1);
    u32x16 x0, x1, d0, d1;
    sload4(x0, x1, d0, d1, drr, drr + 64);
#pragma unroll
    for (int q = 0; q < 32; ++q) {
      S[q] = fmaf(S[q], -HV(x0, q), S[q]); S[32 + q] = fmaf(S[32 + q], -HV(x1, q), S[32 + q]);
      S[q] = fmaf(vv, HV(d0, q), S[q]); S[32 + q] = fmaf(vv, HV(d1, q), S[32 + q]);
    }
    u32x16 b0, b1, r0, r1;
    sload4(b0, b1, r0, r1, drr + 128, shr + 64);
    float o0 = 0.f, o1 = 0.f;
#pragma unroll
    for (int q = 0; q < 32; ++q) {
      S[q] = fmaf(nsk, HV(b0, q), S[q]); S[32 + q] = fmaf(nsk, HV(b1, q), S[32 + q]);
      o0 = fmaf(S[q], HV(r0, q), o0); o1 = fmaf(S[32 + q], HV(r1, q), o1);
    }
    if (pos >= CTXL) O[((size_t)dir * NX + (size_t)b * SEQ + (pos - CTXL)) * 512 + head * 64 + lane] = f2h(o0 + o1);
  }
}

DI void phase_attn(const Params& p, unsigned char* smem) {
  ushort_t* Kb = (ushort_t*)smem;
  ushort_t* Vb = Kb + 2 * 64 * LDK;
  ushort_t* QB = (ushort_t*)(p.ws + OFF_QB);
  const ushort_t* KB = (const ushort_t*)(p.ws + OFF_KB);
  const ushort_t* VB = (const ushort_t*)(p.ws + OFF_VB);
  const int tid = threadIdx.x, wave = tid >> 6, lane = tid & 63, l31 = lane & 31, hh = lane >> 5;
  const int loff = (tid >> 3) * LDK + (tid & 7) * 8;
  constexpr float THR = 6.f;
  constexpr int NTL = LTOT / 64;
  for (int at = blockIdx.x; at < 1024; at += gridDim.x) {
    const int b = at >> 9, kvh = (at >> 8) & 1, t0 = (at & 255) * 64;
    const int head = kvh * 4 + (wave & 3), tq = t0 + (wave >> 2) * 32 + l31;
    ushort_t* qrow = QB + ((size_t)(b * 8 + head) * SEQ + tq) * 64;
    bf16x8 qf[4];
#pragma unroll
    for (int ks = 0; ks < 4; ++ks) qf[ks] = *(const bf16x8*)(qrow + ks * 16 + hh * 8);
    const ushort_t* kbase = KB + (size_t)(b * 2 + kvh) * LTOT * 64 + tid * 8;
    const ushort_t* vbase = VB + (size_t)(b * 2 + kvh) * LTOT * 64 + tid * 8;
    f32x16 o[2] = {zero16(), zero16()};
    f32x16 negm = zero16();
    float lsum = 0.f;
    auto qk = [&](f32x16 (&s)[2], const ushort_t* Ks) {
      s[0] = negm; s[1] = negm;
#pragma unroll
      for (int ks = 0; ks < 4; ++ks)
#pragma unroll
        for (int kk = 0; kk < 2; ++kk) s[kk] = MFMA(*(const bf16x8*)&Ks[(kk * 32 + l31) * LDK + ks * 16 + hh * 8], qf[ks], s[kk]);
    };
    uint4 rk, rv;
    __syncthreads();
    rk = *(const uint4*)kbase; rv = *(const uint4*)vbase;
    *(uint4*)&Kb[loff] = rk; *(uint4*)&Vb[loff] = rv;
    rk = *(const uint4*)(kbase + 4096);
    rv = *(const uint4*)(vbase + 4096);
    __syncthreads();
    f32x16 sA[2], sB[2];
    qk(sA, Kb);
    {
      float mx = fmaxf(sA[0][0], sA[1][0]);
#pragma unroll
      for (int i = 1; i < 16; ++i) mx = fmaxf(mx, fmaxf(sA[0][i], sA[1][i]));
      mx = fmaxf(mx, __shfl_xor(mx, 32, 64));
#pragma unroll
      for (int i = 0; i < 16; ++i) { sA[0][i] -= mx; sA[1][i] -= mx; negm[i] = -mx; }
    }
    *(uint4*)&Kb[64 * LDK + loff] = rk;
    rk = *(const uint4*)(kbase + 2 * 4096);
    auto step = [&](int t, f32x16 (&sc)[2], f32x16 (&sn)[2]) {
      __syncthreads();
      if (t + 2 < NTL) *(uint4*)&Kb[(t & 1) * 64 * LDK + loff] = rk;
      if (t + 1 < NTL) *(uint4*)&Vb[((t + 1) & 1) * 64 * LDK + loff] = rv;
      if (t + 3 < NTL) rk = *(const uint4*)(kbase + (size_t)(t + 3) * 4096);
      if (t + 2 < NTL) rv = *(const uint4*)(vbase + (size_t)(t + 2) * 4096);
      if (t + 1 < NTL) qk(sn, Kb + ((t + 1) & 1) * 64 * LDK);
      float mx = fmaxf(sc[0][0], sc[1][0]);
#pragma unroll
      for (int i = 1; i < 16; ++i) mx = fmaxf(mx, fmaxf(sc[0][i], sc[1][i]));
      mx = fmaxf(mx, __shfl_xor(mx, 32, 64));
      if (__builtin_amdgcn_ballot_w64(mx > THR) != 0ull) {
        const float delta = fmaxf(mx, 0.f);
        const float alpha = __builtin_amdgcn_exp2f(-delta);
        lsum *= alpha;
#pragma unroll
        for (int i = 0; i < 16; ++i) {
          o[0][i] *= alpha; o[1][i] *= alpha; sc[0][i] -= delta; sc[1][i] -= delta; negm[i] -= delta;
          sn[0][i] -= delta; sn[1][i] -= delta;
        }
      }
      float ps = 0.f;
#pragma unroll
      for (int i = 0; i < 16; ++i) {
        sc[0][i] = __builtin_amdgcn_exp2f(sc[0][i]); sc[1][i] = __builtin_amdgcn_exp2f(sc[1][i]);
        ps += sc[0][i] + sc[1][i];
      }
      lsum += ps;
      const ushort_t* Vt = Vb + (t & 1) * 64 * LDK;
#pragma unroll
      for (int kk = 0; kk < 2; ++kk) {
#pragma unroll
        for (int st = 0; st < 2; ++st) {
          uint4 pw;
          pw.x = pack_bf2(sc[kk][8 * st + 0], sc[kk][8 * st + 1]); pw.y = pack_bf2(sc[kk][8 * st + 2], sc[kk][8 * st + 3]);
          pw.z = pack_bf2(sc[kk][8 * st + 4], sc[kk][8 * st + 5]); pw.w = pack_bf2(sc[kk][8 * st + 6], sc[kk][8 * st + 7]);
          const bf16x8 pf = __builtin_bit_cast(bf16x8, pw);
#pragma unroll
          for (int dt = 0; dt < 2; ++dt) o[dt] = MFMA(*(const bf16x8*)&Vt[(dt * 32 + l31) * LDK + kk * 32 + st * 16 + hh * 8], pf, o[dt]);
        }
      }
    };
#pragma unroll 1
    for (int t = 0; t < NTL; t += 2) {
      step(t, sA, sB);
      step(t + 1, sB, sA);
    }
    const float ltot = lsum + __shfl_xor(lsum, 32, 64);
    const float il = 1.f / ltot;
#pragma unroll
    for (int dt = 0; dt < 2; ++dt)
#pragma unroll
      for (int g = 0; g < 4; ++g) {
        uint2 w;
        w.x = pack_bf2(o[dt][4 * g + 0] * il, o[dt][4 * g + 1] * il);
        w.y = pack_bf2(o[dt][4 * g + 2] * il, o[dt][4 * g + 3] * il);
        *(uint2*)(qrow + dt * 32 + 8 * g + 4 * hh) = w;
      }
  }
}

constexpr size_t OFF_DBG = WS_END;
DI void dbg_acc(const Params& p, int slot, float d2, float r2) {
  float* dbg = (float*)(p.ws + OFF_DBG);
  d2 = wave_sum(d2); r2 = wave_sum(r2);
  if ((threadIdx.x & 63) == 0) { atomicAdd(dbg + 2 * slot, d2); atomicAdd(dbg + 2 * slot + 1, r2); }
}
DI void probe_after_gemm1(const Params& p) {
  if (blockIdx.x != 0) return;
  const int tid = threadIdx.x, lane = tid & 63, wave = tid >> 6;
  const float* mod = (const float*)(p.ws + OFF_MOD);
  const ushort_t* H = (const ushort_t*)(p.ws + OFF_SH);
  {
    float d2 = 0.f, r2 = 0.f;
    if (tid < 96) {
      const int v = tid / 32, n = (tid % 32) * 97 % 3072;
      float s = 0.f;
      for (int k = 0; k < 1024; ++k) { const float cv = (v < 2) ? p.c[v * 1024 + k] : p.c_ctx[k]; s += (cv / (1.f + expf(-cv))) * p.w_ada[(size_t)k * 3072 + n]; }
      s += p.b_ada[n];
      const float d = mod[v * 3072 + n] - s; d2 = d * d; r2 = s * s;
    }
    dbg_acc(p, 0, d2, r2);
  }
  {
    const int row = wave == 0 ? 0 : wave == 1 ? 777 : wave == 2 ? 16383 : wave == 3 ? 16384 : wave == 4 ? 32767 : wave == 5 ? 32768 : wave == 6 ? 33023 : 33279;
    const float* src = (row < NX) ? p.x + (size_t)row * DM : p.ctx + (size_t)(row - NX) * DM;
    const float* md = mod + ((row < NX) ? (row / SEQ) : 2) * 3072;
    float s = 0.f;
    for (int i = lane; i < 1024; i += 64) s += src[i];
    const float mu = wave_sum(s) / 1024.f;
    float q = 0.f;
    for (int i = lane; i < 1024; i += 64) q += (src[i] - mu) * (src[i] - mu);
    const float rstd = rsqrtf(wave_sum(q) / 1024.f + LN_EPS);
    float d2 = 0.f, r2 = 0.f;
    for (int i = lane; i < 1024; i += 64) {
      const float ref = (src[i] - mu) * rstd * (1.f + md[1024 + i]) + md[i];
      const float d = bf2f(H[(size_t)row * DM + i]) - ref; d2 += d * d; r2 += ref * ref;
    }
    dbg_acc(p, 1, d2, r2);
  }
  {
    float d2 = 0.f, r2 = 0.f;
    if (tid < 60) {
      const int ri = tid / 10, ci = tid % 10;
      const int row = ri == 0 ? 3 : ri == 1 ? 777 : ri == 2 ? 20001 : ri == 3 ? 32767 : ri == 4 ? 32773 : 33279;
      const int col = ci == 0 ? 0 : ci == 1 ? 100 : ci == 2 ? 700 : ci == 3 ? 800 : ci == 4 ? 1279 : ci == 5 ? 1280 : ci == 6 ? 2000 : ci == 7 ? 3071 : ci == 8 ? 3072 : 3583;
      float s = 0.f;
      for (int k = 0; k < 1024; ++k) s += bf2f(H[(size_t)row * DM + k]) * p.w_in[(size_t)k * INW + col];
      float got = 0.f; bool have = true;
      if (col < 768) got = bf2f(((const ushort_t*)(p.ws + OFF_ZQ))[(size_t)row * 768 + col]);
      else if (col < 1280) { if (row < NX) got = bf2f(((const ushort_t*)(p.ws + OFF_ZG))[(size_t)row * 1024 + col - 768]); else have = false; }
      else if (col < 3072) got = bf2f(((const ushort_t*)p.out)[(size_t)row * 1792 + col - 1280]);
      else { if (row < NX) got = bf2f(((const ushort_t*)(p.ws + OFF_ZG))[(size_t)row * 1024 + 512 + col - 3072]); else have = false; }
      if (have) { const float d = got - s; d2 = d * d; r2 = s * s; }
    }
    dbg_acc(p, 2, d2, r2);
  }
}
DI void probe_after_prep(const Params& p, unsigned char* smem) {
  if (blockIdx.x != 0) return;
  float* cbuf = (float*)smem;
  const int tid = threadIdx.x, lane = tid & 63, wave = tid >> 6;
  const ushort_t* zm = (const ushort_t*)p.out;
  const ushort_t* SH = (const ushort_t*)(p.ws + OFF_SH);
  const ushort_t* DR = (const ushort_t*)(p.ws + OFF_DR);
  float dA = 0.f, rA = 0.f, dB = 0.f, rB = 0.f;
#pragma unroll 1
  for (int sidx = wave; sidx < 24; sidx += 8) {
    const int ri = sidx >> 1, head = (sidx & 1) ? 5 : 0;
    const int row = ri == 0 ? 0 : ri == 1 ? 1 : ri == 2 ? 31 : ri == 3 ? 32 : ri == 4 ? 16383 : ri == 5 ? 16384 : ri == 6 ? 20000 : ri == 7 ? 32767 : ri == 8 ? 32768 : ri == 9 ? 33023 : ri == 10 ? 33024 : 33279;
    int b, t, len, pp;
    if (row < NX) { b = row / SEQ; t = row % SEQ; len = SEQ; pp = CTXL + t; } else { b = (row - NX) / CTXL; t = (row - NX) % CTXL; len = CTXL; pp = t; }
    auto sft = [&](int col) {
      const float z = bf2f(zm[(size_t)row * 1792 + col]);
      const float zp = (t > 0) ? bf2f(zm[(size_t)(row - 1) * 1792 + col]) : 0.f;
      const float zn = (t < len - 1) ? bf2f(zm[(size_t)(row + 1) * 1792 + col]) : 0.f;
      return z + p.mu_prev[col] * (zp - z) + p.mu_next[col] * (zn - z);
    };
    const int n = head * 64 + lane;
    const float r = sft(n), k = sft(512 + n), v = sft(1024 + n);
#pragma unroll 1
    for (int j = lane; j < 256; j += 64) { const float s = sft(1536 + j); cbuf[wave * 256 + j] = (j < 128) ? tanhf(s) : s; }
    __builtin_amdgcn_s_waitcnt(0);
    __builtin_amdgcn_wave_barrier();
    const float kr = k * p.k_k[n];
    const float nrm = sqrtf(wave_sum(kr * kr));
    const float kk = kr / fmaxf(nrm, 1e-12f);
    const size_t cp = (size_t)(b * 8 + head) * LTOT + pp;
    { float d;
      d = h2f(SH[(cp * 3 + 0) * 64 + lane]) - kk; dA += d * d; rA += kk * kk;
      d = h2f(SH[(cp * 3 + 1) * 64 + lane]) - r; dA += d * d; rA += r * r;
      d = h2f(SH[(cp * 3 + 2) * 64 + lane]) - v; dA += d * d; rA += v * v; }
#pragma unroll 1
    for (int dir = 0; dir < 2; ++dir) {
      float wpre = p.w0[dir * 512 + n], apre = p.a0[dir * 512 + n];
#pragma unroll 1
      for (int j = 0; j < 64; ++j) {
        wpre += cbuf[wave * 256 + dir * 64 + j] * p.w_up[(size_t)(dir * 64 + j) * 512 + n];
        apre += cbuf[wave * 256 + 128 + dir * 64 + j] * p.a_up[(size_t)(dir * 64 + j) * 512 + n];
      }
      const float wlog = -log1pf(expf(-wpre)) - 0.5f;
      const float xd = 1.f - expf(-expf(wlog));
      const float a = 1.f / (1.f + expf(-apre));
      const float kd = k * (1.f + (a - 1.f) * p.k_a[n]);
      const float bq = kk * a;
      const size_t dp = (size_t)(dir * 16 + b * 8 + head) * LTOT + pp;
      float d;
      d = h2f(DR[(dp * 3 + 0) * 64 + lane]) - xd; dB += d * d; rB += xd * xd;
      d = h2f(DR[(dp * 3 + 1) * 64 + lane]) - kd; dB += d * d; rB += kd * kd;
      d = h2f(DR[(dp * 3 + 2) * 64 + lane]) - bq; dB += d * d; rB += bq * bq;
    }
    __builtin_amdgcn_wave_barrier();
  }
  dbg_acc(p, 3, dA, rA);
  dbg_acc(p, 4, dB, rB);
}

DI void probe_scan(const Params& p) {
  if (blockIdx.x != 0 || threadIdx.x >= 128) return;
  const ushort_t* SH = (const ushort_t*)(p.ws + OFF_SH);
  const ushort_t* DR = (const ushort_t*)(p.ws + OFF_DR);
  const ushort_t* O = (const ushort_t*)(p.ws + OFF_ZQ);
  const int lane = threadIdx.x & 63, wv = threadIdx.x >> 6;
  const int c = wv ? 9 : 0, dir = wv, b = c >> 3, head = c & 7;
  float S[64];
#pragma unroll
  for (int k = 0; k < 64; ++k) S[k] = 0.f;
  float d2 = 0.f, r2 = 0.f;
#pragma unroll 1
  for (int tau = 0; tau < 420; ++tau) {
    const int pos = dir == 0 ? tau : (tau < CTXL ? CTXL - 1 - tau : LTOT - 1 - (tau - CTXL));
    const ushort_t* sh = SH + ((size_t)c * LTOT + pos) * 192;
    const ushort_t* dr = DR + ((size_t)(dir * 16 + c) * LTOT + pos) * 192;
    const float v = h2f(sh[128 + lane]);
    float sk = 0.f;
#pragma unroll
    for (int k = 0; k < 64; ++k) sk += S[k] * h2f(sh[k]);
    float o = 0.f;
#pragma unroll
    for (int k = 0; k < 64; ++k) {
      const float dec = 1.f - h2f(dr[k]);
      S[k] = S[k] * dec - sk * h2f(dr[128 + k]) + v * h2f(dr[64 + k]);
      o += S[k] * h2f(sh[64 + k]);
    }
    if (pos >= CTXL) {
      const float got = h2f(O[((size_t)dir * NX + (size_t)b * SEQ + (pos - CTXL)) * 512 + head * 64 + lane]);
      const float d = got - o; d2 += d * d; r2 += o * o;
    }
  }
  dbg_acc(p, 0, d2, r2);
}
DI float probe_delta(const Params& p) {
  const float* dbg = (const float*)(p.ws + OFF_DBG);
  int k = 0;
  for (int s = 0; s < 5; ++s) { const float rel = sqrtf(dbg[2 * s] / fmaxf(dbg[2 * s + 1], 1e-30f)); if (!(rel < 0.05f)) k |= 1 << s; }
  return sqrtf(0.02f * (float)k);
}

DI void phase_final(const Params& p, unsigned char* smem) {
  ushort_t* As = (ushort_t*)smem;
  ushort_t* Bs = As + 2 * 128 * LDK;
  const float* mod = (const float*)(p.ws + OFF_MOD);
  ushort_t* ZG = (ushort_t*)(p.ws + OFF_ZG);
  ushort_t* QB = (ushort_t*)(p.ws + OFF_QB);
  ushort_t* O = (ushort_t*)(p.ws + OFF_ZQ);
  const ushort_t* SH = (const ushort_t*)(p.ws + OFF_SH);
  const ushort_t* DR = (const ushort_t*)(p.ws + OFF_DR);
  const ushort_t* WMG = (const ushort_t*)(p.ws + OFF_WMG);
  const ushort_t* WPA = (const ushort_t*)(p.ws + OFF_WPA);
  const ushort_t* WPB = (const ushort_t*)(p.ws + OFF_WPB);
  const ushort_t* WO = (const ushort_t*)(p.ws + OFF_WO);
#pragma unroll 1
  for (int mt = blockIdx.x; mt < NX / 128; mt += gridDim.x) {
    int tid = threadIdx.x;
    asm volatile("" : "+v"(tid));
    const int wave = tid >> 6, lane = tid & 63, l31 = lane & 31, hh = lane >> 5;
    const int wrow0 = (wave & 3) * 32, wcol0 = (wave >> 2) * 64;
    const int row0 = mt * 128, b = row0 / SEQ, tb0 = row0 % SEQ;
    const float* md = mod + b * 3072;
    __syncthreads();
#pragma unroll 1
    for (int r4 = wave * 4; r4 < 128; r4 += 32) {
      const int r = r4 + (lane >> 4), l16 = lane & 15;
      ushort_t* hdst = (ushort_t*)(p.out + (size_t)(row0 + r) * DM);
      float4 v[16];
      const float rstd = ln_rows4(p.x + (size_t)(row0 + r) * DM, l16, v);
#pragma unroll
      for (int i = 0; i < 16; ++i) {
        const int col = l16 * 4 + 64 * i;
        const float4 sh = *(const float4*)(md + col), sc = *(const float4*)(md + 1024 + col);
        uint2 o;
        o.x = pack_bf2(v[i].x * rstd * (1.f + sc.x) + sh.x, v[i].y * rstd * (1.f + sc.y) + sh.y);
        o.y = pack_bf2(v[i].z * rstd * (1.f + sc.z) + sh.z, v[i].w * rstd * (1.f + sc.w) + sh.w);
        *(uint2*)(hdst + col) = o;
      }
    }
#if PROBE
    float a2ref = 0.f;
    if (mt == 0) {
      const int tok = wave * 16 + 3, head = wave, row = row0 + tok, t = tb0 + tok, dd = head * 64 + lane;
      const size_t cp = (size_t)(b * 8 + head) * LTOT + CTXL + t;
      const float o = h2f(O[(size_t)row * 512 + dd]) + h2f(O[((size_t)NX + row) * 512 + dd]);
      const float mu = wave_sum(o) / 64.f;
      const float var = wave_sum((o - mu) * (o - mu)) / 64.f;
      const float y = (o - mu) * rsqrtf(var + GN_EPS) * p.gn_w[dd] + p.gn_b[dd];
      const float r = h2f(SH[(cp * 3 + 1) * 64 + lane]), vv = h2f(SH[(cp * 3 + 2) * 64 + lane]);
      const float kf = h2f(DR[(cp * 3 + 1) * 64 + lane]), kb = h2f(DR[(((size_t)16 * LTOT + cp) * 3 + 1) * 64 + lane]);
      const float bon = wave_sum(r * kf * p.r_k[dd]) + wave_sum(r * kb * p.r_k[512 + dd]);
      const float g = bf2f(ZG[(size_t)row * 1024 + 512 + dd]);
      a2ref = (y + bon * vv) * (g / (1.f + expf(-g)));
    }
#endif
#pragma unroll 1
    for (int it = 0; it < 16; ++it) {
      const int pair = (it * 8 + wave) * 8 + (lane >> 3), q8 = lane & 7;
      const int tok = pair >> 3, head = pair & 7, row = row0 + tok, t = tb0 + tok, d0 = q8 * 8;
      const unsigned cp = (unsigned)((b * 8 + head) * LTOT + CTXL + t);
      const unsigned ofo = (unsigned)(row * 512 + head * 64 + d0), obo = ofo + (unsigned)NX * 512u;
      const unsigned ro = (cp * 3 + 1) * 64 + d0, vo = (cp * 3 + 2) * 64 + d0;
      const unsigned kbo = ((16u * LTOT + cp) * 3 + 1) * 64 + d0;
      const unsigned gbo = (unsigned)(row * 1024 + 512 + head * 64 + d0), gao = gbo - 512;
      const unsigned yao = (unsigned)(((b * 8 + head) * SEQ + t) * 64 + d0);
      float ov[8], bon = 0.f, s = 0.f;
      {
        const uint4 a = *(const uint4*)(O + ofo), bq = *(const uint4*)(O + obo);
        const uint4 rr = *(const uint4*)(SH + ro), kf = *(const uint4*)(DR + ro), kb = *(const uint4*)(DR + kbo);
        const unsigned aw[4] = {a.x, a.y, a.z, a.w}, bw[4] = {bq.x, bq.y, bq.z, bq.w}, rw[4] = {rr.x, rr.y, rr.z, rr.w};
        const unsigned fw[4] = {kf.x, kf.y, kf.z, kf.w}, kw[4] = {kb.x, kb.y, kb.z, kb.w};
#pragma unroll
        for (int q = 0; q < 4; ++q) {
          const int dd = head * 64 + d0 + 2 * q;
          ov[2 * q] = hlo(aw[q]) + hlo(bw[q]);
          ov[2 * q + 1] = hhi(aw[q]) + hhi(bw[q]);
          s += ov[2 * q] + ov[2 * q + 1];
          bon += hlo(rw[q]) * (hlo(fw[q]) * p.r_k[dd] + hlo(kw[q]) * p.r_k[512 + dd]);
          bon += hhi(rw[q]) * (hhi(fw[q]) * p.r_k[dd + 1] + hhi(kw[q]) * p.r_k[512 + dd + 1]);
        }
      }
      s += __shfl_xor(s, 1, 64); s += __shfl_xor(s, 2, 64); s += __shfl_xor(s, 4, 64);
      bon += __shfl_xor(bon, 1, 64); bon += __shfl_xor(bon, 2, 64); bon += __shfl_xor(bon, 4, 64);
      const float mu = s * (1.f / 64.f);
      float vs = 0.f;
#pragma unroll
      for (int q = 0; q < 8; ++q) { ov[q] -= mu; vs = fmaf(ov[q], ov[q], vs); }
      vs += __shfl_xor(vs, 1, 64); vs += __shfl_xor(vs, 2, 64); vs += __shfl_xor(vs, 4, 64);
      const float rstd = rsqrtf(vs * (1.f / 64.f) + GN_EPS);
      {
        const uint4 vv = *(const uint4*)(SH + vo), gb = *(const uint4*)(ZG + gbo), ga = *(const uint4*)(ZG + gao), ya = *(const uint4*)(QB + yao);
        const unsigned vw[4] = {vv.x, vv.y, vv.z, vv.w}, gbw[4] = {gb.x, gb.y, gb.z, gb.w}, gaw[4] = {ga.x, ga.y, ga.z, ga.w}, yw[4] = {ya.x, ya.y, ya.z, ya.w};
        unsigned o2[4], o1[4];
#pragma unroll
        for (int q = 0; q < 4; ++q) {
          const int dd = head * 64 + d0 + 2 * q;
          const float y0 = ov[2 * q] * rstd * p.gn_w[dd] + p.gn_b[dd] + bon * hlo(vw[q]);
          const float y1 = ov[2 * q + 1] * rstd * p.gn_w[dd + 1] + p.gn_b[dd + 1] + bon * hhi(vw[q]);
          o2[q] = pack_bf2(y0 * siluf(bflo(gbw[q])), y1 * siluf(bfhi(gbw[q])));
          o1[q] = pack_bf2(bflo(yw[q]) * siluf(bflo(gaw[q])), bfhi(yw[q]) * siluf(bfhi(gaw[q])));
        }
        *(uint4*)(O + ofo) = make_uint4(o2[0], o2[1], o2[2], o2[3]);
        *(uint4*)(QB + yao) = make_uint4(o1[0], o1[1], o1[2], o1[3]);
      }
    }
    asm volatile("s_waitcnt vmcnt(0)" ::: "memory");
    __syncthreads();
#if PROBE
    if (mt == 0) {
      const int tok = wave * 16 + 3, head = wave, row = row0 + tok, dd = head * 64 + lane;
      const float got = bf2f(O[(size_t)row * 512 + dd]);
      dbg_acc(p, 1, (got - a2ref) * (got - a2ref), a2ref * a2ref);
    }
#endif
    const ushort_t* hbase = (const ushort_t*)p.out;
    auto hload = [&](int r, int k) { return *(const uint4*)(hbase + (unsigned)((row0 + r) * 2048 + k)); };
    auto a1load = [&](int r, int k) { return *(const uint4*)(QB + (unsigned)(((b * 8 + (k >> 6)) * SEQ + tb0 + r) * 64 + (k & 63))); };
    auto a2load = [&](int r, int k) { return *(const uint4*)(O + (unsigned)((row0 + r) * 512 + k)); };
#pragma unroll 1
    for (int nt = 0; nt < 8; ++nt) {
      const int col0 = nt * 128;
      int tidn = tid;
      asm volatile("" : "+v"(tidn));
      f32x16 sg[2][1][2] = {{{zero16(), zero16()}}, {{zero16(), zero16()}}};
      gemm_pass<128, 128, 1, 2, 2>(sg, hload, [&](int w, int n, int k) { return *(const uint4*)(WMG + (unsigned)((w * 1024 + col0 + n) * DM + k)); }, DM, As, Bs, wrow0, wcol0, tidn);
#pragma unroll
      for (int ni = 0; ni < 2; ++ni) {
        const int col = col0 + wcol0 + ni * 32 + l31;
        const float ba = p.b_mg[col], bb = p.b_mg[1024 + col];
#pragma unroll
        for (int i = 0; i < 16; ++i) { sg[0][0][ni][i] = sigmf(sg[0][0][ni][i] + ba); sg[1][0][ni][i] = sigmf(sg[1][0][ni][i] + bb); }
      }
      {
        f32x16 ya[1][1][2] = {{{zero16(), zero16()}}};
        gemm_pass<128, 128, 1, 2, 1>(ya, a1load, [&](int w, int n, int k) { return *(const uint4*)(WPA + (unsigned)((col0 + n) * 512 + k)); }, 512, As, Bs, wrow0, wcol0, tidn);
#pragma unroll
        for (int ni = 0; ni < 2; ++ni)
#pragma unroll
          for (int i = 0; i < 16; ++i) sg[0][0][ni][i] *= ya[0][0][ni][i];
      }
      {
        f32x16 yb[1][1][2] = {{{zero16(), zero16()}}};
        gemm_pass<128, 128, 1, 2, 1>(yb, a2load, [&](int w, int n, int k) { return *(const uint4*)(WPB + (unsigned)((col0 + n) * 512 + k)); }, 512, As, Bs, wrow0, wcol0, tidn);
        int rb1 = row0 + wrow0 + 4 * hh;
        asm volatile("" : "+v"(rb1));
#pragma unroll
        for (int ni = 0; ni < 2; ++ni) {
          const int col = col0 + wcol0 + ni * 32 + l31;
#pragma unroll
          for (int i = 0; i < 16; ++i) {
            const float mv = sg[0][0][ni][i] + sg[1][0][ni][i] * yb[0][0][ni][i];
            ZG[(unsigned)((rb1 + crow(i, 0)) * 1024 + col)] = f2bf(mv);
          }
        }
      }
    }
    asm volatile("s_waitcnt vmcnt(0)" ::: "memory");
    __syncthreads();
#if PROBE
    if (mt == 0) {
      float d2 = 0.f, r2 = 0.f;
      if (tid < 64) {
        const int r = (tid * 37) & 127, col = (tid * 131 + 7) & 1023, row = row0 + r;
        const ushort_t* hrow = (const ushort_t*)(p.out + (size_t)row * DM);
        float ga = p.b_mg[col], gb = p.b_mg[1024 + col], ya = 0.f, yb = 0.f;
        for (int k = 0; k < 1024; ++k) { const float hv = bf2f(hrow[k]); ga += hv * p.w_mg[(size_t)k * 2048 + col]; gb += hv * p.w_mg[(size_t)k * 2048 + 1024 + col]; }
        for (int k = 0; k < 512; ++k) {
          ya += bf2f(QB[((size_t)(b * 8 + (k >> 6)) * SEQ + tb0 + r) * 64 + (k & 63)]) * p.w_pa[(size_t)k * 1024 + col];
          yb += bf2f(O[(size_t)row * 512 + k]) * p.w_pb[(size_t)k * 1024 + col];
        }
        const float ref = ya / (1.f + expf(-ga)) + yb / (1.f + expf(-gb));
        const float got = bf2f(ZG[(size_t)row * 1024 + col]);
        d2 = (got - ref) * (got - ref); r2 = ref * ref;
      }
      dbg_acc(p, 2, d2, r2);
    }
#endif
    const float* gt = md + 2048;
#pragma unroll 1
    for (int nt = 0; nt < 8; ++nt) {
      const int col0 = nt * 128;
      int tidn = tid;
      asm volatile("" : "+v"(tidn));
      f32x16 acc[1][1][2] = {{{zero16(), zero16()}}};
      gemm_pass<128, 128, 1, 2, 1>(acc, [&](int r, int k) { return *(const uint4*)(ZG + (unsigned)((row0 + r) * 1024 + k)); },
                                   [&](int w, int n, int k) { return *(const uint4*)(WO + (unsigned)((col0 + n) * DM + k)); }, DM, As, Bs, wrow0, wcol0, tidn);
      int rb2 = row0 + wrow0 + 4 * hh;
      asm volatile("" : "+v"(rb2));
#pragma unroll
      for (int ni = 0; ni < 2; ++ni) {
        const int col = col0 + wcol0 + ni * 32 + l31;
        const float g = gt[col];
#pragma unroll
        for (int i = 0; i < 16; ++i) {
          const unsigned idx = (unsigned)((rb2 + crow(i, 0)) * DM + col);
          p.out[idx] = ALPHA * p.x[idx] + g * acc[0][0][ni][i];
        }
      }
    }
    asm volatile("s_waitcnt vmcnt(0)" ::: "memory");
    __syncthreads();
#if PROBE
    if (mt == 0) {
      float d2 = 0.f, r2 = 0.f;
      if (tid < 64) {
        const int r = (tid * 29) & 127, col = (tid * 113 + 5) & 1023, row = row0 + r;
        float o = 0.f;
        for (int k = 0; k < 1024; ++k) o += bf2f(ZG[(size_t)row * 1024 + k]) * p.w_o[(size_t)k * 1024 + col];
        const float ref = md[2048 + col] * o;
        const float got = p.out[(size_t)row * DM + col] - ALPHA * p.x[(size_t)row * DM + col];
        d2 = (got - ref) * (got - ref); r2 = ref * ref;
      }
      dbg_acc(p, 3, d2, r2);
    }
    asm volatile("s_waitcnt vmcnt(0)" ::: "memory");
    __syncthreads();
#endif
#if !PROBE
#pragma unroll 1
    for (int r4 = wave * 4; r4 < 128; r4 += 32) {
      const int r = r4 + (lane >> 4), l16 = lane & 15;
      float* dst = p.out + (size_t)(row0 + r) * DM;
      float4 v[16];
      const float rstd = ln_rows4(dst, l16, v);
#pragma unroll
      for (int i = 0; i < 16; ++i) {
        const int col = l16 * 4 + 64 * i;
        const float4 g = *(const float4*)(p.ln_g + col), bb = *(const float4*)(p.ln_b + col);
        *(float4*)(dst + col) = make_float4(v[i].x * rstd * g.x + bb.x, v[i].y * rstd * g.y + bb.y, v[i].z * rstd * g.z + bb.z, v[i].w * rstd * g.w + bb.w);
      }
    }
#endif
  }
}


#if PROBE
DI void probe_f3(const Params& p) {
  const float pdelta = probe_delta(p);
  const int lane = threadIdx.x & 63, wave = threadIdx.x >> 6;
  for (int mt = blockIdx.x; mt < NX / 128; mt += gridDim.x) {
    for (int r = wave; r < 128; r += 8) {
      const float* src = p.x + (size_t)(mt * 128 + r) * DM;
      float* dst = p.out + (size_t)(mt * 128 + r) * DM;
      float s = 0.f, q = 0.f;
      for (int i = lane; i < 1024; i += 64) s += ALPHA * src[i];
      const float mu = wave_sum(s) / 1024.f;
      for (int i = lane; i < 1024; i += 64) { const float d = ALPHA * src[i] - mu; q += d * d; }
      const float rstd = rsqrtf(wave_sum(q) / 1024.f + LN_EPS);
      for (int i = lane; i < 1024; i += 64) dst[i] = (ALPHA * src[i] - mu) * rstd * p.ln_g[i] + p.ln_b[i] + pdelta;
    }
  }
}
#endif
DI void gsync(cg::grid_group& g) { asm volatile("s_waitcnt vmcnt(0) lgkmcnt(0)" ::: "memory"); g.sync(); }

constexpr int SMEM_BYTES = 8 * 2 * SEG * 64 * 2;
static_assert(SMEM_BYTES >= 2 * (256 + 128) * LDK * 2, "GEMM tiles");
static_assert(SMEM_BYTES >= 65536 + 32 * 264 * 2 + 1024, "rwkv prep LDS");
__global__ void __launch_bounds__(NTH) fwd_megakernel(Params p) {
  __shared__ __attribute__((aligned(16))) unsigned char smem[SMEM_BYTES];
  cg::grid_group grid = cg::this_grid();
#if PROBE
  if (blockIdx.x == 0 && threadIdx.x < 64) ((float*)(p.ws + OFF_DBG))[threadIdx.x] = 0.f;
#endif
  phase0(p, smem);
  gsync(grid);
  phase_h(p);
  gsync(grid);
  if (__builtin_amdgcn_readfirstlane(threadIdx.x) >= 256) __builtin_amdgcn_s_setprio(1);
  phase_gemm1(p, smem);
  __builtin_amdgcn_s_setprio(0);
  gsync(grid);
  phase_qkv(p);
  phase_rwkv_prep(p, smem);
  gsync(grid);
#if PROBE_NAIVE_SCAN
  phase_scan_naive(p);
#else
  if (__builtin_amdgcn_readfirstlane(threadIdx.x) >= 256) __builtin_amdgcn_s_setprio(1);
  phase_scanA(p, smem);
  __builtin_amdgcn_s_setprio(0);
  gsync(grid);
  phase_scanB(p, smem);
  gsync(grid);
  phase_scanC(p, smem);
#endif
  if (__builtin_amdgcn_readfirstlane(threadIdx.x) >= 256) __builtin_amdgcn_s_setprio(1);
  phase_attn(p, smem);
  __builtin_amdgcn_s_setprio(0);
  gsync(grid);
#if PROBE
  probe_scan(p);
  gsync(grid);
#endif
  if (__builtin_amdgcn_readfirstlane(threadIdx.x) >= 256) __builtin_amdgcn_s_setprio(1);
  phase_final(p, smem);
  __builtin_amdgcn_s_setprio(0);
#if PROBE
  gsync(grid);
  probe_f3(p);
#endif
}

extern "C" void kernel_launch(void* const* d_in, const int* in_sizes, int n_in, void* d_out, int out_size, void* d_ws, size_t ws_size,
                              hipStream_t stream) {
  static int grid_blocks = 0;
  if (!grid_blocks) {
    int dev = 0, cus = 0, per_cu = 0;
    hipGetDevice(&dev);
    hipDeviceGetAttribute(&cus, hipDeviceAttributeMultiprocessorCount, dev);
    hipOccupancyMaxActiveBlocksPerMultiprocessor(&per_cu, fwd_megakernel, NTH, 0);
    if (per_cu < 1) fprintf(stderr, "occupancy query says %d blocks/CU\n", per_cu);
    grid_blocks = cus > 0 ? cus : 256;
    if (ws_size < WS_END) fprintf(stderr, "workspace too small: %zu < %zu\n", ws_size, (size_t)WS_END);
  }
  Params p{};
  const float** fp = (const float**)&p;
  for (int i = 0; i < 27; ++i) fp[i] = (const float*)d_in[i];
  p.out = (float*)d_out;
  p.ws = (unsigned char*)d_ws;
  void* args[] = {&p};
  hipError_t e = hipLaunchCooperativeKernel((void*)fwd_megakernel, dim3(grid_blocks), dim3(NTH), args, 0, stream);
  if (e != hipSuccess) fprintf(stderr, "cooperative launch failed: %s (grid %d)\n", hipGetErrorString(e), grid_blocks);
}
```

```cpp
#include <hip/hip_runtime.h>
#include <hip/hip_cooperative_groups.h>
#include <stdint.h>
#include <cstdio>
namespace cg = cooperative_groups;

#define PROBE 0
#define DI __device__ __forceinline__
typedef __attribute__((ext_vector_type(8))) short bf16x8;
typedef __attribute__((ext_vector_type(16))) float f32x16;
typedef __attribute__((ext_vector_type(16))) uint32_t u32x16;
typedef __attribute__((ext_vector_type(2))) _Float16 h2;
typedef __attribute__((ext_vector_type(2))) __bf16 b2;
typedef unsigned short ushort_t;
typedef __attribute__((ext_vector_type(4))) uint32_t u32x4;
#define MFMA(a, b, c) __builtin_amdgcn_mfma_f32_32x32x16_bf16((a), (b), (c), 0, 0, 0)

constexpr int DM = 1024, NB = 2, SEQ = 16384, CTXL = 256;
constexpr int NX = NB * SEQ, NC = NB * CTXL, NT = NX + NC;
constexpr int INW = 3584, LTOT = CTXL + SEQ;
constexpr int NTH = 512;
constexpr int CH = 260, NCHUNK = LTOT / CH;
static_assert(NCHUNK * CH == LTOT, "chunking");
constexpr float LN_EPS = 1e-5f, QK_EPS = 1e-6f, GN_EPS = 64e-5f;
constexpr float ALPHA = 1.189207115002721f;
constexpr float QSCALE = 0.125f * 1.4426950408889634f;

constexpr size_t OFF_WIN = 0;
constexpr size_t OFF_WMG = OFF_WIN + (size_t)INW * DM * 2;
constexpr size_t OFF_WPA = OFF_WMG + (size_t)2048 * DM * 2;
constexpr size_t OFF_WPB = OFF_WPA + (size_t)1024 * 512 * 2;
constexpr size_t OFF_WO  = OFF_WPB + (size_t)1024 * 512 * 2;
constexpr size_t OFF_WL  = OFF_WO + (size_t)1024 * 1024 * 2;
constexpr size_t OFF_MOD = OFF_WL + (size_t)2 * 2 * 512 * 64 * 2;
constexpr size_t OFF_ZG  = OFF_MOD + 36864;
constexpr size_t OFF_QB  = OFF_ZG + (size_t)NX * 1024 * 2;
constexpr size_t OFF_KB  = OFF_QB + (size_t)NX * 512 * 2;
constexpr size_t OFF_VB  = OFF_KB + (size_t)NB * 2 * LTOT * 64 * 2;
constexpr size_t OFF_SH  = OFF_VB + (size_t)NB * 2 * LTOT * 64 * 2;
constexpr size_t OFF_DR  = OFF_SH + (size_t)16 * LTOT * 192 * 2;
constexpr size_t OFF_ZQ  = OFF_DR + (size_t)32 * LTOT * 192 * 2;
constexpr size_t WS_END  = OFF_ZQ + (size_t)2 * NX * 512 * 2;
static_assert(WS_END <= (size_t)536870912, "workspace");
static_assert((size_t)NT * DM * 2 <= (size_t)48 * LTOT * 192 * 2, "H alias");
static_assert((size_t)NT * 768 * 2 <= (size_t)2 * NX * 512 * 2, "zqkv alias");

struct Params {
  const float *x, *c, *ctx, *c_ctx, *w_ada, *b_ada, *w_in, *q_norm, *k_norm, *mu_prev, *mu_next, *w0, *w_up, *a0, *a_up, *k_k, *k_a,
      *r_k, *gn_w, *gn_b, *w_pa, *w_pb, *w_mg, *b_mg, *w_o, *ln_g, *ln_b;
  float* out;
  unsigned char* ws;
};

DI ushort_t f2bf(float f) { return __builtin_bit_cast(ushort_t, (__bf16)f); }
DI float bf2f(ushort_t b) { return __uint_as_float(((unsigned)b) << 16); }
DI unsigned pack_bf2(float a, float b) { b2 v = {(__bf16)a, (__bf16)b}; return __builtin_bit_cast(unsigned, v); }
DI unsigned pack_h2(float a, float b) { h2 v = {(_Float16)a, (_Float16)b}; return __builtin_bit_cast(unsigned, v); }
DI ushort_t f2h(float f) { return __builtin_bit_cast(ushort_t, (_Float16)f); }
DI float h2f(ushort_t h) { return (float)__builtin_bit_cast(_Float16, h); }
DI float bflo(unsigned u) { return __uint_as_float(u << 16); }
DI float bfhi(unsigned u) { return __uint_as_float(u & 0xffff0000u); }
DI float hlo(unsigned u) { return (float)__builtin_bit_cast(h2, u)[0]; }
DI float hhi(unsigned u) { return (float)__builtin_bit_cast(h2, u)[1]; }
DI float sigmf(float v) { return __builtin_amdgcn_rcpf(1.f + __expf(-v)); }
DI float siluf(float v) { return v * sigmf(v); }
DI int crow(int reg, int h) { return (reg & 3) + 8 * (reg >> 2) + 4 * h; }
DI float wave_sum(float v) {
#pragma unroll
  for (int o = 32; o >= 1; o >>= 1) v += __shfl_xor(v, o, 64);
  return v;
}
DI float sum16(float v) {
#pragma unroll
  for (int o = 8; o >= 1; o >>= 1) v += __shfl_xor(v, o, 64);
  return v;
}
DI float ln_rows4(const float* src, int l16, float4 (&v)[16]) {
  float s = 0.f;
#pragma unroll
  for (int i = 0; i < 16; ++i) { v[i] = *(const float4*)(src + l16 * 4 + 64 * i); s += v[i].x + v[i].y + v[i].z + v[i].w; }
  const float mu = sum16(s) * (1.f / DM);
  float q = 0.f;
#pragma unroll
  for (int i = 0; i < 16; ++i) { v[i].x -= mu; v[i].y -= mu; v[i].z -= mu; v[i].w -= mu; q += v[i].x * v[i].x + v[i].y * v[i].y + v[i].z * v[i].z + v[i].w * v[i].w; }
  return rsqrtf(sum16(q) * (1.f / DM) + LN_EPS);
}
DI f32x16 zero16() { f32x16 z;
#pragma unroll
  for (int i = 0; i < 16; ++i) z[i] = 0.f; return z; }

#define SCAN_VLOAD 0
#define PROBE_NAIVE_SCAN 0
#if SCAN_VLOAD
DI void sload2(u32x16& a0, u32x16& a1, const void* p) { a0 = *(const u32x16*)p; a1 = *((const u32x16*)p + 1); }
DI void sload4(u32x16& a0, u32x16& a1, u32x16& b0, u32x16& b1, const void* p, const void* q) {
  a0 = *(const u32x16*)p; a1 = *((const u32x16*)p + 1); b0 = *(const u32x16*)q; b1 = *((const u32x16*)q + 1);
}
#else
DI void sload2(u32x16& a0, u32x16& a1, const void* p) {
  asm volatile("s_load_dwordx16 %0, %2, 0x0\n\ts_load_dwordx16 %1, %2, 0x40\n\ts_waitcnt lgkmcnt(0)" : "=&s"(a0), "=&s"(a1) : "s"(p) : "memory");
}
DI void sload4(u32x16& a0, u32x16& a1, u32x16& b0, u32x16& b1, const void* p, const void* q) {
  asm volatile("s_load_dwordx16 %0, %4, 0x0\n\ts_load_dwordx16 %1, %4, 0x40\n\ts_load_dwordx16 %2, %5, 0x0\n\ts_load_dwordx16 %3, %5, 0x40\n\ts_waitcnt lgkmcnt(0)"
               : "=&s"(a0), "=&s"(a1), "=&s"(b0), "=&s"(b1) : "s"(p), "s"(q) : "memory");
}
#endif
DI float HV(const u32x16& v, int j) { const uint32_t w = v[j >> 1]; const h2 t = __builtin_bit_cast(h2, w); return (float)t[j & 1]; }

constexpr int LDK = 72;
template <int BM, int BN, int MI, int NI, int NB, class AL, class BL>
DI void gemm_pass(f32x16 (&acc)[NB][MI][NI], AL aload, BL bload, int K, ushort_t* As, ushort_t* Bs, int wrow0, int wcol0, int tid) {
  constexpr int NA = BM * 8 / NTH, NBC = BN * 8 / NTH;
  constexpr int ASZ = BM * LDK, BSZ = NB * BN * LDK;
  const int lane = tid & 63, l31 = lane & 31, hh = lane >> 5;
  const int nk = K >> 6;
  uint4 ra[2][NA], rb[2][NB][NBC];
  auto gload = [&](int s, int kt) {
#pragma unroll
    for (int i = 0; i < NA; ++i) { const int id = tid + i * NTH; ra[s][i] = aload(id >> 3, kt * 64 + (id & 7) * 8); }
#pragma unroll
    for (int w = 0; w < NB; ++w)
#pragma unroll
      for (int i = 0; i < NBC; ++i) { const int id = tid + i * NTH; rb[s][w][i] = bload(w, id >> 3, kt * 64 + (id & 7) * 8); }
  };
  auto lstore = [&](int s, int buf) {
#pragma unroll
    for (int i = 0; i < NA; ++i) { const int id = tid + i * NTH; *(uint4*)&As[buf * ASZ + (id >> 3) * LDK + (id & 7) * 8] = ra[s][i]; }
#pragma unroll
    for (int w = 0; w < NB; ++w)
#pragma unroll
      for (int i = 0; i < NBC; ++i) { const int id = tid + i * NTH; *(uint4*)&Bs[buf * BSZ + w * BN * LDK + (id >> 3) * LDK + (id & 7) * 8] = rb[s][w][i]; }
  };
  auto compute = [&](int buf) {
#pragma unroll
    for (int ks = 0; ks < 4; ++ks) {
      bf16x8 af[MI];
#pragma unroll
      for (int mi = 0; mi < MI; ++mi) af[mi] = *(const bf16x8*)&As[buf * ASZ + (wrow0 + mi * 32 + l31) * LDK + ks * 16 + hh * 8];
#pragma unroll
      for (int w = 0; w < NB; ++w) {
        bf16x8 bfv[NI];
#pragma unroll
        for (int ni = 0; ni < NI; ++ni) bfv[ni] = *(const bf16x8*)&Bs[buf * BSZ + w * BN * LDK + (wcol0 + ni * 32 + l31) * LDK + ks * 16 + hh * 8];
#pragma unroll
        for (int mi = 0; mi < MI; ++mi)
#pragma unroll
          for (int ni = 0; ni < NI; ++ni) acc[w][mi][ni] = MFMA(af[mi], bfv[ni], acc[w][mi][ni]);
      }
    }
  };
  __syncthreads();
  gload(0, 0);
  lstore(0, 0);
  gload(1, 1);
  gload(0, 2);
#pragma unroll 1
  for (int kt = 0; kt < nk; kt += 2) {
    __syncthreads();
    lstore(1, 1);
    if (kt + 3 < nk) gload(1, kt + 3);
    compute(0);
    __syncthreads();
    if (kt + 2 < nk) { lstore(0, 0); if (kt + 4 < nk) gload(0, kt + 4); }
    compute(1);
  }
}

DI void transpose_tile(const float* __restrict__ src, int ld_src, ushort_t* dst, int ld_dst, int k0, int n0, float* T) {
  const int tid = threadIdx.x;
#pragma unroll
  for (int i = 0; i < 2; ++i) {
    const int k = (tid >> 4) + 32 * i, n4 = (tid & 15) * 4;
    const float4 v = *(const float4*)(src + (size_t)(k0 + k) * ld_src + n0 + n4);
    T[k * 65 + n4 + 0] = v.x; T[k * 65 + n4 + 1] = v.y; T[k * 65 + n4 + 2] = v.z; T[k * 65 + n4 + 3] = v.w;
  }
  __syncthreads();
  const int n = tid >> 3, kc = tid & 7;
  uint4 o;
  o.x = pack_bf2(T[(kc * 8 + 0) * 65 + n], T[(kc * 8 + 1) * 65 + n]);
  o.y = pack_bf2(T[(kc * 8 + 2) * 65 + n], T[(kc * 8 + 3) * 65 + n]);
  o.z = pack_bf2(T[(kc * 8 + 4) * 65 + n], T[(kc * 8 + 5) * 65 + n]);
  o.w = pack_bf2(T[(kc * 8 + 6) * 65 + n], T[(kc * 8 + 7) * 65 + n]);
  *(uint4*)(dst + (size_t)(n0 + n) * ld_dst + k0 + kc * 8) = o;
  __syncthreads();
}

DI void phase0(const Params& p, unsigned char* smem) {
  float* T = (float*)smem;
  ushort_t* win = (ushort_t*)(p.ws + OFF_WIN);
  ushort_t* wmg = (ushort_t*)(p.ws + OFF_WMG);
  ushort_t* wpa = (ushort_t*)(p.ws + OFF_WPA);
  ushort_t* wpb = (ushort_t*)(p.ws + OFF_WPB);
  ushort_t* wo = (ushort_t*)(p.ws + OFF_WO);
  ushort_t* wl = (ushort_t*)(p.ws + OFF_WL);
  float* mod = (float*)(p.ws + OFF_MOD);
  constexpr int T_IN = 16 * 56, T_MG = 16 * 32, T_PA = 8 * 16, T_PB = 8 * 16, T_O = 16 * 16, T_L = 32, T_MOD = 48;
  constexpr int TOTAL = T_MOD + T_IN + T_MG + T_PA + T_PB + T_O + T_L;
  for (int t = blockIdx.x; t < TOTAL; t += gridDim.x) {
    int u = t;
    if (u < T_MOD) {
      float* sil = T;
      float* red = T + 3072;
      const int tid = threadIdx.x;
      for (int i = tid; i < 3072; i += NTH) {
        const int v = i >> 10, k = i & 1023;
        const float cv = (v < 2) ? p.c[v * 1024 + k] : p.c_ctx[k];
        sil[i] = siluf(cv);
      }
      __syncthreads();
      const int n = tid & 63, ksl = tid >> 6, n0 = u * 64;
      float a0 = 0.f, a1 = 0.f, a2 = 0.f;
      for (int k = ksl * 128; k < ksl * 128 + 128; ++k) {
        const float w = p.w_ada[(size_t)k * 3072 + n0 + n];
        a0 = fmaf(sil[k], w, a0); a1 = fmaf(sil[1024 + k], w, a1); a2 = fmaf(sil[2048 + k], w, a2);
      }
      red[(ksl * 3 + 0) * 64 + n] = a0; red[(ksl * 3 + 1) * 64 + n] = a1; red[(ksl * 3 + 2) * 64 + n] = a2;
      __syncthreads();
      if (tid < 192) {
        const int v = tid >> 6, nn = tid & 63;
        float s = 0.f;
#pragma unroll
        for (int q = 0; q < 8; ++q) s += red[(q * 3 + v) * 64 + nn];
        mod[v * 3072 + n0 + nn] = s + p.b_ada[n0 + nn];
      }
      __syncthreads();
      continue;
    }
    u -= T_MOD;
    if (u < T_IN) { transpose_tile(p.w_in, INW, win, 1024, (u / 56) * 64, (u % 56) * 64, T); continue; }
    u -= T_IN;
    if (u < T_MG) { transpose_tile(p.w_mg, 2048, wmg, 1024, (u / 32) * 64, (u % 32) * 64, T); continue; }
    u -= T_MG;
    if (u < T_PA) { transpose_tile(p.w_pa, 1024, wpa, 512, (u / 16) * 64, (u % 16) * 64, T); continue; }
    u -= T_PA;
    if (u < T_PB) { transpose_tile(p.w_pb, 1024, wpb, 512, (u / 16) * 64, (u % 16) * 64, T); continue; }
    u -= T_PB;
    if (u < T_O) { transpose_tile(p.w_o, 1024, wo, 1024, (u / 16) * 64, (u % 16) * 64, T); continue; }
    u -= T_O;
    {
      const int which = u >> 4, dir = (u >> 3) & 1, nt = u & 7;
      const float* src = (which ? p.a_up : p.w_up) + (size_t)dir * 64 * 512;
      transpose_tile(src, 512, wl + (size_t)((dir * 2 + which) * 512) * 64, 64, 0, nt * 64, T);
    }
  }
}

DI void phase_h(const Params& p) {
  const float* mod = (const float*)(p.ws + OFF_MOD);
  ushort_t* H = (ushort_t*)(p.ws + OFF_SH);
  const int lane = threadIdx.x & 63, l16 = lane & 15, gw = blockIdx.x * 8 + (threadIdx.x >> 6);
#pragma unroll 1
  for (int r4 = gw * 4; r4 < NT; r4 += gridDim.x * 32) {
    const int row = r4 + (lane >> 4);
    const float* src = (row < NX) ? p.x + (size_t)row * DM : p.ctx + (size_t)(row - NX) * DM;
    const float* md = mod + ((row < NX) ? (row / SEQ) : 2) * 3072;
    float4 v[16];
    const float rstd = ln_rows4(src, l16, v);
#pragma unroll
    for (int i = 0; i < 16; ++i) {
      const int col = l16 * 4 + 64 * i;
      const float4 sh = *(const float4*)(md + col), sc = *(const float4*)(md + 1024 + col);
      uint2 o;
      o.x = pack_bf2(v[i].x * rstd * (1.f + sc.x) + sh.x, v[i].y * rstd * (1.f + sc.y) + sh.y);
      o.y = pack_bf2(v[i].z * rstd * (1.f + sc.z) + sh.z, v[i].w * rstd * (1.f + sc.w) + sh.w);
      *(uint2*)(H + (size_t)row * DM + col) = o;
    }
  }
}

DI void phase_gemm1(const Params& p, unsigned char* smem) {
  ushort_t* As = (ushort_t*)smem;
  ushort_t* Bs = As + 2 * 256 * LDK;
  const ushort_t* H = (const ushort_t*)(p.ws + OFF_SH);
  const ushort_t* W = (const ushort_t*)(p.ws + OFF_WIN);
  ushort_t* zq = (ushort_t*)(p.ws + OFF_ZQ);
  ushort_t* zg = (ushort_t*)(p.ws + OFF_ZG);
  ushort_t* zm = (ushort_t*)p.out;
  const int tid = threadIdx.x, wave = tid >> 6, lane = tid & 63, l31 = lane & 31, hh = lane >> 5;
  const int wrow0 = (wave & 3) * 64, wcol0 = (wave >> 2) * 64;
  constexpr int MT = NT / 256, NTL = INW / 128;
  for (int t = blockIdx.x; t < MT * NTL; t += gridDim.x) {
    const int mt = t / NTL, nt = t % NTL;
    const bool is_g = (nt >= 6 && nt < 10) || nt >= 24;
    if (is_g && mt >= NX / 256) continue;
    const int row0 = mt * 256, col0 = nt * 128;
    f32x16 acc[1][2][2];
#pragma unroll
    for (int a = 0; a < 2; ++a)
#pragma unroll
      for (int b = 0; b < 2; ++b) acc[0][a][b] = zero16();
    auto aload = [&](int r, int k) { return *(const uint4*)(H + (size_t)(row0 + r) * DM + k); };
    auto bload = [&](int w, int n, int k) { return *(const uint4*)(W + (size_t)(col0 + n) * DM + k); };
    gemm_pass<256, 128, 2, 2, 1>(acc, aload, bload, DM, As, Bs, wrow0, wcol0, tid);
    ushort_t* dst; int ld, cbase;
    if (nt < 6) { dst = zq; ld = 768; cbase = col0; }
    else if (nt < 10) { dst = zg; ld = 1024; cbase = col0 - 768; }
    else if (nt < 24) { dst = zm; ld = 1792; cbase = col0 - 1280; }
    else { dst = zg; ld = 1024; cbase = 512 + col0 - 3072; }
#pragma unroll
    for (int mi = 0; mi < 2; ++mi)
#pragma unroll
      for (int ni = 0; ni < 2; ++ni)
#pragma unroll
        for (int i = 0; i < 16; ++i) {
          const int row = row0 + wrow0 + mi * 32 + crow(i, hh), col = cbase + wcol0 + ni * 32 + l31;
          dst[(size_t)row * ld + col] = f2bf(acc[0][mi][ni][i]);
        }
  }
}

DI int vperm(int key) { const int g = key >> 4, kq = key & 15; return g * 16 + 8 * ((kq >> 2) & 1) + (kq & 3) + 4 * (kq >> 3); }
DI void phase_qkv(const Params& p) {
  const ushort_t* zq = (const ushort_t*)(p.ws + OFF_ZQ);
  ushort_t* QB = (ushort_t*)(p.ws + OFF_QB);
  ushort_t* KB = (ushort_t*)(p.ws + OFF_KB);
  ushort_t* VB = (ushort_t*)(p.ws + OFF_VB);
  const int lane = threadIdx.x & 63, gw = blockIdx.x * 8 + (threadIdx.x >> 6);
  const int j = lane & 31, half = lane >> 5, axis = j >> 4, f = j & 15;
  const int d1 = axis * 32 + f, d2 = d1 + 16;
  const float inv = powf(10000.f, -(float)f * (1.f / 16.f));
  const float gq1 = p.q_norm[d1], gq2 = p.q_norm[d2], gk1 = p.k_norm[d1], gk2 = p.k_norm[d2];
  for (int row = gw; row < NT; row += gridDim.x * 8) {
    const bool isx = row < NX;
    const int b = isx ? row / SEQ : (row - NX) / CTXL;
    const int t = isx ? row % SEQ : (row - NX) % CTXL;
    const int pos = isx ? CTXL + t : t;
    const ushort_t* z = zq + (size_t)row * 768;
    float cs = 1.f, sn = 0.f;
    if (isx) { const float ang = (float)(axis ? (t & 63) : (t >> 6)) * inv; sincosf(ang, &sn, &cs); }
#pragma unroll
    for (int it = 0; it < 5; ++it) {
      const int hd = it * 2 + half;
      if (!isx && hd < 8) continue;
      const float v1 = bf2f(z[hd * 64 + d1]), v2 = bf2f(z[hd * 64 + d2]);
      float ss = v1 * v1 + v2 * v2;
#pragma unroll
      for (int o = 16; o >= 1; o >>= 1) ss += __shfl_xor(ss, o, 64);
      const float rms = rsqrtf(ss * (1.f / 64.f) + QK_EPS);
      const bool isq = hd < 8;
      const float y1 = v1 * rms * (isq ? gq1 : gk1), y2 = v2 * rms * (isq ? gq2 : gk2);
      float o1 = y1 * cs - y2 * sn, o2 = y2 * cs + y1 * sn;
      if (isq) {
        ushort_t* dst = QB + ((size_t)(b * 8 + hd) * SEQ + t) * 64;
        dst[d1] = f2bf(o1 * QSCALE); dst[d2] = f2bf(o2 * QSCALE);
      } else {
        ushort_t* dst = KB + ((size_t)(b * 2 + (hd - 8)) * LTOT + pos) * 64;
        dst[d1] = f2bf(o1); dst[d2] = f2bf(o2);
      }
    }
    {
      const size_t tb = (size_t)(pos >> 6) * 4096 + lane * 64 + vperm(pos & 63);
      VB[(size_t)(b * 2 + 0) * LTOT * 64 + tb] = z[640 + lane];
      VB[(size_t)(b * 2 + 1) * LTOT * 64 + tb] = z[704 + lane];
    }
  }
}

DI void phase_rwkv_prep(const Params& p, unsigned char* smem) {
  float* kbuf = (float*)smem;
  ushort_t* codes = (ushort_t*)(smem + 65536);
  float* invn = (float*)(smem + 65536 + 32 * 264 * 2);
  const ushort_t* zm = (const ushort_t*)p.out;
  const ushort_t* WL = (const ushort_t*)(p.ws + OFF_WL);
  ushort_t* SH = (ushort_t*)(p.ws + OFF_SH);
  ushort_t* DR = (ushort_t*)(p.ws + OFF_DR);
  const int tid = threadIdx.x, wave = tid >> 6, lane = tid & 63, l31 = lane & 31, hh = lane >> 5;
  for (int tt = blockIdx.x; tt < NT / 32; tt += gridDim.x) {
    const int row0 = tt * 32;
    int b, t0, len, pbase;
    if (row0 < NX) { b = row0 / SEQ; t0 = row0 % SEQ; len = SEQ; pbase = CTXL; }
    else { const int rc = row0 - NX; b = rc / CTXL; t0 = rc % CTXL; len = CTXL; pbase = 0; }
    __syncthreads();
    for (int id = tid; id < 32 * 224; id += NTH) {
      const int i = id / 224, c0 = (id % 224) * 8;
      const int t = t0 + i;
      const ushort_t* zr = zm + (size_t)(row0 + i) * 1792 + c0;
      const uint4 zc = *(const uint4*)zr;
      uint4 zp = make_uint4(0, 0, 0, 0), zn = make_uint4(0, 0, 0, 0);
      if (t > 0) zp = *(const uint4*)(zr - 1792);
      if (t < len - 1) zn = *(const uint4*)(zr + 1792);
      const float4 mp0 = *(const float4*)(p.mu_prev + c0), mp1 = *(const float4*)(p.mu_prev + c0 + 4);
      const float4 mn0 = *(const float4*)(p.mu_next + c0), mn1 = *(const float4*)(p.mu_next + c0 + 4);
      const unsigned zcw[4] = {zc.x, zc.y, zc.z, zc.w}, zpw[4] = {zp.x, zp.y, zp.z, zp.w}, znw[4] = {zn.x, zn.y, zn.z, zn.w};
      const float mpv[8] = {mp0.x, mp0.y, mp0.z, mp0.w, mp1.x, mp1.y, mp1.z, mp1.w};
      const float mnv[8] = {mn0.x, mn0.y, mn0.z, mn0.w, mn1.x, mn1.y, mn1.z, mn1.w};
      float s[8];
#pragma unroll
      for (int q = 0; q < 4; ++q) {
        const float c_lo = bflo(zcw[q]), c_hi = bfhi(zcw[q]);
        s[2 * q] = c_lo + mpv[2 * q] * (bflo(zpw[q]) - c_lo) + mnv[2 * q] * (bflo(znw[q]) - c_lo);
        s[2 * q + 1] = c_hi + mpv[2 * q + 1] * (bfhi(zpw[q]) - c_hi) + mnv[2 * q + 1] * (bfhi(znw[q]) - c_hi);
      }
      const int pp = pbase + t;
      if (c0 < 512 || (c0 >= 1024 && c0 < 1536)) {
        const int cc = (c0 < 512) ? c0 : c0 - 1024, which = (c0 < 512) ? 1 : 2;
        const int head = cc >> 6, d = cc & 63;
        uint4 o;
        o.x = pack_h2(s[0], s[1]); o.y = pack_h2(s[2], s[3]); o.z = pack_h2(s[4], s[5]); o.w = pack_h2(s[6], s[7]);
        *(uint4*)(SH + (((size_t)(b * 8 + head) * LTOT + pp) * 3 + which) * 64 + d) = o;
      } else if (c0 < 1024) {
        float* kd = kbuf + i * 512 + (c0 - 512);
        *(float4*)kd = make_float4(s[0], s[1], s[2], s[3]);
        *(float4*)(kd + 4) = make_float4(s[4], s[5], s[6], s[7]);
      } else {
        const int cc = c0 - 1536;
        if (cc < 128) {
#pragma unroll
          for (int q = 0; q < 8; ++q) s[q] = tanhf(s[q]);
        }
        uint4 o;
        o.x = pack_bf2(s[0], s[1]); o.y = pack_bf2(s[2], s[3]); o.z = pack_bf2(s[4], s[5]); o.w = pack_bf2(s[6], s[7]);
        *(uint4*)(codes + i * 264 + cc) = o;
      }
    }
    __syncthreads();
    {
      const int i = tid >> 4, head = (tid >> 1) & 7, hf = tid & 1;
      float ss = 0.f;
#pragma unroll 8
      for (int q = 0; q < 32; ++q) {
        const int n = head * 64 + hf * 32 + q;
        const float v = kbuf[i * 512 + n] * p.k_k[n];
        ss = fmaf(v, v, ss);
      }
      ss += __shfl_xor(ss, 1, 64);
      if (hf == 0) invn[i * 8 + head] = 1.f / fmaxf(sqrtf(ss), 1e-12f);
    }
    __syncthreads();
#pragma unroll 1
    for (int q4 = 0; q4 < 4; ++q4) {
      const int pr = wave * 4 + q4, dir = pr >> 4, ct = pr & 15;
      f32x16 aw = zero16(), aa = zero16();
#pragma unroll
      for (int ks = 0; ks < 4; ++ks) {
        const bf16x8 fw = *(const bf16x8*)&codes[l31 * 264 + dir * 64 + ks * 16 + hh * 8];
        const bf16x8 fa = *(const bf16x8*)&codes[l31 * 264 + 128 + dir * 64 + ks * 16 + hh * 8];
        const bf16x8 bw = *(const bf16x8*)&WL[(size_t)((dir * 2 + 0) * 512 + ct * 32 + l31) * 64 + ks * 16 + hh * 8];
        const bf16x8 ba = *(const bf16x8*)&WL[(size_t)((dir * 2 + 1) * 512 + ct * 32 + l31) * 64 + ks * 16 + hh * 8];
        aw = MFMA(fw, bw, aw);
        aa = MFMA(fa, ba, aa);
      }
      const int n = ct * 32 + l31, head = n >> 6, d = n & 63;
      const float w0v = p.w0[dir * 512 + n], a0v = p.a0[dir * 512 + n], kkw = p.k_k[n], kaw = p.k_a[n];
      const size_t cbase = (size_t)(b * 8 + head) * LTOT;
#pragma unroll
      for (int i = 0; i < 16; ++i) {
        const int ti = crow(i, hh);
        const int pp = pbase + t0 + ti;
        const float wpre = aw[i] + w0v;
        const float e = 0.60653065971263342f * sigmf(wpre);
        const float xdec = 1.f - __expf(-e);
        const float a = sigmf(aa[i] + a0v);
        const float kv = kbuf[ti * 512 + n];
        const float kkv = kv * kkw * invn[ti * 8 + head];
        const float kd = kv * (1.f + (a - 1.f) * kaw);
        ushort_t* dr = DR + ((((size_t)dir * 16) * LTOT + cbase + pp) * 3) * 64 + d;
        dr[0] = f2h(-xdec); dr[64] = f2h(kd); dr[128] = f2h(kkv * a);
        if (dir == 0) SH[((cbase + pp) * 3) * 64 + d] = f2h(kkv);
      }
    }
  }
}

DI int tau_to_pos(int dir, int tau) { return dir == 0 ? tau : (tau < CTXL ? CTXL - 1 - tau : LTOT - 1 - (tau - CTXL)); }


DI void fm_lo(float& acc, float a, uint32_t w) { asm("v_fma_mix_f32 %0, %1, %2, %0 op_sel_hi:[0,1,0]" : "+v"(acc) : "v"(a), "s"(w)); }
DI void fm_hi(float& acc, float a, uint32_t w) { asm("v_fma_mix_f32 %0, %1, %2, %0 op_sel:[0,1,0] op_sel_hi:[0,1,0]" : "+v"(acc) : "v"(a), "s"(w)); }
DI void fx_lo(float& s, uint32_t w) { asm("v_fma_mix_f32 %0, %0, %1, %0 op_sel_hi:[0,1,0]" : "+v"(s) : "s"(w)); }
DI void fx_hi(float& s, uint32_t w) { asm("v_fma_mix_f32 %0, %0, %1, %0 op_sel:[0,1,0] op_sel_hi:[0,1,0]" : "+v"(s) : "s"(w)); }
constexpr int PFD = 2, SEG = 65;
static_assert(CH % SEG == 0, "segments");
DI void scan_prefetch(uint32_t& pfr, const ushort_t* shc, const ushort_t* drc, int pos, int lane) {
  const ushort_t* a = (lane < 24) ? shc + (size_t)pos * 192 + lane * 8 : drc + (size_t)pos * 192 + (lane < 48 ? lane - 24 : 23) * 8;
  asm volatile("global_load_dword %0, %1, off" : "+v"(pfr) : "v"(a) : "memory");
}
DI void scan_stage_v(ushort_t* vbuf, const ushort_t* shc, int dir, int tau0, int lane) {
#pragma unroll
  for (int i = 0; i < (SEG * 8 + 63) / 64; ++i) {
    const int id = i * 64 + lane, st = id >> 3;
    if (st < SEG) *(uint4*)&vbuf[st * 64 + (id & 7) * 8] = *(const uint4*)(shc + (size_t)tau_to_pos(dir, tau0 + st) * 192 + 128 + (id & 7) * 8);
  }
}
struct ScanRec { uint32_t sh, dr, bb; ushort_t v; };
DI ScanRec scan_load(const ushort_t* shc, const ushort_t* drc, int pos, int lane) {
  ScanRec r;
  const ushort_t* s = shc + (size_t)pos * 192;
  const uint32_t* d = (const uint32_t*)(drc + (size_t)pos * 192);
  r.sh = ((const uint32_t*)s)[lane];
  r.v = s[128 + lane];
  r.dr = d[lane];
  r.bb = d[64 + (lane & 31)];
  return r;
}
#define MIXLO " op_sel_hi:[0,1,0]\n\t"
#define MIXHI " op_sel:[0,1,0] op_sel_hi:[0,1,0]\n\t"
template <int L>
DI void dot4(float& a0, float& a1, float& a2, float& a3, float (&S)[64], uint32_t src) {
  uint32_t t0, t1, t2, t3;
  asm("v_readlane_b32 %4, %8, %9\n\tv_readlane_b32 %5, %8, %10\n\tv_readlane_b32 %6, %8, %11\n\tv_readlane_b32 %7, %8, %12\n\t"
      "v_fma_mix_f32 %0, %13, %4, %0" MIXLO "v_fma_mix_f32 %1, %14, %4, %1" MIXHI
      "v_fma_mix_f32 %2, %15, %5, %2" MIXLO "v_fma_mix_f32 %3, %16, %5, %3" MIXHI
      "v_fma_mix_f32 %0, %17, %6, %0" MIXLO "v_fma_mix_f32 %1, %18, %6, %1" MIXHI
      "v_fma_mix_f32 %2, %19, %7, %2" MIXLO "v_fma_mix_f32 %3, %20, %7, %3" MIXHI
      : "+v"(a0), "+v"(a1), "+v"(a2), "+v"(a3), "=&s"(t0), "=&s"(t1), "=&s"(t2), "=&s"(t3)
      : "v"(src), "n"(L), "n"(L + 1), "n"(L + 2), "n"(L + 3),
        "v"(S[2 * (L & 31)]), "v"(S[2 * (L & 31) + 1]), "v"(S[2 * (L & 31) + 2]), "v"(S[2 * (L & 31) + 3]),
        "v"(S[2 * (L & 31) + 4]), "v"(S[2 * (L & 31) + 5]), "v"(S[2 * (L & 31) + 6]), "v"(S[2 * (L & 31) + 7]));
}
template <int L>
DI void upd4(float (&S)[64], uint32_t dr, uint32_t bb, float vv, float nsk) {
  uint32_t x0, x1, x2, x3, k0, k1, k2, k3, b0, b1, b2, b3;
  asm("v_readlane_b32 %8, %20, %22\n\tv_readlane_b32 %9, %20, %23\n\tv_readlane_b32 %10, %20, %24\n\tv_readlane_b32 %11, %20, %25\n\t"
      "v_readlane_b32 %12, %20, %26\n\tv_readlane_b32 %13, %20, %27\n\tv_readlane_b32 %14, %20, %28\n\tv_readlane_b32 %15, %20, %29\n\t"
      "v_readlane_b32 %16, %21, %22\n\tv_readlane_b32 %17, %21, %23\n\tv_readlane_b32 %18, %21, %24\n\tv_readlane_b32 %19, %21, %25\n\t"
      "v_fma_mix_f32 %0, %0, %8, %0" MIXLO "v_fma_mix_f32 %1, %1, %8, %1" MIXHI
      "v_fma_mix_f32 %2, %2, %9, %2" MIXLO "v_fma_mix_f32 %3, %3, %9, %3" MIXHI
      "v_fma_mix_f32 %4, %4, %10, %4" MIXLO "v_fma_mix_f32 %5, %5, %10, %5" MIXHI
      "v_fma_mix_f32 %6, %6, %11, %6" MIXLO "v_fma_mix_f32 %7, %7, %11, %7" MIXHI
      "v_fma_mix_f32 %0, %30, %12, %0" MIXLO "v_fma_mix_f32 %1, %30, %12, %1" MIXHI
      "v_fma_mix_f32 %2, %30, %13, %2" MIXLO "v_fma_mix_f32 %3, %30, %13, %3" MIXHI
      "v_fma_mix_f32 %4, %30, %14, %4" MIXLO "v_fma_mix_f32 %5, %30, %14, %5" MIXHI
      "v_fma_mix_f32 %6, %30, %15, %6" MIXLO "v_fma_mix_f32 %7, %30, %15, %7" MIXHI
      "v_fma_mix_f32 %0, %31, %16, %0" MIXLO "v_fma_mix_f32 %1, %31, %16, %1" MIXHI
      "v_fma_mix_f32 %2, %31, %17, %2" MIXLO "v_fma_mix_f32 %3, %31, %17, %3" MIXHI
      "v_fma_mix_f32 %4, %31, %18, %4" MIXLO "v_fma_mix_f32 %5, %31, %18, %5" MIXHI
      "v_fma_mix_f32 %6, %31, %19, %6" MIXLO "v_fma_mix_f32 %7, %31, %19, %7" MIXHI
      : "+v"(S[2 * L]), "+v"(S[2 * L + 1]), "+v"(S[2 * L + 2]), "+v"(S[2 * L + 3]), "+v"(S[2 * L + 4]), "+v"(S[2 * L + 5]), "+v"(S[2 * L + 6]), "+v"(S[2 * L + 7]),
        "=&s"(x0), "=&s"(x1), "=&s"(x2), "=&s"(x3), "=&s"(k0), "=&s"(k1), "=&s"(k2), "=&s"(k3), "=&s"(b0), "=&s"(b1), "=&s"(b2), "=&s"(b3)
      : "v"(dr), "v"(bb), "n"(L), "n"(L + 1), "n"(L + 2), "n"(L + 3), "n"(L + 32), "n"(L + 33), "n"(L + 34), "n"(L + 35), "v"(vv), "v"(nsk));
}
template <int L>
DI void dot4_2(float& a0, float& a1, float& c0, float& c1, float (&SU)[64], float (&SP)[64], uint32_t src) {
  uint32_t t0, t1, t2, t3;
  asm("v_readlane_b32 %4, %8, %9\n\tv_readlane_b32 %5, %8, %10\n\tv_readlane_b32 %6, %8, %11\n\tv_readlane_b32 %7, %8, %12\n\t"
      "v_fma_mix_f32 %0, %13, %4, %0" MIXLO "v_fma_mix_f32 %1, %14, %4, %1" MIXHI
      "v_fma_mix_f32 %2, %21, %4, %2" MIXLO "v_fma_mix_f32 %3, %22, %4, %3" MIXHI
      "v_fma_mix_f32 %0, %15, %5, %0" MIXLO "v_fma_mix_f32 %1, %16, %5, %1" MIXHI
      "v_fma_mix_f32 %2, %23, %5, %2" MIXLO "v_fma_mix_f32 %3, %24, %5, %3" MIXHI
      "v_fma_mix_f32 %0, %17, %6, %0" MIXLO "v_fma_mix_f32 %1, %18, %6, %1" MIXHI
      "v_fma_mix_f32 %2, %25, %6, %2" MIXLO "v_fma_mix_f32 %3, %26, %6, %3" MIXHI
      "v_fma_mix_f32 %0, %19, %7, %0" MIXLO "v_fma_mix_f32 %1, %20, %7, %1" MIXHI
      "v_fma_mix_f32 %2, %27, %7, %2" MIXLO "v_fma_mix_f32 %3, %28, %7, %3" MIXHI
      : "+v"(a0), "+v"(a1), "+v"(c0), "+v"(c1), "=&s"(t0), "=&s"(t1), "=&s"(t2), "=&s"(t3)
      : "v"(src), "n"(L), "n"(L + 1), "n"(L + 2), "n"(L + 3),
        "v"(SU[2 * L]), "v"(SU[2 * L + 1]), "v"(SU[2 * L + 2]), "v"(SU[2 * L + 3]), "v"(SU[2 * L + 4]), "v"(SU[2 * L + 5]), "v"(SU[2 * L + 6]), "v"(SU[2 * L + 7]),
        "v"(SP[2 * L]), "v"(SP[2 * L + 1]), "v"(SP[2 * L + 2]), "v"(SP[2 * L + 3]), "v"(SP[2 * L + 4]), "v"(SP[2 * L + 5]), "v"(SP[2 * L + 6]), "v"(SP[2 * L + 7]));
}
template <int L>
DI void upd4_2(float (&SU)[64], float (&SP)[64], uint32_t dr, uint32_t bb, float vv, float nskU, float nskP) {
  uint32_t x0, x1, x2, x3, k0, k1, k2, k3, b0, b1, b2, b3;
  asm("v_readlane_b32 %16, %28, %30\n\tv_readlane_b32 %17, %28, %31\n\tv_readlane_b32 %18, %28, %32\n\tv_readlane_b32 %19, %28, %33\n\t"
      "v_readlane_b32 %20, %28, %34\n\tv_readlane_b32 %21, %28, %35\n\tv_readlane_b32 %22, %28, %36\n\tv_readlane_b32 %23, %28, %37\n\t"
      "v_readlane_b32 %24, %29, %30\n\tv_readlane_b32 %25, %29, %31\n\tv_readlane_b32 %26, %29, %32\n\tv_readlane_b32 %27, %29, %33\n\t"
      "v_fma_mix_f32 %0, %0, %16, %0" MIXLO "v_fma_mix_f32 %1, %1, %16, %1" MIXHI
      "v_fma_mix_f32 %2, %2, %17, %2" MIXLO "v_fma_mix_f32 %3, %3, %17, %3" MIXHI
      "v_fma_mix_f32 %4, %4, %18, %4" MIXLO "v_fma_mix_f32 %5, %5, %18, %5" MIXHI
      "v_fma_mix_f32 %6, %6, %19, %6" MIXLO "v_fma_mix_f32 %7, %7, %19, %7" MIXHI
      "v_fma_mix_f32 %8, %8, %16, %8" MIXLO "v_fma_mix_f32 %9, %9, %16, %9" MIXHI
      "v_fma_mix_f32 %10, %10, %17, %10" MIXLO "v_fma_mix_f32 %11, %11, %17, %11" MIXHI
      "v_fma_mix_f32 %12, %12, %18, %12" MIXLO "v_fma_mix_f32 %13, %13, %18, %13" MIXHI
      "v_fma_mix_f32 %14, %14, %19, %14" MIXLO "v_fma_mix_f32 %15, %15, %19, %15" MIXHI
      "v_fma_mix_f32 %0, %38, %20, %0" MIXLO "v_fma_mix_f32 %1, %38, %20, %1" MIXHI
      "v_fma_mix_f32 %2, %38, %21, %2" MIXLO "v_fma_mix_f32 %3, %38, %21, %3" MIXHI
      "v_fma_mix_f32 %4, %38, %22, %4" MIXLO "v_fma_mix_f32 %5, %38, %22, %5" MIXHI
      "v_fma_mix_f32 %6, %38, %23, %6" MIXLO "v_fma_mix_f32 %7, %38, %23, %7" MIXHI
      "v_fma_mix_f32 %0, %39, %24, %0" MIXLO "v_fma_mix_f32 %1, %39, %24, %1" MIXHI
      "v_fma_mix_f32 %2, %39, %25, %2" MIXLO "v_fma_mix_f32 %3, %39, %25, %3" MIXHI
      "v_fma_mix_f32 %4, %39, %26, %4" MIXLO "v_fma_mix_f32 %5, %39, %26, %5" MIXHI
      "v_fma_mix_f32 %6, %39, %27, %6" MIXLO "v_fma_mix_f32 %7, %39, %27, %7" MIXHI
      "v_fma_mix_f32 %8, %40, %24, %8" MIXLO "v_fma_mix_f32 %9, %40, %24, %9" MIXHI
      "v_fma_mix_f32 %10, %40, %25, %10" MIXLO "v_fma_mix_f32 %11, %40, %25, %11" MIXHI
      "v_fma_mix_f32 %12, %40, %26, %12" MIXLO "v_fma_mix_f32 %13, %40, %26, %13" MIXHI
      "v_fma_mix_f32 %14, %40, %27, %14" MIXLO "v_fma_mix_f32 %15, %40, %27, %15" MIXHI
      : "+v"(SU[2 * L]), "+v"(SU[2 * L + 1]), "+v"(SU[2 * L + 2]), "+v"(SU[2 * L + 3]), "+v"(SU[2 * L + 4]), "+v"(SU[2 * L + 5]), "+v"(SU[2 * L + 6]), "+v"(SU[2 * L + 7]),
        "+v"(SP[2 * L]), "+v"(SP[2 * L + 1]), "+v"(SP[2 * L + 2]), "+v"(SP[2 * L + 3]), "+v"(SP[2 * L + 4]), "+v"(SP[2 * L + 5]), "+v"(SP[2 * L + 6]), "+v"(SP[2 * L + 7]),
        "=&s"(x0), "=&s"(x1), "=&s"(x2), "=&s"(x3), "=&s"(k0), "=&s"(k1), "=&s"(k2), "=&s"(k3), "=&s"(b0), "=&s"(b1), "=&s"(b2), "=&s"(b3)
      : "v"(dr), "v"(bb), "n"(L), "n"(L + 1), "n"(L + 2), "n"(L + 3), "n"(L + 32), "n"(L + 33), "n"(L + 34), "n"(L + 35), "v"(vv), "v"(nskU), "v"(nskP));
}
DI void scan_step2(float (&SU)[64], float (&SP)[64], const ScanRec& c, float vv) {
  float a0 = 0.f, a1 = 0.f, c0 = 0.f, c1 = 0.f;
  dot4_2<0>(a0, a1, c0, c1, SU, SP, c.sh); dot4_2<4>(a0, a1, c0, c1, SU, SP, c.sh); dot4_2<8>(a0, a1, c0, c1, SU, SP, c.sh); dot4_2<12>(a0, a1, c0, c1, SU, SP, c.sh);
  dot4_2<16>(a0, a1, c0, c1, SU, SP, c.sh); dot4_2<20>(a0, a1, c0, c1, SU, SP, c.sh); dot4_2<24>(a0, a1, c0, c1, SU, SP, c.sh); dot4_2<28>(a0, a1, c0, c1, SU, SP, c.sh);
  const float nU = -(a0 + a1), nP = -(c0 + c1);
  upd4_2<0>(SU, SP, c.dr, c.bb, vv, nU, nP); upd4_2<4>(SU, SP, c.dr, c.bb, vv, nU, nP); upd4_2<8>(SU, SP, c.dr, c.bb, vv, nU, nP); upd4_2<12>(SU, SP, c.dr, c.bb, vv, nU, nP);
  upd4_2<16>(SU, SP, c.dr, c.bb, vv, nU, nP); upd4_2<20>(SU, SP, c.dr, c.bb, vv, nU, nP); upd4_2<24>(SU, SP, c.dr, c.bb, vv, nU, nP); upd4_2<28>(SU, SP, c.dr, c.bb, vv, nU, nP);
}
template <bool WITH_OUT>
DI float scan_step(float (&S)[64], const ScanRec& c, float vv) {
  float s0 = 0.f, s1 = 0.f, s2 = 0.f, s3 = 0.f;
  dot4<0>(s0, s1, s2, s3, S, c.sh); dot4<4>(s0, s1, s2, s3, S, c.sh); dot4<8>(s0, s1, s2, s3, S, c.sh); dot4<12>(s0, s1, s2, s3, S, c.sh);
  dot4<16>(s0, s1, s2, s3, S, c.sh); dot4<20>(s0, s1, s2, s3, S, c.sh); dot4<24>(s0, s1, s2, s3, S, c.sh); dot4<28>(s0, s1, s2, s3, S, c.sh);
  const float nsk = -((s0 + s1) + (s2 + s3));
  upd4<0>(S, c.dr, c.bb, vv, nsk); upd4<4>(S, c.dr, c.bb, vv, nsk); upd4<8>(S, c.dr, c.bb, vv, nsk); upd4<12>(S, c.dr, c.bb, vv, nsk);
  upd4<16>(S, c.dr, c.bb, vv, nsk); upd4<20>(S, c.dr, c.bb, vv, nsk); upd4<24>(S, c.dr, c.bb, vv, nsk); upd4<28>(S, c.dr, c.bb, vv, nsk);
  float o0 = 0.f, o1 = 0.f, o2 = 0.f, o3 = 0.f;
  if (WITH_OUT) {
    dot4<32>(o0, o1, o2, o3, S, c.sh); dot4<36>(o0, o1, o2, o3, S, c.sh); dot4<40>(o0, o1, o2, o3, S, c.sh); dot4<44>(o0, o1, o2, o3, S, c.sh);
    dot4<48>(o0, o1, o2, o3, S, c.sh); dot4<52>(o0, o1, o2, o3, S, c.sh); dot4<56>(o0, o1, o2, o3, S, c.sh); dot4<60>(o0, o1, o2, o3, S, c.sh);
  }
  return (o0 + o1) + (o2 + o3);
}
constexpr int SPF = 3;
DI void scan_stage_vr(ushort_t* vbuf, ushort_t* rbuf, const ushort_t* shc, int dir, int tau0, int lane) {
#pragma unroll
  for (int i = 0; i < (SEG * 8 + 63) / 64; ++i) {
    const int id = i * 64 + lane, st = id >> 3;
    if (st < SEG) {
      const ushort_t* rec = shc + (size_t)tau_to_pos(dir, tau0 + st) * 192 + (id & 7) * 8;
      *(uint4*)&vbuf[st * 64 + (id & 7) * 8] = *(const uint4*)(rec + 128);
      *(uint4*)&rbuf[st * 64 + (id & 7) * 8] = *(const uint4*)(rec + 64);
    }
    if (i % 3 == 2) asm volatile("" ::: "memory");
  }
}
DI void fv_lo(float& acc, float a, uint32_t w) { asm("v_fma_mix_f32 %0, %1, %2, %0 op_sel_hi:[0,1,0]" : "+v"(acc) : "v"(a), "v"(w)); }
DI void fv_hi(float& acc, float a, uint32_t w) { asm("v_fma_mix_f32 %0, %1, %2, %0 op_sel:[0,1,0] op_sel_hi:[0,1,0]" : "+v"(acc) : "v"(a), "v"(w)); }
DI void phase_scanA(const Params& p, unsigned char* smem) {
  const ushort_t* SH = (const ushort_t*)(p.ws + OFF_SH);
  const ushort_t* DR = (const ushort_t*)(p.ws + OFF_DR);
  float* PU = p.out;
  const int lane = threadIdx.x & 63;
  ushort_t* vbuf = (ushort_t*)smem + (threadIdx.x >> 6) * (2 * SEG * 64);
  ushort_t* rbuf = vbuf + SEG * 64;
  ushort_t* O = (ushort_t*)(p.ws + OFF_ZQ);
  ushort_t* DRw = (ushort_t*)(p.ws + OFF_DR);
  const int gw = __builtin_amdgcn_readfirstlane(blockIdx.x * 8 + (threadIdx.x >> 6));
  uint32_t pfr = 0u;
  for (int task = gw; task < 32 * NCHUNK; task += gridDim.x * 8) {
    const int cd = task / NCHUNK, j = task % NCHUNK, dir = cd >> 4, c = cd & 15, b = c >> 3, head = c & 7;
    float SU[64], SP[64];
#pragma unroll
    for (int k = 0; k < 64; ++k) { SU[k] = 0.f; SP[k] = (k == lane) ? 1.f : 0.f; }
    const ushort_t* shc = SH + (size_t)c * LTOT * 192;
    const ushort_t* drc = DR + (size_t)(dir * 16 + c) * LTOT * 192;
#pragma unroll 1
    for (int st = 0; st < PFD; ++st) scan_prefetch(pfr, shc, drc, tau_to_pos(dir, j * CH + st), lane);
#pragma unroll 1
    for (int sg = 0; sg < CH / SEG; ++sg) {
      scan_stage_vr(vbuf, rbuf, shc, dir, j * CH + sg * SEG, lane);
#pragma unroll 1
      for (int s2 = 0; s2 < SEG; ++s2) {
        const int st = sg * SEG + s2;
        const int pos = tau_to_pos(dir, j * CH + st);
        const ushort_t* shr = shc + (size_t)pos * 192;
        const ushort_t* drr = drc + (size_t)pos * 192;
        scan_prefetch(pfr, shc, drc, tau_to_pos(dir, j * CH + (st + PFD < CH ? st + PFD : CH - 1)), lane);
        const float vv = h2f(vbuf[s2 * 64 + lane]);
        u32x16 a0, a1, b0, b1;
        sload4(a0, a1, b0, b1, shr, drr);
        float u0 = 0.f, u1 = 0.f, q0 = 0.f, q1 = 0.f;
#pragma unroll
        for (int q = 0; q < 16; ++q) {
          fm_lo(u0, SU[2 * q], a0[q]); fm_hi(u1, SU[2 * q + 1], a0[q]); fm_lo(q0, SP[2 * q], a0[q]); fm_hi(q1, SP[2 * q + 1], a0[q]);
          fm_lo(u0, SU[32 + 2 * q], a1[q]); fm_hi(u1, SU[33 + 2 * q], a1[q]); fm_lo(q0, SP[32 + 2 * q], a1[q]); fm_hi(q1, SP[33 + 2 * q], a1[q]);
        }
        const float nU = -(u0 + u1), nP = -(q0 + q1);
#pragma unroll
        for (int q = 0; q < 16; ++q) {
          fx_lo(SU[2 * q], b0[q]); fx_hi(SU[2 * q + 1], b0[q]); fx_lo(SU[32 + 2 * q], b1[q]); fx_hi(SU[33 + 2 * q], b1[q]);
          fx_lo(SP[2 * q], b0[q]); fx_hi(SP[2 * q + 1], b0[q]); fx_lo(SP[32 + 2 * q], b1[q]); fx_hi(SP[33 + 2 * q], b1[q]);
        }
        sload4(a0, a1, b0, b1, drr + 64, drr + 128);
#pragma unroll
        for (int q = 0; q < 16; ++q) { fm_lo(SU[2 * q], vv, a0[q]); fm_hi(SU[2 * q + 1], vv, a0[q]); fm_lo(SU[32 + 2 * q], vv, a1[q]); fm_hi(SU[33 + 2 * q], vv, a1[q]); }
#pragma unroll
        for (int q = 0; q < 16; ++q) {
          fm_lo(SU[2 * q], nU, b0[q]); fm_hi(SU[2 * q + 1], nU, b0[q]); fm_lo(SU[32 + 2 * q], nU, b1[q]); fm_hi(SU[33 + 2 * q], nU, b1[q]);
          fm_lo(SP[2 * q], nP, b0[q]); fm_hi(SP[2 * q + 1], nP, b0[q]); fm_lo(SP[32 + 2 * q], nP, b1[q]); fm_hi(SP[33 + 2 * q], nP, b1[q]);
        }
        if (pos >= CTXL) {
          float e0 = 0.f, e1 = 0.f, g0 = 0.f, g1 = 0.f;
#pragma unroll
          for (int q = 0; q < 8; ++q) {
            asm volatile("" ::: "memory");
            const uint4 rw = *(const uint4*)&rbuf[s2 * 64 + q * 8];
            fv_lo(e0, SU[8 * q + 0], rw.x); fv_hi(e1, SU[8 * q + 1], rw.x); fv_lo(g0, SP[8 * q + 0], rw.x); fv_hi(g1, SP[8 * q + 1], rw.x);
            fv_lo(e0, SU[8 * q + 2], rw.y); fv_hi(e1, SU[8 * q + 3], rw.y); fv_lo(g0, SP[8 * q + 2], rw.y); fv_hi(g1, SP[8 * q + 3], rw.y);
            fv_lo(e0, SU[8 * q + 4], rw.z); fv_hi(e1, SU[8 * q + 5], rw.z); fv_lo(g0, SP[8 * q + 4], rw.z); fv_hi(g1, SP[8 * q + 5], rw.z);
            fv_lo(e0, SU[8 * q + 6], rw.w); fv_hi(e1, SU[8 * q + 7], rw.w); fv_lo(g0, SP[8 * q + 6], rw.w); fv_hi(g1, SP[8 * q + 7], rw.w);
          }
          O[(unsigned)((dir * NX + b * SEQ + (pos - CTXL)) * 512 + head * 64 + lane)] = f2h(e0 + e1);
          DRw[(unsigned)(((dir * 16 + c) * LTOT + pos) * 192 + lane)] = f2h(g0 + g1);
        }
      }
    }
    const unsigned dsto = (unsigned)(task * 2 * 4096 + lane * 64);
#pragma unroll
    for (int k = 0; k < 64; k += 4) {
      *(float4*)(PU + dsto + k) = make_float4(SU[k], SU[k + 1], SU[k + 2], SU[k + 3]);
      *(float4*)(PU + dsto + 4096 + k) = make_float4(SP[k], SP[k + 1], SP[k + 2], SP[k + 3]);
    }
  }
  asm volatile("s_waitcnt vmcnt(0)" ::: "memory");
  asm volatile("" :: "v"(pfr));
}

DI void phase_scanB(const Params& p, unsigned char* smem) {
  int tix = threadIdx.x;
  asm volatile("" : "+v"(tix));
  if (blockIdx.x >= 32) return;
  float* Sb = (float*)smem;
  float* Xb = Sb + 64 * 65;
  float* Pb = Xb + 4096;
  float* Ub = Pb + 4096;
  float* PU = p.out;
  const int cd = blockIdx.x, tid = tix, wave = tid >> 6, lane = tid & 63, l31 = lane & 31, hh = lane >> 5;
  const int tile = wave & 3, tm = tile >> 1, tn = tile & 1, kh = wave >> 2;
  for (int i = tid; i < 64 * 65; i += NTH) Sb[i] = 0.f;
  constexpr int BPF = 3;
  float4 st[BPF][4];
  auto fetch = [&](int j, float4 (&r)[4]) {
    const float* base = PU + (size_t)(cd * NCHUNK + j) * 2 * 4096 + tid * 8;
    r[0] = *(const float4*)(base + 4096); r[1] = *(const float4*)(base + 4100);
    r[2] = *(const float4*)base; r[3] = *(const float4*)(base + 4);
  };
  auto stage = [&](const float4 (&r)[4]) {
    *(float4*)&Pb[tid * 8] = r[0]; *(float4*)&Pb[tid * 8 + 4] = r[1];
    *(float4*)&Ub[tid * 8] = r[2]; *(float4*)&Ub[tid * 8 + 4] = r[3];
  };
  auto put_state = [&](int j, const f32x16& sv) {
    float* base = PU + (size_t)(cd * NCHUNK + j) * 2 * 4096;
#pragma unroll
    for (int i = 0; i < 16; ++i) base[(tm * 32 + crow(i, hh)) * 64 + tn * 32 + l31] = sv[i];
  };
#pragma unroll
  for (int s = 0; s < BPF; ++s) fetch(s, st[s]);
  stage(st[0]);
#pragma unroll
  for (int s = 0; s + 1 < BPF; ++s)
#pragma unroll
    for (int q = 0; q < 4; ++q) st[s][q] = st[s + 1][q];
  fetch(BPF, st[BPF - 1]);
  __syncthreads();
  if (kh == 0) put_state(0, zero16());
#pragma unroll 1
  for (int j = 0; j < NCHUNK; ++j) {
    f32x16 acc = zero16();
    if (kh == 0) {
#pragma unroll
      for (int i = 0; i < 16; ++i) acc[i] = Ub[(tm * 32 + crow(i, hh)) * 64 + tn * 32 + l31];
    }
#pragma unroll
    for (int kk = 0; kk < 16; ++kk) {
      const int k = kh * 32 + 2 * kk + hh;
      acc = __builtin_amdgcn_mfma_f32_32x32x2f32(Sb[(tm * 32 + l31) * 65 + k], Pb[k * 64 + tn * 32 + l31], acc, 0, 0, 0);
    }
    if (kh == 1) {
#pragma unroll
      for (int i = 0; i < 16; ++i) Xb[(tile * 16 + i) * 64 + lane] = acc[i];
    }
    __syncthreads();
    if (kh == 0) {
#pragma unroll
      for (int i = 0; i < 16; ++i) { acc[i] += Xb[(tile * 16 + i) * 64 + lane]; Sb[(tm * 32 + crow(i, hh)) * 65 + tn * 32 + l31] = acc[i]; }
    }
    if (j + 1 < NCHUNK) {
      stage(st[0]);
#pragma unroll
      for (int s = 0; s + 1 < BPF; ++s)
#pragma unroll
        for (int q = 0; q < 4; ++q) st[s][q] = st[s + 1][q];
      if (j + 1 + BPF < NCHUNK) fetch(j + 1 + BPF, st[BPF - 1]);
    }
    __syncthreads();
    if (kh == 0 && j + 1 < NCHUNK) put_state(j + 1, acc);
  }
}

typedef __attribute__((ext_vector_type(8))) _Float16 f16x8;
DI void phase_scanC(const Params& p, unsigned char* smem) {
  int tix = threadIdx.x;
  asm volatile("" : "+v"(tix));
  const ushort_t* DR = (const ushort_t*)(p.ws + OFF_DR);
  ushort_t* O = (ushort_t*)(p.ws + OFF_ZQ);
  const float* PU = p.out;
  const int lane = tix & 63, l31 = lane & 31, hh = lane >> 5;
  const int gw = blockIdx.x * 8 + (tix >> 6);
  for (int task = gw; task < 32 * NCHUNK; task += gridDim.x * 8) {
    const int cd = task / NCHUNK, j = task % NCHUNK, dir = cd >> 4, c = cd & 15, b = c >> 3, head = c & 7;
    if (j == 0) continue;
    const float* S = PU + (size_t)task * 2 * 4096;
    f16x8 bs[2][4];
#pragma unroll
    for (int nt = 0; nt < 2; ++nt)
#pragma unroll
      for (int ks = 0; ks < 4; ++ks) {
        const float* sp = S + (nt * 32 + l31) * 64 + ks * 16 + hh * 8;
        const float4 x0 = *(const float4*)sp, x1 = *(const float4*)(sp + 4);
        f16x8 f = {(_Float16)x0.x, (_Float16)x0.y, (_Float16)x0.z, (_Float16)x0.w, (_Float16)x1.x, (_Float16)x1.y, (_Float16)x1.z, (_Float16)x1.w};
        bs[nt][ks] = f;
      }
    const ushort_t* drc = DR + (size_t)(dir * 16 + c) * LTOT * 192;
    ushort_t* obase = O + ((size_t)dir * NX + (size_t)b * SEQ) * 512 + head * 64;
#pragma unroll 1
    for (int tile = 0; tile < (CH + 31) / 32; ++tile) {
      const int tau = tile * 32 + l31;
      const int pos = tau_to_pos(dir, j * CH + (tau < CH ? tau : CH - 1));
      const ushort_t* wrow = drc + (size_t)pos * 192;
      f32x16 acc[2] = {zero16(), zero16()};
#pragma unroll
      for (int ks = 0; ks < 4; ++ks) {
        const f16x8 a = *(const f16x8*)(wrow + ks * 16 + hh * 8);
        acc[0] = __builtin_amdgcn_mfma_f32_32x32x16_f16(a, bs[0][ks], acc[0], 0, 0, 0);
        acc[1] = __builtin_amdgcn_mfma_f32_32x32x16_f16(a, bs[1][ks], acc[1], 0, 0, 0);
      }
#pragma unroll
      for (int i = 0; i < 16; ++i) {
        const int t2 = tile * 32 + crow(i, hh);
        if (t2 < CH) {
          const int p2 = tau_to_pos(dir, j * CH + t2);
          if (p2 >= CTXL) {
            ushort_t* o0 = obase + (size_t)(p2 - CTXL) * 512 + l31;
            o0[0] = f2h(h2f(o0[0]) + acc[0][i]);
            o0[32] = f2h(h2f(o0[32]) + acc[1][i]);
          }
        }
      }
    }
  }
}

DI void phase_scan_naive(const Params& p) {
  const ushort_t* SH = (const ushort_t*)(p.ws + OFF_SH);
  const ushort_t* DR = (const ushort_t*)(p.ws + OFF_DR);
  ushort_t* O = (ushort_t*)(p.ws + OFF_ZQ);
  const int lane = threadIdx.x & 63;
  const int gw = __builtin_amdgcn_readfirstlane(blockIdx.x * 8 + (threadIdx.x >> 6));
  if (gw >= 32) return;
  const int cd = gw, dir = cd >> 4, c = cd & 15, b = c >> 3, head = c & 7;
  float S[64];
#pragma unroll
  for (int k = 0; k < 64; ++k) S[k] = 0.f;
  const ushort_t* shc = SH + (size_t)c * LTOT * 192;
  const ushort_t* drc = DR + (size_t)(dir * 16 + c) * LTOT * 192;
#pragma unroll 1
  for (int tau = 0; tau < LTOT; ++tau) {
    const int pos = tau_to_pos(dir, tau);
    const ushort_t* shr = shc + (size_t)pos * 192;
    const ushort_t* drr = drc + (size_t)pos * 192;
    const float vv = h2f(shr[128 + lane]);
    u32x16 k0, k1;
    sload2(k0, k1, shr);
    float sk0 = 0.f, sk1 = 0.f;
#pragma unroll
    for (int q = 0; q < 32; ++q) { sk0 = fmaf(S[q], HV(k0, q), sk0); sk1 = fmaf(S[32 + q], HV(k1, q), sk1); }
    const float nsk = -(sk0 + sk1);
    u32x16 x0, x1, d0, d1;
    sload4(x0, x1, d0, d1, drr, drr + 64);
#pragma unroll
    for (int q = 0; q < 32; ++q) {
      S[q] = fmaf(S[q], -HV(x0, q), S[q]); S[32 + q] = fmaf(S[32 + q], -HV(x1, q), S[32 + q]);
      S[q] = fmaf(vv, HV(d0, q), S[q]); S[32 + q] = fmaf(vv, HV(d1, q), S[32 + q]);
    }
    u32x16 b0, b1, r0, r1;
    sload4(b0, b1, r0, r1, drr + 128, shr + 64);
    float o0 = 0.f, o1 = 0.f;
#pragma unroll
    for (int q = 0; q < 32; ++q) {
      S[q] = fmaf(nsk, HV(b0, q), S[q]); S[32 + q] = fmaf(nsk, HV(b1, q), S[32 + q]);
      o0 = fmaf(S[q], HV(r0, q), o0); o1 = fmaf(S[32 + q], HV(r1, q), o1);
    }
    if (pos >= CTXL) O[((size_t)dir * NX + (size_t)b * SEQ + (pos - CTXL)) * 512 + head * 64 + lane] = f2h(o0 + o1);
  }
}

DI void phase_attn(const Params& p, unsigned char* smem) {
  int tix = threadIdx.x;
  asm volatile("" : "+v"(tix));
  ushort_t* Kb = (ushort_t*)smem;
  ushort_t* Vb = Kb + 2 * 64 * LDK;
  ushort_t* QB = (ushort_t*)(p.ws + OFF_QB);
  const ushort_t* KB = (const ushort_t*)(p.ws + OFF_KB);
  const ushort_t* VB = (const ushort_t*)(p.ws + OFF_VB);
  const int tid = tix, wave = tid >> 6, lane = tid & 63, l31 = lane & 31, hh = lane >> 5;
  const int loff = (tid >> 3) * LDK + (tid & 7) * 8;
  constexpr float THR = 6.f;
  constexpr int NTL = LTOT / 64;
  for (int at = blockIdx.x; at < 1024; at += gridDim.x) {
    const int b = at >> 9, kvh = (at >> 8) & 1, t0 = (at & 255) * 64;
    const int head = kvh * 4 + (wave & 3), tq = t0 + (wave >> 2) * 32 + l31;
    ushort_t* qrow = QB + ((size_t)(b * 8 + head) * SEQ + tq) * 64;
    bf16x8 qf[4];
#pragma unroll
    for (int ks = 0; ks < 4; ++ks) qf[ks] = *(const bf16x8*)(qrow + ks * 16 + hh * 8);
    const ushort_t* kbase = KB + (size_t)(b * 2 + kvh) * LTOT * 64 + tid * 8;
    const ushort_t* vbase = VB + (size_t)(b * 2 + kvh) * LTOT * 64 + tid * 8;
    f32x16 o[2] = {zero16(), zero16()};
    f32x16 negm = zero16();
    float lsum = 0.f;
    auto qk = [&](f32x16 (&s)[2], const ushort_t* Ks) {
      s[0] = negm; s[1] = negm;
#pragma unroll
      for (int ks = 0; ks < 4; ++ks)
#pragma unroll
        for (int kk = 0; kk < 2; ++kk) s[kk] = MFMA(*(const bf16x8*)&Ks[(kk * 32 + l31) * LDK + ks * 16 + hh * 8], qf[ks], s[kk]);
    };
    uint4 rk, rv;
    __syncthreads();
    rk = *(const uint4*)kbase; rv = *(const uint4*)vbase;
    *(uint4*)&Kb[loff] = rk; *(uint4*)&Vb[loff] = rv;
    rk = *(const uint4*)(kbase + 4096);
    rv = *(const uint4*)(vbase + 4096);
    __syncthreads();
    f32x16 sA[2], sB[2];
    qk(sA, Kb);
    {
      float mx = fmaxf(sA[0][0], sA[1][0]);
#pragma unroll
      for (int i = 1; i < 16; ++i) mx = fmaxf(mx, fmaxf(sA[0][i], sA[1][i]));
      mx = fmaxf(mx, __shfl_xor(mx, 32, 64));
#pragma unroll
      for (int i = 0; i < 16; ++i) { sA[0][i] -= mx; sA[1][i] -= mx; negm[i] = -mx; }
    }
    *(uint4*)&Kb[64 * LDK + loff] = rk;
    rk = *(const uint4*)(kbase + 2 * 4096);
    auto step = [&](int t, f32x16 (&sc)[2], f32x16 (&sn)[2]) {
      __syncthreads();
      if (t + 2 < NTL) *(uint4*)&Kb[(t & 1) * 64 * LDK + loff] = rk;
      if (t + 1 < NTL) *(uint4*)&Vb[((t + 1) & 1) * 64 * LDK + loff] = rv;
      if (t + 3 < NTL) rk = *(const uint4*)(kbase + (size_t)(t + 3) * 4096);
      if (t + 2 < NTL) rv = *(const uint4*)(vbase + (size_t)(t + 2) * 4096);
      if (t + 1 < NTL) qk(sn, Kb + ((t + 1) & 1) * 64 * LDK);
      float mx = fmaxf(sc[0][0], sc[1][0]);
#pragma unroll
      for (int i = 1; i < 16; ++i) mx = fmaxf(mx, fmaxf(sc[0][i], sc[1][i]));
      mx = fmaxf(mx, __shfl_xor(mx, 32, 64));
      if (__builtin_amdgcn_ballot_w64(mx > THR) != 0ull) {
        const float delta = fmaxf(mx, 0.f);
        const float alpha = __builtin_amdgcn_exp2f(-delta);
        lsum *= alpha;
#pragma unroll
        for (int i = 0; i < 16; ++i) {
          o[0][i] *= alpha; o[1][i] *= alpha; sc[0][i] -= delta; sc[1][i] -= delta; negm[i] -= delta;
          sn[0][i] -= delta; sn[1][i] -= delta;
        }
      }
      float ps = 0.f;
#pragma unroll
      for (int i = 0; i < 16; ++i) {
        sc[0][i] = __builtin_amdgcn_exp2f(sc[0][i]); sc[1][i] = __builtin_amdgcn_exp2f(sc[1][i]);
        ps += sc[0][i] + sc[1][i];
      }
      lsum += ps;
      const ushort_t* Vt = Vb + (t & 1) * 64 * LDK;
#pragma unroll
      for (int kk = 0; kk < 2; ++kk) {
#pragma unroll
        for (int st = 0; st < 2; ++st) {
          uint4 pw;
          pw.x = pack_bf2(sc[kk][8 * st + 0], sc[kk][8 * st + 1]); pw.y = pack_bf2(sc[kk][8 * st + 2], sc[kk][8 * st + 3]);
          pw.z = pack_bf2(sc[kk][8 * st + 4], sc[kk][8 * st + 5]); pw.w = pack_bf2(sc[kk][8 * st + 6], sc[kk][8 * st + 7]);
          const bf16x8 pf = __builtin_bit_cast(bf16x8, pw);
#pragma unroll
          for (int dt = 0; dt < 2; ++dt) o[dt] = MFMA(*(const bf16x8*)&Vt[(dt * 32 + l31) * LDK + kk * 32 + st * 16 + hh * 8], pf, o[dt]);
        }
      }
    };
#pragma unroll 1
    for (int t = 0; t < NTL; t += 2) {
      step(t, sA, sB);
      step(t + 1, sB, sA);
    }
    const float ltot = lsum + __shfl_xor(lsum, 32, 64);
    const float il = 1.f / ltot;
#pragma unroll
    for (int dt = 0; dt < 2; ++dt)
#pragma unroll
      for (int g = 0; g < 4; ++g) {
        uint2 w;
        w.x = pack_bf2(o[dt][4 * g + 0] * il, o[dt][4 * g + 1] * il);
        w.y = pack_bf2(o[dt][4 * g + 2] * il, o[dt][4 * g + 3] * il);
        *(uint2*)(qrow + dt * 32 + 8 * g + 4 * hh) = w;
      }
  }
}

constexpr size_t OFF_DBG = WS_END;
DI void dbg_acc(const Params& p, int slot, float d2, float r2) {
  float* dbg = (float*)(p.ws + OFF_DBG);
  d2 = wave_sum(d2); r2 = wave_sum(r2);
  if ((threadIdx.x & 63) == 0) { atomicAdd(dbg + 2 * slot, d2); atomicAdd(dbg + 2 * slot + 1, r2); }
}
DI void probe_after_gemm1(const Params& p) {
  if (blockIdx.x != 0) return;
  const int tid = threadIdx.x, lane = tid & 63, wave = tid >> 6;
  const float* mod = (const float*)(p.ws + OFF_MOD);
  const ushort_t* H = (const ushort_t*)(p.ws + OFF_SH);
  {
    float d2 = 0.f, r2 = 0.f;
    if (tid < 96) {
      const int v = tid / 32, n = (tid % 32) * 97 % 3072;
      float s = 0.f;
      for (int k = 0; k < 1024; ++k) { const float cv = (v < 2) ? p.c[v * 1024 + k] : p.c_ctx[k]; s += (cv / (1.f + expf(-cv))) * p.w_ada[(size_t)k * 3072 + n]; }
      s += p.b_ada[n];
      const float d = mod[v * 3072 + n] - s; d2 = d * d; r2 = s * s;
    }
    dbg_acc(p, 0, d2, r2);
  }
  {
    const int row = wave == 0 ? 0 : wave == 1 ? 777 : wave == 2 ? 16383 : wave == 3 ? 16384 : wave == 4 ? 32767 : wave == 5 ? 32768 : wave == 6 ? 33023 : 33279;
    const float* src = (row < NX) ? p.x + (size_t)row * DM : p.ctx + (size_t)(row - NX) * DM;
    const float* md = mod + ((row < NX) ? (row / SEQ) : 2) * 3072;
    float s = 0.f;
    for (int i = lane; i < 1024; i += 64) s += src[i];
    const float mu = wave_sum(s) / 1024.f;
    float q = 0.f;
    for (int i = lane; i < 1024; i += 64) q += (src[i] - mu) * (src[i] - mu);
    const float rstd = rsqrtf(wave_sum(q) / 1024.f + LN_EPS);
    float d2 = 0.f, r2 = 0.f;
    for (int i = lane; i < 1024; i += 64) {
      const float ref = (src[i] - mu) * rstd * (1.f + md[1024 + i]) + md[i];
      const float d = bf2f(H[(size_t)row * DM + i]) - ref; d2 += d * d; r2 += ref * ref;
    }
    dbg_acc(p, 1, d2, r2);
  }
  {
    float d2 = 0.f, r2 = 0.f;
    if (tid < 60) {
      const int ri = tid / 10, ci = tid % 10;
      const int row = ri == 0 ? 3 : ri == 1 ? 777 : ri == 2 ? 20001 : ri == 3 ? 32767 : ri == 4 ? 32773 : 33279;
      const int col = ci == 0 ? 0 : ci == 1 ? 100 : ci == 2 ? 700 : ci == 3 ? 800 : ci == 4 ? 1279 : ci == 5 ? 1280 : ci == 6 ? 2000 : ci == 7 ? 3071 : ci == 8 ? 3072 : 3583;
      float s = 0.f;
      for (int k = 0; k < 1024; ++k) s += bf2f(H[(size_t)row * DM + k]) * p.w_in[(size_t)k * INW + col];
      float got = 0.f; bool have = true;
      if (col < 768) got = bf2f(((const ushort_t*)(p.ws + OFF_ZQ))[(size_t)row * 768 + col]);
      else if (col < 1280) { if (row < NX) got = bf2f(((const ushort_t*)(p.ws + OFF_ZG))[(size_t)row * 1024 + col - 768]); else have = false; }
      else if (col < 3072) got = bf2f(((const ushort_t*)p.out)[(size_t)row * 1792 + col - 1280]);
      else { if (row < NX) got = bf2f(((const ushort_t*)(p.ws + OFF_ZG))[(size_t)row * 1024 + 512 + col - 3072]); else have = false; }
      if (have) { const float d = got - s; d2 = d * d; r2 = s * s; }
    }
    dbg_acc(p, 2, d2, r2);
  }
}
DI void probe_after_prep(const Params& p, unsigned char* smem) {
  if (blockIdx.x != 0) return;
  float* cbuf = (float*)smem;
  const int tid = threadIdx.x, lane = tid & 63, wave = tid >> 6;
  const ushort_t* zm = (const ushort_t*)p.out;
  const ushort_t* SH = (const ushort_t*)(p.ws + OFF_SH);
  const ushort_t* DR = (const ushort_t*)(p.ws + OFF_DR);
  float dA = 0.f, rA = 0.f, dB = 0.f, rB = 0.f;
#pragma unroll 1
  for (int sidx = wave; sidx < 24; sidx += 8) {
    const int ri = sidx >> 1, head = (sidx & 1) ? 5 : 0;
    const int row = ri == 0 ? 0 : ri == 1 ? 1 : ri == 2 ? 31 : ri == 3 ? 32 : ri == 4 ? 16383 : ri == 5 ? 16384 : ri == 6 ? 20000 : ri == 7 ? 32767 : ri == 8 ? 32768 : ri == 9 ? 33023 : ri == 10 ? 33024 : 33279;
    int b, t, len, pp;
    if (row < NX) { b = row / SEQ; t = row % SEQ; len = SEQ; pp = CTXL + t; } else { b = (row - NX) / CTXL; t = (row - NX) % CTXL; len = CTXL; pp = t; }
    auto sft = [&](int col) {
      const float z = bf2f(zm[(size_t)row * 1792 + col]);
      const float zp = (t > 0) ? bf2f(zm[(size_t)(row - 1) * 1792 + col]) : 0.f;
      const float zn = (t < len - 1) ? bf2f(zm[(size_t)(row + 1) * 1792 + col]) : 0.f;
      return z + p.mu_prev[col] * (zp - z) + p.mu_next[col] * (zn - z);
    };
    const int n = head * 64 + lane;
    const float r = sft(n), k = sft(512 + n), v = sft(1024 + n);
#pragma unroll 1
    for (int j = lane; j < 256; j += 64) { const float s = sft(1536 + j); cbuf[wave * 256 + j] = (j < 128) ? tanhf(s) : s; }
    __builtin_amdgcn_s_waitcnt(0);
    __builtin_amdgcn_wave_barrier();
    const float kr = k * p.k_k[n];
    const float nrm = sqrtf(wave_sum(kr * kr));
    const float kk = kr / fmaxf(nrm, 1e-12f);
    const size_t cp = (size_t)(b * 8 + head) * LTOT + pp;
    { float d;
      d = h2f(SH[(cp * 3 + 0) * 64 + lane]) - kk; dA += d * d; rA += kk * kk;
      d = h2f(SH[(cp * 3 + 1) * 64 + lane]) - r; dA += d * d; rA += r * r;
      d = h2f(SH[(cp * 3 + 2) * 64 + lane]) - v; dA += d * d; rA += v * v; }
#pragma unroll 1
    for (int dir = 0; dir < 2; ++dir) {
      float wpre = p.w0[dir * 512 + n], apre = p.a0[dir * 512 + n];
#pragma unroll 1
      for (int j = 0; j < 64; ++j) {
        wpre += cbuf[wave * 256 + dir * 64 + j] * p.w_up[(size_t)(dir * 64 + j) * 512 + n];
        apre += cbuf[wave * 256 + 128 + dir * 64 + j] * p.a_up[(size_t)(dir * 64 + j) * 512 + n];
      }
      const float wlog = -log1pf(expf(-wpre)) - 0.5f;
      const float xd = 1.f - expf(-expf(wlog));
      const float a = 1.f / (1.f + expf(-apre));
      const float kd = k * (1.f + (a - 1.f) * p.k_a[n]);
      const float bq = kk * a;
      const size_t dp = (size_t)(dir * 16 + b * 8 + head) * LTOT + pp;
      float d;
      d = h2f(DR[(dp * 3 + 0) * 64 + lane]) - xd; dB += d * d; rB += xd * xd;
      d = h2f(DR[(dp * 3 + 1) * 64 + lane]) - kd; dB += d * d; rB += kd * kd;
      d = h2f(DR[(dp * 3 + 2) * 64 + lane]) - bq; dB += d * d; rB += bq * bq;
    }
    __builtin_amdgcn_wave_barrier();
  }
  dbg_acc(p, 3, dA, rA);
  dbg_acc(p, 4, dB, rB);
}

DI void probe_scan(const Params& p) {
  if (blockIdx.x != 0 || threadIdx.x >= 128) return;
  const ushort_t* SH = (const ushort_t*)(p.ws + OFF_SH);
  const ushort_t* DR = (const ushort_t*)(p.ws + OFF_DR);
  const ushort_t* O = (const ushort_t*)(p.ws + OFF_ZQ);
  const int lane = threadIdx.x & 63, wv = threadIdx.x >> 6;
  const int c = wv ? 9 : 0, dir = wv, b = c >> 3, head = c & 7;
  float S[64];
#pragma unroll
  for (int k = 0; k < 64; ++k) S[k] = 0.f;
  float d2 = 0.f, r2 = 0.f;
#pragma unroll 1
  for (int tau = 0; tau < 420; ++tau) {
    const int pos = dir == 0 ? tau : (tau < CTXL ? CTXL - 1 - tau : LTOT - 1 - (tau - CTXL));
    const ushort_t* sh = SH + ((size_t)c * LTOT + pos) * 192;
    const ushort_t* dr = DR + ((size_t)(dir * 16 + c) * LTOT + pos) * 192;
    const float v = h2f(sh[128 + lane]);
    float sk = 0.f;
#pragma unroll
    for (int k = 0; k < 64; ++k) sk += S[k] * h2f(sh[k]);
    float o = 0.f;
#pragma unroll
    for (int k = 0; k < 64; ++k) {
      const float dec = 1.f - h2f(dr[k]);
      S[k] = S[k] * dec - sk * h2f(dr[128 + k]) + v * h2f(dr[64 + k]);
      o += S[k] * h2f(sh[64 + k]);
    }
    if (pos >= CTXL) {
      const float got = h2f(O[((size_t)dir * NX + (size_t)b * SEQ + (pos - CTXL)) * 512 + head * 64 + lane]);
      const float d = got - o; d2 += d * d; r2 += o * o;
    }
  }
  dbg_acc(p, 0, d2, r2);
}
DI float probe_delta(const Params& p) {
  const float* dbg = (const float*)(p.ws + OFF_DBG);
  int k = 0;
  for (int s = 0; s < 5; ++s) { const float rel = sqrtf(dbg[2 * s] / fmaxf(dbg[2 * s + 1], 1e-30f)); if (!(rel < 0.05f)) k |= 1 << s; }
  return sqrtf(0.02f * (float)k);
}

DI void phase_final(const Params& p, unsigned char* smem) {
  ushort_t* As = (ushort_t*)smem;
  ushort_t* Bs = As + 2 * 128 * LDK;
  const float* mod = (const float*)(p.ws + OFF_MOD);
  ushort_t* ZG = (ushort_t*)(p.ws + OFF_ZG);
  ushort_t* QB = (ushort_t*)(p.ws + OFF_QB);
  ushort_t* O = (ushort_t*)(p.ws + OFF_ZQ);
  const ushort_t* SH = (const ushort_t*)(p.ws + OFF_SH);
  const ushort_t* DR = (const ushort_t*)(p.ws + OFF_DR);
  const ushort_t* WMG = (const ushort_t*)(p.ws + OFF_WMG);
  const ushort_t* WPA = (const ushort_t*)(p.ws + OFF_WPA);
  const ushort_t* WPB = (const ushort_t*)(p.ws + OFF_WPB);
  const ushort_t* WO = (const ushort_t*)(p.ws + OFF_WO);
#pragma unroll 1
  for (int mt = blockIdx.x; mt < NX / 128; mt += gridDim.x) {
    int tid = threadIdx.x;
    asm volatile("" : "+v"(tid));
    const int wave = tid >> 6, lane = tid & 63, l31 = lane & 31, hh = lane >> 5;
    const int wrow0 = (wave & 3) * 32, wcol0 = (wave >> 2) * 64;
    const int row0 = mt * 128, b = row0 / SEQ, tb0 = row0 % SEQ;
    const float* md = mod + b * 3072;
    __syncthreads();
#pragma unroll 1
    for (int r4 = wave * 4; r4 < 128; r4 += 32) {
      const int r = r4 + (lane >> 4), l16 = lane & 15;
      ushort_t* hdst = (ushort_t*)(p.out + (size_t)(row0 + r) * DM);
      float4 v[16];
      const float rstd = ln_rows4(p.x + (size_t)(row0 + r) * DM, l16, v);
#pragma unroll
      for (int i = 0; i < 16; ++i) {
        const int col = l16 * 4 + 64 * i;
        const float4 sh = *(const float4*)(md + col), sc = *(const float4*)(md + 1024 + col);
        uint2 o;
        o.x = pack_bf2(v[i].x * rstd * (1.f + sc.x) + sh.x, v[i].y * rstd * (1.f + sc.y) + sh.y);
        o.y = pack_bf2(v[i].z * rstd * (1.f + sc.z) + sh.z, v[i].w * rstd * (1.f + sc.w) + sh.w);
        *(uint2*)(hdst + col) = o;
      }
    }
#if PROBE
    float a2ref = 0.f;
    if (mt == 0) {
      const int tok = wave * 16 + 3, head = wave, row = row0 + tok, t = tb0 + tok, dd = head * 64 + lane;
      const size_t cp = (size_t)(b * 8 + head) * LTOT + CTXL + t;
      const float o = h2f(O[(size_t)row * 512 + dd]) + h2f(O[((size_t)NX + row) * 512 + dd]);
      const float mu = wave_sum(o) / 64.f;
      const float var = wave_sum((o - mu) * (o - mu)) / 64.f;
      const float y = (o - mu) * rsqrtf(var + GN_EPS) * p.gn_w[dd] + p.gn_b[dd];
      const float r = h2f(SH[(cp * 3 + 1) * 64 + lane]), vv = h2f(SH[(cp * 3 + 2) * 64 + lane]);
      const float kf = h2f(DR[(cp * 3 + 1) * 64 + lane]), kb = h2f(DR[(((size_t)16 * LTOT + cp) * 3 + 1) * 64 + lane]);
      const float bon = wave_sum(r * kf * p.r_k[dd]) + wave_sum(r * kb * p.r_k[512 + dd]);
      const float g = bf2f(ZG[(size_t)row * 1024 + 512 + dd]);
      a2ref = (y + bon * vv) * (g / (1.f + expf(-g)));
    }
#endif
#pragma unroll 1
    for (int it = 0; it < 16; ++it) {
      const int pair = (it * 8 + wave) * 8 + (lane >> 3), q8 = lane & 7;
      const int tok = pair >> 3, head = pair & 7, row = row0 + tok, t = tb0 + tok, d0 = q8 * 8;
      const unsigned cp = (unsigned)((b * 8 + head) * LTOT + CTXL + t);
      const unsigned ofo = (unsigned)(row * 512 + head * 64 + d0), obo = ofo + (unsigned)NX * 512u;
      const unsigned ro = (cp * 3 + 1) * 64 + d0, vo = (cp * 3 + 2) * 64 + d0;
      const unsigned kbo = ((16u * LTOT + cp) * 3 + 1) * 64 + d0;
      const unsigned gbo = (unsigned)(row * 1024 + 512 + head * 64 + d0), gao = gbo - 512;
      const unsigned yao = (unsigned)(((b * 8 + head) * SEQ + t) * 64 + d0);
      float ov[8], bon = 0.f, s = 0.f;
      {
        const uint4 a = *(const uint4*)(O + ofo), bq = *(const uint4*)(O + obo);
        const uint4 rr = *(const uint4*)(SH + ro), kf = *(const uint4*)(DR + ro), kb = *(const uint4*)(DR + kbo);
        const unsigned aw[4] = {a.x, a.y, a.z, a.w}, bw[4] = {bq.x, bq.y, bq.z, bq.w}, rw[4] = {rr.x, rr.y, rr.z, rr.w};
        const unsigned fw[4] = {kf.x, kf.y, kf.z, kf.w}, kw[4] = {kb.x, kb.y, kb.z, kb.w};
#pragma unroll
        for (int q = 0; q < 4; ++q) {
          const int dd = head * 64 + d0 + 2 * q;
          ov[2 * q] = hlo(aw[q]) + hlo(bw[q]);
          ov[2 * q + 1] = hhi(aw[q]) + hhi(bw[q]);
          s += ov[2 * q] + ov[2 * q + 1];
          bon += hlo(rw[q]) * (hlo(fw[q]) * p.r_k[dd] + hlo(kw[q]) * p.r_k[512 + dd]);
          bon += hhi(rw[q]) * (hhi(fw[q]) * p.r_k[dd + 1] + hhi(kw[q]) * p.r_k[512 + dd + 1]);
        }
      }
      s += __shfl_xor(s, 1, 64); s += __shfl_xor(s, 2, 64); s += __shfl_xor(s, 4, 64);
      bon += __shfl_xor(bon, 1, 64); bon += __shfl_xor(bon, 2, 64); bon += __shfl_xor(bon, 4, 64);
      const float mu = s * (1.f / 64.f);
      float vs = 0.f;
#pragma unroll
      for (int q = 0; q < 8; ++q) { ov[q] -= mu; vs = fmaf(ov[q], ov[q], vs); }
      vs += __shfl_xor(vs, 1, 64); vs += __shfl_xor(vs, 2, 64); vs += __shfl_xor(vs, 4, 64);
      const float rstd = rsqrtf(vs * (1.f / 64.f) + GN_EPS);
      {
        const uint4 vv = *(const uint4*)(SH + vo), gb = *(const uint4*)(ZG + gbo), ga = *(const uint4*)(ZG + gao), ya = *(const uint4*)(QB + yao);
        const unsigned vw[4] = {vv.x, vv.y, vv.z, vv.w}, gbw[4] = {gb.x, gb.y, gb.z, gb.w}, gaw[4] = {ga.x, ga.y, ga.z, ga.w}, yw[4] = {ya.x, ya.y, ya.z, ya.w};
        unsigned o2[4], o1[4];
#pragma unroll
        for (int q = 0; q < 4; ++q) {
          const int dd = head * 64 + d0 + 2 * q;
          const float y0 = ov[2 * q] * rstd * p.gn_w[dd] + p.gn_b[dd] + bon * hlo(vw[q]);
          const float y1 = ov[2 * q + 1] * rstd * p.gn_w[dd + 1] + p.gn_b[dd + 1] + bon * hhi(vw[q]);
          o2[q] = pack_bf2(y0 * siluf(bflo(gbw[q])), y1 * siluf(bfhi(gbw[q])));
          o1[q] = pack_bf2(bflo(yw[q]) * siluf(bflo(gaw[q])), bfhi(yw[q]) * siluf(bfhi(gaw[q])));
        }
        *(uint4*)(O + ofo) = make_uint4(o2[0], o2[1], o2[2], o2[3]);
        *(uint4*)(QB + yao) = make_uint4(o1[0], o1[1], o1[2], o1[3]);
      }
    }
    asm volatile("s_waitcnt vmcnt(0)" ::: "memory");
    __syncthreads();
#if PROBE
    if (mt == 0) {
      const int tok = wave * 16 + 3, head = wave, row = row0 + tok, dd = head * 64 + lane;
      const float got = bf2f(O[(size_t)row * 512 + dd]);
      dbg_acc(p, 1, (got - a2ref) * (got - a2ref), a2ref * a2ref);
    }
#endif
    const ushort_t* hbase = (const ushort_t*)p.out;
    auto hload = [&](int r, int k) { return *(const uint4*)(hbase + (unsigned)((row0 + r) * 2048 + k)); };
    auto a1load = [&](int r, int k) { return *(const uint4*)(QB + (unsigned)(((b * 8 + (k >> 6)) * SEQ + tb0 + r) * 64 + (k & 63))); };
    auto a2load = [&](int r, int k) { return *(const uint4*)(O + (unsigned)((row0 + r) * 512 + k)); };
#pragma unroll 1
    for (int nt = 0; nt < 8; ++nt) {
      const int col0 = nt * 128;
      int tidn = tid;
      asm volatile("" : "+v"(tidn));
      f32x16 sg[2][1][2] = {{{zero16(), zero16()}}, {{zero16(), zero16()}}};
      gemm_pass<128, 128, 1, 2, 2>(sg, hload, [&](int w, int n, int k) { return *(const uint4*)(WMG + (unsigned)((w * 1024 + col0 + n) * DM + k)); }, DM, As, Bs, wrow0, wcol0, tidn);
#pragma unroll
      for (int ni = 0; ni < 2; ++ni) {
        const int col = col0 + wcol0 + ni * 32 + l31;
        const float ba = p.b_mg[col], bb = p.b_mg[1024 + col];
#pragma unroll
        for (int i = 0; i < 16; ++i) { sg[0][0][ni][i] = sigmf(sg[0][0][ni][i] + ba); sg[1][0][ni][i] = sigmf(sg[1][0][ni][i] + bb); }
      }
      {
        f32x16 ya[1][1][2] = {{{zero16(), zero16()}}};
        gemm_pass<128, 128, 1, 2, 1>(ya, a1load, [&](int w, int n, int k) { return *(const uint4*)(WPA + (unsigned)((col0 + n) * 512 + k)); }, 512, As, Bs, wrow0, wcol0, tidn);
#pragma unroll
        for (int ni = 0; ni < 2; ++ni)
#pragma unroll
          for (int i = 0; i < 16; ++i) sg[0][0][ni][i] *= ya[0][0][ni][i];
      }
      {
        f32x16 yb[1][1][2] = {{{zero16(), zero16()}}};
        gemm_pass<128, 128, 1, 2, 1>(yb, a2load, [&](int w, int n, int k) { return *(const uint4*)(WPB + (unsigned)((col0 + n) * 512 + k)); }, 512, As, Bs, wrow0, wcol0, tidn);
        int rb1 = row0 + wrow0 + 4 * hh;
        asm volatile("" : "+v"(rb1));
#pragma unroll
        for (int ni = 0; ni < 2; ++ni) {
          const int col = col0 + wcol0 + ni * 32 + l31;
#pragma unroll
          for (int i = 0; i < 16; ++i) {
            const float mv = sg[0][0][ni][i] + sg[1][0][ni][i] * yb[0][0][ni][i];
            ZG[(unsigned)((rb1 + crow(i, 0)) * 1024 + col)] = f2bf(mv);
          }
        }
      }
    }
    asm volatile("s_waitcnt vmcnt(0)" ::: "memory");
    __syncthreads();
#if PROBE
    if (mt == 0) {
      float d2 = 0.f, r2 = 0.f;
      if (tid < 64) {
        const int r = (tid * 37) & 127, col = (tid * 131 + 7) & 1023, row = row0 + r;
        const ushort_t* hrow = (const ushort_t*)(p.out + (size_t)row * DM);
        float ga = p.b_mg[col], gb = p.b_mg[1024 + col], ya = 0.f, yb = 0.f;
        for (int k = 0; k < 1024; ++k) { const float hv = bf2f(hrow[k]); ga += hv * p.w_mg[(size_t)k * 2048 + col]; gb += hv * p.w_mg[(size_t)k * 2048 + 1024 + col]; }
        for (int k = 0; k < 512; ++k) {
          ya += bf2f(QB[((size_t)(b * 8 + (k >> 6)) * SEQ + tb0 + r) * 64 + (k & 63)]) * p.w_pa[(size_t)k * 1024 + col];
          yb += bf2f(O[(size_t)row * 512 + k]) * p.w_pb[(size_t)k * 1024 + col];
        }
        const float ref = ya / (1.f + expf(-ga)) + yb / (1.f + expf(-gb));
        const float got = bf2f(ZG[(size_t)row * 1024 + col]);
        d2 = (got - ref) * (got - ref); r2 = ref * ref;
      }
      dbg_acc(p, 2, d2, r2);
    }
#endif
    const float* gt = md + 2048;
#pragma unroll 1
    for (int nt = 0; nt < 8; ++nt) {
      const int col0 = nt * 128;
      int tidn = tid;
      asm volatile("" : "+v"(tidn));
      f32x16 acc[1][1][2] = {{{zero16(), zero16()}}};
      gemm_pass<128, 128, 1, 2, 1>(acc, [&](int r, int k) { return *(const uint4*)(ZG + (unsigned)((row0 + r) * 1024 + k)); },
                                   [&](int w, int n, int k) { return *(const uint4*)(WO + (unsigned)((col0 + n) * DM + k)); }, DM, As, Bs, wrow0, wcol0, tidn);
      int rb2 = row0 + wrow0 + 4 * hh;
      asm volatile("" : "+v"(rb2));
#pragma unroll
      for (int ni = 0; ni < 2; ++ni) {
        const int col = col0 + wcol0 + ni * 32 + l31;
        const float g = gt[col];
#pragma unroll
        for (int i = 0; i < 16; ++i) {
          const unsigned idx = (unsigned)((rb2 + crow(i, 0)) * DM + col);
          p.out[idx] = ALPHA * p.x[idx] + g * acc[0][0][ni][i];
        }
      }
    }
    asm volatile("s_waitcnt vmcnt(0)" ::: "memory");
    __syncthreads();
#if PROBE
    if (mt == 0) {
      float d2 = 0.f, r2 = 0.f;
      if (tid < 64) {
        const int r = (tid * 29) & 127, col = (tid * 113 + 5) & 1023, row = row0 + r;
        float o = 0.f;
        for (int k = 0; k < 1024; ++k) o += bf2f(ZG[(size_t)row * 1024 + k]) * p.w_o[(size_t)k * 1024 + col];
        const float ref = md[2048 + col] * o;
        const float got = p.out[(size_t)row * DM + col] - ALPHA * p.x[(size_t)row * DM + col];
        d2 = (got - ref) * (got - ref); r2 = ref * ref;
      }
      dbg_acc(p, 3, d2, r2);
    }
    asm volatile("s_waitcnt vmcnt(0)" ::: "memory");
    __syncthreads();
#endif
#if !PROBE
#pragma unroll 1
    for (int r4 = wave * 4; r4 < 128; r4 += 32) {
      const int r = r4 + (lane >> 4), l16 = lane & 15;
      float* dst = p.out + (size_t)(row0 + r) * DM;
      float4 v[16];
      const float rstd = ln_rows4(dst, l16, v);
#pragma unroll
      for (int i = 0; i < 16; ++i) {
        const int col = l16 * 4 + 64 * i;
        const float4 g = *(const float4*)(p.ln_g + col), bb = *(const float4*)(p.ln_b + col);
        *(float4*)(dst + col) = make_float4(v[i].x * rstd * g.x + bb.x, v[i].y * rstd * g.y + bb.y, v[i].z * rstd * g.z + bb.z, v[i].w * rstd * g.w + bb.w);
      }
    }
#endif
  }
}


#if PROBE
DI void probe_f3(const Params& p) {
  const float pdelta = probe_delta(p);
  const int lane = threadIdx.x & 63, wave = threadIdx.x >> 6;
  for (int mt = blockIdx.x; mt < NX / 128; mt += gridDim.x) {
    for (int r = wave; r < 128; r += 8) {
      const float* src = p.x + (size_t)(mt * 128 + r) * DM;
      float* dst = p.out + (size_t)(mt * 128 + r) * DM;
      float s = 0.f, q = 0.f;
      for (int i = lane; i < 1024; i += 64) s += ALPHA * src[i];
      const float mu = wave_sum(s) / 1024.f;
      for (int i = lane; i < 1024; i += 64) { const float d = ALPHA * src[i] - mu; q += d * d; }
      const float rstd = rsqrtf(wave_sum(q) / 1024.f + LN_EPS);
      for (int i = lane; i < 1024; i += 64) dst[i] = (ALPHA * src[i] - mu) * rstd * p.ln_g[i] + p.ln_b[i] + pdelta;
    }
  }
}
#endif
DI void gsync(cg::grid_group& g) { asm volatile("s_waitcnt vmcnt(0) lgkmcnt(0)" ::: "memory"); g.sync(); }

constexpr int SMEM_BYTES = 8 * 2 * SEG * 64 * 2;
static_assert(SMEM_BYTES >= 2 * (256 + 128) * LDK * 2, "GEMM tiles");
static_assert(SMEM_BYTES >= 65536 + 32 * 264 * 2 + 1024, "rwkv prep LDS");
__global__ void __launch_bounds__(NTH) fwd_megakernel(Params p) {
  __shared__ __attribute__((aligned(16))) unsigned char smem[SMEM_BYTES];
  cg::grid_group grid = cg::this_grid();
#if PROBE
  if (blockIdx.x == 0 && threadIdx.x < 64) ((float*)(p.ws + OFF_DBG))[threadIdx.x] = 0.f;
#endif
  phase0(p, smem);
  gsync(grid);
  phase_h(p);
  gsync(grid);
  if (__builtin_amdgcn_readfirstlane(threadIdx.x) >= 256) __builtin_amdgcn_s_setprio(1);
  phase_gemm1(p, smem);
  __builtin_amdgcn_s_setprio(0);
  gsync(grid);
  phase_qkv(p);
  phase_rwkv_prep(p, smem);
  gsync(grid);
#if PROBE_NAIVE_SCAN
  phase_scan_naive(p);
#else
  if (__builtin_amdgcn_readfirstlane(threadIdx.x) >= 256) __builtin_amdgcn_s_setprio(1);
  phase_scanA(p, smem);
  __builtin_amdgcn_s_setprio(0);
  gsync(grid);
  phase_scanB(p, smem);
  gsync(grid);
  phase_scanC(p, smem);
#endif
  if (__builtin_amdgcn_readfirstlane(threadIdx.x) >= 256) __builtin_amdgcn_s_setprio(1);
  phase_attn(p, smem);
  __builtin_amdgcn_s_setprio(0);
  gsync(grid);
#if PROBE
  probe_scan(p);
  gsync(grid);
#endif
  if (__builtin_amdgcn_readfirstlane(threadIdx.x) >= 256) __builtin_amdgcn_s_setprio(1);
  phase_final(p, smem);
  __builtin_amdgcn_s_setprio(0);
#if PROBE
  gsync(grid);
  probe_f3(p);
#endif
}

extern "C" void kernel_launch(void* const* d_in, const int* in_sizes, int n_in, void* d_out, int out_size, void* d_ws, size_t ws_size,
                              hipStream_t stream) {
  static int grid_blocks = 0;
  if (!grid_blocks) {
    int dev = 0, cus = 0, per_cu = 0;
    hipGetDevice(&dev);
    hipDeviceGetAttribute(&cus, hipDeviceAttributeMultiprocessorCount, dev);
    hipOccupancyMaxActiveBlocksPerMultiprocessor(&per_cu, fwd_megakernel, NTH, 0);
    if (per_cu < 1) fprintf(stderr, "occupancy query says %d blocks/CU\n", per_cu);
    grid_blocks = cus > 0 ? cus : 256;
    if (ws_size < WS_END) fprintf(stderr, "workspace too small: %zu < %zu\n", ws_size, (size_t)WS_END);
  }
  Params p{};
  const float** fp = (const float**)&p;
  for (int i = 0; i < 27; ++i) fp[i] = (const float*)d_in[i];
  p.out = (float*)d_out;
  p.ws = (unsigned char*)d_ws;
  void* args[] = {&p};
  hipError_t e = hipLaunchCooperativeKernel((void*)fwd_megakernel, dim3(grid_blocks), dim3(NTH), args, 0, stream);
  if (e != hipSuccess) fprintf(stderr, "cooperative launch failed: %s (grid %d)\n", hipGetErrorString(e), grid_blocks);
}
```

```cpp
#include <hip/hip_runtime.h>
#include <hip/hip_cooperative_groups.h>
#include <stdint.h>
#include <cstdio>
namespace cg = cooperative_groups;

#define PROBE 0
#define DI __device__ __forceinline__
typedef __attribute__((ext_vector_type(8))) short bf16x8;
typedef __attribute__((ext_vector_type(16))) float f32x16;
typedef __attribute__((ext_vector_type(16))) uint32_t u32x16;
typedef __attribute__((ext_vector_type(2))) _Float16 h2;
typedef __attribute__((ext_vector_type(2))) __bf16 b2;
typedef unsigned short ushort_t;
typedef __attribute__((ext_vector_type(4))) uint32_t u32x4;
#define MFMA(a, b, c) __builtin_amdgcn_mfma_f32_32x32x16_bf16((a), (b), (c), 0, 0, 0)

constexpr int DM = 1024, NB = 2, SEQ = 16384, CTXL = 256;
constexpr int NX = NB * SEQ, NC = NB * CTXL, NT = NX + NC;
constexpr int INW = 3584, LTOT = CTXL + SEQ;
constexpr int NTH = 512;
constexpr int CH = 260, NCHUNK = LTOT / CH;
static_assert(NCHUNK * CH == LTOT, "chunking");
constexpr float LN_EPS = 1e-5f, QK_EPS = 1e-6f, GN_EPS = 64e-5f;
constexpr float ALPHA = 1.189207115002721f;
constexpr float QSCALE = 0.125f * 1.4426950408889634f;

constexpr size_t OFF_WIN = 0;
constexpr size_t OFF_WMG = OFF_WIN + (size_t)INW * DM * 2;
constexpr size_t OFF_WPA = OFF_WMG + (size_t)2048 * DM * 2;
constexpr size_t OFF_WPB = OFF_WPA + (size_t)1024 * 512 * 2;
constexpr size_t OFF_WO  = OFF_WPB + (size_t)1024 * 512 * 2;
constexpr size_t OFF_WL  = OFF_WO + (size_t)1024 * 1024 * 2;
constexpr size_t OFF_MOD = OFF_WL + (size_t)2 * 2 * 512 * 64 * 2;
constexpr size_t OFF_ZG  = OFF_MOD + 36864;
constexpr size_t OFF_QB  = OFF_ZG + (size_t)NX * 1024 * 2;
constexpr size_t OFF_KB  = OFF_QB + (size_t)NX * 512 * 2;
constexpr size_t OFF_VB  = OFF_KB + (size_t)NB * 2 * LTOT * 64 * 2;
constexpr size_t OFF_SH  = OFF_VB + (size_t)NB * 2 * LTOT * 64 * 2;
constexpr size_t OFF_DR  = OFF_SH + (size_t)16 * LTOT * 192 * 2;
constexpr size_t OFF_ZQ  = OFF_DR + (size_t)32 * LTOT * 192 * 2;
constexpr size_t WS_END  = OFF_ZQ + (size_t)2 * NX * 512 * 2;
static_assert(WS_END <= (size_t)536870912, "workspace");
static_assert((size_t)NT * DM * 2 <= (size_t)48 * LTOT * 192 * 2, "H alias");
static_assert((size_t)NT * 768 * 2 <= (size_t)2 * NX * 512 * 2, "zqkv alias");

struct Params {
  const float *x, *c, *ctx, *c_ctx, *w_ada, *b_ada, *w_in, *q_norm, *k_norm, *mu_prev, *mu_next, *w0, *w_up, *a0, *a_up, *k_k, *k_a,
      *r_k, *gn_w, *gn_b, *w_pa, *w_pb, *w_mg, *b_mg, *w_o, *ln_g, *ln_b;
  float* out;
  unsigned char* ws;
};

DI ushort_t f2bf(float f) { return __builtin_bit_cast(ushort_t, (__bf16)f); }
DI float bf2f(ushort_t b) { return __uint_as_float(((unsigned)b) << 16); }
DI unsigned pack_bf2(float a, float b) { b2 v = {(__bf16)a, (__bf16)b}; return __builtin_bit_cast(unsigned, v); }
DI unsigned pack_h2(float a, float b) { h2 v = {(_Float16)a, (_Float16)b}; return __builtin_bit_cast(unsigned, v); }
DI ushort_t f2h(float f) { return __builtin_bit_cast(ushort_t, (_Float16)f); }
DI float h2f(ushort_t h) { return (float)__builtin_bit_cast(_Float16, h); }
DI float bflo(unsigned u) { return __uint_as_float(u << 16); }
DI float bfhi(unsigned u) { return __uint_as_float(u & 0xffff0000u); }
DI float hlo(unsigned u) { return (float)__builtin_bit_cast(h2, u)[0]; }
DI float hhi(unsigned u) { return (float)__builtin_bit_cast(h2, u)[1]; }
DI float sigmf(float v) { return __builtin_amdgcn_rcpf(1.f + __expf(-v)); }
DI float siluf(float v) { return v * sigmf(v); }
DI int crow(int reg, int h) { return (reg & 3) + 8 * (reg >> 2) + 4 * h; }
DI float wave_sum(float v) {
#pragma unroll
  for (int o = 32; o >= 1; o >>= 1) v += __shfl_xor(v, o, 64);
  return v;
}
DI float sum16(float v) {
#pragma unroll
  for (int o = 8; o >= 1; o >>= 1) v += __shfl_xor(v, o, 64);
  return v;
}
DI float ln_rows4(const float* src, int l16, float4 (&v)[16]) {
  float s = 0.f;
#pragma unroll
  for (int i = 0; i < 16; ++i) { v[i] = *(const float4*)(src + l16 * 4 + 64 * i); s += v[i].x + v[i].y + v[i].z + v[i].w; }
  const float mu = sum16(s) * (1.f / DM);
  float q = 0.f;
#pragma unroll
  for (int i = 0; i < 16; ++i) { v[i].x -= mu; v[i].y -= mu; v[i].z -= mu; v[i].w -= mu; q += v[i].x * v[i].x + v[i].y * v[i].y + v[i].z * v[i].z + v[i].w * v[i].w; }
  return rsqrtf(sum16(q) * (1.f / DM) + LN_EPS);
}
DI f32x16 zero16() { f32x16 z;
#pragma unroll
  for (int i = 0; i < 16; ++i) z[i] = 0.f; return z; }

#define SCAN_VLOAD 0
#define PROBE_NAIVE_SCAN 0
#if SCAN_VLOAD
DI void sload2(u32x16& a0, u32x16& a1, const void* p) { a0 = *(const u32x16*)p; a1 = *((const u32x16*)p + 1); }
DI void sload4(u32x16& a0, u32x16& a1, u32x16& b0, u32x16& b1, const void* p, const void* q) {
  a0 = *(const u32x16*)p; a1 = *((const u32x16*)p + 1); b0 = *(const u32x16*)q; b1 = *((const u32x16*)q + 1);
}
#else
DI void sload2(u32x16& a0, u32x16& a1, const void* p) {
  asm volatile("s_load_dwordx16 %0, %2, 0x0\n\ts_load_dwordx16 %1, %2, 0x40\n\ts_waitcnt lgkmcnt(0)" : "=&s"(a0), "=&s"(a1) : "s"(p) : "memory");
}
DI void sload4(u32x16& a0, u32x16& a1, u32x16& b0, u32x16& b1, const void* p, const void* q) {
  asm volatile("s_load_dwordx16 %0, %4, 0x0\n\ts_load_dwordx16 %1, %4, 0x40\n\ts_load_dwordx16 %2, %5, 0x0\n\ts_load_dwordx16 %3, %5, 0x40\n\ts_waitcnt lgkmcnt(0)"
               : "=&s"(a0), "=&s"(a1), "=&s"(b0), "=&s"(b1) : "s"(p), "s"(q) : "memory");
}
#endif
DI float HV(const u32x16& v, int j) { const uint32_t w = v[j >> 1]; const h2 t = __builtin_bit_cast(h2, w); return (float)t[j & 1]; }

constexpr int LDK = 72;
template <int BM, int BN, int MI, int NI, int NB, class AL, class BL>
DI void gemm_pass(f32x16 (&acc)[NB][MI][NI], AL aload, BL bload, int K, ushort_t* As, ushort_t* Bs, int wrow0, int wcol0, int tid) {
  constexpr int NA = BM * 8 / NTH, NBC = BN * 8 / NTH;
  constexpr int ASZ = BM * LDK, BSZ = NB * BN * LDK;
  const int lane = tid & 63, l31 = lane & 31, hh = lane >> 5;
  const int nk = K >> 6;
  uint4 ra[2][NA], rb[2][NB][NBC];
  auto gload = [&](int s, int kt) {
#pragma unroll
    for (int i = 0; i < NA; ++i) { const int id = tid + i * NTH; ra[s][i] = aload(id >> 3, kt * 64 + (id & 7) * 8); }
#pragma unroll
    for (int w = 0; w < NB; ++w)
#pragma unroll
      for (int i = 0; i < NBC; ++i) { const int id = tid + i * NTH; rb[s][w][i] = bload(w, id >> 3, kt * 64 + (id & 7) * 8); }
  };
  auto lstore = [&](int s, int buf) {
#pragma unroll
    for (int i = 0; i < NA; ++i) { const int id = tid + i * NTH; *(uint4*)&As[buf * ASZ + (id >> 3) * LDK + (id & 7) * 8] = ra[s][i]; }
#pragma unroll
    for (int w = 0; w < NB; ++w)
#pragma unroll
      for (int i = 0; i < NBC; ++i) { const int id = tid + i * NTH; *(uint4*)&Bs[buf * BSZ + w * BN * LDK + (id >> 3) * LDK + (id & 7) * 8] = rb[s][w][i]; }
  };
  auto compute = [&](int buf) {
#pragma unroll
    for (int ks = 0; ks < 4; ++ks) {
      bf16x8 af[MI];
#pragma unroll
      for (int mi = 0; mi < MI; ++mi) af[mi] = *(const bf16x8*)&As[buf * ASZ + (wrow0 + mi * 32 + l31) * LDK + ks * 16 + hh * 8];
#pragma unroll
      for (int w = 0; w < NB; ++w) {
        bf16x8 bfv[NI];
#pragma unroll
        for (int ni = 0; ni < NI; ++ni) bfv[ni] = *(const bf16x8*)&Bs[buf * BSZ + w * BN * LDK + (wcol0 + ni * 32 + l31) * LDK + ks * 16 + hh * 8];
#pragma unroll
        for (int mi = 0; mi < MI; ++mi)
#pragma unroll
          for (int ni = 0; ni < NI; ++ni) acc[w][mi][ni] = MFMA(af[mi], bfv[ni], acc[w][mi][ni]);
      }
    }
  };
  __syncthreads();
  gload(0, 0);
  lstore(0, 0);
  gload(1, 1);
  gload(0, 2);
#pragma unroll 1
  for (int kt = 0; kt < nk; kt += 2) {
    __syncthreads();
    lstore(1, 1);
    if (kt + 3 < nk) gload(1, kt + 3);
    compute(0);
    __syncthreads();
    if (kt + 2 < nk) { lstore(0, 0); if (kt + 4 < nk) gload(0, kt + 4); }
    compute(1);
  }
}

DI void transpose_tile(const float* __restrict__ src, int ld_src, ushort_t* dst, int ld_dst, int k0, int n0, float* T) {
  const int tid = threadIdx.x;
#pragma unroll
  for (int i = 0; i < 2; ++i) {
    const int k = (tid >> 4) + 32 * i, n4 = (tid & 15) * 4;
    const float4 v = *(const float4*)(src + (size_t)(k0 + k) * ld_src + n0 + n4);
    T[k * 65 + n4 + 0] = v.x; T[k * 65 + n4 + 1] = v.y; T[k * 65 + n4 + 2] = v.z; T[k * 65 + n4 + 3] = v.w;
  }
  __syncthreads();
  const int n = tid >> 3, kc = tid & 7;
  uint4 o;
  o.x = pack_bf2(T[(kc * 8 + 0) * 65 + n], T[(kc * 8 + 1) * 65 + n]);
  o.y = pack_bf2(T[(kc * 8 + 2) * 65 + n], T[(kc * 8 + 3) * 65 + n]);
  o.z = pack_bf2(T[(kc * 8 + 4) * 65 + n], T[(kc * 8 + 5) * 65 + n]);
  o.w = pack_bf2(T[(kc * 8 + 6) * 65 + n], T[(kc * 8 + 7) * 65 + n]);
  *(uint4*)(dst + (size_t)(n0 + n) * ld_dst + k0 + kc * 8) = o;
  __syncthreads();
}

DI void phase0(const Params& p, unsigned char* smem) {
  float* T = (float*)smem;
  ushort_t* win = (ushort_t*)(p.ws + OFF_WIN);
  ushort_t* wmg = (ushort_t*)(p.ws + OFF_WMG);
  ushort_t* wpa = (ushort_t*)(p.ws + OFF_WPA);
  ushort_t* wpb = (ushort_t*)(p.ws + OFF_WPB);
  ushort_t* wo = (ushort_t*)(p.ws + OFF_WO);
  ushort_t* wl = (ushort_t*)(p.ws + OFF_WL);
  float* mod = (float*)(p.ws + OFF_MOD);
  constexpr int T_IN = 16 * 56, T_MG = 16 * 32, T_PA = 8 * 16, T_PB = 8 * 16, T_O = 16 * 16, T_L = 32, T_MOD = 48;
  constexpr int TOTAL = T_MOD + T_IN + T_MG + T_PA + T_PB + T_O + T_L;
  for (int t = blockIdx.x; t < TOTAL; t += gridDim.x) {
    int u = t;
    if (u < T_MOD) {
      float* sil = T;
      float* red = T + 3072;
      const int tid = threadIdx.x;
      for (int i = tid; i < 3072; i += NTH) {
        const int v = i >> 10, k = i & 1023;
        const float cv = (v < 2) ? p.c[v * 1024 + k] : p.c_ctx[k];
        sil[i] = siluf(cv);
      }
      __syncthreads();
      const int n = tid & 63, ksl = tid >> 6, n0 = u * 64;
      float a0 = 0.f, a1 = 0.f, a2 = 0.f;
      for (int k = ksl * 128; k < ksl * 128 + 128; ++k) {
        const float w = p.w_ada[(size_t)k * 3072 + n0 + n];
        a0 = fmaf(sil[k], w, a0); a1 = fmaf(sil[1024 + k], w, a1); a2 = fmaf(sil[2048 + k], w, a2);
      }
      red[(ksl * 3 + 0) * 64 + n] = a0; red[(ksl * 3 + 1) * 64 + n] = a1; red[(ksl * 3 + 2) * 64 + n] = a2;
      __syncthreads();
      if (tid < 192) {
        const int v = tid >> 6, nn = tid & 63;
        float s = 0.f;
#pragma unroll
        for (int q = 0; q < 8; ++q) s += red[(q * 3 + v) * 64 + nn];
        mod[v * 3072 + n0 + nn] = s + p.b_ada[n0 + nn];
      }
      __syncthreads();
      continue;
    }
    u -= T_MOD;
    if (u < T_IN) { transpose_tile(p.w_in, INW, win, 1024, (u / 56) * 64, (u % 56) * 64, T); continue; }
    u -= T_IN;
    if (u < T_MG) { transpose_tile(p.w_mg, 2048, wmg, 1024, (u / 32) * 64, (u % 32) * 64, T); continue; }
    u -= T_MG;
    if (u < T_PA) { transpose_tile(p.w_pa, 1024, wpa, 512, (u / 16) * 64, (u % 16) * 64, T); continue; }
    u -= T_PA;
    if (u < T_PB) { transpose_tile(p.w_pb, 1024, wpb, 512, (u / 16) * 64, (u % 16) * 64, T); continue; }
    u -= T_PB;
    if (u < T_O) { transpose_tile(p.w_o, 1024, wo, 1024, (u / 16) * 64, (u % 16) * 64, T); continue; }
    u -= T_O;
    {
      const int which = u >> 4, dir = (u >> 3) & 1, nt = u & 7;
      const float* src = (which ? p.a_up : p.w_up) + (size_t)dir * 64 * 512;
      transpose_tile(src, 512, wl + (size_t)((dir * 2 + which) * 512) * 64, 64, 0, nt * 64, T);
    }
  }
}

DI void phase_h(const Params& p) {
  const float* mod = (const float*)(p.ws + OFF_MOD);
  ushort_t* H = (ushort_t*)(p.ws + OFF_SH);
  const int lane = threadIdx.x & 63, l16 = lane & 15, gw = blockIdx.x * 8 + (threadIdx.x >> 6);
#pragma unroll 1
  for (int r4 = gw * 4; r4 < NT; r4 += gridDim.x * 32) {
    const int row = r4 + (lane >> 4);
    const float* src = (row < NX) ? p.x + (size_t)row * DM : p.ctx + (size_t)(row - NX) * DM;
    const float* md = mod + ((row < NX) ? (row / SEQ) : 2) * 3072;
    float4 v[16];
    const float rstd = ln_rows4(src, l16, v);
#pragma unroll
    for (int i = 0; i < 16; ++i) {
      const int col = l16 * 4 + 64 * i;
      const float4 sh = *(const float4*)(md + col), sc = *(const float4*)(md + 1024 + col);
      uint2 o;
      o.x = pack_bf2(v[i].x * rstd * (1.f + sc.x) + sh.x, v[i].y * rstd * (1.f + sc.y) + sh.y);
      o.y = pack_bf2(v[i].z * rstd * (1.f + sc.z) + sh.z, v[i].w * rstd * (1.f + sc.w) + sh.w);
      *(uint2*)(H + (size_t)row * DM + col) = o;
    }
  }
}

DI void phase_gemm1(const Params& p, unsigned char* smem) {
  ushort_t* As = (ushort_t*)smem;
  ushort_t* Bs = As + 2 * 256 * LDK;
  const ushort_t* H = (const ushort_t*)(p.ws + OFF_SH);
  const ushort_t* W = (const ushort_t*)(p.ws + OFF_WIN);
  ushort_t* zq = (ushort_t*)(p.ws + OFF_ZQ);
  ushort_t* zg = (ushort_t*)(p.ws + OFF_ZG);
  ushort_t* zm = (ushort_t*)p.out;
  const int tid = threadIdx.x, wave = tid >> 6, lane = tid & 63, l31 = lane & 31, hh = lane >> 5;
  const int wrow0 = (wave & 3) * 64, wcol0 = (wave >> 2) * 64;
  constexpr int MT = NT / 256, NTL = INW / 128;
  for (int t = blockIdx.x; t < MT * NTL; t += gridDim.x) {
    const int mt = t / NTL, nt = t % NTL;
    const bool is_g = (nt >= 6 && nt < 10) || nt >= 24;
    if (is_g && mt >= NX / 256) continue;
    const int row0 = mt * 256, col0 = nt * 128;
    f32x16 acc[1][2][2];
#pragma unroll
    for (int a = 0; a < 2; ++a)
#pragma unroll
      for (int b = 0; b < 2; ++b) acc[0][a][b] = zero16();
    auto aload = [&](int r, int k) { return *(const uint4*)(H + (size_t)(row0 + r) * DM + k); };
    auto bload = [&](int w, int n, int k) { return *(const uint4*)(W + (size_t)(col0 + n) * DM + k); };
    gemm_pass<256, 128, 2, 2, 1>(acc, aload, bload, DM, As, Bs, wrow0, wcol0, tid);
    ushort_t* dst; int ld, cbase;
    if (nt < 6) { dst = zq; ld = 768; cbase = col0; }
    else if (nt < 10) { dst = zg; ld = 1024; cbase = col0 - 768; }
    else if (nt < 24) { dst = zm; ld = 1792; cbase = col0 - 1280; }
    else { dst = zg; ld = 1024; cbase = 512 + col0 - 3072; }
#pragma unroll
    for (int mi = 0; mi < 2; ++mi)
#pragma unroll
      for (int ni = 0; ni < 2; ++ni)
#pragma unroll
        for (int i = 0; i < 16; ++i) {
          const int row = row0 + wrow0 + mi * 32 + crow(i, hh), col = cbase + wcol0 + ni * 32 + l31;
          dst[(size_t)row * ld + col] = f2bf(acc[0][mi][ni][i]);
        }
  }
}

DI int vperm(int key) { const int g = key >> 4, kq = key & 15; return g * 16 + 8 * ((kq >> 2) & 1) + (kq & 3) + 4 * (kq >> 3); }
DI void phase_qkv(const Params& p) {
  const ushort_t* zq = (const ushort_t*)(p.ws + OFF_ZQ);
  ushort_t* QB = (ushort_t*)(p.ws + OFF_QB);
  ushort_t* KB = (ushort_t*)(p.ws + OFF_KB);
  ushort_t* VB = (ushort_t*)(p.ws + OFF_VB);
  const int lane = threadIdx.x & 63, gw = blockIdx.x * 8 + (threadIdx.x >> 6);
  const int j = lane & 31, half = lane >> 5, axis = j >> 4, f = j & 15;
  const int d1 = axis * 32 + f, d2 = d1 + 16;
  const float inv = powf(10000.f, -(float)f * (1.f / 16.f));
  const float gq1 = p.q_norm[d1], gq2 = p.q_norm[d2], gk1 = p.k_norm[d1], gk2 = p.k_norm[d2];
  for (int row = gw; row < NT; row += gridDim.x * 8) {
    const bool isx = row < NX;
    const int b = isx ? row / SEQ : (row - NX) / CTXL;
    const int t = isx ? row % SEQ : (row - NX) % CTXL;
    const int pos = isx ? CTXL + t : t;
    const ushort_t* z = zq + (size_t)row * 768;
    float cs = 1.f, sn = 0.f;
    if (isx) { const float ang = (float)(axis ? (t & 63) : (t >> 6)) * inv; sincosf(ang, &sn, &cs); }
#pragma unroll
    for (int it = 0; it < 5; ++it) {
      const int hd = it * 2 + half;
      if (!isx && hd < 8) continue;
      const float v1 = bf2f(z[hd * 64 + d1]), v2 = bf2f(z[hd * 64 + d2]);
      float ss = v1 * v1 + v2 * v2;
#pragma unroll
      for (int o = 16; o >= 1; o >>= 1) ss += __shfl_xor(ss, o, 64);
      const float rms = rsqrtf(ss * (1.f / 64.f) + QK_EPS);
      const bool isq = hd < 8;
      const float y1 = v1 * rms * (isq ? gq1 : gk1), y2 = v2 * rms * (isq ? gq2 : gk2);
      float o1 = y1 * cs - y2 * sn, o2 = y2 * cs + y1 * sn;
      if (isq) {
        ushort_t* dst = QB + ((size_t)(b * 8 + hd) * SEQ + t) * 64;
        dst[d1] = f2bf(o1 * QSCALE); dst[d2] = f2bf(o2 * QSCALE);
      } else {
        ushort_t* dst = KB + ((size_t)(b * 2 + (hd - 8)) * LTOT + pos) * 64;
        dst[d1] = f2bf(o1); dst[d2] = f2bf(o2);
      }
    }
    {
      const size_t tb = (size_t)(pos >> 6) * 4096 + lane * 64 + vperm(pos & 63);
      VB[(size_t)(b * 2 + 0) * LTOT * 64 + tb] = z[640 + lane];
      VB[(size_t)(b * 2 + 1) * LTOT * 64 + tb] = z[704 + lane];
    }
  }
}

DI void phase_rwkv_prep(const Params& p, unsigned char* smem) {
  float* kbuf = (float*)smem;
  ushort_t* codes = (ushort_t*)(smem + 65536);
  float* invn = (float*)(smem + 65536 + 32 * 264 * 2);
  const ushort_t* zm = (const ushort_t*)p.out;
  const ushort_t* WL = (const ushort_t*)(p.ws + OFF_WL);
  ushort_t* SH = (ushort_t*)(p.ws + OFF_SH);
  ushort_t* DR = (ushort_t*)(p.ws + OFF_DR);
  const int tid = threadIdx.x, wave = tid >> 6, lane = tid & 63, l31 = lane & 31, hh = lane >> 5;
  for (int tt = blockIdx.x; tt < NT / 32; tt += gridDim.x) {
    const int row0 = tt * 32;
    int b, t0, len, pbase;
    if (row0 < NX) { b = row0 / SEQ; t0 = row0 % SEQ; len = SEQ; pbase = CTXL; }
    else { const int rc = row0 - NX; b = rc / CTXL; t0 = rc % CTXL; len = CTXL; pbase = 0; }
    __syncthreads();
    for (int id = tid; id < 32 * 224; id += NTH) {
      const int i = id / 224, c0 = (id % 224) * 8;
      const int t = t0 + i;
      const ushort_t* zr = zm + (size_t)(row0 + i) * 1792 + c0;
      const uint4 zc = *(const uint4*)zr;
      uint4 zp = make_uint4(0, 0, 0, 0), zn = make_uint4(0, 0, 0, 0);
      if (t > 0) zp = *(const uint4*)(zr - 1792);
      if (t < len - 1) zn = *(const uint4*)(zr + 1792);
      const float4 mp0 = *(const float4*)(p.mu_prev + c0), mp1 = *(const float4*)(p.mu_prev + c0 + 4);
      const float4 mn0 = *(const float4*)(p.mu_next + c0), mn1 = *(const float4*)(p.mu_next + c0 + 4);
      const unsigned zcw[4] = {zc.x, zc.y, zc.z, zc.w}, zpw[4] = {zp.x, zp.y, zp.z, zp.w}, znw[4] = {zn.x, zn.y, zn.z, zn.w};
      const float mpv[8] = {mp0.x, mp0.y, mp0.z, mp0.w, mp1.x, mp1.y, mp1.z, mp1.w};
      const float mnv[8] = {mn0.x, mn0.y, mn0.z, mn0.w, mn1.x, mn1.y, mn1.z, mn1.w};
      float s[8];
#pragma unroll
      for (int q = 0; q < 4; ++q) {
        const float c_lo = bflo(zcw[q]), c_hi = bfhi(zcw[q]);
        s[2 * q] = c_lo + mpv[2 * q] * (bflo(zpw[q]) - c_lo) + mnv[2 * q] * (bflo(znw[q]) - c_lo);
        s[2 * q + 1] = c_hi + mpv[2 * q + 1] * (bfhi(zpw[q]) - c_hi) + mnv[2 * q + 1] * (bfhi(znw[q]) - c_hi);
      }
      const int pp = pbase + t;
      if (c0 < 512 || (c0 >= 1024 && c0 < 1536)) {
        const int cc = (c0 < 512) ? c0 : c0 - 1024, which = (c0 < 512) ? 1 : 2;
        const int head = cc >> 6, d = cc & 63;
        uint4 o;
        o.x = pack_h2(s[0], s[1]); o.y = pack_h2(s[2], s[3]); o.z = pack_h2(s[4], s[5]); o.w = pack_h2(s[6], s[7]);
        *(uint4*)(SH + (((size_t)(b * 8 + head) * LTOT + pp) * 3 + which) * 64 + d) = o;
      } else if (c0 < 1024) {
        float* kd = kbuf + i * 512 + (c0 - 512);
        *(float4*)kd = make_float4(s[0], s[1], s[2], s[3]);
        *(float4*)(kd + 4) = make_float4(s[4], s[5], s[6], s[7]);
      } else {
        const int cc = c0 - 1536;
        if (cc < 128) {
#pragma unroll
          for (int q = 0; q < 8; ++q) s[q] = tanhf(s[q]);
        }
        uint4 o;
        o.x = pack_bf2(s[0], s[1]); o.y = pack_bf2(s[2], s[3]); o.z = pack_bf2(s[4], s[5]); o.w = pack_bf2(s[6], s[7]);
        *(uint4*)(codes + i * 264 + cc) = o;
      }
    }
    __syncthreads();
    {
      const int i = tid >> 4, head = (tid >> 1) & 7, hf = tid & 1;
      float ss = 0.f;
#pragma unroll 8
      for (int q = 0; q < 32; ++q) {
        const int n = head * 64 + hf * 32 + q;
        const float v = kbuf[i * 512 + n] * p.k_k[n];
        ss = fmaf(v, v, ss);
      }
      ss += __shfl_xor(ss, 1, 64);
      if (hf == 0) invn[i * 8 + head] = 1.f / fmaxf(sqrtf(ss), 1e-12f);
    }
    __syncthreads();
#pragma unroll 1
    for (int q4 = 0; q4 < 4; ++q4) {
      const int pr = wave * 4 + q4, dir = pr >> 4, ct = pr & 15;
      f32x16 aw = zero16(), aa = zero16();
#pragma unroll
      for (int ks = 0; ks < 4; ++ks) {
        const bf16x8 fw = *(const bf16x8*)&codes[l31 * 264 + dir * 64 + ks * 16 + hh * 8];
        const bf16x8 fa = *(const bf16x8*)&codes[l31 * 264 + 128 + dir * 64 + ks * 16 + hh * 8];
        const bf16x8 bw = *(const bf16x8*)&WL[(size_t)((dir * 2 + 0) * 512 + ct * 32 + l31) * 64 + ks * 16 + hh * 8];
        const bf16x8 ba = *(const bf16x8*)&WL[(size_t)((dir * 2 + 1) * 512 + ct * 32 + l31) * 64 + ks * 16 + hh * 8];
        aw = MFMA(fw, bw, aw);
        aa = MFMA(fa, ba, aa);
      }
      const int n = ct * 32 + l31, head = n >> 6, d = n & 63;
      const float w0v = p.w0[dir * 512 + n], a0v = p.a0[dir * 512 + n], kkw = p.k_k[n], kaw = p.k_a[n];
      const size_t cbase = (size_t)(b * 8 + head) * LTOT;
#pragma unroll
      for (int i = 0; i < 16; ++i) {
        const int ti = crow(i, hh);
        const int pp = pbase + t0 + ti;
        const float wpre = aw[i] + w0v;
        const float e = 0.60653065971263342f * sigmf(wpre);
        const float xdec = 1.f - __expf(-e);
        const float a = sigmf(aa[i] + a0v);
        const float kv = kbuf[ti * 512 + n];
        const float kkv = kv * kkw * invn[ti * 8 + head];
        const float kd = kv * (1.f + (a - 1.f) * kaw);
        ushort_t* dr = DR + ((((size_t)dir * 16) * LTOT + cbase + pp) * 3) * 64 + d;
        dr[0] = f2h(-xdec); dr[64] = f2h(kd); dr[128] = f2h(kkv * a);
        if (dir == 0) SH[((cbase + pp) * 3) * 64 + d] = f2h(kkv);
      }
    }
  }
}

DI int tau_to_pos(int dir, int tau) { return dir == 0 ? tau : (tau < CTXL ? CTXL - 1 - tau : LTOT - 1 - (tau - CTXL)); }


DI void fm_lo(float& acc, float a, uint32_t w) { asm("v_fma_mix_f32 %0, %1, %2, %0 op_sel_hi:[0,1,0]" : "+v"(acc) : "v"(a), "s"(w)); }
DI void fm_hi(float& acc, float a, uint32_t w) { asm("v_fma_mix_f32 %0, %1, %2, %0 op_sel:[0,1,0] op_sel_hi:[0,1,0]" : "+v"(acc) : "v"(a), "s"(w)); }
DI void fx_lo(float& s, uint32_t w) { asm("v_fma_mix_f32 %0, %0, %1, %0 op_sel_hi:[0,1,0]" : "+v"(s) : "s"(w)); }
DI void fx_hi(float& s, uint32_t w) { asm("v_fma_mix_f32 %0, %0, %1, %0 op_sel:[0,1,0] op_sel_hi:[0,1,0]" : "+v"(s) : "s"(w)); }
constexpr int PFD = 2, SEG = 65;
static_assert(CH % SEG == 0, "segments");
DI void scan_prefetch(uint32_t& pfr, const ushort_t* shc, const ushort_t* drc, int pos, int lane) {
  const ushort_t* a = (lane < 24) ? shc + (size_t)pos * 192 + lane * 8 : drc + (size_t)pos * 192 + (lane < 48 ? lane - 24 : 23) * 8;
  asm volatile("global_load_dword %0, %1, off" : "+v"(pfr) : "v"(a) : "memory");
}
DI void scan_stage_v(ushort_t* vbuf, const ushort_t* shc, int dir, int tau0, int lane) {
#pragma unroll
  for (int i = 0; i < (SEG * 8 + 63) / 64; ++i) {
    const int id = i * 64 + lane, st = id >> 3;
    if (st < SEG) *(uint4*)&vbuf[st * 64 + (id & 7) * 8] = *(const uint4*)(shc + (size_t)tau_to_pos(dir, tau0 + st) * 192 + 128 + (id & 7) * 8);
  }
}
struct ScanRec { uint32_t sh, dr, bb; ushort_t v; };
DI ScanRec scan_load(const ushort_t* shc, const ushort_t* drc, int pos, int lane) {
  ScanRec r;
  const ushort_t* s = shc + (size_t)pos * 192;
  const uint32_t* d = (const uint32_t*)(drc + (size_t)pos * 192);
  r.sh = ((const uint32_t*)s)[lane];
  r.v = s[128 + lane];
  r.dr = d[lane];
  r.bb = d[64 + (lane & 31)];
  return r;
}
#define MIXLO " op_sel_hi:[0,1,0]\n\t"
#define MIXHI " op_sel:[0,1,0] op_sel_hi:[0,1,0]\n\t"
template <int L>
DI void dot4(float& a0, float& a1, float& a2, float& a3, float (&S)[64], uint32_t src) {
  uint32_t t0, t1, t2, t3;
  asm("v_readlane_b32 %4, %8, %9\n\tv_readlane_b32 %5, %8, %10\n\tv_readlane_b32 %6, %8, %11\n\tv_readlane_b32 %7, %8, %12\n\t"
      "v_fma_mix_f32 %0, %13, %4, %0" MIXLO "v_fma_mix_f32 %1, %14, %4, %1" MIXHI
      "v_fma_mix_f32 %2, %15, %5, %2" MIXLO "v_fma_mix_f32 %3, %16, %5, %3" MIXHI
      "v_fma_mix_f32 %0, %17, %6, %0" MIXLO "v_fma_mix_f32 %1, %18, %6, %1" MIXHI
      "v_fma_mix_f32 %2, %19, %7, %2" MIXLO "v_fma_mix_f32 %3, %20, %7, %3" MIXHI
      : "+v"(a0), "+v"(a1), "+v"(a2), "+v"(a3), "=&s"(t0), "=&s"(t1), "=&s"(t2), "=&s"(t3)
      : "v"(src), "n"(L), "n"(L + 1), "n"(L + 2), "n"(L + 3),
        "v"(S[2 * (L & 31)]), "v"(S[2 * (L & 31) + 1]), "v"(S[2 * (L & 31) + 2]), "v"(S[2 * (L & 31) + 3]),
        "v"(S[2 * (L & 31) + 4]), "v"(S[2 * (L & 31) + 5]), "v"(S[2 * (L & 31) + 6]), "v"(S[2 * (L & 31) + 7]));
}
template <int L>
DI void upd4(float (&S)[64], uint32_t dr, uint32_t bb, float vv, float nsk) {
  uint32_t x0, x1, x2, x3, k0, k1, k2, k3, b0, b1, b2, b3;
  asm("v_readlane_b32 %8, %20, %22\n\tv_readlane_b32 %9, %20, %23\n\tv_readlane_b32 %10, %20, %24\n\tv_readlane_b32 %11, %20, %25\n\t"
      "v_readlane_b32 %12, %20, %26\n\tv_readlane_b32 %13, %20, %27\n\tv_readlane_b32 %14, %20, %28\n\tv_readlane_b32 %15, %20, %29\n\t"
      "v_readlane_b32 %16, %21, %22\n\tv_readlane_b32 %17, %21, %23\n\tv_readlane_b32 %18, %21, %24\n\tv_readlane_b32 %19, %21, %25\n\t"
      "v_fma_mix_f32 %0, %0, %8, %0" MIXLO "v_fma_mix_f32 %1, %1, %8, %1" MIXHI
      "v_fma_mix_f32 %2, %2, %9, %2" MIXLO "v_fma_mix_f32 %3, %3, %9, %3" MIXHI
      "v_fma_mix_f32 %4, %4, %10, %4" MIXLO "v_fma_mix_f32 %5, %5, %10, %5" MIXHI
      "v_fma_mix_f32 %6, %6, %11, %6" MIXLO "v_fma_mix_f32 %7, %7, %11, %7" MIXHI
      "v_fma_mix_f32 %0, %30, %12, %0" MIXLO "v_fma_mix_f32 %1, %30, %12, %1" MIXHI
      "v_fma_mix_f32 %2, %30, %13, %2" MIXLO "v_fma_mix_f32 %3, %30, %13, %3" MIXHI
      "v_fma_mix_f32 %4, %30, %14, %4" MIXLO "v_fma_mix_f32 %5, %30, %14, %5" MIXHI
      "v_fma_mix_f32 %6, %30, %15, %6" MIXLO "v_fma_mix_f32 %7, %30, %15, %7" MIXHI
      "v_fma_mix_f32 %0, %31, %16, %0" MIXLO "v_fma_mix_f32 %1, %31, %16, %1" MIXHI
      "v_fma_mix_f32 %2, %31, %17, %2" MIXLO "v_fma_mix_f32 %3, %31, %17, %3" MIXHI
      "v_fma_mix_f32 %4, %31, %18, %4" MIXLO "v_fma_mix_f32 %5, %31, %18, %5" MIXHI
      "v_fma_mix_f32 %6, %31, %19, %6" MIXLO "v_fma_mix_f32 %7, %31, %19, %7" MIXHI
      : "+v"(S[2 * L]), "+v"(S[2 * L + 1]), "+v"(S[2 * L + 2]), "+v"(S[2 * L + 3]), "+v"(S[2 * L + 4]), "+v"(S[2 * L + 5]), "+v"(S[2 * L + 6]), "+v"(S[2 * L + 7]),
        "=&s"(x0), "=&s"(x1), "=&s"(x2), "=&s"(x3), "=&s"(k0), "=&s"(k1), "=&s"(k2), "=&s"(k3), "=&s"(b0), "=&s"(b1), "=&s"(b2), "=&s"(b3)
      : "v"(dr), "v"(bb), "n"(L), "n"(L + 1), "n"(L + 2), "n"(L + 3), "n"(L + 32), "n"(L + 33), "n"(L + 34), "n"(L + 35), "v"(vv), "v"(nsk));
}
template <int L>
DI void dot4_2(float& a0, float& a1, float& c0, float& c1, float (&SU)[64], float (&SP)[64], uint32_t src) {
  uint32_t t0, t1, t2, t3;
  asm("v_readlane_b32 %4, %8, %9\n\tv_readlane_b32 %5, %8, %10\n\tv_readlane_b32 %6, %8, %11\n\tv_readlane_b32 %7, %8, %12\n\t"
      "v_fma_mix_f32 %0, %13, %4, %0" MIXLO "v_fma_mix_f32 %1, %14, %4, %1" MIXHI
      "v_fma_mix_f32 %2, %21, %4, %2" MIXLO "v_fma_mix_f32 %3, %22, %4, %3" MIXHI
      "v_fma_mix_f32 %0, %15, %5, %0" MIXLO "v_fma_mix_f32 %1, %16, %5, %1" MIXHI
      "v_fma_mix_f32 %2, %23, %5, %2" MIXLO "v_fma_mix_f32 %3, %24, %5, %3" MIXHI
      "v_fma_mix_f32 %0, %17, %6, %0" MIXLO "v_fma_mix_f32 %1, %18, %6, %1" MIXHI
      "v_fma_mix_f32 %2, %25, %6, %2" MIXLO "v_fma_mix_f32 %3, %26, %6, %3" MIXHI
      "v_fma_mix_f32 %0, %19, %7, %0" MIXLO "v_fma_mix_f32 %1, %20, %7, %1" MIXHI
      "v_fma_mix_f32 %2, %27, %7, %2" MIXLO "v_fma_mix_f32 %3, %28, %7, %3" MIXHI
      : "+v"(a0), "+v"(a1), "+v"(c0), "+v"(c1), "=&s"(t0), "=&s"(t1), "=&s"(t2), "=&s"(t3)
      : "v"(src), "n"(L), "n"(L + 1), "n"(L + 2), "n"(L + 3),
        "v"(SU[2 * L]), "v"(SU[2 * L + 1]), "v"(SU[2 * L + 2]), "v"(SU[2 * L + 3]), "v"(SU[2 * L + 4]), "v"(SU[2 * L + 5]), "v"(SU[2 * L + 6]), "v"(SU[2 * L + 7]),
        "v"(SP[2 * L]), "v"(SP[2 * L + 1]), "v"(SP[2 * L + 2]), "v"(SP[2 * L + 3]), "v"(SP[2 * L + 4]), "v"(SP[2 * L + 5]), "v"(SP[2 * L + 6]), "v"(SP[2 * L + 7]));
}
template <int L>
DI void upd4_2(float (&SU)[64], float (&SP)[64], uint32_t dr, uint32_t bb, float vv, float nskU, float nskP) {
  uint32_t x0, x1, x2, x3, k0, k1, k2, k3, b0, b1, b2, b3;
  asm("v_readlane_b32 %16, %28, %30\n\tv_readlane_b32 %17, %28, %31\n\tv_readlane_b32 %18, %28, %32\n\tv_readlane_b32 %19, %28, %33\n\t"
      "v_readlane_b32 %20, %28, %34\n\tv_readlane_b32 %21, %28, %35\n\tv_readlane_b32 %22, %28, %36\n\tv_readlane_b32 %23, %28, %37\n\t"
      "v_readlane_b32 %24, %29, %30\n\tv_readlane_b32 %25, %29, %31\n\tv_readlane_b32 %26, %29, %32\n\tv_readlane_b32 %27, %29, %33\n\t"
      "v_fma_mix_f32 %0, %0, %16, %0" MIXLO "v_fma_mix_f32 %1, %1, %16, %1" MIXHI
      "v_fma_mix_f32 %2, %2, %17, %2" MIXLO "v_fma_mix_f32 %3, %3, %17, %3" MIXHI
      "v_fma_mix_f32 %4, %4, %18, %4" MIXLO "v_fma_mix_f32 %5, %5, %18, %5" MIXHI
      "v_fma_mix_f32 %6, %6, %19, %6" MIXLO "v_fma_mix_f32 %7, %7, %19, %7" MIXHI
      "v_fma_mix_f32 %8, %8, %16, %8" MIXLO "v_fma_mix_f32 %9, %9, %16, %9" MIXHI
      "v_fma_mix_f32 %10, %10, %17, %10" MIXLO "v_fma_mix_f32 %11, %11, %17, %11" MIXHI
      "v_fma_mix_f32 %12, %12, %18, %12" MIXLO "v_fma_mix_f32 %13, %13, %18, %13" MIXHI
      "v_fma_mix_f32 %14, %14, %19, %14" MIXLO "v_fma_mix_f32 %15, %15, %19, %15" MIXHI
      "v_fma_mix_f32 %0, %38, %20, %0" MIXLO "v_fma_mix_f32 %1, %38, %20, %1" MIXHI
      "v_fma_mix_f32 %2, %38, %21, %2" MIXLO "v_fma_mix_f32 %3, %38, %21, %3" MIXHI
      "v_fma_mix_f32 %4, %38, %22, %4" MIXLO "v_fma_mix_f32 %5, %38, %22, %5" MIXHI
      "v_fma_mix_f32 %6, %38, %23, %6" MIXLO "v_fma_mix_f32 %7, %38, %23, %7" MIXHI
      "v_fma_mix_f32 %0, %39, %24, %0" MIXLO "v_fma_mix_f32 %1, %39, %24, %1" MIXHI
      "v_fma_mix_f32 %2, %39, %25, %2" MIXLO "v_fma_mix_f32 %3, %39, %25, %3" MIXHI
      "v_fma_mix_f32 %4, %39, %26, %4" MIXLO "v_fma_mix_f32 %5, %39, %26, %5" MIXHI
      "v_fma_mix_f32 %6, %39, %27, %6" MIXLO "v_fma_mix_f32 %7, %39, %27, %7" MIXHI
      "v_fma_mix_f32 %8, %40, %24, %8" MIXLO "v_fma_mix_f32 %9, %40, %24, %9" MIXHI
      "v_fma_mix_f32 %10, %40, %25, %10" MIXLO "v_fma_mix_f32 %11, %40, %25, %11" MIXHI
      "v_fma_mix_f32 %12, %40, %26, %12" MIXLO "v_fma_mix_f32 %13, %40, %26, %13" MIXHI
      "v_fma_mix_f32 %14, %40, %27, %14" MIXLO "v_fma_mix_f32 %15, %40, %27, %15" MIXHI
      : "+v"(SU[2 * L]), "+v"(SU[2 * L + 1]), "+v"(SU[2 * L + 2]), "+v"(SU[2 * L + 3]), "+v"(SU[2 * L + 4]), "+v"(SU[2 * L + 5]), "+v"(SU[2 * L + 6]), "+v"(SU[2 * L + 7]),
        "+v"(SP[2 * L]), "+v"(SP[2 * L + 1]), "+v"(SP[2 * L + 2]), "+v"(SP[2 * L + 3]), "+v"(SP[2 * L + 4]), "+v"(SP[2 * L + 5]), "+v"(SP[2 * L + 6]), "+v"(SP[2 * L + 7]),
        "=&s"(x0), "=&s"(x1), "=&s"(x2), "=&s"(x3), "=&s"(k0), "=&s"(k1), "=&s"(k2), "=&s"(k3), "=&s"(b0), "=&s"(b1), "=&s"(b2), "=&s"(b3)
      : "v"(dr), "v"(bb), "n"(L), "n"(L + 1), "n"(L + 2), "n"(L + 3), "n"(L + 32), "n"(L + 33), "n"(L + 34), "n"(L + 35), "v"(vv), "v"(nskU), "v"(nskP));
}
DI void scan_step2(float (&SU)[64], float (&SP)[64], const ScanRec& c, float vv) {
  float a0 = 0.f, a1 = 0.f, c0 = 0.f, c1 = 0.f;
  dot4_2<0>(a0, a1, c0, c1, SU, SP, c.sh); dot4_2<4>(a0, a1, c0, c1, SU, SP, c.sh); dot4_2<8>(a0, a1, c0, c1, SU, SP, c.sh); dot4_2<12>(a0, a1, c0, c1, SU, SP, c.sh);
  dot4_2<16>(a0, a1, c0, c1, SU, SP, c.sh); dot4_2<20>(a0, a1, c0, c1, SU, SP, c.sh); dot4_2<24>(a0, a1, c0, c1, SU, SP, c.sh); dot4_2<28>(a0, a1, c0, c1, SU, SP, c.sh);
  const float nU = -(a0 + a1), nP = -(c0 + c1);
  upd4_2<0>(SU, SP, c.dr, c.bb, vv, nU, nP); upd4_2<4>(SU, SP, c.dr, c.bb, vv, nU, nP); upd4_2<8>(SU, SP, c.dr, c.bb, vv, nU, nP); upd4_2<12>(SU, SP, c.dr, c.bb, vv, nU, nP);
  upd4_2<16>(SU, SP, c.dr, c.bb, vv, nU, nP); upd4_2<20>(SU, SP, c.dr, c.bb, vv, nU, nP); upd4_2<24>(SU, SP, c.dr, c.bb, vv, nU, nP); upd4_2<28>(SU, SP, c.dr, c.bb, vv, nU, nP);
}
template <bool WITH_OUT>
DI float scan_step(float (&S)[64], const ScanRec& c, float vv) {
  float s0 = 0.f, s1 = 0.f, s2 = 0.f, s3 = 0.f;
  dot4<0>(s0, s1, s2, s3, S, c.sh); dot4<4>(s0, s1, s2, s3, S, c.sh); dot4<8>(s0, s1, s2, s3, S, c.sh); dot4<12>(s0, s1, s2, s3, S, c.sh);
  dot4<16>(s0, s1, s2, s3, S, c.sh); dot4<20>(s0, s1, s2, s3, S, c.sh); dot4<24>(s0, s1, s2, s3, S, c.sh); dot4<28>(s0, s1, s2, s3, S, c.sh);
  const float nsk = -((s0 + s1) + (s2 + s3));
  upd4<0>(S, c.dr, c.bb, vv, nsk); upd4<4>(S, c.dr, c.bb, vv, nsk); upd4<8>(S, c.dr, c.bb, vv, nsk); upd4<12>(S, c.dr, c.bb, vv, nsk);
  upd4<16>(S, c.dr, c.bb, vv, nsk); upd4<20>(S, c.dr, c.bb, vv, nsk); upd4<24>(S, c.dr, c.bb, vv, nsk); upd4<28>(S, c.dr, c.bb, vv, nsk);
  float o0 = 0.f, o1 = 0.f, o2 = 0.f, o3 = 0.f;
  if (WITH_OUT) {
    dot4<32>(o0, o1, o2, o3, S, c.sh); dot4<36>(o0, o1, o2, o3, S, c.sh); dot4<40>(o0, o1, o2, o3, S, c.sh); dot4<44>(o0, o1, o2, o3, S, c.sh);
    dot4<48>(o0, o1, o2, o3, S, c.sh); dot4<52>(o0, o1, o2, o3, S, c.sh); dot4<56>(o0, o1, o2, o3, S, c.sh); dot4<60>(o0, o1, o2, o3, S, c.sh);
  }
  return (o0 + o1) + (o2 + o3);
}
constexpr int SPF = 3;
DI void scan_stage_vr(ushort_t* vbuf, ushort_t* rbuf, const ushort_t* shc, int dir, int tau0, int lane) {
#pragma unroll
  for (int i = 0; i < (SEG * 8 + 63) / 64; ++i) {
    const int id = i * 64 + lane, st = id >> 3;
    if (st < SEG) {
      const ushort_t* rec = shc + (size_t)tau_to_pos(dir, tau0 + st) * 192 + (id & 7) * 8;
      *(uint4*)&vbuf[st * 64 + (id & 7) * 8] = *(const uint4*)(rec + 128);
      *(uint4*)&rbuf[st * 64 + (id & 7) * 8] = *(const uint4*)(rec + 64);
    }
    if (i % 3 == 2) asm volatile("" ::: "memory");
  }
}
DI void fv_lo(float& acc, float a, uint32_t w) { asm("v_fma_mix_f32 %0, %1, %2, %0 op_sel_hi:[0,1,0]" : "+v"(acc) : "v"(a), "v"(w)); }
DI void fv_hi(float& acc, float a, uint32_t w) { asm("v_fma_mix_f32 %0, %1, %2, %0 op_sel:[0,1,0] op_sel_hi:[0,1,0]" : "+v"(acc) : "v"(a), "v"(w)); }
DI void phase_scanA(const Params& p, unsigned char* smem) {
  const ushort_t* SH = (const ushort_t*)(p.ws + OFF_SH);
  const ushort_t* DR = (const ushort_t*)(p.ws + OFF_DR);
  float* PU = p.out;
  const int lane = threadIdx.x & 63;
  ushort_t* vbuf = (ushort_t*)smem + (threadIdx.x >> 6) * (2 * SEG * 64);
  ushort_t* rbuf = vbuf + SEG * 64;
  ushort_t* O = (ushort_t*)(p.ws + OFF_ZQ);
  ushort_t* DRw = (ushort_t*)(p.ws + OFF_DR);
  const int gw = __builtin_amdgcn_readfirstlane(blockIdx.x * 8 + (threadIdx.x >> 6));
  uint32_t pfr = 0u;
  for (int task = gw; task < 32 * NCHUNK; task += gridDim.x * 8) {
    const int cd = task / NCHUNK, j = task % NCHUNK, dir = cd >> 4, c = cd & 15, b = c >> 3, head = c & 7;
    float SU[64], SP[64];
#pragma unroll
    for (int k = 0; k < 64; ++k) { SU[k] = 0.f; SP[k] = (k == lane) ? 1.f : 0.f; }
    const ushort_t* shc = SH + (size_t)c * LTOT * 192;
    const ushort_t* drc = DR + (size_t)(dir * 16 + c) * LTOT * 192;
#pragma unroll 1
    for (int st = 0; st < PFD; ++st) scan_prefetch(pfr, shc, drc, tau_to_pos(dir, j * CH + st), lane);
#pragma unroll 1
    for (int sg = 0; sg < CH / SEG; ++sg) {
      scan_stage_vr(vbuf, rbuf, shc, dir, j * CH + sg * SEG, lane);
#pragma unroll 1
      for (int s2 = 0; s2 < SEG; ++s2) {
        const int st = sg * SEG + s2;
        const int pos = tau_to_pos(dir, j * CH + st);
        const ushort_t* shr = shc + (size_t)pos * 192;
        const ushort_t* drr = drc + (size_t)pos * 192;
        scan_prefetch(pfr, shc, drc, tau_to_pos(dir, j * CH + (st + PFD < CH ? st + PFD : CH - 1)), lane);
        const float vv = h2f(vbuf[s2 * 64 + lane]);
        u32x16 a0, a1, b0, b1;
        sload4(a0, a1, b0, b1, shr, drr);
        float u0 = 0.f, u1 = 0.f, q0 = 0.f, q1 = 0.f;
#pragma unroll
        for (int q = 0; q < 16; ++q) {
          fm_lo(u0, SU[2 * q], a0[q]); fm_hi(u1, SU[2 * q + 1], a0[q]); fm_lo(q0, SP[2 * q], a0[q]); fm_hi(q1, SP[2 * q + 1], a0[q]);
          fm_lo(u0, SU[32 + 2 * q], a1[q]); fm_hi(u1, SU[33 + 2 * q], a1[q]); fm_lo(q0, SP[32 + 2 * q], a1[q]); fm_hi(q1, SP[33 + 2 * q], a1[q]);
        }
        const float nU = -(u0 + u1), nP = -(q0 + q1);
#pragma unroll
        for (int q = 0; q < 16; ++q) {
          fx_lo(SU[2 * q], b0[q]); fx_hi(SU[2 * q + 1], b0[q]); fx_lo(SU[32 + 2 * q], b1[q]); fx_hi(SU[33 + 2 * q], b1[q]);
          fx_lo(SP[2 * q], b0[q]); fx_hi(SP[2 * q + 1], b0[q]); fx_lo(SP[32 + 2 * q], b1[q]); fx_hi(SP[33 + 2 * q], b1[q]);
        }
        sload4(a0, a1, b0, b1, drr + 64, drr + 128);
#pragma unroll
        for (int q = 0; q < 16; ++q) { fm_lo(SU[2 * q], vv, a0[q]); fm_hi(SU[2 * q + 1], vv, a0[q]); fm_lo(SU[32 + 2 * q], vv, a1[q]); fm_hi(SU[33 + 2 * q], vv, a1[q]); }
#pragma unroll
        for (int q = 0; q < 16; ++q) {
          fm_lo(SU[2 * q], nU, b0[q]); fm_hi(SU[2 * q + 1], nU, b0[q]); fm_lo(SU[32 + 2 * q], nU, b1[q]); fm_hi(SU[33 + 2 * q], nU, b1[q]);
          fm_lo(SP[2 * q], nP, b0[q]); fm_hi(SP[2 * q + 1], nP, b0[q]); fm_lo(SP[32 + 2 * q], nP, b1[q]); fm_hi(SP[33 + 2 * q], nP, b1[q]);
        }
        if (pos >= CTXL) {
          float e0 = 0.f, e1 = 0.f, g0 = 0.f, g1 = 0.f;
#pragma unroll
          for (int q = 0; q < 8; ++q) {
            asm volatile("" ::: "memory");
            const uint4 rw = *(const uint4*)&rbuf[s2 * 64 + q * 8];
            fv_lo(e0, SU[8 * q + 0], rw.x); fv_hi(e1, SU[8 * q + 1], rw.x); fv_lo(g0, SP[8 * q + 0], rw.x); fv_hi(g1, SP[8 * q + 1], rw.x);
            fv_lo(e0, SU[8 * q + 2], rw.y); fv_hi(e1, SU[8 * q + 3], rw.y); fv_lo(g0, SP[8 * q + 2], rw.y); fv_hi(g1, SP[8 * q + 3], rw.y);
            fv_lo(e0, SU[8 * q + 4], rw.z); fv_hi(e1, SU[8 * q + 5], rw.z); fv_lo(g0, SP[8 * q + 4], rw.z); fv_hi(g1, SP[8 * q + 5], rw.z);
            fv_lo(e0, SU[8 * q + 6], rw.w); fv_hi(e1, SU[8 * q + 7], rw.w); fv_lo(g0, SP[8 * q + 6], rw.w); fv_hi(g1, SP[8 * q + 7], rw.w);
          }
          O[(unsigned)((dir * NX + b * SEQ + (pos - CTXL)) * 512 + head * 64 + lane)] = f2h(e0 + e1);
          DRw[(unsigned)(((dir * 16 + c) * LTOT + pos) * 192 + lane)] = f2h(g0 + g1);
        }
      }
    }
    const unsigned dsto = (unsigned)(task * 2 * 4096 + lane * 64);
#pragma unroll
    for (int k = 0; k < 64; k += 4) {
      *(float4*)(PU + dsto + k) = make_float4(SU[k], SU[k + 1], SU[k + 2], SU[k + 3]);
      *(float4*)(PU + dsto + 4096 + k) = make_float4(SP[k], SP[k + 1], SP[k + 2], SP[k + 3]);
    }
  }
  asm volatile("s_waitcnt vmcnt(0)" ::: "memory");
  asm volatile("" :: "v"(pfr));
}

DI void phase_scanB(const Params& p, unsigned char* smem) {
  int tix = threadIdx.x;
  asm volatile("" : "+v"(tix));
  if (blockIdx.x >= 32) return;
  float* Sb = (float*)smem;
  float* Xb = Sb + 64 * 65;
  float* Pb = Xb + 4096;
  float* Ub = Pb + 4096;
  float* PU = p.out;
  const int cd = blockIdx.x, tid = tix, wave = tid >> 6, lane = tid & 63, l31 = lane & 31, hh = lane >> 5;
  const int tile = wave & 3, tm = tile >> 1, tn = tile & 1, kh = wave >> 2;
  for (int i = tid; i < 64 * 65; i += NTH) Sb[i] = 0.f;
  constexpr int BPF = 5;
  float4 st[BPF][4];
  auto fetch = [&](int j, float4 (&r)[4]) {
    const float* base = PU + (size_t)(cd * NCHUNK + j) * 2 * 4096 + tid * 8;
    r[0] = *(const float4*)(base + 4096); r[1] = *(const float4*)(base + 4100);
    r[2] = *(const float4*)base; r[3] = *(const float4*)(base + 4);
  };
  auto stage = [&](const float4 (&r)[4]) {
    *(float4*)&Pb[tid * 8] = r[0]; *(float4*)&Pb[tid * 8 + 4] = r[1];
    *(float4*)&Ub[tid * 8] = r[2]; *(float4*)&Ub[tid * 8 + 4] = r[3];
  };
  auto put_state = [&](int j, const f32x16& sv) {
    float* base = PU + (size_t)(cd * NCHUNK + j) * 2 * 4096;
#pragma unroll
    for (int i = 0; i < 16; ++i) base[(tm * 32 + crow(i, hh)) * 64 + tn * 32 + l31] = sv[i];
  };
#pragma unroll
  for (int s = 0; s < BPF; ++s) fetch(s, st[s]);
  stage(st[0]);
#pragma unroll
  for (int s = 0; s + 1 < BPF; ++s)
#pragma unroll
    for (int q = 0; q < 4; ++q) st[s][q] = st[s + 1][q];
  fetch(BPF, st[BPF - 1]);
  __syncthreads();
  if (kh == 0) put_state(0, zero16());
#pragma unroll 1
  for (int j = 0; j < NCHUNK; ++j) {
    f32x16 acc = zero16();
    if (kh == 0) {
#pragma unroll
      for (int i = 0; i < 16; ++i) acc[i] = Ub[(tm * 32 + crow(i, hh)) * 64 + tn * 32 + l31];
    }
#pragma unroll
    for (int kk = 0; kk < 16; ++kk) {
      const int k = kh * 32 + 2 * kk + hh;
      acc = __builtin_amdgcn_mfma_f32_32x32x2f32(Sb[(tm * 32 + l31) * 65 + k], Pb[k * 64 + tn * 32 + l31], acc, 0, 0, 0);
    }
    if (kh == 1) {
#pragma unroll
      for (int i = 0; i < 16; ++i) Xb[(tile * 16 + i) * 64 + lane] = acc[i];
    }
    __syncthreads();
    if (kh == 0) {
#pragma unroll
      for (int i = 0; i < 16; ++i) { acc[i] += Xb[(tile * 16 + i) * 64 + lane]; Sb[(tm * 32 + crow(i, hh)) * 65 + tn * 32 + l31] = acc[i]; }
    }
    if (j + 1 < NCHUNK) {
      stage(st[0]);
#pragma unroll
      for (int s = 0; s + 1 < BPF; ++s)
#pragma unroll
        for (int q = 0; q < 4; ++q) st[s][q] = st[s + 1][q];
      if (j + 1 + BPF < NCHUNK) fetch(j + 1 + BPF, st[BPF - 1]);
    }
    __syncthreads();
    if (kh == 0 && j + 1 < NCHUNK) put_state(j + 1, acc);
  }
}

typedef __attribute__((ext_vector_type(8))) _Float16 f16x8;
DI void phase_scanC(const Params& p, unsigned char* smem) {
  int tix = threadIdx.x;
  asm volatile("" : "+v"(tix));
  const ushort_t* DR = (const ushort_t*)(p.ws + OFF_DR);
  ushort_t* O = (ushort_t*)(p.ws + OFF_ZQ);
  const float* PU = p.out;
  const int lane = tix & 63, l31 = lane & 31, hh = lane >> 5;
  const int gw = blockIdx.x * 8 + (tix >> 6);
  for (int task = gw; task < 32 * NCHUNK; task += gridDim.x * 8) {
    const int cd = task / NCHUNK, j = task % NCHUNK, dir = cd >> 4, c = cd & 15, b = c >> 3, head = c & 7;
    if (j == 0) continue;
    const float* S = PU + (size_t)task * 2 * 4096;
    f16x8 bs[2][4];
#pragma unroll
    for (int nt = 0; nt < 2; ++nt)
#pragma unroll
      for (int ks = 0; ks < 4; ++ks) {
        const float* sp = S + (nt * 32 + l31) * 64 + ks * 16 + hh * 8;
        const float4 x0 = *(const float4*)sp, x1 = *(const float4*)(sp + 4);
        f16x8 f = {(_Float16)x0.x, (_Float16)x0.y, (_Float16)x0.z, (_Float16)x0.w, (_Float16)x1.x, (_Float16)x1.y, (_Float16)x1.z, (_Float16)x1.w};
        bs[nt][ks] = f;
      }
    const ushort_t* drc = DR + (size_t)(dir * 16 + c) * LTOT * 192;
    ushort_t* obase = O + ((size_t)dir * NX + (size_t)b * SEQ) * 512 + head * 64;
#pragma unroll 1
    for (int tile = 0; tile < (CH + 31) / 32; ++tile) {
      const int tau = tile * 32 + l31;
      const int pos = tau_to_pos(dir, j * CH + (tau < CH ? tau : CH - 1));
      const ushort_t* wrow = drc + (size_t)pos * 192;
      f32x16 acc[2] = {zero16(), zero16()};
#pragma unroll
      for (int ks = 0; ks < 4; ++ks) {
        const f16x8 a = *(const f16x8*)(wrow + ks * 16 + hh * 8);
        acc[0] = __builtin_amdgcn_mfma_f32_32x32x16_f16(a, bs[0][ks], acc[0], 0, 0, 0);
        acc[1] = __builtin_amdgcn_mfma_f32_32x32x16_f16(a, bs[1][ks], acc[1], 0, 0, 0);
      }
#pragma unroll
      for (int i = 0; i < 16; ++i) {
        const int t2 = tile * 32 + crow(i, hh);
        if (t2 < CH) {
          const int p2 = tau_to_pos(dir, j * CH + t2);
          if (p2 >= CTXL) {
            ushort_t* o0 = obase + (size_t)(p2 - CTXL) * 512 + l31;
            o0[0] = f2h(h2f(o0[0]) + acc[0][i]);
            o0[32] = f2h(h2f(o0[32]) + acc[1][i]);
          }
        }
      }
    }
  }
}

DI void phase_scan_naive(const Params& p) {
  const ushort_t* SH = (const ushort_t*)(p.ws + OFF_SH);
  const ushort_t* DR = (const ushort_t*)(p.ws + OFF_DR);
  ushort_t* O = (ushort_t*)(p.ws + OFF_ZQ);
  const int lane = threadIdx.x & 63;
  const int gw = __builtin_amdgcn_readfirstlane(blockIdx.x * 8 + (threadIdx.x >> 6));
  if (gw >= 32) return;
  const int cd = gw, dir = cd >> 4, c = cd & 15, b = c >> 3, head = c & 7;
  float S[64];
#pragma unroll
  for (int k = 0; k < 64; ++k) S[k] = 0.f;
  const ushort_t* shc = SH + (size_t)c * LTOT * 192;
  const ushort_t* drc = DR + (size_t)(dir * 16 + c) * LTOT * 192;
#pragma unroll 1
  for (int tau = 0; tau < LTOT; ++tau) {
    const int pos = tau_to_pos(dir, tau);
    const ushort_t* shr = shc + (size_t)pos * 192;
    const ushort_t* drr = drc + (size_t)pos * 192;
    const float vv = h2f(shr[128 + lane]);
    u32x16 k0, k1;
    sload2(k0, k1, shr);
    float sk0 = 0.f, sk1 = 0.f;
#pragma unroll
    for (int q = 0; q < 32; ++q) { sk0 = fmaf(S[q], HV(k0, q), sk0); sk1 = fmaf(S[32 + q], HV(k1, q), sk1); }
    const float nsk = -(sk0 + sk1);
    u32x16 x0, x1, d0, d1;
    sload4(x0, x1, d0, d1, drr, drr + 64);
#pragma unroll
    for (int q = 0; q < 32; ++q) {
      S[q] = fmaf(S[q], -HV(x0, q), S[q]); S[32 + q] = fmaf(S[32 + q], -HV(x1, q), S[32 + q]);
      S[q] = fmaf(vv, HV(d0, q), S[q]); S[32 + q] = fmaf(vv, HV(d1, q), S[32 + q]);
    }
    u32x16 b0, b1, r0, r1;
    sload4(b0, b1, r0, r1, drr + 128, shr + 64);
    float o0 = 0.f, o1 = 0.f;
#pragma unroll
    for (int q = 0; q < 32; ++q) {
      S[q] = fmaf(nsk, HV(b0, q), S[q]); S[32 + q] = fmaf(nsk, HV(b1, q), S[32 + q]);
      o0 = fmaf(S[q], HV(r0, q), o0); o1 = fmaf(S[32 + q], HV(r1, q), o1);
    }
    if (pos >= CTXL) O[((size_t)dir * NX + (size_t)b * SEQ + (pos - CTXL)) * 512 + head * 64 + lane] = f2h(o0 + o1);
  }
}

DI void phase_attn(const Params& p, unsigned char* smem) {
  int tix = threadIdx.x;
  asm volatile("" : "+v"(tix));
  ushort_t* Kb = (ushort_t*)smem;
  ushort_t* Vb = Kb + 2 * 64 * LDK;
  ushort_t* QB = (ushort_t*)(p.ws + OFF_QB);
  const ushort_t* KB = (const ushort_t*)(p.ws + OFF_KB);
  const ushort_t* VB = (const ushort_t*)(p.ws + OFF_VB);
  const int tid = tix, wave = tid >> 6, lane = tid & 63, l31 = lane & 31, hh = lane >> 5;
  const int loff = (tid >> 3) * LDK + (tid & 7) * 8;
  constexpr float THR = 6.f;
  constexpr int NTL = LTOT / 64;
  for (int at = blockIdx.x; at < 1024; at += gridDim.x) {
    const int b = at >> 9, kvh = (at >> 8) & 1, t0 = (at & 255) * 64;
    const int head = kvh * 4 + (wave & 3), tq = t0 + (wave >> 2) * 32 + l31;
    ushort_t* qrow = QB + ((size_t)(b * 8 + head) * SEQ + tq) * 64;
    bf16x8 qf[4];
#pragma unroll
    for (int ks = 0; ks < 4; ++ks) qf[ks] = *(const bf16x8*)(qrow + ks * 16 + hh * 8);
    const ushort_t* kbase = KB + (size_t)(b * 2 + kvh) * LTOT * 64 + tid * 8;
    const ushort_t* vbase = VB + (size_t)(b * 2 + kvh) * LTOT * 64 + tid * 8;
    f32x16 o[2] = {zero16(), zero16()};
    f32x16 negm = zero16();
    float lsum = 0.f;
    auto qk = [&](f32x16 (&s)[2], const ushort_t* Ks) {
      s[0] = negm; s[1] = negm;
#pragma unroll
      for (int ks = 0; ks < 4; ++ks)
#pragma unroll
        for (int kk = 0; kk < 2; ++kk) s[kk] = MFMA(*(const bf16x8*)&Ks[(kk * 32 + l31) * LDK + ks * 16 + hh * 8], qf[ks], s[kk]);
    };
    uint4 rk, rv;
    __syncthreads();
    rk = *(const uint4*)kbase; rv = *(const uint4*)vbase;
    *(uint4*)&Kb[loff] = rk; *(uint4*)&Vb[loff] = rv;
    rk = *(const uint4*)(kbase + 4096);
    rv = *(const uint4*)(vbase + 4096);
    __syncthreads();
    f32x16 sA[2], sB[2];
    qk(sA, Kb);
    {
      float mx = fmaxf(sA[0][0], sA[1][0]);
#pragma unroll
      for (int i = 1; i < 16; ++i) mx = fmaxf(mx, fmaxf(sA[0][i], sA[1][i]));
      mx = fmaxf(mx, __shfl_xor(mx, 32, 64));
#pragma unroll
      for (int i = 0; i < 16; ++i) { sA[0][i] -= mx; sA[1][i] -= mx; negm[i] = -mx; }
    }
    *(uint4*)&Kb[64 * LDK + loff] = rk;
    rk = *(const uint4*)(kbase + 2 * 4096);
    auto step = [&](int t, f32x16 (&sc)[2], f32x16 (&sn)[2]) {
      __syncthreads();
      if (t + 2 < NTL) *(uint4*)&Kb[(t & 1) * 64 * LDK + loff] = rk;
      if (t + 1 < NTL) *(uint4*)&Vb[((t + 1) & 1) * 64 * LDK + loff] = rv;
      if (t + 3 < NTL) rk = *(const uint4*)(kbase + (size_t)(t + 3) * 4096);
      if (t + 2 < NTL) rv = *(const uint4*)(vbase + (size_t)(t + 2) * 4096);
      if (t + 1 < NTL) qk(sn, Kb + ((t + 1) & 1) * 64 * LDK);
      float mx = fmaxf(sc[0][0], sc[1][0]);
#pragma unroll
      for (int i = 1; i < 16; ++i) mx = fmaxf(mx, fmaxf(sc[0][i], sc[1][i]));
      mx = fmaxf(mx, __shfl_xor(mx, 32, 64));
      if (__builtin_amdgcn_ballot_w64(mx > THR) != 0ull) {
        const float delta = fmaxf(mx, 0.f);
        const float alpha = __builtin_amdgcn_exp2f(-delta);
        lsum *= alpha;
#pragma unroll
        for (int i = 0; i < 16; ++i) {
          o[0][i] *= alpha; o[1][i] *= alpha; sc[0][i] -= delta; sc[1][i] -= delta; negm[i] -= delta;
          sn[0][i] -= delta; sn[1][i] -= delta;
        }
      }
      float ps = 0.f;
#pragma unroll
      for (int i = 0; i < 16; ++i) {
        sc[0][i] = __builtin_amdgcn_exp2f(sc[0][i]); sc[1][i] = __builtin_amdgcn_exp2f(sc[1][i]);
        ps += sc[0][i] + sc[1][i];
      }
      lsum += ps;
      const ushort_t* Vt = Vb + (t & 1) * 64 * LDK;
#pragma unroll
      for (int kk = 0; kk < 2; ++kk) {
#pragma unroll
        for (int st = 0; st < 2; ++st) {
          uint4 pw;
          pw.x = pack_bf2(sc[kk][8 * st + 0], sc[kk][8 * st + 1]); pw.y = pack_bf2(sc[kk][8 * st + 2], sc[kk][8 * st + 3]);
          pw.z = pack_bf2(sc[kk][8 * st + 4], sc[kk][8 * st + 5]); pw.w = pack_bf2(sc[kk][8 * st + 6], sc[kk][8 * st + 7]);
          const bf16x8 pf = __builtin_bit_cast(bf16x8, pw);
#pragma unroll
          for (int dt = 0; dt < 2; ++dt) o[dt] = MFMA(*(const bf16x8*)&Vt[(dt * 32 + l31) * LDK + kk * 32 + st * 16 + hh * 8], pf, o[dt]);
        }
      }
    };
#pragma unroll 1
    for (int t = 0; t < NTL; t += 2) {
      step(t, sA, sB);
      step(t + 1, sB, sA);
    }
    const float ltot = lsum + __shfl_xor(lsum, 32, 64);
    const float il = 1.f / ltot;
#pragma unroll
    for (int dt = 0; dt < 2; ++dt)
#pragma unroll
      for (int g = 0; g < 4; ++g) {
        uint2 w;
        w.x = pack_bf2(o[dt][4 * g + 0] * il, o[dt][4 * g + 1] * il);
        w.y = pack_bf2(o[dt][4 * g + 2] * il, o[dt][4 * g + 3] * il);
        *(uint2*)(qrow + dt * 32 + 8 * g + 4 * hh) = w;
      }
  }
}

constexpr size_t OFF_DBG = WS_END;
DI void dbg_acc(const Params& p, int slot, float d2, float r2) {
  float* dbg = (float*)(p.ws + OFF_DBG);
  d2 = wave_sum(d2); r2 = wave_sum(r2);
  if ((threadIdx.x & 63) == 0) { atomicAdd(dbg + 2 * slot, d2); atomicAdd(dbg + 2 * slot + 1, r2); }
}
DI void probe_after_gemm1(const Params& p) {
  if (blockIdx.x != 0) return;
  const int tid = threadIdx.x, lane = tid & 63, wave = tid >> 6;
  const float* mod = (const float*)(p.ws + OFF_MOD);
  const ushort_t* H = (const ushort_t*)(p.ws + OFF_SH);
  {
    float d2 = 0.f, r2 = 0.f;
    if (tid < 96) {
      const int v = tid / 32, n = (tid % 32) * 97 % 3072;
      float s = 0.f;
      for (int k = 0; k < 1024; ++k) { const float cv = (v < 2) ? p.c[v * 1024 + k] : p.c_ctx[k]; s += (cv / (1.f + expf(-cv))) * p.w_ada[(size_t)k * 3072 + n]; }
      s += p.b_ada[n];
      const float d = mod[v * 3072 + n] - s; d2 = d * d; r2 = s * s;
    }
    dbg_acc(p, 0, d2, r2);
  }
  {
    const int row = wave == 0 ? 0 : wave == 1 ? 777 : wave == 2 ? 16383 : wave == 3 ? 16384 : wave == 4 ? 32767 : wave == 5 ? 32768 : wave == 6 ? 33023 : 33279;
    const float* src = (row < NX) ? p.x + (size_t)row * DM : p.ctx + (size_t)(row - NX) * DM;
    const float* md = mod + ((row < NX) ? (row / SEQ) : 2) * 3072;
    float s = 0.f;
    for (int i = lane; i < 1024; i += 64) s += src[i];
    const float mu = wave_sum(s) / 1024.f;
    float q = 0.f;
    for (int i = lane; i < 1024; i += 64) q += (src[i] - mu) * (src[i] - mu);
    const float rstd = rsqrtf(wave_sum(q) / 1024.f + LN_EPS);
    float d2 = 0.f, r2 = 0.f;
    for (int i = lane; i < 1024; i += 64) {
      const float ref = (src[i] - mu) * rstd * (1.f + md[1024 + i]) + md[i];
      const float d = bf2f(H[(size_t)row * DM + i]) - ref; d2 += d * d; r2 += ref * ref;
    }
    dbg_acc(p, 1, d2, r2);
  }
  {
    float d2 = 0.f, r2 = 0.f;
    if (tid < 60) {
      const int ri = tid / 10, ci = tid % 10;
      const int row = ri == 0 ? 3 : ri == 1 ? 777 : ri == 2 ? 20001 : ri == 3 ? 32767 : ri == 4 ? 32773 : 33279;
      const int col = ci == 0 ? 0 : ci == 1 ? 100 : ci == 2 ? 700 : ci == 3 ? 800 : ci == 4 ? 1279 : ci == 5 ? 1280 : ci == 6 ? 2000 : ci == 7 ? 3071 : ci == 8 ? 3072 : 3583;
      float s = 0.f;
      for (int k = 0; k < 1024; ++k) s += bf2f(H[(size_t)row * DM + k]) * p.w_in[(size_t)k * INW + col];
      float got = 0.f; bool have = true;
      if (col < 768) got = bf2f(((const ushort_t*)(p.ws + OFF_ZQ))[(size_t)row * 768 + col]);
      else if (col < 1280) { if (row < NX) got = bf2f(((const ushort_t*)(p.ws + OFF_ZG))[(size_t)row * 1024 + col - 768]); else have = false; }
      else if (col < 3072) got = bf2f(((const ushort_t*)p.out)[(size_t)row * 1792 + col - 1280]);
      else { if (row < NX) got = bf2f(((const ushort_t*)(p.ws + OFF_ZG))[(size_t)row * 1024 + 512 + col - 3072]); else have = false; }
      if (have) { const float d = got - s; d2 = d * d; r2 = s * s; }
    }
    dbg_acc(p, 2, d2, r2);
  }
}
DI void probe_after_prep(const Params& p, unsigned char* smem) {
  if (blockIdx.x != 0) return;
  float* cbuf = (float*)smem;
  const int tid = threadIdx.x, lane = tid & 63, wave = tid >> 6;
  const ushort_t* zm = (const ushort_t*)p.out;
  const ushort_t* SH = (const ushort_t*)(p.ws + OFF_SH);
  const ushort_t* DR = (const ushort_t*)(p.ws + OFF_DR);
  float dA = 0.f, rA = 0.f, dB = 0.f, rB = 0.f;
#pragma unroll 1
  for (int sidx = wave; sidx < 24; sidx += 8) {
    const int ri = sidx >> 1, head = (sidx & 1) ? 5 : 0;
    const int row = ri == 0 ? 0 : ri == 1 ? 1 : ri == 2 ? 31 : ri == 3 ? 32 : ri == 4 ? 16383 : ri == 5 ? 16384 : ri == 6 ? 20000 : ri == 7 ? 32767 : ri == 8 ? 32768 : ri == 9 ? 33023 : ri == 10 ? 33024 : 33279;
    int b, t, len, pp;
    if (row < NX) { b = row / SEQ; t = row % SEQ; len = SEQ; pp = CTXL + t; } else { b = (row - NX) / CTXL; t = (row - NX) % CTXL; len = CTXL; pp = t; }
    auto sft = [&](int col) {
      const float z = bf2f(zm[(size_t)row * 1792 + col]);
      const float zp = (t > 0) ? bf2f(zm[(size_t)(row - 1) * 1792 + col]) : 0.f;
      const float zn = (t < len - 1) ? bf2f(zm[(size_t)(row + 1) * 1792 + col]) : 0.f;
      return z + p.mu_prev[col] * (zp - z) + p.mu_next[col] * (zn - z);
    };
    const int n = head * 64 + lane;
    const float r = sft(n), k = sft(512 + n), v = sft(1024 + n);
#pragma unroll 1
    for (int j = lane; j < 256; j += 64) { const float s = sft(1536 + j); cbuf[wave * 256 + j] = (j < 128) ? tanhf(s) : s; }
    __builtin_amdgcn_s_waitcnt(0);
    __builtin_amdgcn_wave_barrier();
    const float kr = k * p.k_k[n];
    const float nrm = sqrtf(wave_sum(kr * kr));
    const float kk = kr / fmaxf(nrm, 1e-12f);
    const size_t cp = (size_t)(b * 8 + head) * LTOT + pp;
    { float d;
      d = h2f(SH[(cp * 3 + 0) * 64 + lane]) - kk; dA += d * d; rA += kk * kk;
      d = h2f(SH[(cp * 3 + 1) * 64 + lane]) - r; dA += d * d; rA += r * r;
      d = h2f(SH[(cp * 3 + 2) * 64 + lane]) - v; dA += d * d; rA += v * v; }
#pragma unroll 1
    for (int dir = 0; dir < 2; ++dir) {
      float wpre = p.w0[dir * 512 + n], apre = p.a0[dir * 512 + n];
#pragma unroll 1
      for (int j = 0; j < 64; ++j) {
        wpre += cbuf[wave * 256 + dir * 64 + j] * p.w_up[(size_t)(dir * 64 + j) * 512 + n];
        apre += cbuf[wave * 256 + 128 + dir * 64 + j] * p.a_up[(size_t)(dir * 64 + j) * 512 + n];
      }
      const float wlog = -log1pf(expf(-wpre)) - 0.5f;
      const float xd = 1.f - expf(-expf(wlog));
      const float a = 1.f / (1.f + expf(-apre));
      const float kd = k * (1.f + (a - 1.f) * p.k_a[n]);
      const float bq = kk * a;
      const size_t dp = (size_t)(dir * 16 + b * 8 + head) * LTOT + pp;
      float d;
      d = h2f(DR[(dp * 3 + 0) * 64 + lane]) - xd; dB += d * d; rB += xd * xd;
      d = h2f(DR[(dp * 3 + 1) * 64 + lane]) - kd; dB += d * d; rB += kd * kd;
      d = h2f(DR[(dp * 3 + 2) * 64 + lane]) - bq; dB += d * d; rB += bq * bq;
    }
    __builtin_amdgcn_wave_barrier();
  }
  dbg_acc(p, 3, dA, rA);
  dbg_acc(p, 4, dB, rB);
}

DI void probe_scan(const Params& p) {
  if (blockIdx.x != 0 || threadIdx.x >= 128) return;
  const ushort_t* SH = (const ushort_t*)(p.ws + OFF_SH);
  const ushort_t* DR = (const ushort_t*)(p.ws + OFF_DR);
  const ushort_t* O = (const ushort_t*)(p.ws + OFF_ZQ);
  const int lane = threadIdx.x & 63, wv = threadIdx.x >> 6;
  const int c = wv ? 9 : 0, dir = wv, b = c >> 3, head = c & 7;
  float S[64];
#pragma unroll
  for (int k = 0; k < 64; ++k) S[k] = 0.f;
  float d2 = 0.f, r2 = 0.f;
#pragma unroll 1
  for (int tau = 0; tau < 420; ++tau) {
    const int pos = dir == 0 ? tau : (tau < CTXL ? CTXL - 1 - tau : LTOT - 1 - (tau - CTXL));
    const ushort_t* sh = SH + ((size_t)c * LTOT + pos) * 192;
    const ushort_t* dr = DR + ((size_t)(dir * 16 + c) * LTOT + pos) * 192;
    const float v = h2f(sh[128 + lane]);
    float sk = 0.f;
#pragma unroll
    for (int k = 0; k < 64; ++k) sk += S[k] * h2f(sh[k]);
    float o = 0.f;
#pragma unroll
    for (int k = 0; k < 64; ++k) {
      const float dec = 1.f - h2f(dr[k]);
      S[k] = S[k] * dec - sk * h2f(dr[128 + k]) + v * h2f(dr[64 + k]);
      o += S[k] * h2f(sh[64 + k]);
    }
    if (pos >= CTXL) {
      const float got = h2f(O[((size_t)dir * NX + (size_t)b * SEQ + (pos - CTXL)) * 512 + head * 64 + lane]);
      const float d = got - o; d2 += d * d; r2 += o * o;
    }
  }
  dbg_acc(p, 0, d2, r2);
}
DI float probe_delta(const Params& p) {
  const float* dbg = (const float*)(p.ws + OFF_DBG);
  int k = 0;
  for (int s = 0; s < 5; ++s) { const float rel = sqrtf(dbg[2 * s] / fmaxf(dbg[2 * s + 1], 1e-30f)); if (!(rel < 0.05f)) k |= 1 << s; }
  return sqrtf(0.02f * (float)k);
}

DI void phase_final(const Params& p, unsigned char* smem) {
  ushort_t* As = (ushort_t*)smem;
  ushort_t* Bs = As + 2 * 128 * LDK;
  const float* mod = (const float*)(p.ws + OFF_MOD);
  ushort_t* ZG = (ushort_t*)(p.ws + OFF_ZG);
  ushort_t* QB = (ushort_t*)(p.ws + OFF_QB);
  ushort_t* O = (ushort_t*)(p.ws + OFF_ZQ);
  const ushort_t* SH = (const ushort_t*)(p.ws + OFF_SH);
  const ushort_t* DR = (const ushort_t*)(p.ws + OFF_DR);
  const ushort_t* WMG = (const ushort_t*)(p.ws + OFF_WMG);
  const ushort_t* WPA = (const ushort_t*)(p.ws + OFF_WPA);
  const ushort_t* WPB = (const ushort_t*)(p.ws + OFF_WPB);
  const ushort_t* WO = (const ushort_t*)(p.ws + OFF_WO);
#pragma unroll 1
  for (int mt = blockIdx.x; mt < NX / 128; mt += gridDim.x) {
    int tid = threadIdx.x;
    asm volatile("" : "+v"(tid));
    const int wave = tid >> 6, lane = tid & 63, l31 = lane & 31, hh = lane >> 5;
    const int wrow0 = (wave & 3) * 32, wcol0 = (wave >> 2) * 64;
    const int row0 = mt * 128, b = row0 / SEQ, tb0 = row0 % SEQ;
    const float* md = mod + b * 3072;
    __syncthreads();
#pragma unroll 1
    for (int r4 = wave * 4; r4 < 128; r4 += 32) {
      const int r = r4 + (lane >> 4), l16 = lane & 15;
      ushort_t* hdst = (ushort_t*)(p.out + (size_t)(row0 + r) * DM);
      float4 v[16];
      const float rstd = ln_rows4(p.x + (size_t)(row0 + r) * DM, l16, v);
#pragma unroll
      for (int i = 0; i < 16; ++i) {
        const int col = l16 * 4 + 64 * i;
        const float4 sh = *(const float4*)(md + col), sc = *(const float4*)(md + 1024 + col);
        uint2 o;
        o.x = pack_bf2(v[i].x * rstd * (1.f + sc.x) + sh.x, v[i].y * rstd * (1.f + sc.y) + sh.y);
        o.y = pack_bf2(v[i].z * rstd * (1.f + sc.z) + sh.z, v[i].w * rstd * (1.f + sc.w) + sh.w);
        *(uint2*)(hdst + col) = o;
      }
    }
#if PROBE
    float a2ref = 0.f;
    if (mt == 0) {
      const int tok = wave * 16 + 3, head = wave, row = row0 + tok, t = tb0 + tok, dd = head * 64 + lane;
      const size_t cp = (size_t)(b * 8 + head) * LTOT + CTXL + t;
      const float o = h2f(O[(size_t)row * 512 + dd]) + h2f(O[((size_t)NX + row) * 512 + dd]);
      const float mu = wave_sum(o) / 64.f;
      const float var = wave_sum((o - mu) * (o - mu)) / 64.f;
      const float y = (o - mu) * rsqrtf(var + GN_EPS) * p.gn_w[dd] + p.gn_b[dd];
      const float r = h2f(SH[(cp * 3 + 1) * 64 + lane]), vv = h2f(SH[(cp * 3 + 2) * 64 + lane]);
      const float kf = h2f(DR[(cp * 3 + 1) * 64 + lane]), kb = h2f(DR[(((size_t)16 * LTOT + cp) * 3 + 1) * 64 + lane]);
      const float bon = wave_sum(r * kf * p.r_k[dd]) + wave_sum(r * kb * p.r_k[512 + dd]);
      const float g = bf2f(ZG[(size_t)row * 1024 + 512 + dd]);
      a2ref = (y + bon * vv) * (g / (1.f + expf(-g)));
    }
#endif
#pragma unroll 1
    for (int it = 0; it < 16; ++it) {
      const int pair = (it * 8 + wave) * 8 + (lane >> 3), q8 = lane & 7;
      const int tok = pair >> 3, head = pair & 7, row = row0 + tok, t = tb0 + tok, d0 = q8 * 8;
      const unsigned cp = (unsigned)((b * 8 + head) * LTOT + CTXL + t);
      const unsigned ofo = (unsigned)(row * 512 + head * 64 + d0), obo = ofo + (unsigned)NX * 512u;
      const unsigned ro = (cp * 3 + 1) * 64 + d0, vo = (cp * 3 + 2) * 64 + d0;
      const unsigned kbo = ((16u * LTOT + cp) * 3 + 1) * 64 + d0;
      const unsigned gbo = (unsigned)(row * 1024 + 512 + head * 64 + d0), gao = gbo - 512;
      const unsigned yao = (unsigned)(((b * 8 + head) * SEQ + t) * 64 + d0);
      float ov[8], bon = 0.f, s = 0.f;
      {
        const uint4 a = *(const uint4*)(O + ofo), bq = *(const uint4*)(O + obo);
        const uint4 rr = *(const uint4*)(SH + ro), kf = *(const uint4*)(DR + ro), kb = *(const uint4*)(DR + kbo);
        const unsigned aw[4] = {a.x, a.y, a.z, a.w}, bw[4] = {bq.x, bq.y, bq.z, bq.w}, rw[4] = {rr.x, rr.y, rr.z, rr.w};
        const unsigned fw[4] = {kf.x, kf.y, kf.z, kf.w}, kw[4] = {kb.x, kb.y, kb.z, kb.w};
#pragma unroll
        for (int q = 0; q < 4; ++q) {
          const int dd = head * 64 + d0 + 2 * q;
          ov[2 * q] = hlo(aw[q]) + hlo(bw[q]);
          ov[2 * q + 1] = hhi(aw[q]) + hhi(bw[q]);
          s += ov[2 * q] + ov[2 * q + 1];
          bon += hlo(rw[q]) * (hlo(fw[q]) * p.r_k[dd] + hlo(kw[q]) * p.r_k[512 + dd]);
          bon += hhi(rw[q]) * (hhi(fw[q]) * p.r_k[dd + 1] + hhi(kw[q]) * p.r_k[512 + dd + 1]);
        }
      }
      s += __shfl_xor(s, 1, 64); s += __shfl_xor(s, 2, 64); s += __shfl_xor(s, 4, 64);
      bon += __shfl_xor(bon, 1, 64); bon += __shfl_xor(bon, 2, 64); bon += __shfl_xor(bon, 4, 64);
      const float mu = s * (1.f / 64.f);
      float vs = 0.f;
#pragma unroll
      for (int q = 0; q < 8; ++q) { ov[q] -= mu; vs = fmaf(ov[q], ov[q], vs); }
      vs += __shfl_xor(vs, 1, 64); vs += __shfl_xor(vs, 2, 64); vs += __shfl_xor(vs, 4, 64);
      const float rstd = rsqrtf(vs * (1.f / 64.f) + GN_EPS);
      {
        const uint4 vv = *(const uint4*)(SH + vo), gb = *(const uint4*)(ZG + gbo), ga = *(const uint4*)(ZG + gao), ya = *(const uint4*)(QB + yao);
        const unsigned vw[4] = {vv.x, vv.y, vv.z, vv.w}, gbw[4] = {gb.x, gb.y, gb.z, gb.w}, gaw[4] = {ga.x, ga.y, ga.z, ga.w}, yw[4] = {ya.x, ya.y, ya.z, ya.w};
        unsigned o2[4], o1[4];
#pragma unroll
        for (int q = 0; q < 4; ++q) {
          const int dd = head * 64 + d0 + 2 * q;
          const float y0 = ov[2 * q] * rstd * p.gn_w[dd] + p.gn_b[dd] + bon * hlo(vw[q]);
          const float y1 = ov[2 * q + 1] * rstd * p.gn_w[dd + 1] + p.gn_b[dd + 1] + bon * hhi(vw[q]);
          o2[q] = pack_bf2(y0 * siluf(bflo(gbw[q])), y1 * siluf(bfhi(gbw[q])));
          o1[q] = pack_bf2(bflo(yw[q]) * siluf(bflo(gaw[q])), bfhi(yw[q]) * siluf(bfhi(gaw[q])));
        }
        *(uint4*)(O + ofo) = make_uint4(o2[0], o2[1], o2[2], o2[3]);
        *(uint4*)(QB + yao) = make_uint4(o1[0], o1[1], o1[2], o1[3]);
      }
    }
    asm volatile("s_waitcnt vmcnt(0)" ::: "memory");
    __syncthreads();
#if PROBE
    if (mt == 0) {
      const int tok = wave * 16 + 3, head = wave, row = row0 + tok, dd = head * 64 + lane;
      const float got = bf2f(O[(size_t)row * 512 + dd]);
      dbg_acc(p, 1, (got - a2ref) * (got - a2ref), a2ref * a2ref);
    }
#endif
    const ushort_t* hbase = (const ushort_t*)p.out;
    auto hload = [&](int r, int k) { return *(const uint4*)(hbase + (unsigned)((row0 + r) * 2048 + k)); };
    auto a1load = [&](int r, int k) { return *(const uint4*)(QB + (unsigned)(((b * 8 + (k >> 6)) * SEQ + tb0 + r) * 64 + (k & 63))); };
    auto a2load = [&](int r, int k) { return *(const uint4*)(O + (unsigned)((row0 + r) * 512 + k)); };
#pragma unroll 1
    for (int nt = 0; nt < 8; ++nt) {
      const int col0 = nt * 128;
      int tidn = tid;
      asm volatile("" : "+v"(tidn));
      f32x16 sg[2][1][2] = {{{zero16(), zero16()}}, {{zero16(), zero16()}}};
      gemm_pass<128, 128, 1, 2, 2>(sg, hload, [&](int w, int n, int k) { return *(const uint4*)(WMG + (unsigned)((w * 1024 + col0 + n) * DM + k)); }, DM, As, Bs, wrow0, wcol0, tidn);
#pragma unroll
      for (int ni = 0; ni < 2; ++ni) {
        const int col = col0 + wcol0 + ni * 32 + l31;
        const float ba = p.b_mg[col], bb = p.b_mg[1024 + col];
#pragma unroll
        for (int i = 0; i < 16; ++i) { sg[0][0][ni][i] = sigmf(sg[0][0][ni][i] + ba); sg[1][0][ni][i] = sigmf(sg[1][0][ni][i] + bb); }
      }
      {
        f32x16 ya[1][1][2] = {{{zero16(), zero16()}}};
        gemm_pass<128, 128, 1, 2, 1>(ya, a1load, [&](int w, int n, int k) { return *(const uint4*)(WPA + (unsigned)((col0 + n) * 512 + k)); }, 512, As, Bs, wrow0, wcol0, tidn);
#pragma unroll
        for (int ni = 0; ni < 2; ++ni)
#pragma unroll
          for (int i = 0; i < 16; ++i) sg[0][0][ni][i] *= ya[0][0][ni][i];
      }
      {
        f32x16 yb[1][1][2] = {{{zero16(), zero16()}}};
        gemm_pass<128, 128, 1, 2, 1>(yb, a2load, [&](int w, int n, int k) { return *(const uint4*)(WPB + (unsigned)((col0 + n) * 512 + k)); }, 512, As, Bs, wrow0, wcol0, tidn);
        int rb1 = row0 + wrow0 + 4 * hh;
        asm volatile("" : "+v"(rb1));
#pragma unroll
        for (int ni = 0; ni < 2; ++ni) {
          const int col = col0 + wcol0 + ni * 32 + l31;
#pragma unroll
          for (int i = 0; i < 16; ++i) {
            const float mv = sg[0][0][ni][i] + sg[1][0][ni][i] * yb[0][0][ni][i];
            ZG[(unsigned)((rb1 + crow(i, 0)) * 1024 + col)] = f2bf(mv);
          }
        }
      }
    }
    asm volatile("s_waitcnt vmcnt(0)" ::: "memory");
    __syncthreads();
#if PROBE
    if (mt == 0) {
      float d2 = 0.f, r2 = 0.f;
      if (tid < 64) {
        const int r = (tid * 37) & 127, col = (tid * 131 + 7) & 1023, row = row0 + r;
        const ushort_t* hrow = (const ushort_t*)(p.out + (size_t)row * DM);
        float ga = p.b_mg[col], gb = p.b_mg[1024 + col], ya = 0.f, yb = 0.f;
        for (int k = 0; k < 1024; ++k) { const float hv = bf2f(hrow[k]); ga += hv * p.w_mg[(size_t)k * 2048 + col]; gb += hv * p.w_mg[(size_t)k * 2048 + 1024 + col]; }
        for (int k = 0; k < 512; ++k) {
          ya += bf2f(QB[((size_t)(b * 8 + (k >> 6)) * SEQ + tb0 + r) * 64 + (k & 63)]) * p.w_pa[(size_t)k * 1024 + col];
          yb += bf2f(O[(size_t)row * 512 + k]) * p.w_pb[(size_t)k * 1024 + col];
        }
        const float ref = ya / (1.f + expf(-ga)) + yb / (1.f + expf(-gb));
        const float got = bf2f(ZG[(size_t)row * 1024 + col]);
        d2 = (got - ref) * (got - ref); r2 = ref * ref;
      }
      dbg_acc(p, 2, d2, r2);
    }
#endif
    const float* gt = md + 2048;
#pragma unroll 1
    for (int nt = 0; nt < 8; ++nt) {
      const int col0 = nt * 128;
      int tidn = tid;
      asm volatile("" : "+v"(tidn));
      f32x16 acc[1][1][2] = {{{zero16(), zero16()}}};
      gemm_pass<128, 128, 1, 2, 1>(acc, [&](int r, int k) { return *(const uint4*)(ZG + (unsigned)((row0 + r) * 1024 + k)); },
                                   [&](int w, int n, int k) { return *(const uint4*)(WO + (unsigned)((col0 + n) * DM + k)); }, DM, As, Bs, wrow0, wcol0, tidn);
      int rb2 = row0 + wrow0 + 4 * hh;
      asm volatile("" : "+v"(rb2));
#pragma unroll
      for (int ni = 0; ni < 2; ++ni) {
        const int col = col0 + wcol0 + ni * 32 + l31;
        const float g = gt[col];
#pragma unroll
        for (int i = 0; i < 16; ++i) {
          const unsigned idx = (unsigned)((rb2 + crow(i, 0)) * DM + col);
          p.out[idx] = ALPHA * p.x[idx] + g * acc[0][0][ni][i];
        }
      }
    }
    asm volatile("s_waitcnt vmcnt(0)" ::: "memory");
    __syncthreads();
#if PROBE
    if (mt == 0) {
      float d2 = 0.f, r2 = 0.f;
      if (tid < 64) {
        const int r = (tid * 29) & 127, col = (tid * 113 + 5) & 1023, row = row0 + r;
        float o = 0.f;
        for (int k = 0; k < 1024; ++k) o += bf2f(ZG[(size_t)row * 1024 + k]) * p.w_o[(size_t)k * 1024 + col];
        const float ref = md[2048 + col] * o;
        const float got = p.out[(size_t)row * DM + col] - ALPHA * p.x[(size_t)row * DM + col];
        d2 = (got - ref) * (got - ref); r2 = ref * ref;
      }
      dbg_acc(p, 3, d2, r2);
    }
    asm volatile("s_waitcnt vmcnt(0)" ::: "memory");
    __syncthreads();
#endif
#if !PROBE
#pragma unroll 1
    for (int r4 = wave * 4; r4 < 128; r4 += 32) {
      const int r = r4 + (lane >> 4), l16 = lane & 15;
      float* dst = p.out + (size_t)(row0 + r) * DM;
      float4 v[16];
      const float rstd = ln_rows4(dst, l16, v);
#pragma unroll
      for (int i = 0; i < 16; ++i) {
        const int col = l16 * 4 + 64 * i;
        const float4 g = *(const float4*)(p.ln_g + col), bb = *(const float4*)(p.ln_b + col);
        *(float4*)(dst + col) = make_float4(v[i].x * rstd * g.x + bb.x, v[i].y * rstd * g.y + bb.y, v[i].z * rstd * g.z + bb.z, v[i].w * rstd * g.w + bb.w);
      }
    }
#endif
  }
}


#if PROBE
DI void probe_f3(const Params& p) {
  const float pdelta = probe_delta(p);
  const int lane = threadIdx.x & 63, wave = threadIdx.x >> 6;
  for (int mt = blockIdx.x; mt < NX / 128; mt += gridDim.x) {
    for (int r = wave; r < 128; r += 8) {
      const float* src = p.x + (size_t)(mt * 128 + r) * DM;
      float* dst = p.out + (size_t)(mt * 128 + r) * DM;
      float s = 0.f, q = 0.f;
      for (int i = lane; i < 1024; i += 64) s += ALPHA * src[i];
      const float mu = wave_sum(s) / 1024.f;
      for (int i = lane; i < 1024; i += 64) { const float d = ALPHA * src[i] - mu; q += d * d; }
      const float rstd = rsqrtf(wave_sum(q) / 1024.f + LN_EPS);
      for (int i = lane; i < 1024; i += 64) dst[i] = (ALPHA * src[i] - mu) * rstd * p.ln_g[i] + p.ln_b[i] + pdelta;
    }
  }
}
#endif
DI void gsync(cg::grid_group& g) { asm volatile("s_waitcnt vmcnt(0) lgkmcnt(0)" ::: "memory"); g.sync(); }

constexpr int SMEM_BYTES = 8 * 2 * SEG * 64 * 2;
static_assert(SMEM_BYTES >= 2 * (256 + 128) * LDK * 2, "GEMM tiles");
static_assert(SMEM_BYTES >= 65536 + 32 * 264 * 2 + 1024, "rwkv prep LDS");
__global__ void __launch_bounds__(NTH) fwd_megakernel(Params p) {
  __shared__ __attribute__((aligned(16))) unsigned char smem[SMEM_BYTES];
  cg::grid_group grid = cg::this_grid();
#if PROBE
  if (blockIdx.x == 0 && threadIdx.x < 64) ((float*)(p.ws + OFF_DBG))[threadIdx.x] = 0.f;
#endif
  phase0(p, smem);
  gsync(grid);
  phase_h(p);
  gsync(grid);
  if (__builtin_amdgcn_readfirstlane(threadIdx.x) >= 256) __builtin_amdgcn_s_setprio(1);
  phase_gemm1(p, smem);
  __builtin_amdgcn_s_setprio(0);
  gsync(grid);
  phase_qkv(p);
  phase_rwkv_prep(p, smem);
  gsync(grid);
#if PROBE_NAIVE_SCAN
  phase_scan_naive(p);
#else
  if (__builtin_amdgcn_readfirstlane(threadIdx.x) >= 256) __builtin_amdgcn_s_setprio(1);
  phase_scanA(p, smem);
  __builtin_amdgcn_s_setprio(0);
  gsync(grid);
  phase_scanB(p, smem);
  gsync(grid);
  phase_scanC(p, smem);
#endif
  if (__builtin_amdgcn_readfirstlane(threadIdx.x) >= 256) __builtin_amdgcn_s_setprio(1);
  phase_attn(p, smem);
  __builtin_amdgcn_s_setprio(0);
  gsync(grid);
#if PROBE
  probe_scan(p);
  gsync(grid);
#endif
  if (__builtin_amdgcn_readfirstlane(threadIdx.x) >= 256) __builtin_amdgcn_s_setprio(1);
  phase_final(p, smem);
  __builtin_amdgcn_s_setprio(0);
#if PROBE
  gsync(grid);
  probe_f3(p);
#endif
}

extern "C" void kernel_launch(void* const* d_in, const int* in_sizes, int n_in, void* d_out, int out_size, void* d_ws, size_t ws_size,
                              hipStream_t stream) {
  static int grid_blocks = 0;
  if (!grid_blocks) {
    int dev = 0, cus = 0, per_cu = 0;
    hipGetDevice(&dev);
    hipDeviceGetAttribute(&cus, hipDeviceAttributeMultiprocessorCount, dev);
    hipOccupancyMaxActiveBlocksPerMultiprocessor(&per_cu, fwd_megakernel, NTH, 0);
    if (per_cu < 1) fprintf(stderr, "occupancy query says %d blocks/CU\n", per_cu);
    grid_blocks = cus > 0 ? cus : 256;
    if (ws_size < WS_END) fprintf(stderr, "workspace too small: %zu < %zu\n", ws_size, (size_t)WS_END);
  }
  Params p{};
  const float** fp = (const float**)&p;
  for (int i = 0; i < 27; ++i) fp[i] = (const float*)d_in[i];
  p.out = (float*)d_out;
  p.ws = (unsigned char*)d_ws;
  void* args[] = {&p};
  hipError_t e = hipLaunchCooperativeKernel((void*)fwd_megakernel, dim3(grid_blocks), dim3(NTH), args, 0, stream);
  if (e != hipSuccess) fprintf(stderr, "cooperative launch failed: %s (grid %d)\n", hipGetErrorString(e), grid_blocks);
}
```

```cpp
#include <hip/hip_runtime.h>
#include <hip/hip_cooperative_groups.h>
#include <stdint.h>
#include <cstdio>
namespace cg = cooperative_groups;

#define PROBE 0
#define DI __device__ __forceinline__
typedef __attribute__((ext_vector_type(8))) short bf16x8;
typedef __attribute__((ext_vector_type(16))) float f32x16;
typedef __attribute__((ext_vector_type(16))) uint32_t u32x16;
typedef __attribute__((ext_vector_type(2))) _Float16 h2;
typedef __attribute__((ext_vector_type(2))) __bf16 b2;
typedef unsigned short ushort_t;
typedef __attribute__((ext_vector_type(4))) uint32_t u32x4;
#define MFMA(a, b, c) __builtin_amdgcn_mfma_f32_32x32x16_bf16((a), (b), (c), 0, 0, 0)

constexpr int DM = 1024, NB = 2, SEQ = 16384, CTXL = 256;
constexpr int NX = NB * SEQ, NC = NB * CTXL, NT = NX + NC;
constexpr int INW = 3584, LTOT = CTXL + SEQ;
constexpr int NTH = 512;
constexpr int CH = 260, NCHUNK = LTOT / CH;
static_assert(NCHUNK * CH == LTOT, "chunking");
constexpr float LN_EPS = 1e-5f, QK_EPS = 1e-6f, GN_EPS = 64e-5f;
constexpr float ALPHA = 1.189207115002721f;
constexpr float QSCALE = 0.125f * 1.4426950408889634f;

constexpr size_t OFF_WIN = 0;
constexpr size_t OFF_WMG = OFF_WIN + (size_t)INW * DM * 2;
constexpr size_t OFF_WPA = OFF_WMG + (size_t)2048 * DM * 2;
constexpr size_t OFF_WPB = OFF_WPA + (size_t)1024 * 512 * 2;
constexpr size_t OFF_WO  = OFF_WPB + (size_t)1024 * 512 * 2;
constexpr size_t OFF_WL  = OFF_WO + (size_t)1024 * 1024 * 2;
constexpr size_t OFF_MOD = OFF_WL + (size_t)2 * 2 * 512 * 64 * 2;
constexpr size_t OFF_ZG  = OFF_MOD + 36864;
constexpr size_t OFF_QB  = OFF_ZG + (size_t)NX * 1024 * 2;
constexpr size_t OFF_KB  = OFF_QB + (size_t)NX * 512 * 2;
constexpr size_t OFF_VB  = OFF_KB + (size_t)NB * 2 * LTOT * 64 * 2;
constexpr size_t OFF_SH  = OFF_VB + (size_t)NB * 2 * LTOT * 64 * 2;
constexpr size_t OFF_DR  = OFF_SH + (size_t)16 * LTOT * 192 * 2;
constexpr size_t OFF_ZQ  = OFF_DR + (size_t)32 * LTOT * 192 * 2;
constexpr size_t WS_END  = OFF_ZQ + (size_t)2 * NX * 512 * 2;
static_assert(WS_END <= (size_t)536870912, "workspace");
static_assert((size_t)NT * DM * 2 <= (size_t)48 * LTOT * 192 * 2, "H alias");
static_assert((size_t)NT * 768 * 2 <= (size_t)2 * NX * 512 * 2, "zqkv alias");

struct Params {
  const float *x, *c, *ctx, *c_ctx, *w_ada, *b_ada, *w_in, *q_norm, *k_norm, *mu_prev, *mu_next, *w0, *w_up, *a0, *a_up, *k_k, *k_a,
      *r_k, *gn_w, *gn_b, *w_pa, *w_pb, *w_mg, *b_mg, *w_o, *ln_g, *ln_b;
  float* out;
  unsigned char* ws;
};

DI ushort_t f2bf(float f) { return __builtin_bit_cast(ushort_t, (__bf16)f); }
DI float bf2f(ushort_t b) { return __uint_as_float(((unsigned)b) << 16); }
DI unsigned pack_bf2(float a, float b) { b2 v = {(__bf16)a, (__bf16)b}; return __builtin_bit_cast(unsigned, v); }
DI unsigned pack_h2(float a, float b) { h2 v = {(_Float16)a, (_Float16)b}; return __builtin_bit_cast(unsigned, v); }
DI ushort_t f2h(float f) { return __builtin_bit_cast(ushort_t, (_Float16)f); }
DI float h2f(ushort_t h) { return (float)__builtin_bit_cast(_Float16, h); }
DI float bflo(unsigned u) { return __uint_as_float(u << 16); }
DI float bfhi(unsigned u) { return __uint_as_float(u & 0xffff0000u); }
DI float hlo(unsigned u) { return (float)__builtin_bit_cast(h2, u)[0]; }
DI float hhi(unsigned u) { return (float)__builtin_bit_cast(h2, u)[1]; }
DI float sigmf(float v) { return __builtin_amdgcn_rcpf(1.f + __expf(-v)); }
DI float siluf(float v) { return v * sigmf(v); }
DI int crow(int reg, int h) { return (reg & 3) + 8 * (reg >> 2) + 4 * h; }
DI float wave_sum(float v) {
#pragma unroll
  for (int o = 32; o >= 1; o >>= 1) v += __shfl_xor(v, o, 64);
  return v;
}
DI float sum16(float v) {
#pragma unroll
  for (int o = 8; o >= 1; o >>= 1) v += __shfl_xor(v, o, 64);
  return v;
}
DI float ln_rows4(const float* src, int l16, float4 (&v)[16]) {
  float s = 0.f;
#pragma unroll
  for (int i = 0; i < 16; ++i) { v[i] = *(const float4*)(src + l16 * 4 + 64 * i); s += v[i].x + v[i].y + v[i].z + v[i].w; }
  const float mu = sum16(s) * (1.f / DM);
  float q = 0.f;
#pragma unroll
  for (int i = 0; i < 16; ++i) { v[i].x -= mu; v[i].y -= mu; v[i].z -= mu; v[i].w -= mu; q += v[i].x * v[i].x + v[i].y * v[i].y + v[i].z * v[i].z + v[i].w * v[i].w; }
  return rsqrtf(sum16(q) * (1.f / DM) + LN_EPS);
}
DI f32x16 zero16() { f32x16 z;
#pragma unroll
  for (int i = 0; i < 16; ++i) z[i] = 0.f; return z; }

#define SCAN_VLOAD 0
#define PROBE_NAIVE_SCAN 0
#if SCAN_VLOAD
DI void sload2(u32x16& a0, u32x16& a1, const void* p) { a0 = *(const u32x16*)p; a1 = *((const u32x16*)p + 1); }
DI void sload4(u32x16& a0, u32x16& a1, u32x16& b0, u32x16& b1, const void* p, const void* q) {
  a0 = *(const u32x16*)p; a1 = *((const u32x16*)p + 1); b0 = *(const u32x16*)q; b1 = *((const u32x16*)q + 1);
}
#else
DI void sload2(u32x16& a0, u32x16& a1, const void* p) {
  asm volatile("s_load_dwordx16 %0, %2, 0x0\n\ts_load_dwordx16 %1, %2, 0x40\n\ts_waitcnt lgkmcnt(0)" : "=&s"(a0), "=&s"(a1) : "s"(p) : "memory");
}
DI void sload4(u32x16& a0, u32x16& a1, u32x16& b0, u32x16& b1, const void* p, const void* q) {
  asm volatile("s_load_dwordx16 %0, %4, 0x0\n\ts_load_dwordx16 %1, %4, 0x40\n\ts_load_dwordx16 %2, %5, 0x0\n\ts_load_dwordx16 %3, %5, 0x40\n\ts_waitcnt lgkmcnt(0)"
               : "=&s"(a0), "=&s"(a1), "=&s"(b0), "=&s"(b1) : "s"(p), "s"(q) : "memory");
}
#endif
DI float HV(const u32x16& v, int j) { const uint32_t w = v[j >> 1]; const h2 t = __builtin_bit_cast(h2, w); return (float)t[j & 1]; }

constexpr int LDK = 72;
template <int BM, int BN, int MI, int NI, int NB, class AL, class BL>
DI void gemm_pass(f32x16 (&acc)[NB][MI][NI], AL aload, BL bload, int K, ushort_t* As, ushort_t* Bs, int wrow0, int wcol0, int tid) {
  constexpr int NA = BM * 8 / NTH, NBC = BN * 8 / NTH;
  constexpr int ASZ = BM * LDK, BSZ = NB * BN * LDK;
  const int lane = tid & 63, l31 = lane & 31, hh = lane >> 5;
  const int nk = K >> 6;
  uint4 ra[2][NA], rb[2][NB][NBC];
  auto gload = [&](int s, int kt) {
#pragma unroll
    for (int i = 0; i < NA; ++i) { const int id = tid + i * NTH; ra[s][i] = aload(id >> 3, kt * 64 + (id & 7) * 8); }
#pragma unroll
    for (int w = 0; w < NB; ++w)
#pragma unroll
      for (int i = 0; i < NBC; ++i) { const int id = tid + i * NTH; rb[s][w][i] = bload(w, id >> 3, kt * 64 + (id & 7) * 8); }
  };
  auto lstore = [&](int s, int buf) {
#pragma unroll
    for (int i = 0; i < NA; ++i) { const int id = tid + i * NTH; *(uint4*)&As[buf * ASZ + (id >> 3) * LDK + (id & 7) * 8] = ra[s][i]; }
#pragma unroll
    for (int w = 0; w < NB; ++w)
#pragma unroll
      for (int i = 0; i < NBC; ++i) { const int id = tid + i * NTH; *(uint4*)&Bs[buf * BSZ + w * BN * LDK + (id >> 3) * LDK + (id & 7) * 8] = rb[s][w][i]; }
  };
  auto compute = [&](int buf) {
#pragma unroll
    for (int ks = 0; ks < 4; ++ks) {
      bf16x8 af[MI];
#pragma unroll
      for (int mi = 0; mi < MI; ++mi) af[mi] = *(const bf16x8*)&As[buf * ASZ + (wrow0 + mi * 32 + l31) * LDK + ks * 16 + hh * 8];
#pragma unroll
      for (int w = 0; w < NB; ++w) {
        bf16x8 bfv[NI];
#pragma unroll
        for (int ni = 0; ni < NI; ++ni) bfv[ni] = *(const bf16x8*)&Bs[buf * BSZ + w * BN * LDK + (wcol0 + ni * 32 + l31) * LDK + ks * 16 + hh * 8];
#pragma unroll
        for (int mi = 0; mi < MI; ++mi)
#pragma unroll
          for (int ni = 0; ni < NI; ++ni) acc[w][mi][ni] = MFMA(af[mi], bfv[ni], acc[w][mi][ni]);
      }
    }
  };
  __syncthreads();
  gload(0, 0);
  lstore(0, 0);
  gload(1, 1);
  gload(0, 2);
#pragma unroll 1
  for (int kt = 0; kt < nk; kt += 2) {
    __syncthreads();
    lstore(1, 1);
    if (kt + 3 < nk) gload(1, kt + 3);
    compute(0);
    __syncthreads();
    if (kt + 2 < nk) { lstore(0, 0); if (kt + 4 < nk) gload(0, kt + 4); }
    compute(1);
  }
}

DI void transpose_tile(const float* __restrict__ src, int ld_src, ushort_t* dst, int ld_dst, int k0, int n0, float* T) {
  const int tid = threadIdx.x;
#pragma unroll
  for (int i = 0; i < 2; ++i) {
    const int k = (tid >> 4) + 32 * i, n4 = (tid & 15) * 4;
    const float4 v = *(const float4*)(src + (size_t)(k0 + k) * ld_src + n0 + n4);
    T[k * 65 + n4 + 0] = v.x; T[k * 65 + n4 + 1] = v.y; T[k * 65 + n4 + 2] = v.z; T[k * 65 + n4 + 3] = v.w;
  }
  __syncthreads();
  const int n = tid >> 3, kc = tid & 7;
  uint4 o;
  o.x = pack_bf2(T[(kc * 8 + 0) * 65 + n], T[(kc * 8 + 1) * 65 + n]);
  o.y = pack_bf2(T[(kc * 8 + 2) * 65 + n], T[(kc * 8 + 3) * 65 + n]);
  o.z = pack_bf2(T[(kc * 8 + 4) * 65 + n], T[(kc * 8 + 5) * 65 + n]);
  o.w = pack_bf2(T[(kc * 8 + 6) * 65 + n], T[(kc * 8 + 7) * 65 + n]);
  *(uint4*)(dst + (size_t)(n0 + n) * ld_dst + k0 + kc * 8) = o;
  __syncthreads();
}

DI void phase0(const Params& p, unsigned char* smem) {
  float* T = (float*)smem;
  ushort_t* win = (ushort_t*)(p.ws + OFF_WIN);
  ushort_t* wmg = (ushort_t*)(p.ws + OFF_WMG);
  ushort_t* wpa = (ushort_t*)(p.ws + OFF_WPA);
  ushort_t* wpb = (ushort_t*)(p.ws + OFF_WPB);
  ushort_t* wo = (ushort_t*)(p.ws + OFF_WO);
  ushort_t* wl = (ushort_t*)(p.ws + OFF_WL);
  float* mod = (float*)(p.ws + OFF_MOD);
  constexpr int T_IN = 16 * 56, T_MG = 16 * 32, T_PA = 8 * 16, T_PB = 8 * 16, T_O = 16 * 16, T_L = 32, T_MOD = 48;
  constexpr int TOTAL = T_MOD + T_IN + T_MG + T_PA + T_PB + T_O + T_L;
  for (int t = blockIdx.x; t < TOTAL; t += gridDim.x) {
    int u = t;
    if (u < T_MOD) {
      float* sil = T;
      float* red = T + 3072;
      const int tid = threadIdx.x;
      for (int i = tid; i < 3072; i += NTH) {
        const int v = i >> 10, k = i & 1023;
        const float cv = (v < 2) ? p.c[v * 1024 + k] : p.c_ctx[k];
        sil[i] = siluf(cv);
      }
      __syncthreads();
      const int n = tid & 63, ksl = tid >> 6, n0 = u * 64;
      float a0 = 0.f, a1 = 0.f, a2 = 0.f;
      for (int k = ksl * 128; k < ksl * 128 + 128; ++k) {
        const float w = p.w_ada[(size_t)k * 3072 + n0 + n];
        a0 = fmaf(sil[k], w, a0); a1 = fmaf(sil[1024 + k], w, a1); a2 = fmaf(sil[2048 + k], w, a2);
      }
      red[(ksl * 3 + 0) * 64 + n] = a0; red[(ksl * 3 + 1) * 64 + n] = a1; red[(ksl * 3 + 2) * 64 + n] = a2;
      __syncthreads();
      if (tid < 192) {
        const int v = tid >> 6, nn = tid & 63;
        float s = 0.f;
#pragma unroll
        for (int q = 0; q < 8; ++q) s += red[(q * 3 + v) * 64 + nn];
        mod[v * 3072 + n0 + nn] = s + p.b_ada[n0 + nn];
      }
      __syncthreads();
      continue;
    }
    u -= T_MOD;
    if (u < T_IN) { transpose_tile(p.w_in, INW, win, 1024, (u / 56) * 64, (u % 56) * 64, T); continue; }
    u -= T_IN;
    if (u < T_MG) { transpose_tile(p.w_mg, 2048, wmg, 1024, (u / 32) * 64, (u % 32) * 64, T); continue; }
    u -= T_MG;
    if (u < T_PA) { transpose_tile(p.w_pa, 1024, wpa, 512, (u / 16) * 64, (u % 16) * 64, T); continue; }
    u -= T_PA;
    if (u < T_PB) { transpose_tile(p.w_pb, 1024, wpb, 512, (u / 16) * 64, (u % 16) * 64, T); continue; }
    u -= T_PB;
    if (u < T_O) { transpose_tile(p.w_o, 1024, wo, 1024, (u / 16) * 64, (u % 16) * 64, T); continue; }
    u -= T_O;
    {
      const int which = u >> 4, dir = (u >> 3) & 1, nt = u & 7;
      const float* src = (which ? p.a_up : p.w_up) + (size_t)dir * 64 * 512;
      transpose_tile(src, 512, wl + (size_t)((dir * 2 + which) * 512) * 64, 64, 0, nt * 64, T);
    }
  }
}

DI void phase_h(const Params& p) {
  const float* mod = (const float*)(p.ws + OFF_MOD);
  ushort_t* H = (ushort_t*)(p.ws + OFF_SH);
  const int lane = threadIdx.x & 63, l16 = lane & 15, gw = blockIdx.x * 8 + (threadIdx.x >> 6);
#pragma unroll 1
  for (int r4 = gw * 4; r4 < NT; r4 += gridDim.x * 32) {
    const int row = r4 + (lane >> 4);
    const float* src = (row < NX) ? p.x + (size_t)row * DM : p.ctx + (size_t)(row - NX) * DM;
    const float* md = mod + ((row < NX) ? (row / SEQ) : 2) * 3072;
    float4 v[16];
    const float rstd = ln_rows4(src, l16, v);
#pragma unroll
    for (int i = 0; i < 16; ++i) {
      const int col = l16 * 4 + 64 * i;
      const float4 sh = *(const float4*)(md + col), sc = *(const float4*)(md + 1024 + col);
      uint2 o;
      o.x = pack_bf2(v[i].x * rstd * (1.f + sc.x) + sh.x, v[i].y * rstd * (1.f + sc.y) + sh.y);
      o.y = pack_bf2(v[i].z * rstd * (1.f + sc.z) + sh.z, v[i].w * rstd * (1.f + sc.w) + sh.w);
      *(uint2*)(H + (size_t)row * DM + col) = o;
    }
  }
}

DI void phase_gemm1(const Params& p, unsigned char* smem) {
  ushort_t* As = (ushort_t*)smem;
  ushort_t* Bs = As + 2 * 256 * LDK;
  const ushort_t* H = (const ushort_t*)(p.ws + OFF_SH);
  const ushort_t* W = (const ushort_t*)(p.ws + OFF_WIN);
  ushort_t* zq = (ushort_t*)(p.ws + OFF_ZQ);
  ushort_t* zg = (ushort_t*)(p.ws + OFF_ZG);
  ushort_t* zm = (ushort_t*)p.out;
  const int tid = threadIdx.x, wave = tid >> 6, lane = tid & 63, l31 = lane & 31, hh = lane >> 5;
  const int wrow0 = (wave & 3) * 64, wcol0 = (wave >> 2) * 64;
  constexpr int MT = NT / 256, NTL = INW / 128;
  for (int t = blockIdx.x; t < MT * NTL; t += gridDim.x) {
    const int mt = t / NTL, nt = t % NTL;
    const bool is_g = (nt >= 6 && nt < 10) || nt >= 24;
    if (is_g && mt >= NX / 256) continue;
    const int row0 = mt * 256, col0 = nt * 128;
    f32x16 acc[1][2][2];
#pragma unroll
    for (int a = 0; a < 2; ++a)
#pragma unroll
      for (int b = 0; b < 2; ++b) acc[0][a][b] = zero16();
    auto aload = [&](int r, int k) { return *(const uint4*)(H + (size_t)(row0 + r) * DM + k); };
    auto bload = [&](int w, int n, int k) { return *(const uint4*)(W + (size_t)(col0 + n) * DM + k); };
    gemm_pass<256, 128, 2, 2, 1>(acc, aload, bload, DM, As, Bs, wrow0, wcol0, tid);
    ushort_t* dst; int ld, cbase;
    if (nt < 6) { dst = zq; ld = 768; cbase = col0; }
    else if (nt < 10) { dst = zg; ld = 1024; cbase = col0 - 768; }
    else if (nt < 24) { dst = zm; ld = 1792; cbase = col0 - 1280; }
    else { dst = zg; ld = 1024; cbase = 512 + col0 - 3072; }
#pragma unroll
    for (int mi = 0; mi < 2; ++mi)
#pragma unroll
      for (int ni = 0; ni < 2; ++ni)
#pragma unroll
        for (int i = 0; i < 16; ++i) {
          const int row = row0 + wrow0 + mi * 32 + crow(i, hh), col = cbase + wcol0 + ni * 32 + l31;
          dst[(size_t)row * ld + col] = f2bf(acc[0][mi][ni][i]);
        }
  }
}

DI int vperm(int key) { const int g = key >> 4, kq = key & 15; return g * 16 + 8 * ((kq >> 2) & 1) + (kq & 3) + 4 * (kq >> 3); }
DI void phase_qkv(const Params& p) {
  const ushort_t* zq = (const ushort_t*)(p.ws + OFF_ZQ);
  ushort_t* QB = (ushort_t*)(p.ws + OFF_QB);
  ushort_t* KB = (ushort_t*)(p.ws + OFF_KB);
  ushort_t* VB = (ushort_t*)(p.ws + OFF_VB);
  const int lane = threadIdx.x & 63, gw = blockIdx.x * 8 + (threadIdx.x >> 6);
  const int j = lane & 31, half = lane >> 5, axis = j >> 4, f = j & 15;
  const int d1 = axis * 32 + f, d2 = d1 + 16;
  const float inv = powf(10000.f, -(float)f * (1.f / 16.f));
  const float gq1 = p.q_norm[d1], gq2 = p.q_norm[d2], gk1 = p.k_norm[d1], gk2 = p.k_norm[d2];
  for (int row = gw; row < NT; row += gridDim.x * 8) {
    const bool isx = row < NX;
    const int b = isx ? row / SEQ : (row - NX) / CTXL;
    const int t = isx ? row % SEQ : (row - NX) % CTXL;
    const int pos = isx ? CTXL + t : t;
    const ushort_t* z = zq + (size_t)row * 768;
    float cs = 1.f, sn = 0.f;
    if (isx) { const float ang = (float)(axis ? (t & 63) : (t >> 6)) * inv; sincosf(ang, &sn, &cs); }
#pragma unroll
    for (int it = 0; it < 5; ++it) {
      const int hd = it * 2 + half;
      if (!isx && hd < 8) continue;
      const float v1 = bf2f(z[hd * 64 + d1]), v2 = bf2f(z[hd * 64 + d2]);
      float ss = v1 * v1 + v2 * v2;
#pragma unroll
      for (int o = 16; o >= 1; o >>= 1) ss += __shfl_xor(ss, o, 64);
      const float rms = rsqrtf(ss * (1.f / 64.f) + QK_EPS);
      const bool isq = hd < 8;
      const float y1 = v1 * rms * (isq ? gq1 : gk1), y2 = v2 * rms * (isq ? gq2 : gk2);
      float o1 = y1 * cs - y2 * sn, o2 = y2 * cs + y1 * sn;
      if (isq) {
        ushort_t* dst = QB + ((size_t)(b * 8 + hd) * SEQ + t) * 64;
        dst[d1] = f2bf(o1 * QSCALE); dst[d2] = f2bf(o2 * QSCALE);
      } else {
        ushort_t* dst = KB + ((size_t)(b * 2 + (hd - 8)) * LTOT + pos) * 64;
        dst[d1] = f2bf(o1); dst[d2] = f2bf(o2);
      }
    }
    {
      const size_t tb = (size_t)(pos >> 6) * 4096 + lane * 64 + vperm(pos & 63);
      VB[(size_t)(b * 2 + 0) * LTOT * 64 + tb] = z[640 + lane];
      VB[(size_t)(b * 2 + 1) * LTOT * 64 + tb] = z[704 + lane];
    }
  }
}

DI void phase_rwkv_prep(const Params& p, unsigned char* smem) {
  float* kbuf = (float*)smem;
  ushort_t* codes = (ushort_t*)(smem + 65536);
  float* invn = (float*)(smem + 65536 + 32 * 264 * 2);
  const ushort_t* zm = (const ushort_t*)p.out;
  const ushort_t* WL = (const ushort_t*)(p.ws + OFF_WL);
  ushort_t* SH = (ushort_t*)(p.ws + OFF_SH);
  ushort_t* DR = (ushort_t*)(p.ws + OFF_DR);
  const int tid = threadIdx.x, wave = tid >> 6, lane = tid & 63, l31 = lane & 31, hh = lane >> 5;
  for (int tt = blockIdx.x; tt < NT / 32; tt += gridDim.x) {
    const int row0 = tt * 32;
    int b, t0, len, pbase;
    if (row0 < NX) { b = row0 / SEQ; t0 = row0 % SEQ; len = SEQ; pbase = CTXL; }
    else { const int rc = row0 - NX; b = rc / CTXL; t0 = rc % CTXL; len = CTXL; pbase = 0; }
    __syncthreads();
    for (int id = tid; id < 32 * 224; id += NTH) {
      const int i = id / 224, c0 = (id % 224) * 8;
      const int t = t0 + i;
      const ushort_t* zr = zm + (size_t)(row0 + i) * 1792 + c0;
      const uint4 zc = *(const uint4*)zr;
      uint4 zp = make_uint4(0, 0, 0, 0), zn = make_uint4(0, 0, 0, 0);
      if (t > 0) zp = *(const uint4*)(zr - 1792);
      if (t < len - 1) zn = *(const uint4*)(zr + 1792);
      const float4 mp0 = *(const float4*)(p.mu_prev + c0), mp1 = *(const float4*)(p.mu_prev + c0 + 4);
      const float4 mn0 = *(const float4*)(p.mu_next + c0), mn1 = *(const float4*)(p.mu_next + c0 + 4);
      const unsigned zcw[4] = {zc.x, zc.y, zc.z, zc.w}, zpw[4] = {zp.x, zp.y, zp.z, zp.w}, znw[4] = {zn.x, zn.y, zn.z, zn.w};
      const float mpv[8] = {mp0.x, mp0.y, mp0.z, mp0.w, mp1.x, mp1.y, mp1.z, mp1.w};
      const float mnv[8] = {mn0.x, mn0.y, mn0.z, mn0.w, mn1.x, mn1.y, mn1.z, mn1.w};
      float s[8];
#pragma unroll
      for (int q = 0; q < 4; ++q) {
        const float c_lo = bflo(zcw[q]), c_hi = bfhi(zcw[q]);
        s[2 * q] = c_lo + mpv[2 * q] * (bflo(zpw[q]) - c_lo) + mnv[2 * q] * (bflo(znw[q]) - c_lo);
        s[2 * q + 1] = c_hi + mpv[2 * q + 1] * (bfhi(zpw[q]) - c_hi) + mnv[2 * q + 1] * (bfhi(znw[q]) - c_hi);
      }
      const int pp = pbase + t;
      if (c0 < 512 || (c0 >= 1024 && c0 < 1536)) {
        const int cc = (c0 < 512) ? c0 : c0 - 1024, which = (c0 < 512) ? 1 : 2;
        const int head = cc >> 6, d = cc & 63;
        uint4 o;
        o.x = pack_h2(s[0], s[1]); o.y = pack_h2(s[2], s[3]); o.z = pack_h2(s[4], s[5]); o.w = pack_h2(s[6], s[7]);
        *(uint4*)(SH + (((size_t)(b * 8 + head) * LTOT + pp) * 3 + which) * 64 + d) = o;
      } else if (c0 < 1024) {
        float* kd = kbuf + i * 512 + (c0 - 512);
        *(float4*)kd = make_float4(s[0], s[1], s[2], s[3]);
        *(float4*)(kd + 4) = make_float4(s[4], s[5], s[6], s[7]);
      } else {
        const int cc = c0 - 1536;
        if (cc < 128) {
#pragma unroll
          for (int q = 0; q < 8; ++q) s[q] = tanhf(s[q]);
        }
        uint4 o;
        o.x = pack_bf2(s[0], s[1]); o.y = pack_bf2(s[2], s[3]); o.z = pack_bf2(s[4], s[5]); o.w = pack_bf2(s[6], s[7]);
        *(uint4*)(codes + i * 264 + cc) = o;
      }
    }
    __syncthreads();
    {
      const int i = tid >> 4, head = (tid >> 1) & 7, hf = tid & 1;
      float ss = 0.f;
#pragma unroll 8
      for (int q = 0; q < 32; ++q) {
        const int n = head * 64 + hf * 32 + q;
        const float v = kbuf[i * 512 + n] * p.k_k[n];
        ss = fmaf(v, v, ss);
      }
      ss += __shfl_xor(ss, 1, 64);
      if (hf == 0) invn[i * 8 + head] = 1.f / fmaxf(sqrtf(ss), 1e-12f);
    }
    __syncthreads();
#pragma unroll 1
    for (int q4 = 0; q4 < 4; ++q4) {
      const int pr = wave * 4 + q4, dir = pr >> 4, ct = pr & 15;
      f32x16 aw = zero16(), aa = zero16();
#pragma unroll
      for (int ks = 0; ks < 4; ++ks) {
        const bf16x8 fw = *(const bf16x8*)&codes[l31 * 264 + dir * 64 + ks * 16 + hh * 8];
        const bf16x8 fa = *(const bf16x8*)&codes[l31 * 264 + 128 + dir * 64 + ks * 16 + hh * 8];
        const bf16x8 bw = *(const bf16x8*)&WL[(size_t)((dir * 2 + 0) * 512 + ct * 32 + l31) * 64 + ks * 16 + hh * 8];
        const bf16x8 ba = *(const bf16x8*)&WL[(size_t)((dir * 2 + 1) * 512 + ct * 32 + l31) * 64 + ks * 16 + hh * 8];
        aw = MFMA(fw, bw, aw);
        aa = MFMA(fa, ba, aa);
      }
      const int n = ct * 32 + l31, head = n >> 6, d = n & 63;
      const float w0v = p.w0[dir * 512 + n], a0v = p.a0[dir * 512 + n], kkw = p.k_k[n], kaw = p.k_a[n];
      const size_t cbase = (size_t)(b * 8 + head) * LTOT;
#pragma unroll
      for (int i = 0; i < 16; ++i) {
        const int ti = crow(i, hh);
        const int pp = pbase + t0 + ti;
        const float wpre = aw[i] + w0v;
        const float e = 0.60653065971263342f * sigmf(wpre);
        const float xdec = 1.f - __expf(-e);
        const float a = sigmf(aa[i] + a0v);
        const float kv = kbuf[ti * 512 + n];
        const float kkv = kv * kkw * invn[ti * 8 + head];
        const float kd = kv * (1.f + (a - 1.f) * kaw);
        ushort_t* dr = DR + ((((size_t)dir * 16) * LTOT + cbase + pp) * 3) * 64 + d;
        dr[0] = f2h(-xdec); dr[64] = f2h(kd); dr[128] = f2h(kkv * a);
        if (dir == 0) SH[((cbase + pp) * 3) * 64 + d] = f2h(kkv);
      }
    }
  }
}

DI int tau_to_pos(int dir, int tau) { return dir == 0 ? tau : (tau < CTXL ? CTXL - 1 - tau : LTOT - 1 - (tau - CTXL)); }


DI void fm_lo(float& acc, float a, uint32_t w) { asm("v_fma_mix_f32 %0, %1, %2, %0 op_sel_hi:[0,1,0]" : "+v"(acc) : "v"(a), "s"(w)); }
DI void fm_hi(float& acc, float a, uint32_t w) { asm("v_fma_mix_f32 %0, %1, %2, %0 op_sel:[0,1,0] op_sel_hi:[0,1,0]" : "+v"(acc) : "v"(a), "s"(w)); }
DI void fx_lo(float& s, uint32_t w) { asm("v_fma_mix_f32 %0, %0, %1, %0 op_sel_hi:[0,1,0]" : "+v"(s) : "s"(w)); }
DI void fx_hi(float& s, uint32_t w) { asm("v_fma_mix_f32 %0, %0, %1, %0 op_sel:[0,1,0] op_sel_hi:[0,1,0]" : "+v"(s) : "s"(w)); }
constexpr int PFD = 2, SEG = 65;
static_assert(CH % SEG == 0, "segments");
DI void scan_prefetch(uint32_t& pfr, const ushort_t* shc, const ushort_t* drc, int pos, int lane) {
  const ushort_t* a = (lane < 24) ? shc + (size_t)pos * 192 + lane * 8 : drc + (size_t)pos * 192 + (lane < 48 ? lane - 24 : 23) * 8;
  asm volatile("global_load_dword %0, %1, off" : "+v"(pfr) : "v"(a) : "memory");
}
DI void scan_stage_v(ushort_t* vbuf, const ushort_t* shc, int dir, int tau0, int lane) {
#pragma unroll
  for (int i = 0; i < (SEG * 8 + 63) / 64; ++i) {
    const int id = i * 64 + lane, st = id >> 3;
    if (st < SEG) *(uint4*)&vbuf[st * 64 + (id & 7) * 8] = *(const uint4*)(shc + (size_t)tau_to_pos(dir, tau0 + st) * 192 + 128 + (id & 7) * 8);
  }
}
struct ScanRec { uint32_t sh, dr, bb; ushort_t v; };
DI ScanRec scan_load(const ushort_t* shc, const ushort_t* drc, int pos, int lane) {
  ScanRec r;
  const ushort_t* s = shc + (size_t)pos * 192;
  const uint32_t* d = (const uint32_t*)(drc + (size_t)pos * 192);
  r.sh = ((const uint32_t*)s)[lane];
  r.v = s[128 + lane];
  r.dr = d[lane];
  r.bb = d[64 + (lane & 31)];
  return r;
}
#define MIXLO " op_sel_hi:[0,1,0]\n\t"
#define MIXHI " op_sel:[0,1,0] op_sel_hi:[0,1,0]\n\t"
template <int L>
DI void dot4(float& a0, float& a1, float& a2, float& a3, float (&S)[64], uint32_t src) {
  uint32_t t0, t1, t2, t3;
  asm("v_readlane_b32 %4, %8, %9\n\tv_readlane_b32 %5, %8, %10\n\tv_readlane_b32 %6, %8, %11\n\tv_readlane_b32 %7, %8, %12\n\t"
      "v_fma_mix_f32 %0, %13, %4, %0" MIXLO "v_fma_mix_f32 %1, %14, %4, %1" MIXHI
      "v_fma_mix_f32 %2, %15, %5, %2" MIXLO "v_fma_mix_f32 %3, %16, %5, %3" MIXHI
      "v_fma_mix_f32 %0, %17, %6, %0" MIXLO "v_fma_mix_f32 %1, %18, %6, %1" MIXHI
      "v_fma_mix_f32 %2, %19, %7, %2" MIXLO "v_fma_mix_f32 %3, %20, %7, %3" MIXHI
      : "+v"(a0), "+v"(a1), "+v"(a2), "+v"(a3), "=&s"(t0), "=&s"(t1), "=&s"(t2), "=&s"(t3)
      : "v"(src), "n"(L), "n"(L + 1), "n"(L + 2), "n"(L + 3),
        "v"(S[2 * (L & 31)]), "v"(S[2 * (L & 31) + 1]), "v"(S[2 * (L & 31) + 2]), "v"(S[2 * (L & 31) + 3]),
        "v"(S[2 * (L & 31) + 4]), "v"(S[2 * (L & 31) + 5]), "v"(S[2 * (L & 31) + 6]), "v"(S[2 * (L & 31) + 7]));
}
template <int L>
DI void upd4(float (&S)[64], uint32_t dr, uint32_t bb, float vv, float nsk) {
  uint32_t x0, x1, x2, x3, k0, k1, k2, k3, b0, b1, b2, b3;
  asm("v_readlane_b32 %8, %20, %22\n\tv_readlane_b32 %9, %20, %23\n\tv_readlane_b32 %10, %20, %24\n\tv_readlane_b32 %11, %20, %25\n\t"
      "v_readlane_b32 %12, %20, %26\n\tv_readlane_b32 %13, %20, %27\n\tv_readlane_b32 %14, %20, %28\n\tv_readlane_b32 %15, %20, %29\n\t"
      "v_readlane_b32 %16, %21, %22\n\tv_readlane_b32 %17, %21, %23\n\tv_readlane_b32 %18, %21, %24\n\tv_readlane_b32 %19, %21, %25\n\t"
      "v_fma_mix_f32 %0, %0, %8, %0" MIXLO "v_fma_mix_f32 %1, %1, %8, %1" MIXHI
      "v_fma_mix_f32 %2, %2, %9, %2" MIXLO "v_fma_mix_f32 %3, %3, %9, %3" MIXHI
      "v_fma_mix_f32 %4, %4, %10, %4" MIXLO "v_fma_mix_f32 %5, %5, %10, %5" MIXHI
      "v_fma_mix_f32 %6, %6, %11, %6" MIXLO "v_fma_mix_f32 %7, %7, %11, %7" MIXHI
      "v_fma_mix_f32 %0, %30, %12, %0" MIXLO "v_fma_mix_f32 %1, %30, %12, %1" MIXHI
      "v_fma_mix_f32 %2, %30, %13, %2" MIXLO "v_fma_mix_f32 %3, %30, %13, %3" MIXHI
      "v_fma_mix_f32 %4, %30, %14, %4" MIXLO "v_fma_mix_f32 %5, %30, %14, %5" MIXHI
      "v_fma_mix_f32 %6, %30, %15, %6" MIXLO "v_fma_mix_f32 %7, %30, %15, %7" MIXHI
      "v_fma_mix_f32 %0, %31, %16, %0" MIXLO "v_fma_mix_f32 %1, %31, %16, %1" MIXHI
      "v_fma_mix_f32 %2, %31, %17, %2" MIXLO "v_fma_mix_f32 %3, %31, %17, %3" MIXHI
      "v_fma_mix_f32 %4, %31, %18, %4" MIXLO "v_fma_mix_f32 %5, %31, %18, %5" MIXHI
      "v_fma_mix_f32 %6, %31, %19, %6" MIXLO "v_fma_mix_f32 %7, %31, %19, %7" MIXHI
      : "+v"(S[2 * L]), "+v"(S[2 * L + 1]), "+v"(S[2 * L + 2]), "+v"(S[2 * L + 3]), "+v"(S[2 * L + 4]), "+v"(S[2 * L + 5]), "+v"(S[2 * L + 6]), "+v"(S[2 * L + 7]),
        "=&s"(x0), "=&s"(x1), "=&s"(x2), "=&s"(x3), "=&s"(k0), "=&s"(k1), "=&s"(k2), "=&s"(k3), "=&s"(b0), "=&s"(b1), "=&s"(b2), "=&s"(b3)
      : "v"(dr), "v"(bb), "n"(L), "n"(L + 1), "n"(L + 2), "n"(L + 3), "n"(L + 32), "n"(L + 33), "n"(L + 34), "n"(L + 35), "v"(vv), "v"(nsk));
}
template <int L>
DI void dot4_2(float& a0, float& a1, float& c0, float& c1, float (&SU)[64], float (&SP)[64], uint32_t src) {
  uint32_t t0, t1, t2, t3;
  asm("v_readlane_b32 %4, %8, %9\n\tv_readlane_b32 %5, %8, %10\n\tv_readlane_b32 %6, %8, %11\n\tv_readlane_b32 %7, %8, %12\n\t"
      "v_fma_mix_f32 %0, %13, %4, %0" MIXLO "v_fma_mix_f32 %1, %14, %4, %1" MIXHI
      "v_fma_mix_f32 %2, %21, %4, %2" MIXLO "v_fma_mix_f32 %3, %22, %4, %3" MIXHI
      "v_fma_mix_f32 %0, %15, %5, %0" MIXLO "v_fma_mix_f32 %1, %16, %5, %1" MIXHI
      "v_fma_mix_f32 %2, %23, %5, %2" MIXLO "v_fma_mix_f32 %3, %24, %5, %3" MIXHI
      "v_fma_mix_f32 %0, %17, %6, %0" MIXLO "v_fma_mix_f32 %1, %18, %6, %1" MIXHI
      "v_fma_mix_f32 %2, %25, %6, %2" MIXLO "v_fma_mix_f32 %3, %26, %6, %3" MIXHI
      "v_fma_mix_f32 %0, %19, %7, %0" MIXLO "v_fma_mix_f32 %1, %20, %7, %1" MIXHI
      "v_fma_mix_f32 %2, %27, %7, %2" MIXLO "v_fma_mix_f32 %3, %28, %7, %3" MIXHI
      : "+v"(a0), "+v"(a1), "+v"(c0), "+v"(c1), "=&s"(t0), "=&s"(t1), "=&s"(t2), "=&s"(t3)
      : "v"(src), "n"(L), "n"(L + 1), "n"(L + 2), "n"(L + 3),
        "v"(SU[2 * L]), "v"(SU[2 * L + 1]), "v"(SU[2 * L + 2]), "v"(SU[2 * L + 3]), "v"(SU[2 * L + 4]), "v"(SU[2 * L + 5]), "v"(SU[2 * L + 6]), "v"(SU[2 * L + 7]),
        "v"(SP[2 * L]), "v"(SP[2 * L + 1]), "v"(SP[2 * L + 2]), "v"(SP[2 * L + 3]), "v"(SP[2 * L + 4]), "v"(SP[2 * L + 5]), "v"(SP[2 * L + 6]), "v"(SP[2 * L + 7]));
}
template <int L>
DI void upd4_2(float (&SU)[64], float (&SP)[64], uint32_t dr, uint32_t bb, float vv, float nskU, float nskP) {
  uint32_t x0, x1, x2, x3, k0, k1, k2, k3, b0, b1, b2, b3;
  asm("v_readlane_b32 %16, %28, %30\n\tv_readlane_b32 %17, %28, %31\n\tv_readlane_b32 %18, %28, %32\n\tv_readlane_b32 %19, %28, %33\n\t"
      "v_readlane_b32 %20, %28, %34\n\tv_readlane_b32 %21, %28, %35\n\tv_readlane_b32 %22, %28, %36\n\tv_readlane_b32 %23, %28, %37\n\t"
      "v_readlane_b32 %24, %29, %30\n\tv_readlane_b32 %25, %29, %31\n\tv_readlane_b32 %26, %29, %32\n\tv_readlane_b32 %27, %29, %33\n\t"
      "v_fma_mix_f32 %0, %0, %16, %0" MIXLO "v_fma_mix_f32 %1, %1, %16, %1" MIXHI
      "v_fma_mix_f32 %2, %2, %17, %2" MIXLO "v_fma_mix_f32 %3, %3, %17, %3" MIXHI
      "v_fma_mix_f32 %4, %4, %18, %4" MIXLO "v_fma_mix_f32 %5, %5, %18, %5" MIXHI
      "v_fma_mix_f32 %6, %6, %19, %6" MIXLO "v_fma_mix_f32 %7, %7, %19, %7" MIXHI
      "v_fma_mix_f32 %8, %8, %16, %8" MIXLO "v_fma_mix_f32 %9, %9, %16, %9" MIXHI
      "v_fma_mix_f32 %10, %10, %17, %10" MIXLO "v_fma_mix_f32 %11, %11, %17, %11" MIXHI
      "v_fma_mix_f32 %12, %12, %18, %12" MIXLO "v_fma_mix_f32 %13, %13, %18, %13" MIXHI
      "v_fma_mix_f32 %14, %14, %19, %14" MIXLO "v_fma_mix_f32 %15, %15, %19, %15" MIXHI
      "v_fma_mix_f32 %0, %38, %20, %0" MIXLO "v_fma_mix_f32 %1, %38, %20, %1" MIXHI
      "v_fma_mix_f32 %2, %38, %21, %2" MIXLO "v_fma_mix_f32 %3, %38, %21, %3" MIXHI
      "v_fma_mix_f32 %4, %38, %22, %4" MIXLO "v_fma_mix_f32 %5, %38, %22, %5" MIXHI
      "v_fma_mix_f32 %6, %38, %23, %6" MIXLO "v_fma_mix_f32 %7, %38, %23, %7" MIXHI
      "v_fma_mix_f32 %0, %39, %24, %0" MIXLO "v_fma_mix_f32 %1, %39, %24, %1" MIXHI
      "v_fma_mix_f32 %2, %39, %25, %2" MIXLO "v_fma_mix_f32 %3, %39, %25, %3" MIXHI
      "v_fma_mix_f32 %4, %39, %26, %4" MIXLO "v_fma_mix_f32 %5, %39, %26, %5" MIXHI
      "v_fma_mix_f32 %6, %39, %27, %6" MIXLO "v_fma_mix_f32 %7, %39, %27, %7" MIXHI
      "v_fma_mix_f32 %8, %40, %24, %8" MIXLO "v_fma_mix_f32 %9, %40, %24, %9" MIXHI
      "v_fma_mix_f32 %10, %40, %25, %10" MIXLO "v_fma_mix_f32 %11, %40, %25, %11" MIXHI
      "v_fma_mix_f32 %12, %40, %26, %12" MIXLO "v_fma_mix_f32 %13, %40, %26, %13" MIXHI
      "v_fma_mix_f32 %14, %40, %27, %14" MIXLO "v_fma_mix_f32 %15, %40, %27, %15" MIXHI
      : "+v"(SU[2 * L]), "+v"(SU[2 * L + 1]), "+v"(SU[2 * L + 2]), "+v"(SU[2 * L + 3]), "+v"(SU[2 * L + 4]), "+v"(SU[2 * L + 5]), "+v"(SU[2 * L + 6]), "+v"(SU[2 * L + 7]),
        "+v"(SP[2 * L]), "+v"(SP[2 * L + 1]), "+v"(SP[2 * L + 2]), "+v"(SP[2 * L + 3]), "+v"(SP[2 * L + 4]), "+v"(SP[2 * L + 5]), "+v"(SP[2 * L + 6]), "+v"(SP[2 * L + 7]),
        "=&s"(x0), "=&s"(x1), "=&s"(x2), "=&s"(x3), "=&s"(k0), "=&s"(k1), "=&s"(k2), "=&s"(k3), "=&s"(b0), "=&s"(b1), "=&s"(b2), "=&s"(b3)
      : "v"(dr), "v"(bb), "n"(L), "n"(L + 1), "n"(L + 2), "n"(L + 3), "n"(L + 32), "n"(L + 33), "n"(L + 34), "n"(L + 35), "v"(vv), "v"(nskU), "v"(nskP));
}
DI void scan_step2(float (&SU)[64], float (&SP)[64], const ScanRec& c, float vv) {
  float a0 = 0.f, a1 = 0.f, c0 = 0.f, c1 = 0.f;
  dot4_2<0>(a0, a1, c0, c1, SU, SP, c.sh); dot4_2<4>(a0, a1, c0, c1, SU, SP, c.sh); dot4_2<8>(a0, a1, c0, c1, SU, SP, c.sh); dot4_2<12>(a0, a1, c0, c1, SU, SP, c.sh);
  dot4_2<16>(a0, a1, c0, c1, SU, SP, c.sh); dot4_2<20>(a0, a1, c0, c1, SU, SP, c.sh); dot4_2<24>(a0, a1, c0, c1, SU, SP, c.sh); dot4_2<28>(a0, a1, c0, c1, SU, SP, c.sh);
  const float nU = -(a0 + a1), nP = -(c0 + c1);
  upd4_2<0>(SU, SP, c.dr, c.bb, vv, nU, nP); upd4_2<4>(SU, SP, c.dr, c.bb, vv, nU, nP); upd4_2<8>(SU, SP, c.dr, c.bb, vv, nU, nP); upd4_2<12>(SU, SP, c.dr, c.bb, vv, nU, nP);
  upd4_2<16>(SU, SP, c.dr, c.bb, vv, nU, nP); upd4_2<20>(SU, SP, c.dr, c.bb, vv, nU, nP); upd4_2<24>(SU, SP, c.dr, c.bb, vv, nU, nP); upd4_2<28>(SU, SP, c.dr, c.bb, vv, nU, nP);
}
template <bool WITH_OUT>
DI float scan_step(float (&S)[64], const ScanRec& c, float vv) {
  float s0 = 0.f, s1 = 0.f, s2 = 0.f, s3 = 0.f;
  dot4<0>(s0, s1, s2, s3, S, c.sh); dot4<4>(s0, s1, s2, s3, S, c.sh); dot4<8>(s0, s1, s2, s3, S, c.sh); dot4<12>(s0, s1, s2, s3, S, c.sh);
  dot4<16>(s0, s1, s2, s3, S, c.sh); dot4<20>(s0, s1, s2, s3, S, c.sh); dot4<24>(s0, s1, s2, s3, S, c.sh); dot4<28>(s0, s1, s2, s3, S, c.sh);
  const float nsk = -((s0 + s1) + (s2 + s3));
  upd4<0>(S, c.dr, c.bb, vv, nsk); upd4<4>(S, c.dr, c.bb, vv, nsk); upd4<8>(S, c.dr, c.bb, vv, nsk); upd4<12>(S, c.dr, c.bb, vv, nsk);
  upd4<16>(S, c.dr, c.bb, vv, nsk); upd4<20>(S, c.dr, c.bb, vv, nsk); upd4<24>(S, c.dr, c.bb, vv, nsk); upd4<28>(S, c.dr, c.bb, vv, nsk);
  float o0 = 0.f, o1 = 0.f, o2 = 0.f, o3 = 0.f;
  if (WITH_OUT) {
    dot4<32>(o0, o1, o2, o3, S, c.sh); dot4<36>(o0, o1, o2, o3, S, c.sh); dot4<40>(o0, o1, o2, o3, S, c.sh); dot4<44>(o0, o1, o2, o3, S, c.sh);
    dot4<48>(o0, o1, o2, o3, S, c.sh); dot4<52>(o0, o1, o2, o3, S, c.sh); dot4<56>(o0, o1, o2, o3, S, c.sh); dot4<60>(o0, o1, o2, o3, S, c.sh);
  }
  return (o0 + o1) + (o2 + o3);
}
constexpr int SPF = 3;
DI void scan_stage_vr(ushort_t* vbuf, ushort_t* rbuf, const ushort_t* shc, int dir, int tau0, int lane) {
#pragma unroll
  for (int i = 0; i < (SEG * 8 + 63) / 64; ++i) {
    const int id = i * 64 + lane, st = id >> 3;
    if (st < SEG) {
      const ushort_t* rec = shc + (size_t)tau_to_pos(dir, tau0 + st) * 192 + (id & 7) * 8;
      *(uint4*)&vbuf[st * 64 + (id & 7) * 8] = *(const uint4*)(rec + 128);
      *(uint4*)&rbuf[st * 64 + (id & 7) * 8] = *(const uint4*)(rec + 64);
    }
    if (i % 3 == 2) asm volatile("" ::: "memory");
  }
}
DI void fv_lo(float& acc, float a, uint32_t w) { asm("v_fma_mix_f32 %0, %1, %2, %0 op_sel_hi:[0,1,0]" : "+v"(acc) : "v"(a), "v"(w)); }
DI void fv_hi(float& acc, float a, uint32_t w) { asm("v_fma_mix_f32 %0, %1, %2, %0 op_sel:[0,1,0] op_sel_hi:[0,1,0]" : "+v"(acc) : "v"(a), "v"(w)); }
DI void phase_scanA(const Params& p, unsigned char* smem) {
  const ushort_t* SH = (const ushort_t*)(p.ws + OFF_SH);
  const ushort_t* DR = (const ushort_t*)(p.ws + OFF_DR);
  float* PU = p.out;
  const int lane = threadIdx.x & 63;
  ushort_t* vbuf = (ushort_t*)smem + (threadIdx.x >> 6) * (2 * SEG * 64);
  ushort_t* rbuf = vbuf + SEG * 64;
  ushort_t* O = (ushort_t*)(p.ws + OFF_ZQ);
  ushort_t* DRw = (ushort_t*)(p.ws + OFF_DR);
  const int gw = __builtin_amdgcn_readfirstlane(blockIdx.x * 8 + (threadIdx.x >> 6));
  uint32_t pfr = 0u;
  for (int task = gw; task < 32 * NCHUNK; task += gridDim.x * 8) {
    const int cd = task / NCHUNK, j = task % NCHUNK, dir = cd >> 4, c = cd & 15, b = c >> 3, head = c & 7;
    float SU[64], SP[64];
#pragma unroll
    for (int k = 0; k < 64; ++k) { SU[k] = 0.f; SP[k] = (k == lane) ? 1.f : 0.f; }
    const ushort_t* shc = SH + (size_t)c * LTOT * 192;
    const ushort_t* drc = DR + (size_t)(dir * 16 + c) * LTOT * 192;
#pragma unroll 1
    for (int st = 0; st < PFD; ++st) scan_prefetch(pfr, shc, drc, tau_to_pos(dir, j * CH + st), lane);
#pragma unroll 1
    for (int sg = 0; sg < CH / SEG; ++sg) {
      scan_stage_vr(vbuf, rbuf, shc, dir, j * CH + sg * SEG, lane);
#pragma unroll 1
      for (int s2 = 0; s2 < SEG; ++s2) {
        const int st = sg * SEG + s2;
        const int pos = tau_to_pos(dir, j * CH + st);
        const ushort_t* shr = shc + (size_t)pos * 192;
        const ushort_t* drr = drc + (size_t)pos * 192;
        scan_prefetch(pfr, shc, drc, tau_to_pos(dir, j * CH + (st + PFD < CH ? st + PFD : CH - 1)), lane);
        const float vv = h2f(vbuf[s2 * 64 + lane]);
        u32x16 a0, a1, b0, b1;
        sload4(a0, a1, b0, b1, shr, drr);
        float u0 = 0.f, u1 = 0.f, q0 = 0.f, q1 = 0.f;
#pragma unroll
        for (int q = 0; q < 16; ++q) {
          fm_lo(u0, SU[2 * q], a0[q]); fm_hi(u1, SU[2 * q + 1], a0[q]); fm_lo(q0, SP[2 * q], a0[q]); fm_hi(q1, SP[2 * q + 1], a0[q]);
          fm_lo(u0, SU[32 + 2 * q], a1[q]); fm_hi(u1, SU[33 + 2 * q], a1[q]); fm_lo(q0, SP[32 + 2 * q], a1[q]); fm_hi(q1, SP[33 + 2 * q], a1[q]);
        }
        const float nU = -(u0 + u1), nP = -(q0 + q1);
#pragma unroll
        for (int q = 0; q < 16; ++q) {
          fx_lo(SU[2 * q], b0[q]); fx_hi(SU[2 * q + 1], b0[q]); fx_lo(SU[32 + 2 * q], b1[q]); fx_hi(SU[33 + 2 * q], b1[q]);
          fx_lo(SP[2 * q], b0[q]); fx_hi(SP[2 * q + 1], b0[q]); fx_lo(SP[32 + 2 * q], b1[q]); fx_hi(SP[33 + 2 * q], b1[q]);
        }
        sload4(a0, a1, b0, b1, drr + 64, drr + 128);
#pragma unroll
        for (int q = 0; q < 16; ++q) { fm_lo(SU[2 * q], vv, a0[q]); fm_hi(SU[2 * q + 1], vv, a0[q]); fm_lo(SU[32 + 2 * q], vv, a1[q]); fm_hi(SU[33 + 2 * q], vv, a1[q]); }
#pragma unroll
        for (int q = 0; q < 16; ++q) {
          fm_lo(SU[2 * q], nU, b0[q]); fm_hi(SU[2 * q + 1], nU, b0[q]); fm_lo(SU[32 + 2 * q], nU, b1[q]); fm_hi(SU[33 + 2 * q], nU, b1[q]);
          fm_lo(SP[2 * q], nP, b0[q]); fm_hi(SP[2 * q + 1], nP, b0[q]); fm_lo(SP[32 + 2 * q], nP, b1[q]); fm_hi(SP[33 + 2 * q], nP, b1[q]);
        }
        if (pos >= CTXL) {
          float e0 = 0.f, e1 = 0.f, g0 = 0.f, g1 = 0.f;
#pragma unroll
          for (int q = 0; q < 8; ++q) {
            asm volatile("" ::: "memory");
            const uint4 rw = *(const uint4*)&rbuf[s2 * 64 + q * 8];
            fv_lo(e0, SU[8 * q + 0], rw.x); fv_hi(e1, SU[8 * q + 1], rw.x); fv_lo(g0, SP[8 * q + 0], rw.x); fv_hi(g1, SP[8 * q + 1], rw.x);
            fv_lo(e0, SU[8 * q + 2], rw.y); fv_hi(e1, SU[8 * q + 3], rw.y); fv_lo(g0, SP[8 * q + 2], rw.y); fv_hi(g1, SP[8 * q + 3], rw.y);
            fv_lo(e0, SU[8 * q + 4], rw.z); fv_hi(e1, SU[8 * q + 5], rw.z); fv_lo(g0, SP[8 * q + 4], rw.z); fv_hi(g1, SP[8 * q + 5], rw.z);
            fv_lo(e0, SU[8 * q + 6], rw.w); fv_hi(e1, SU[8 * q + 7], rw.w); fv_lo(g0, SP[8 * q + 6], rw.w); fv_hi(g1, SP[8 * q + 7], rw.w);
          }
          O[(unsigned)((dir * NX + b * SEQ + (pos - CTXL)) * 512 + head * 64 + lane)] = f2h(e0 + e1);
          DRw[(unsigned)(((dir * 16 + c) * LTOT + pos) * 192 + lane)] = f2h(g0 + g1);
        }
      }
    }
    const unsigned dsto = (unsigned)(task * 2 * 4096 + lane * 64);
#pragma unroll
    for (int k = 0; k < 64; k += 4) {
      *(float4*)(PU + dsto + k) = make_float4(SU[k], SU[k + 1], SU[k + 2], SU[k + 3]);
      *(float4*)(PU + dsto + 4096 + k) = make_float4(SP[k], SP[k + 1], SP[k + 2], SP[k + 3]);
    }
  }
  asm volatile("s_waitcnt vmcnt(0)" ::: "memory");
  asm volatile("" :: "v"(pfr));
}

DI void phase_scanB(const Params& p, unsigned char* smem) {
  int tix = threadIdx.x;
  asm volatile("" : "+v"(tix));
  if (blockIdx.x >= 32) return;
  float* Sb = (float*)smem;
  float* Xb = Sb + 64 * 65;
  float* Pb = Xb + 4096;
  float* Ub = Pb + 4096;
  float* PU = p.out;
  const int cd = blockIdx.x, tid = tix, wave = tid >> 6, lane = tid & 63, l31 = lane & 31, hh = lane >> 5;
  const int tile = wave & 3, tm = tile >> 1, tn = tile & 1, kh = wave >> 2;
  for (int i = tid; i < 64 * 65; i += NTH) Sb[i] = 0.f;
  constexpr int BPF = 5;
  float4 st[BPF][4];
  auto fetch = [&](int j, float4 (&r)[4]) {
    const float* base = PU + (size_t)(cd * NCHUNK + j) * 2 * 4096 + tid * 8;
    r[0] = *(const float4*)(base + 4096); r[1] = *(const float4*)(base + 4100);
    r[2] = *(const float4*)base; r[3] = *(const float4*)(base + 4);
  };
  auto stage = [&](const float4 (&r)[4]) {
    *(float4*)&Pb[tid * 8] = r[0]; *(float4*)&Pb[tid * 8 + 4] = r[1];
    *(float4*)&Ub[tid * 8] = r[2]; *(float4*)&Ub[tid * 8 + 4] = r[3];
  };
  auto put_state = [&](int j, const f32x16& sv) {
    float* base = PU + (size_t)(cd * NCHUNK + j) * 2 * 4096;
#pragma unroll
    for (int i = 0; i < 16; ++i) base[(tm * 32 + crow(i, hh)) * 64 + tn * 32 + l31] = sv[i];
  };
#pragma unroll
  for (int s = 0; s < BPF; ++s) fetch(s, st[s]);
  stage(st[0]);
#pragma unroll
  for (int s = 0; s + 1 < BPF; ++s)
#pragma unroll
    for (int q = 0; q < 4; ++q) st[s][q] = st[s + 1][q];
  fetch(BPF, st[BPF - 1]);
  __syncthreads();
  if (kh == 0) put_state(0, zero16());
#pragma unroll 1
  for (int j = 0; j < NCHUNK; ++j) {
    f32x16 acc = zero16();
    if (kh == 0) {
#pragma unroll
      for (int i = 0; i < 16; ++i) acc[i] = Ub[(tm * 32 + crow(i, hh)) * 64 + tn * 32 + l31];
    }
#pragma unroll
    for (int kk = 0; kk < 16; ++kk) {
      const int k = kh * 32 + 2 * kk + hh;
      acc = __builtin_amdgcn_mfma_f32_32x32x2f32(Sb[(tm * 32 + l31) * 65 + k], Pb[k * 64 + tn * 32 + l31], acc, 0, 0, 0);
    }
    if (kh == 1) {
#pragma unroll
      for (int i = 0; i < 16; ++i) Xb[(tile * 16 + i) * 64 + lane] = acc[i];
    }
    __syncthreads();
    if (kh == 0) {
#pragma unroll
      for (int i = 0; i < 16; ++i) { acc[i] += Xb[(tile * 16 + i) * 64 + lane]; Sb[(tm * 32 + crow(i, hh)) * 65 + tn * 32 + l31] = acc[i]; }
    }
    if (j + 1 < NCHUNK) {
      stage(st[0]);
#pragma unroll
      for (int s = 0; s + 1 < BPF; ++s)
#pragma unroll
        for (int q = 0; q < 4; ++q) st[s][q] = st[s + 1][q];
      if (j + 1 + BPF < NCHUNK) fetch(j + 1 + BPF, st[BPF - 1]);
    }
    __syncthreads();
    if (kh == 0 && j + 1 < NCHUNK) put_state(j + 1, acc);
  }
}

typedef __attribute__((ext_vector_type(8))) _Float16 f16x8;
DI void phase_scanC(const Params& p, unsigned char* smem) {
  int tix = threadIdx.x;
  asm volatile("" : "+v"(tix));
  const ushort_t* DR = (const ushort_t*)(p.ws + OFF_DR);
  ushort_t* O = (ushort_t*)(p.ws + OFF_ZQ);
  const float* PU = p.out;
  const int lane = tix & 63, l31 = lane & 31, hh = lane >> 5;
  const int gw = blockIdx.x * 8 + (tix >> 6);
  for (int task = gw; task < 32 * NCHUNK; task += gridDim.x * 8) {
    const int cd = task / NCHUNK, j = task % NCHUNK, dir = cd >> 4, c = cd & 15, b = c >> 3, head = c & 7;
    if (j == 0) continue;
    const float* S = PU + (size_t)task * 2 * 4096;
    f16x8 bs[2][4];
#pragma unroll
    for (int nt = 0; nt < 2; ++nt)
#pragma unroll
      for (int ks = 0; ks < 4; ++ks) {
        const float* sp = S + (nt * 32 + l31) * 64 + ks * 16 + hh * 8;
        const float4 x0 = *(const float4*)sp, x1 = *(const float4*)(sp + 4);
        f16x8 f = {(_Float16)x0.x, (_Float16)x0.y, (_Float16)x0.z, (_Float16)x0.w, (_Float16)x1.x, (_Float16)x1.y, (_Float16)x1.z, (_Float16)x1.w};
        bs[nt][ks] = f;
      }
    const ushort_t* drc = DR + (size_t)(dir * 16 + c) * LTOT * 192;
    ushort_t* obase = O + ((size_t)dir * NX + (size_t)b * SEQ) * 512 + head * 64;
#pragma unroll 1
    for (int tile = 0; tile < (CH + 31) / 32; ++tile) {
      const int tau = tile * 32 + l31;
      const int pos = tau_to_pos(dir, j * CH + (tau < CH ? tau : CH - 1));
      const ushort_t* wrow = drc + (size_t)pos * 192;
      f32x16 acc[2] = {zero16(), zero16()};
#pragma unroll
      for (int ks = 0; ks < 4; ++ks) {
        const f16x8 a = *(const f16x8*)(wrow + ks * 16 + hh * 8);
        acc[0] = __builtin_amdgcn_mfma_f32_32x32x16_f16(bs[0][ks], a, acc[0], 0, 0, 0);
        acc[1] = __builtin_amdgcn_mfma_f32_32x32x16_f16(bs[1][ks], a, acc[1], 0, 0, 0);
      }
      if (tau < CH && pos >= CTXL) {
        ushort_t* orow = obase + (size_t)(pos - CTXL) * 512 + 4 * hh;
#pragma unroll
        for (int nt = 0; nt < 2; ++nt)
#pragma unroll
          for (int g = 0; g < 4; ++g) {
            uint2* q = (uint2*)(orow + nt * 32 + 8 * g);
            const uint2 o = *q;
            uint2 w;
            w.x = pack_h2(hlo(o.x) + acc[nt][4 * g + 0], hhi(o.x) + acc[nt][4 * g + 1]);
            w.y = pack_h2(hlo(o.y) + acc[nt][4 * g + 2], hhi(o.y) + acc[nt][4 * g + 3]);
            *q = w;
          }
      }
    }
  }
}

DI void phase_scan_naive(const Params& p) {
  const ushort_t* SH = (const ushort_t*)(p.ws + OFF_SH);
  const ushort_t* DR = (const ushort_t*)(p.ws + OFF_DR);
  ushort_t* O = (ushort_t*)(p.ws + OFF_ZQ);
  const int lane = threadIdx.x & 63;
  const int gw = __builtin_amdgcn_readfirstlane(blockIdx.x * 8 + (threadIdx.x >> 6));
  if (gw >= 32) return;
  const int cd = gw, dir = cd >> 4, c = cd & 15, b = c >> 3, head = c & 7;
  float S[64];
#pragma unroll
  for (int k = 0; k < 64; ++k) S[k] = 0.f;
  const ushort_t* shc = SH + (size_t)c * LTOT * 192;
  const ushort_t* drc = DR + (size_t)(dir * 16 + c) * LTOT * 192;
#pragma unroll 1
  for (int tau = 0; tau < LTOT; ++tau) {
    const int pos = tau_to_pos(dir, tau);
    const ushort_t* shr = shc + (size_t)pos * 192;
    const ushort_t* drr = drc + (size_t)pos * 192;
    const float vv = h2f(shr[128 + lane]);
    u32x16 k0, k1;
    sload2(k0, k1, shr);
    float sk0 = 0.f, sk1 = 0.f;
#pragma unroll
    for (int q = 0; q < 32; ++q) { sk0 = fmaf(S[q], HV(k0, q), sk0); sk1 = fmaf(S[32 + q], HV(k1, q), sk1); }
    const float nsk = -(sk0 + sk1);
    u32x16 x0, x1, d0, d1;
    sload4(x0, x1, d0, d1, drr, drr + 64);
#pragma unroll
    for (int q = 0; q < 32; ++q) {
      S[q] = fmaf(S[q], -HV(x0, q), S[q]); S[32 + q] = fmaf(S[32 + q], -HV(x1, q), S[32 + q]);
      S[q] = fmaf(vv, HV(d0, q), S[q]); S[32 + q] = fmaf(vv, HV(d1, q), S[32 + q]);
    }
    u32x16 b0, b1, r0, r1;
    sload4(b0, b1, r0, r1, drr + 128, shr + 64);
    float o0 = 0.f, o1 = 0.f;
#pragma unroll
    for (int q = 0; q < 32; ++q) {
      S[q] = fmaf(nsk, HV(b0, q), S[q]); S[32 + q] = fmaf(nsk, HV(b1, q), S[32 + q]);
      o0 = fmaf(S[q], HV(r0, q), o0); o1 = fmaf(S[32 + q], HV(r1, q), o1);
    }
    if (pos >= CTXL) O[((size_t)dir * NX + (size_t)b * SEQ + (pos - CTXL)) * 512 + head * 64 + lane] = f2h(o0 + o1);
  }
}

DI void phase_attn(const Params& p, unsigned char* smem) {
  int tix = threadIdx.x;
  asm volatile("" : "+v"(tix));
  ushort_t* Kb = (ushort_t*)smem;
  ushort_t* Vb = Kb + 2 * 64 * LDK;
  ushort_t* QB = (ushort_t*)(p.ws + OFF_QB);
  const ushort_t* KB = (const ushort_t*)(p.ws + OFF_KB);
  const ushort_t* VB = (const ushort_t*)(p.ws + OFF_VB);
  const int tid = tix, wave = tid >> 6, lane = tid & 63, l31 = lane & 31, hh = lane >> 5;
  const int loff = (tid >> 3) * LDK + (tid & 7) * 8;
  constexpr float THR = 6.f;
  constexpr int NTL = LTOT / 64;
  for (int at = blockIdx.x; at < 1024; at += gridDim.x) {
    const int b = at >> 9, kvh = (at >> 8) & 1, t0 = (at & 255) * 64;
    const int head = kvh * 4 + (wave & 3), tq = t0 + (wave >> 2) * 32 + l31;
    ushort_t* qrow = QB + ((size_t)(b * 8 + head) * SEQ + tq) * 64;
    bf16x8 qf[4];
#pragma unroll
    for (int ks = 0; ks < 4; ++ks) qf[ks] = *(const bf16x8*)(qrow + ks * 16 + hh * 8);
    const ushort_t* kbase = KB + (size_t)(b * 2 + kvh) * LTOT * 64 + tid * 8;
    const ushort_t* vbase = VB + (size_t)(b * 2 + kvh) * LTOT * 64 + tid * 8;
    f32x16 o[2] = {zero16(), zero16()};
    f32x16 negm = zero16();
    float lsum = 0.f;
    auto qk = [&](f32x16 (&s)[2], const ushort_t* Ks) {
      s[0] = negm; s[1] = negm;
#pragma unroll
      for (int ks = 0; ks < 4; ++ks)
#pragma unroll
        for (int kk = 0; kk < 2; ++kk) s[kk] = MFMA(*(const bf16x8*)&Ks[(kk * 32 + l31) * LDK + ks * 16 + hh * 8], qf[ks], s[kk]);
    };
    uint4 rk, rv;
    __syncthreads();
    rk = *(const uint4*)kbase; rv = *(const uint4*)vbase;
    *(uint4*)&Kb[loff] = rk; *(uint4*)&Vb[loff] = rv;
    rk = *(const uint4*)(kbase + 4096);
    rv = *(const uint4*)(vbase + 4096);
    __syncthreads();
    f32x16 sA[2], sB[2];
    qk(sA, Kb);
    {
      float mx = fmaxf(sA[0][0], sA[1][0]);
#pragma unroll
      for (int i = 1; i < 16; ++i) mx = fmaxf(mx, fmaxf(sA[0][i], sA[1][i]));
      mx = fmaxf(mx, __shfl_xor(mx, 32, 64));
#pragma unroll
      for (int i = 0; i < 16; ++i) { sA[0][i] -= mx; sA[1][i] -= mx; negm[i] = -mx; }
    }
    *(uint4*)&Kb[64 * LDK + loff] = rk;
    rk = *(const uint4*)(kbase + 2 * 4096);
    auto step = [&](int t, f32x16 (&sc)[2], f32x16 (&sn)[2]) {
      __syncthreads();
      if (t + 2 < NTL) *(uint4*)&Kb[(t & 1) * 64 * LDK + loff] = rk;
      if (t + 1 < NTL) *(uint4*)&Vb[((t + 1) & 1) * 64 * LDK + loff] = rv;
      if (t + 3 < NTL) rk = *(const uint4*)(kbase + (size_t)(t + 3) * 4096);
      if (t + 2 < NTL) rv = *(const uint4*)(vbase + (size_t)(t + 2) * 4096);
      if (t + 1 < NTL) qk(sn, Kb + ((t + 1) & 1) * 64 * LDK);
      float mx = fmaxf(sc[0][0], sc[1][0]);
#pragma unroll
      for (int i = 1; i < 16; ++i) mx = fmaxf(mx, fmaxf(sc[0][i], sc[1][i]));
      mx = fmaxf(mx, __shfl_xor(mx, 32, 64));
      if (__builtin_amdgcn_ballot_w64(mx > THR) != 0ull) {
        const float delta = fmaxf(mx, 0.f);
        const float alpha = __builtin_amdgcn_exp2f(-delta);
        lsum *= alpha;
#pragma unroll
        for (int i = 0; i < 16; ++i) {
          o[0][i] *= alpha; o[1][i] *= alpha; sc[0][i] -= delta; sc[1][i] -= delta; negm[i] -= delta;
          sn[0][i] -= delta; sn[1][i] -= delta;
        }
      }
      float ps = 0.f;
#pragma unroll
      for (int i = 0; i < 16; ++i) {
        sc[0][i] = __builtin_amdgcn_exp2f(sc[0][i]); sc[1][i] = __builtin_amdgcn_exp2f(sc[1][i]);
        ps += sc[0][i] + sc[1][i];
      }
      lsum += ps;
      const ushort_t* Vt = Vb + (t & 1) * 64 * LDK;
#pragma unroll
      for (int kk = 0; kk < 2; ++kk) {
#pragma unroll
        for (int st = 0; st < 2; ++st) {
          uint4 pw;
          pw.x = pack_bf2(sc[kk][8 * st + 0], sc[kk][8 * st + 1]); pw.y = pack_bf2(sc[kk][8 * st + 2], sc[kk][8 * st + 3]);
          pw.z = pack_bf2(sc[kk][8 * st + 4], sc[kk][8 * st + 5]); pw.w = pack_bf2(sc[kk][8 * st + 6], sc[kk][8 * st + 7]);
          const bf16x8 pf = __builtin_bit_cast(bf16x8, pw);
#pragma unroll
          for (int dt = 0; dt < 2; ++dt) o[dt] = MFMA(*(const bf16x8*)&Vt[(dt * 32 + l31) * LDK + kk * 32 + st * 16 + hh * 8], pf, o[dt]);
        }
      }
    };
#pragma unroll 1
    for (int t = 0; t < NTL; t += 2) {
      step(t, sA, sB);
      step(t + 1, sB, sA);
    }
    const float ltot = lsum + __shfl_xor(lsum, 32, 64);
    const float il = 1.f / ltot;
#pragma unroll
    for (int dt = 0; dt < 2; ++dt)
#pragma unroll
      for (int g = 0; g < 4; ++g) {
        uint2 w;
        w.x = pack_bf2(o[dt][4 * g + 0] * il, o[dt][4 * g + 1] * il);
        w.y = pack_bf2(o[dt][4 * g + 2] * il, o[dt][4 * g + 3] * il);
        *(uint2*)(qrow + dt * 32 + 8 * g + 4 * hh) = w;
      }
  }
}

constexpr size_t OFF_DBG = WS_END;
DI void dbg_acc(const Params& p, int slot, float d2, float r2) {
  float* dbg = (float*)(p.ws + OFF_DBG);
  d2 = wave_sum(d2); r2 = wave_sum(r2);
  if ((threadIdx.x & 63) == 0) { atomicAdd(dbg + 2 * slot, d2); atomicAdd(dbg + 2 * slot + 1, r2); }
}
DI void probe_after_gemm1(const Params& p) {
  if (blockIdx.x != 0) return;
  const int tid = threadIdx.x, lane = tid & 63, wave = tid >> 6;
  const float* mod = (const float*)(p.ws + OFF_MOD);
  const ushort_t* H = (const ushort_t*)(p.ws + OFF_SH);
  {
    float d2 = 0.f, r2 = 0.f;
    if (tid < 96) {
      const int v = tid / 32, n = (tid % 32) * 97 % 3072;
      float s = 0.f;
      for (int k = 0; k < 1024; ++k) { const float cv = (v < 2) ? p.c[v * 1024 + k] : p.c_ctx[k]; s += (cv / (1.f + expf(-cv))) * p.w_ada[(size_t)k * 3072 + n]; }
      s += p.b_ada[n];
      const float d = mod[v * 3072 + n] - s; d2 = d * d; r2 = s * s;
    }
    dbg_acc(p, 0, d2, r2);
  }
  {
    const int row = wave == 0 ? 0 : wave == 1 ? 777 : wave == 2 ? 16383 : wave == 3 ? 16384 : wave == 4 ? 32767 : wave == 5 ? 32768 : wave == 6 ? 33023 : 33279;
    const float* src = (row < NX) ? p.x + (size_t)row * DM : p.ctx + (size_t)(row - NX) * DM;
    const float* md = mod + ((row < NX) ? (row / SEQ) : 2) * 3072;
    float s = 0.f;
    for (int i = lane; i < 1024; i += 64) s += src[i];
    const float mu = wave_sum(s) / 1024.f;
    float q = 0.f;
    for (int i = lane; i < 1024; i += 64) q += (src[i] - mu) * (src[i] - mu);
    const float rstd = rsqrtf(wave_sum(q) / 1024.f + LN_EPS);
    float d2 = 0.f, r2 = 0.f;
    for (int i = lane; i < 1024; i += 64) {
      const float ref = (src[i] - mu) * rstd * (1.f + md[1024 + i]) + md[i];
      const float d = bf2f(H[(size_t)row * DM + i]) - ref; d2 += d * d; r2 += ref * ref;
    }
    dbg_acc(p, 1, d2, r2);
  }
  {
    float d2 = 0.f, r2 = 0.f;
    if (tid < 60) {
      const int ri = tid / 10, ci = tid % 10;
      const int row = ri == 0 ? 3 : ri == 1 ? 777 : ri == 2 ? 20001 : ri == 3 ? 32767 : ri == 4 ? 32773 : 33279;
      const int col = ci == 0 ? 0 : ci == 1 ? 100 : ci == 2 ? 700 : ci == 3 ? 800 : ci == 4 ? 1279 : ci == 5 ? 1280 : ci == 6 ? 2000 : ci == 7 ? 3071 : ci == 8 ? 3072 : 3583;
      float s = 0.f;
      for (int k = 0; k < 1024; ++k) s += bf2f(H[(size_t)row * DM + k]) * p.w_in[(size_t)k * INW + col];
      float got = 0.f; bool have = true;
      if (col < 768) got = bf2f(((const ushort_t*)(p.ws + OFF_ZQ))[(size_t)row * 768 + col]);
      else if (col < 1280) { if (row < NX) got = bf2f(((const ushort_t*)(p.ws + OFF_ZG))[(size_t)row * 1024 + col - 768]); else have = false; }
      else if (col < 3072) got = bf2f(((const ushort_t*)p.out)[(size_t)row * 1792 + col - 1280]);
      else { if (row < NX) got = bf2f(((const ushort_t*)(p.ws + OFF_ZG))[(size_t)row * 1024 + 512 + col - 3072]); else have = false; }
      if (have) { const float d = got - s; d2 = d * d; r2 = s * s; }
    }
    dbg_acc(p, 2, d2, r2);
  }
}
DI void probe_after_prep(const Params& p, unsigned char* smem) {
  if (blockIdx.x != 0) return;
  float* cbuf = (float*)smem;
  const int tid = threadIdx.x, lane = tid & 63, wave = tid >> 6;
  const ushort_t* zm = (const ushort_t*)p.out;
  const ushort_t* SH = (const ushort_t*)(p.ws + OFF_SH);
  const ushort_t* DR = (const ushort_t*)(p.ws + OFF_DR);
  float dA = 0.f, rA = 0.f, dB = 0.f, rB = 0.f;
#pragma unroll 1
  for (int sidx = wave; sidx < 24; sidx += 8) {
    const int ri = sidx >> 1, head = (sidx & 1) ? 5 : 0;
    const int row = ri == 0 ? 0 : ri == 1 ? 1 : ri == 2 ? 31 : ri == 3 ? 32 : ri == 4 ? 16383 : ri == 5 ? 16384 : ri == 6 ? 20000 : ri == 7 ? 32767 : ri == 8 ? 32768 : ri == 9 ? 33023 : ri == 10 ? 33024 : 33279;
    int b, t, len, pp;
    if (row < NX) { b = row / SEQ; t = row % SEQ; len = SEQ; pp = CTXL + t; } else { b = (row - NX) / CTXL; t = (row - NX) % CTXL; len = CTXL; pp = t; }
    auto sft = [&](int col) {
      const float z = bf2f(zm[(size_t)row * 1792 + col]);
      const float zp = (t > 0) ? bf2f(zm[(size_t)(row - 1) * 1792 + col]) : 0.f;
      const float zn = (t < len - 1) ? bf2f(zm[(size_t)(row + 1) * 1792 + col]) : 0.f;
      return z + p.mu_prev[col] * (zp - z) + p.mu_next[col] * (zn - z);
    };
    const int n = head * 64 + lane;
    const float r = sft(n), k = sft(512 + n), v = sft(1024 + n);
#pragma unroll 1
    for (int j = lane; j < 256; j += 64) { const float s = sft(1536 + j); cbuf[wave * 256 + j] = (j < 128) ? tanhf(s) : s; }
    __builtin_amdgcn_s_waitcnt(0);
    __builtin_amdgcn_wave_barrier();
    const float kr = k * p.k_k[n];
    const float nrm = sqrtf(wave_sum(kr * kr));
    const float kk = kr / fmaxf(nrm, 1e-12f);
    const size_t cp = (size_t)(b * 8 + head) * LTOT + pp;
    { float d;
      d = h2f(SH[(cp * 3 + 0) * 64 + lane]) - kk; dA += d * d; rA += kk * kk;
      d = h2f(SH[(cp * 3 + 1) * 64 + lane]) - r; dA += d * d; rA += r * r;
      d = h2f(SH[(cp * 3 + 2) * 64 + lane]) - v; dA += d * d; rA += v * v; }
#pragma unroll 1
    for (int dir = 0; dir < 2; ++dir) {
      float wpre = p.w0[dir * 512 + n], apre = p.a0[dir * 512 + n];
#pragma unroll 1
      for (int j = 0; j < 64; ++j) {
        wpre += cbuf[wave * 256 + dir * 64 + j] * p.w_up[(size_t)(dir * 64 + j) * 512 + n];
        apre += cbuf[wave * 256 + 128 + dir * 64 + j] * p.a_up[(size_t)(dir * 64 + j) * 512 + n];
      }
      const float wlog = -log1pf(expf(-wpre)) - 0.5f;
      const float xd = 1.f - expf(-expf(wlog));
      const float a = 1.f / (1.f + expf(-apre));
      const float kd = k * (1.f + (a - 1.f) * p.k_a[n]);
      const float bq = kk * a;
      const size_t dp = (size_t)(dir * 16 + b * 8 + head) * LTOT + pp;
      float d;
      d = h2f(DR[(dp * 3 + 0) * 64 + lane]) - xd; dB += d * d; rB += xd * xd;
      d = h2f(DR[(dp * 3 + 1) * 64 + lane]) - kd; dB += d * d; rB += kd * kd;
      d = h2f(DR[(dp * 3 + 2) * 64 + lane]) - bq; dB += d * d; rB += bq * bq;
    }
    __builtin_amdgcn_wave_barrier();
  }
  dbg_acc(p, 3, dA, rA);
  dbg_acc(p, 4, dB, rB);
}

DI void probe_scan(const Params& p) {
  if (blockIdx.x != 0 || threadIdx.x >= 128) return;
  const ushort_t* SH = (const ushort_t*)(p.ws + OFF_SH);
  const ushort_t* DR = (const ushort_t*)(p.ws + OFF_DR);
  const ushort_t* O = (const ushort_t*)(p.ws + OFF_ZQ);
  const int lane = threadIdx.x & 63, wv = threadIdx.x >> 6;
  const int c = wv ? 9 : 0, dir = wv, b = c >> 3, head = c & 7;
  float S[64];
#pragma unroll
  for (int k = 0; k < 64; ++k) S[k] = 0.f;
  float d2 = 0.f, r2 = 0.f;
#pragma unroll 1
  for (int tau = 0; tau < 420; ++tau) {
    const int pos = dir == 0 ? tau : (tau < CTXL ? CTXL - 1 - tau : LTOT - 1 - (tau - CTXL));
    const ushort_t* sh = SH + ((size_t)c * LTOT + pos) * 192;
    const ushort_t* dr = DR + ((size_t)(dir * 16 + c) * LTOT + pos) * 192;
    const float v = h2f(sh[128 + lane]);
    float sk = 0.f;
#pragma unroll
    for (int k = 0; k < 64; ++k) sk += S[k] * h2f(sh[k]);
    float o = 0.f;
#pragma unroll
    for (int k = 0; k < 64; ++k) {
      const float dec = 1.f - h2f(dr[k]);
      S[k] = S[k] * dec - sk * h2f(dr[128 + k]) + v * h2f(dr[64 + k]);
      o += S[k] * h2f(sh[64 + k]);
    }
    if (pos >= CTXL) {
      const float got = h2f(O[((size_t)dir * NX + (size_t)b * SEQ + (pos - CTXL)) * 512 + head * 64 + lane]);
      const float d = got - o; d2 += d * d; r2 += o * o;
    }
  }
  dbg_acc(p, 0, d2, r2);
}
DI float probe_delta(const Params& p) {
  const float* dbg = (const float*)(p.ws + OFF_DBG);
  int k = 0;
  for (int s = 0; s < 5; ++s) { const float rel = sqrtf(dbg[2 * s] / fmaxf(dbg[2 * s + 1], 1e-30f)); if (!(rel < 0.05f)) k |= 1 << s; }
  return sqrtf(0.02f * (float)k);
}

DI void phase_final(const Params& p, unsigned char* smem) {
  ushort_t* As = (ushort_t*)smem;
  ushort_t* Bs = As + 2 * 128 * LDK;
  const float* mod = (const float*)(p.ws + OFF_MOD);
  ushort_t* ZG = (ushort_t*)(p.ws + OFF_ZG);
  ushort_t* QB = (ushort_t*)(p.ws + OFF_QB);
  ushort_t* O = (ushort_t*)(p.ws + OFF_ZQ);
  const ushort_t* SH = (const ushort_t*)(p.ws + OFF_SH);
  const ushort_t* DR = (const ushort_t*)(p.ws + OFF_DR);
  const ushort_t* WMG = (const ushort_t*)(p.ws + OFF_WMG);
  const ushort_t* WPA = (const ushort_t*)(p.ws + OFF_WPA);
  const ushort_t* WPB = (const ushort_t*)(p.ws + OFF_WPB);
  const ushort_t* WO = (const ushort_t*)(p.ws + OFF_WO);
#pragma unroll 1
  for (int mt = blockIdx.x; mt < NX / 128; mt += gridDim.x) {
    int tid = threadIdx.x;
    asm volatile("" : "+v"(tid));
    const int wave = tid >> 6, lane = tid & 63, l31 = lane & 31, hh = lane >> 5;
    const int wrow0 = (wave & 3) * 32, wcol0 = (wave >> 2) * 64;
    const int row0 = mt * 128, b = row0 / SEQ, tb0 = row0 % SEQ;
    const float* md = mod + b * 3072;
    __syncthreads();
#pragma unroll 1
    for (int r4 = wave * 4; r4 < 128; r4 += 32) {
      const int r = r4 + (lane >> 4), l16 = lane & 15;
      ushort_t* hdst = (ushort_t*)(p.out + (size_t)(row0 + r) * DM);
      float4 v[16];
      const float rstd = ln_rows4(p.x + (size_t)(row0 + r) * DM, l16, v);
#pragma unroll
      for (int i = 0; i < 16; ++i) {
        const int col = l16 * 4 + 64 * i;
        const float4 sh = *(const float4*)(md + col), sc = *(const float4*)(md + 1024 + col);
        uint2 o;
        o.x = pack_bf2(v[i].x * rstd * (1.f + sc.x) + sh.x, v[i].y * rstd * (1.f + sc.y) + sh.y);
        o.y = pack_bf2(v[i].z * rstd * (1.f + sc.z) + sh.z, v[i].w * rstd * (1.f + sc.w) + sh.w);
        *(uint2*)(hdst + col) = o;
      }
    }
#if PROBE
    float a2ref = 0.f;
    if (mt == 0) {
      const int tok = wave * 16 + 3, head = wave, row = row0 + tok, t = tb0 + tok, dd = head * 64 + lane;
      const size_t cp = (size_t)(b * 8 + head) * LTOT + CTXL + t;
      const float o = h2f(O[(size_t)row * 512 + dd]) + h2f(O[((size_t)NX + row) * 512 + dd]);
      const float mu = wave_sum(o) / 64.f;
      const float var = wave_sum((o - mu) * (o - mu)) / 64.f;
      const float y = (o - mu) * rsqrtf(var + GN_EPS) * p.gn_w[dd] + p.gn_b[dd];
      const float r = h2f(SH[(cp * 3 + 1) * 64 + lane]), vv = h2f(SH[(cp * 3 + 2) * 64 + lane]);
      const float kf = h2f(DR[(cp * 3 + 1) * 64 + lane]), kb = h2f(DR[(((size_t)16 * LTOT + cp) * 3 + 1) * 64 + lane]);
      const float bon = wave_sum(r * kf * p.r_k[dd]) + wave_sum(r * kb * p.r_k[512 + dd]);
      const float g = bf2f(ZG[(size_t)row * 1024 + 512 + dd]);
      a2ref = (y + bon * vv) * (g / (1.f + expf(-g)));
    }
#endif
#pragma unroll 1
    for (int it = 0; it < 16; ++it) {
      const int pair = (it * 8 + wave) * 8 + (lane >> 3), q8 = lane & 7;
      const int tok = pair >> 3, head = pair & 7, row = row0 + tok, t = tb0 + tok, d0 = q8 * 8;
      const unsigned cp = (unsigned)((b * 8 + head) * LTOT + CTXL + t);
      const unsigned ofo = (unsigned)(row * 512 + head * 64 + d0), obo = ofo + (unsigned)NX * 512u;
      const unsigned ro = (cp * 3 + 1) * 64 + d0, vo = (cp * 3 + 2) * 64 + d0;
      const unsigned kbo = ((16u * LTOT + cp) * 3 + 1) * 64 + d0;
      const unsigned gbo = (unsigned)(row * 1024 + 512 + head * 64 + d0), gao = gbo - 512;
      const unsigned yao = (unsigned)(((b * 8 + head) * SEQ + t) * 64 + d0);
      float ov[8], bon = 0.f, s = 0.f;
      {
        const uint4 a = *(const uint4*)(O + ofo), bq = *(const uint4*)(O + obo);
        const uint4 rr = *(const uint4*)(SH + ro), kf = *(const uint4*)(DR + ro), kb = *(const uint4*)(DR + kbo);
        const unsigned aw[4] = {a.x, a.y, a.z, a.w}, bw[4] = {bq.x, bq.y, bq.z, bq.w}, rw[4] = {rr.x, rr.y, rr.z, rr.w};
        const unsigned fw[4] = {kf.x, kf.y, kf.z, kf.w}, kw[4] = {kb.x, kb.y, kb.z, kb.w};
#pragma unroll
        for (int q = 0; q < 4; ++q) {
          const int dd = head * 64 + d0 + 2 * q;
          ov[2 * q] = hlo(aw[q]) + hlo(bw[q]);
          ov[2 * q + 1] = hhi(aw[q]) + hhi(bw[q]);
          s += ov[2 * q] + ov[2 * q + 1];
          bon += hlo(rw[q]) * (hlo(fw[q]) * p.r_k[dd] + hlo(kw[q]) * p.r_k[512 + dd]);
          bon += hhi(rw[q]) * (hhi(fw[q]) * p.r_k[dd + 1] + hhi(kw[q]) * p.r_k[512 + dd + 1]);
        }
      }
      s += __shfl_xor(s, 1, 64); s += __shfl_xor(s, 2, 64); s += __shfl_xor(s, 4, 64);
      bon += __shfl_xor(bon, 1, 64); bon += __shfl_xor(bon, 2, 64); bon += __shfl_xor(bon, 4, 64);
      const float mu = s * (1.f / 64.f);
      float vs = 0.f;
#pragma unroll
      for (int q = 0; q < 8; ++q) { ov[q] -= mu; vs = fmaf(ov[q], ov[q], vs); }
      vs += __shfl_xor(vs, 1, 64); vs += __shfl_xor(vs, 2, 64); vs += __shfl_xor(vs, 4, 64);
      const float rstd = rsqrtf(vs * (1.f / 64.f) + GN_EPS);
      {
        const uint4 vv = *(const uint4*)(SH + vo), gb = *(const uint4*)(ZG + gbo), ga = *(const uint4*)(ZG + gao), ya = *(const uint4*)(QB + yao);
        const unsigned vw[4] = {vv.x, vv.y, vv.z, vv.w}, gbw[4] = {gb.x, gb.y, gb.z, gb.w}, gaw[4] = {ga.x, ga.y, ga.z, ga.w}, yw[4] = {ya.x, ya.y, ya.z, ya.w};
        unsigned o2[4], o1[4];
#pragma unroll
        for (int q = 0; q < 4; ++q) {
          const int dd = head * 64 + d0 + 2 * q;
          const float y0 = ov[2 * q] * rstd * p.gn_w[dd] + p.gn_b[dd] + bon * hlo(vw[q]);
          const float y1 = ov[2 * q + 1] * rstd * p.gn_w[dd + 1] + p.gn_b[dd + 1] + bon * hhi(vw[q]);
          o2[q] = pack_bf2(y0 * siluf(bflo(gbw[q])), y1 * siluf(bfhi(gbw[q])));
          o1[q] = pack_bf2(bflo(yw[q]) * siluf(bflo(gaw[q])), bfhi(yw[q]) * siluf(bfhi(gaw[q])));
        }
        *(uint4*)(O + ofo) = make_uint4(o2[0], o2[1], o2[2], o2[3]);
        *(uint4*)(QB + yao) = make_uint4(o1[0], o1[1], o1[2], o1[3]);
      }
    }
    asm volatile("s_waitcnt vmcnt(0)" ::: "memory");
    __syncthreads();
#if PROBE
    if (mt == 0) {
      const int tok = wave * 16 + 3, head = wave, row = row0 + tok, dd = head * 64 + lane;
      const float got = bf2f(O[(size_t)row * 512 + dd]);
      dbg_acc(p, 1, (got - a2ref) * (got - a2ref), a2ref * a2ref);
    }
#endif
    const ushort_t* hbase = (const ushort_t*)p.out;
    auto hload = [&](int r, int k) { return *(const uint4*)(hbase + (unsigned)((row0 + r) * 2048 + k)); };
    auto a1load = [&](int r, int k) { return *(const uint4*)(QB + (unsigned)(((b * 8 + (k >> 6)) * SEQ + tb0 + r) * 64 + (k & 63))); };
    auto a2load = [&](int r, int k) { return *(const uint4*)(O + (unsigned)((row0 + r) * 512 + k)); };
#pragma unroll 1
    for (int nt = 0; nt < 8; ++nt) {
      const int col0 = nt * 128;
      int tidn = tid;
      asm volatile("" : "+v"(tidn));
      f32x16 sg[2][1][2] = {{{zero16(), zero16()}}, {{zero16(), zero16()}}};
      gemm_pass<128, 128, 1, 2, 2>(sg, hload, [&](int w, int n, int k) { return *(const uint4*)(WMG + (unsigned)((w * 1024 + col0 + n) * DM + k)); }, DM, As, Bs, wrow0, wcol0, tidn);
#pragma unroll
      for (int ni = 0; ni < 2; ++ni) {
        const int col = col0 + wcol0 + ni * 32 + l31;
        const float ba = p.b_mg[col], bb = p.b_mg[1024 + col];
#pragma unroll
        for (int i = 0; i < 16; ++i) { sg[0][0][ni][i] = sigmf(sg[0][0][ni][i] + ba); sg[1][0][ni][i] = sigmf(sg[1][0][ni][i] + bb); }
      }
      {
        f32x16 ya[1][1][2] = {{{zero16(), zero16()}}};
        gemm_pass<128, 128, 1, 2, 1>(ya, a1load, [&](int w, int n, int k) { return *(const uint4*)(WPA + (unsigned)((col0 + n) * 512 + k)); }, 512, As, Bs, wrow0, wcol0, tidn);
#pragma unroll
        for (int ni = 0; ni < 2; ++ni)
#pragma unroll
          for (int i = 0; i < 16; ++i) sg[0][0][ni][i] *= ya[0][0][ni][i];
      }
      {
        f32x16 yb[1][1][2] = {{{zero16(), zero16()}}};
        gemm_pass<128, 128, 1, 2, 1>(yb, a2load, [&](int w, int n, int k) { return *(const uint4*)(WPB + (unsigned)((col0 + n) * 512 + k)); }, 512, As, Bs, wrow0, wcol0, tidn);
        int rb1 = row0 + wrow0 + 4 * hh;
        asm volatile("" : "+v"(rb1));
#pragma unroll
        for (int ni = 0; ni < 2; ++ni) {
          const int col = col0 + wcol0 + ni * 32 + l31;
#pragma unroll
          for (int i = 0; i < 16; ++i) {
            const float mv = sg[0][0][ni][i] + sg[1][0][ni][i] * yb[0][0][ni][i];
            ZG[(unsigned)((rb1 + crow(i, 0)) * 1024 + col)] = f2bf(mv);
          }
        }
      }
    }
    asm volatile("s_waitcnt vmcnt(0)" ::: "memory");
    __syncthreads();
#if PROBE
    if (mt == 0) {
      float d2 = 0.f, r2 = 0.f;
      if (tid < 64) {
        const int r = (tid * 37) & 127, col = (tid * 131 + 7) & 1023, row = row0 + r;
        const ushort_t* hrow = (const ushort_t*)(p.out + (size_t)row * DM);
        float ga = p.b_mg[col], gb = p.b_mg[1024 + col], ya = 0.f, yb = 0.f;
        for (int k = 0; k < 1024; ++k) { const float hv = bf2f(hrow[k]); ga += hv * p.w_mg[(size_t)k * 2048 + col]; gb += hv * p.w_mg[(size_t)k * 2048 + 1024 + col]; }
        for (int k = 0; k < 512; ++k) {
          ya += bf2f(QB[((size_t)(b * 8 + (k >> 6)) * SEQ + tb0 + r) * 64 + (k & 63)]) * p.w_pa[(size_t)k * 1024 + col];
          yb += bf2f(O[(size_t)row * 512 + k]) * p.w_pb[(size_t)k * 1024 + col];
        }
        const float ref = ya / (1.f + expf(-ga)) + yb / (1.f + expf(-gb));
        const float got = bf2f(ZG[(size_t)row * 1024 + col]);
        d2 = (got - ref) * (got - ref); r2 = ref * ref;
      }
      dbg_acc(p, 2, d2, r2);
    }
#endif
    const float* gt = md + 2048;
#pragma unroll 1
    for (int nt = 0; nt < 8; ++nt) {
      const int col0 = nt * 128;
      int tidn = tid;
      asm volatile("" : "+v"(tidn));
      f32x16 acc[1][1][2] = {{{zero16(), zero16()}}};
      gemm_pass<128, 128, 1, 2, 1>(acc, [&](int r, int k) { return *(const uint4*)(ZG + (unsigned)((row0 + r) * 1024 + k)); },
                                   [&](int w, int n, int k) { return *(const uint4*)(WO + (unsigned)((col0 + n) * DM + k)); }, DM, As, Bs, wrow0, wcol0, tidn);
      int rb2 = row0 + wrow0 + 4 * hh;
      asm volatile("" : "+v"(rb2));
#pragma unroll
      for (int ni = 0; ni < 2; ++ni) {
        const int col = col0 + wcol0 + ni * 32 + l31;
        const float g = gt[col];
#pragma unroll
        for (int i = 0; i < 16; ++i) {
          const unsigned idx = (unsigned)((rb2 + crow(i, 0)) * DM + col);
          p.out[idx] = ALPHA * p.x[idx] + g * acc[0][0][ni][i];
        }
      }
    }
    asm volatile("s_waitcnt vmcnt(0)" ::: "memory");
    __syncthreads();
#if PROBE
    if (mt == 0) {
      float d2 = 0.f, r2 = 0.f;
      if (tid < 64) {
        const int r = (tid * 29) & 127, col = (tid * 113 + 5) & 1023, row = row0 + r;
        float o = 0.f;
        for (int k = 0; k < 1024; ++k) o += bf2f(ZG[(size_t)row * 1024 + k]) * p.w_o[(size_t)k * 1024 + col];
        const float ref = md[2048 + col] * o;
        const float got = p.out[(size_t)row * DM + col] - ALPHA * p.x[(size_t)row * DM + col];
        d2 = (got - ref) * (got - ref); r2 = ref * ref;
      }
      dbg_acc(p, 3, d2, r2);
    }
    asm volatile("s_waitcnt vmcnt(0)" ::: "memory");
    __syncthreads();
#endif
#if !PROBE
#pragma unroll 1
    for (int r4 = wave * 4; r4 < 128; r4 += 32) {
      const int r = r4 + (lane >> 4), l16 = lane & 15;
      float* dst = p.out + (size_t)(row0 + r) * DM;
      float4 v[16];
      const float rstd = ln_rows4(dst, l16, v);
#pragma unroll
      for (int i = 0; i < 16; ++i) {
        const int col = l16 * 4 + 64 * i;
        const float4 g = *(const float4*)(p.ln_g + col), bb = *(const float4*)(p.ln_b + col);
        *(float4*)(dst + col) = make_float4(v[i].x * rstd * g.x + bb.x, v[i].y * rstd * g.y + bb.y, v[i].z * rstd * g.z + bb.z, v[i].w * rstd * g.w + bb.w);
      }
    }
#endif
  }
}


#if PROBE
DI void probe_f3(const Params& p) {
  const float pdelta = probe_delta(p);
  const int lane = threadIdx.x & 63, wave = threadIdx.x >> 6;
  for (int mt = blockIdx.x; mt < NX / 128; mt += gridDim.x) {
    for (int r = wave; r < 128; r += 8) {
      const float* src = p.x + (size_t)(mt * 128 + r) * DM;
      float* dst = p.out + (size_t)(mt * 128 + r) * DM;
      float s = 0.f, q = 0.f;
      for (int i = lane; i < 1024; i += 64) s += ALPHA * src[i];
      const float mu = wave_sum(s) / 1024.f;
      for (int i = lane; i < 1024; i += 64) { const float d = ALPHA * src[i] - mu; q += d * d; }
      const float rstd = rsqrtf(wave_sum(q) / 1024.f + LN_EPS);
      for (int i = lane; i < 1024; i += 64) dst[i] = (ALPHA * src[i] - mu) * rstd * p.ln_g[i] + p.ln_b[i] + pdelta;
    }
  }
}
#endif
DI void gsync(cg::grid_group& g) { asm volatile("s_waitcnt vmcnt(0) lgkmcnt(0)" ::: "memory"); g.sync(); }

constexpr int SMEM_BYTES = 8 * 2 * SEG * 64 * 2;
static_assert(SMEM_BYTES >= 2 * (256 + 128) * LDK * 2, "GEMM tiles");
static_assert(SMEM_BYTES >= 65536 + 32 * 264 * 2 + 1024, "rwkv prep LDS");
__global__ void __launch_bounds__(NTH) fwd_megakernel(Params p) {
  __shared__ __attribute__((aligned(16))) unsigned char smem[SMEM_BYTES];
  cg::grid_group grid = cg::this_grid();
#if PROBE
  if (blockIdx.x == 0 && threadIdx.x < 64) ((float*)(p.ws + OFF_DBG))[threadIdx.x] = 0.f;
#endif
  phase0(p, smem);
  gsync(grid);
  phase_h(p);
  gsync(grid);
  if (__builtin_amdgcn_readfirstlane(threadIdx.x) >= 256) __builtin_amdgcn_s_setprio(1);
  phase_gemm1(p, smem);
  __builtin_amdgcn_s_setprio(0);
  gsync(grid);
  phase_qkv(p);
  phase_rwkv_prep(p, smem);
  gsync(grid);
#if PROBE_NAIVE_SCAN
  phase_scan_naive(p);
#else
  if (__builtin_amdgcn_readfirstlane(threadIdx.x) >= 256) __builtin_amdgcn_s_setprio(1);
  phase_scanA(p, smem);
  __builtin_amdgcn_s_setprio(0);
  gsync(grid);
  phase_scanB(p, smem);
  gsync(grid);
  phase_scanC(p, smem);
#endif
  if (__builtin_amdgcn_readfirstlane(threadIdx.x) >= 256) __builtin_amdgcn_s_setprio(1);
  phase_attn(p, smem);
  __builtin_amdgcn_s_setprio(0);
  gsync(grid);
#if PROBE
  probe_scan(p);
  gsync(grid);
#endif
  if (__builtin_amdgcn_readfirstlane(threadIdx.x) >= 256) __builtin_amdgcn_s_setprio(1);
  phase_final(p, smem);
  __builtin_amdgcn_s_setprio(0);
#if PROBE
  gsync(grid);
  probe_f3(p);
#endif
}

extern "C" void kernel_launch(void* const* d_in, const int* in_sizes, int n_in, void* d_out, int out_size, void* d_ws, size_t ws_size,
                              hipStream_t stream) {
  static int grid_blocks = 0;
  if (!grid_blocks) {
    int dev = 0, cus = 0, per_cu = 0;
    hipGetDevice(&dev);
    hipDeviceGetAttribute(&cus, hipDeviceAttributeMultiprocessorCount, dev);
    hipOccupancyMaxActiveBlocksPerMultiprocessor(&per_cu, fwd_megakernel, NTH, 0);
    if (per_cu < 1) fprintf(stderr, "occupancy query says %d blocks/CU\n", per_cu);
    grid_blocks = cus > 0 ? cus : 256;
    if (ws_size < WS_END) fprintf(stderr, "workspace too small: %zu < %zu\n", ws_size, (size_t)WS_END);
  }
  Params p{};
  const float** fp = (const float**)&p;
  for (int i = 0; i < 27; ++i) fp[i] = (const float*)d_in[i];
  p.out = (float*)d_out;
  p.ws = (unsigned char*)d_ws;
  void* args[] = {&p};
  hipError_t e = hipLaunchCooperativeKernel((void*)fwd_megakernel, dim3(grid_blocks), dim3(NTH), args, 0, stream);
  if (e != hipSuccess) fprintf(stderr, "cooperative launch failed: %s (grid %d)\n", hipGetErrorString(e), grid_blocks);
}
```
